# Optimizing an MI355X kernel written in HIP

```python
import math
import jax, jax.numpy as jnp
from jax import lax
import numpy as np

D_MODEL = 1024
BATCH = 4
SEQ = 4096
DEPTH = 1

HYENA_WIDTH = 1024
SHORT_CONV = 3
FILTER_EMB = 33
FILTER_BANDS = (FILTER_EMB - 1) // 2
FILTER_HIDDEN = 64
FILTER_OUT_SCALE = 0.04
DECAY_TARGET = 1e-2
DECAY_FAST = 0.3
DECAY_SLOW = 1.5
SGU_WIDTH = 1024
SGU_HEADS = 8
SGU_HEAD_DIM = SGU_WIDTH // SGU_HEADS
SGU_CHUNK = 128
FFN_HIDDEN = 2816
FFN_CONV = 3
EPS = 1e-6
IN_WIDTH = 3 * HYENA_WIDTH + 2 * SGU_WIDTH + 2 * D_MODEL

kernel_name = "hyena_sgu_gated_hybrid_encoder"


def rms_norm(x, g):
    xf = x.astype(jnp.float32)
    y = xf * lax.rsqrt(jnp.mean(xf * xf, axis=-1, keepdims=True) + EPS)
    return (y * g.astype(jnp.float32)).astype(x.dtype)


def depthwise_conv_centred(x, w, b):
    y = lax.conv_general_dilated(
        x, w[:, None, :].astype(x.dtype), window_strides=(1,), padding="SAME",
        dimension_numbers=("NWC", "WIO", "NWC"), feature_group_count=x.shape[-1])
    return y + b.astype(x.dtype)


def implicit_filters(L, w1, b1, w2, b2, w3, b3, freq, w4, decay):
    f32 = jnp.float32
    t = jnp.linspace(0.0, 1.0, L, dtype=f32)[:, None]
    bands = jnp.linspace(1e-4, FILTER_BANDS - 1, FILTER_BANDS, dtype=f32)[None, :]
    phase = (2.0 * math.pi / L) * jnp.arange(L, dtype=f32)[:, None] * bands
    z = jnp.concatenate([t, jnp.cos(phase), -jnp.sin(phase)], axis=-1)
    a = freq.astype(f32)
    h = jnp.sin(a * (z @ w1.astype(f32) + b1.astype(f32)))
    h = jnp.sin(a * (h @ w2.astype(f32) + b2.astype(f32)))
    h = jnp.sin(a * (h @ w3.astype(f32) + b3.astype(f32)))
    h = h @ w4.astype(f32)
    return h * jnp.exp(-t * jnp.abs(decay.astype(f32)))


def bidirectional_long_conv(u, h_fwd, h_bwd, skip):
    L, C = u.shape[1], u.shape[2]
    k = jnp.concatenate([h_fwd, jnp.zeros((1, C), jnp.float32), h_bwd[:0:-1]], axis=0)
    uf = u.astype(jnp.float32)
    spec = jnp.fft.rfft(uf, n=2 * L, axis=1) * jnp.fft.rfft(k, axis=0)[None]
    y = jnp.fft.irfft(spec, n=2 * L, axis=1)[:, :L]
    return (y + uf * skip.astype(jnp.float32)).astype(u.dtype)


def hyena_branch(p, conv_w, conv_b, fw1, fb1, fw2, fb2, fw3, fb3, ffreq, fw4, decay, skip):
    p = depthwise_conv_centred(p, conv_w, conv_b)
    x0, x1, v = jnp.split(p, 3, axis=-1)
    filt = implicit_filters(p.shape[1], fw1, fb1, fw2, fb2, fw3, fb3, ffreq, fw4, decay)
    return x0 * bidirectional_long_conv(x1 * v, filt[:, :HYENA_WIDTH], filt[:, HYENA_WIDTH:], skip)


def spatial_gating_branch(p, norm_g, w_s, b_s):
    B, L, _ = p.shape
    u, v = jnp.split(jax.nn.gelu(p, approximate=False), 2, axis=-1)
    v = rms_norm(v, norm_g).reshape(B, L // SGU_CHUNK, SGU_CHUNK, SGU_HEADS, SGU_HEAD_DIM)
    s = jnp.einsum("gpq,bnqgd->bnpgd", w_s.astype(v.dtype), v) + b_s.T.astype(v.dtype)[:, :, None]
    return u * s.reshape(B, L, SGU_WIDTH)


def hybrid_layer(x, norm1_g, w_in, hy_conv_w, hy_conv_b, filt_w1, filt_b1, filt_w2, filt_b2,
                 filt_w3, filt_b3, filt_freq, filt_w4, hy_decay, hy_skip, sgu_norm_g, sgu_w,
                 sgu_b, w_proj_hyena, w_proj_sgu, w_out, norm2_g, w_up, ffn_conv_w, ffn_conv_b,
                 w_down):
    h = rms_norm(x, norm1_g)
    proj = h @ w_in
    p_hy, p_sgu, p_gate = jnp.split(
        proj, [3 * HYENA_WIDTH, 3 * HYENA_WIDTH + 2 * SGU_WIDTH], axis=-1)
    y_a = hyena_branch(p_hy, hy_conv_w, hy_conv_b, filt_w1, filt_b1, filt_w2, filt_b2,
                       filt_w3, filt_b3, filt_freq, filt_w4, hy_decay, hy_skip)
    y_b = spatial_gating_branch(p_sgu, sgu_norm_g, sgu_w, sgu_b)
    g_a, g_b = jnp.split(jax.nn.sigmoid(p_gate), 2, axis=-1)
    merged = g_a * (y_a @ w_proj_hyena) + g_b * (y_b @ w_proj_sgu)
    x = x + merged @ w_out
    h = rms_norm(x, norm2_g)
    a, gate = jnp.split(h @ w_up, 2, axis=-1)
    a = depthwise_conv_centred(a, ffn_conv_w, ffn_conv_b)
    return x + (jax.nn.silu(a) * gate) @ w_down


def setup_inputs(seed: int = 0) -> dict:
    key = jax.random.key(seed)
    ks = iter(jax.random.split(key, 32))
    f32 = jnp.float32

    def nrm(shape, scale):
        return scale * jax.random.normal(next(ks), shape, f32)

    Dp = DEPTH
    decay_lo = math.log(DECAY_TARGET) / DECAY_SLOW
    decay_hi = math.log(DECAY_TARGET) / DECAY_FAST
    decay_base = jnp.tile(jnp.linspace(decay_lo, decay_hi, HYENA_WIDTH, dtype=f32), 2)
    return {
        "x": nrm((BATCH, SEQ, D_MODEL), 1.0),
        "norm1_g": 1.0 + nrm((Dp, D_MODEL), 0.1),
        "w_in": nrm((Dp, D_MODEL, IN_WIDTH), D_MODEL ** -0.5),
        "hy_conv_w": nrm((Dp, SHORT_CONV, 3 * HYENA_WIDTH), SHORT_CONV ** -0.5),
        "hy_conv_b": nrm((Dp, 3 * HYENA_WIDTH), 0.01),
        "filt_w1": nrm((Dp, FILTER_EMB, FILTER_HIDDEN), FILTER_EMB ** -0.5),
        "filt_b1": nrm((Dp, FILTER_HIDDEN), 0.2),
        "filt_w2": nrm((Dp, FILTER_HIDDEN, FILTER_HIDDEN), FILTER_HIDDEN ** -0.5),
        "filt_b2": nrm((Dp, FILTER_HIDDEN), 0.2),
        "filt_w3": nrm((Dp, FILTER_HIDDEN, FILTER_HIDDEN), FILTER_HIDDEN ** -0.5),
        "filt_b3": nrm((Dp, FILTER_HIDDEN), 0.2),
        "filt_freq": 1.0 + nrm((Dp, FILTER_HIDDEN), 0.1),
        "filt_w4": nrm((Dp, FILTER_HIDDEN, 2 * HYENA_WIDTH), FILTER_OUT_SCALE * FILTER_HIDDEN ** -0.5),
        "hy_decay": decay_base * (1.0 + nrm((Dp, 2 * HYENA_WIDTH), 0.05)),
        "hy_skip": nrm((Dp, HYENA_WIDTH), 0.5),
        "sgu_norm_g": 1.0 + nrm((Dp, SGU_WIDTH), 0.1),
        "sgu_w": nrm((Dp, SGU_HEADS, SGU_CHUNK, SGU_CHUNK), SGU_CHUNK ** -0.5),
        "sgu_b": 1.0 + nrm((Dp, SGU_HEADS, SGU_CHUNK), 0.1),
        "w_proj_hyena": nrm((Dp, HYENA_WIDTH, D_MODEL), HYENA_WIDTH ** -0.5),
        "w_proj_sgu": nrm((Dp, SGU_WIDTH, D_MODEL), SGU_WIDTH ** -0.5),
        "w_out": nrm((Dp, D_MODEL, D_MODEL), D_MODEL ** -0.5),
        "norm2_g": 1.0 + nrm((Dp, D_MODEL), 0.1),
        "w_up": nrm((Dp, D_MODEL, 2 * FFN_HIDDEN), D_MODEL ** -0.5),
        "ffn_conv_w": nrm((Dp, FFN_CONV, FFN_HIDDEN), FFN_CONV ** -0.5),
        "ffn_conv_b": nrm((Dp, FFN_HIDDEN), 0.01),
        "w_down": nrm((Dp, FFN_HIDDEN, D_MODEL), FFN_HIDDEN ** -0.5),
        "final_g": 1.0 + nrm((D_MODEL,), 0.1),
    }


def reference(x, norm1_g, w_in, hy_conv_w, hy_conv_b, filt_w1, filt_b1, filt_w2, filt_b2,
              filt_w3, filt_b3, filt_freq, filt_w4, hy_decay, hy_skip, sgu_norm_g, sgu_w, sgu_b,
              w_proj_hyena, w_proj_sgu, w_out, norm2_g, w_up, ffn_conv_w, ffn_conv_b, w_down,
              final_g):
    for i in range(DEPTH):
        x = hybrid_layer(
            x, norm1_g[i], w_in[i], hy_conv_w[i], hy_conv_b[i], filt_w1[i], filt_b1[i],
            filt_w2[i], filt_b2[i], filt_w3[i], filt_b3[i], filt_freq[i], filt_w4[i],
            hy_decay[i], hy_skip[i], sgu_norm_g[i], sgu_w[i], sgu_b[i], w_proj_hyena[i],
            w_proj_sgu[i], w_out[i], norm2_g[i], w_up[i], ffn_conv_w[i], ffn_conv_b[i],
            w_down[i])
    return rms_norm(x, final_g)
```

```cpp
#include <hip/hip_runtime.h>
#include <math.h>
#include <stdint.h>

namespace {
constexpr int D = 1024, NB = 4, L = 4096, HW = 1024, SW = 1024, INW = 7168, FH = 2816, FHID = 64, FEMB = 33;
constexpr float EPS = 1e-6f;

__device__ __forceinline__ float block_sum256(float v, float* red) {
#pragma unroll
    for (int o = 32; o > 0; o >>= 1) v += __shfl_xor(v, o);
    const int w = threadIdx.x >> 6;
    __syncthreads();
    if ((threadIdx.x & 63) == 0) red[w] = v;
    __syncthreads();
    return red[0] + red[1] + red[2] + red[3];
}

__global__ __launch_bounds__(64) void k_filter_mlp(const float* w1, const float* b1, const float* w2, const float* b2, const float* w3, const float* b3,
                                                   const float* freq, float* h3out) {
    __shared__ float z[64];
    __shared__ float ha[64];
    __shared__ float hb[64];
    const int l = blockIdx.x, j = threadIdx.x;
    if (j < FEMB) {
        float val;
        if (j == 0) val = (float)((double)l / (double)(L - 1));
        else {
            const int i = (j - 1) & 15;
            const double band = 1e-4 + (double)i * ((15.0 - 1e-4) / 15.0);
            double rev = (double)l * band / (double)L;
            rev -= floor(rev);
            const float ang = (float)(rev * 6.283185307179586);
            val = (j <= 16) ? cosf(ang) : -sinf(ang);
        }
        z[j] = val;
    }
    __syncthreads();
    const float a = freq[j];
    float s = b1[j];
    for (int i = 0; i < FEMB; ++i) s += z[i] * w1[i * FHID + j];
    ha[j] = sinf(a * s);
    __syncthreads();
    s = b2[j];
    for (int i = 0; i < FHID; ++i) s += ha[i] * w2[i * FHID + j];
    hb[j] = sinf(a * s);
    __syncthreads();
    s = b3[j];
    for (int i = 0; i < FHID; ++i) s += hb[i] * w3[i * FHID + j];
    h3out[l * FHID + j] = sinf(a * s);
}
__global__ __launch_bounds__(256) void k_filter_out(const float* h3, const float* w4, const float* decay, float* filtT) {
    const int l = blockIdx.x * 256 + threadIdx.x, c = blockIdx.y;
    float s = 0.f;
    for (int j = 0; j < FHID; ++j) s += h3[l * FHID + j] * w4[j * 2048 + c];
    const float t = (float)((double)l / (double)(L - 1));
    filtT[(size_t)c * L + l] = s * expf(-t * fabsf(decay[c]));
}
__global__ __launch_bounds__(256) void k_rmsnorm(const float* in, const float* in2, const float* g, float* out) {
    __shared__ float red[4];
    const size_t row = blockIdx.x;
    float4 v = ((const float4*)(in + row * D))[threadIdx.x];
    if (in2) { const float4 w = ((const float4*)(in2 + row * D))[threadIdx.x]; v.x += w.x; v.y += w.y; v.z += w.z; v.w += w.w; }
    const float ss = block_sum256(v.x * v.x + v.y * v.y + v.z * v.z + v.w * v.w, red);
    const float r = rsqrtf(ss * (1.0f / D) + EPS);
    const float4 gg = ((const float4*)g)[threadIdx.x];
    float4 o; o.x = v.x * r * gg.x; o.y = v.y * r * gg.y; o.z = v.z * r * gg.z; o.w = v.w * r * gg.w;
    ((float4*)(out + row * D))[threadIdx.x] = o;
}
__global__ __launch_bounds__(256) void k_gemm(const float* __restrict__ A, int lda, const float* __restrict__ Bm, int ldb, float* __restrict__ C, int ldc, int K) {
    __shared__ float As[16][68];
    __shared__ float Bs[16][68];
    const int tid = threadIdx.x, tx = tid & 15, ty = tid >> 4;
    const int m0 = blockIdx.y * 64, n0 = blockIdx.x * 64;
    float acc[4][4];
#pragma unroll
    for (int i = 0; i < 4; ++i)
#pragma unroll
        for (int j = 0; j < 4; ++j) acc[i][j] = 0.f;
    for (int k0 = 0; k0 < K; k0 += 16) {
        { const int r = tid >> 2, c = (tid & 3) * 4; const float4 v = *(const float4*)(A + (size_t)(m0 + r) * lda + k0 + c);
          As[c][r] = v.x; As[c + 1][r] = v.y; As[c + 2][r] = v.z; As[c + 3][r] = v.w; }
        { const int r = tid >> 4, c = (tid & 15) * 4; *(float4*)&Bs[r][c] = *(const float4*)(Bm + (size_t)(k0 + r) * ldb + n0 + c); }
        __syncthreads();
#pragma unroll
        for (int k = 0; k < 16; ++k) {
            const float4 a = *(const float4*)&As[k][ty * 4];
            const float4 b = *(const float4*)&Bs[k][tx * 4];
            const float av[4] = {a.x, a.y, a.z, a.w}, bv[4] = {b.x, b.y, b.z, b.w};
#pragma unroll
            for (int i = 0; i < 4; ++i)
#pragma unroll
                for (int j = 0; j < 4; ++j) acc[i][j] += av[i] * bv[j];
        }
        __syncthreads();
    }
#pragma unroll
    for (int i = 0; i < 4; ++i) {
        float4 o; o.x = acc[i][0]; o.y = acc[i][1]; o.z = acc[i][2]; o.w = acc[i][3];
        *(float4*)(C + (size_t)(m0 + ty * 4 + i) * ldc + n0 + tx * 4) = o;
    }
}
__global__ __launch_bounds__(256) void k_hy_prep(const float* proj, const float* cw, const float* cb, float* x0c, float* u) {
    const int t = blockIdx.x;
    for (int c = threadIdx.x; c < HW; c += 256) {
        float r[3];
#pragma unroll
        for (int p = 0; p < 3; ++p) {
            const int ch = p * HW + c;
            float s = cb[ch];
            if (t > 0) s += cw[0 * 3072 + ch] * proj[(size_t)(t - 1) * INW + ch];
            s += cw[1 * 3072 + ch] * proj[(size_t)t * INW + ch];
            if (t < L - 1) s += cw[2 * 3072 + ch] * proj[(size_t)(t + 1) * INW + ch];
            r[p] = s;
        }
        x0c[(size_t)t * HW + c] = r[0];
        u[(size_t)t * HW + c] = r[1] * r[2];
    }
}
__global__ __launch_bounds__(256) void k_longconv(const float* filtT, const float* u, const float* skip, float* x0c_ya) {
    __shared__ float kk[8192];
    __shared__ float us[4096];
    const int c = blockIdx.x, tid = threadIdx.x;
    if (tid == 0) kk[0] = 0.f;
    for (int i = tid; i < L; i += 256) {
        us[i] = u[(size_t)i * HW + c];
        kk[4096 + i] = filtT[(size_t)c * L + i];
        if (i >= 1) kk[4096 - i] = filtT[(size_t)(HW + c) * L + i];
    }
    __syncthreads();
    float acc[16];
#pragma unroll
    for (int i = 0; i < 16; ++i) acc[i] = 0.f;
    for (int m = 0; m < L; ++m) {
        const float um = us[m];
        const float* kp = kk + 4096 + tid - m;
#pragma unroll
        for (int i = 0; i < 16; ++i) acc[i] += kp[256 * i] * um;
    }
    const float sk = skip[c];
#pragma unroll
    for (int i = 0; i < 16; ++i) {
        const int n = tid + 256 * i;
        const size_t o = (size_t)n * HW + c;
        x0c_ya[o] = x0c_ya[o] * (acc[i] + sk * us[n]);
    }
}
__device__ __forceinline__ float gelu_exact(float x) { return 0.5f * x * (1.0f + erff(x * 0.70710678118654752f)); }
__global__ __launch_bounds__(256) void k_sgu_prep(const float* proj, const float* g, float* ug, float* vn) {
    __shared__ float red[4];
    const size_t t = blockIdx.x;
    const float* pr = proj + t * INW + 3 * HW;
    float4 a = ((const float4*)pr)[threadIdx.x];
    float4 b = ((const float4*)(pr + SW))[threadIdx.x];
    a.x = gelu_exact(a.x); a.y = gelu_exact(a.y); a.z = gelu_exact(a.z); a.w = gelu_exact(a.w);
    b.x = gelu_exact(b.x); b.y = gelu_exact(b.y); b.z = gelu_exact(b.z); b.w = gelu_exact(b.w);
    const float ss = block_sum256(b.x * b.x + b.y * b.y + b.z * b.z + b.w * b.w, red);
    const float r = rsqrtf(ss * (1.0f / SW) + EPS);
    const float4 gg = ((const float4*)g)[threadIdx.x];
    b.x *= r * gg.x; b.y *= r * gg.y; b.z *= r * gg.z; b.w *= r * gg.w;
    ((float4*)(ug + t * SW))[threadIdx.x] = a;
    ((float4*)(vn + t * SW))[threadIdx.x] = b;
}
__global__ __launch_bounds__(256) void k_sgu_mix(const float* vn, const float* ws, const float* bs, float* ug_yb) {
    const int n = blockIdx.x, g = blockIdx.y, d = threadIdx.x & 127, ph = threadIdx.x >> 7;
    const float* vcol = vn + (size_t)(n * 128) * SW + g * 128 + d;
    for (int pp = 0; pp < 64; ++pp) {
        const int p = ph * 64 + pp;
        const float* wr = ws + ((size_t)g * 128 + p) * 128;
        float s = bs[g * 128 + p];
        for (int q = 0; q < 128; ++q) s += wr[q] * vcol[(size_t)q * SW];
        const size_t o = (size_t)(n * 128 + p) * SW + g * 128 + d;
        ug_yb[o] = ug_yb[o] * s;
    }
}
__device__ __forceinline__ float sigmoidf_(float x) { return 1.0f / (1.0f + expf(-x)); }
__global__ __launch_bounds__(256) void k_merge(const float* proj, float* A1, const float* A2) {
    const size_t t = blockIdx.x;
    for (int c = threadIdx.x; c < D; c += 256) {
        const float ga = sigmoidf_(proj[t * INW + 5 * HW + c]), gb = sigmoidf_(proj[t * INW + 6 * HW + c]);
        A1[t * D + c] = ga * A1[t * D + c] + gb * A2[t * D + c];
    }
}
__global__ __launch_bounds__(256) void k_add(const float* x, float* y) {
    const size_t i = (size_t)blockIdx.x * 256 + threadIdx.x;
    float4 a = ((const float4*)x)[i], b = ((float4*)y)[i];
    b.x += a.x; b.y += a.y; b.z += a.z; b.w += a.w;
    ((float4*)y)[i] = b;
}
__global__ __launch_bounds__(256) void k_ffn_act(const float* up, const float* cw, const float* cb, float* act) {
    const int t = blockIdx.x;
    for (int c = threadIdx.x; c < FH; c += 256) {
        float s = cb[c];
        if (t > 0) s += cw[0 * FH + c] * up[(size_t)(t - 1) * (2 * FH) + c];
        s += cw[1 * FH + c] * up[(size_t)t * (2 * FH) + c];
        if (t < L - 1) s += cw[2 * FH + c] * up[(size_t)(t + 1) * (2 * FH) + c];
        const float si = s / (1.0f + expf(-s));
        act[(size_t)t * FH + c] = si * up[(size_t)t * (2 * FH) + FH + c];
    }
}
}

extern "C" void kernel_launch(void* const* d_in, const int* in_sizes, int n_in, void* d_out, int out_size, void* d_ws, size_t ws_size, hipStream_t stream) {
    const float* x = (const float*)d_in[0];
    const float* norm1_g = (const float*)d_in[1];
    const float* w_in = (const float*)d_in[2];
    const float* hy_conv_w = (const float*)d_in[3];
    const float* hy_conv_b = (const float*)d_in[4];
    const float* fw1 = (const float*)d_in[5];
    const float* fb1 = (const float*)d_in[6];
    const float* fw2 = (const float*)d_in[7];
    const float* fb2 = (const float*)d_in[8];
    const float* fw3 = (const float*)d_in[9];
    const float* fb3 = (const float*)d_in[10];
    const float* ffreq = (const float*)d_in[11];
    const float* fw4 = (const float*)d_in[12];
    const float* decay = (const float*)d_in[13];
    const float* skip = (const float*)d_in[14];
    const float* sgu_g = (const float*)d_in[15];
    const float* sgu_w = (const float*)d_in[16];
    const float* sgu_b = (const float*)d_in[17];
    const float* w_pa = (const float*)d_in[18];
    const float* w_pb = (const float*)d_in[19];
    const float* w_out = (const float*)d_in[20];
    const float* norm2_g = (const float*)d_in[21];
    const float* w_up = (const float*)d_in[22];
    const float* fcw = (const float*)d_in[23];
    const float* fcb = (const float*)d_in[24];
    const float* w_down = (const float*)d_in[25];
    const float* final_g = (const float*)d_in[26];
    float* out = (float*)d_out;
    float* ws = (float*)d_ws;
    const size_t MI = 1u << 18;
    float* filtT = ws;
    float* h3 = ws + 32 * MI;
    float* hbuf = ws + 33 * MI;
    float* proj = ws + 49 * MI;
    float* S1 = ws + 161 * MI;
    float* S2 = S1 + 16 * MI;
    float* S3 = S2 + 16 * MI;
    float* S4 = S3 + 16 * MI;

    k_filter_mlp<<<L, 64, 0, stream>>>(fw1, fb1, fw2, fb2, fw3, fb3, ffreq, h3);
    k_filter_out<<<dim3(L / 256, 2048), 256, 0, stream>>>(h3, fw4, decay, filtT);
    for (int b = 0; b < NB; ++b) {
        const float* xb = x + (size_t)b * L * D;
        float* outb = out + (size_t)b * L * D;
        k_rmsnorm<<<L, 256, 0, stream>>>(xb, nullptr, norm1_g, hbuf);
        k_gemm<<<dim3(INW / 64, L / 64), 256, 0, stream>>>(hbuf, D, w_in, INW, proj, INW, D);
        k_hy_prep<<<L, 256, 0, stream>>>(proj, hy_conv_w, hy_conv_b, S1, S2);
        k_longconv<<<HW, 256, 0, stream>>>(filtT, S2, skip, S1);
        k_sgu_prep<<<L, 256, 0, stream>>>(proj, sgu_g, S3, S4);
        k_sgu_mix<<<dim3(L / 128, 8), 256, 0, stream>>>(S4, sgu_w, sgu_b, S3);
        k_gemm<<<dim3(D / 64, L / 64), 256, 0, stream>>>(S1, HW, w_pa, D, S2, D, HW);
        k_gemm<<<dim3(D / 64, L / 64), 256, 0, stream>>>(S3, SW, w_pb, D, S4, D, SW);
        k_merge<<<L, 256, 0, stream>>>(proj, S2, S4);
        k_gemm<<<dim3(D / 64, L / 64), 256, 0, stream>>>(S2, D, w_out, D, S4, D, D);
        k_add<<<L * D / 4 / 256, 256, 0, stream>>>(xb, S4);
        k_rmsnorm<<<L, 256, 0, stream>>>(S4, nullptr, norm2_g, hbuf);
        k_gemm<<<dim3(2 * FH / 64, L / 64), 256, 0, stream>>>(hbuf, D, w_up, 2 * FH, proj, 2 * FH, D);
        k_ffn_act<<<L, 256, 0, stream>>>(proj, fcw, fcb, S1);
        k_gemm<<<dim3(D / 64, L / 64), 256, 0, stream>>>(S1, FH, w_down, D, hbuf, D, FH);
        k_rmsnorm<<<L, 256, 0, stream>>>(S4, hbuf, final_g, outb);
    }
}
```

```cpp
#include <hip/hip_runtime.h>
#include <hip/hip_cooperative_groups.h>
#include <math.h>
#include <stdint.h>
#include <cstdio>
namespace cg = cooperative_groups;
namespace pg8 {
#define PG8_LAS __attribute__((address_space(3)))
typedef unsigned short bf16_t;
typedef short bf16x8 __attribute__((ext_vector_type(8)));
typedef float f32x4 __attribute__((ext_vector_type(4)));
typedef unsigned u32x4 __attribute__((ext_vector_type(4)));
constexpr int BM = 256, BK = 64, HALF = 128, HTB = HALF * BK * 2  , STAGE_BYTES = 8 * HTB, NXCD = 8, WGM = 8;

__host__ __device__ __forceinline__ int lds_byte(int r, int c) { const int st = (r >> 4) * 2 + (c >> 5), rr = r & 15, cc = c & 31, ob = rr * 64 + cc * 2; return st * 1024 + (ob ^ (((ob >> 9) & 1) << 5)); }
__host__ __device__ __forceinline__ void stage_rc(int b, int& R, int& C) { const int st = b / 1024, sb = b % 1024, swz = sb ^ (((sb >> 9) & 1) << 5); R = (st >> 1) * 16 + swz / 64; C = (st & 1) * 32 + (swz % 64) / 2; }
__host__ __device__ __forceinline__ int perm32(int rho) { const int n = rho >> 4, i = rho & 15; return 8 * (i >> 2) + 4 * n + (i & 3); }

struct Unit { int pm, pn; };
struct Gemm { const bf16_t* A; const bf16_t* Bt; int M, N, K, lda, ldb; };

struct StaticOrder {
    int nM, nN, nwg, G, c;
    __host__ __device__ void init(int M, int N, int G_, int c_) { nM = M / BM; nN = N / BM; nwg = nM * nN; G = G_; c = c_; }
    __host__ __device__ bool next(int i, Unit& u) const {
        const long L = (long)i * G + c; if (L >= nwg) return false;
        int wgid = (int)L; { const int q = nwg / NXCD, r = nwg % NXCD, xcd = wgid % NXCD, off = wgid / NXCD; wgid = (xcd < r ? xcd * (q + 1) : r * (q + 1) + (xcd - r) * q) + off; }
        const int nig = WGM * nN, gid = wgid / nig, fm = gid * WGM, gsz = (nM - fm) < WGM ? (nM - fm) : WGM;
        u.pm = fm + ((wgid % nig) % gsz); u.pn = (wgid % nig) / gsz; return true;
    }
    __device__ __forceinline__ void a_ready(const Unit&) const {}
    __device__ __forceinline__ void done(const Unit&) const {}
};

__device__ __forceinline__ unsigned cvt_pk_bf16(float lo, float hi) { unsigned r; asm volatile("v_cvt_pk_bf16_f32 %0, %1, %2" : "=v"(r) : "v"(lo), "v"(hi)); return r; }
typedef float f32x2 __attribute__((ext_vector_type(2)));
__device__ __forceinline__ f32x2 gelu_pk(f32x2 v) {
    const f32x2 av = __builtin_elementwise_abs(v), d = av * 0.2316418882f + 1.0f;
    f32x2 t; t.x = __builtin_amdgcn_rcpf(d.x); t.y = __builtin_amdgcn_rcpf(d.y);
    f32x2 q = t * 0.5307027145f + (-0.7265760135f); q = q * t + 0.7107068705f; q = q * t + (-0.142248368f); q = q * t + 0.127414796f; q = q * t;
    const f32x2 s = (v * v) * (-0.72134752044f);
    f32x2 e; e.x = __builtin_amdgcn_exp2f(s.x); e.y = __builtin_amdgcn_exp2f(s.y);
    const f32x2 m = v * (q * e), r = v - m;
    f32x2 o; o.x = v.x < 0.f ? m.x : r.x; o.y = v.y < 0.f ? m.y : r.y; return o;
}

template <int ACT  > struct EpiBf16 {
    static constexpr bool PERM = true, AFTER_DRAIN = false, MID = false; static_assert(ACT == 0 || ACT == 1, "EpiBf16: ACT is 0 (none) or 1 (gelu_pk)");
    bf16_t* O; int ldc; const float* bias; int split_cols; size_t split_stride; float scale0;
    __device__ __forceinline__ void operator()(const f32x4 (&acc)[2][2][4][2], const Unit& u, int wr, int wc, int fr, int fq) const {
        const int row0 = u.pm * BM + wr * 64 + fr; int colt = u.pn * BM; bf16_t* base = O;
        float sc = 1.f; if (split_cols) { const int t = colt / split_cols; base += (size_t)t * split_stride; colt -= t * split_cols; if (t == 0) sc = scale0; }
        const int col0 = colt + wc * 32 + 8 * fq, bcol0 = u.pn * BM + wc * 32 + 8 * fq;
        f32x4 bv[2][2];
#pragma unroll
        for (int bj = 0; bj < 2; ++bj)
#pragma unroll
            for (int n = 0; n < 2; ++n) bv[bj][n] = bias ? *(const f32x4*)(bias + bcol0 + bj * HALF + 4 * n) : (f32x4){0.f, 0.f, 0.f, 0.f};
#pragma unroll
        for (int ai = 0; ai < 2; ++ai)
#pragma unroll
            for (int m = 0; m < 4; ++m) { bf16_t* rowp = base + (size_t)(row0 + ai * HALF + m * 16) * ldc + col0;
#pragma unroll
                for (int bj = 0; bj < 2; ++bj) { f32x4 v0 = acc[ai][bj][m][0] + bv[bj][0], v1 = acc[ai][bj][m][1] + bv[bj][1];
                    if (ACT == 1) { f32x2 a = gelu_pk((f32x2){v0[0], v0[1]}), b = gelu_pk((f32x2){v0[2], v0[3]}), c = gelu_pk((f32x2){v1[0], v1[1]}), d = gelu_pk((f32x2){v1[2], v1[3]});
                        v0 = (f32x4){a.x, a.y, b.x, b.y}; v1 = (f32x4){c.x, c.y, d.x, d.y}; }
                    v0 = v0 * sc; v1 = v1 * sc; u32x4 w; w.x = cvt_pk_bf16(v0[0], v0[1]); w.y = cvt_pk_bf16(v0[2], v0[3]); w.z = cvt_pk_bf16(v1[0], v1[1]); w.w = cvt_pk_bf16(v1[2], v1[3]);
                    *(u32x4*)(rowp + bj * HALF) = w; } }
    }
};

struct EpiF32 {
    static constexpr bool PERM = false, AFTER_DRAIN = false, MID = false;
    float* C; int ldc; const float* bias;
    __device__ __forceinline__ void operator()(const f32x4 (&acc)[2][2][4][2], const Unit& u, int wr, int wc, int fr, int fq) const {
        const int row0 = u.pm * BM + wr * 64 + fr, col0 = u.pn * BM + wc * 32 + 4 * fq;
        f32x4 bv[2][2];
#pragma unroll
        for (int bj = 0; bj < 2; ++bj)
#pragma unroll
            for (int n = 0; n < 2; ++n) bv[bj][n] = bias ? *(const f32x4*)(bias + col0 + bj * HALF + n * 16) : (f32x4){0.f, 0.f, 0.f, 0.f};
#pragma unroll
        for (int ai = 0; ai < 2; ++ai)
#pragma unroll
            for (int m = 0; m < 4; ++m) { float* rowp = C + (size_t)(row0 + ai * HALF + m * 16) * ldc + col0;
#pragma unroll
                for (int bj = 0; bj < 2; ++bj)
#pragma unroll
                    for (int n = 0; n < 2; ++n) *(f32x4*)(rowp + bj * HALF + n * 16) = acc[ai][bj][m][n] + bv[bj][n]; }
    }
};

template <class Epi, class Sched, bool ALIGN_EPI = false, bool SP2 = false>
__device__ __forceinline__ void gemm_phase(PG8_LAS unsigned char* lds, const Gemm g, const Sched& S, const Epi& E, const int tid) {
    const int wid = __builtin_amdgcn_readfirstlane(tid >> 6), lane = tid & 63, wr = wid >> 2, wc = wid & 3, fr = lane & 15, fq = lane >> 4;
    const int K = g.K, nt = K / BK;
    unsigned voffA[2], voffB[2];
#pragma unroll
    for (int i = 0; i < 2; ++i) { int R, C; stage_rc(tid * 16 + i * 8192, R, C); const int Rb = Epi::PERM ? ((R & ~31) + perm32(R & 31)) : R;
        voffA[i] = (unsigned)(R * g.lda + C) * 2u; voffB[i] = (unsigned)(Rb * g.ldb + C) * 2u; }
    const size_t kstep = (size_t)(BK * 2);
    const size_t hstepA = (size_t)HALF * g.lda * 2, hstepB = (size_t)HALF * g.ldb * 2;
    const size_t tstepA = 2 * hstepA, tstepB = 2 * hstepB;
    const unsigned ldsw = (unsigned)wid * 1024u;
    const int aoff = lds_byte(wr * 64 + fr, fq * 8), boff = lds_byte(wc * 32 + fr, fq * 8);
#define PG8_SA(b, h) (((b) * 2 + (h)) * HTB)
#define PG8_SB(b, h) ((4 + (b) * 2 + (h)) * HTB)
#define PG8_STAGE(bufoff, gbase, voff) do { _Pragma("unroll") for (int _i = 0; _i < 2; ++_i) \
        __builtin_amdgcn_global_load_lds((const unsigned*)((const char*)(gbase) + (voff)[_i]), (PG8_LAS unsigned*)(lds + (bufoff) + ldsw + _i * 8192), 16, 0, 0); } while (0)
#define PG8_LDA(dst, b, h) do { _Pragma("unroll") for (int m = 0; m < 4; ++m) _Pragma("unroll") for (int k = 0; k < 2; ++k) dst[m][k] = *(const PG8_LAS bf16x8*)(lds + PG8_SA(b, h) + aoff + m * 2048 + k * 1024); } while (0)
#define PG8_LDB(dst, b, h) do { _Pragma("unroll") for (int n = 0; n < 2; ++n) _Pragma("unroll") for (int k = 0; k < 2; ++k) dst[n][k] = *(const PG8_LAS bf16x8*)(lds + PG8_SB(b, h) + boff + n * 2048 + k * 1024); } while (0)
#define PG8_MMA(ai, bj, At, Bt) do { __builtin_amdgcn_s_setprio(1); _Pragma("unroll") for (int m = 0; m < 4; ++m) _Pragma("unroll") for (int n = 0; n < 2; ++n) _Pragma("unroll") for (int k = 0; k < 2; ++k) \
        acc[ai][bj][m][n] = __builtin_amdgcn_mfma_f32_16x16x32_bf16(Bt[n][k], At[m][k], acc[ai][bj][m][n], 0, 0, 0); __builtin_amdgcn_s_setprio(0); } while (0)
#define PG8_WAIT_V(n) asm volatile("s_waitcnt vmcnt(" #n ")" ::: "memory")
#define PG8_WAIT_L(n) asm volatile("s_waitcnt lgkmcnt(" #n ")" ::: "memory")
#define PG8_BAR __builtin_amdgcn_s_barrier()
#define PG8_SCHED __builtin_amdgcn_sched_barrier(0)
    Unit cur, nxt; int ui = 0;
    if (!S.next(0, cur)) return;
    f32x4 acc[2][2][4][2];
#pragma unroll
    for (int a = 0; a < 2; ++a)
#pragma unroll
        for (int b = 0; b < 2; ++b)
#pragma unroll
            for (int m = 0; m < 4; ++m)
#pragma unroll
                for (int n = 0; n < 2; ++n) acc[a][b][m][n] = (f32x4){0.f, 0.f, 0.f, 0.f};
    bf16x8 At[4][2], B0[2][2], B1[2][2];
    const char* cA = (const char*)g.A + (size_t)cur.pm * tstepA; const char* cB = (const char*)g.Bt + (size_t)cur.pn * tstepB;
    S.a_ready(cur);
    if constexpr (SP2) {
        PG8_STAGE(PG8_SB(0, 0), cB, voffB); PG8_STAGE(PG8_SB(0, 1), cB + hstepB, voffB); PG8_STAGE(PG8_SA(0, 0), cA, voffA); PG8_STAGE(PG8_SA(0, 1), cA + hstepA, voffA);
        if (wr == 1) PG8_BAR;
        PG8_WAIT_V(2); PG8_BAR;
        PG8_STAGE(PG8_SB(1, 0), cB + kstep, voffB); PG8_STAGE(PG8_SA(1, 0), cA + kstep, voffA); PG8_STAGE(PG8_SB(1, 1), cB + hstepB + kstep, voffB);
        PG8_WAIT_V(6); PG8_BAR;
    } else {
        PG8_STAGE(PG8_SB(0, 0), cB, voffB); PG8_STAGE(PG8_SA(0, 0), cA, voffA); PG8_STAGE(PG8_SB(0, 1), cB + hstepB, voffB); PG8_STAGE(PG8_SA(0, 1), cA + hstepA, voffA);
        if (wr == 1) PG8_BAR;
        PG8_WAIT_V(4); PG8_BAR;
        PG8_STAGE(PG8_SB(1, 0), cB + kstep, voffB); PG8_STAGE(PG8_SA(1, 0), cA + kstep, voffA); PG8_STAGE(PG8_SB(1, 1), cB + hstepB + kstep, voffB);
        PG8_WAIT_V(6); PG8_BAR;
    }
    for (;;) {
        const bool has_next = S.next(ui + 1, nxt);
        const char* nA = has_next ? (const char*)g.A + (size_t)nxt.pm * tstepA : cA; const char* nB = has_next ? (const char*)g.Bt + (size_t)nxt.pn * tstepB : cB;
        for (int t = 0; t < nt; t += 2) {
            const bool last = (t == nt - 2);
            const char* a1 = cA + (size_t)(t + 1) * kstep;
            const char* a2 = last ? nA : cA + (size_t)(t + 2) * kstep; const char* b2 = last ? nB : cB + (size_t)(t + 2) * kstep;
            const char* a3 = a2 + kstep; const char* b3 = b2 + kstep;
            if (last && has_next) S.a_ready(nxt);
            if constexpr (Epi::MID) { if (t == (nt >> 1)) E.mid(acc, cur, wr, wc, fr, fq); }
            if constexpr (SP2) {
            PG8_LDB(B0, 0, 0); PG8_LDB(B1, 0, 1); PG8_SCHED; PG8_LDA(At, 0, 0); PG8_STAGE(PG8_SA(1, 1), a1 + hstepA, voffA);
            PG8_WAIT_V(8); PG8_WAIT_L(0); PG8_BAR; PG8_MMA(0, 0, At, B0); PG8_MMA(0, 1, At, B1); PG8_BAR; PG8_SCHED;
            PG8_LDA(At, 0, 1); PG8_STAGE(PG8_SB(0, 0), b2, voffB); PG8_STAGE(PG8_SB(0, 1), b2 + hstepB, voffB); PG8_STAGE(PG8_SA(0, 0), a2, voffA);
            PG8_WAIT_V(8); PG8_WAIT_L(0); PG8_BAR; PG8_MMA(1, 0, At, B0); PG8_MMA(1, 1, At, B1); PG8_BAR; PG8_SCHED;
            PG8_LDB(B0, 1, 0); PG8_LDB(B1, 1, 1); PG8_SCHED; PG8_LDA(At, 1, 0); PG8_STAGE(PG8_SA(0, 1), a2 + hstepA, voffA);
            PG8_WAIT_V(8); PG8_WAIT_L(0); PG8_BAR; PG8_MMA(0, 0, At, B0); PG8_MMA(0, 1, At, B1); PG8_BAR; PG8_SCHED;
            PG8_LDA(At, 1, 1); PG8_STAGE(PG8_SB(1, 0), b3, voffB); PG8_STAGE(PG8_SB(1, 1), b3 + hstepB, voffB); PG8_STAGE(PG8_SA(1, 0), a3, voffA);
            PG8_WAIT_V(8); PG8_WAIT_L(0); PG8_BAR; PG8_MMA(1, 0, At, B0); PG8_MMA(1, 1, At, B1); PG8_BAR; PG8_SCHED;
            } else {
            PG8_LDB(B0, 0, 0); PG8_SCHED; PG8_LDA(At, 0, 0); PG8_STAGE(PG8_SA(1, 1), a1 + hstepA, voffA);
            PG8_WAIT_L(8); PG8_BAR; PG8_WAIT_L(0); PG8_MMA(0, 0, At, B0); PG8_BAR; PG8_SCHED;
            PG8_LDB(B1, 0, 1); PG8_STAGE(PG8_SB(0, 0), b2, voffB);
            PG8_BAR; PG8_WAIT_L(0); PG8_MMA(0, 1, At, B1); PG8_BAR;
            PG8_LDA(At, 0, 1); PG8_STAGE(PG8_SA(0, 0), a2, voffA);
            PG8_BAR; PG8_WAIT_L(0); PG8_MMA(1, 0, At, B0); PG8_BAR; PG8_SCHED;
            PG8_STAGE(PG8_SB(0, 1), b2 + hstepB, voffB);
            PG8_WAIT_V(6); PG8_BAR; PG8_MMA(1, 1, At, B1); PG8_BAR;
            PG8_LDB(B0, 1, 0); PG8_SCHED; PG8_LDA(At, 1, 0); PG8_STAGE(PG8_SA(0, 1), a2 + hstepA, voffA);
            PG8_WAIT_L(8); PG8_BAR; PG8_WAIT_L(0); PG8_MMA(0, 0, At, B0); PG8_BAR; PG8_SCHED;
            PG8_LDB(B1, 1, 1); PG8_STAGE(PG8_SB(1, 0), b3, voffB);
            PG8_BAR; PG8_WAIT_L(0); PG8_MMA(0, 1, At, B1); PG8_BAR;
            PG8_LDA(At, 1, 1); PG8_STAGE(PG8_SA(1, 0), a3, voffA);
            PG8_BAR; PG8_WAIT_L(0); PG8_MMA(1, 0, At, B0); PG8_BAR; PG8_SCHED;
            PG8_STAGE(PG8_SB(1, 1), b3 + hstepB, voffB);
            PG8_WAIT_V(6); PG8_BAR; PG8_MMA(1, 1, At, B1); PG8_BAR;
            }
        }
        if constexpr (ALIGN_EPI) { if (wr == 0) PG8_BAR; }
        if constexpr (!Epi::AFTER_DRAIN) { E(acc, cur, wr, wc, fr, fq); S.done(cur); }
        if (!has_next) break;
#pragma unroll
        for (int a = 0; a < 2; ++a)
#pragma unroll
            for (int b = 0; b < 2; ++b)
#pragma unroll
                for (int m = 0; m < 4; ++m)
#pragma unroll
                    for (int n = 0; n < 2; ++n) acc[a][b][m][n] = (f32x4){0.f, 0.f, 0.f, 0.f};
        cur = nxt; cA = nA; cB = nB; ++ui;
        if constexpr (ALIGN_EPI) { if (wr == 1) PG8_BAR; }
    }
    PG8_WAIT_V(0);
    if constexpr (!ALIGN_EPI) { if (wr == 0) PG8_BAR; }
    PG8_BAR;
    if constexpr (Epi::AFTER_DRAIN) { E.fused(acc, cur, wr, wc, fr, fq, lds, wid, lane); S.done(cur); }
#undef PG8_SA
#undef PG8_SB
#undef PG8_STAGE
#undef PG8_LDA
#undef PG8_LDB
#undef PG8_MMA
#undef PG8_WAIT_V
#undef PG8_WAIT_L
#undef PG8_BAR
#undef PG8_SCHED
}
}
namespace {
constexpr int D = 1024, NB = 4, L = 4096, HW = 1024, SW = 1024, INW = 7168, FH = 2816, FHID = 64, FEMB = 33;
constexpr float EPS = 1e-6f;
typedef unsigned short bf16;
__device__ __forceinline__ unsigned f2bf(float f) { unsigned u = __builtin_bit_cast(unsigned, f); return (u + 0x7fffu + ((u >> 16) & 1u)) >> 16; }
}
namespace {
#define HD __device__ __forceinline__
#define FFT_OPAQUE(w) asm volatile("" : "+v"(w))
#ifndef HD
#define HD inline
#endif
typedef float cf __attribute__((ext_vector_type(2)));
HD cf cmk(float x, float y) { return (cf){x, y}; }
HD cf cadd(cf a, cf b) { return cmk(a.x + b.x, a.y + b.y); }
HD cf csub(cf a, cf b) { return cmk(a.x - b.x, a.y - b.y); }
HD cf cmul(cf a, cf b) { return cmk(a.x * b.x - a.y * b.y, a.x * b.y + a.y * b.x); }
HD cf cconj(cf a) { return cmk(a.x, -a.y); }
template <bool INV> HD cf mulmi(cf a) { return INV ? cmk(-a.y, a.x) : cmk(a.y, -a.x); }
template <bool INV> HD cf twc(float c, float s) { return INV ? cmk(c, s) : cmk(c, -s); }
HD int fpad(int p) { return p + (p >> 4); }
constexpr int FSUB = 4352;

template <bool INV> HD void dft4(cf& a, cf& b, cf& c, cf& d) {
    const cf t0 = cadd(a, c), t1 = csub(a, c), t2 = cadd(b, d), t3 = mulmi<INV>(csub(b, d));
    a = cadd(t0, t2); b = cadd(t1, t3); c = csub(t0, t2); d = csub(t1, t3);
}
template <bool INV> HD void dft16(cf (&v)[16]) {
    constexpr float C1 = 0.92387953251128674f, S1 = 0.38268343236508977f, R = 0.70710678118654752f;
#pragma unroll
    for (int n0 = 0; n0 < 4; ++n0) dft4<INV>(v[n0], v[n0 + 4], v[n0 + 8], v[n0 + 12]);
    v[1 + 4 * 1] = cmul(v[1 + 4 * 1], twc<INV>(C1, S1));
    v[1 + 4 * 2] = cmul(v[1 + 4 * 2], twc<INV>(R, R));
    v[1 + 4 * 3] = cmul(v[1 + 4 * 3], twc<INV>(S1, C1));
    v[2 + 4 * 1] = cmul(v[2 + 4 * 1], twc<INV>(R, R));
    v[2 + 4 * 2] = mulmi<INV>(v[2 + 4 * 2]);
    v[2 + 4 * 3] = cmul(v[2 + 4 * 3], twc<INV>(-R, R));
    v[3 + 4 * 1] = cmul(v[3 + 4 * 1], twc<INV>(S1, C1));
    v[3 + 4 * 2] = cmul(v[3 + 4 * 2], twc<INV>(-R, R));
    v[3 + 4 * 3] = cmul(v[3 + 4 * 3], twc<INV>(-C1, -S1));
#pragma unroll
    for (int k0 = 0; k0 < 4; ++k0) dft4<INV>(v[4 * k0], v[4 * k0 + 1], v[4 * k0 + 2], v[4 * k0 + 3]);
    cf t;
    t = v[1]; v[1] = v[4]; v[4] = t;   t = v[2]; v[2] = v[8]; v[8] = t;   t = v[3]; v[3] = v[12]; v[12] = t;
    t = v[6]; v[6] = v[9]; v[9] = t;   t = v[7]; v[7] = v[13]; v[13] = t; t = v[11]; v[11] = v[14]; v[14] = t;
}
#ifndef FFT_OPAQUE
#define FFT_OPAQUE(w)
#endif
HD void twiddle16(cf (&v)[16], cf w) {
    FFT_OPAQUE(w);
    cf p = w;
#pragma unroll
    for (int k = 1; k < 16; ++k) { v[k] = cmul(v[k], p); if (k < 15) p = cmul(p, w); }
}
template <class P> HD void fwd_pass1(P Z, int t, cf w1) {
    cf v[16]; const int b = t + (t >> 4);
#pragma unroll
    for (int j = 0; j < 16; ++j) v[j] = Z[b + 272 * j];
    dft16<false>(v); twiddle16(v, w1);
#pragma unroll
    for (int j = 0; j < 16; ++j) Z[b + 272 * j] = v[j];
}
template <class P> HD void fwd_pass2(P Z, int t, cf w2) {
    const int b = 272 * (t >> 4) + (t & 15);
    cf v[16];
#pragma unroll
    for (int j = 0; j < 16; ++j) v[j] = Z[b + 17 * j];
    dft16<false>(v); twiddle16(v, w2);
#pragma unroll
    for (int j = 0; j < 16; ++j) Z[b + 17 * j] = v[j];
}
template <class P> HD void fwd_pass3_load(P Z, int t, cf (&v)[16]) {
#pragma unroll
    for (int j = 0; j < 16; ++j) v[j] = Z[17 * t + j];
    dft16<false>(v);
}
template <class P> HD void inv_pass1_store(P Z, int t, cf (&v)[16]) {
    dft16<true>(v);
#pragma unroll
    for (int j = 0; j < 16; ++j) Z[17 * t + j] = v[j];
}
template <class P> HD void inv_pass2(P Z, int t, cf w2) {
    const int b = 272 * (t >> 4) + (t & 15);
    cf v[16];
#pragma unroll
    for (int j = 0; j < 16; ++j) v[j] = Z[b + 17 * j];
    twiddle16(v, cconj(w2)); dft16<true>(v);
#pragma unroll
    for (int j = 0; j < 16; ++j) Z[b + 17 * j] = v[j];
}
template <class P> HD void inv_pass3(P Z, int t, cf w1) {
    cf v[16]; const int b = t + (t >> 4);
#pragma unroll
    for (int j = 0; j < 16; ++j) v[j] = Z[b + 272 * j];
    twiddle16(v, cconj(w1)); dft16<true>(v);
#pragma unroll
    for (int j = 0; j < 16; ++j) Z[b + 272 * j] = v[j];
}
#define LAS __attribute__((address_space(3)))
typedef LAS cf* lcf;
struct HyArgs {
    const bf16* hyT;
    bf16* yaT;
    const float* fsum;
    const float* fdif;
    const float* cw;
    const float* cb;
    const float* skip;
    const cf* T;
    int TS, npairs, off00, off01, off10, off11;
};
__device__ __forceinline__ float bf2f(unsigned h) { return __builtin_bit_cast(float, h << 16); }
__device__ __forceinline__ void conv8(const bf16* row, int n0, float w0, float w1, float w2, float b, float (&o)[8]) {
    const uint4 q = *(const uint4*)(row + n0);
    float x[10];
    x[0] = n0 > 0 ? bf2f(row[n0 - 1]) : 0.f;
    x[9] = n0 + 8 < 4096 ? bf2f(row[n0 + 8]) : 0.f;
    x[1] = bf2f(q.x & 0xffffu); x[2] = bf2f(q.x >> 16); x[3] = bf2f(q.y & 0xffffu); x[4] = bf2f(q.y >> 16);
    x[5] = bf2f(q.z & 0xffffu); x[6] = bf2f(q.z >> 16); x[7] = bf2f(q.w & 0xffffu); x[8] = bf2f(q.w >> 16);
#pragma unroll
    for (int i = 0; i < 8; ++i) o[i] = b + w0 * x[i] + w1 * x[i + 1] + w2 * x[i + 2];
}
__device__ __forceinline__ void hyena_channel(lcf Z, const HyArgs& A, int c, int tid, cf w1, cf w2, cf wp) {
    const int s = tid >> 8, t = tid & 255, n0 = 8 * tid, pb = 8 * tid + (tid >> 1);
    lcf Zs = Z + s * FSUB;
    constexpr float W8C[8] = {1.0f, 0.99999970586f, 0.99999882345f, 0.99999735277f, 0.99999529381f, 0.99999264659f, 0.99998941108f, 0.99998558731f};
    constexpr float W8S[8] = {0.0f, 0.00076699031874f, 0.0015339801863f, 0.0023009691514f, 0.0030679567630f, 0.0038349425697f, 0.0046019261204f, 0.0053689069640f};
    cf tw[8];
#pragma unroll
    for (int i = 0; i < 8; ++i) tw[i] = cmul(wp, cmk(W8C[i], -W8S[i]));
    cf Kr[16];
    {
        const float4 a0 = *(const float4*)(A.fsum + (size_t)c * 4096 + n0), a1 = *(const float4*)(A.fsum + (size_t)c * 4096 + n0 + 4);
        const float4 d0 = *(const float4*)(A.fdif + (size_t)c * 4096 + n0), d1 = *(const float4*)(A.fdif + (size_t)c * 4096 + n0 + 4);
        const float fs[8] = {a0.x, a0.y, a0.z, a0.w, a1.x, a1.y, a1.z, a1.w}, fd[8] = {d0.x, d0.y, d0.z, d0.w, d1.x, d1.y, d1.z, d1.w};
#pragma unroll
        for (int i = 0; i < 8; ++i) { Z[pb + i] = cmk(fs[i], 0.f); Z[FSUB + pb + i] = cmk(fd[i] * tw[i].x, fd[i] * tw[i].y); }
    }
    __syncthreads();
    fwd_pass1(Zs, t, w1); __syncthreads();
    fwd_pass2(Zs, t, w2); __syncthreads();
    fwd_pass3_load(Zs, t, Kr);
#pragma unroll
    for (int j = 0; j < 16; ++j) { Kr[j].x *= (1.0f / 8192.0f); Kr[j].y *= (1.0f / 8192.0f); }
    __syncthreads();
    const float sk = A.skip[c];
    const float cx0 = A.cw[c], cx1 = A.cw[3072 + c], cx2 = A.cw[6144 + c], cxb = A.cb[c];
    const float ca0 = A.cw[1024 + c], ca1 = A.cw[3072 + 1024 + c], ca2 = A.cw[6144 + 1024 + c], cab = A.cb[1024 + c];
    const float cv0 = A.cw[2048 + c], cv1 = A.cw[3072 + 2048 + c], cv2 = A.cw[6144 + 2048 + c], cvb = A.cb[2048 + c];
    for (int p = 0; p < A.npairs; ++p) {
        const int o0 = p ? A.off10 : A.off00, o1 = p ? A.off11 : A.off01;
        float u0[8], u1[8];
        {
            float a[8], b[8];
            conv8(A.hyT + (size_t)(1024 + c) * A.TS + o0, n0, ca0, ca1, ca2, cab, a);
            conv8(A.hyT + (size_t)(2048 + c) * A.TS + o0, n0, cv0, cv1, cv2, cvb, b);
#pragma unroll
            for (int i = 0; i < 8; ++i) u0[i] = a[i] * b[i];
            conv8(A.hyT + (size_t)(1024 + c) * A.TS + o1, n0, ca0, ca1, ca2, cab, a);
            conv8(A.hyT + (size_t)(2048 + c) * A.TS + o1, n0, cv0, cv1, cv2, cvb, b);
#pragma unroll
            for (int i = 0; i < 8; ++i) u1[i] = a[i] * b[i];
        }
#pragma unroll
        for (int i = 0; i < 8; ++i) { const cf z = cmk(u0[i], u1[i]); Z[pb + i] = z; Z[FSUB + pb + i] = cmul(z, tw[i]); }
        __syncthreads();
        fwd_pass1(Zs, t, w1); __syncthreads();
        fwd_pass2(Zs, t, w2); __syncthreads();
        {
            cf v[16];
            fwd_pass3_load(Zs, t, v);
#pragma unroll
            for (int j = 0; j < 16; ++j) v[j] = cmul(v[j], Kr[j]);
            inv_pass1_store(Zs, t, v);
        }
        __syncthreads();
        inv_pass2(Zs, t, w2); __syncthreads();
        inv_pass3(Zs, t, w1); __syncthreads();
        {
            float y0[8], y1[8];
#pragma unroll
            for (int i = 0; i < 8; ++i) { const cf e = Z[pb + i], o = Z[FSUB + pb + i]; const cf y = cadd(e, cmul(o, cconj(tw[i]))); y0[i] = y.x + sk * u0[i]; y1[i] = y.y + sk * u1[i]; }
            float x0c[8];
            conv8(A.hyT + (size_t)c * A.TS + o0, n0, cx0, cx1, cx2, cxb, x0c);
            uint4 w;
            w.x = f2bf(x0c[0] * y0[0]) | (f2bf(x0c[1] * y0[1]) << 16); w.y = f2bf(x0c[2] * y0[2]) | (f2bf(x0c[3] * y0[3]) << 16);
            w.z = f2bf(x0c[4] * y0[4]) | (f2bf(x0c[5] * y0[5]) << 16); w.w = f2bf(x0c[6] * y0[6]) | (f2bf(x0c[7] * y0[7]) << 16);
            *(uint4*)(A.yaT + (size_t)c * A.TS + o0 + n0) = w;
            if (o1 != o0) {
                conv8(A.hyT + (size_t)c * A.TS + o1, n0, cx0, cx1, cx2, cxb, x0c);
                w.x = f2bf(x0c[0] * y1[0]) | (f2bf(x0c[1] * y1[1]) << 16); w.y = f2bf(x0c[2] * y1[2]) | (f2bf(x0c[3] * y1[3]) << 16);
                w.z = f2bf(x0c[4] * y1[4]) | (f2bf(x0c[5] * y1[5]) << 16); w.w = f2bf(x0c[6] * y1[6]) | (f2bf(x0c[7] * y1[7]) << 16);
                *(uint4*)(A.yaT + (size_t)c * A.TS + o1 + n0) = w;
            }
        }
        __syncthreads();
    }
}
__device__ __forceinline__ void hyena_phase(lcf Z, const HyArgs& A, int first, int stride, const int tid) {
    const int t = tid & 255;
    const cf w1 = A.T[2 * t], w2 = A.T[32 * (t & 15)], wp = A.T[8 * tid];
    for (int c = first; c < 1024; c += stride) hyena_channel(Z, A, c, tid, w1, w2, wp);
}

}
namespace pg8 {
__device__ __forceinline__ f32x2 sigmoid_pk(f32x2 v) {
    f32x2 e; e.x = __builtin_amdgcn_exp2f(v.x * -1.4426950408889634f); e.y = __builtin_amdgcn_exp2f(v.y * -1.4426950408889634f);
    f32x2 o; o.x = __builtin_amdgcn_rcpf(1.0f + e.x); o.y = __builtin_amdgcn_rcpf(1.0f + e.y); return o;
}
struct EpiHyT {
    static constexpr bool PERM = true, AFTER_DRAIN = false, MID = false;
    bf16_t* O; int ldc; float* vss;
    __device__ __forceinline__ void operator()(const f32x4 (&acc)[2][2][4][2], const Unit& u, int wr, int wc, int fr, int fq) const {
        const int row0 = u.pm * BM + wr * 64 + fr, col0 = u.pn * BM + wc * 32 + 8 * fq;
        const bool isv = u.pm >= 12;
        f32x4 ss[2][2];
#pragma unroll
        for (int bj = 0; bj < 2; ++bj)
#pragma unroll
            for (int n = 0; n < 2; ++n) ss[bj][n] = (f32x4){0.f, 0.f, 0.f, 0.f};
#pragma unroll
        for (int ai = 0; ai < 2; ++ai)
#pragma unroll
            for (int m = 0; m < 4; ++m) { bf16_t* rowp = O + (size_t)(row0 + ai * HALF + m * 16) * ldc + col0;
#pragma unroll
                for (int bj = 0; bj < 2; ++bj) { f32x4 v0 = acc[ai][bj][m][0], v1 = acc[ai][bj][m][1];
                    if (isv) { f32x2 a = gelu_pk((f32x2){v0[0], v0[1]}), b = gelu_pk((f32x2){v0[2], v0[3]}), c = gelu_pk((f32x2){v1[0], v1[1]}), d = gelu_pk((f32x2){v1[2], v1[3]});
                        v0 = (f32x4){a.x, a.y, b.x, b.y}; v1 = (f32x4){c.x, c.y, d.x, d.y}; ss[bj][0] += v0 * v0; ss[bj][1] += v1 * v1; }
                    u32x4 w; w.x = cvt_pk_bf16(v0[0], v0[1]); w.y = cvt_pk_bf16(v0[2], v0[3]); w.z = cvt_pk_bf16(v1[0], v1[1]); w.w = cvt_pk_bf16(v1[2], v1[3]);
                    *(u32x4*)(rowp + bj * HALF) = w; } }
        if (isv) {
#pragma unroll
            for (int bj = 0; bj < 2; ++bj)
#pragma unroll
                for (int n = 0; n < 2; ++n)
#pragma unroll
                    for (int j = 0; j < 4; ++j) { float s = ss[bj][n][j]; s += __shfl_xor(s, 1); s += __shfl_xor(s, 2); s += __shfl_xor(s, 4); s += __shfl_xor(s, 8);
                        if (fr == 0) atomicAdd(vss + col0 + bj * HALF + 4 * n + j, s); }
        }
    }
};
struct EpiUG {
    static constexpr bool PERM = true, AFTER_DRAIN = false, MID = false;
    bf16_t* U; bf16_t* G; int ldu;
    __device__ __forceinline__ void operator()(const f32x4 (&acc)[2][2][4][2], const Unit& u, int wr, int wc, int fr, int fq) const {
        const int row0 = u.pm * BM + wr * 64 + fr; int colt = u.pn * BM; const bool isu = colt < 1024;
        bf16_t* base = isu ? U : G; const int ldc = isu ? ldu : 2048; if (!isu) colt -= 1024;
        const int col0 = colt + wc * 32 + 8 * fq;
#pragma unroll
        for (int ai = 0; ai < 2; ++ai)
#pragma unroll
            for (int m = 0; m < 4; ++m) { bf16_t* rowp = base + (size_t)(row0 + ai * HALF + m * 16) * ldc + col0;
#pragma unroll
                for (int bj = 0; bj < 2; ++bj) { f32x4 v0 = acc[ai][bj][m][0], v1 = acc[ai][bj][m][1];
                    f32x2 a, b, c, d;
                    if (isu) { a = gelu_pk((f32x2){v0[0], v0[1]}); b = gelu_pk((f32x2){v0[2], v0[3]}); c = gelu_pk((f32x2){v1[0], v1[1]}); d = gelu_pk((f32x2){v1[2], v1[3]}); }
                    else { a = sigmoid_pk((f32x2){v0[0], v0[1]}); b = sigmoid_pk((f32x2){v0[2], v0[3]}); c = sigmoid_pk((f32x2){v1[0], v1[1]}); d = sigmoid_pk((f32x2){v1[2], v1[3]}); }
                    u32x4 w; w.x = cvt_pk_bf16(a.x, a.y); w.y = cvt_pk_bf16(b.x, b.y); w.z = cvt_pk_bf16(c.x, c.y); w.w = cvt_pk_bf16(d.x, d.y);
                    *(u32x4*)(rowp + bj * HALF) = w; } }
    }
};
}
namespace {
struct WJob { const float* W; const float* g; bf16* dst; int K, N, c0, nc, ldd, r0, koff, pad; };
constexpr int NWJ = 9;
struct WJobs { WJob j[NWJ]; };
__device__ __forceinline__ unsigned pk2(float lo, float hi) { return f2bf(lo) | (f2bf(hi) << 16); }
__device__ __forceinline__ void wT_item(const WJob& J, LAS float* scr, int item, int lane) {
    const int nblk = J.nc / 32, kb = item / nblk, nb = item % nblk, k0 = 64 * kb, n0 = 32 * nb;
#pragma unroll 8
    for (int i = 0; i < 32; ++i) { const int kk = 2 * i + (lane >> 5); float v = J.W[(size_t)(k0 + kk) * J.N + J.c0 + n0 + (lane & 31)]; if (J.g) v *= J.g[k0 + kk]; scr[kk * 33 + (lane & 31)] = v; }
    asm volatile("s_waitcnt lgkmcnt(0)" ::: "memory");
    const int c = lane & 7;
#pragma unroll
    for (int j = 0; j < 4; ++j) { const int n = (lane >> 3) + 8 * j; const LAS float* s = scr + (8 * c) * 33 + n;
        uint4 o; o.x = pk2(s[0 * 33], s[1 * 33]); o.y = pk2(s[2 * 33], s[3 * 33]); o.z = pk2(s[4 * 33], s[5 * 33]); o.w = pk2(s[6 * 33], s[7 * 33]);
        *(uint4*)(J.dst + (size_t)(J.r0 + n0 + n) * J.ldd + J.koff + k0 + 8 * c) = o; }
    asm volatile("s_waitcnt lgkmcnt(0)" ::: "memory");
}
__device__ __forceinline__ void p0_weights(const WJobs& WJ, int jlo, int jhi, LAS float* scr, int gw, int NGW, int lane) {
    int base = 0;
    for (int q = jlo; q < jhi; ++q) {
        const WJob& J = WJ.j[q]; const int ni = (J.K / 64) * (J.nc / 32);
        int it = gw - (base % NGW); if (it < 0) it += NGW;
        for (; it < ni; it += NGW) wT_item(J, scr, it, lane);
        base += ni;
    }
}
__device__ __forceinline__ float wave_sum(float v) {
#pragma unroll
    for (int o = 1; o < 64; o <<= 1) v += __shfl_xor(v, o);
    return v;
}
__device__ __forceinline__ void rms_row_to_bf16(const float* xrow, const float* g, bf16* orow, int lane) {
    const float4* xr = (const float4*)xrow + lane; const float4* gr = (const float4*)g + lane;
    float4 v[4]; float s = 0.f;
#pragma unroll
    for (int j = 0; j < 4; ++j) { v[j] = xr[64 * j]; s += (v[j].x * v[j].x + v[j].y * v[j].y) + (v[j].z * v[j].z + v[j].w * v[j].w); }
    const float r = rsqrtf(wave_sum(s) * (1.f / 1024.f) + EPS);
    unsigned long long* o8 = (unsigned long long*)orow + lane;
#pragma unroll
    for (int j = 0; j < 4; ++j) { const float4 gg = gr[64 * j];
        o8[64 * j] = (unsigned long long)pk2(v[j].x * r * gg.x, v[j].y * r * gg.y) | ((unsigned long long)pk2(v[j].z * r * gg.z, v[j].w * r * gg.w) << 32); }
}
}

namespace {
struct SguArgs {
    const bf16* vT;
    bf16* U;
    const float* vss;
    const float* ws;
    const float* bs;
    const float* gn;
    int TS, ldu;
};
typedef short bf16x8_t __attribute__((ext_vector_type(8)));
typedef float f32x4_t __attribute__((ext_vector_type(4)));
__device__ __forceinline__ void sgu_item(LAS unsigned char* lds, const SguArgs& A, int item, int tid) {
    const int g = item & 7, ch = item >> 3, tok0 = ch * 128;
    const int wave = tid >> 6, lane = tid & 63, fr = lane & 15, fq = lane >> 4;
#pragma unroll
    for (int j = 0; j < 4; ++j) { const int idx = tid + 512 * j, d = idx >> 4, chunk = idx & 15;
        const pg8::u32x4 v = *(const pg8::u32x4*)(A.vT + (size_t)(g * 128 + d) * A.TS + tok0 + chunk * 8);
        *(LAS pg8::u32x4*)(lds + d * 272 + chunk * 16) = v; }
    bf16x8_t af[4];
    const int p = 16 * wave + fr;
#pragma unroll
    for (int kk = 0; kk < 4; ++kk) { const int q = 32 * kk + 8 * fq;
        const float4 w0 = *(const float4*)(A.ws + ((size_t)g * 128 + p) * 128 + q), w1 = *(const float4*)(A.ws + ((size_t)g * 128 + p) * 128 + q + 4);
        const float4 s0 = *(const float4*)(A.vss + tok0 + q), s1 = *(const float4*)(A.vss + tok0 + q + 4);
        const float r0 = rsqrtf(s0.x * (1.f / 1024.f) + EPS), r1 = rsqrtf(s0.y * (1.f / 1024.f) + EPS), r2 = rsqrtf(s0.z * (1.f / 1024.f) + EPS), r3 = rsqrtf(s0.w * (1.f / 1024.f) + EPS);
        const float r4 = rsqrtf(s1.x * (1.f / 1024.f) + EPS), r5 = rsqrtf(s1.y * (1.f / 1024.f) + EPS), r6 = rsqrtf(s1.z * (1.f / 1024.f) + EPS), r7 = rsqrtf(s1.w * (1.f / 1024.f) + EPS);
        uint4 o; o.x = pk2(w0.x * r0, w0.y * r1); o.y = pk2(w0.z * r2, w0.w * r3); o.z = pk2(w1.x * r4, w1.y * r5); o.w = pk2(w1.z * r6, w1.w * r7);
        af[kk] = __builtin_bit_cast(bf16x8_t, o); }
    __syncthreads();
    f32x4_t acc[8];
#pragma unroll
    for (int nt = 0; nt < 8; ++nt) acc[nt] = (f32x4_t){0.f, 0.f, 0.f, 0.f};
#pragma unroll
    for (int kk = 0; kk < 4; ++kk) {
        bf16x8_t bfr[8];
#pragma unroll
        for (int nt = 0; nt < 8; ++nt) bfr[nt] = *(const LAS bf16x8_t*)(lds + (16 * nt + fr) * 272 + (32 * kk + 8 * fq) * 2);
#pragma unroll
        for (int nt = 0; nt < 8; ++nt) acc[nt] = __builtin_amdgcn_mfma_f32_16x16x32_bf16(bfr[nt], af[kk], acc[nt], 0, 0, 0);
    }
    const float bsp = A.bs[g * 128 + p];
    bf16* urow = A.U + (size_t)(tok0 + p) * A.ldu + g * 128 + 4 * fq;
    const float* gnp = A.gn + g * 128 + 4 * fq;
#pragma unroll
    for (int nt = 0; nt < 8; ++nt) {
        const uint2 uu = *(const uint2*)(urow + 16 * nt);
        const float4 gv = *(const float4*)(gnp + 16 * nt);
        const float y0 = bf2f(uu.x & 0xffffu) * (gv.x * acc[nt][0] + bsp), y1 = bf2f(uu.x >> 16) * (gv.y * acc[nt][1] + bsp);
        const float y2 = bf2f(uu.y & 0xffffu) * (gv.z * acc[nt][2] + bsp), y3 = bf2f(uu.y >> 16) * (gv.w * acc[nt][3] + bsp);
        uint2 o; o.x = pk2(y0, y1); o.y = pk2(y2, y3);
        *(uint2*)(urow + 16 * nt) = o;
    }
    __syncthreads();
}
}

namespace pg8 {
__device__ __forceinline__ void bf8_to_f32(const u32x4 q, f32x4& lo, f32x4& hi) {
    lo = (f32x4){__builtin_bit_cast(float, q.x << 16), __builtin_bit_cast(float, q.x & 0xffff0000u), __builtin_bit_cast(float, q.y << 16), __builtin_bit_cast(float, q.y & 0xffff0000u)};
    hi = (f32x4){__builtin_bit_cast(float, q.z << 16), __builtin_bit_cast(float, q.z & 0xffff0000u), __builtin_bit_cast(float, q.w << 16), __builtin_bit_cast(float, q.w & 0xffff0000u)};
}
struct EpiMerge {
    static constexpr bool PERM = true, AFTER_DRAIN = false, MID = true;
    const bf16_t* G; bf16_t* O;
    __device__ __forceinline__ void mid(f32x4 (&acc)[2][2][4][2], const Unit& u, int wr, int wc, int fr, int fq) const {
        unsigned off0 = (unsigned)(u.pm * BM + wr * 64 + fr) * 2048u + (unsigned)(u.pn * BM + wc * 32 + 8 * fq);
        asm volatile("" : "+v"(off0));
#pragma unroll
        for (int ai = 0; ai < 2; ++ai)
#pragma unroll
            for (int m = 0; m < 4; ++m)
#pragma unroll
                for (int bj = 0; bj < 2; ++bj) { const bf16_t* gp = G + (off0 + (unsigned)((ai * HALF + m * 16) * 2048 + bj * HALF));
                    const u32x4 qa = *(const u32x4*)gp, qb = *(const u32x4*)(gp + 1024);
                    f32x4 a0, a1, b0, b1; bf8_to_f32(qa, a0, a1); bf8_to_f32(qb, b0, b1);
#pragma unroll
                    for (int j = 0; j < 4; ++j) { acc[ai][bj][m][0][j] *= a0[j] * __builtin_amdgcn_rcpf(b0[j]); acc[ai][bj][m][1][j] *= a1[j] * __builtin_amdgcn_rcpf(b1[j]); }
                    asm volatile("" ::: "memory"); }
    }
    __device__ __forceinline__ void operator()(const f32x4 (&acc)[2][2][4][2], const Unit& u, int wr, int wc, int fr, int fq) const {
        const int row0 = u.pm * BM + wr * 64 + fr, col0 = u.pn * BM + wc * 32 + 8 * fq;
#pragma unroll
        for (int ai = 0; ai < 2; ++ai)
#pragma unroll
            for (int m = 0; m < 4; ++m) { const size_t r = (size_t)(row0 + ai * HALF + m * 16);
#pragma unroll
                for (int bj = 0; bj < 2; ++bj) { f32x4 b0, b1; bf8_to_f32(*(const u32x4*)(G + r * 2048 + 1024 + col0 + bj * HALF), b0, b1);
                    const f32x4 v0 = acc[ai][bj][m][0] * b0, v1 = acc[ai][bj][m][1] * b1;
                    u32x4 w; w.x = cvt_pk_bf16(v0[0], v0[1]); w.y = cvt_pk_bf16(v0[2], v0[3]); w.z = cvt_pk_bf16(v1[0], v1[1]); w.w = cvt_pk_bf16(v1[2], v1[3]);
                    *(u32x4*)(O + r * 1024 + col0 + bj * HALF) = w; } }
    }
};
}
namespace {
__device__ __forceinline__ void tr64_item(const bf16* yaT, int TS, bf16* out, int ldo, LAS unsigned short* scr, int c0, int t0, int lane) {
#pragma unroll
    for (int i = 0; i < 8; ++i) { const int r = 8 * i + (lane >> 3), ch = lane & 7;
        const pg8::u32x4 q = *(const pg8::u32x4*)(yaT + (size_t)(c0 + r) * TS + t0 + 8 * ch);
        LAS unsigned short* d = scr + (8 * ch) * 72 + r;
        d[0 * 72] = (unsigned short)(q.x & 0xffffu); d[1 * 72] = (unsigned short)(q.x >> 16); d[2 * 72] = (unsigned short)(q.y & 0xffffu); d[3 * 72] = (unsigned short)(q.y >> 16);
        d[4 * 72] = (unsigned short)(q.z & 0xffffu); d[5 * 72] = (unsigned short)(q.z >> 16); d[6 * 72] = (unsigned short)(q.w & 0xffffu); d[7 * 72] = (unsigned short)(q.w >> 16); }
    asm volatile("s_waitcnt lgkmcnt(0)" ::: "memory");
#pragma unroll
    for (int i = 0; i < 8; ++i) { const int tk = 8 * i + (lane >> 3), ch = lane & 7;
        const pg8::u32x4 q = *(const LAS pg8::u32x4*)(scr + tk * 72 + 8 * ch);
        *(pg8::u32x4*)(out + (size_t)(t0 + tk) * ldo + c0 + 8 * ch) = q; }
    asm volatile("s_waitcnt lgkmcnt(0)" ::: "memory");
}
__device__ __forceinline__ void transpose_ya(const bf16* yaT, int TS, bf16* out, int ldo, LAS unsigned short* scr, int gw, int NGW, int lane) {
    const int ntt = TS / 64, nit = 16 * ntt;
    for (int it = gw; it < nit; it += NGW) tr64_item(yaT, TS, out, ldo, scr, 64 * (it / ntt), 64 * (it % ntt), lane);
}
}

namespace pg8 {
template <bool WITH_BF16> struct EpiResid {
    static constexpr bool PERM = false, AFTER_DRAIN = false, MID = false;
    const float* X; float* X1; bf16_t* X1b; float* xss;
    __device__ __forceinline__ void operator()(const f32x4 (&acc)[2][2][4][2], const Unit& u, int wr, int wc, int fr, int fq) const {
        const int row0 = u.pm * BM + wr * 64 + fr, col0 = u.pn * BM + wc * 32 + 4 * fq;
        typedef unsigned u32x2v __attribute__((ext_vector_type(2)));
#pragma unroll
        for (int ai = 0; ai < 2; ++ai)
#pragma unroll
            for (int m = 0; m < 4; ++m) { const size_t r = (size_t)(row0 + ai * HALF + m * 16); float s = 0.f;
#pragma unroll
                for (int bj = 0; bj < 2; ++bj)
#pragma unroll
                    for (int n = 0; n < 2; ++n) { const size_t o = r * 1024 + col0 + bj * HALF + n * 16;
                        const f32x4 v = acc[ai][bj][m][n] + *(const f32x4*)(X + o);
                        *(f32x4*)(X1 + o) = v;
                        if (WITH_BF16) { u32x2v w; w.x = cvt_pk_bf16(v[0], v[1]); w.y = cvt_pk_bf16(v[2], v[3]); *(u32x2v*)(X1b + o) = w; }
                        s += (v[0] * v[0] + v[1] * v[1]) + (v[2] * v[2] + v[3] * v[3]); }
                s += __shfl_xor(s, 16); s += __shfl_xor(s, 32);
                if (fq == 0) atomicAdd(xss + r, s);
                asm volatile("" ::: "memory"); }
    }
};
struct EpiUp {
    static constexpr bool PERM = true, AFTER_DRAIN = false, MID = false;
    bf16_t* AP; bf16_t* GP; const float* xss;
    __device__ __forceinline__ void operator()(const f32x4 (&acc)[2][2][4][2], const Unit& u, int wr, int wc, int fr, int fq) const {
        const int row0 = u.pm * BM + wr * 64 + fr; int colt = u.pn * BM; const bool isg = colt >= 2816;
        bf16_t* base = isg ? GP : AP; if (isg) colt -= 2816;
        const int col0 = colt + wc * 32 + 8 * fq;
#pragma unroll
        for (int ai = 0; ai < 2; ++ai)
#pragma unroll
            for (int m = 0; m < 4; ++m) { const size_t r = (size_t)(row0 + ai * HALF + m * 16); const float rs = rsqrtf(xss[r] * (1.0f / 1024.0f) + 1e-6f);
#pragma unroll
                for (int bj = 0; bj < 2; ++bj) { const f32x4 v0 = acc[ai][bj][m][0] * rs, v1 = acc[ai][bj][m][1] * rs;
                    u32x4 w; w.x = cvt_pk_bf16(v0[0], v0[1]); w.y = cvt_pk_bf16(v0[2], v0[3]); w.z = cvt_pk_bf16(v1[0], v1[1]); w.w = cvt_pk_bf16(v1[2], v1[3]);
                    *(u32x4*)(base + r * 2816 + col0 + bj * HALF) = w; } }
    }
};
}
namespace {
__device__ __forceinline__ void act_pass(const bf16* AP, bf16* GP, const float* cw, const float* cb, int TS, int gid, int gstride) {
    const int nitems = (TS / 32) * 352;
    for (int it = gid; it < nitems; it += gstride) {
        const int run = it / 352, ch = it % 352, t0 = run * 32, c0 = ch * 8;
        pg8::f32x4 w0l, w0h, w1l, w1h, w2l, w2h, bl, bh;
        w0l = *(const pg8::f32x4*)(cw + c0); w0h = *(const pg8::f32x4*)(cw + c0 + 4);
        w1l = *(const pg8::f32x4*)(cw + 2816 + c0); w1h = *(const pg8::f32x4*)(cw + 2816 + c0 + 4);
        w2l = *(const pg8::f32x4*)(cw + 5632 + c0); w2h = *(const pg8::f32x4*)(cw + 5632 + c0 + 4);
        bl = *(const pg8::f32x4*)(cb + c0); bh = *(const pg8::f32x4*)(cb + c0 + 4);
        pg8::f32x4 pl, ph, cl, chh, nl, nh;
        const pg8::f32x4 z4 = {0.f, 0.f, 0.f, 0.f};
        if ((t0 & 4095) != 0) pg8::bf8_to_f32(*(const pg8::u32x4*)(AP + (size_t)(t0 - 1) * 2816 + c0), pl, ph); else { pl = z4; ph = z4; }
        pg8::bf8_to_f32(*(const pg8::u32x4*)(AP + (size_t)t0 * 2816 + c0), cl, chh);
        for (int i = 0; i < 32; ++i) {
            const int t = t0 + i;
            if ((t & 4095) != 4095) pg8::bf8_to_f32(*(const pg8::u32x4*)(AP + (size_t)(t + 1) * 2816 + c0), nl, nh); else { nl = z4; nh = z4; }
            pg8::f32x4 gl, gh; pg8::bf8_to_f32(*(const pg8::u32x4*)(GP + (size_t)t * 2816 + c0), gl, gh);
            pg8::f32x4 sl = bl + w0l * pl + w1l * cl + w2l * nl, sh = bh + w0h * ph + w1h * chh + w2h * nh;
            pg8::f32x4 ol, oh;
#pragma unroll
            for (int j = 0; j < 4; ++j) { ol[j] = sl[j] * __builtin_amdgcn_rcpf(1.0f + __builtin_amdgcn_exp2f(sl[j] * -1.4426950408889634f)) * gl[j];
                                          oh[j] = sh[j] * __builtin_amdgcn_rcpf(1.0f + __builtin_amdgcn_exp2f(sh[j] * -1.4426950408889634f)) * gh[j]; }
            pg8::u32x4 w; w.x = pg8::cvt_pk_bf16(ol[0], ol[1]); w.y = pg8::cvt_pk_bf16(ol[2], ol[3]); w.z = pg8::cvt_pk_bf16(oh[0], oh[1]); w.w = pg8::cvt_pk_bf16(oh[2], oh[3]);
            *(pg8::u32x4*)(GP + (size_t)t * 2816 + c0) = w;
            pl = cl; ph = chh; cl = nl; chh = nh;
        }
    }
}
__device__ __forceinline__ void final_norm(const float* X2, const float* ss, const float* g, float* out, int TS, int gw, int NGW, int lane) {
    for (int t = gw; t < TS; t += NGW) {
        const float r = rsqrtf(ss[t] * (1.0f / 1024.0f) + EPS);
#pragma unroll
        for (int j = 0; j < 4; ++j) { const pg8::f32x4 v = *((const pg8::f32x4*)(X2 + (size_t)t * 1024) + lane + 64 * j), gg = *((const pg8::f32x4*)g + lane + 64 * j);
            *((pg8::f32x4*)(out + (size_t)t * 1024) + lane + 64 * j) = v * gg * r; }
    }
}
}

namespace {
__device__ __forceinline__ void filter_mlp_row(const float* w1, const float* b1, const float* w2, const float* b2, const float* w3, const float* b3,
                                               const float* freq, float* h3out, LAS float* scr, int l, int j) {
    LAS float* z = scr; LAS float* ha = scr + 64; LAS float* hb = scr + 128;
    if (j < FEMB) {
        float val;
        if (j == 0) val = (float)((double)l / (double)(L - 1));
        else {
            const int i = (j - 1) & 15;
            const double band = 1e-4 + (double)i * ((15.0 - 1e-4) / 15.0);
            double rev = (double)l * band / (double)L;
            rev -= floor(rev);
            const float ang = (float)(rev * 6.283185307179586);
            val = (j <= 16) ? cosf(ang) : -sinf(ang);
        }
        z[j] = val;
    }
    asm volatile("s_waitcnt lgkmcnt(0)" ::: "memory");
    const float a = freq[j];
    float s = b1[j];
#pragma unroll 1
    for (int i = 0; i < FEMB; ++i) s += z[i] * w1[i * FHID + j];
    ha[j] = sinf(a * s);
    asm volatile("s_waitcnt lgkmcnt(0)" ::: "memory");
    s = b2[j];
#pragma unroll 1
    for (int i = 0; i < FHID; ++i) s += ha[i] * w2[i * FHID + j];
    hb[j] = sinf(a * s);
    asm volatile("s_waitcnt lgkmcnt(0)" ::: "memory");
    s = b3[j];
#pragma unroll 1
    for (int i = 0; i < FHID; ++i) s += hb[i] * w3[i * FHID + j];
    h3out[l * FHID + j] = sinf(a * s);
    asm volatile("s_waitcnt lgkmcnt(0)" ::: "memory");
}
__device__ __forceinline__ void filter_tables(const float* h3, const float* w4, const float* decay, float* fsum, float* fdif, int gw, int NGW, int lane) {
    for (int it = gw; it < 2048; it += NGW) {
        const int n = (it & 63) * 64 + lane, c0 = (it >> 6) * 32, nb = n ? 4096 - n : 0;
        float sf[32], sb[32];
#pragma unroll
        for (int cc = 0; cc < 32; ++cc) { sf[cc] = 0.f; sb[cc] = 0.f; }
        for (int j = 0; j < FHID; ++j) {
            const float hn = h3[n * FHID + j], hm = h3[nb * FHID + j];
            const float* wf = w4 + j * 2048 + c0;
#pragma unroll
            for (int cc = 0; cc < 32; ++cc) { sf[cc] += hn * wf[cc]; sb[cc] += hm * wf[1024 + cc]; }
        }
        const float tf = (float)((double)n / (double)(L - 1)), tb = (float)((double)nb / (double)(L - 1));
#pragma unroll
        for (int cc = 0; cc < 32; ++cc) {
            const float hf = sf[cc] * expf(-tf * fabsf(decay[c0 + cc]));
            const float hb = n ? sb[cc] * expf(-tb * fabsf(decay[1024 + c0 + cc])) : 0.f;
            fsum[(size_t)(c0 + cc) * 4096 + n] = hf + hb;
            fdif[(size_t)(c0 + cc) * 4096 + n] = hf - hb;
        }
    }
}
constexpr size_t MiB = 1u << 20;
constexpr int M = NB * L;
constexpr size_t WS_VSS = 0, WS_XSS = 64 * 1024, WS_X2SS = 128 * 1024, WS_TTAB = 192 * 1024, WS_H3 = 1 * MiB;
constexpr size_t WS_WTA = 2 * MiB, WS_WTB = 10 * MiB, WS_PAB = 16 * MiB, WS_WO = 20 * MiB;
constexpr size_t WS_FSUM = 24 * MiB, WS_WUP = 24 * MiB, WS_WDN = 35 * MiB;
constexpr size_t WS_HYT = 41 * MiB;
constexpr size_t WS_X1B = 41 * MiB, WS_MRG = 105 * MiB;
constexpr size_t WS_YAB = 169 * MiB;
constexpr size_t WS_FDIF = 233 * MiB;
constexpr size_t WS_AP = 73 * MiB, WS_GP = 161 * MiB;
static_assert(WS_GP + (size_t)M * FH * 2 <= 256 * MiB && WS_AP + (size_t)M * FH * 2 <= WS_GP && WS_FDIF + 16 * MiB <= 256 * MiB && WS_WDN + (size_t)D * FH * 2 <= WS_HYT, "d_ws map");
constexpr int LDS_BYTES = 147456;
constexpr int NPH = 10;

struct MegaArgs { const float* in[27]; float* out; unsigned char* ws; int ph_lo, ph_hi; WJobs wj; };

__global__ void __launch_bounds__(512, 2) mega_fwd(MegaArgs a) {
    extern __shared__ __attribute__((aligned(16))) unsigned char lds_raw[];
    LAS unsigned char* lds = (LAS unsigned char*)lds_raw;
    cg::grid_group grid = cg::this_grid();
    const int wave = __builtin_amdgcn_readfirstlane((int)threadIdx.x >> 6);
    const int G = gridDim.x, bid = blockIdx.x, gw = bid * 8 + wave, NGW = G * 8;
#define FRESH_TID int lane; asm volatile("v_mbcnt_lo_u32_b32 %0, -1, 0\n\tv_mbcnt_hi_u32_b32 %0, -1, %0" : "=v"(lane)); const int tid = wave * 64 + lane; (void)tid
    unsigned char* ws = a.ws;
    const float* x = a.in[0];
    float* vss = (float*)(ws + WS_VSS); float* xss = (float*)(ws + WS_XSS); float* x2ss = (float*)(ws + WS_X2SS);
    cf* Ttab = (cf*)(ws + WS_TTAB); float* h3 = (float*)(ws + WS_H3);
    bf16* WtA = (bf16*)(ws + WS_WTA); bf16* WtB = (bf16*)(ws + WS_WTB); bf16* PabT = (bf16*)(ws + WS_PAB); bf16* WoT = (bf16*)(ws + WS_WO);
    bf16* WupT = (bf16*)(ws + WS_WUP); bf16* WdnT = (bf16*)(ws + WS_WDN);
    float* fsum = (float*)(ws + WS_FSUM); float* fdif = (float*)(ws + WS_FDIF);
    bf16* hyvT = (bf16*)(ws + WS_HYT); bf16* yaT = hyvT + (size_t)1024 * M; bf16* vT = hyvT + (size_t)3072 * M;
    bf16* YAB = (bf16*)(ws + WS_YAB); bf16* h1 = YAB; bf16* Ub = YAB + 1024;
    bf16* Gb = (bf16*)a.out;
    bf16* mrg = (bf16*)(ws + WS_MRG); bf16* X1b = (bf16*)(ws + WS_X1B); float* X1 = a.out;
    bf16* APb = (bf16*)(ws + WS_AP); bf16* GPb = (bf16*)(ws + WS_GP);
    const int lo = a.ph_lo, hi = a.ph_hi;
#define IN(k) (lo <= (k) && (k) < hi)
#define SEAM(k) do { if (IN(k) && IN((k) + 1)) grid.sync(); } while (0)

    if (IN(0)) { FRESH_TID;
        p0_weights(a.wj, 0, 7, (LAS float*)lds + wave * 4096, gw, NGW, lane);
        for (int m = gw; m < M; m += NGW) rms_row_to_bf16(x + (size_t)m * 1024, a.in[1], h1 + (size_t)m * 2048, lane);
        for (int i = bid * 512 + tid; i < 3 * M; i += G * 512) vss[i] = 0.f;
        for (int l = gw; l < L; l += NGW) filter_mlp_row(a.in[5], a.in[6], a.in[7], a.in[8], a.in[9], a.in[10], a.in[11], h3, (LAS float*)lds + wave * 4096, l, lane);
        for (int m = bid * 512 + tid; m < 4096; m += G * 512) { const float ang = (float)m / 4096.0f; Ttab[m] = cmk(cospif(ang), -sinpif(ang)); }
    }
    SEAM(0);
    if (IN(1)) { FRESH_TID;
        { pg8::Gemm g{WtA, h1, 4096, M, 1024, 1024, 2048}; pg8::StaticOrder S; S.init(4096, M, G, bid);
          pg8::EpiHyT E{hyvT, M, vss};
          pg8::gemm_phase<pg8::EpiHyT, pg8::StaticOrder, true, true>(lds, g, S, E, tid); }
        { pg8::Gemm g{h1, WtB, M, 3072, 1024, 2048, 1024}; pg8::StaticOrder S; S.init(M, 3072, G, bid);
          pg8::EpiUG E{Ub, Gb, 2048};
          pg8::gemm_phase<pg8::EpiUG, pg8::StaticOrder, true, true>(lds, g, S, E, tid); }
        filter_tables(h3, a.in[12], a.in[13], fsum, fdif, gw, NGW, lane);
    }
    SEAM(1);
    if (IN(2)) { FRESH_TID;
        HyArgs H; H.hyT = hyvT; H.yaT = yaT; H.fsum = fsum; H.fdif = fdif; H.cw = a.in[3]; H.cb = a.in[4]; H.skip = a.in[14]; H.T = Ttab;
        H.TS = M; H.npairs = 2; H.off00 = 0; H.off01 = L; H.off10 = 2 * L; H.off11 = 3 * L;
        hyena_phase((lcf)lds, H, bid, G, tid);
        SguArgs Sg; Sg.vT = vT; Sg.U = Ub; Sg.vss = vss; Sg.ws = a.in[16]; Sg.bs = a.in[17]; Sg.gn = a.in[15]; Sg.TS = M; Sg.ldu = 2048;
        for (int it = bid; it < (M / 128) * 8; it += G) sgu_item(lds, Sg, it, tid);
    }
    SEAM(2);
    if (IN(3)) { FRESH_TID;
        transpose_ya(yaT, M, YAB, 2048, (LAS unsigned short*)lds + wave * 8192, gw, NGW, lane);
        p0_weights(a.wj, 7, 9, (LAS float*)lds + wave * 4096, gw, NGW, lane);
    }
    SEAM(3);
    if (IN(4)) { FRESH_TID;
        pg8::Gemm g{YAB, PabT, M, 1024, 2048, 2048, 2048}; pg8::StaticOrder S; S.init(M, 1024, G, bid);
        pg8::EpiMerge E{Gb, mrg};
        pg8::gemm_phase<pg8::EpiMerge, pg8::StaticOrder, true, true>(lds, g, S, E, tid);
    }
    SEAM(4);
    if (IN(5)) { FRESH_TID;
        pg8::Gemm g{mrg, WoT, M, 1024, 1024, 1024, 1024}; pg8::StaticOrder S; S.init(M, 1024, G, bid);
        pg8::EpiResid<true> E{x, X1, X1b, xss};
        pg8::gemm_phase<pg8::EpiResid<true>, pg8::StaticOrder, true, true>(lds, g, S, E, tid);
    }
    SEAM(5);
    if (IN(6)) { FRESH_TID;
        pg8::Gemm g{X1b, WupT, M, 2 * FH, 1024, 1024, 1024}; pg8::StaticOrder S; S.init(M, 2 * FH, G, bid);
        pg8::EpiUp E{APb, GPb, xss};
        pg8::gemm_phase<pg8::EpiUp, pg8::StaticOrder, true, true>(lds, g, S, E, tid);
    }
    SEAM(6);
    if (IN(7)) { FRESH_TID; act_pass(APb, GPb, a.in[23], a.in[24], M, bid * 512 + tid, G * 512); }
    SEAM(7);
    if (IN(8)) { FRESH_TID;
        pg8::Gemm g{GPb, WdnT, M, 1024, FH, FH, FH}; pg8::StaticOrder S; S.init(M, 1024, G, bid);
        pg8::EpiResid<false> E{X1, X1, nullptr, x2ss};
        pg8::gemm_phase<pg8::EpiResid<false>, pg8::StaticOrder, true, true>(lds, g, S, E, tid);
    }
    SEAM(8);
    if (IN(9)) { FRESH_TID; final_norm(X1, x2ss, a.in[26], a.out, M, gw, NGW, lane); }
#undef IN
#undef SEAM
}
}

#ifndef MK_CUTS
#define MK_CUTS 0
#endif
extern "C" void kernel_launch(void* const* d_in, const int* in_sizes, int n_in, void* d_out, int out_size, void* d_ws, size_t ws_size, hipStream_t stream) {
    static int grid = 0;
    if (grid == 0) {
        int dev = 0, cus = 0, per_cu = 0;
        hipGetDevice(&dev);
        hipDeviceGetAttribute(&cus, hipDeviceAttributeMultiprocessorCount, dev);
        hipFuncSetAttribute((const void*)mega_fwd, hipFuncAttributeMaxDynamicSharedMemorySize, LDS_BYTES);
        hipOccupancyMaxActiveBlocksPerMultiprocessor(&per_cu, (const void*)mega_fwd, 512, LDS_BYTES);
        if (per_cu < 1) { fprintf(stderr, "kernel_launch: occupancy query says %d blocks per CU\n", per_cu); per_cu = 1; }
        grid = cus * 1;
        (void)hipGetLastError();
    }
    MegaArgs a{};
    for (int i = 0; i < 27; ++i) a.in[i] = (const float*)d_in[i];
    a.out = (float*)d_out; a.ws = (unsigned char*)d_ws;
    { unsigned char* ws = (unsigned char*)d_ws;
      bf16* WtA = (bf16*)(ws + WS_WTA); bf16* WtB = (bf16*)(ws + WS_WTB); bf16* PabT = (bf16*)(ws + WS_PAB); bf16* WoT = (bf16*)(ws + WS_WO); bf16* WupT = (bf16*)(ws + WS_WUP); bf16* WdnT = (bf16*)(ws + WS_WDN);
    a.wj.j[0] = WJob{(const float*)d_in[2], nullptr, WtA, 1024, INW, 0, 3072, 1024, 0, 0, 0};
    a.wj.j[1] = WJob{(const float*)d_in[2], nullptr, WtA, 1024, INW, 4096, 1024, 1024, 3072, 0, 0};
    a.wj.j[2] = WJob{(const float*)d_in[2], nullptr, WtB, 1024, INW, 3072, 1024, 1024, 0, 0, 0};
    a.wj.j[3] = WJob{(const float*)d_in[2], nullptr, WtB, 1024, INW, 5120, 2048, 1024, 1024, 0, 0};
    a.wj.j[4] = WJob{(const float*)d_in[18], nullptr, PabT, 1024, 1024, 0, 1024, 2048, 0, 0, 0};
    a.wj.j[5] = WJob{(const float*)d_in[19], nullptr, PabT, 1024, 1024, 0, 1024, 2048, 0, 1024, 0};
    a.wj.j[6] = WJob{(const float*)d_in[20], nullptr, WoT, 1024, 1024, 0, 1024, 1024, 0, 0, 0};
    a.wj.j[7] = WJob{(const float*)d_in[22], (const float*)d_in[21], WupT, 1024, 2 * FH, 0, 2 * FH, 1024, 0, 0, 0};
    a.wj.j[8] = WJob{(const float*)d_in[25], nullptr, WdnT, FH, 1024, 0, 1024, FH, 0, 0, 0};

    }
#if MK_CUTS
    for (int p = 0; p < NPH; ++p) { a.ph_lo = p; a.ph_hi = p + 1; hipLaunchKernelGGL(mega_fwd, dim3(grid), dim3(512), LDS_BYTES, stream, a); }
#else
    a.ph_lo = 0; a.ph_hi = NPH;
    void* args[] = {&a};
    hipError_t e = hipLaunchCooperativeKernel((const void*)mega_fwd, dim3(grid), dim3(512), args, LDS_BYTES, stream);
    if (e != hipSuccess) fprintf(stderr, "cooperative launch failed: %s (grid %d)\n", hipGetErrorString(e), grid);
#endif
}
```

```cpp
#include <hip/hip_runtime.h>
#include <hip/hip_cooperative_groups.h>
#include <math.h>
#include <stdint.h>
#include <cstdio>
namespace cg = cooperative_groups;
namespace pg8 {
#define PG8_LAS __attribute__((address_space(3)))
typedef unsigned short bf16_t;
typedef short bf16x8 __attribute__((ext_vector_type(8)));
typedef float f32x4 __attribute__((ext_vector_type(4)));
typedef unsigned u32x4 __attribute__((ext_vector_type(4)));
constexpr int BM = 256, BK = 64, HALF = 128, HTB = HALF * BK * 2  , STAGE_BYTES = 8 * HTB, NXCD = 8, WGM = 8;

__host__ __device__ __forceinline__ int lds_byte(int r, int c) { const int st = (r >> 4) * 2 + (c >> 5), rr = r & 15, cc = c & 31, ob = rr * 64 + cc * 2; return st * 1024 + (ob ^ (((ob >> 9) & 1) << 5)); }
__host__ __device__ __forceinline__ void stage_rc(int b, int& R, int& C) { const int st = b / 1024, sb = b % 1024, swz = sb ^ (((sb >> 9) & 1) << 5); R = (st >> 1) * 16 + swz / 64; C = (st & 1) * 32 + (swz % 64) / 2; }
__host__ __device__ __forceinline__ int perm32(int rho) { const int n = rho >> 4, i = rho & 15; return 8 * (i >> 2) + 4 * n + (i & 3); }

struct Unit { int pm, pn; };
struct Gemm { const bf16_t* A; const bf16_t* Bt; int M, N, K, lda, ldb; };

struct StaticOrder {
    int nM, nN, nwg, G, c;
    __host__ __device__ void init(int M, int N, int G_, int c_) { nM = M / BM; nN = N / BM; nwg = nM * nN; G = G_; c = c_; }
    __host__ __device__ bool next(int i, Unit& u) const {
        const long L = (long)i * G + c; if (L >= nwg) return false;
        int wgid = (int)L; { const int q = nwg / NXCD, r = nwg % NXCD, xcd = wgid % NXCD, off = wgid / NXCD; wgid = (xcd < r ? xcd * (q + 1) : r * (q + 1) + (xcd - r) * q) + off; }
        const int nig = WGM * nN, gid = wgid / nig, fm = gid * WGM, gsz = (nM - fm) < WGM ? (nM - fm) : WGM;
        u.pm = fm + ((wgid % nig) % gsz); u.pn = (wgid % nig) / gsz; return true;
    }
    __device__ __forceinline__ void a_ready(const Unit&) const {}
    __device__ __forceinline__ void done(const Unit&) const {}
};

__device__ __forceinline__ unsigned cvt_pk_bf16(float lo, float hi) { unsigned r; asm volatile("v_cvt_pk_bf16_f32 %0, %1, %2" : "=v"(r) : "v"(lo), "v"(hi)); return r; }
typedef float f32x2 __attribute__((ext_vector_type(2)));
__device__ __forceinline__ f32x2 gelu_pk(f32x2 v) {
    const f32x2 av = __builtin_elementwise_abs(v), d = av * 0.2316418882f + 1.0f;
    f32x2 t; t.x = __builtin_amdgcn_rcpf(d.x); t.y = __builtin_amdgcn_rcpf(d.y);
    f32x2 q = t * 0.5307027145f + (-0.7265760135f); q = q * t + 0.7107068705f; q = q * t + (-0.142248368f); q = q * t + 0.127414796f; q = q * t;
    const f32x2 s = (v * v) * (-0.72134752044f);
    f32x2 e; e.x = __builtin_amdgcn_exp2f(s.x); e.y = __builtin_amdgcn_exp2f(s.y);
    const f32x2 m = v * (q * e), r = v - m;
    f32x2 o; o.x = v.x < 0.f ? m.x : r.x; o.y = v.y < 0.f ? m.y : r.y; return o;
}

template <int ACT  > struct EpiBf16 {
    static constexpr bool PERM = true, AFTER_DRAIN = false, MID = false; static_assert(ACT == 0 || ACT == 1, "EpiBf16: ACT is 0 (none) or 1 (gelu_pk)");
    bf16_t* O; int ldc; const float* bias; int split_cols; size_t split_stride; float scale0;
    __device__ __forceinline__ void operator()(const f32x4 (&acc)[2][2][4][2], const Unit& u, int wr, int wc, int fr, int fq) const {
        const int row0 = u.pm * BM + wr * 64 + fr; int colt = u.pn * BM; bf16_t* base = O;
        float sc = 1.f; if (split_cols) { const int t = colt / split_cols; base += (size_t)t * split_stride; colt -= t * split_cols; if (t == 0) sc = scale0; }
        const int col0 = colt + wc * 32 + 8 * fq, bcol0 = u.pn * BM + wc * 32 + 8 * fq;
        f32x4 bv[2][2];
#pragma unroll
        for (int bj = 0; bj < 2; ++bj)
#pragma unroll
            for (int n = 0; n < 2; ++n) bv[bj][n] = bias ? *(const f32x4*)(bias + bcol0 + bj * HALF + 4 * n) : (f32x4){0.f, 0.f, 0.f, 0.f};
#pragma unroll
        for (int ai = 0; ai < 2; ++ai)
#pragma unroll
            for (int m = 0; m < 4; ++m) { bf16_t* rowp = base + (size_t)(row0 + ai * HALF + m * 16) * ldc + col0;
#pragma unroll
                for (int bj = 0; bj < 2; ++bj) { f32x4 v0 = acc[ai][bj][m][0] + bv[bj][0], v1 = acc[ai][bj][m][1] + bv[bj][1];
                    if (ACT == 1) { f32x2 a = gelu_pk((f32x2){v0[0], v0[1]}), b = gelu_pk((f32x2){v0[2], v0[3]}), c = gelu_pk((f32x2){v1[0], v1[1]}), d = gelu_pk((f32x2){v1[2], v1[3]});
                        v0 = (f32x4){a.x, a.y, b.x, b.y}; v1 = (f32x4){c.x, c.y, d.x, d.y}; }
                    v0 = v0 * sc; v1 = v1 * sc; u32x4 w; w.x = cvt_pk_bf16(v0[0], v0[1]); w.y = cvt_pk_bf16(v0[2], v0[3]); w.z = cvt_pk_bf16(v1[0], v1[1]); w.w = cvt_pk_bf16(v1[2], v1[3]);
                    *(u32x4*)(rowp + bj * HALF) = w; } }
    }
};

struct EpiF32 {
    static constexpr bool PERM = false, AFTER_DRAIN = false, MID = false;
    float* C; int ldc; const float* bias;
    __device__ __forceinline__ void operator()(const f32x4 (&acc)[2][2][4][2], const Unit& u, int wr, int wc, int fr, int fq) const {
        const int row0 = u.pm * BM + wr * 64 + fr, col0 = u.pn * BM + wc * 32 + 4 * fq;
        f32x4 bv[2][2];
#pragma unroll
        for (int bj = 0; bj < 2; ++bj)
#pragma unroll
            for (int n = 0; n < 2; ++n) bv[bj][n] = bias ? *(const f32x4*)(bias + col0 + bj * HALF + n * 16) : (f32x4){0.f, 0.f, 0.f, 0.f};
#pragma unroll
        for (int ai = 0; ai < 2; ++ai)
#pragma unroll
            for (int m = 0; m < 4; ++m) { float* rowp = C + (size_t)(row0 + ai * HALF + m * 16) * ldc + col0;
#pragma unroll
                for (int bj = 0; bj < 2; ++bj)
#pragma unroll
                    for (int n = 0; n < 2; ++n) *(f32x4*)(rowp + bj * HALF + n * 16) = acc[ai][bj][m][n] + bv[bj][n]; }
    }
};

template <class Epi, class Sched, bool ALIGN_EPI = false, bool SP2 = false>
__device__ __forceinline__ void gemm_phase(PG8_LAS unsigned char* lds, const Gemm g, const Sched& S, const Epi& E, const int tid) {
    const int wid = __builtin_amdgcn_readfirstlane(tid >> 6), lane = tid & 63, wr = wid >> 2, wc = wid & 3, fr = lane & 15, fq = lane >> 4;
    const int K = g.K, nt = K / BK;
    unsigned voffA[2], voffB[2];
#pragma unroll
    for (int i = 0; i < 2; ++i) { int R, C; stage_rc(tid * 16 + i * 8192, R, C); const int Rb = Epi::PERM ? ((R & ~31) + perm32(R & 31)) : R;
        voffA[i] = (unsigned)(R * g.lda + C) * 2u; voffB[i] = (unsigned)(Rb * g.ldb + C) * 2u; }
    const size_t kstep = (size_t)(BK * 2);
    const size_t hstepA = (size_t)HALF * g.lda * 2, hstepB = (size_t)HALF * g.ldb * 2;
    const size_t tstepA = 2 * hstepA, tstepB = 2 * hstepB;
    const unsigned ldsw = (unsigned)wid * 1024u;
    const int aoff = lds_byte(wr * 64 + fr, fq * 8), boff = lds_byte(wc * 32 + fr, fq * 8);
#define PG8_SA(b, h) (((b) * 2 + (h)) * HTB)
#define PG8_SB(b, h) ((4 + (b) * 2 + (h)) * HTB)
#define PG8_STAGE(bufoff, gbase, voff) do { _Pragma("unroll") for (int _i = 0; _i < 2; ++_i) \
        __builtin_amdgcn_global_load_lds((const unsigned*)((const char*)(gbase) + (voff)[_i]), (PG8_LAS unsigned*)(lds + (bufoff) + ldsw + _i * 8192), 16, 0, 0); } while (0)
#define PG8_LDA(dst, b, h) do { _Pragma("unroll") for (int m = 0; m < 4; ++m) _Pragma("unroll") for (int k = 0; k < 2; ++k) dst[m][k] = *(const PG8_LAS bf16x8*)(lds + PG8_SA(b, h) + aoff + m * 2048 + k * 1024); } while (0)
#define PG8_LDB(dst, b, h) do { _Pragma("unroll") for (int n = 0; n < 2; ++n) _Pragma("unroll") for (int k = 0; k < 2; ++k) dst[n][k] = *(const PG8_LAS bf16x8*)(lds + PG8_SB(b, h) + boff + n * 2048 + k * 1024); } while (0)
#define PG8_MMA(ai, bj, At, Bt) do { __builtin_amdgcn_s_setprio(1); _Pragma("unroll") for (int m = 0; m < 4; ++m) _Pragma("unroll") for (int n = 0; n < 2; ++n) _Pragma("unroll") for (int k = 0; k < 2; ++k) \
        acc[ai][bj][m][n] = __builtin_amdgcn_mfma_f32_16x16x32_bf16(Bt[n][k], At[m][k], acc[ai][bj][m][n], 0, 0, 0); __builtin_amdgcn_s_setprio(0); } while (0)
#define PG8_WAIT_V(n) asm volatile("s_waitcnt vmcnt(" #n ")" ::: "memory")
#define PG8_WAIT_L(n) asm volatile("s_waitcnt lgkmcnt(" #n ")" ::: "memory")
#define PG8_BAR __builtin_amdgcn_s_barrier()
#define PG8_SCHED __builtin_amdgcn_sched_barrier(0)
    Unit cur, nxt; int ui = 0;
    if (!S.next(0, cur)) return;
    f32x4 acc[2][2][4][2];
#pragma unroll
    for (int a = 0; a < 2; ++a)
#pragma unroll
        for (int b = 0; b < 2; ++b)
#pragma unroll
            for (int m = 0; m < 4; ++m)
#pragma unroll
                for (int n = 0; n < 2; ++n) acc[a][b][m][n] = (f32x4){0.f, 0.f, 0.f, 0.f};
    bf16x8 At[4][2], B0[2][2], B1[2][2];
    const char* cA = (const char*)g.A + (size_t)cur.pm * tstepA; const char* cB = (const char*)g.Bt + (size_t)cur.pn * tstepB;
    S.a_ready(cur);
    if constexpr (SP2) {
        PG8_STAGE(PG8_SB(0, 0), cB, voffB); PG8_STAGE(PG8_SB(0, 1), cB + hstepB, voffB); PG8_STAGE(PG8_SA(0, 0), cA, voffA); PG8_STAGE(PG8_SA(0, 1), cA + hstepA, voffA);
        if (wr == 1) PG8_BAR;
        PG8_WAIT_V(2); PG8_BAR;
        PG8_STAGE(PG8_SB(1, 0), cB + kstep, voffB); PG8_STAGE(PG8_SA(1, 0), cA + kstep, voffA); PG8_STAGE(PG8_SB(1, 1), cB + hstepB + kstep, voffB);
        PG8_WAIT_V(6); PG8_BAR;
    } else {
        PG8_STAGE(PG8_SB(0, 0), cB, voffB); PG8_STAGE(PG8_SA(0, 0), cA, voffA); PG8_STAGE(PG8_SB(0, 1), cB + hstepB, voffB); PG8_STAGE(PG8_SA(0, 1), cA + hstepA, voffA);
        if (wr == 1) PG8_BAR;
        PG8_WAIT_V(4); PG8_BAR;
        PG8_STAGE(PG8_SB(1, 0), cB + kstep, voffB); PG8_STAGE(PG8_SA(1, 0), cA + kstep, voffA); PG8_STAGE(PG8_SB(1, 1), cB + hstepB + kstep, voffB);
        PG8_WAIT_V(6); PG8_BAR;
    }
    for (;;) {
        const bool has_next = S.next(ui + 1, nxt);
        const char* nA = has_next ? (const char*)g.A + (size_t)nxt.pm * tstepA : cA; const char* nB = has_next ? (const char*)g.Bt + (size_t)nxt.pn * tstepB : cB;
        for (int t = 0; t < nt; t += 2) {
            const bool last = (t == nt - 2);
            const char* a1 = cA + (size_t)(t + 1) * kstep;
            const char* a2 = last ? nA : cA + (size_t)(t + 2) * kstep; const char* b2 = last ? nB : cB + (size_t)(t + 2) * kstep;
            const char* a3 = a2 + kstep; const char* b3 = b2 + kstep;
            if (last && has_next) S.a_ready(nxt);
            if constexpr (Epi::MID) { if (t == (nt >> 1)) E.mid(acc, cur, wr, wc, fr, fq); }
            if constexpr (SP2) {
            PG8_LDB(B0, 0, 0); PG8_LDB(B1, 0, 1); PG8_SCHED; PG8_LDA(At, 0, 0); PG8_STAGE(PG8_SA(1, 1), a1 + hstepA, voffA);
            PG8_WAIT_V(8); PG8_WAIT_L(0); PG8_BAR; PG8_MMA(0, 0, At, B0); PG8_MMA(0, 1, At, B1); PG8_BAR; PG8_SCHED;
            PG8_LDA(At, 0, 1); PG8_STAGE(PG8_SB(0, 0), b2, voffB); PG8_STAGE(PG8_SB(0, 1), b2 + hstepB, voffB); PG8_STAGE(PG8_SA(0, 0), a2, voffA);
            PG8_WAIT_V(8); PG8_WAIT_L(0); PG8_BAR; PG8_MMA(1, 0, At, B0); PG8_MMA(1, 1, At, B1); PG8_BAR; PG8_SCHED;
            PG8_LDB(B0, 1, 0); PG8_LDB(B1, 1, 1); PG8_SCHED; PG8_LDA(At, 1, 0); PG8_STAGE(PG8_SA(0, 1), a2 + hstepA, voffA);
            PG8_WAIT_V(8); PG8_WAIT_L(0); PG8_BAR; PG8_MMA(0, 0, At, B0); PG8_MMA(0, 1, At, B1); PG8_BAR; PG8_SCHED;
            PG8_LDA(At, 1, 1); PG8_STAGE(PG8_SB(1, 0), b3, voffB); PG8_STAGE(PG8_SB(1, 1), b3 + hstepB, voffB); PG8_STAGE(PG8_SA(1, 0), a3, voffA);
            PG8_WAIT_V(8); PG8_WAIT_L(0); PG8_BAR; PG8_MMA(1, 0, At, B0); PG8_MMA(1, 1, At, B1); PG8_BAR; PG8_SCHED;
            } else {
            PG8_LDB(B0, 0, 0); PG8_SCHED; PG8_LDA(At, 0, 0); PG8_STAGE(PG8_SA(1, 1), a1 + hstepA, voffA);
            PG8_WAIT_L(8); PG8_BAR; PG8_WAIT_L(0); PG8_MMA(0, 0, At, B0); PG8_BAR; PG8_SCHED;
            PG8_LDB(B1, 0, 1); PG8_STAGE(PG8_SB(0, 0), b2, voffB);
            PG8_BAR; PG8_WAIT_L(0); PG8_MMA(0, 1, At, B1); PG8_BAR;
            PG8_LDA(At, 0, 1); PG8_STAGE(PG8_SA(0, 0), a2, voffA);
            PG8_BAR; PG8_WAIT_L(0); PG8_MMA(1, 0, At, B0); PG8_BAR; PG8_SCHED;
            PG8_STAGE(PG8_SB(0, 1), b2 + hstepB, voffB);
            PG8_WAIT_V(6); PG8_BAR; PG8_MMA(1, 1, At, B1); PG8_BAR;
            PG8_LDB(B0, 1, 0); PG8_SCHED; PG8_LDA(At, 1, 0); PG8_STAGE(PG8_SA(0, 1), a2 + hstepA, voffA);
            PG8_WAIT_L(8); PG8_BAR; PG8_WAIT_L(0); PG8_MMA(0, 0, At, B0); PG8_BAR; PG8_SCHED;
            PG8_LDB(B1, 1, 1); PG8_STAGE(PG8_SB(1, 0), b3, voffB);
            PG8_BAR; PG8_WAIT_L(0); PG8_MMA(0, 1, At, B1); PG8_BAR;
            PG8_LDA(At, 1, 1); PG8_STAGE(PG8_SA(1, 0), a3, voffA);
            PG8_BAR; PG8_WAIT_L(0); PG8_MMA(1, 0, At, B0); PG8_BAR; PG8_SCHED;
            PG8_STAGE(PG8_SB(1, 1), b3 + hstepB, voffB);
            PG8_WAIT_V(6); PG8_BAR; PG8_MMA(1, 1, At, B1); PG8_BAR;
            }
        }
        if constexpr (ALIGN_EPI) { if (wr == 0) PG8_BAR; }
        if constexpr (!Epi::AFTER_DRAIN) { E(acc, cur, wr, wc, fr, fq); S.done(cur); }
        if (!has_next) break;
#pragma unroll
        for (int a = 0; a < 2; ++a)
#pragma unroll
            for (int b = 0; b < 2; ++b)
#pragma unroll
                for (int m = 0; m < 4; ++m)
#pragma unroll
                    for (int n = 0; n < 2; ++n) acc[a][b][m][n] = (f32x4){0.f, 0.f, 0.f, 0.f};
        cur = nxt; cA = nA; cB = nB; ++ui;
        if constexpr (ALIGN_EPI) { if (wr == 1) PG8_BAR; }
    }
    PG8_WAIT_V(0);
    if constexpr (!ALIGN_EPI) { if (wr == 0) PG8_BAR; }
    PG8_BAR;
    if constexpr (Epi::AFTER_DRAIN) { E.fused(acc, cur, wr, wc, fr, fq, lds, wid, lane); S.done(cur); }
#undef PG8_SA
#undef PG8_SB
#undef PG8_STAGE
#undef PG8_LDA
#undef PG8_LDB
#undef PG8_MMA
#undef PG8_WAIT_V
#undef PG8_WAIT_L
#undef PG8_BAR
#undef PG8_SCHED
}
}
namespace {
constexpr int D = 1024, NB = 4, L = 4096, HW = 1024, SW = 1024, INW = 7168, FH = 2816, FHID = 64, FEMB = 33;
constexpr float EPS = 1e-6f;
typedef unsigned short bf16;
__device__ __forceinline__ unsigned f2bf(float f) { unsigned u = __builtin_bit_cast(unsigned, f); return (u + 0x7fffu + ((u >> 16) & 1u)) >> 16; }
}
namespace {
#define HD __device__ __forceinline__
#define FFT_OPAQUE(w) asm volatile("" : "+v"(w))
#ifndef HD
#define HD inline
#endif
typedef float cf __attribute__((ext_vector_type(2)));
HD cf cmk(float x, float y) { return (cf){x, y}; }
HD cf cadd(cf a, cf b) { return cmk(a.x + b.x, a.y + b.y); }
HD cf csub(cf a, cf b) { return cmk(a.x - b.x, a.y - b.y); }
HD cf cmul(cf a, cf b) { return cmk(a.x * b.x - a.y * b.y, a.x * b.y + a.y * b.x); }
HD cf cconj(cf a) { return cmk(a.x, -a.y); }
template <bool INV> HD cf mulmi(cf a) { return INV ? cmk(-a.y, a.x) : cmk(a.y, -a.x); }
template <bool INV> HD cf twc(float c, float s) { return INV ? cmk(c, s) : cmk(c, -s); }
HD int fpad(int p) { return p + (p >> 4); }
constexpr int FSUB = 4352;

template <bool INV> HD void dft4(cf& a, cf& b, cf& c, cf& d) {
    const cf t0 = cadd(a, c), t1 = csub(a, c), t2 = cadd(b, d), t3 = mulmi<INV>(csub(b, d));
    a = cadd(t0, t2); b = cadd(t1, t3); c = csub(t0, t2); d = csub(t1, t3);
}
template <bool INV> HD void dft16(cf (&v)[16]) {
    constexpr float C1 = 0.92387953251128674f, S1 = 0.38268343236508977f, R = 0.70710678118654752f;
#pragma unroll
    for (int n0 = 0; n0 < 4; ++n0) dft4<INV>(v[n0], v[n0 + 4], v[n0 + 8], v[n0 + 12]);
    v[1 + 4 * 1] = cmul(v[1 + 4 * 1], twc<INV>(C1, S1));
    v[1 + 4 * 2] = cmul(v[1 + 4 * 2], twc<INV>(R, R));
    v[1 + 4 * 3] = cmul(v[1 + 4 * 3], twc<INV>(S1, C1));
    v[2 + 4 * 1] = cmul(v[2 + 4 * 1], twc<INV>(R, R));
    v[2 + 4 * 2] = mulmi<INV>(v[2 + 4 * 2]);
    v[2 + 4 * 3] = cmul(v[2 + 4 * 3], twc<INV>(-R, R));
    v[3 + 4 * 1] = cmul(v[3 + 4 * 1], twc<INV>(S1, C1));
    v[3 + 4 * 2] = cmul(v[3 + 4 * 2], twc<INV>(-R, R));
    v[3 + 4 * 3] = cmul(v[3 + 4 * 3], twc<INV>(-C1, -S1));
#pragma unroll
    for (int k0 = 0; k0 < 4; ++k0) dft4<INV>(v[4 * k0], v[4 * k0 + 1], v[4 * k0 + 2], v[4 * k0 + 3]);
    cf t;
    t = v[1]; v[1] = v[4]; v[4] = t;   t = v[2]; v[2] = v[8]; v[8] = t;   t = v[3]; v[3] = v[12]; v[12] = t;
    t = v[6]; v[6] = v[9]; v[9] = t;   t = v[7]; v[7] = v[13]; v[13] = t; t = v[11]; v[11] = v[14]; v[14] = t;
}
#ifndef FFT_OPAQUE
#define FFT_OPAQUE(w)
#endif
HD void twiddle16(cf (&v)[16], cf w) {
    FFT_OPAQUE(w);
    cf p = w;
#pragma unroll
    for (int k = 1; k < 16; ++k) { v[k] = cmul(v[k], p); if (k < 15) p = cmul(p, w); }
}
template <class P> HD void fwd_pass1(P Z, int t, cf w1) {
    cf v[16]; const int b = t + (t >> 4);
#pragma unroll
    for (int j = 0; j < 16; ++j) v[j] = Z[b + 272 * j];
    dft16<false>(v); twiddle16(v, w1);
#pragma unroll
    for (int j = 0; j < 16; ++j) Z[b + 272 * j] = v[j];
}
template <class P> HD void fwd_pass2(P Z, int t, cf w2) {
    const int b = 272 * (t >> 4) + (t & 15);
    cf v[16];
#pragma unroll
    for (int j = 0; j < 16; ++j) v[j] = Z[b + 17 * j];
    dft16<false>(v); twiddle16(v, w2);
#pragma unroll
    for (int j = 0; j < 16; ++j) Z[b + 17 * j] = v[j];
}
template <class P> HD void fwd_pass3_load(P Z, int t, cf (&v)[16]) {
#pragma unroll
    for (int j = 0; j < 16; ++j) v[j] = Z[17 * t + j];
    dft16<false>(v);
}
template <class P> HD void inv_pass1_store(P Z, int t, cf (&v)[16]) {
    dft16<true>(v);
#pragma unroll
    for (int j = 0; j < 16; ++j) Z[17 * t + j] = v[j];
}
template <class P> HD void inv_pass2(P Z, int t, cf w2) {
    const int b = 272 * (t >> 4) + (t & 15);
    cf v[16];
#pragma unroll
    for (int j = 0; j < 16; ++j) v[j] = Z[b + 17 * j];
    twiddle16(v, cconj(w2)); dft16<true>(v);
#pragma unroll
    for (int j = 0; j < 16; ++j) Z[b + 17 * j] = v[j];
}
template <class P> HD void inv_pass3(P Z, int t, cf w1) {
    cf v[16]; const int b = t + (t >> 4);
#pragma unroll
    for (int j = 0; j < 16; ++j) v[j] = Z[b + 272 * j];
    twiddle16(v, cconj(w1)); dft16<true>(v);
#pragma unroll
    for (int j = 0; j < 16; ++j) Z[b + 272 * j] = v[j];
}
#define LAS __attribute__((address_space(3)))
typedef LAS cf* lcf;
struct HyArgs {
    const bf16* hyT;
    bf16* yaT;
    const float* fsum;
    const float* fdif;
    const float* cw;
    const float* cb;
    const float* skip;
    const cf* T;
    int TS, npairs, off00, off01, off10, off11;
};
__device__ __forceinline__ float bf2f(unsigned h) { return __builtin_bit_cast(float, h << 16); }
__device__ __forceinline__ void conv8(const bf16* row, int n0, float w0, float w1, float w2, float b, float (&o)[8]) {
    const uint4 q = *(const uint4*)(row + n0);
    float x[10];
    x[0] = n0 > 0 ? bf2f(row[n0 - 1]) : 0.f;
    x[9] = n0 + 8 < 4096 ? bf2f(row[n0 + 8]) : 0.f;
    x[1] = bf2f(q.x & 0xffffu); x[2] = bf2f(q.x >> 16); x[3] = bf2f(q.y & 0xffffu); x[4] = bf2f(q.y >> 16);
    x[5] = bf2f(q.z & 0xffffu); x[6] = bf2f(q.z >> 16); x[7] = bf2f(q.w & 0xffffu); x[8] = bf2f(q.w >> 16);
#pragma unroll
    for (int i = 0; i < 8; ++i) o[i] = b + w0 * x[i] + w1 * x[i + 1] + w2 * x[i + 2];
}
__device__ __forceinline__ void hyena_channel(lcf Z, const HyArgs& A, int c, int tid, cf w1, cf w2, cf wp) {
    const int s = tid >> 8, t = tid & 255, n0 = 8 * tid, pb = 8 * tid + (tid >> 1);
    lcf Zs = Z + s * FSUB;
    constexpr float W8C[8] = {1.0f, 0.99999970586f, 0.99999882345f, 0.99999735277f, 0.99999529381f, 0.99999264659f, 0.99998941108f, 0.99998558731f};
    constexpr float W8S[8] = {0.0f, 0.00076699031874f, 0.0015339801863f, 0.0023009691514f, 0.0030679567630f, 0.0038349425697f, 0.0046019261204f, 0.0053689069640f};
    cf tw[8];
#pragma unroll
    for (int i = 0; i < 8; ++i) tw[i] = cmul(wp, cmk(W8C[i], -W8S[i]));
    cf Kr[16];
    {
        const float4 a0 = *(const float4*)(A.fsum + (size_t)c * 4096 + n0), a1 = *(const float4*)(A.fsum + (size_t)c * 4096 + n0 + 4);
        const float4 d0 = *(const float4*)(A.fdif + (size_t)c * 4096 + n0), d1 = *(const float4*)(A.fdif + (size_t)c * 4096 + n0 + 4);
        const float fs[8] = {a0.x, a0.y, a0.z, a0.w, a1.x, a1.y, a1.z, a1.w}, fd[8] = {d0.x, d0.y, d0.z, d0.w, d1.x, d1.y, d1.z, d1.w};
#pragma unroll
        for (int i = 0; i < 8; ++i) { Z[pb + i] = cmk(fs[i], 0.f); Z[FSUB + pb + i] = cmk(fd[i] * tw[i].x, fd[i] * tw[i].y); }
    }
    __syncthreads();
    fwd_pass1(Zs, t, w1); __syncthreads();
    fwd_pass2(Zs, t, w2); __syncthreads();
    fwd_pass3_load(Zs, t, Kr);
#pragma unroll
    for (int j = 0; j < 16; ++j) { Kr[j].x *= (1.0f / 8192.0f); Kr[j].y *= (1.0f / 8192.0f); }
    __syncthreads();
    const float sk = A.skip[c];
    const float cx0 = A.cw[c], cx1 = A.cw[3072 + c], cx2 = A.cw[6144 + c], cxb = A.cb[c];
    const float ca0 = A.cw[1024 + c], ca1 = A.cw[3072 + 1024 + c], ca2 = A.cw[6144 + 1024 + c], cab = A.cb[1024 + c];
    const float cv0 = A.cw[2048 + c], cv1 = A.cw[3072 + 2048 + c], cv2 = A.cw[6144 + 2048 + c], cvb = A.cb[2048 + c];
    for (int p = 0; p < A.npairs; ++p) {
        const int o0 = p ? A.off10 : A.off00, o1 = p ? A.off11 : A.off01;
        float u0[8], u1[8];
        {
            float a[8], b[8];
            conv8(A.hyT + (size_t)(1024 + c) * A.TS + o0, n0, ca0, ca1, ca2, cab, a);
            conv8(A.hyT + (size_t)(2048 + c) * A.TS + o0, n0, cv0, cv1, cv2, cvb, b);
#pragma unroll
            for (int i = 0; i < 8; ++i) u0[i] = a[i] * b[i];
            conv8(A.hyT + (size_t)(1024 + c) * A.TS + o1, n0, ca0, ca1, ca2, cab, a);
            conv8(A.hyT + (size_t)(2048 + c) * A.TS + o1, n0, cv0, cv1, cv2, cvb, b);
#pragma unroll
            for (int i = 0; i < 8; ++i) u1[i] = a[i] * b[i];
        }
#pragma unroll
        for (int i = 0; i < 8; ++i) { const cf z = cmk(u0[i], u1[i]); Z[pb + i] = z; Z[FSUB + pb + i] = cmul(z, tw[i]); }
        __syncthreads();
        fwd_pass1(Zs, t, w1); __syncthreads();
        fwd_pass2(Zs, t, w2); __syncthreads();
        {
            cf v[16];
            fwd_pass3_load(Zs, t, v);
#pragma unroll
            for (int j = 0; j < 16; ++j) v[j] = cmul(v[j], Kr[j]);
            inv_pass1_store(Zs, t, v);
        }
        __syncthreads();
        inv_pass2(Zs, t, w2); __syncthreads();
        inv_pass3(Zs, t, w1); __syncthreads();
        {
            float y0[8], y1[8];
#pragma unroll
            for (int i = 0; i < 8; ++i) { const cf e = Z[pb + i], o = Z[FSUB + pb + i]; const cf y = cadd(e, cmul(o, cconj(tw[i]))); y0[i] = y.x + sk * u0[i]; y1[i] = y.y + sk * u1[i]; }
            float x0c[8];
            conv8(A.hyT + (size_t)c * A.TS + o0, n0, cx0, cx1, cx2, cxb, x0c);
            uint4 w;
            w.x = f2bf(x0c[0] * y0[0]) | (f2bf(x0c[1] * y0[1]) << 16); w.y = f2bf(x0c[2] * y0[2]) | (f2bf(x0c[3] * y0[3]) << 16);
            w.z = f2bf(x0c[4] * y0[4]) | (f2bf(x0c[5] * y0[5]) << 16); w.w = f2bf(x0c[6] * y0[6]) | (f2bf(x0c[7] * y0[7]) << 16);
            *(uint4*)(A.yaT + (size_t)c * A.TS + o0 + n0) = w;
            if (o1 != o0) {
                conv8(A.hyT + (size_t)c * A.TS + o1, n0, cx0, cx1, cx2, cxb, x0c);
                w.x = f2bf(x0c[0] * y1[0]) | (f2bf(x0c[1] * y1[1]) << 16); w.y = f2bf(x0c[2] * y1[2]) | (f2bf(x0c[3] * y1[3]) << 16);
                w.z = f2bf(x0c[4] * y1[4]) | (f2bf(x0c[5] * y1[5]) << 16); w.w = f2bf(x0c[6] * y1[6]) | (f2bf(x0c[7] * y1[7]) << 16);
                *(uint4*)(A.yaT + (size_t)c * A.TS + o1 + n0) = w;
            }
        }
        __syncthreads();
    }
}
__device__ __forceinline__ void hyena_phase(lcf Z, const HyArgs& A, int first, int stride, const int tid) {
    const int t = tid & 255;
    const cf w1 = A.T[2 * t], w2 = A.T[32 * (t & 15)], wp = A.T[8 * tid];
    for (int c = first; c < 1024; c += stride) hyena_channel(Z, A, c, tid, w1, w2, wp);
}

}
namespace pg8 {
__device__ __forceinline__ f32x2 sigmoid_pk(f32x2 v) {
    f32x2 e; e.x = __builtin_amdgcn_exp2f(v.x * -1.4426950408889634f); e.y = __builtin_amdgcn_exp2f(v.y * -1.4426950408889634f);
    f32x2 o; o.x = __builtin_amdgcn_rcpf(1.0f + e.x); o.y = __builtin_amdgcn_rcpf(1.0f + e.y); return o;
}
struct EpiHyT {
    static constexpr bool PERM = true, AFTER_DRAIN = false, MID = false;
    bf16_t* O; int ldc; float* vss;
    __device__ __forceinline__ void operator()(const f32x4 (&acc)[2][2][4][2], const Unit& u, int wr, int wc, int fr, int fq) const {
        const int row0 = u.pm * BM + wr * 64 + fr, col0 = u.pn * BM + wc * 32 + 8 * fq;
        const bool isv = u.pm >= 12;
        f32x4 ss[2][2];
#pragma unroll
        for (int bj = 0; bj < 2; ++bj)
#pragma unroll
            for (int n = 0; n < 2; ++n) ss[bj][n] = (f32x4){0.f, 0.f, 0.f, 0.f};
#pragma unroll
        for (int ai = 0; ai < 2; ++ai)
#pragma unroll
            for (int m = 0; m < 4; ++m) { bf16_t* rowp = O + (size_t)(row0 + ai * HALF + m * 16) * ldc + col0;
#pragma unroll
                for (int bj = 0; bj < 2; ++bj) { f32x4 v0 = acc[ai][bj][m][0], v1 = acc[ai][bj][m][1];
                    if (isv) { f32x2 a = gelu_pk((f32x2){v0[0], v0[1]}), b = gelu_pk((f32x2){v0[2], v0[3]}), c = gelu_pk((f32x2){v1[0], v1[1]}), d = gelu_pk((f32x2){v1[2], v1[3]});
                        v0 = (f32x4){a.x, a.y, b.x, b.y}; v1 = (f32x4){c.x, c.y, d.x, d.y}; ss[bj][0] += v0 * v0; ss[bj][1] += v1 * v1; }
                    u32x4 w; w.x = cvt_pk_bf16(v0[0], v0[1]); w.y = cvt_pk_bf16(v0[2], v0[3]); w.z = cvt_pk_bf16(v1[0], v1[1]); w.w = cvt_pk_bf16(v1[2], v1[3]);
                    *(u32x4*)(rowp + bj * HALF) = w; } }
        if (isv) {
#pragma unroll
            for (int bj = 0; bj < 2; ++bj)
#pragma unroll
                for (int n = 0; n < 2; ++n)
#pragma unroll
                    for (int j = 0; j < 4; ++j) { float s = ss[bj][n][j]; s += __shfl_xor(s, 1); s += __shfl_xor(s, 2); s += __shfl_xor(s, 4); s += __shfl_xor(s, 8);
                        if (fr == 0) atomicAdd(vss + col0 + bj * HALF + 4 * n + j, s); }
        }
    }
};
struct EpiUG {
    static constexpr bool PERM = true, AFTER_DRAIN = false, MID = false;
    bf16_t* U; bf16_t* G; int ldu;
    __device__ __forceinline__ void operator()(const f32x4 (&acc)[2][2][4][2], const Unit& u, int wr, int wc, int fr, int fq) const {
        const int row0 = u.pm * BM + wr * 64 + fr; int colt = u.pn * BM; const bool isu = colt < 1024;
        bf16_t* base = isu ? U : G; const int ldc = isu ? ldu : 2048; if (!isu) colt -= 1024;
        const int col0 = colt + wc * 32 + 8 * fq;
#pragma unroll
        for (int ai = 0; ai < 2; ++ai)
#pragma unroll
            for (int m = 0; m < 4; ++m) { bf16_t* rowp = base + (size_t)(row0 + ai * HALF + m * 16) * ldc + col0;
#pragma unroll
                for (int bj = 0; bj < 2; ++bj) { f32x4 v0 = acc[ai][bj][m][0], v1 = acc[ai][bj][m][1];
                    f32x2 a, b, c, d;
                    if (isu) { a = gelu_pk((f32x2){v0[0], v0[1]}); b = gelu_pk((f32x2){v0[2], v0[3]}); c = gelu_pk((f32x2){v1[0], v1[1]}); d = gelu_pk((f32x2){v1[2], v1[3]}); }
                    else { a = sigmoid_pk((f32x2){v0[0], v0[1]}); b = sigmoid_pk((f32x2){v0[2], v0[3]}); c = sigmoid_pk((f32x2){v1[0], v1[1]}); d = sigmoid_pk((f32x2){v1[2], v1[3]}); }
                    u32x4 w; w.x = cvt_pk_bf16(a.x, a.y); w.y = cvt_pk_bf16(b.x, b.y); w.z = cvt_pk_bf16(c.x, c.y); w.w = cvt_pk_bf16(d.x, d.y);
                    *(u32x4*)(rowp + bj * HALF) = w; } }
    }
};
}
namespace {
struct WJob { const float* W; const float* g; bf16* dst; int K, N, c0, nc, ldd, r0, koff, pad; };
constexpr int NWJ = 9;
struct WJobs { WJob j[NWJ]; };
__device__ __forceinline__ unsigned pk2(float lo, float hi) { return f2bf(lo) | (f2bf(hi) << 16); }
__device__ __forceinline__ void wT_item(const WJob& J, LAS float* scr, int item, int lane) {
    const int nblk = J.nc / 32, kb = item / nblk, nb = item % nblk, k0 = 64 * kb, n0 = 32 * nb;
#pragma unroll 8
    for (int i = 0; i < 32; ++i) { const int kk = 2 * i + (lane >> 5); float v = J.W[(size_t)(k0 + kk) * J.N + J.c0 + n0 + (lane & 31)]; if (J.g) v *= J.g[k0 + kk]; scr[kk * 33 + (lane & 31)] = v; }
    asm volatile("s_waitcnt lgkmcnt(0)" ::: "memory");
    const int c = lane & 7;
#pragma unroll
    for (int j = 0; j < 4; ++j) { const int n = (lane >> 3) + 8 * j; const LAS float* s = scr + (8 * c) * 33 + n;
        uint4 o; o.x = pk2(s[0 * 33], s[1 * 33]); o.y = pk2(s[2 * 33], s[3 * 33]); o.z = pk2(s[4 * 33], s[5 * 33]); o.w = pk2(s[6 * 33], s[7 * 33]);
        *(uint4*)(J.dst + (size_t)(J.r0 + n0 + n) * J.ldd + J.koff + k0 + 8 * c) = o; }
    asm volatile("s_waitcnt lgkmcnt(0)" ::: "memory");
}
__device__ __forceinline__ void p0_weights(const WJobs& WJ, int jlo, int jhi, LAS float* scr, int gw, int NGW, int lane) {
    int base = 0;
    for (int q = jlo; q < jhi; ++q) {
        const WJob& J = WJ.j[q]; const int ni = (J.K / 64) * (J.nc / 32);
        int it = gw - (base % NGW); if (it < 0) it += NGW;
        for (; it < ni; it += NGW) wT_item(J, scr, it, lane);
        base += ni;
    }
}
__device__ __forceinline__ float wave_sum(float v) {
#pragma unroll
    for (int o = 1; o < 64; o <<= 1) v += __shfl_xor(v, o);
    return v;
}
__device__ __forceinline__ void rms_row_to_bf16(const float* xrow, const float* g, bf16* orow, int lane) {
    const float4* xr = (const float4*)xrow + lane; const float4* gr = (const float4*)g + lane;
    float4 v[4]; float s = 0.f;
#pragma unroll
    for (int j = 0; j < 4; ++j) { v[j] = xr[64 * j]; s += (v[j].x * v[j].x + v[j].y * v[j].y) + (v[j].z * v[j].z + v[j].w * v[j].w); }
    const float r = rsqrtf(wave_sum(s) * (1.f / 1024.f) + EPS);
    unsigned long long* o8 = (unsigned long long*)orow + lane;
#pragma unroll
    for (int j = 0; j < 4; ++j) { const float4 gg = gr[64 * j];
        o8[64 * j] = (unsigned long long)pk2(v[j].x * r * gg.x, v[j].y * r * gg.y) | ((unsigned long long)pk2(v[j].z * r * gg.z, v[j].w * r * gg.w) << 32); }
}
}

namespace {
struct SguArgs {
    const bf16* vT;
    bf16* U;
    const float* vss;
    const float* ws;
    const float* bs;
    const float* gn;
    int TS, ldu;
};
typedef short bf16x8_t __attribute__((ext_vector_type(8)));
typedef float f32x4_t __attribute__((ext_vector_type(4)));
__device__ __forceinline__ void sgu_item(LAS unsigned char* lds, const SguArgs& A, int item, int tid) {
    const int g = item & 7, ch = item >> 3, tok0 = ch * 128;
    const int wave = tid >> 6, lane = tid & 63, fr = lane & 15, fq = lane >> 4;
#pragma unroll
    for (int j = 0; j < 4; ++j) { const int idx = tid + 512 * j, d = idx >> 4, chunk = idx & 15;
        const pg8::u32x4 v = *(const pg8::u32x4*)(A.vT + (size_t)(g * 128 + d) * A.TS + tok0 + chunk * 8);
        *(LAS pg8::u32x4*)(lds + d * 272 + chunk * 16) = v; }
    bf16x8_t af[4];
    const int p = 16 * wave + fr;
#pragma unroll
    for (int kk = 0; kk < 4; ++kk) { const int q = 32 * kk + 8 * fq;
        const float4 w0 = *(const float4*)(A.ws + ((size_t)g * 128 + p) * 128 + q), w1 = *(const float4*)(A.ws + ((size_t)g * 128 + p) * 128 + q + 4);
        const float4 s0 = *(const float4*)(A.vss + tok0 + q), s1 = *(const float4*)(A.vss + tok0 + q + 4);
        const float r0 = rsqrtf(s0.x * (1.f / 1024.f) + EPS), r1 = rsqrtf(s0.y * (1.f / 1024.f) + EPS), r2 = rsqrtf(s0.z * (1.f / 1024.f) + EPS), r3 = rsqrtf(s0.w * (1.f / 1024.f) + EPS);
        const float r4 = rsqrtf(s1.x * (1.f / 1024.f) + EPS), r5 = rsqrtf(s1.y * (1.f / 1024.f) + EPS), r6 = rsqrtf(s1.z * (1.f / 1024.f) + EPS), r7 = rsqrtf(s1.w * (1.f / 1024.f) + EPS);
        uint4 o; o.x = pk2(w0.x * r0, w0.y * r1); o.y = pk2(w0.z * r2, w0.w * r3); o.z = pk2(w1.x * r4, w1.y * r5); o.w = pk2(w1.z * r6, w1.w * r7);
        af[kk] = __builtin_bit_cast(bf16x8_t, o); }
    __syncthreads();
    f32x4_t acc[8];
#pragma unroll
    for (int nt = 0; nt < 8; ++nt) acc[nt] = (f32x4_t){0.f, 0.f, 0.f, 0.f};
#pragma unroll
    for (int kk = 0; kk < 4; ++kk) {
        bf16x8_t bfr[8];
#pragma unroll
        for (int nt = 0; nt < 8; ++nt) bfr[nt] = *(const LAS bf16x8_t*)(lds + (16 * nt + fr) * 272 + (32 * kk + 8 * fq) * 2);
#pragma unroll
        for (int nt = 0; nt < 8; ++nt) acc[nt] = __builtin_amdgcn_mfma_f32_16x16x32_bf16(bfr[nt], af[kk], acc[nt], 0, 0, 0);
    }
    const float bsp = A.bs[g * 128 + p];
    bf16* urow = A.U + (size_t)(tok0 + p) * A.ldu + g * 128 + 4 * fq;
    const float* gnp = A.gn + g * 128 + 4 * fq;
#pragma unroll
    for (int nt = 0; nt < 8; ++nt) {
        const uint2 uu = *(const uint2*)(urow + 16 * nt);
        const float4 gv = *(const float4*)(gnp + 16 * nt);
        const float y0 = bf2f(uu.x & 0xffffu) * (gv.x * acc[nt][0] + bsp), y1 = bf2f(uu.x >> 16) * (gv.y * acc[nt][1] + bsp);
        const float y2 = bf2f(uu.y & 0xffffu) * (gv.z * acc[nt][2] + bsp), y3 = bf2f(uu.y >> 16) * (gv.w * acc[nt][3] + bsp);
        uint2 o; o.x = pk2(y0, y1); o.y = pk2(y2, y3);
        *(uint2*)(urow + 16 * nt) = o;
    }
    __syncthreads();
}
}

namespace pg8 {
__device__ __forceinline__ void bf8_to_f32(const u32x4 q, f32x4& lo, f32x4& hi) {
    lo = (f32x4){__builtin_bit_cast(float, q.x << 16), __builtin_bit_cast(float, q.x & 0xffff0000u), __builtin_bit_cast(float, q.y << 16), __builtin_bit_cast(float, q.y & 0xffff0000u)};
    hi = (f32x4){__builtin_bit_cast(float, q.z << 16), __builtin_bit_cast(float, q.z & 0xffff0000u), __builtin_bit_cast(float, q.w << 16), __builtin_bit_cast(float, q.w & 0xffff0000u)};
}
struct EpiMerge {
    static constexpr bool PERM = true, AFTER_DRAIN = false, MID = true;
    const bf16_t* G; bf16_t* O;
    __device__ __forceinline__ void mid(f32x4 (&acc)[2][2][4][2], const Unit& u, int wr, int wc, int fr, int fq) const {
        unsigned off0 = (unsigned)(u.pm * BM + wr * 64 + fr) * 2048u + (unsigned)(u.pn * BM + wc * 32 + 8 * fq);
        asm volatile("" : "+v"(off0));
#pragma unroll
        for (int ai = 0; ai < 2; ++ai)
#pragma unroll
            for (int m = 0; m < 4; ++m)
#pragma unroll
                for (int bj = 0; bj < 2; ++bj) { const bf16_t* gp = G + (off0 + (unsigned)((ai * HALF + m * 16) * 2048 + bj * HALF));
                    const u32x4 qa = *(const u32x4*)gp, qb = *(const u32x4*)(gp + 1024);
                    f32x4 a0, a1, b0, b1; bf8_to_f32(qa, a0, a1); bf8_to_f32(qb, b0, b1);
#pragma unroll
                    for (int j = 0; j < 4; ++j) { acc[ai][bj][m][0][j] *= a0[j] * __builtin_amdgcn_rcpf(b0[j]); acc[ai][bj][m][1][j] *= a1[j] * __builtin_amdgcn_rcpf(b1[j]); }
                    asm volatile("" ::: "memory"); }
    }
    __device__ __forceinline__ void operator()(const f32x4 (&acc)[2][2][4][2], const Unit& u, int wr, int wc, int fr, int fq) const {
        const int row0 = u.pm * BM + wr * 64 + fr, col0 = u.pn * BM + wc * 32 + 8 * fq;
#pragma unroll
        for (int ai = 0; ai < 2; ++ai)
#pragma unroll
            for (int m = 0; m < 4; ++m) { const size_t r = (size_t)(row0 + ai * HALF + m * 16);
#pragma unroll
                for (int bj = 0; bj < 2; ++bj) { f32x4 b0, b1; bf8_to_f32(*(const u32x4*)(G + r * 2048 + 1024 + col0 + bj * HALF), b0, b1);
                    const f32x4 v0 = acc[ai][bj][m][0] * b0, v1 = acc[ai][bj][m][1] * b1;
                    u32x4 w; w.x = cvt_pk_bf16(v0[0], v0[1]); w.y = cvt_pk_bf16(v0[2], v0[3]); w.z = cvt_pk_bf16(v1[0], v1[1]); w.w = cvt_pk_bf16(v1[2], v1[3]);
                    *(u32x4*)(O + r * 1024 + col0 + bj * HALF) = w; } }
    }
};
}
namespace {
__device__ __forceinline__ void tr64_item(const bf16* yaT, int TS, bf16* out, int ldo, LAS unsigned short* scr, int c0, int t0, int lane) {
#pragma unroll
    for (int i = 0; i < 8; ++i) { const int r = 8 * i + (lane >> 3), ch = lane & 7;
        const pg8::u32x4 q = *(const pg8::u32x4*)(yaT + (size_t)(c0 + r) * TS + t0 + 8 * ch);
        LAS unsigned short* d = scr + (8 * ch) * 72 + r;
        d[0 * 72] = (unsigned short)(q.x & 0xffffu); d[1 * 72] = (unsigned short)(q.x >> 16); d[2 * 72] = (unsigned short)(q.y & 0xffffu); d[3 * 72] = (unsigned short)(q.y >> 16);
        d[4 * 72] = (unsigned short)(q.z & 0xffffu); d[5 * 72] = (unsigned short)(q.z >> 16); d[6 * 72] = (unsigned short)(q.w & 0xffffu); d[7 * 72] = (unsigned short)(q.w >> 16); }
    asm volatile("s_waitcnt lgkmcnt(0)" ::: "memory");
#pragma unroll
    for (int i = 0; i < 8; ++i) { const int tk = 8 * i + (lane >> 3), ch = lane & 7;
        const pg8::u32x4 q = *(const LAS pg8::u32x4*)(scr + tk * 72 + 8 * ch);
        *(pg8::u32x4*)(out + (size_t)(t0 + tk) * ldo + c0 + 8 * ch) = q; }
    asm volatile("s_waitcnt lgkmcnt(0)" ::: "memory");
}
__device__ __forceinline__ void transpose_ya(const bf16* yaT, int TS, bf16* out, int ldo, LAS unsigned short* scr, int gw, int NGW, int lane) {
    const int ntt = TS / 64, nit = 16 * ntt;
    for (int it = gw; it < nit; it += NGW) tr64_item(yaT, TS, out, ldo, scr, 64 * (it / ntt), 64 * (it % ntt), lane);
}
}

namespace pg8 {
template <bool WITH_BF16> struct EpiResid {
    static constexpr bool PERM = false, AFTER_DRAIN = false, MID = false;
    const float* X; float* X1; bf16_t* X1b; float* xss;
    __device__ __forceinline__ void operator()(const f32x4 (&acc)[2][2][4][2], const Unit& u, int wr, int wc, int fr, int fq) const {
        const int row0 = u.pm * BM + wr * 64 + fr, col0 = u.pn * BM + wc * 32 + 4 * fq;
        typedef unsigned u32x2v __attribute__((ext_vector_type(2)));
#pragma unroll
        for (int ai = 0; ai < 2; ++ai)
#pragma unroll
            for (int m = 0; m < 4; ++m) { const size_t r = (size_t)(row0 + ai * HALF + m * 16); float s = 0.f;
#pragma unroll
                for (int bj = 0; bj < 2; ++bj)
#pragma unroll
                    for (int n = 0; n < 2; ++n) { const size_t o = r * 1024 + col0 + bj * HALF + n * 16;
                        const f32x4 v = acc[ai][bj][m][n] + *(const f32x4*)(X + o);
                        *(f32x4*)(X1 + o) = v;
                        if (WITH_BF16) { u32x2v w; w.x = cvt_pk_bf16(v[0], v[1]); w.y = cvt_pk_bf16(v[2], v[3]); *(u32x2v*)(X1b + o) = w; }
                        s += (v[0] * v[0] + v[1] * v[1]) + (v[2] * v[2] + v[3] * v[3]); }
                s += __shfl_xor(s, 16); s += __shfl_xor(s, 32);
                if (fq == 0) atomicAdd(xss + r, s);
                asm volatile("" ::: "memory"); }
    }
};
struct EpiUp {
    static constexpr bool PERM = true, AFTER_DRAIN = false, MID = false;
    bf16_t* AP; bf16_t* GP; const float* xss;
    __device__ __forceinline__ void operator()(const f32x4 (&acc)[2][2][4][2], const Unit& u, int wr, int wc, int fr, int fq) const {
        const int row0 = u.pm * BM + wr * 64 + fr; int colt = u.pn * BM; const bool isg = colt >= 2816;
        bf16_t* base = isg ? GP : AP; if (isg) colt -= 2816;
        const int col0 = colt + wc * 32 + 8 * fq;
#pragma unroll
        for (int ai = 0; ai < 2; ++ai)
#pragma unroll
            for (int m = 0; m < 4; ++m) { const size_t r = (size_t)(row0 + ai * HALF + m * 16); const float rs = rsqrtf(xss[r] * (1.0f / 1024.0f) + 1e-6f);
#pragma unroll
                for (int bj = 0; bj < 2; ++bj) { const f32x4 v0 = acc[ai][bj][m][0] * rs, v1 = acc[ai][bj][m][1] * rs;
                    u32x4 w; w.x = cvt_pk_bf16(v0[0], v0[1]); w.y = cvt_pk_bf16(v0[2], v0[3]); w.z = cvt_pk_bf16(v1[0], v1[1]); w.w = cvt_pk_bf16(v1[2], v1[3]);
                    *(u32x4*)(base + r * 2816 + col0 + bj * HALF) = w; } }
    }
};
}
namespace {
__device__ __forceinline__ void act_pass(const bf16* AP, bf16* GP, const float* cw, const float* cb, int TS, int gid, int gstride) {
    const int nitems = (TS / 32) * 352;
    for (int it = gid; it < nitems; it += gstride) {
        const int run = it / 352, ch = it % 352, t0 = run * 32, c0 = ch * 8;
        pg8::f32x4 w0l, w0h, w1l, w1h, w2l, w2h, bl, bh;
        w0l = *(const pg8::f32x4*)(cw + c0); w0h = *(const pg8::f32x4*)(cw + c0 + 4);
        w1l = *(const pg8::f32x4*)(cw + 2816 + c0); w1h = *(const pg8::f32x4*)(cw + 2816 + c0 + 4);
        w2l = *(const pg8::f32x4*)(cw + 5632 + c0); w2h = *(const pg8::f32x4*)(cw + 5632 + c0 + 4);
        bl = *(const pg8::f32x4*)(cb + c0); bh = *(const pg8::f32x4*)(cb + c0 + 4);
        pg8::f32x4 pl, ph, cl, chh, nl, nh;
        const pg8::f32x4 z4 = {0.f, 0.f, 0.f, 0.f};
        if ((t0 & 4095) != 0) pg8::bf8_to_f32(*(const pg8::u32x4*)(AP + (size_t)(t0 - 1) * 2816 + c0), pl, ph); else { pl = z4; ph = z4; }
        pg8::bf8_to_f32(*(const pg8::u32x4*)(AP + (size_t)t0 * 2816 + c0), cl, chh);
        for (int i = 0; i < 32; ++i) {
            const int t = t0 + i;
            if ((t & 4095) != 4095) pg8::bf8_to_f32(*(const pg8::u32x4*)(AP + (size_t)(t + 1) * 2816 + c0), nl, nh); else { nl = z4; nh = z4; }
            pg8::f32x4 gl, gh; pg8::bf8_to_f32(*(const pg8::u32x4*)(GP + (size_t)t * 2816 + c0), gl, gh);
            pg8::f32x4 sl = bl + w0l * pl + w1l * cl + w2l * nl, sh = bh + w0h * ph + w1h * chh + w2h * nh;
            pg8::f32x4 ol, oh;
#pragma unroll
            for (int j = 0; j < 4; ++j) { ol[j] = sl[j] * __builtin_amdgcn_rcpf(1.0f + __builtin_amdgcn_exp2f(sl[j] * -1.4426950408889634f)) * gl[j];
                                          oh[j] = sh[j] * __builtin_amdgcn_rcpf(1.0f + __builtin_amdgcn_exp2f(sh[j] * -1.4426950408889634f)) * gh[j]; }
            pg8::u32x4 w; w.x = pg8::cvt_pk_bf16(ol[0], ol[1]); w.y = pg8::cvt_pk_bf16(ol[2], ol[3]); w.z = pg8::cvt_pk_bf16(oh[0], oh[1]); w.w = pg8::cvt_pk_bf16(oh[2], oh[3]);
            *(pg8::u32x4*)(GP + (size_t)t * 2816 + c0) = w;
            pl = cl; ph = chh; cl = nl; chh = nh;
        }
    }
}
__device__ __forceinline__ void final_norm(const float* X2, const float* ss, const float* g, float* out, int TS, int gw, int NGW, int lane) {
    for (int t = gw; t < TS; t += NGW) {
        const float r = rsqrtf(ss[t] * (1.0f / 1024.0f) + EPS);
#pragma unroll
        for (int j = 0; j < 4; ++j) { const pg8::f32x4 v = *((const pg8::f32x4*)(X2 + (size_t)t * 1024) + lane + 64 * j), gg = *((const pg8::f32x4*)g + lane + 64 * j);
            *((pg8::f32x4*)(out + (size_t)t * 1024) + lane + 64 * j) = v * gg * r; }
    }
}
}

namespace {
__device__ __forceinline__ void filter_mlp_row(const float* w1, const float* b1, const float* w2, const float* b2, const float* w3, const float* b3,
                                               const float* freq, float* h3out, LAS float* scr, int l, int j) {
    LAS float* z = scr; LAS float* ha = scr + 64; LAS float* hb = scr + 128;
    if (j < FEMB) {
        float val;
        if (j == 0) val = (float)((double)l / (double)(L - 1));
        else {
            const int i = (j - 1) & 15;
            const double band = 1e-4 + (double)i * ((15.0 - 1e-4) / 15.0);
            double rev = (double)l * band / (double)L;
            rev -= floor(rev);
            const float ang = (float)(rev * 6.283185307179586);
            val = (j <= 16) ? cosf(ang) : -sinf(ang);
        }
        z[j] = val;
    }
    asm volatile("s_waitcnt lgkmcnt(0)" ::: "memory");
    const float a = freq[j];
    float s = b1[j];
#pragma unroll 1
    for (int i = 0; i < FEMB; ++i) s += z[i] * w1[i * FHID + j];
    ha[j] = sinf(a * s);
    asm volatile("s_waitcnt lgkmcnt(0)" ::: "memory");
    s = b2[j];
#pragma unroll 1
    for (int i = 0; i < FHID; ++i) s += ha[i] * w2[i * FHID + j];
    hb[j] = sinf(a * s);
    asm volatile("s_waitcnt lgkmcnt(0)" ::: "memory");
    s = b3[j];
#pragma unroll 1
    for (int i = 0; i < FHID; ++i) s += hb[i] * w3[i * FHID + j];
    h3out[l * FHID + j] = sinf(a * s);
    asm volatile("s_waitcnt lgkmcnt(0)" ::: "memory");
}
__device__ __forceinline__ void filter_tables(const float* h3, const float* w4, const float* decay, float* fsum, float* fdif, int gw, int NGW, int lane) {
    for (int it = gw; it < 2048; it += NGW) {
        const int n = (it & 63) * 64 + lane, c0 = (it >> 6) * 32, nb = n ? 4096 - n : 0;
        float sf[32], sb[32];
#pragma unroll
        for (int cc = 0; cc < 32; ++cc) { sf[cc] = 0.f; sb[cc] = 0.f; }
        for (int j = 0; j < FHID; ++j) {
            const float hn = h3[n * FHID + j], hm = h3[nb * FHID + j];
            const float* wf = w4 + j * 2048 + c0;
#pragma unroll
            for (int cc = 0; cc < 32; ++cc) { sf[cc] += hn * wf[cc]; sb[cc] += hm * wf[1024 + cc]; }
        }
        const float tf = (float)((double)n / (double)(L - 1)), tb = (float)((double)nb / (double)(L - 1));
#pragma unroll
        for (int cc = 0; cc < 32; ++cc) {
            const float hf = sf[cc] * expf(-tf * fabsf(decay[c0 + cc]));
            const float hb = n ? sb[cc] * expf(-tb * fabsf(decay[1024 + c0 + cc])) : 0.f;
            fsum[(size_t)(c0 + cc) * 4096 + n] = hf + hb;
            fdif[(size_t)(c0 + cc) * 4096 + n] = hf - hb;
        }
    }
}
#define RLX_AGENT __ATOMIC_RELAXED, __HIP_MEMORY_SCOPE_AGENT
#define XB_TMO      128
#define XB_XCNT(j)  (256  + 64 * (j))
#define XB_XSUB(j)  (1280 + 64 * (j))
#define XB_XGEN(j)  (2304 + 64 * (j))
#define XB_TOP      3328
#define XB_TOPGEN   3392
#define XCD_BAR_WORDS 3456
#define XB_SPIN_CAP (1u << 18)

__device__ __forceinline__ unsigned xb_ld(unsigned* p)              { return __hip_atomic_load(p, __ATOMIC_RELAXED, __HIP_MEMORY_SCOPE_AGENT); }
__device__ __forceinline__ unsigned xb_add(unsigned* p, unsigned v) { return __hip_atomic_fetch_add(p, v, __ATOMIC_RELAXED, __HIP_MEMORY_SCOPE_AGENT); }
__device__ __forceinline__ unsigned xb_xcc_id() { return (unsigned)__builtin_amdgcn_s_getreg((3 << 11) | 20) & 0xFu; }
#define XB_SPIN(cond, bar) do { unsigned _sp = 0; while (cond) { __builtin_amdgcn_s_sleep(1); \
    if ((++_sp & 255u) == 0u) { if (xb_ld(&(bar)[XB_TMO])) break; if (_sp > XB_SPIN_CAP) { atomicAdd(&(bar)[XB_TMO], 1u); break; } } } } while (0)

struct XcdBarrier {
    unsigned* bar; unsigned x;
    volatile LAS unsigned* st;
};

__device__ __forceinline__ XcdBarrier xcd_barrier_post(unsigned* bar, volatile LAS unsigned* st) {
    XcdBarrier b; b.bar = bar; b.x = xb_xcc_id(); b.st = st;
    if (threadIdx.x == 0) (void)xb_add(&bar[XB_XCNT(b.x)], 1u);
    return b;
}
__device__ __forceinline__ void xcd_barrier_complete(unsigned* bar, unsigned x, unsigned& nloc, unsigned& nx) {
    const unsigned G = gridDim.x * gridDim.y * gridDim.z;
    unsigned sum, cnt, mine, sp = 0u;
    for (;;) {
        sum = 0u; cnt = 0u; mine = 0u;
#pragma unroll
        for (unsigned j = 0; j < 16; ++j) { const unsigned c = xb_ld(&bar[XB_XCNT(j)]); sum += c; cnt += (c > 0u) ? 1u : 0u; mine = (j == x) ? c : mine; }
        if (sum == G) break;
        __builtin_amdgcn_s_sleep(1);
        if ((++sp & 255u) == 0u) { if (xb_ld(&bar[XB_TMO])) break; if (sp > XB_SPIN_CAP) { atomicAdd(&bar[XB_TMO], 1u); break; } }
    }
    nloc = mine > 0u ? mine : 1u; nx = cnt > 0u ? cnt : 1u;
}

__device__ __forceinline__ void xcd_barrier(const XcdBarrier& b) {
    asm volatile("s_waitcnt vmcnt(0)" ::: "memory");
    __syncthreads();
    if (threadIdx.x == 0) {
        unsigned* bar = b.bar;
        __builtin_amdgcn_s_waitcnt(0);
        unsigned nloc = b.st[0], nx = b.st[1];
        if (nloc == 0u) { xcd_barrier_complete(bar, b.x, nloc, nx); b.st[0] = nloc; b.st[1] = nx; }
        const unsigned old = xb_add(&bar[XB_XSUB(b.x)], 1u);
        const unsigned gen = old / nloc;
        if (old + 1u == (gen + 1u) * nloc) {
            __builtin_amdgcn_fence(__ATOMIC_RELEASE, "agent");
            asm volatile("s_waitcnt vmcnt(0)" ::: "memory");
            const unsigned og = xb_add(&bar[XB_TOP], 1u);
            const unsigned tg = og / nx;
            if (og + 1u == (tg + 1u) * nx) xb_add(&bar[XB_TOPGEN], 1u);
            else XB_SPIN(xb_ld(&bar[XB_TOPGEN]) == tg, bar);
            __builtin_amdgcn_fence(__ATOMIC_ACQUIRE, "agent");
            xb_add(&bar[XB_XGEN(b.x)], 1u);
            asm volatile("s_waitcnt vmcnt(0)" ::: "memory");
        } else {
            XB_SPIN(xb_ld(&bar[XB_XGEN(b.x)]) == gen, bar);
            __builtin_amdgcn_fence(__ATOMIC_ACQUIRE, "agent");
            asm volatile("s_waitcnt vmcnt(0)" ::: "memory");
        }
    }
    __syncthreads();
}

constexpr size_t MiB = 1u << 20;
constexpr int M = NB * L;
constexpr size_t WS_VSS = 0, WS_XSS = 64 * 1024, WS_X2SS = 128 * 1024, WS_TTAB = 192 * 1024, WS_BAR = 256 * 1024, WS_H3 = 1 * MiB;
constexpr size_t WS_WTA = 2 * MiB, WS_WTB = 10 * MiB, WS_PAB = 16 * MiB, WS_WO = 20 * MiB;
constexpr size_t WS_FSUM = 24 * MiB, WS_WUP = 24 * MiB, WS_WDN = 35 * MiB;
constexpr size_t WS_HYT = 41 * MiB;
constexpr size_t WS_X1B = 41 * MiB, WS_MRG = 105 * MiB;
constexpr size_t WS_YAB = 169 * MiB;
constexpr size_t WS_FDIF = 233 * MiB;
constexpr size_t WS_AP = 73 * MiB, WS_GP = 161 * MiB;
static_assert(WS_GP + (size_t)M * FH * 2 <= 256 * MiB && WS_AP + (size_t)M * FH * 2 <= WS_GP && WS_FDIF + 16 * MiB <= 256 * MiB && WS_WDN + (size_t)D * FH * 2 <= WS_HYT, "d_ws map");
constexpr int LDS_BYTES = 147456;
constexpr int NPH = 10;

struct MegaArgs { const float* in[27]; float* out; unsigned char* ws; int ph_lo, ph_hi; WJobs wj; };

__global__ void __launch_bounds__(512, 2) mega_fwd(MegaArgs a) {
    extern __shared__ __attribute__((aligned(16))) unsigned char lds_raw[];
    LAS unsigned char* lds = (LAS unsigned char*)lds_raw;
    cg::grid_group grid = cg::this_grid();
    const int wave = __builtin_amdgcn_readfirstlane((int)threadIdx.x >> 6);
    const int G = gridDim.x, bid = blockIdx.x, gw = bid * 8 + wave, NGW = G * 8;
#define FRESH_TID int lane; asm volatile("v_mbcnt_lo_u32_b32 %0, -1, 0\n\tv_mbcnt_hi_u32_b32 %0, -1, %0" : "=v"(lane)); const int tid = wave * 64 + lane; (void)tid
    unsigned char* ws = a.ws;
    const float* x = a.in[0];
    float* vss = (float*)(ws + WS_VSS); float* xss = (float*)(ws + WS_XSS); float* x2ss = (float*)(ws + WS_X2SS);
    cf* Ttab = (cf*)(ws + WS_TTAB); float* h3 = (float*)(ws + WS_H3);
    bf16* WtA = (bf16*)(ws + WS_WTA); bf16* WtB = (bf16*)(ws + WS_WTB); bf16* PabT = (bf16*)(ws + WS_PAB); bf16* WoT = (bf16*)(ws + WS_WO);
    bf16* WupT = (bf16*)(ws + WS_WUP); bf16* WdnT = (bf16*)(ws + WS_WDN);
    float* fsum = (float*)(ws + WS_FSUM); float* fdif = (float*)(ws + WS_FDIF);
    bf16* hyvT = (bf16*)(ws + WS_HYT); bf16* yaT = hyvT + (size_t)1024 * M; bf16* vT = hyvT + (size_t)3072 * M;
    bf16* YAB = (bf16*)(ws + WS_YAB); bf16* h1 = YAB; bf16* Ub = YAB + 1024;
    bf16* Gb = (bf16*)a.out;
    bf16* mrg = (bf16*)(ws + WS_MRG); bf16* X1b = (bf16*)(ws + WS_X1B); float* X1 = a.out;
    bf16* APb = (bf16*)(ws + WS_AP); bf16* GPb = (bf16*)(ws + WS_GP);
    const int lo = a.ph_lo, hi = a.ph_hi;
#define IN(k) (lo <= (k) && (k) < hi)
    for (int u = (int)threadIdx.x; u < 16; u += 512) ((LAS unsigned*)(lds + 131072 + 1024))[u] = 0u;
    __syncthreads();
    XcdBarrier xbar = xcd_barrier_post((unsigned*)(ws + WS_BAR), (volatile LAS unsigned*)(lds + 131072 + 1024));
#define SEAM(k) do { if (IN(k) && IN((k) + 1)) { if ((k) == 0) grid.sync(); else xcd_barrier(xbar); } } while (0)

    if (IN(0)) { FRESH_TID;
        p0_weights(a.wj, 0, 7, (LAS float*)lds + wave * 4096, gw, NGW, lane);
        for (int m = gw; m < M; m += NGW) rms_row_to_bf16(x + (size_t)m * 1024, a.in[1], h1 + (size_t)m * 2048, lane);
        for (int i = bid * 512 + tid; i < 3 * M; i += G * 512) vss[i] = 0.f;
        for (int l = gw; l < L; l += NGW) filter_mlp_row(a.in[5], a.in[6], a.in[7], a.in[8], a.in[9], a.in[10], a.in[11], h3, (LAS float*)lds + wave * 4096, l, lane);
        for (int m = bid * 512 + tid; m < 4096; m += G * 512) { const float ang = (float)m / 4096.0f; Ttab[m] = cmk(cospif(ang), -sinpif(ang)); }
    }
    SEAM(0);
    if (IN(1)) { FRESH_TID;
        { pg8::Gemm g{WtA, h1, 4096, M, 1024, 1024, 2048}; pg8::StaticOrder S; S.init(4096, M, G, bid);
          pg8::EpiHyT E{hyvT, M, vss};
          pg8::gemm_phase<pg8::EpiHyT, pg8::StaticOrder, true, true>(lds, g, S, E, tid); }
        { pg8::Gemm g{h1, WtB, M, 3072, 1024, 2048, 1024}; pg8::StaticOrder S; S.init(M, 3072, G, bid);
          pg8::EpiUG E{Ub, Gb, 2048};
          pg8::gemm_phase<pg8::EpiUG, pg8::StaticOrder, true, true>(lds, g, S, E, tid); }
        filter_tables(h3, a.in[12], a.in[13], fsum, fdif, gw, NGW, lane);
    }
    SEAM(1);
    if (IN(2)) { FRESH_TID;
        HyArgs H; H.hyT = hyvT; H.yaT = yaT; H.fsum = fsum; H.fdif = fdif; H.cw = a.in[3]; H.cb = a.in[4]; H.skip = a.in[14]; H.T = Ttab;
        H.TS = M; H.npairs = 2; H.off00 = 0; H.off01 = L; H.off10 = 2 * L; H.off11 = 3 * L;
        hyena_phase((lcf)lds, H, bid, G, tid);
        SguArgs Sg; Sg.vT = vT; Sg.U = Ub; Sg.vss = vss; Sg.ws = a.in[16]; Sg.bs = a.in[17]; Sg.gn = a.in[15]; Sg.TS = M; Sg.ldu = 2048;
        for (int it = bid; it < (M / 128) * 8; it += G) sgu_item(lds, Sg, it, tid);
    }
    SEAM(2);
    if (IN(3)) { FRESH_TID;
        transpose_ya(yaT, M, YAB, 2048, (LAS unsigned short*)lds + wave * 8192, gw, NGW, lane);
        p0_weights(a.wj, 7, 9, (LAS float*)lds + wave * 4096, gw, NGW, lane);
    }
    SEAM(3);
    if (IN(4)) { FRESH_TID;
        pg8::Gemm g{YAB, PabT, M, 1024, 2048, 2048, 2048}; pg8::StaticOrder S; S.init(M, 1024, G, bid);
        pg8::EpiMerge E{Gb, mrg};
        pg8::gemm_phase<pg8::EpiMerge, pg8::StaticOrder, true, true>(lds, g, S, E, tid);
    }
    SEAM(4);
    if (IN(5)) { FRESH_TID;
        pg8::Gemm g{mrg, WoT, M, 1024, 1024, 1024, 1024}; pg8::StaticOrder S; S.init(M, 1024, G, bid);
        pg8::EpiResid<true> E{x, X1, X1b, xss};
        pg8::gemm_phase<pg8::EpiResid<true>, pg8::StaticOrder, true, true>(lds, g, S, E, tid);
    }
    SEAM(5);
    if (IN(6)) { FRESH_TID;
        pg8::Gemm g{X1b, WupT, M, 2 * FH, 1024, 1024, 1024}; pg8::StaticOrder S; S.init(M, 2 * FH, G, bid);
        pg8::EpiUp E{APb, GPb, xss};
        pg8::gemm_phase<pg8::EpiUp, pg8::StaticOrder, true, true>(lds, g, S, E, tid);
    }
    SEAM(6);
    if (IN(7)) { FRESH_TID; act_pass(APb, GPb, a.in[23], a.in[24], M, bid * 512 + tid, G * 512); }
    SEAM(7);
    if (IN(8)) { FRESH_TID;
        pg8::Gemm g{GPb, WdnT, M, 1024, FH, FH, FH}; pg8::StaticOrder S; S.init(M, 1024, G, bid);
        pg8::EpiResid<false> E{X1, X1, nullptr, x2ss};
        pg8::gemm_phase<pg8::EpiResid<false>, pg8::StaticOrder, true, true>(lds, g, S, E, tid);
    }
    SEAM(8);
    if (IN(9)) { FRESH_TID; final_norm(X1, x2ss, a.in[26], a.out, M, gw, NGW, lane); }
#undef IN
#undef SEAM
}
}

#ifndef MK_CUTS
#define MK_CUTS 0
#endif
extern "C" void kernel_launch(void* const* d_in, const int* in_sizes, int n_in, void* d_out, int out_size, void* d_ws, size_t ws_size, hipStream_t stream) {
    static int grid = 0;
    if (grid == 0) {
        int dev = 0, cus = 0, per_cu = 0;
        hipGetDevice(&dev);
        hipDeviceGetAttribute(&cus, hipDeviceAttributeMultiprocessorCount, dev);
        hipFuncSetAttribute((const void*)mega_fwd, hipFuncAttributeMaxDynamicSharedMemorySize, LDS_BYTES);
        hipOccupancyMaxActiveBlocksPerMultiprocessor(&per_cu, (const void*)mega_fwd, 512, LDS_BYTES);
        if (per_cu < 1) { fprintf(stderr, "kernel_launch: occupancy query says %d blocks per CU\n", per_cu); per_cu = 1; }
        grid = cus * 1;
        (void)hipGetLastError();
    }
    hipMemsetAsync((char*)d_ws + WS_BAR, 0, XCD_BAR_WORDS * 4, stream);
    MegaArgs a{};
    for (int i = 0; i < 27; ++i) a.in[i] = (const float*)d_in[i];
    a.out = (float*)d_out; a.ws = (unsigned char*)d_ws;
    { unsigned char* ws = (unsigned char*)d_ws;
      bf16* WtA = (bf16*)(ws + WS_WTA); bf16* WtB = (bf16*)(ws + WS_WTB); bf16* PabT = (bf16*)(ws + WS_PAB); bf16* WoT = (bf16*)(ws + WS_WO); bf16* WupT = (bf16*)(ws + WS_WUP); bf16* WdnT = (bf16*)(ws + WS_WDN);
    a.wj.j[0] = WJob{(const float*)d_in[2], nullptr, WtA, 1024, INW, 0, 3072, 1024, 0, 0, 0};
    a.wj.j[1] = WJob{(const float*)d_in[2], nullptr, WtA, 1024, INW, 4096, 1024, 1024, 3072, 0, 0};
    a.wj.j[2] = WJob{(const float*)d_in[2], nullptr, WtB, 1024, INW, 3072, 1024, 1024, 0, 0, 0};
    a.wj.j[3] = WJob{(const float*)d_in[2], nullptr, WtB, 1024, INW, 5120, 2048, 1024, 1024, 0, 0};
    a.wj.j[4] = WJob{(const float*)d_in[18], nullptr, PabT, 1024, 1024, 0, 1024, 2048, 0, 0, 0};
    a.wj.j[5] = WJob{(const float*)d_in[19], nullptr, PabT, 1024, 1024, 0, 1024, 2048, 0, 1024, 0};
    a.wj.j[6] = WJob{(const float*)d_in[20], nullptr, WoT, 1024, 1024, 0, 1024, 1024, 0, 0, 0};
    a.wj.j[7] = WJob{(const float*)d_in[22], (const float*)d_in[21], WupT, 1024, 2 * FH, 0, 2 * FH, 1024, 0, 0, 0};
    a.wj.j[8] = WJob{(const float*)d_in[25], nullptr, WdnT, FH, 1024, 0, 1024, FH, 0, 0, 0};

    }
#if MK_CUTS
    for (int p = 0; p < NPH; ++p) { a.ph_lo = p; a.ph_hi = p + 1; hipLaunchKernelGGL(mega_fwd, dim3(grid), dim3(512), LDS_BYTES, stream, a); }
#else
    a.ph_lo = 0; a.ph_hi = NPH;
    void* args[] = {&a};
    hipError_t e = hipLaunchCooperativeKernel((const void*)mega_fwd, dim3(grid), dim3(512), args, LDS_BYTES, stream);
    if (e != hipSuccess) fprintf(stderr, "cooperative launch failed: %s (grid %d)\n", hipGetErrorString(e), grid);
#endif
}
```

```cpp
#include <hip/hip_runtime.h>
#include <hip/hip_cooperative_groups.h>
#include <math.h>
#include <stdint.h>
#include <cstdio>
namespace cg = cooperative_groups;
namespace pg8 {
#define PG8_LAS __attribute__((address_space(3)))
typedef unsigned short bf16_t;
typedef short bf16x8 __attribute__((ext_vector_type(8)));
typedef float f32x4 __attribute__((ext_vector_type(4)));
typedef unsigned u32x4 __attribute__((ext_vector_type(4)));
constexpr int BM = 256, BK = 64, HALF = 128, HTB = HALF * BK * 2  , STAGE_BYTES = 8 * HTB, NXCD = 8, WGM = 8;

__host__ __device__ __forceinline__ int lds_byte(int r, int c) { const int st = (r >> 4) * 2 + (c >> 5), rr = r & 15, cc = c & 31, ob = rr * 64 + cc * 2; return st * 1024 + (ob ^ (((ob >> 9) & 1) << 5)); }
__host__ __device__ __forceinline__ void stage_rc(int b, int& R, int& C) { const int st = b / 1024, sb = b % 1024, swz = sb ^ (((sb >> 9) & 1) << 5); R = (st >> 1) * 16 + swz / 64; C = (st & 1) * 32 + (swz % 64) / 2; }
__host__ __device__ __forceinline__ int perm32(int rho) { const int n = rho >> 4, i = rho & 15; return 8 * (i >> 2) + 4 * n + (i & 3); }

struct Unit { int pm, pn; };
struct Gemm { const bf16_t* A; const bf16_t* Bt; int M, N, K, lda, ldb; };

struct StaticOrder {
    int nM, nN, nwg, G, c;
    __host__ __device__ void init(int M, int N, int G_, int c_) { nM = M / BM; nN = N / BM; nwg = nM * nN; G = G_; c = c_; }
    __host__ __device__ bool next(int i, Unit& u) const {
        const long L = (long)i * G + c; if (L >= nwg) return false;
        int wgid = (int)L; { const int q = nwg / NXCD, r = nwg % NXCD, xcd = wgid % NXCD, off = wgid / NXCD; wgid = (xcd < r ? xcd * (q + 1) : r * (q + 1) + (xcd - r) * q) + off; }
        const int nig = WGM * nN, gid = wgid / nig, fm = gid * WGM, gsz = (nM - fm) < WGM ? (nM - fm) : WGM;
        u.pm = fm + ((wgid % nig) % gsz); u.pn = (wgid % nig) / gsz; return true;
    }
    __device__ __forceinline__ void a_ready(const Unit&) const {}
    __device__ __forceinline__ void done(const Unit&) const {}
};

__device__ __forceinline__ unsigned cvt_pk_bf16(float lo, float hi) { unsigned r; asm volatile("v_cvt_pk_bf16_f32 %0, %1, %2" : "=v"(r) : "v"(lo), "v"(hi)); return r; }
typedef float f32x2 __attribute__((ext_vector_type(2)));
__device__ __forceinline__ f32x2 gelu_pk(f32x2 v) {
    const f32x2 av = __builtin_elementwise_abs(v), d = av * 0.2316418882f + 1.0f;
    f32x2 t; t.x = __builtin_amdgcn_rcpf(d.x); t.y = __builtin_amdgcn_rcpf(d.y);
    f32x2 q = t * 0.5307027145f + (-0.7265760135f); q = q * t + 0.7107068705f; q = q * t + (-0.142248368f); q = q * t + 0.127414796f; q = q * t;
    const f32x2 s = (v * v) * (-0.72134752044f);
    f32x2 e; e.x = __builtin_amdgcn_exp2f(s.x); e.y = __builtin_amdgcn_exp2f(s.y);
    const f32x2 m = v * (q * e), r = v - m;
    f32x2 o; o.x = v.x < 0.f ? m.x : r.x; o.y = v.y < 0.f ? m.y : r.y; return o;
}

template <int ACT  > struct EpiBf16 {
    static constexpr bool PERM = true, AFTER_DRAIN = false, MID = false; static_assert(ACT == 0 || ACT == 1, "EpiBf16: ACT is 0 (none) or 1 (gelu_pk)");
    bf16_t* O; int ldc; const float* bias; int split_cols; size_t split_stride; float scale0;
    __device__ __forceinline__ void operator()(const f32x4 (&acc)[2][2][4][2], const Unit& u, int wr, int wc, int fr, int fq) const {
        const int row0 = u.pm * BM + wr * 64 + fr; int colt = u.pn * BM; bf16_t* base = O;
        float sc = 1.f; if (split_cols) { const int t = colt / split_cols; base += (size_t)t * split_stride; colt -= t * split_cols; if (t == 0) sc = scale0; }
        const int col0 = colt + wc * 32 + 8 * fq, bcol0 = u.pn * BM + wc * 32 + 8 * fq;
        f32x4 bv[2][2];
#pragma unroll
        for (int bj = 0; bj < 2; ++bj)
#pragma unroll
            for (int n = 0; n < 2; ++n) bv[bj][n] = bias ? *(const f32x4*)(bias + bcol0 + bj * HALF + 4 * n) : (f32x4){0.f, 0.f, 0.f, 0.f};
#pragma unroll
        for (int ai = 0; ai < 2; ++ai)
#pragma unroll
            for (int m = 0; m < 4; ++m) { bf16_t* rowp = base + (size_t)(row0 + ai * HALF + m * 16) * ldc + col0;
#pragma unroll
                for (int bj = 0; bj < 2; ++bj) { f32x4 v0 = acc[ai][bj][m][0] + bv[bj][0], v1 = acc[ai][bj][m][1] + bv[bj][1];
                    if (ACT == 1) { f32x2 a = gelu_pk((f32x2){v0[0], v0[1]}), b = gelu_pk((f32x2){v0[2], v0[3]}), c = gelu_pk((f32x2){v1[0], v1[1]}), d = gelu_pk((f32x2){v1[2], v1[3]});
                        v0 = (f32x4){a.x, a.y, b.x, b.y}; v1 = (f32x4){c.x, c.y, d.x, d.y}; }
                    v0 = v0 * sc; v1 = v1 * sc; u32x4 w; w.x = cvt_pk_bf16(v0[0], v0[1]); w.y = cvt_pk_bf16(v0[2], v0[3]); w.z = cvt_pk_bf16(v1[0], v1[1]); w.w = cvt_pk_bf16(v1[2], v1[3]);
                    *(u32x4*)(rowp + bj * HALF) = w; } }
    }
};

struct EpiF32 {
    static constexpr bool PERM = false, AFTER_DRAIN = false, MID = false;
    float* C; int ldc; const float* bias;
    __device__ __forceinline__ void operator()(const f32x4 (&acc)[2][2][4][2], const Unit& u, int wr, int wc, int fr, int fq) const {
        const int row0 = u.pm * BM + wr * 64 + fr, col0 = u.pn * BM + wc * 32 + 4 * fq;
        f32x4 bv[2][2];
#pragma unroll
        for (int bj = 0; bj < 2; ++bj)
#pragma unroll
            for (int n = 0; n < 2; ++n) bv[bj][n] = bias ? *(const f32x4*)(bias + col0 + bj * HALF + n * 16) : (f32x4){0.f, 0.f, 0.f, 0.f};
#pragma unroll
        for (int ai = 0; ai < 2; ++ai)
#pragma unroll
            for (int m = 0; m < 4; ++m) { float* rowp = C + (size_t)(row0 + ai * HALF + m * 16) * ldc + col0;
#pragma unroll
                for (int bj = 0; bj < 2; ++bj)
#pragma unroll
                    for (int n = 0; n < 2; ++n) *(f32x4*)(rowp + bj * HALF + n * 16) = acc[ai][bj][m][n] + bv[bj][n]; }
    }
};

template <class Epi, class Sched, bool ALIGN_EPI = false, bool SP2 = false>
__device__ __forceinline__ void gemm_phase(PG8_LAS unsigned char* lds, const Gemm g, const Sched& S, const Epi& E, const int tid) {
    const int wid = __builtin_amdgcn_readfirstlane(tid >> 6), lane = tid & 63, wr = wid >> 2, wc = wid & 3, fr = lane & 15, fq = lane >> 4;
    const int K = g.K, nt = K / BK;
    unsigned voffA[2], voffB[2];
#pragma unroll
    for (int i = 0; i < 2; ++i) { int R, C; stage_rc(tid * 16 + i * 8192, R, C); const int Rb = Epi::PERM ? ((R & ~31) + perm32(R & 31)) : R;
        voffA[i] = (unsigned)(R * g.lda + C) * 2u; voffB[i] = (unsigned)(Rb * g.ldb + C) * 2u; }
    const size_t kstep = (size_t)(BK * 2);
    const size_t hstepA = (size_t)HALF * g.lda * 2, hstepB = (size_t)HALF * g.ldb * 2;
    const size_t tstepA = 2 * hstepA, tstepB = 2 * hstepB;
    const unsigned ldsw = (unsigned)wid * 1024u;
    const int aoff = lds_byte(wr * 64 + fr, fq * 8), boff = lds_byte(wc * 32 + fr, fq * 8);
#define PG8_SA(b, h) (((b) * 2 + (h)) * HTB)
#define PG8_SB(b, h) ((4 + (b) * 2 + (h)) * HTB)
#define PG8_STAGE(bufoff, gbase, voff) do { _Pragma("unroll") for (int _i = 0; _i < 2; ++_i) \
        __builtin_amdgcn_global_load_lds((const unsigned*)((const char*)(gbase) + (voff)[_i]), (PG8_LAS unsigned*)(lds + (bufoff) + ldsw + _i * 8192), 16, 0, 0); } while (0)
#define PG8_LDA(dst, b, h) do { _Pragma("unroll") for (int m = 0; m < 4; ++m) _Pragma("unroll") for (int k = 0; k < 2; ++k) dst[m][k] = *(const PG8_LAS bf16x8*)(lds + PG8_SA(b, h) + aoff + m * 2048 + k * 1024); } while (0)
#define PG8_LDB(dst, b, h) do { _Pragma("unroll") for (int n = 0; n < 2; ++n) _Pragma("unroll") for (int k = 0; k < 2; ++k) dst[n][k] = *(const PG8_LAS bf16x8*)(lds + PG8_SB(b, h) + boff + n * 2048 + k * 1024); } while (0)
#define PG8_MMA(ai, bj, At, Bt) do { __builtin_amdgcn_s_setprio(1); _Pragma("unroll") for (int m = 0; m < 4; ++m) _Pragma("unroll") for (int n = 0; n < 2; ++n) _Pragma("unroll") for (int k = 0; k < 2; ++k) \
        acc[ai][bj][m][n] = __builtin_amdgcn_mfma_f32_16x16x32_bf16(Bt[n][k], At[m][k], acc[ai][bj][m][n], 0, 0, 0); __builtin_amdgcn_s_setprio(0); } while (0)
#define PG8_WAIT_V(n) asm volatile("s_waitcnt vmcnt(" #n ")" ::: "memory")
#define PG8_WAIT_L(n) asm volatile("s_waitcnt lgkmcnt(" #n ")" ::: "memory")
#define PG8_BAR __builtin_amdgcn_s_barrier()
#define PG8_SCHED __builtin_amdgcn_sched_barrier(0)
    Unit cur, nxt; int ui = 0;
    if (!S.next(0, cur)) return;
    f32x4 acc[2][2][4][2];
#pragma unroll
    for (int a = 0; a < 2; ++a)
#pragma unroll
        for (int b = 0; b < 2; ++b)
#pragma unroll
            for (int m = 0; m < 4; ++m)
#pragma unroll
                for (int n = 0; n < 2; ++n) acc[a][b][m][n] = (f32x4){0.f, 0.f, 0.f, 0.f};
    bf16x8 At[4][2], B0[2][2], B1[2][2];
    const char* cA = (const char*)g.A + (size_t)cur.pm * tstepA; const char* cB = (const char*)g.Bt + (size_t)cur.pn * tstepB;
    S.a_ready(cur);
    if constexpr (SP2) {
        PG8_STAGE(PG8_SB(0, 0), cB, voffB); PG8_STAGE(PG8_SB(0, 1), cB + hstepB, voffB); PG8_STAGE(PG8_SA(0, 0), cA, voffA); PG8_STAGE(PG8_SA(0, 1), cA + hstepA, voffA);
        if (wr == 1) PG8_BAR;
        PG8_WAIT_V(2); PG8_BAR;
        PG8_STAGE(PG8_SB(1, 0), cB + kstep, voffB); PG8_STAGE(PG8_SA(1, 0), cA + kstep, voffA); PG8_STAGE(PG8_SB(1, 1), cB + hstepB + kstep, voffB);
        PG8_WAIT_V(6); PG8_BAR;
    } else {
        PG8_STAGE(PG8_SB(0, 0), cB, voffB); PG8_STAGE(PG8_SA(0, 0), cA, voffA); PG8_STAGE(PG8_SB(0, 1), cB + hstepB, voffB); PG8_STAGE(PG8_SA(0, 1), cA + hstepA, voffA);
        if (wr == 1) PG8_BAR;
        PG8_WAIT_V(4); PG8_BAR;
        PG8_STAGE(PG8_SB(1, 0), cB + kstep, voffB); PG8_STAGE(PG8_SA(1, 0), cA + kstep, voffA); PG8_STAGE(PG8_SB(1, 1), cB + hstepB + kstep, voffB);
        PG8_WAIT_V(6); PG8_BAR;
    }
    for (;;) {
        const bool has_next = S.next(ui + 1, nxt);
        const char* nA = has_next ? (const char*)g.A + (size_t)nxt.pm * tstepA : cA; const char* nB = has_next ? (const char*)g.Bt + (size_t)nxt.pn * tstepB : cB;
        for (int t = 0; t < nt; t += 2) {
            const bool last = (t == nt - 2);
            const char* a1 = cA + (size_t)(t + 1) * kstep;
            const char* a2 = last ? nA : cA + (size_t)(t + 2) * kstep; const char* b2 = last ? nB : cB + (size_t)(t + 2) * kstep;
            const char* a3 = a2 + kstep; const char* b3 = b2 + kstep;
            if (last && has_next) S.a_ready(nxt);
            if constexpr (Epi::MID) { if (t == (nt >> 1)) E.mid(acc, cur, wr, wc, fr, fq); }
            if constexpr (SP2) {
            PG8_LDB(B0, 0, 0); PG8_LDB(B1, 0, 1); PG8_SCHED; PG8_LDA(At, 0, 0); PG8_STAGE(PG8_SA(1, 1), a1 + hstepA, voffA);
            PG8_WAIT_V(8); PG8_WAIT_L(0); PG8_BAR; PG8_MMA(0, 0, At, B0); PG8_MMA(0, 1, At, B1); PG8_BAR; PG8_SCHED;
            PG8_LDA(At, 0, 1); PG8_STAGE(PG8_SB(0, 0), b2, voffB); PG8_STAGE(PG8_SB(0, 1), b2 + hstepB, voffB); PG8_STAGE(PG8_SA(0, 0), a2, voffA);
            PG8_WAIT_V(8); PG8_WAIT_L(0); PG8_BAR; PG8_MMA(1, 0, At, B0); PG8_MMA(1, 1, At, B1); PG8_BAR; PG8_SCHED;
            PG8_LDB(B0, 1, 0); PG8_LDB(B1, 1, 1); PG8_SCHED; PG8_LDA(At, 1, 0); PG8_STAGE(PG8_SA(0, 1), a2 + hstepA, voffA);
            PG8_WAIT_V(8); PG8_WAIT_L(0); PG8_BAR; PG8_MMA(0, 0, At, B0); PG8_MMA(0, 1, At, B1); PG8_BAR; PG8_SCHED;
            PG8_LDA(At, 1, 1); PG8_STAGE(PG8_SB(1, 0), b3, voffB); PG8_STAGE(PG8_SB(1, 1), b3 + hstepB, voffB); PG8_STAGE(PG8_SA(1, 0), a3, voffA);
            PG8_WAIT_V(8); PG8_WAIT_L(0); PG8_BAR; PG8_MMA(1, 0, At, B0); PG8_MMA(1, 1, At, B1); PG8_BAR; PG8_SCHED;
            } else {
            PG8_LDB(B0, 0, 0); PG8_SCHED; PG8_LDA(At, 0, 0); PG8_STAGE(PG8_SA(1, 1), a1 + hstepA, voffA);
            PG8_WAIT_L(8); PG8_BAR; PG8_WAIT_L(0); PG8_MMA(0, 0, At, B0); PG8_BAR; PG8_SCHED;
            PG8_LDB(B1, 0, 1); PG8_STAGE(PG8_SB(0, 0), b2, voffB);
            PG8_BAR; PG8_WAIT_L(0); PG8_MMA(0, 1, At, B1); PG8_BAR;
            PG8_LDA(At, 0, 1); PG8_STAGE(PG8_SA(0, 0), a2, voffA);
            PG8_BAR; PG8_WAIT_L(0); PG8_MMA(1, 0, At, B0); PG8_BAR; PG8_SCHED;
            PG8_STAGE(PG8_SB(0, 1), b2 + hstepB, voffB);
            PG8_WAIT_V(6); PG8_BAR; PG8_MMA(1, 1, At, B1); PG8_BAR;
            PG8_LDB(B0, 1, 0); PG8_SCHED; PG8_LDA(At, 1, 0); PG8_STAGE(PG8_SA(0, 1), a2 + hstepA, voffA);
            PG8_WAIT_L(8); PG8_BAR; PG8_WAIT_L(0); PG8_MMA(0, 0, At, B0); PG8_BAR; PG8_SCHED;
            PG8_LDB(B1, 1, 1); PG8_STAGE(PG8_SB(1, 0), b3, voffB);
            PG8_BAR; PG8_WAIT_L(0); PG8_MMA(0, 1, At, B1); PG8_BAR;
            PG8_LDA(At, 1, 1); PG8_STAGE(PG8_SA(1, 0), a3, voffA);
            PG8_BAR; PG8_WAIT_L(0); PG8_MMA(1, 0, At, B0); PG8_BAR; PG8_SCHED;
            PG8_STAGE(PG8_SB(1, 1), b3 + hstepB, voffB);
            PG8_WAIT_V(6); PG8_BAR; PG8_MMA(1, 1, At, B1); PG8_BAR;
            }
        }
        if constexpr (ALIGN_EPI) { if (wr == 0) PG8_BAR; }
        if constexpr (!Epi::AFTER_DRAIN) { E(acc, cur, wr, wc, fr, fq); S.done(cur); }
        if (!has_next) break;
#pragma unroll
        for (int a = 0; a < 2; ++a)
#pragma unroll
            for (int b = 0; b < 2; ++b)
#pragma unroll
                for (int m = 0; m < 4; ++m)
#pragma unroll
                    for (int n = 0; n < 2; ++n) acc[a][b][m][n] = (f32x4){0.f, 0.f, 0.f, 0.f};
        cur = nxt; cA = nA; cB = nB; ++ui;
        if constexpr (ALIGN_EPI) { if (wr == 1) PG8_BAR; }
    }
    PG8_WAIT_V(0);
    if constexpr (!ALIGN_EPI) { if (wr == 0) PG8_BAR; }
    PG8_BAR;
    if constexpr (Epi::AFTER_DRAIN) { E.fused(acc, cur, wr, wc, fr, fq, lds, wid, lane); S.done(cur); }
#undef PG8_SA
#undef PG8_SB
#undef PG8_STAGE
#undef PG8_LDA
#undef PG8_LDB
#undef PG8_MMA
#undef PG8_WAIT_V
#undef PG8_WAIT_L
#undef PG8_BAR
#undef PG8_SCHED
}
}
namespace {
constexpr int D = 1024, NB = 4, L = 4096, HW = 1024, SW = 1024, INW = 7168, FH = 2816, FHID = 64, FEMB = 33;
constexpr float EPS = 1e-6f;
typedef unsigned short bf16;
__device__ __forceinline__ unsigned f2bf(float f) { unsigned u = __builtin_bit_cast(unsigned, f); return (u + 0x7fffu + ((u >> 16) & 1u)) >> 16; }
}
namespace {
#define HD __device__ __forceinline__
#define FFT_OPAQUE(w) asm volatile("" : "+v"(w))
#ifndef HD
#define HD inline
#endif
typedef float cf __attribute__((ext_vector_type(2)));
HD cf cmk(float x, float y) { return (cf){x, y}; }
HD cf cadd(cf a, cf b) { return cmk(a.x + b.x, a.y + b.y); }
HD cf csub(cf a, cf b) { return cmk(a.x - b.x, a.y - b.y); }
HD cf cmul(cf a, cf b) { return cmk(a.x * b.x - a.y * b.y, a.x * b.y + a.y * b.x); }
HD cf cconj(cf a) { return cmk(a.x, -a.y); }
template <bool INV> HD cf mulmi(cf a) { return INV ? cmk(-a.y, a.x) : cmk(a.y, -a.x); }
template <bool INV> HD cf twc(float c, float s) { return INV ? cmk(c, s) : cmk(c, -s); }
HD int fpad(int p) { return p + (p >> 4); }
constexpr int FSUB = 4352;

template <bool INV> HD void dft4(cf& a, cf& b, cf& c, cf& d) {
    const cf t0 = cadd(a, c), t1 = csub(a, c), t2 = cadd(b, d), t3 = mulmi<INV>(csub(b, d));
    a = cadd(t0, t2); b = cadd(t1, t3); c = csub(t0, t2); d = csub(t1, t3);
}
template <bool INV> HD void dft16(cf (&v)[16]) {
    constexpr float C1 = 0.92387953251128674f, S1 = 0.38268343236508977f, R = 0.70710678118654752f;
#pragma unroll
    for (int n0 = 0; n0 < 4; ++n0) dft4<INV>(v[n0], v[n0 + 4], v[n0 + 8], v[n0 + 12]);
    v[1 + 4 * 1] = cmul(v[1 + 4 * 1], twc<INV>(C1, S1));
    v[1 + 4 * 2] = cmul(v[1 + 4 * 2], twc<INV>(R, R));
    v[1 + 4 * 3] = cmul(v[1 + 4 * 3], twc<INV>(S1, C1));
    v[2 + 4 * 1] = cmul(v[2 + 4 * 1], twc<INV>(R, R));
    v[2 + 4 * 2] = mulmi<INV>(v[2 + 4 * 2]);
    v[2 + 4 * 3] = cmul(v[2 + 4 * 3], twc<INV>(-R, R));
    v[3 + 4 * 1] = cmul(v[3 + 4 * 1], twc<INV>(S1, C1));
    v[3 + 4 * 2] = cmul(v[3 + 4 * 2], twc<INV>(-R, R));
    v[3 + 4 * 3] = cmul(v[3 + 4 * 3], twc<INV>(-C1, -S1));
#pragma unroll
    for (int k0 = 0; k0 < 4; ++k0) dft4<INV>(v[4 * k0], v[4 * k0 + 1], v[4 * k0 + 2], v[4 * k0 + 3]);
    cf t;
    t = v[1]; v[1] = v[4]; v[4] = t;   t = v[2]; v[2] = v[8]; v[8] = t;   t = v[3]; v[3] = v[12]; v[12] = t;
    t = v[6]; v[6] = v[9]; v[9] = t;   t = v[7]; v[7] = v[13]; v[13] = t; t = v[11]; v[11] = v[14]; v[14] = t;
}
#ifndef FFT_OPAQUE
#define FFT_OPAQUE(w)
#endif
HD void twiddle16(cf (&v)[16], cf w) {
    FFT_OPAQUE(w);
    cf p = w;
#pragma unroll
    for (int k = 1; k < 16; ++k) { v[k] = cmul(v[k], p); if (k < 15) p = cmul(p, w); }
}
template <class P> HD void fwd_pass1(P Z, int t, cf w1) {
    cf v[16]; const int b = t + (t >> 4);
#pragma unroll
    for (int j = 0; j < 16; ++j) v[j] = Z[b + 272 * j];
    dft16<false>(v); twiddle16(v, w1);
#pragma unroll
    for (int j = 0; j < 16; ++j) Z[b + 272 * j] = v[j];
}
template <class P> HD void fwd_pass2(P Z, int t, cf w2) {
    const int b = 272 * (t >> 4) + (t & 15);
    cf v[16];
#pragma unroll
    for (int j = 0; j < 16; ++j) v[j] = Z[b + 17 * j];
    dft16<false>(v); twiddle16(v, w2);
#pragma unroll
    for (int j = 0; j < 16; ++j) Z[b + 17 * j] = v[j];
}
template <class P> HD void fwd_pass3_load(P Z, int t, cf (&v)[16]) {
#pragma unroll
    for (int j = 0; j < 16; ++j) v[j] = Z[17 * t + j];
    dft16<false>(v);
}
template <class P> HD void inv_pass1_store(P Z, int t, cf (&v)[16]) {
    dft16<true>(v);
#pragma unroll
    for (int j = 0; j < 16; ++j) Z[17 * t + j] = v[j];
}
template <class P> HD void inv_pass2(P Z, int t, cf w2) {
    const int b = 272 * (t >> 4) + (t & 15);
    cf v[16];
#pragma unroll
    for (int j = 0; j < 16; ++j) v[j] = Z[b + 17 * j];
    twiddle16(v, cconj(w2)); dft16<true>(v);
#pragma unroll
    for (int j = 0; j < 16; ++j) Z[b + 17 * j] = v[j];
}
template <class P> HD void inv_pass3(P Z, int t, cf w1) {
    cf v[16]; const int b = t + (t >> 4);
#pragma unroll
    for (int j = 0; j < 16; ++j) v[j] = Z[b + 272 * j];
    twiddle16(v, cconj(w1)); dft16<true>(v);
#pragma unroll
    for (int j = 0; j < 16; ++j) Z[b + 272 * j] = v[j];
}
#define LAS __attribute__((address_space(3)))
typedef LAS cf* lcf;
struct HyArgs {
    const bf16* hyT;
    bf16* yaT;
    const float* fsum;
    const float* fdif;
    const float* cw;
    const float* cb;
    const float* skip;
    const cf* T;
    int TS, npairs, off00, off01, off10, off11;
};
__device__ __forceinline__ float bf2f(unsigned h) { return __builtin_bit_cast(float, h << 16); }
__device__ __forceinline__ void conv8(const bf16* row, int n0, float w0, float w1, float w2, float b, float (&o)[8]) {
    const uint4 q = *(const uint4*)(row + n0);
    float x[10];
    x[0] = n0 > 0 ? bf2f(row[n0 - 1]) : 0.f;
    x[9] = n0 + 8 < 4096 ? bf2f(row[n0 + 8]) : 0.f;
    x[1] = bf2f(q.x & 0xffffu); x[2] = bf2f(q.x >> 16); x[3] = bf2f(q.y & 0xffffu); x[4] = bf2f(q.y >> 16);
    x[5] = bf2f(q.z & 0xffffu); x[6] = bf2f(q.z >> 16); x[7] = bf2f(q.w & 0xffffu); x[8] = bf2f(q.w >> 16);
#pragma unroll
    for (int i = 0; i < 8; ++i) o[i] = b + w0 * x[i] + w1 * x[i + 1] + w2 * x[i + 2];
}
__device__ __forceinline__ void hyena_channel(lcf Z, const HyArgs& A, int c, int tid, cf w1, cf w2, cf wp) {
    const int s = tid >> 8, t = tid & 255, n0 = 8 * tid, pb = 8 * tid + (tid >> 1);
    lcf Zs = Z + s * FSUB;
    constexpr float W8C[8] = {1.0f, 0.99999970586f, 0.99999882345f, 0.99999735277f, 0.99999529381f, 0.99999264659f, 0.99998941108f, 0.99998558731f};
    constexpr float W8S[8] = {0.0f, 0.00076699031874f, 0.0015339801863f, 0.0023009691514f, 0.0030679567630f, 0.0038349425697f, 0.0046019261204f, 0.0053689069640f};
    cf tw[8];
#pragma unroll
    for (int i = 0; i < 8; ++i) tw[i] = cmul(wp, cmk(W8C[i], -W8S[i]));
    cf Kr[16];
    {
        const float4 a0 = *(const float4*)(A.fsum + (size_t)c * 4096 + n0), a1 = *(const float4*)(A.fsum + (size_t)c * 4096 + n0 + 4);
        const float4 d0 = *(const float4*)(A.fdif + (size_t)c * 4096 + n0), d1 = *(const float4*)(A.fdif + (size_t)c * 4096 + n0 + 4);
        const float fs[8] = {a0.x, a0.y, a0.z, a0.w, a1.x, a1.y, a1.z, a1.w}, fd[8] = {d0.x, d0.y, d0.z, d0.w, d1.x, d1.y, d1.z, d1.w};
#pragma unroll
        for (int i = 0; i < 8; ++i) { Z[pb + i] = cmk(fs[i], 0.f); Z[FSUB + pb + i] = cmk(fd[i] * tw[i].x, fd[i] * tw[i].y); }
    }
    __syncthreads();
    fwd_pass1(Zs, t, w1); __syncthreads();
    fwd_pass2(Zs, t, w2); __syncthreads();
    fwd_pass3_load(Zs, t, Kr);
#pragma unroll
    for (int j = 0; j < 16; ++j) { Kr[j].x *= (1.0f / 8192.0f); Kr[j].y *= (1.0f / 8192.0f); }
    __syncthreads();
    const float sk = A.skip[c];
    const float cx0 = A.cw[c], cx1 = A.cw[3072 + c], cx2 = A.cw[6144 + c], cxb = A.cb[c];
    const float ca0 = A.cw[1024 + c], ca1 = A.cw[3072 + 1024 + c], ca2 = A.cw[6144 + 1024 + c], cab = A.cb[1024 + c];
    const float cv0 = A.cw[2048 + c], cv1 = A.cw[3072 + 2048 + c], cv2 = A.cw[6144 + 2048 + c], cvb = A.cb[2048 + c];
    for (int p = 0; p < A.npairs; ++p) {
        const int o0 = p ? A.off10 : A.off00, o1 = p ? A.off11 : A.off01;
        float u0[8], u1[8];
        {
            float a[8], b[8];
            conv8(A.hyT + (size_t)(1024 + c) * A.TS + o0, n0, ca0, ca1, ca2, cab, a);
            conv8(A.hyT + (size_t)(2048 + c) * A.TS + o0, n0, cv0, cv1, cv2, cvb, b);
#pragma unroll
            for (int i = 0; i < 8; ++i) u0[i] = a[i] * b[i];
            conv8(A.hyT + (size_t)(1024 + c) * A.TS + o1, n0, ca0, ca1, ca2, cab, a);
            conv8(A.hyT + (size_t)(2048 + c) * A.TS + o1, n0, cv0, cv1, cv2, cvb, b);
#pragma unroll
            for (int i = 0; i < 8; ++i) u1[i] = a[i] * b[i];
        }
#pragma unroll
        for (int i = 0; i < 8; ++i) { const cf z = cmk(u0[i], u1[i]); Z[pb + i] = z; Z[FSUB + pb + i] = cmul(z, tw[i]); }
        __syncthreads();
        fwd_pass1(Zs, t, w1); __syncthreads();
        fwd_pass2(Zs, t, w2); __syncthreads();
        {
            cf v[16];
            fwd_pass3_load(Zs, t, v);
#pragma unroll
            for (int j = 0; j < 16; ++j) v[j] = cmul(v[j], Kr[j]);
            inv_pass1_store(Zs, t, v);
        }
        __syncthreads();
        inv_pass2(Zs, t, w2); __syncthreads();
        inv_pass3(Zs, t, w1); __syncthreads();
        {
            float y0[8], y1[8];
#pragma unroll
            for (int i = 0; i < 8; ++i) { const cf e = Z[pb + i], o = Z[FSUB + pb + i]; const cf y = cadd(e, cmul(o, cconj(tw[i]))); y0[i] = y.x + sk * u0[i]; y1[i] = y.y + sk * u1[i]; }
            float x0c[8];
            conv8(A.hyT + (size_t)c * A.TS + o0, n0, cx0, cx1, cx2, cxb, x0c);
            uint4 w;
            w.x = f2bf(x0c[0] * y0[0]) | (f2bf(x0c[1] * y0[1]) << 16); w.y = f2bf(x0c[2] * y0[2]) | (f2bf(x0c[3] * y0[3]) << 16);
            w.z = f2bf(x0c[4] * y0[4]) | (f2bf(x0c[5] * y0[5]) << 16); w.w = f2bf(x0c[6] * y0[6]) | (f2bf(x0c[7] * y0[7]) << 16);
            *(uint4*)(A.yaT + (size_t)c * A.TS + o0 + n0) = w;
            if (o1 != o0) {
                conv8(A.hyT + (size_t)c * A.TS + o1, n0, cx0, cx1, cx2, cxb, x0c);
                w.x = f2bf(x0c[0] * y1[0]) | (f2bf(x0c[1] * y1[1]) << 16); w.y = f2bf(x0c[2] * y1[2]) | (f2bf(x0c[3] * y1[3]) << 16);
                w.z = f2bf(x0c[4] * y1[4]) | (f2bf(x0c[5] * y1[5]) << 16); w.w = f2bf(x0c[6] * y1[6]) | (f2bf(x0c[7] * y1[7]) << 16);
                *(uint4*)(A.yaT + (size_t)c * A.TS + o1 + n0) = w;
            }
        }
        __syncthreads();
    }
}
__device__ __forceinline__ void hyena_phase(lcf Z, const HyArgs& A, int first, int stride, const int tid) {
    const int t = tid & 255;
    const cf w1 = A.T[2 * t], w2 = A.T[32 * (t & 15)], wp = A.T[8 * tid];
    for (int c = first; c < 1024; c += stride) hyena_channel(Z, A, c, tid, w1, w2, wp);
}

}
namespace pg8 {
__device__ __forceinline__ f32x2 sigmoid_pk(f32x2 v) {
    f32x2 e; e.x = __builtin_amdgcn_exp2f(v.x * -1.4426950408889634f); e.y = __builtin_amdgcn_exp2f(v.y * -1.4426950408889634f);
    f32x2 o; o.x = __builtin_amdgcn_rcpf(1.0f + e.x); o.y = __builtin_amdgcn_rcpf(1.0f + e.y); return o;
}
struct EpiHyT {
    static constexpr bool PERM = true, AFTER_DRAIN = false, MID = false;
    bf16_t* O; int ldc; float* vss;
    __device__ __forceinline__ void operator()(const f32x4 (&acc)[2][2][4][2], const Unit& u, int wr, int wc, int fr, int fq) const {
        const int row0 = u.pm * BM + wr * 64 + fr, col0 = u.pn * BM + wc * 32 + 8 * fq;
        const bool isv = u.pm >= 12;
        f32x4 ss[2][2];
#pragma unroll
        for (int bj = 0; bj < 2; ++bj)
#pragma unroll
            for (int n = 0; n < 2; ++n) ss[bj][n] = (f32x4){0.f, 0.f, 0.f, 0.f};
#pragma unroll
        for (int ai = 0; ai < 2; ++ai)
#pragma unroll
            for (int m = 0; m < 4; ++m) { bf16_t* rowp = O + (size_t)(row0 + ai * HALF + m * 16) * ldc + col0;
#pragma unroll
                for (int bj = 0; bj < 2; ++bj) { f32x4 v0 = acc[ai][bj][m][0], v1 = acc[ai][bj][m][1];
                    if (isv) { f32x2 a = gelu_pk((f32x2){v0[0], v0[1]}), b = gelu_pk((f32x2){v0[2], v0[3]}), c = gelu_pk((f32x2){v1[0], v1[1]}), d = gelu_pk((f32x2){v1[2], v1[3]});
                        v0 = (f32x4){a.x, a.y, b.x, b.y}; v1 = (f32x4){c.x, c.y, d.x, d.y}; ss[bj][0] += v0 * v0; ss[bj][1] += v1 * v1; }
                    u32x4 w; w.x = cvt_pk_bf16(v0[0], v0[1]); w.y = cvt_pk_bf16(v0[2], v0[3]); w.z = cvt_pk_bf16(v1[0], v1[1]); w.w = cvt_pk_bf16(v1[2], v1[3]);
                    *(u32x4*)(rowp + bj * HALF) = w; } }
        if (isv) {
#pragma unroll
            for (int bj = 0; bj < 2; ++bj)
#pragma unroll
                for (int n = 0; n < 2; ++n)
#pragma unroll
                    for (int j = 0; j < 4; ++j) { float s = ss[bj][n][j]; s += __shfl_xor(s, 1); s += __shfl_xor(s, 2); s += __shfl_xor(s, 4); s += __shfl_xor(s, 8);
                        if (fr == 0) atomicAdd(vss + col0 + bj * HALF + 4 * n + j, s); }
        }
    }
};
struct EpiUG {
    static constexpr bool PERM = true, AFTER_DRAIN = false, MID = false;
    bf16_t* U; bf16_t* G; int ldu;
    __device__ __forceinline__ void operator()(const f32x4 (&acc)[2][2][4][2], const Unit& u, int wr, int wc, int fr, int fq) const {
        const int row0 = u.pm * BM + wr * 64 + fr; int colt = u.pn * BM; const bool isu = colt < 1024;
        bf16_t* base = isu ? U : G; const int ldc = isu ? ldu : 2048; if (!isu) colt -= 1024;
        const int col0 = colt + wc * 32 + 8 * fq;
#pragma unroll
        for (int ai = 0; ai < 2; ++ai)
#pragma unroll
            for (int m = 0; m < 4; ++m) { bf16_t* rowp = base + (size_t)(row0 + ai * HALF + m * 16) * ldc + col0;
#pragma unroll
                for (int bj = 0; bj < 2; ++bj) { f32x4 v0 = acc[ai][bj][m][0], v1 = acc[ai][bj][m][1];
                    f32x2 a, b, c, d;
                    if (isu) { a = gelu_pk((f32x2){v0[0], v0[1]}); b = gelu_pk((f32x2){v0[2], v0[3]}); c = gelu_pk((f32x2){v1[0], v1[1]}); d = gelu_pk((f32x2){v1[2], v1[3]}); }
                    else { a = sigmoid_pk((f32x2){v0[0], v0[1]}); b = sigmoid_pk((f32x2){v0[2], v0[3]}); c = sigmoid_pk((f32x2){v1[0], v1[1]}); d = sigmoid_pk((f32x2){v1[2], v1[3]}); }
                    u32x4 w; w.x = cvt_pk_bf16(a.x, a.y); w.y = cvt_pk_bf16(b.x, b.y); w.z = cvt_pk_bf16(c.x, c.y); w.w = cvt_pk_bf16(d.x, d.y);
                    *(u32x4*)(rowp + bj * HALF) = w; } }
    }
};
}
namespace {
struct WJob { const float* W; const float* g; bf16* dst; int K, N, c0, nc, ldd, r0, koff, pad; };
constexpr int NWJ = 9;
struct WJobs { WJob j[NWJ]; };
__device__ __forceinline__ unsigned pk2(float lo, float hi) { return f2bf(lo) | (f2bf(hi) << 16); }
__device__ __forceinline__ void wT_item(const WJob& J, LAS float* scr, int item, int lane) {
    const int nblk = J.nc / 32, kb = item / nblk, nb = item % nblk, k0 = 64 * kb, n0 = 32 * nb;
#pragma unroll 8
    for (int i = 0; i < 32; ++i) { const int kk = 2 * i + (lane >> 5); float v = J.W[(size_t)(k0 + kk) * J.N + J.c0 + n0 + (lane & 31)]; if (J.g) v *= J.g[k0 + kk]; scr[kk * 33 + (lane & 31)] = v; }
    asm volatile("s_waitcnt lgkmcnt(0)" ::: "memory");
    const int c = lane & 7;
#pragma unroll
    for (int j = 0; j < 4; ++j) { const int n = (lane >> 3) + 8 * j; const LAS float* s = scr + (8 * c) * 33 + n;
        uint4 o; o.x = pk2(s[0 * 33], s[1 * 33]); o.y = pk2(s[2 * 33], s[3 * 33]); o.z = pk2(s[4 * 33], s[5 * 33]); o.w = pk2(s[6 * 33], s[7 * 33]);
        *(uint4*)(J.dst + (size_t)(J.r0 + n0 + n) * J.ldd + J.koff + k0 + 8 * c) = o; }
    asm volatile("s_waitcnt lgkmcnt(0)" ::: "memory");
}
__device__ __forceinline__ void p0_weights(const WJobs& WJ, int jlo, int jhi, LAS float* scr, int gw, int NGW, int lane) {
    int base = 0;
    for (int q = jlo; q < jhi; ++q) {
        const WJob& J = WJ.j[q]; const int ni = (J.K / 64) * (J.nc / 32);
        int it = gw - (base % NGW); if (it < 0) it += NGW;
        for (; it < ni; it += NGW) wT_item(J, scr, it, lane);
        base += ni;
    }
}
__device__ __forceinline__ float wave_sum(float v) {
#pragma unroll
    for (int o = 1; o < 64; o <<= 1) v += __shfl_xor(v, o);
    return v;
}
__device__ __forceinline__ void rms_row_to_bf16(const float* xrow, const float* g, bf16* orow, int lane) {
    const float4* xr = (const float4*)xrow + lane; const float4* gr = (const float4*)g + lane;
    float4 v[4]; float s = 0.f;
#pragma unroll
    for (int j = 0; j < 4; ++j) { v[j] = xr[64 * j]; s += (v[j].x * v[j].x + v[j].y * v[j].y) + (v[j].z * v[j].z + v[j].w * v[j].w); }
    const float r = rsqrtf(wave_sum(s) * (1.f / 1024.f) + EPS);
    unsigned long long* o8 = (unsigned long long*)orow + lane;
#pragma unroll
    for (int j = 0; j < 4; ++j) { const float4 gg = gr[64 * j];
        o8[64 * j] = (unsigned long long)pk2(v[j].x * r * gg.x, v[j].y * r * gg.y) | ((unsigned long long)pk2(v[j].z * r * gg.z, v[j].w * r * gg.w) << 32); }
}
}

namespace {
struct SguArgs {
    const bf16* vT;
    bf16* U;
    const float* vss;
    const float* ws;
    const float* bs;
    const float* gn;
    int TS, ldu;
};
typedef short bf16x8_t __attribute__((ext_vector_type(8)));
typedef float f32x4_t __attribute__((ext_vector_type(4)));
__device__ __forceinline__ void sgu_item(LAS unsigned char* lds, const SguArgs& A, int item, int tid) {
    const int g = item & 7, ch = item >> 3, tok0 = ch * 128;
    const int wave = tid >> 6, lane = tid & 63, fr = lane & 15, fq = lane >> 4;
#pragma unroll
    for (int j = 0; j < 4; ++j) { const int idx = tid + 512 * j, d = idx >> 4, chunk = idx & 15;
        const pg8::u32x4 v = *(const pg8::u32x4*)(A.vT + (size_t)(g * 128 + d) * A.TS + tok0 + chunk * 8);
        *(LAS pg8::u32x4*)(lds + d * 272 + chunk * 16) = v; }
    bf16x8_t af[4];
    const int p = 16 * wave + fr;
#pragma unroll
    for (int kk = 0; kk < 4; ++kk) { const int q = 32 * kk + 8 * fq;
        const float4 w0 = *(const float4*)(A.ws + ((size_t)g * 128 + p) * 128 + q), w1 = *(const float4*)(A.ws + ((size_t)g * 128 + p) * 128 + q + 4);
        const float4 s0 = *(const float4*)(A.vss + tok0 + q), s1 = *(const float4*)(A.vss + tok0 + q + 4);
        const float r0 = rsqrtf(s0.x * (1.f / 1024.f) + EPS), r1 = rsqrtf(s0.y * (1.f / 1024.f) + EPS), r2 = rsqrtf(s0.z * (1.f / 1024.f) + EPS), r3 = rsqrtf(s0.w * (1.f / 1024.f) + EPS);
        const float r4 = rsqrtf(s1.x * (1.f / 1024.f) + EPS), r5 = rsqrtf(s1.y * (1.f / 1024.f) + EPS), r6 = rsqrtf(s1.z * (1.f / 1024.f) + EPS), r7 = rsqrtf(s1.w * (1.f / 1024.f) + EPS);
        uint4 o; o.x = pk2(w0.x * r0, w0.y * r1); o.y = pk2(w0.z * r2, w0.w * r3); o.z = pk2(w1.x * r4, w1.y * r5); o.w = pk2(w1.z * r6, w1.w * r7);
        af[kk] = __builtin_bit_cast(bf16x8_t, o); }
    __syncthreads();
    f32x4_t acc[8];
#pragma unroll
    for (int nt = 0; nt < 8; ++nt) acc[nt] = (f32x4_t){0.f, 0.f, 0.f, 0.f};
#pragma unroll
    for (int kk = 0; kk < 4; ++kk) {
        bf16x8_t bfr[8];
#pragma unroll
        for (int nt = 0; nt < 8; ++nt) bfr[nt] = *(const LAS bf16x8_t*)(lds + (16 * nt + fr) * 272 + (32 * kk + 8 * fq) * 2);
#pragma unroll
        for (int nt = 0; nt < 8; ++nt) acc[nt] = __builtin_amdgcn_mfma_f32_16x16x32_bf16(bfr[nt], af[kk], acc[nt], 0, 0, 0);
    }
    const float bsp = A.bs[g * 128 + p];
    bf16* urow = A.U + (size_t)(tok0 + p) * A.ldu + g * 128 + 4 * fq;
    const float* gnp = A.gn + g * 128 + 4 * fq;
#pragma unroll
    for (int nt = 0; nt < 8; ++nt) {
        const uint2 uu = *(const uint2*)(urow + 16 * nt);
        const float4 gv = *(const float4*)(gnp + 16 * nt);
        const float y0 = bf2f(uu.x & 0xffffu) * (gv.x * acc[nt][0] + bsp), y1 = bf2f(uu.x >> 16) * (gv.y * acc[nt][1] + bsp);
        const float y2 = bf2f(uu.y & 0xffffu) * (gv.z * acc[nt][2] + bsp), y3 = bf2f(uu.y >> 16) * (gv.w * acc[nt][3] + bsp);
        uint2 o; o.x = pk2(y0, y1); o.y = pk2(y2, y3);
        *(uint2*)(urow + 16 * nt) = o;
    }
    __syncthreads();
}
}

namespace pg8 {
__device__ __forceinline__ void bf8_to_f32(const u32x4 q, f32x4& lo, f32x4& hi) {
    lo = (f32x4){__builtin_bit_cast(float, q.x << 16), __builtin_bit_cast(float, q.x & 0xffff0000u), __builtin_bit_cast(float, q.y << 16), __builtin_bit_cast(float, q.y & 0xffff0000u)};
    hi = (f32x4){__builtin_bit_cast(float, q.z << 16), __builtin_bit_cast(float, q.z & 0xffff0000u), __builtin_bit_cast(float, q.w << 16), __builtin_bit_cast(float, q.w & 0xffff0000u)};
}
struct EpiMerge {
    static constexpr bool PERM = true, AFTER_DRAIN = false, MID = true;
    const bf16_t* G; bf16_t* O;
    __device__ __forceinline__ void mid(f32x4 (&acc)[2][2][4][2], const Unit& u, int wr, int wc, int fr, int fq) const {
        unsigned off0 = (unsigned)(u.pm * BM + wr * 64 + fr) * 2048u + (unsigned)(u.pn * BM + wc * 32 + 8 * fq);
        asm volatile("" : "+v"(off0));
#pragma unroll
        for (int ai = 0; ai < 2; ++ai)
#pragma unroll
            for (int m = 0; m < 4; ++m)
#pragma unroll
                for (int bj = 0; bj < 2; ++bj) { const bf16_t* gp = G + (off0 + (unsigned)((ai * HALF + m * 16) * 2048 + bj * HALF));
                    const u32x4 qa = *(const u32x4*)gp, qb = *(const u32x4*)(gp + 1024);
                    f32x4 a0, a1, b0, b1; bf8_to_f32(qa, a0, a1); bf8_to_f32(qb, b0, b1);
#pragma unroll
                    for (int j = 0; j < 4; ++j) { acc[ai][bj][m][0][j] *= a0[j] * __builtin_amdgcn_rcpf(b0[j]); acc[ai][bj][m][1][j] *= a1[j] * __builtin_amdgcn_rcpf(b1[j]); }
                    asm volatile("" ::: "memory"); }
    }
    __device__ __forceinline__ void operator()(const f32x4 (&acc)[2][2][4][2], const Unit& u, int wr, int wc, int fr, int fq) const {
        const int row0 = u.pm * BM + wr * 64 + fr, col0 = u.pn * BM + wc * 32 + 8 * fq;
#pragma unroll
        for (int ai = 0; ai < 2; ++ai)
#pragma unroll
            for (int m = 0; m < 4; ++m) { const size_t r = (size_t)(row0 + ai * HALF + m * 16);
#pragma unroll
                for (int bj = 0; bj < 2; ++bj) { f32x4 b0, b1; bf8_to_f32(*(const u32x4*)(G + r * 2048 + 1024 + col0 + bj * HALF), b0, b1);
                    const f32x4 v0 = acc[ai][bj][m][0] * b0, v1 = acc[ai][bj][m][1] * b1;
                    u32x4 w; w.x = cvt_pk_bf16(v0[0], v0[1]); w.y = cvt_pk_bf16(v0[2], v0[3]); w.z = cvt_pk_bf16(v1[0], v1[1]); w.w = cvt_pk_bf16(v1[2], v1[3]);
                    *(u32x4*)(O + r * 1024 + col0 + bj * HALF) = w; } }
    }
};
}
namespace {
__device__ __forceinline__ void tr64_item(const bf16* yaT, int TS, bf16* out, int ldo, LAS unsigned short* scr, int c0, int t0, int lane) {
#pragma unroll
    for (int i = 0; i < 8; ++i) { const int r = 8 * i + (lane >> 3), ch = lane & 7;
        const pg8::u32x4 q = *(const pg8::u32x4*)(yaT + (size_t)(c0 + r) * TS + t0 + 8 * ch);
        LAS unsigned short* d = scr + (8 * ch) * 72 + r;
        d[0 * 72] = (unsigned short)(q.x & 0xffffu); d[1 * 72] = (unsigned short)(q.x >> 16); d[2 * 72] = (unsigned short)(q.y & 0xffffu); d[3 * 72] = (unsigned short)(q.y >> 16);
        d[4 * 72] = (unsigned short)(q.z & 0xffffu); d[5 * 72] = (unsigned short)(q.z >> 16); d[6 * 72] = (unsigned short)(q.w & 0xffffu); d[7 * 72] = (unsigned short)(q.w >> 16); }
    asm volatile("s_waitcnt lgkmcnt(0)" ::: "memory");
#pragma unroll
    for (int i = 0; i < 8; ++i) { const int tk = 8 * i + (lane >> 3), ch = lane & 7;
        const pg8::u32x4 q = *(const LAS pg8::u32x4*)(scr + tk * 72 + 8 * ch);
        *(pg8::u32x4*)(out + (size_t)(t0 + tk) * ldo + c0 + 8 * ch) = q; }
    asm volatile("s_waitcnt lgkmcnt(0)" ::: "memory");
}
__device__ __forceinline__ void transpose_ya(const bf16* yaT, int TS, bf16* out, int ldo, LAS unsigned short* scr, int gw, int NGW, int lane) {
    const int ntt = TS / 64, nit = 16 * ntt;
    for (int it = gw; it < nit; it += NGW) tr64_item(yaT, TS, out, ldo, scr, 64 * (it / ntt), 64 * (it % ntt), lane);
}
}

namespace pg8 {
template <bool FIRST> struct EpiResid {
    static constexpr bool PERM = false, AFTER_DRAIN = false, MID = false;
    const float* X; const bf16_t* XB; float* X1; bf16_t* X1b; float* xss;
    __device__ __forceinline__ void operator()(const f32x4 (&acc)[2][2][4][2], const Unit& u, int wr, int wc, int fr, int fq) const {
        const int row0 = u.pm * BM + wr * 64 + fr, col0 = u.pn * BM + wc * 32 + 4 * fq;
        typedef unsigned u32x2v __attribute__((ext_vector_type(2)));
#pragma unroll
        for (int ai = 0; ai < 2; ++ai)
#pragma unroll
            for (int m = 0; m < 4; ++m) { const size_t r = (size_t)(row0 + ai * HALF + m * 16); float s = 0.f;
#pragma unroll
                for (int bj = 0; bj < 2; ++bj)
#pragma unroll
                    for (int n = 0; n < 2; ++n) { const size_t o = r * 1024 + col0 + bj * HALF + n * 16;
                        f32x4 v;
                        if (FIRST) v = acc[ai][bj][m][n] + *(const f32x4*)(X + o);
                        else { const u32x2v q = *(const u32x2v*)(XB + o);
                               v = acc[ai][bj][m][n] + (f32x4){__builtin_bit_cast(float, q.x << 16), __builtin_bit_cast(float, q.x & 0xffff0000u), __builtin_bit_cast(float, q.y << 16), __builtin_bit_cast(float, q.y & 0xffff0000u)}; }
                        if (FIRST) { u32x2v w; w.x = cvt_pk_bf16(v[0], v[1]); w.y = cvt_pk_bf16(v[2], v[3]); *(u32x2v*)(X1b + o) = w; }
                        else *(f32x4*)(X1 + o) = v;
                        s += (v[0] * v[0] + v[1] * v[1]) + (v[2] * v[2] + v[3] * v[3]); }
                s += __shfl_xor(s, 16); s += __shfl_xor(s, 32);
                if (fq == 0) atomicAdd(xss + r, s);
                asm volatile("" ::: "memory"); }
    }
};
struct EpiUp {
    static constexpr bool PERM = true, AFTER_DRAIN = false, MID = false;
    bf16_t* AP; bf16_t* GP; const float* xss;
    __device__ __forceinline__ void operator()(const f32x4 (&acc)[2][2][4][2], const Unit& u, int wr, int wc, int fr, int fq) const {
        const int row0 = u.pm * BM + wr * 64 + fr; int colt = u.pn * BM; const bool isg = colt >= 2816;
        bf16_t* base = isg ? GP : AP; if (isg) colt -= 2816;
        const int col0 = colt + wc * 32 + 8 * fq;
#pragma unroll
        for (int ai = 0; ai < 2; ++ai)
#pragma unroll
            for (int m = 0; m < 4; ++m) { const size_t r = (size_t)(row0 + ai * HALF + m * 16); const float rs = rsqrtf(xss[r] * (1.0f / 1024.0f) + 1e-6f);
#pragma unroll
                for (int bj = 0; bj < 2; ++bj) { const f32x4 v0 = acc[ai][bj][m][0] * rs, v1 = acc[ai][bj][m][1] * rs;
                    u32x4 w; w.x = cvt_pk_bf16(v0[0], v0[1]); w.y = cvt_pk_bf16(v0[2], v0[3]); w.z = cvt_pk_bf16(v1[0], v1[1]); w.w = cvt_pk_bf16(v1[2], v1[3]);
                    *(u32x4*)(base + r * 2816 + col0 + bj * HALF) = w; } }
    }
};
}
namespace {
__device__ __forceinline__ void act_pass(const bf16* AP, bf16* GP, const float* cw, const float* cb, int TS, int gid, int gstride) {
    const int nitems = (TS / 16) * 352;
    const pg8::u32x4 zq = {0u, 0u, 0u, 0u};
    for (int it = gid; it < nitems; it += gstride) {
        const int run = it / 352, ch = it % 352, t0 = run * 16, c0 = ch * 8;
        const pg8::f32x4 w0l = *(const pg8::f32x4*)(cw + c0), w0h = *(const pg8::f32x4*)(cw + c0 + 4);
        const pg8::f32x4 w1l = *(const pg8::f32x4*)(cw + 2816 + c0), w1h = *(const pg8::f32x4*)(cw + 2816 + c0 + 4);
        const pg8::f32x4 w2l = *(const pg8::f32x4*)(cw + 5632 + c0), w2h = *(const pg8::f32x4*)(cw + 5632 + c0 + 4);
        const pg8::f32x4 bl = *(const pg8::f32x4*)(cb + c0), bh = *(const pg8::f32x4*)(cb + c0 + 4);
        const bf16* ap = AP + (size_t)t0 * 2816 + c0; bf16* gp = GP + (size_t)t0 * 2816 + c0;
        pg8::u32x4 qa[6];
        qa[0] = (t0 & 4095) != 0 ? *(const pg8::u32x4*)(ap - 2816) : zq;
        qa[1] = *(const pg8::u32x4*)ap;
#pragma unroll 1
        for (int i = 0; i < 16; i += 4) {
            pg8::u32x4 qg[4];
#pragma unroll
            for (int k = 0; k < 4; ++k) { const int t = t0 + i + k;
                qa[2 + k] = (t & 4095) != 4095 ? *(const pg8::u32x4*)(ap + (size_t)(i + k + 1) * 2816) : zq;
                qg[k] = *(const pg8::u32x4*)(gp + (size_t)(i + k) * 2816); }
#pragma unroll
            for (int k = 0; k < 4; ++k) {
                pg8::f32x4 pl, ph, cl, chh, nl, nh, gl, gh;
                pg8::bf8_to_f32(qa[k], pl, ph); pg8::bf8_to_f32(qa[k + 1], cl, chh); pg8::bf8_to_f32(qa[k + 2], nl, nh); pg8::bf8_to_f32(qg[k], gl, gh);
                const pg8::f32x4 sl = bl + w0l * pl + w1l * cl + w2l * nl, sh = bh + w0h * ph + w1h * chh + w2h * nh;
                pg8::f32x4 ol, oh;
#pragma unroll
                for (int j = 0; j < 4; ++j) { ol[j] = sl[j] * __builtin_amdgcn_rcpf(1.0f + __builtin_amdgcn_exp2f(sl[j] * -1.4426950408889634f)) * gl[j];
                                              oh[j] = sh[j] * __builtin_amdgcn_rcpf(1.0f + __builtin_amdgcn_exp2f(sh[j] * -1.4426950408889634f)) * gh[j]; }
                pg8::u32x4 w; w.x = pg8::cvt_pk_bf16(ol[0], ol[1]); w.y = pg8::cvt_pk_bf16(ol[2], ol[3]); w.z = pg8::cvt_pk_bf16(oh[0], oh[1]); w.w = pg8::cvt_pk_bf16(oh[2], oh[3]);
                *(pg8::u32x4*)(gp + (size_t)(i + k) * 2816) = w;
            }
            qa[0] = qa[4]; qa[1] = qa[5];
        }
    }
}
__device__ __forceinline__ void final_norm(const float* X2, const float* ss, const float* g, float* out, int TS, int gw, int NGW, int lane) {
    for (int t = gw; t < TS; t += NGW) {
        const float r = rsqrtf(ss[t] * (1.0f / 1024.0f) + EPS);
#pragma unroll
        for (int j = 0; j < 4; ++j) { const pg8::f32x4 v = *((const pg8::f32x4*)(X2 + (size_t)t * 1024) + lane + 64 * j), gg = *((const pg8::f32x4*)g + lane + 64 * j);
            *((pg8::f32x4*)(out + (size_t)t * 1024) + lane + 64 * j) = v * gg * r; }
    }
}
}

namespace {
constexpr int MLPW_W2 = 33 * 64, MLPW_W3 = MLPW_W2 + 4096, MLPW_B = MLPW_W3 + 4096, MLPW_N = MLPW_B + 256;
__device__ __forceinline__ float filt_z(int l, int j) {
    if (j == 0) return (float)((double)l / (double)(L - 1));
    const int i = (j - 1) & 15;
    const double band = 1e-4 + (double)i * ((15.0 - 1e-4) / 15.0);
    double rev = (double)l * band / (double)L;
    rev -= floor(rev);
    const float ang = (float)(rev * 6.283185307179586);
    return (j <= 16) ? cosf(ang) : -sinf(ang);
}
__device__ __forceinline__ void filter_mlp_rows2(const LAS float* wl, float* h3out, LAS float* scr, int l0, int l1, int j) {
    LAS float* za = scr; LAS float* zb = scr + 64;
    if (j < FEMB) { za[j] = filt_z(l0, j); zb[j] = filt_z(l1, j); }
    asm volatile("s_waitcnt lgkmcnt(0)" ::: "memory");
    const float a = wl[MLPW_B + 192 + j];
    float s0 = wl[MLPW_B + j], s1 = s0;
#pragma unroll 11
    for (int i = 0; i < FEMB; ++i) { const float w = wl[i * 64 + j]; s0 += za[i] * w; s1 += zb[i] * w; }
    asm volatile("s_waitcnt lgkmcnt(0)" ::: "memory");
    za[j] = sinf(a * s0); zb[j] = sinf(a * s1);
    asm volatile("s_waitcnt lgkmcnt(0)" ::: "memory");
    s0 = wl[MLPW_B + 64 + j]; s1 = s0;
#pragma unroll 8
    for (int i = 0; i < FHID; ++i) { const float w = wl[MLPW_W2 + i * 64 + j]; s0 += za[i] * w; s1 += zb[i] * w; }
    asm volatile("s_waitcnt lgkmcnt(0)" ::: "memory");
    za[j] = sinf(a * s0); zb[j] = sinf(a * s1);
    asm volatile("s_waitcnt lgkmcnt(0)" ::: "memory");
    s0 = wl[MLPW_B + 128 + j]; s1 = s0;
#pragma unroll 8
    for (int i = 0; i < FHID; ++i) { const float w = wl[MLPW_W3 + i * 64 + j]; s0 += za[i] * w; s1 += zb[i] * w; }
    h3out[l0 * FHID + j] = sinf(a * s0); h3out[l1 * FHID + j] = sinf(a * s1);
    asm volatile("s_waitcnt lgkmcnt(0)" ::: "memory");
}
__device__ __forceinline__ void stage_h3_tile(const float* h3, int row0, LAS float* scr, int lane) {
#pragma unroll 4
    for (int i = 0; i < 16; ++i) { const int e = 4 * (lane + 64 * i), r = e >> 6, jj = e & 63;
        if (row0 + r < 4096) { const pg8::f32x4 v = *(const pg8::f32x4*)(h3 + (size_t)(row0 + r) * 64 + jj);
            LAS float* d = scr + r * 65 + jj; d[0] = v[0]; d[1] = v[1]; d[2] = v[2]; d[3] = v[3]; } }
    asm volatile("s_waitcnt lgkmcnt(0)" ::: "memory");
}
__device__ __forceinline__ void filter_tables(const float* h3, const float* w4, const float* decay, float* fsum, float* fdif, LAS float* scr, int gw, int NGW, int lane) {
    for (int it = gw; it < 2048; it += NGW) {
        const int n0 = (it & 63) * 64, n = n0 + lane, c0 = (it >> 6) * 32, nb = n ? 4096 - n : 0;
        float sf[32], sb[32];
#pragma unroll
        for (int cc = 0; cc < 32; ++cc) { sf[cc] = 0.f; sb[cc] = 0.f; }
        stage_h3_tile(h3, n0, scr, lane);
#pragma unroll 2
        for (int j = 0; j < FHID; ++j) { const float hn = scr[lane * 65 + j]; const float* wf = w4 + j * 2048 + c0;
#pragma unroll
            for (int cc = 0; cc < 32; ++cc) sf[cc] += hn * wf[cc]; }
        asm volatile("s_waitcnt lgkmcnt(0)" ::: "memory");
        stage_h3_tile(h3, 4096 - n0 - 63, scr, lane);
#pragma unroll 2
        for (int j = 0; j < FHID; ++j) { const float hm = scr[(63 - lane) * 65 + j]; const float* wf = w4 + j * 2048 + 1024 + c0;
#pragma unroll
            for (int cc = 0; cc < 32; ++cc) sb[cc] += hm * wf[cc]; }
        asm volatile("s_waitcnt lgkmcnt(0)" ::: "memory");
        const float tf = (float)((double)n / (double)(L - 1)), tb = (float)((double)nb / (double)(L - 1));
#pragma unroll
        for (int cc = 0; cc < 32; ++cc) {
            const float hf = sf[cc] * expf(-tf * fabsf(decay[c0 + cc]));
            const float hb = n ? sb[cc] * expf(-tb * fabsf(decay[1024 + c0 + cc])) : 0.f;
            fsum[(size_t)(c0 + cc) * 4096 + n] = hf + hb;
            fdif[(size_t)(c0 + cc) * 4096 + n] = hf - hb;
        }
    }
}
#define RLX_AGENT __ATOMIC_RELAXED, __HIP_MEMORY_SCOPE_AGENT
#define XB_TMO      128
#define XB_XCNT(j)  (256  + 64 * (j))
#define XB_XSUB(j)  (1280 + 64 * (j))
#define XB_XGEN(j)  (2304 + 64 * (j))
#define XB_TOP      3328
#define XB_TOPGEN   3392
#define XCD_BAR_WORDS 3456
#define XB_SPIN_CAP (1u << 18)

__device__ __forceinline__ unsigned xb_ld(unsigned* p)              { return __hip_atomic_load(p, __ATOMIC_RELAXED, __HIP_MEMORY_SCOPE_AGENT); }
__device__ __forceinline__ unsigned xb_add(unsigned* p, unsigned v) { return __hip_atomic_fetch_add(p, v, __ATOMIC_RELAXED, __HIP_MEMORY_SCOPE_AGENT); }
__device__ __forceinline__ unsigned xb_xcc_id() { return (unsigned)__builtin_amdgcn_s_getreg((3 << 11) | 20) & 0xFu; }
#define XB_SPIN(cond, bar) do { unsigned _sp = 0; while (cond) { __builtin_amdgcn_s_sleep(1); \
    if ((++_sp & 255u) == 0u) { if (xb_ld(&(bar)[XB_TMO])) break; if (_sp > XB_SPIN_CAP) { atomicAdd(&(bar)[XB_TMO], 1u); break; } } } } while (0)

struct XcdBarrier {
    unsigned* bar; unsigned x;
    volatile LAS unsigned* st;
};

__device__ __forceinline__ XcdBarrier xcd_barrier_post(unsigned* bar, volatile LAS unsigned* st) {
    XcdBarrier b; b.bar = bar; b.x = xb_xcc_id(); b.st = st;
    if (threadIdx.x == 0) (void)xb_add(&bar[XB_XCNT(b.x)], 1u);
    return b;
}
__device__ __forceinline__ void xcd_barrier_complete(unsigned* bar, unsigned x, unsigned& nloc, unsigned& nx) {
    const unsigned G = gridDim.x * gridDim.y * gridDim.z;
    unsigned sum, cnt, mine, sp = 0u;
    for (;;) {
        sum = 0u; cnt = 0u; mine = 0u;
#pragma unroll
        for (unsigned j = 0; j < 16; ++j) { const unsigned c = xb_ld(&bar[XB_XCNT(j)]); sum += c; cnt += (c > 0u) ? 1u : 0u; mine = (j == x) ? c : mine; }
        if (sum == G) break;
        __builtin_amdgcn_s_sleep(1);
        if ((++sp & 255u) == 0u) { if (xb_ld(&bar[XB_TMO])) break; if (sp > XB_SPIN_CAP) { atomicAdd(&bar[XB_TMO], 1u); break; } }
    }
    nloc = mine > 0u ? mine : 1u; nx = cnt > 0u ? cnt : 1u;
}

__device__ __forceinline__ void xcd_barrier(const XcdBarrier& b) {
    asm volatile("s_waitcnt vmcnt(0)" ::: "memory");
    __syncthreads();
    if (threadIdx.x == 0) {
        unsigned* bar = b.bar;
        __builtin_amdgcn_s_waitcnt(0);
        unsigned nloc = b.st[0], nx = b.st[1];
        if (nloc == 0u) { xcd_barrier_complete(bar, b.x, nloc, nx); b.st[0] = nloc; b.st[1] = nx; }
        const unsigned old = xb_add(&bar[XB_XSUB(b.x)], 1u);
        const unsigned gen = old / nloc;
        if (old + 1u == (gen + 1u) * nloc) {
            __builtin_amdgcn_fence(__ATOMIC_RELEASE, "agent");
            asm volatile("s_waitcnt vmcnt(0)" ::: "memory");
            const unsigned og = xb_add(&bar[XB_TOP], 1u);
            const unsigned tg = og / nx;
            if (og + 1u == (tg + 1u) * nx) xb_add(&bar[XB_TOPGEN], 1u);
            else XB_SPIN(xb_ld(&bar[XB_TOPGEN]) == tg, bar);
            __builtin_amdgcn_fence(__ATOMIC_ACQUIRE, "agent");
            xb_add(&bar[XB_XGEN(b.x)], 1u);
            asm volatile("s_waitcnt vmcnt(0)" ::: "memory");
        } else {
            XB_SPIN(xb_ld(&bar[XB_XGEN(b.x)]) == gen, bar);
            __builtin_amdgcn_fence(__ATOMIC_ACQUIRE, "agent");
            asm volatile("s_waitcnt vmcnt(0)" ::: "memory");
        }
    }
    __syncthreads();
}

constexpr size_t MiB = 1u << 20;
constexpr int M = NB * L;
constexpr size_t WS_VSS = 0, WS_XSS = 64 * 1024, WS_X2SS = 128 * 1024, WS_TTAB = 192 * 1024, WS_BAR = 256 * 1024, WS_H3 = 1 * MiB;
constexpr size_t WS_WTA = 2 * MiB, WS_WTB = 10 * MiB, WS_PAB = 16 * MiB, WS_WO = 20 * MiB;
constexpr size_t WS_FSUM = 24 * MiB, WS_WUP = 24 * MiB, WS_WDN = 35 * MiB;
constexpr size_t WS_HYT = 41 * MiB;
constexpr size_t WS_X1B = 41 * MiB, WS_MRG = 105 * MiB;
constexpr size_t WS_YAB = 169 * MiB;
constexpr size_t WS_FDIF = 233 * MiB;
constexpr size_t WS_AP = 73 * MiB, WS_GP = 161 * MiB;
static_assert(WS_GP + (size_t)M * FH * 2 <= 256 * MiB && WS_AP + (size_t)M * FH * 2 <= WS_GP && WS_FDIF + 16 * MiB <= 256 * MiB && WS_WDN + (size_t)D * FH * 2 <= WS_HYT, "d_ws map");
constexpr int LDS_BYTES = 147456;
constexpr int NPH = 10;

struct MegaArgs { const float* in[27]; float* out; unsigned char* ws; int ph_lo, ph_hi; WJobs wj; };

__global__ void __launch_bounds__(512, 2) mega_fwd(MegaArgs a) {
    extern __shared__ __attribute__((aligned(16))) unsigned char lds_raw[];
    LAS unsigned char* lds = (LAS unsigned char*)lds_raw;
    cg::grid_group grid = cg::this_grid();
    const int wave = __builtin_amdgcn_readfirstlane((int)threadIdx.x >> 6);
    const int G = gridDim.x, bid = blockIdx.x, gw = bid * 8 + wave, NGW = G * 8;
#define FRESH_TID int lane; asm volatile("v_mbcnt_lo_u32_b32 %0, -1, 0\n\tv_mbcnt_hi_u32_b32 %0, -1, %0" : "=v"(lane)); const int tid = wave * 64 + lane; (void)tid
    unsigned char* ws = a.ws;
    const float* x = a.in[0];
    float* vss = (float*)(ws + WS_VSS); float* xss = (float*)(ws + WS_XSS); float* x2ss = (float*)(ws + WS_X2SS);
    cf* Ttab = (cf*)(ws + WS_TTAB); float* h3 = (float*)(ws + WS_H3);
    bf16* WtA = (bf16*)(ws + WS_WTA); bf16* WtB = (bf16*)(ws + WS_WTB); bf16* PabT = (bf16*)(ws + WS_PAB); bf16* WoT = (bf16*)(ws + WS_WO);
    bf16* WupT = (bf16*)(ws + WS_WUP); bf16* WdnT = (bf16*)(ws + WS_WDN);
    float* fsum = (float*)(ws + WS_FSUM); float* fdif = (float*)(ws + WS_FDIF);
    bf16* hyvT = (bf16*)(ws + WS_HYT); bf16* yaT = hyvT + (size_t)1024 * M; bf16* vT = hyvT + (size_t)3072 * M;
    bf16* YAB = (bf16*)(ws + WS_YAB); bf16* h1 = YAB; bf16* Ub = YAB + 1024;
    bf16* Gb = (bf16*)a.out;
    bf16* mrg = (bf16*)(ws + WS_MRG); bf16* X1b = (bf16*)(ws + WS_X1B); float* X1 = a.out;
    bf16* APb = (bf16*)(ws + WS_AP); bf16* GPb = (bf16*)(ws + WS_GP);
    const int lo = a.ph_lo, hi = a.ph_hi;
#define IN(k) (lo <= (k) && (k) < hi)
    for (int u = (int)threadIdx.x; u < 16; u += 512) ((LAS unsigned*)(lds + LDS_BYTES - 256))[u] = 0u;
    __syncthreads();
    XcdBarrier xbar = xcd_barrier_post((unsigned*)(ws + WS_BAR), (volatile LAS unsigned*)(lds + LDS_BYTES - 256));
#ifdef MK_PROBE
#define STAMP(i) do { if (threadIdx.x == 0) ((volatile LAS unsigned long long*)(lds + LDS_BYTES - 128))[i] = __builtin_amdgcn_s_memrealtime(); } while (0)
#else
#define STAMP(i) do { } while (0)
#endif
    STAMP(0);
#define SEAM(k) do { if (IN(k) && IN((k) + 1)) { if ((k) == 0) grid.sync(); else xcd_barrier(xbar); } STAMP((k) + 1); } while (0)

    if (IN(0)) { FRESH_TID;
        p0_weights(a.wj, 0, 7, (LAS float*)lds + wave * 4096, gw, NGW, lane);
        for (int m = gw; m < M; m += NGW) rms_row_to_bf16(x + (size_t)m * 1024, a.in[1], h1 + (size_t)m * 2048, lane);
        for (int i = bid * 512 + tid; i < 3 * M; i += G * 512) vss[i] = 0.f;
        __syncthreads();
        { LAS float* wl = (LAS float*)lds;
          for (int i = tid; i < MLPW_N; i += 512) { float v;
              if (i < MLPW_W2) v = a.in[5][i]; else if (i < MLPW_W3) v = a.in[7][i - MLPW_W2]; else if (i < MLPW_B) v = a.in[9][i - MLPW_W3];
              else { const int q = i - MLPW_B; v = q < 64 ? a.in[6][q] : q < 128 ? a.in[8][q - 64] : q < 192 ? a.in[10][q - 128] : a.in[11][q - 192]; }
              wl[i] = v; }
          __syncthreads();
          for (int l = 2 * gw; l < L; l += 2 * NGW) filter_mlp_rows2(wl, h3, (LAS float*)(lds + 65536) + wave * 128, l, l + 1, lane); }
        for (int m = bid * 512 + tid; m < 4096; m += G * 512) { const float ang = (float)m / 4096.0f; Ttab[m] = cmk(cospif(ang), -sinpif(ang)); }
    }
    SEAM(0);
    if (IN(1)) { FRESH_TID;
        { pg8::Gemm g{WtA, h1, 4096, M, 1024, 1024, 2048}; pg8::StaticOrder S; S.init(4096, M, G, bid);
          pg8::EpiHyT E{hyvT, M, vss};
          pg8::gemm_phase<pg8::EpiHyT, pg8::StaticOrder, true, true>(lds, g, S, E, tid); }
        { pg8::Gemm g{h1, WtB, M, 3072, 1024, 2048, 1024}; pg8::StaticOrder S; S.init(M, 3072, G, bid);
          pg8::EpiUG E{Ub, Gb, 2048};
          pg8::gemm_phase<pg8::EpiUG, pg8::StaticOrder, true, true>(lds, g, S, E, tid); }
        filter_tables(h3, a.in[12], a.in[13], fsum, fdif, (LAS float*)(lds + wave * 17408), gw, NGW, lane);
    }
    SEAM(1);
    if (IN(2)) { FRESH_TID;
        HyArgs H; H.hyT = hyvT; H.yaT = yaT; H.fsum = fsum; H.fdif = fdif; H.cw = a.in[3]; H.cb = a.in[4]; H.skip = a.in[14]; H.T = Ttab;
        H.TS = M; H.npairs = 2; H.off00 = 0; H.off01 = L; H.off10 = 2 * L; H.off11 = 3 * L;
        hyena_phase((lcf)lds, H, bid, G, tid);
        SguArgs Sg; Sg.vT = vT; Sg.U = Ub; Sg.vss = vss; Sg.ws = a.in[16]; Sg.bs = a.in[17]; Sg.gn = a.in[15]; Sg.TS = M; Sg.ldu = 2048;
        for (int it = bid; it < (M / 128) * 8; it += G) sgu_item(lds, Sg, it, tid);
    }
    SEAM(2);
    if (IN(3)) { FRESH_TID;
        transpose_ya(yaT, M, YAB, 2048, (LAS unsigned short*)lds + wave * 8192, gw, NGW, lane);
        p0_weights(a.wj, 7, 9, (LAS float*)lds + wave * 4096, gw, NGW, lane);
    }
    SEAM(3);
    if (IN(4)) { FRESH_TID;
        pg8::Gemm g{YAB, PabT, M, 1024, 2048, 2048, 2048}; pg8::StaticOrder S; S.init(M, 1024, G, bid);
        pg8::EpiMerge E{Gb, mrg};
        pg8::gemm_phase<pg8::EpiMerge, pg8::StaticOrder, true, true>(lds, g, S, E, tid);
    }
    SEAM(4);
    if (IN(5)) { FRESH_TID;
        pg8::Gemm g{mrg, WoT, M, 1024, 1024, 1024, 1024}; pg8::StaticOrder S; S.init(M, 1024, G, bid);
        pg8::EpiResid<true> E{x, nullptr, nullptr, X1b, xss};
        pg8::gemm_phase<pg8::EpiResid<true>, pg8::StaticOrder, true, true>(lds, g, S, E, tid);
    }
    SEAM(5);
    if (IN(6)) { FRESH_TID;
        pg8::Gemm g{X1b, WupT, M, 2 * FH, 1024, 1024, 1024}; pg8::StaticOrder S; S.init(M, 2 * FH, G, bid);
        pg8::EpiUp E{APb, GPb, xss};
        pg8::gemm_phase<pg8::EpiUp, pg8::StaticOrder, true, true>(lds, g, S, E, tid);
    }
    SEAM(6);
    if (IN(7)) { FRESH_TID; act_pass(APb, GPb, a.in[23], a.in[24], M, bid * 512 + tid, G * 512); }
    SEAM(7);
    if (IN(8)) { FRESH_TID;
        pg8::Gemm g{GPb, WdnT, M, 1024, FH, FH, FH}; pg8::StaticOrder S; S.init(M, 1024, G, bid);
        pg8::EpiResid<false> E{nullptr, X1b, X1, nullptr, x2ss};
        pg8::gemm_phase<pg8::EpiResid<false>, pg8::StaticOrder, true, true>(lds, g, S, E, tid);
    }
    SEAM(8);
    if (IN(9)) { FRESH_TID; final_norm(X1, x2ss, a.in[26], a.out, M, gw, NGW, lane); }
    STAMP(10);
#ifdef MK_PROBE
    if (threadIdx.x == 0) { volatile LAS unsigned long long* ts = (volatile LAS unsigned long long*)(lds + LDS_BYTES - 128);
        const unsigned long long dt = 2ull * (ts[MK_PROBE + 1] - ts[MK_PROBE]), t0 = __builtin_amdgcn_s_memrealtime();
        while (__builtin_amdgcn_s_memrealtime() - t0 < dt) __builtin_amdgcn_s_sleep(8); }
    __syncthreads();
#endif
#undef IN
#undef SEAM
}
}

#ifndef MK_CUTS
#define MK_CUTS 0
#endif
extern "C" void kernel_launch(void* const* d_in, const int* in_sizes, int n_in, void* d_out, int out_size, void* d_ws, size_t ws_size, hipStream_t stream) {
    static int grid = 0;
    if (grid == 0) {
        int dev = 0, cus = 0, per_cu = 0;
        hipGetDevice(&dev);
        hipDeviceGetAttribute(&cus, hipDeviceAttributeMultiprocessorCount, dev);
        hipFuncSetAttribute((const void*)mega_fwd, hipFuncAttributeMaxDynamicSharedMemorySize, LDS_BYTES);
        hipOccupancyMaxActiveBlocksPerMultiprocessor(&per_cu, (const void*)mega_fwd, 512, LDS_BYTES);
        if (per_cu < 1) { fprintf(stderr, "kernel_launch: occupancy query says %d blocks per CU\n", per_cu); per_cu = 1; }
        grid = cus * 1;
        (void)hipGetLastError();
    }
    hipMemsetAsync((char*)d_ws + WS_BAR, 0, XCD_BAR_WORDS * 4, stream);
    MegaArgs a{};
    for (int i = 0; i < 27; ++i) a.in[i] = (const float*)d_in[i];
    a.out = (float*)d_out; a.ws = (unsigned char*)d_ws;
    { unsigned char* ws = (unsigned char*)d_ws;
      bf16* WtA = (bf16*)(ws + WS_WTA); bf16* WtB = (bf16*)(ws + WS_WTB); bf16* PabT = (bf16*)(ws + WS_PAB); bf16* WoT = (bf16*)(ws + WS_WO); bf16* WupT = (bf16*)(ws + WS_WUP); bf16* WdnT = (bf16*)(ws + WS_WDN);
    a.wj.j[0] = WJob{(const float*)d_in[2], nullptr, WtA, 1024, INW, 0, 3072, 1024, 0, 0, 0};
    a.wj.j[1] = WJob{(const float*)d_in[2], nullptr, WtA, 1024, INW, 4096, 1024, 1024, 3072, 0, 0};
    a.wj.j[2] = WJob{(const float*)d_in[2], nullptr, WtB, 1024, INW, 3072, 1024, 1024, 0, 0, 0};
    a.wj.j[3] = WJob{(const float*)d_in[2], nullptr, WtB, 1024, INW, 5120, 2048, 1024, 1024, 0, 0};
    a.wj.j[4] = WJob{(const float*)d_in[18], nullptr, PabT, 1024, 1024, 0, 1024, 2048, 0, 0, 0};
    a.wj.j[5] = WJob{(const float*)d_in[19], nullptr, PabT, 1024, 1024, 0, 1024, 2048, 0, 1024, 0};
    a.wj.j[6] = WJob{(const float*)d_in[20], nullptr, WoT, 1024, 1024, 0, 1024, 1024, 0, 0, 0};
    a.wj.j[7] = WJob{(const float*)d_in[22], (const float*)d_in[21], WupT, 1024, 2 * FH, 0, 2 * FH, 1024, 0, 0, 0};
    a.wj.j[8] = WJob{(const float*)d_in[25], nullptr, WdnT, FH, 1024, 0, 1024, FH, 0, 0, 0};

    }
#if MK_CUTS
    for (int p = 0; p < NPH; ++p) { a.ph_lo = p; a.ph_hi = p + 1; hipLaunchKernelGGL(mega_fwd, dim3(grid), dim3(512), LDS_BYTES, stream, a); }
#else
    a.ph_lo = 0; a.ph_hi = NPH;
    void* args[] = {&a};
    hipError_t e = hipLaunchCooperativeKernel((const void*)mega_fwd, dim3(grid), dim3(512), args, LDS_BYTES, stream);
    if (e != hipSuccess) fprintf(stderr, "cooperative launch failed: %s (grid %d)\n", hipGetErrorString(e), grid);
#endif
}
```

```cpp
#include <hip/hip_runtime.h>
#include <hip/hip_cooperative_groups.h>
#include <math.h>
#include <stdint.h>
#include <cstdio>
namespace cg = cooperative_groups;
namespace pg8 {
#define PG8_LAS __attribute__((address_space(3)))
typedef unsigned short bf16_t;
typedef short bf16x8 __attribute__((ext_vector_type(8)));
typedef float f32x4 __attribute__((ext_vector_type(4)));
typedef unsigned u32x4 __attribute__((ext_vector_type(4)));
constexpr int BM = 256, BK = 64, HALF = 128, HTB = HALF * BK * 2  , STAGE_BYTES = 8 * HTB, NXCD = 8, WGM = 8;

__host__ __device__ __forceinline__ int lds_byte(int r, int c) { const int st = (r >> 4) * 2 + (c >> 5), rr = r & 15, cc = c & 31, ob = rr * 64 + cc * 2; return st * 1024 + (ob ^ (((ob >> 9) & 1) << 5)); }
__host__ __device__ __forceinline__ void stage_rc(int b, int& R, int& C) { const int st = b / 1024, sb = b % 1024, swz = sb ^ (((sb >> 9) & 1) << 5); R = (st >> 1) * 16 + swz / 64; C = (st & 1) * 32 + (swz % 64) / 2; }
__host__ __device__ __forceinline__ int perm32(int rho) { const int n = rho >> 4, i = rho & 15; return 8 * (i >> 2) + 4 * n + (i & 3); }

struct Unit { int pm, pn; };
struct Gemm { const bf16_t* A; const bf16_t* Bt; int M, N, K, lda, ldb; };

struct StaticOrder {
    int nM, nN, nwg, G, c;
    __host__ __device__ void init(int M, int N, int G_, int c_) { nM = M / BM; nN = N / BM; nwg = nM * nN; G = G_; c = c_; }
    __host__ __device__ bool next(int i, Unit& u) const {
        const long L = (long)i * G + c; if (L >= nwg) return false;
        int wgid = (int)L; { const int q = nwg / NXCD, r = nwg % NXCD, xcd = wgid % NXCD, off = wgid / NXCD; wgid = (xcd < r ? xcd * (q + 1) : r * (q + 1) + (xcd - r) * q) + off; }
        const int nig = WGM * nN, gid = wgid / nig, fm = gid * WGM, gsz = (nM - fm) < WGM ? (nM - fm) : WGM;
        u.pm = fm + ((wgid % nig) % gsz); u.pn = (wgid % nig) / gsz; return true;
    }
    __device__ __forceinline__ void a_ready(const Unit&) const {}
    __device__ __forceinline__ void done(const Unit&) const {}
};

__device__ __forceinline__ unsigned cvt_pk_bf16(float lo, float hi) { unsigned r; asm volatile("v_cvt_pk_bf16_f32 %0, %1, %2" : "=v"(r) : "v"(lo), "v"(hi)); return r; }
typedef float f32x2 __attribute__((ext_vector_type(2)));
__device__ __forceinline__ f32x2 gelu_pk(f32x2 v) {
    const f32x2 av = __builtin_elementwise_abs(v), d = av * 0.2316418882f + 1.0f;
    f32x2 t; t.x = __builtin_amdgcn_rcpf(d.x); t.y = __builtin_amdgcn_rcpf(d.y);
    f32x2 q = t * 0.5307027145f + (-0.7265760135f); q = q * t + 0.7107068705f; q = q * t + (-0.142248368f); q = q * t + 0.127414796f; q = q * t;
    const f32x2 s = (v * v) * (-0.72134752044f);
    f32x2 e; e.x = __builtin_amdgcn_exp2f(s.x); e.y = __builtin_amdgcn_exp2f(s.y);
    const f32x2 m = v * (q * e), r = v - m;
    f32x2 o; o.x = v.x < 0.f ? m.x : r.x; o.y = v.y < 0.f ? m.y : r.y; return o;
}

template <int ACT  > struct EpiBf16 {
    static constexpr bool PERM = true, AFTER_DRAIN = false, MID = false; static_assert(ACT == 0 || ACT == 1, "EpiBf16: ACT is 0 (none) or 1 (gelu_pk)");
    bf16_t* O; int ldc; const float* bias; int split_cols; size_t split_stride; float scale0;
    __device__ __forceinline__ void operator()(const f32x4 (&acc)[2][2][4][2], const Unit& u, int wr, int wc, int fr, int fq) const {
        const int row0 = u.pm * BM + wr * 64 + fr; int colt = u.pn * BM; bf16_t* base = O;
        float sc = 1.f; if (split_cols) { const int t = colt / split_cols; base += (size_t)t * split_stride; colt -= t * split_cols; if (t == 0) sc = scale0; }
        const int col0 = colt + wc * 32 + 8 * fq, bcol0 = u.pn * BM + wc * 32 + 8 * fq;
        f32x4 bv[2][2];
#pragma unroll
        for (int bj = 0; bj < 2; ++bj)
#pragma unroll
            for (int n = 0; n < 2; ++n) bv[bj][n] = bias ? *(const f32x4*)(bias + bcol0 + bj * HALF + 4 * n) : (f32x4){0.f, 0.f, 0.f, 0.f};
#pragma unroll
        for (int ai = 0; ai < 2; ++ai)
#pragma unroll
            for (int m = 0; m < 4; ++m) { bf16_t* rowp = base + (size_t)(row0 + ai * HALF + m * 16) * ldc + col0;
#pragma unroll
                for (int bj = 0; bj < 2; ++bj) { f32x4 v0 = acc[ai][bj][m][0] + bv[bj][0], v1 = acc[ai][bj][m][1] + bv[bj][1];
                    if (ACT == 1) { f32x2 a = gelu_pk((f32x2){v0[0], v0[1]}), b = gelu_pk((f32x2){v0[2], v0[3]}), c = gelu_pk((f32x2){v1[0], v1[1]}), d = gelu_pk((f32x2){v1[2], v1[3]});
                        v0 = (f32x4){a.x, a.y, b.x, b.y}; v1 = (f32x4){c.x, c.y, d.x, d.y}; }
                    v0 = v0 * sc; v1 = v1 * sc; u32x4 w; w.x = cvt_pk_bf16(v0[0], v0[1]); w.y = cvt_pk_bf16(v0[2], v0[3]); w.z = cvt_pk_bf16(v1[0], v1[1]); w.w = cvt_pk_bf16(v1[2], v1[3]);
                    *(u32x4*)(rowp + bj * HALF) = w; } }
    }
};

struct EpiF32 {
    static constexpr bool PERM = false, AFTER_DRAIN = false, MID = false;
    float* C; int ldc; const float* bias;
    __device__ __forceinline__ void operator()(const f32x4 (&acc)[2][2][4][2], const Unit& u, int wr, int wc, int fr, int fq) const {
        const int row0 = u.pm * BM + wr * 64 + fr, col0 = u.pn * BM + wc * 32 + 4 * fq;
        f32x4 bv[2][2];
#pragma unroll
        for (int bj = 0; bj < 2; ++bj)
#pragma unroll
            for (int n = 0; n < 2; ++n) bv[bj][n] = bias ? *(const f32x4*)(bias + col0 + bj * HALF + n * 16) : (f32x4){0.f, 0.f, 0.f, 0.f};
#pragma unroll
        for (int ai = 0; ai < 2; ++ai)
#pragma unroll
            for (int m = 0; m < 4; ++m) { float* rowp = C + (size_t)(row0 + ai * HALF + m * 16) * ldc + col0;
#pragma unroll
                for (int bj = 0; bj < 2; ++bj)
#pragma unroll
                    for (int n = 0; n < 2; ++n) *(f32x4*)(rowp + bj * HALF + n * 16) = acc[ai][bj][m][n] + bv[bj][n]; }
    }
};

template <class Epi, class Sched, bool ALIGN_EPI = false, bool SP2 = false>
__device__ __forceinline__ void gemm_phase(PG8_LAS unsigned char* lds, const Gemm g, const Sched& S, const Epi& E, const int tid) {
    const int wid = __builtin_amdgcn_readfirstlane(tid >> 6), lane = tid & 63, wr = wid >> 2, wc = wid & 3, fr = lane & 15, fq = lane >> 4;
    const int K = g.K, nt = K / BK;
    unsigned voffA[2], voffB[2];
#pragma unroll
    for (int i = 0; i < 2; ++i) { int R, C; stage_rc(tid * 16 + i * 8192, R, C); const int Rb = Epi::PERM ? ((R & ~31) + perm32(R & 31)) : R;
        voffA[i] = (unsigned)(R * g.lda + C) * 2u; voffB[i] = (unsigned)(Rb * g.ldb + C) * 2u; }
    const size_t kstep = (size_t)(BK * 2);
    const size_t hstepA = (size_t)HALF * g.lda * 2, hstepB = (size_t)HALF * g.ldb * 2;
    const size_t tstepA = 2 * hstepA, tstepB = 2 * hstepB;
    const unsigned ldsw = (unsigned)wid * 1024u;
    const int aoff = lds_byte(wr * 64 + fr, fq * 8), boff = lds_byte(wc * 32 + fr, fq * 8);
#define PG8_SA(b, h) (((b) * 2 + (h)) * HTB)
#define PG8_SB(b, h) ((4 + (b) * 2 + (h)) * HTB)
#define PG8_STAGE(bufoff, gbase, voff) do { _Pragma("unroll") for (int _i = 0; _i < 2; ++_i) \
        __builtin_amdgcn_global_load_lds((const unsigned*)((const char*)(gbase) + (voff)[_i]), (PG8_LAS unsigned*)(lds + (bufoff) + ldsw + _i * 8192), 16, 0, 0); } while (0)
#define PG8_LDA(dst, b, h) do { _Pragma("unroll") for (int m = 0; m < 4; ++m) _Pragma("unroll") for (int k = 0; k < 2; ++k) dst[m][k] = *(const PG8_LAS bf16x8*)(lds + PG8_SA(b, h) + aoff + m * 2048 + k * 1024); } while (0)
#define PG8_LDB(dst, b, h) do { _Pragma("unroll") for (int n = 0; n < 2; ++n) _Pragma("unroll") for (int k = 0; k < 2; ++k) dst[n][k] = *(const PG8_LAS bf16x8*)(lds + PG8_SB(b, h) + boff + n * 2048 + k * 1024); } while (0)
#define PG8_MMA(ai, bj, At, Bt) do { __builtin_amdgcn_s_setprio(1); _Pragma("unroll") for (int m = 0; m < 4; ++m) _Pragma("unroll") for (int n = 0; n < 2; ++n) _Pragma("unroll") for (int k = 0; k < 2; ++k) \
        acc[ai][bj][m][n] = __builtin_amdgcn_mfma_f32_16x16x32_bf16(Bt[n][k], At[m][k], acc[ai][bj][m][n], 0, 0, 0); __builtin_amdgcn_s_setprio(0); } while (0)
#define PG8_WAIT_V(n) asm volatile("s_waitcnt vmcnt(" #n ")" ::: "memory")
#define PG8_WAIT_L(n) asm volatile("s_waitcnt lgkmcnt(" #n ")" ::: "memory")
#define PG8_BAR __builtin_amdgcn_s_barrier()
#define PG8_SCHED __builtin_amdgcn_sched_barrier(0)
    Unit cur, nxt; int ui = 0;
    if (!S.next(0, cur)) return;
    f32x4 acc[2][2][4][2];
#pragma unroll
    for (int a = 0; a < 2; ++a)
#pragma unroll
        for (int b = 0; b < 2; ++b)
#pragma unroll
            for (int m = 0; m < 4; ++m)
#pragma unroll
                for (int n = 0; n < 2; ++n) acc[a][b][m][n] = (f32x4){0.f, 0.f, 0.f, 0.f};
    bf16x8 At[4][2], B0[2][2], B1[2][2];
    const char* cA = (const char*)g.A + (size_t)cur.pm * tstepA; const char* cB = (const char*)g.Bt + (size_t)cur.pn * tstepB;
    S.a_ready(cur);
    if constexpr (SP2) {
        PG8_STAGE(PG8_SB(0, 0), cB, voffB); PG8_STAGE(PG8_SB(0, 1), cB + hstepB, voffB); PG8_STAGE(PG8_SA(0, 0), cA, voffA); PG8_STAGE(PG8_SA(0, 1), cA + hstepA, voffA);
        if (wr == 1) PG8_BAR;
        PG8_WAIT_V(2); PG8_BAR;
        PG8_STAGE(PG8_SB(1, 0), cB + kstep, voffB); PG8_STAGE(PG8_SA(1, 0), cA + kstep, voffA); PG8_STAGE(PG8_SB(1, 1), cB + hstepB + kstep, voffB);
        PG8_WAIT_V(6); PG8_BAR;
    } else {
        PG8_STAGE(PG8_SB(0, 0), cB, voffB); PG8_STAGE(PG8_SA(0, 0), cA, voffA); PG8_STAGE(PG8_SB(0, 1), cB + hstepB, voffB); PG8_STAGE(PG8_SA(0, 1), cA + hstepA, voffA);
        if (wr == 1) PG8_BAR;
        PG8_WAIT_V(4); PG8_BAR;
        PG8_STAGE(PG8_SB(1, 0), cB + kstep, voffB); PG8_STAGE(PG8_SA(1, 0), cA + kstep, voffA); PG8_STAGE(PG8_SB(1, 1), cB + hstepB + kstep, voffB);
        PG8_WAIT_V(6); PG8_BAR;
    }
    for (;;) {
        const bool has_next = S.next(ui + 1, nxt);
        const char* nA = has_next ? (const char*)g.A + (size_t)nxt.pm * tstepA : cA; const char* nB = has_next ? (const char*)g.Bt + (size_t)nxt.pn * tstepB : cB;
        for (int t = 0; t < nt; t += 2) {
            const bool last = (t == nt - 2);
            const char* a1 = cA + (size_t)(t + 1) * kstep;
            const char* a2 = last ? nA : cA + (size_t)(t + 2) * kstep; const char* b2 = last ? nB : cB + (size_t)(t + 2) * kstep;
            const char* a3 = a2 + kstep; const char* b3 = b2 + kstep;
            if (last && has_next) S.a_ready(nxt);
            if constexpr (Epi::MID) { if (t == (nt >> 1)) E.mid(acc, cur, wr, wc, fr, fq); }
            if constexpr (SP2) {
            PG8_LDB(B0, 0, 0); PG8_LDB(B1, 0, 1); PG8_SCHED; PG8_LDA(At, 0, 0); PG8_STAGE(PG8_SA(1, 1), a1 + hstepA, voffA);
            PG8_WAIT_V(8); PG8_WAIT_L(0); PG8_BAR; PG8_MMA(0, 0, At, B0); PG8_MMA(0, 1, At, B1); PG8_BAR; PG8_SCHED;
            PG8_LDA(At, 0, 1); PG8_STAGE(PG8_SB(0, 0), b2, voffB); PG8_STAGE(PG8_SB(0, 1), b2 + hstepB, voffB); PG8_STAGE(PG8_SA(0, 0), a2, voffA);
            PG8_WAIT_V(8); PG8_WAIT_L(0); PG8_BAR; PG8_MMA(1, 0, At, B0); PG8_MMA(1, 1, At, B1); PG8_BAR; PG8_SCHED;
            PG8_LDB(B0, 1, 0); PG8_LDB(B1, 1, 1); PG8_SCHED; PG8_LDA(At, 1, 0); PG8_STAGE(PG8_SA(0, 1), a2 + hstepA, voffA);
            PG8_WAIT_V(8); PG8_WAIT_L(0); PG8_BAR; PG8_MMA(0, 0, At, B0); PG8_MMA(0, 1, At, B1); PG8_BAR; PG8_SCHED;
            PG8_LDA(At, 1, 1); PG8_STAGE(PG8_SB(1, 0), b3, voffB); PG8_STAGE(PG8_SB(1, 1), b3 + hstepB, voffB); PG8_STAGE(PG8_SA(1, 0), a3, voffA);
            PG8_WAIT_V(8); PG8_WAIT_L(0); PG8_BAR; PG8_MMA(1, 0, At, B0); PG8_MMA(1, 1, At, B1); PG8_BAR; PG8_SCHED;
            } else {
            PG8_LDB(B0, 0, 0); PG8_SCHED; PG8_LDA(At, 0, 0); PG8_STAGE(PG8_SA(1, 1), a1 + hstepA, voffA);
            PG8_WAIT_L(8); PG8_BAR; PG8_WAIT_L(0); PG8_MMA(0, 0, At, B0); PG8_BAR; PG8_SCHED;
            PG8_LDB(B1, 0, 1); PG8_STAGE(PG8_SB(0, 0), b2, voffB);
            PG8_BAR; PG8_WAIT_L(0); PG8_MMA(0, 1, At, B1); PG8_BAR;
            PG8_LDA(At, 0, 1); PG8_STAGE(PG8_SA(0, 0), a2, voffA);
            PG8_BAR; PG8_WAIT_L(0); PG8_MMA(1, 0, At, B0); PG8_BAR; PG8_SCHED;
            PG8_STAGE(PG8_SB(0, 1), b2 + hstepB, voffB);
            PG8_WAIT_V(6); PG8_BAR; PG8_MMA(1, 1, At, B1); PG8_BAR;
            PG8_LDB(B0, 1, 0); PG8_SCHED; PG8_LDA(At, 1, 0); PG8_STAGE(PG8_SA(0, 1), a2 + hstepA, voffA);
            PG8_WAIT_L(8); PG8_BAR; PG8_WAIT_L(0); PG8_MMA(0, 0, At, B0); PG8_BAR; PG8_SCHED;
            PG8_LDB(B1, 1, 1); PG8_STAGE(PG8_SB(1, 0), b3, voffB);
            PG8_BAR; PG8_WAIT_L(0); PG8_MMA(0, 1, At, B1); PG8_BAR;
            PG8_LDA(At, 1, 1); PG8_STAGE(PG8_SA(1, 0), a3, voffA);
            PG8_BAR; PG8_WAIT_L(0); PG8_MMA(1, 0, At, B0); PG8_BAR; PG8_SCHED;
            PG8_STAGE(PG8_SB(1, 1), b3 + hstepB, voffB);
            PG8_WAIT_V(6); PG8_BAR; PG8_MMA(1, 1, At, B1); PG8_BAR;
            }
        }
        if constexpr (ALIGN_EPI) { if (wr == 0) PG8_BAR; }
        if constexpr (!Epi::AFTER_DRAIN) { E(acc, cur, wr, wc, fr, fq); S.done(cur); }
        if (!has_next) break;
#pragma unroll
        for (int a = 0; a < 2; ++a)
#pragma unroll
            for (int b = 0; b < 2; ++b)
#pragma unroll
                for (int m = 0; m < 4; ++m)
#pragma unroll
                    for (int n = 0; n < 2; ++n) acc[a][b][m][n] = (f32x4){0.f, 0.f, 0.f, 0.f};
        cur = nxt; cA = nA; cB = nB; ++ui;
        if constexpr (ALIGN_EPI) { if (wr == 1) PG8_BAR; }
    }
    PG8_WAIT_V(0);
    if constexpr (!ALIGN_EPI) { if (wr == 0) PG8_BAR; }
    PG8_BAR;
    if constexpr (Epi::AFTER_DRAIN) { E.fused(acc, cur, wr, wc, fr, fq, lds, wid, lane); S.done(cur); }
#undef PG8_SA
#undef PG8_SB
#undef PG8_STAGE
#undef PG8_LDA
#undef PG8_LDB
#undef PG8_MMA
#undef PG8_WAIT_V
#undef PG8_WAIT_L
#undef PG8_BAR
#undef PG8_SCHED
}
}
namespace {
constexpr int D = 1024, NB = 4, L = 4096, HW = 1024, SW = 1024, INW = 7168, FH = 2816, FHID = 64, FEMB = 33;
constexpr float EPS = 1e-6f;
typedef unsigned short bf16;
__device__ __forceinline__ unsigned f2bf(float f) { unsigned u = __builtin_bit_cast(unsigned, f); return (u + 0x7fffu + ((u >> 16) & 1u)) >> 16; }
}
namespace {
#define HD __device__ __forceinline__
#define FFT_OPAQUE(w) asm volatile("" : "+v"(w))
#ifndef HD
#define HD inline
#endif
typedef float cf __attribute__((ext_vector_type(2)));
HD cf cmk(float x, float y) { return (cf){x, y}; }
HD cf cadd(cf a, cf b) { return cmk(a.x + b.x, a.y + b.y); }
HD cf csub(cf a, cf b) { return cmk(a.x - b.x, a.y - b.y); }
HD cf cmul(cf a, cf b) { return cmk(a.x * b.x - a.y * b.y, a.x * b.y + a.y * b.x); }
HD cf cconj(cf a) { return cmk(a.x, -a.y); }
template <bool INV> HD cf mulmi(cf a) { return INV ? cmk(-a.y, a.x) : cmk(a.y, -a.x); }
template <bool INV> HD cf twc(float c, float s) { return INV ? cmk(c, s) : cmk(c, -s); }
HD int fpad(int p) { return p + (p >> 4); }
constexpr int FSUB = 4352;

template <bool INV> HD void dft4(cf& a, cf& b, cf& c, cf& d) {
    const cf t0 = cadd(a, c), t1 = csub(a, c), t2 = cadd(b, d), t3 = mulmi<INV>(csub(b, d));
    a = cadd(t0, t2); b = cadd(t1, t3); c = csub(t0, t2); d = csub(t1, t3);
}
template <bool INV> HD void dft16(cf (&v)[16]) {
    constexpr float C1 = 0.92387953251128674f, S1 = 0.38268343236508977f, R = 0.70710678118654752f;
#pragma unroll
    for (int n0 = 0; n0 < 4; ++n0) dft4<INV>(v[n0], v[n0 + 4], v[n0 + 8], v[n0 + 12]);
    v[1 + 4 * 1] = cmul(v[1 + 4 * 1], twc<INV>(C1, S1));
    v[1 + 4 * 2] = cmul(v[1 + 4 * 2], twc<INV>(R, R));
    v[1 + 4 * 3] = cmul(v[1 + 4 * 3], twc<INV>(S1, C1));
    v[2 + 4 * 1] = cmul(v[2 + 4 * 1], twc<INV>(R, R));
    v[2 + 4 * 2] = mulmi<INV>(v[2 + 4 * 2]);
    v[2 + 4 * 3] = cmul(v[2 + 4 * 3], twc<INV>(-R, R));
    v[3 + 4 * 1] = cmul(v[3 + 4 * 1], twc<INV>(S1, C1));
    v[3 + 4 * 2] = cmul(v[3 + 4 * 2], twc<INV>(-R, R));
    v[3 + 4 * 3] = cmul(v[3 + 4 * 3], twc<INV>(-C1, -S1));
#pragma unroll
    for (int k0 = 0; k0 < 4; ++k0) dft4<INV>(v[4 * k0], v[4 * k0 + 1], v[4 * k0 + 2], v[4 * k0 + 3]);
    cf t;
    t = v[1]; v[1] = v[4]; v[4] = t;   t = v[2]; v[2] = v[8]; v[8] = t;   t = v[3]; v[3] = v[12]; v[12] = t;
    t = v[6]; v[6] = v[9]; v[9] = t;   t = v[7]; v[7] = v[13]; v[13] = t; t = v[11]; v[11] = v[14]; v[14] = t;
}
#ifndef FFT_OPAQUE
#define FFT_OPAQUE(w)
#endif
HD void twiddle16(cf (&v)[16], cf w) {
    FFT_OPAQUE(w);
    cf p = w;
#pragma unroll
    for (int k = 1; k < 16; ++k) { v[k] = cmul(v[k], p); if (k < 15) p = cmul(p, w); }
}
template <class P> HD void fwd_pass1(P Z, int t, cf w1) {
    cf v[16]; const int b = t + (t >> 4);
#pragma unroll
    for (int j = 0; j < 16; ++j) v[j] = Z[b + 272 * j];
    dft16<false>(v); twiddle16(v, w1);
#pragma unroll
    for (int j = 0; j < 16; ++j) Z[b + 272 * j] = v[j];
}
template <class P> HD void fwd_pass2(P Z, int t, cf w2) {
    const int b = 272 * (t >> 4) + (t & 15);
    cf v[16];
#pragma unroll
    for (int j = 0; j < 16; ++j) v[j] = Z[b + 17 * j];
    dft16<false>(v); twiddle16(v, w2);
#pragma unroll
    for (int j = 0; j < 16; ++j) Z[b + 17 * j] = v[j];
}
template <class P> HD void fwd_pass3_load(P Z, int t, cf (&v)[16]) {
#pragma unroll
    for (int j = 0; j < 16; ++j) v[j] = Z[17 * t + j];
    dft16<false>(v);
}
template <class P> HD void inv_pass1_store(P Z, int t, cf (&v)[16]) {
    dft16<true>(v);
#pragma unroll
    for (int j = 0; j < 16; ++j) Z[17 * t + j] = v[j];
}
template <class P> HD void inv_pass2(P Z, int t, cf w2) {
    const int b = 272 * (t >> 4) + (t & 15);
    cf v[16];
#pragma unroll
    for (int j = 0; j < 16; ++j) v[j] = Z[b + 17 * j];
    twiddle16(v, cconj(w2)); dft16<true>(v);
#pragma unroll
    for (int j = 0; j < 16; ++j) Z[b + 17 * j] = v[j];
}
template <class P> HD void inv_pass3(P Z, int t, cf w1) {
    cf v[16]; const int b = t + (t >> 4);
#pragma unroll
    for (int j = 0; j < 16; ++j) v[j] = Z[b + 272 * j];
    twiddle16(v, cconj(w1)); dft16<true>(v);
#pragma unroll
    for (int j = 0; j < 16; ++j) Z[b + 272 * j] = v[j];
}
#define LAS __attribute__((address_space(3)))
typedef LAS cf* lcf;
struct HyArgs {
    const bf16* hyT;
    bf16* yaT;
    const float* fsum;
    const float* fdif;
    const float* cw;
    const float* cb;
    const float* skip;
    const cf* T;
    int TS, npairs, off00, off01, off10, off11;
};
__device__ __forceinline__ float bf2f(unsigned h) { return __builtin_bit_cast(float, h << 16); }
__device__ __forceinline__ void conv8(const bf16* row, int n0, float w0, float w1, float w2, float b, float (&o)[8]) {
    const uint4 q = *(const uint4*)(row + n0);
    float x[10];
    x[0] = n0 > 0 ? bf2f(row[n0 - 1]) : 0.f;
    x[9] = n0 + 8 < 4096 ? bf2f(row[n0 + 8]) : 0.f;
    x[1] = bf2f(q.x & 0xffffu); x[2] = bf2f(q.x >> 16); x[3] = bf2f(q.y & 0xffffu); x[4] = bf2f(q.y >> 16);
    x[5] = bf2f(q.z & 0xffffu); x[6] = bf2f(q.z >> 16); x[7] = bf2f(q.w & 0xffffu); x[8] = bf2f(q.w >> 16);
#pragma unroll
    for (int i = 0; i < 8; ++i) o[i] = b + w0 * x[i] + w1 * x[i + 1] + w2 * x[i + 2];
}
__device__ __forceinline__ void hyena_channel(lcf Z, const HyArgs& A, int c, int tid, cf w1, cf w2, cf wp) {
    const int s = tid >> 8, t = tid & 255, n0 = 8 * tid, pb = 8 * tid + (tid >> 1);
    lcf Zs = Z + s * FSUB;
    constexpr float W8C[8] = {1.0f, 0.99999970586f, 0.99999882345f, 0.99999735277f, 0.99999529381f, 0.99999264659f, 0.99998941108f, 0.99998558731f};
    constexpr float W8S[8] = {0.0f, 0.00076699031874f, 0.0015339801863f, 0.0023009691514f, 0.0030679567630f, 0.0038349425697f, 0.0046019261204f, 0.0053689069640f};
    cf tw[8];
#pragma unroll
    for (int i = 0; i < 8; ++i) tw[i] = cmul(wp, cmk(W8C[i], -W8S[i]));
    cf Kr[16];
    {
        const float4 a0 = *(const float4*)(A.fsum + (size_t)c * 4096 + n0), a1 = *(const float4*)(A.fsum + (size_t)c * 4096 + n0 + 4);
        const float4 d0 = *(const float4*)(A.fdif + (size_t)c * 4096 + n0), d1 = *(const float4*)(A.fdif + (size_t)c * 4096 + n0 + 4);
        const float fs[8] = {a0.x, a0.y, a0.z, a0.w, a1.x, a1.y, a1.z, a1.w}, fd[8] = {d0.x, d0.y, d0.z, d0.w, d1.x, d1.y, d1.z, d1.w};
#pragma unroll
        for (int i = 0; i < 8; ++i) { Z[pb + i] = cmk(fs[i], 0.f); Z[FSUB + pb + i] = cmk(fd[i] * tw[i].x, fd[i] * tw[i].y); }
    }
    __syncthreads();
    fwd_pass1(Zs, t, w1); __syncthreads();
    fwd_pass2(Zs, t, w2); __syncthreads();
    fwd_pass3_load(Zs, t, Kr);
#pragma unroll
    for (int j = 0; j < 16; ++j) { Kr[j].x *= (1.0f / 8192.0f); Kr[j].y *= (1.0f / 8192.0f); }
    __syncthreads();
    const float sk = A.skip[c];
    const float cx0 = A.cw[c], cx1 = A.cw[3072 + c], cx2 = A.cw[6144 + c], cxb = A.cb[c];
    const float ca0 = A.cw[1024 + c], ca1 = A.cw[3072 + 1024 + c], ca2 = A.cw[6144 + 1024 + c], cab = A.cb[1024 + c];
    const float cv0 = A.cw[2048 + c], cv1 = A.cw[3072 + 2048 + c], cv2 = A.cw[6144 + 2048 + c], cvb = A.cb[2048 + c];
    for (int p = 0; p < A.npairs; ++p) {
        const int o0 = p ? A.off10 : A.off00, o1 = p ? A.off11 : A.off01;
        float u0[8], u1[8];
        {
            float a[8], b[8];
            conv8(A.hyT + (size_t)(1024 + c) * A.TS + o0, n0, ca0, ca1, ca2, cab, a);
            conv8(A.hyT + (size_t)(2048 + c) * A.TS + o0, n0, cv0, cv1, cv2, cvb, b);
#pragma unroll
            for (int i = 0; i < 8; ++i) u0[i] = a[i] * b[i];
            conv8(A.hyT + (size_t)(1024 + c) * A.TS + o1, n0, ca0, ca1, ca2, cab, a);
            conv8(A.hyT + (size_t)(2048 + c) * A.TS + o1, n0, cv0, cv1, cv2, cvb, b);
#pragma unroll
            for (int i = 0; i < 8; ++i) u1[i] = a[i] * b[i];
        }
#pragma unroll
        for (int i = 0; i < 8; ++i) { const cf z = cmk(u0[i], u1[i]); Z[pb + i] = z; Z[FSUB + pb + i] = cmul(z, tw[i]); }
        __syncthreads();
        fwd_pass1(Zs, t, w1); __syncthreads();
        fwd_pass2(Zs, t, w2); __syncthreads();
        {
            cf v[16];
            fwd_pass3_load(Zs, t, v);
#pragma unroll
            for (int j = 0; j < 16; ++j) v[j] = cmul(v[j], Kr[j]);
            inv_pass1_store(Zs, t, v);
        }
        __syncthreads();
        inv_pass2(Zs, t, w2); __syncthreads();
        inv_pass3(Zs, t, w1); __syncthreads();
        {
            float y0[8], y1[8];
#pragma unroll
            for (int i = 0; i < 8; ++i) { const cf e = Z[pb + i], o = Z[FSUB + pb + i]; const cf y = cadd(e, cmul(o, cconj(tw[i]))); y0[i] = y.x + sk * u0[i]; y1[i] = y.y + sk * u1[i]; }
            float x0c[8];
            conv8(A.hyT + (size_t)c * A.TS + o0, n0, cx0, cx1, cx2, cxb, x0c);
            uint4 w;
            w.x = f2bf(x0c[0] * y0[0]) | (f2bf(x0c[1] * y0[1]) << 16); w.y = f2bf(x0c[2] * y0[2]) | (f2bf(x0c[3] * y0[3]) << 16);
            w.z = f2bf(x0c[4] * y0[4]) | (f2bf(x0c[5] * y0[5]) << 16); w.w = f2bf(x0c[6] * y0[6]) | (f2bf(x0c[7] * y0[7]) << 16);
            *(uint4*)(A.yaT + (size_t)c * A.TS + o0 + n0) = w;
            if (o1 != o0) {
                conv8(A.hyT + (size_t)c * A.TS + o1, n0, cx0, cx1, cx2, cxb, x0c);
                w.x = f2bf(x0c[0] * y1[0]) | (f2bf(x0c[1] * y1[1]) << 16); w.y = f2bf(x0c[2] * y1[2]) | (f2bf(x0c[3] * y1[3]) << 16);
                w.z = f2bf(x0c[4] * y1[4]) | (f2bf(x0c[5] * y1[5]) << 16); w.w = f2bf(x0c[6] * y1[6]) | (f2bf(x0c[7] * y1[7]) << 16);
                *(uint4*)(A.yaT + (size_t)c * A.TS + o1 + n0) = w;
            }
        }
        __syncthreads();
    }
}
__device__ __forceinline__ void hyena_phase(lcf Z, const HyArgs& A, int first, int stride, const int tid) {
    const int t = tid & 255;
    const cf w1 = A.T[2 * t], w2 = A.T[32 * (t & 15)], wp = A.T[8 * tid];
    for (int c = first; c < 1024; c += stride) hyena_channel(Z, A, c, tid, w1, w2, wp);
}

}
namespace pg8 {
__device__ __forceinline__ f32x2 sigmoid_pk(f32x2 v) {
    f32x2 e; e.x = __builtin_amdgcn_exp2f(v.x * -1.4426950408889634f); e.y = __builtin_amdgcn_exp2f(v.y * -1.4426950408889634f);
    f32x2 o; o.x = __builtin_amdgcn_rcpf(1.0f + e.x); o.y = __builtin_amdgcn_rcpf(1.0f + e.y); return o;
}
struct EpiHyT {
    static constexpr bool PERM = true, AFTER_DRAIN = false, MID = false;
    bf16_t* O; int ldc; float* vss;
    __device__ __forceinline__ void operator()(const f32x4 (&acc)[2][2][4][2], const Unit& u, int wr, int wc, int fr, int fq) const {
        const int row0 = u.pm * BM + wr * 64 + fr, col0 = u.pn * BM + wc * 32 + 8 * fq;
        const bool isv = u.pm >= 12;
        f32x4 ss[2][2];
#pragma unroll
        for (int bj = 0; bj < 2; ++bj)
#pragma unroll
            for (int n = 0; n < 2; ++n) ss[bj][n] = (f32x4){0.f, 0.f, 0.f, 0.f};
#pragma unroll
        for (int ai = 0; ai < 2; ++ai)
#pragma unroll
            for (int m = 0; m < 4; ++m) { bf16_t* rowp = O + (size_t)(row0 + ai * HALF + m * 16) * ldc + col0;
#pragma unroll
                for (int bj = 0; bj < 2; ++bj) { f32x4 v0 = acc[ai][bj][m][0], v1 = acc[ai][bj][m][1];
                    if (isv) { f32x2 a = gelu_pk((f32x2){v0[0], v0[1]}), b = gelu_pk((f32x2){v0[2], v0[3]}), c = gelu_pk((f32x2){v1[0], v1[1]}), d = gelu_pk((f32x2){v1[2], v1[3]});
                        v0 = (f32x4){a.x, a.y, b.x, b.y}; v1 = (f32x4){c.x, c.y, d.x, d.y}; ss[bj][0] += v0 * v0; ss[bj][1] += v1 * v1; }
                    u32x4 w; w.x = cvt_pk_bf16(v0[0], v0[1]); w.y = cvt_pk_bf16(v0[2], v0[3]); w.z = cvt_pk_bf16(v1[0], v1[1]); w.w = cvt_pk_bf16(v1[2], v1[3]);
                    *(u32x4*)(rowp + bj * HALF) = w; } }
        if (isv) {
#pragma unroll
            for (int bj = 0; bj < 2; ++bj)
#pragma unroll
                for (int n = 0; n < 2; ++n)
#pragma unroll
                    for (int j = 0; j < 4; ++j) { float s = ss[bj][n][j]; s += __shfl_xor(s, 1); s += __shfl_xor(s, 2); s += __shfl_xor(s, 4); s += __shfl_xor(s, 8);
                        if (fr == 0) atomicAdd(vss + col0 + bj * HALF + 4 * n + j, s); }
        }
    }
};
struct EpiUG {
    static constexpr bool PERM = true, AFTER_DRAIN = false, MID = false;
    bf16_t* U; bf16_t* G; int ldu;
    __device__ __forceinline__ void operator()(const f32x4 (&acc)[2][2][4][2], const Unit& u, int wr, int wc, int fr, int fq) const {
        const int row0 = u.pm * BM + wr * 64 + fr; int colt = u.pn * BM; const bool isu = colt < 1024;
        bf16_t* base = isu ? U : G; const int ldc = isu ? ldu : 2048; if (!isu) colt -= 1024;
        const int col0 = colt + wc * 32 + 8 * fq;
#pragma unroll
        for (int ai = 0; ai < 2; ++ai)
#pragma unroll
            for (int m = 0; m < 4; ++m) { bf16_t* rowp = base + (size_t)(row0 + ai * HALF + m * 16) * ldc + col0;
#pragma unroll
                for (int bj = 0; bj < 2; ++bj) { f32x4 v0 = acc[ai][bj][m][0], v1 = acc[ai][bj][m][1];
                    f32x2 a, b, c, d;
                    if (isu) { a = gelu_pk((f32x2){v0[0], v0[1]}); b = gelu_pk((f32x2){v0[2], v0[3]}); c = gelu_pk((f32x2){v1[0], v1[1]}); d = gelu_pk((f32x2){v1[2], v1[3]}); }
                    else { a = sigmoid_pk((f32x2){v0[0], v0[1]}); b = sigmoid_pk((f32x2){v0[2], v0[3]}); c = sigmoid_pk((f32x2){v1[0], v1[1]}); d = sigmoid_pk((f32x2){v1[2], v1[3]}); }
                    u32x4 w; w.x = cvt_pk_bf16(a.x, a.y); w.y = cvt_pk_bf16(b.x, b.y); w.z = cvt_pk_bf16(c.x, c.y); w.w = cvt_pk_bf16(d.x, d.y);
                    *(u32x4*)(rowp + bj * HALF) = w; } }
    }
};
}
namespace {
struct WJob { const float* W; const float* g; bf16* dst; int K, N, c0, nc, ldd, r0, koff, pad; };
constexpr int NWJ = 9;
struct WJobs { WJob j[NWJ]; };
__device__ __forceinline__ unsigned pk2(float lo, float hi) { return f2bf(lo) | (f2bf(hi) << 16); }
__device__ __forceinline__ void wT_item(const WJob& J, LAS float* scr, int item, int lane) {
    const int nblk = J.nc / 32, kb = item / nblk, nb = item % nblk, k0 = 64 * kb, n0 = 32 * nb;
    float v[32];
#pragma unroll
    for (int i = 0; i < 32; ++i) v[i] = J.W[(size_t)(k0 + 2 * i + (lane >> 5)) * J.N + J.c0 + n0 + (lane & 31)];
    if (J.g) {
#pragma unroll
        for (int i = 0; i < 32; ++i) v[i] *= J.g[k0 + 2 * i + (lane >> 5)]; }
#pragma unroll
    for (int i = 0; i < 32; ++i) scr[(2 * i + (lane >> 5)) * 33 + (lane & 31)] = v[i];
    asm volatile("s_waitcnt lgkmcnt(0)" ::: "memory");
    const int c = lane & 7;
#pragma unroll
    for (int j = 0; j < 4; ++j) { const int n = (lane >> 3) + 8 * j; const LAS float* s = scr + (8 * c) * 33 + n;
        uint4 o; o.x = pk2(s[0 * 33], s[1 * 33]); o.y = pk2(s[2 * 33], s[3 * 33]); o.z = pk2(s[4 * 33], s[5 * 33]); o.w = pk2(s[6 * 33], s[7 * 33]);
        *(uint4*)(J.dst + (size_t)(J.r0 + n0 + n) * J.ldd + J.koff + k0 + 8 * c) = o; }
    asm volatile("s_waitcnt lgkmcnt(0)" ::: "memory");
}
__device__ __forceinline__ void p0_weights(const WJobs& WJ, int jlo, int jhi, LAS float* scr, int gw, int NGW, int lane) {
    int base = 0;
    for (int q = jlo; q < jhi; ++q) {
        const WJob& J = WJ.j[q]; const int ni = (J.K / 64) * (J.nc / 32);
        int it = gw - (base % NGW); if (it < 0) it += NGW;
        for (; it < ni; it += NGW) wT_item(J, scr, it, lane);
        base += ni;
    }
}
__device__ __forceinline__ float wave_sum(float v) {
#pragma unroll
    for (int o = 1; o < 64; o <<= 1) v += __shfl_xor(v, o);
    return v;
}
__device__ __forceinline__ void rms_row_to_bf16(const float* xrow, const float* g, bf16* orow, int lane) {
    const float4* xr = (const float4*)xrow + lane; const float4* gr = (const float4*)g + lane;
    float4 v[4]; float s = 0.f;
#pragma unroll
    for (int j = 0; j < 4; ++j) { v[j] = xr[64 * j]; s += (v[j].x * v[j].x + v[j].y * v[j].y) + (v[j].z * v[j].z + v[j].w * v[j].w); }
    const float r = rsqrtf(wave_sum(s) * (1.f / 1024.f) + EPS);
    unsigned long long* o8 = (unsigned long long*)orow + lane;
#pragma unroll
    for (int j = 0; j < 4; ++j) { const float4 gg = gr[64 * j];
        o8[64 * j] = (unsigned long long)pk2(v[j].x * r * gg.x, v[j].y * r * gg.y) | ((unsigned long long)pk2(v[j].z * r * gg.z, v[j].w * r * gg.w) << 32); }
}
__device__ __forceinline__ void rms_rows4_to_bf16(const float* xrow, const float* g, bf16* orow, int ldo, int lane) {
    float4 v[4][4]; float s[4];
#pragma unroll
    for (int r = 0; r < 4; ++r)
#pragma unroll
        for (int j = 0; j < 4; ++j) v[r][j] = ((const float4*)(xrow + (size_t)r * 1024) + lane)[64 * j];
#pragma unroll
    for (int r = 0; r < 4; ++r) { s[r] = 0.f;
#pragma unroll
        for (int j = 0; j < 4; ++j) s[r] += (v[r][j].x * v[r][j].x + v[r][j].y * v[r][j].y) + (v[r][j].z * v[r][j].z + v[r][j].w * v[r][j].w); }
#pragma unroll
    for (int r = 0; r < 4; ++r) { const float rr = rsqrtf(wave_sum(s[r]) * (1.f / 1024.f) + EPS);
        unsigned long long* o8 = (unsigned long long*)(orow + (size_t)r * ldo) + lane;
#pragma unroll
        for (int j = 0; j < 4; ++j) { const float4 gg = ((const float4*)g + lane)[64 * j];
            o8[64 * j] = (unsigned long long)pk2(v[r][j].x * rr * gg.x, v[r][j].y * rr * gg.y) | ((unsigned long long)pk2(v[r][j].z * rr * gg.z, v[r][j].w * rr * gg.w) << 32); } }
}
}

namespace {
struct SguArgs {
    const bf16* vT;
    bf16* U;
    const float* vss;
    const float* ws;
    const float* bs;
    const float* gn;
    int TS, ldu;
};
typedef short bf16x8_t __attribute__((ext_vector_type(8)));
typedef float f32x4_t __attribute__((ext_vector_type(4)));
__device__ __forceinline__ void sgu_item(LAS unsigned char* lds, const SguArgs& A, int item, int tid) {
    const int g = item & 7, ch = item >> 3, tok0 = ch * 128;
    const int wave = tid >> 6, lane = tid & 63, fr = lane & 15, fq = lane >> 4;
#pragma unroll
    for (int j = 0; j < 4; ++j) { const int idx = tid + 512 * j, d = idx >> 4, chunk = idx & 15;
        const pg8::u32x4 v = *(const pg8::u32x4*)(A.vT + (size_t)(g * 128 + d) * A.TS + tok0 + chunk * 8);
        *(LAS pg8::u32x4*)(lds + d * 272 + chunk * 16) = v; }
    bf16x8_t af[4];
    const int p = 16 * wave + fr;
#pragma unroll
    for (int kk = 0; kk < 4; ++kk) { const int q = 32 * kk + 8 * fq;
        const float4 w0 = *(const float4*)(A.ws + ((size_t)g * 128 + p) * 128 + q), w1 = *(const float4*)(A.ws + ((size_t)g * 128 + p) * 128 + q + 4);
        const float4 s0 = *(const float4*)(A.vss + tok0 + q), s1 = *(const float4*)(A.vss + tok0 + q + 4);
        const float r0 = rsqrtf(s0.x * (1.f / 1024.f) + EPS), r1 = rsqrtf(s0.y * (1.f / 1024.f) + EPS), r2 = rsqrtf(s0.z * (1.f / 1024.f) + EPS), r3 = rsqrtf(s0.w * (1.f / 1024.f) + EPS);
        const float r4 = rsqrtf(s1.x * (1.f / 1024.f) + EPS), r5 = rsqrtf(s1.y * (1.f / 1024.f) + EPS), r6 = rsqrtf(s1.z * (1.f / 1024.f) + EPS), r7 = rsqrtf(s1.w * (1.f / 1024.f) + EPS);
        uint4 o; o.x = pk2(w0.x * r0, w0.y * r1); o.y = pk2(w0.z * r2, w0.w * r3); o.z = pk2(w1.x * r4, w1.y * r5); o.w = pk2(w1.z * r6, w1.w * r7);
        af[kk] = __builtin_bit_cast(bf16x8_t, o); }
    const float bsp = A.bs[g * 128 + p];
    bf16* urow = A.U + (size_t)(tok0 + p) * A.ldu + g * 128 + 4 * fq;
    const float* gnp = A.gn + g * 128 + 4 * fq;
    uint2 uq[8];
#pragma unroll
    for (int nt = 0; nt < 8; ++nt) uq[nt] = *(const uint2*)(urow + 16 * nt);
    __syncthreads();
    f32x4_t acc[8];
#pragma unroll
    for (int nt = 0; nt < 8; ++nt) acc[nt] = (f32x4_t){0.f, 0.f, 0.f, 0.f};
#pragma unroll
    for (int kk = 0; kk < 4; ++kk) {
        bf16x8_t bfr[8];
#pragma unroll
        for (int nt = 0; nt < 8; ++nt) bfr[nt] = *(const LAS bf16x8_t*)(lds + (16 * nt + fr) * 272 + (32 * kk + 8 * fq) * 2);
#pragma unroll
        for (int nt = 0; nt < 8; ++nt) acc[nt] = __builtin_amdgcn_mfma_f32_16x16x32_bf16(bfr[nt], af[kk], acc[nt], 0, 0, 0);
    }
#pragma unroll
    for (int nt = 0; nt < 8; ++nt) {
        const uint2 uu = uq[nt];
        const float4 gv = *(const float4*)(gnp + 16 * nt);
        const float y0 = bf2f(uu.x & 0xffffu) * (gv.x * acc[nt][0] + bsp), y1 = bf2f(uu.x >> 16) * (gv.y * acc[nt][1] + bsp);
        const float y2 = bf2f(uu.y & 0xffffu) * (gv.z * acc[nt][2] + bsp), y3 = bf2f(uu.y >> 16) * (gv.w * acc[nt][3] + bsp);
        uint2 o; o.x = pk2(y0, y1); o.y = pk2(y2, y3);
        *(uint2*)(urow + 16 * nt) = o;
    }
    __syncthreads();
}
}

namespace pg8 {
__device__ __forceinline__ void bf8_to_f32(const u32x4 q, f32x4& lo, f32x4& hi) {
    lo = (f32x4){__builtin_bit_cast(float, q.x << 16), __builtin_bit_cast(float, q.x & 0xffff0000u), __builtin_bit_cast(float, q.y << 16), __builtin_bit_cast(float, q.y & 0xffff0000u)};
    hi = (f32x4){__builtin_bit_cast(float, q.z << 16), __builtin_bit_cast(float, q.z & 0xffff0000u), __builtin_bit_cast(float, q.w << 16), __builtin_bit_cast(float, q.w & 0xffff0000u)};
}
struct EpiMerge {
    static constexpr bool PERM = true, AFTER_DRAIN = false, MID = true;
    const bf16_t* G; bf16_t* O;
    __device__ __forceinline__ void mid(f32x4 (&acc)[2][2][4][2], const Unit& u, int wr, int wc, int fr, int fq) const {
        unsigned off0 = (unsigned)(u.pm * BM + wr * 64 + fr) * 2048u + (unsigned)(u.pn * BM + wc * 32 + 8 * fq);
        asm volatile("" : "+v"(off0));
#pragma unroll
        for (int ai = 0; ai < 2; ++ai)
#pragma unroll
            for (int m = 0; m < 4; ++m)
#pragma unroll
                for (int bj = 0; bj < 2; ++bj) { const bf16_t* gp = G + (off0 + (unsigned)((ai * HALF + m * 16) * 2048 + bj * HALF));
                    const u32x4 qa = *(const u32x4*)gp, qb = *(const u32x4*)(gp + 1024);
                    f32x4 a0, a1, b0, b1; bf8_to_f32(qa, a0, a1); bf8_to_f32(qb, b0, b1);
#pragma unroll
                    for (int j = 0; j < 4; ++j) { acc[ai][bj][m][0][j] *= a0[j] * __builtin_amdgcn_rcpf(b0[j]); acc[ai][bj][m][1][j] *= a1[j] * __builtin_amdgcn_rcpf(b1[j]); }
                    asm volatile("" ::: "memory"); }
    }
    __device__ __forceinline__ void operator()(const f32x4 (&acc)[2][2][4][2], const Unit& u, int wr, int wc, int fr, int fq) const {
        const int row0 = u.pm * BM + wr * 64 + fr, col0 = u.pn * BM + wc * 32 + 8 * fq;
#pragma unroll
        for (int ai = 0; ai < 2; ++ai)
#pragma unroll
            for (int m = 0; m < 4; ++m) { const size_t r = (size_t)(row0 + ai * HALF + m * 16);
#pragma unroll
                for (int bj = 0; bj < 2; ++bj) { f32x4 b0, b1; bf8_to_f32(*(const u32x4*)(G + r * 2048 + 1024 + col0 + bj * HALF), b0, b1);
                    const f32x4 v0 = acc[ai][bj][m][0] * b0, v1 = acc[ai][bj][m][1] * b1;
                    u32x4 w; w.x = cvt_pk_bf16(v0[0], v0[1]); w.y = cvt_pk_bf16(v0[2], v0[3]); w.z = cvt_pk_bf16(v1[0], v1[1]); w.w = cvt_pk_bf16(v1[2], v1[3]);
                    *(u32x4*)(O + r * 1024 + col0 + bj * HALF) = w; } }
    }
};
}
namespace {
__device__ __forceinline__ void tr64_item(const bf16* yaT, int TS, bf16* out, int ldo, LAS unsigned short* scr, int c0, int t0, int lane) {
#pragma unroll
    for (int i = 0; i < 8; ++i) { const int r = 8 * i + (lane >> 3), ch = lane & 7;
        const pg8::u32x4 q = *(const pg8::u32x4*)(yaT + (size_t)(c0 + r) * TS + t0 + 8 * ch);
        LAS unsigned short* d = scr + (8 * ch) * 72 + r;
        d[0 * 72] = (unsigned short)(q.x & 0xffffu); d[1 * 72] = (unsigned short)(q.x >> 16); d[2 * 72] = (unsigned short)(q.y & 0xffffu); d[3 * 72] = (unsigned short)(q.y >> 16);
        d[4 * 72] = (unsigned short)(q.z & 0xffffu); d[5 * 72] = (unsigned short)(q.z >> 16); d[6 * 72] = (unsigned short)(q.w & 0xffffu); d[7 * 72] = (unsigned short)(q.w >> 16); }
    asm volatile("s_waitcnt lgkmcnt(0)" ::: "memory");
#pragma unroll
    for (int i = 0; i < 8; ++i) { const int tk = 8 * i + (lane >> 3), ch = lane & 7;
        const pg8::u32x4 q = *(const LAS pg8::u32x4*)(scr + tk * 72 + 8 * ch);
        *(pg8::u32x4*)(out + (size_t)(t0 + tk) * ldo + c0 + 8 * ch) = q; }
    asm volatile("s_waitcnt lgkmcnt(0)" ::: "memory");
}
__device__ __forceinline__ void transpose_ya(const bf16* yaT, int TS, bf16* out, int ldo, LAS unsigned short* scr, int gw, int NGW, int lane) {
    const int ntt = TS / 64, nit = 16 * ntt;
    for (int it = gw; it < nit; it += NGW) tr64_item(yaT, TS, out, ldo, scr, 64 * (it / ntt), 64 * (it % ntt), lane);
}
}

namespace pg8 {
template <bool FIRST> struct EpiResid {
    static constexpr bool PERM = false, AFTER_DRAIN = false, MID = false;
    const float* X; const bf16_t* XB; float* X1; bf16_t* X1b; float* xss;
    __device__ __forceinline__ void operator()(const f32x4 (&acc)[2][2][4][2], const Unit& u, int wr, int wc, int fr, int fq) const {
        const int row0 = u.pm * BM + wr * 64 + fr, col0 = u.pn * BM + wc * 32 + 4 * fq;
        typedef unsigned u32x2v __attribute__((ext_vector_type(2)));
#pragma unroll
        for (int ai = 0; ai < 2; ++ai)
#pragma unroll
            for (int m = 0; m < 4; ++m) { const size_t r = (size_t)(row0 + ai * HALF + m * 16); float s = 0.f;
#pragma unroll
                for (int bj = 0; bj < 2; ++bj)
#pragma unroll
                    for (int n = 0; n < 2; ++n) { const size_t o = r * 1024 + col0 + bj * HALF + n * 16;
                        f32x4 v;
                        if (FIRST) v = acc[ai][bj][m][n] + *(const f32x4*)(X + o);
                        else { const u32x2v q = *(const u32x2v*)(XB + o);
                               v = acc[ai][bj][m][n] + (f32x4){__builtin_bit_cast(float, q.x << 16), __builtin_bit_cast(float, q.x & 0xffff0000u), __builtin_bit_cast(float, q.y << 16), __builtin_bit_cast(float, q.y & 0xffff0000u)}; }
                        if (FIRST) { u32x2v w; w.x = cvt_pk_bf16(v[0], v[1]); w.y = cvt_pk_bf16(v[2], v[3]); *(u32x2v*)(X1b + o) = w; }
                        else *(f32x4*)(X1 + o) = v;
                        s += (v[0] * v[0] + v[1] * v[1]) + (v[2] * v[2] + v[3] * v[3]); }
                s += __shfl_xor(s, 16); s += __shfl_xor(s, 32);
                if (fq == 0) atomicAdd(xss + r, s);
                asm volatile("" ::: "memory"); }
    }
};
struct EpiUp {
    static constexpr bool PERM = true, AFTER_DRAIN = false, MID = false;
    bf16_t* AP; bf16_t* GP; const float* xss;
    __device__ __forceinline__ void operator()(const f32x4 (&acc)[2][2][4][2], const Unit& u, int wr, int wc, int fr, int fq) const {
        const int row0 = u.pm * BM + wr * 64 + fr; int colt = u.pn * BM; const bool isg = colt >= 2816;
        bf16_t* base = isg ? GP : AP; if (isg) colt -= 2816;
        const int col0 = colt + wc * 32 + 8 * fq;
#pragma unroll
        for (int ai = 0; ai < 2; ++ai)
#pragma unroll
            for (int m = 0; m < 4; ++m) { const size_t r = (size_t)(row0 + ai * HALF + m * 16); const float rs = rsqrtf(xss[r] * (1.0f / 1024.0f) + 1e-6f);
#pragma unroll
                for (int bj = 0; bj < 2; ++bj) { const f32x4 v0 = acc[ai][bj][m][0] * rs, v1 = acc[ai][bj][m][1] * rs;
                    u32x4 w; w.x = cvt_pk_bf16(v0[0], v0[1]); w.y = cvt_pk_bf16(v0[2], v0[3]); w.z = cvt_pk_bf16(v1[0], v1[1]); w.w = cvt_pk_bf16(v1[2], v1[3]);
                    *(u32x4*)(base + r * 2816 + col0 + bj * HALF) = w; } }
    }
};
}
namespace {
__device__ __forceinline__ void act_pass(const bf16* AP, bf16* GP, const float* cw, const float* cb, int TS, int gid, int gstride) {
    const int nitems = (TS / 16) * 352;
    const pg8::u32x4 zq = {0u, 0u, 0u, 0u};
    for (int it = gid; it < nitems; it += gstride) {
        const int run = it / 352, ch = it % 352, t0 = run * 16, c0 = ch * 8;
        const pg8::f32x4 w0l = *(const pg8::f32x4*)(cw + c0), w0h = *(const pg8::f32x4*)(cw + c0 + 4);
        const pg8::f32x4 w1l = *(const pg8::f32x4*)(cw + 2816 + c0), w1h = *(const pg8::f32x4*)(cw + 2816 + c0 + 4);
        const pg8::f32x4 w2l = *(const pg8::f32x4*)(cw + 5632 + c0), w2h = *(const pg8::f32x4*)(cw + 5632 + c0 + 4);
        const pg8::f32x4 bl = *(const pg8::f32x4*)(cb + c0), bh = *(const pg8::f32x4*)(cb + c0 + 4);
        const bf16* ap = AP + (size_t)t0 * 2816 + c0; bf16* gp = GP + (size_t)t0 * 2816 + c0;
        pg8::u32x4 qa[6];
        qa[0] = (t0 & 4095) != 0 ? *(const pg8::u32x4*)(ap - 2816) : zq;
        qa[1] = *(const pg8::u32x4*)ap;
#pragma unroll 1
        for (int i = 0; i < 16; i += 4) {
            pg8::u32x4 qg[4];
#pragma unroll
            for (int k = 0; k < 4; ++k) { const int t = t0 + i + k;
                qa[2 + k] = (t & 4095) != 4095 ? *(const pg8::u32x4*)(ap + (size_t)(i + k + 1) * 2816) : zq;
                qg[k] = *(const pg8::u32x4*)(gp + (size_t)(i + k) * 2816); }
#pragma unroll
            for (int k = 0; k < 4; ++k) {
                pg8::f32x4 pl, ph, cl, chh, nl, nh, gl, gh;
                pg8::bf8_to_f32(qa[k], pl, ph); pg8::bf8_to_f32(qa[k + 1], cl, chh); pg8::bf8_to_f32(qa[k + 2], nl, nh); pg8::bf8_to_f32(qg[k], gl, gh);
                const pg8::f32x4 sl = bl + w0l * pl + w1l * cl + w2l * nl, sh = bh + w0h * ph + w1h * chh + w2h * nh;
                pg8::f32x4 ol, oh;
#pragma unroll
                for (int j = 0; j < 4; ++j) { ol[j] = sl[j] * __builtin_amdgcn_rcpf(1.0f + __builtin_amdgcn_exp2f(sl[j] * -1.4426950408889634f)) * gl[j];
                                              oh[j] = sh[j] * __builtin_amdgcn_rcpf(1.0f + __builtin_amdgcn_exp2f(sh[j] * -1.4426950408889634f)) * gh[j]; }
                pg8::u32x4 w; w.x = pg8::cvt_pk_bf16(ol[0], ol[1]); w.y = pg8::cvt_pk_bf16(ol[2], ol[3]); w.z = pg8::cvt_pk_bf16(oh[0], oh[1]); w.w = pg8::cvt_pk_bf16(oh[2], oh[3]);
                *(pg8::u32x4*)(gp + (size_t)(i + k) * 2816) = w;
            }
            qa[0] = qa[4]; qa[1] = qa[5];
        }
    }
}
__device__ __forceinline__ void final_norm(const float* X2, const float* ss, const float* g, float* out, int TS, int gw, int NGW, int lane) {
    for (int t = gw; t < TS; t += NGW) {
        const float r = rsqrtf(ss[t] * (1.0f / 1024.0f) + EPS);
#pragma unroll
        for (int j = 0; j < 4; ++j) { const pg8::f32x4 v = *((const pg8::f32x4*)(X2 + (size_t)t * 1024) + lane + 64 * j), gg = *((const pg8::f32x4*)g + lane + 64 * j);
            *((pg8::f32x4*)(out + (size_t)t * 1024) + lane + 64 * j) = v * gg * r; }
    }
}
}

namespace {
constexpr int MLPW_W2 = 33 * 64, MLPW_W3 = MLPW_W2 + 4096, MLPW_B = MLPW_W3 + 4096, MLPW_N = MLPW_B + 256;
__device__ __forceinline__ float filt_z(int l, int j) {
    if (j == 0) return (float)((double)l / (double)(L - 1));
    const int i = (j - 1) & 15;
    const double band = 1e-4 + (double)i * ((15.0 - 1e-4) / 15.0);
    double rev = (double)l * band / (double)L;
    rev -= floor(rev);
    const float ang = (float)(rev * 6.283185307179586);
    return (j <= 16) ? cosf(ang) : -sinf(ang);
}
__device__ __forceinline__ void filter_mlp_rows2(const LAS float* wl, float* h3out, LAS float* scr, int l0, int l1, int j) {
    LAS float* za = scr; LAS float* zb = scr + 64;
    if (j < FEMB) { za[j] = filt_z(l0, j); zb[j] = filt_z(l1, j); }
    asm volatile("s_waitcnt lgkmcnt(0)" ::: "memory");
    const float a = wl[MLPW_B + 192 + j];
    float s0 = wl[MLPW_B + j], s1 = s0;
#pragma unroll 11
    for (int i = 0; i < FEMB; ++i) { const float w = wl[i * 64 + j]; s0 += za[i] * w; s1 += zb[i] * w; }
    asm volatile("s_waitcnt lgkmcnt(0)" ::: "memory");
    za[j] = sinf(a * s0); zb[j] = sinf(a * s1);
    asm volatile("s_waitcnt lgkmcnt(0)" ::: "memory");
    s0 = wl[MLPW_B + 64 + j]; s1 = s0;
#pragma unroll 8
    for (int i = 0; i < FHID; ++i) { const float w = wl[MLPW_W2 + i * 64 + j]; s0 += za[i] * w; s1 += zb[i] * w; }
    asm volatile("s_waitcnt lgkmcnt(0)" ::: "memory");
    za[j] = sinf(a * s0); zb[j] = sinf(a * s1);
    asm volatile("s_waitcnt lgkmcnt(0)" ::: "memory");
    s0 = wl[MLPW_B + 128 + j]; s1 = s0;
#pragma unroll 8
    for (int i = 0; i < FHID; ++i) { const float w = wl[MLPW_W3 + i * 64 + j]; s0 += za[i] * w; s1 += zb[i] * w; }
    h3out[l0 * FHID + j] = sinf(a * s0); h3out[l1 * FHID + j] = sinf(a * s1);
    asm volatile("s_waitcnt lgkmcnt(0)" ::: "memory");
}
__device__ __forceinline__ void stage_h3_tile(const float* h3, int row0, LAS float* scr, int lane) {
#pragma unroll
    for (int i = 0; i < 16; ++i) { const int e = 4 * (lane + 64 * i), r = e >> 6, jj = e & 63;
        if (row0 + r < 4096) { const pg8::f32x4 v = *(const pg8::f32x4*)(h3 + (size_t)(row0 + r) * 64 + jj);
            LAS float* d = scr + r * 65 + jj; d[0] = v[0]; d[1] = v[1]; d[2] = v[2]; d[3] = v[3]; } }
    asm volatile("s_waitcnt lgkmcnt(0)" ::: "memory");
}
__device__ __forceinline__ void filter_tables(const float* h3, const float* w4, const float* decay, float* fsum, float* fdif, LAS float* scr, int gw, int NGW, int lane) {
    for (int it = gw; it < 2048; it += NGW) {
        const int n0 = (it & 63) * 64, n = n0 + lane, c0 = (it >> 6) * 32, nb = n ? 4096 - n : 0;
        float sf[32], sb[32];
#pragma unroll
        for (int cc = 0; cc < 32; ++cc) { sf[cc] = 0.f; sb[cc] = 0.f; }
        float wv[32];
#pragma unroll
        for (int q = 0; q < 8; ++q) { const pg8::f32x4 t4 = *(const pg8::f32x4*)(w4 + lane * 2048 + c0 + 4 * q); wv[4 * q] = t4[0]; wv[4 * q + 1] = t4[1]; wv[4 * q + 2] = t4[2]; wv[4 * q + 3] = t4[3]; }
        stage_h3_tile(h3, n0, scr, lane);
#pragma unroll 4
        for (int j = 0; j < FHID; ++j) { const float hn = scr[lane * 65 + j];
#pragma unroll
            for (int cc = 0; cc < 32; ++cc) sf[cc] += hn * __builtin_bit_cast(float, __builtin_amdgcn_readlane(__builtin_bit_cast(int, wv[cc]), j)); }
        asm volatile("s_waitcnt lgkmcnt(0)" ::: "memory");
#pragma unroll
        for (int q = 0; q < 8; ++q) { const pg8::f32x4 t4 = *(const pg8::f32x4*)(w4 + lane * 2048 + 1024 + c0 + 4 * q); wv[4 * q] = t4[0]; wv[4 * q + 1] = t4[1]; wv[4 * q + 2] = t4[2]; wv[4 * q + 3] = t4[3]; }
        stage_h3_tile(h3, 4096 - n0 - 63, scr, lane);
#pragma unroll 4
        for (int j = 0; j < FHID; ++j) { const float hm = scr[(63 - lane) * 65 + j];
#pragma unroll
            for (int cc = 0; cc < 32; ++cc) sb[cc] += hm * __builtin_bit_cast(float, __builtin_amdgcn_readlane(__builtin_bit_cast(int, wv[cc]), j)); }
        asm volatile("s_waitcnt lgkmcnt(0)" ::: "memory");
        const float tf = (float)((double)n / (double)(L - 1)), tb = (float)((double)nb / (double)(L - 1));
#pragma unroll
        for (int cc = 0; cc < 32; ++cc) {
            const float hf = sf[cc] * expf(-tf * fabsf(decay[c0 + cc]));
            const float hb = n ? sb[cc] * expf(-tb * fabsf(decay[1024 + c0 + cc])) : 0.f;
            fsum[(size_t)(c0 + cc) * 4096 + n] = hf + hb;
            fdif[(size_t)(c0 + cc) * 4096 + n] = hf - hb;
        }
    }
}
#define RLX_AGENT __ATOMIC_RELAXED, __HIP_MEMORY_SCOPE_AGENT
#define XB_TMO      128
#define XB_XCNT(j)  (256  + 64 * (j))
#define XB_XSUB(j)  (1280 + 64 * (j))
#define XB_XGEN(j)  (2304 + 64 * (j))
#define XB_TOP      3328
#define XB_TOPGEN   3392
#define XCD_BAR_WORDS 3456
#define XB_SPIN_CAP (1u << 18)

__device__ __forceinline__ unsigned xb_ld(unsigned* p)              { return __hip_atomic_load(p, __ATOMIC_RELAXED, __HIP_MEMORY_SCOPE_AGENT); }
__device__ __forceinline__ unsigned xb_add(unsigned* p, unsigned v) { return __hip_atomic_fetch_add(p, v, __ATOMIC_RELAXED, __HIP_MEMORY_SCOPE_AGENT); }
__device__ __forceinline__ unsigned xb_xcc_id() { return (unsigned)__builtin_amdgcn_s_getreg((3 << 11) | 20) & 0xFu; }
#define XB_SPIN(cond, bar) do { unsigned _sp = 0; while (cond) { __builtin_amdgcn_s_sleep(1); \
    if ((++_sp & 255u) == 0u) { if (xb_ld(&(bar)[XB_TMO])) break; if (_sp > XB_SPIN_CAP) { atomicAdd(&(bar)[XB_TMO], 1u); break; } } } } while (0)

struct XcdBarrier {
    unsigned* bar; unsigned x;
    volatile LAS unsigned* st;
};

__device__ __forceinline__ XcdBarrier xcd_barrier_post(unsigned* bar, volatile LAS unsigned* st) {
    XcdBarrier b; b.bar = bar; b.x = xb_xcc_id(); b.st = st;
    if (threadIdx.x == 0) (void)xb_add(&bar[XB_XCNT(b.x)], 1u);
    return b;
}
__device__ __forceinline__ void xcd_barrier_complete(unsigned* bar, unsigned x, unsigned& nloc, unsigned& nx) {
    const unsigned G = gridDim.x * gridDim.y * gridDim.z;
    unsigned sum, cnt, mine, sp = 0u;
    for (;;) {
        sum = 0u; cnt = 0u; mine = 0u;
#pragma unroll
        for (unsigned j = 0; j < 16; ++j) { const unsigned c = xb_ld(&bar[XB_XCNT(j)]); sum += c; cnt += (c > 0u) ? 1u : 0u; mine = (j == x) ? c : mine; }
        if (sum == G) break;
        __builtin_amdgcn_s_sleep(1);
        if ((++sp & 255u) == 0u) { if (xb_ld(&bar[XB_TMO])) break; if (sp > XB_SPIN_CAP) { atomicAdd(&bar[XB_TMO], 1u); break; } }
    }
    nloc = mine > 0u ? mine : 1u; nx = cnt > 0u ? cnt : 1u;
}

__device__ __forceinline__ void xcd_barrier(const XcdBarrier& b) {
    asm volatile("s_waitcnt vmcnt(0)" ::: "memory");
    __syncthreads();
    if (threadIdx.x == 0) {
        unsigned* bar = b.bar;
        __builtin_amdgcn_s_waitcnt(0);
        unsigned nloc = b.st[0], nx = b.st[1];
        if (nloc == 0u) { xcd_barrier_complete(bar, b.x, nloc, nx); b.st[0] = nloc; b.st[1] = nx; }
        const unsigned old = xb_add(&bar[XB_XSUB(b.x)], 1u);
        const unsigned gen = old / nloc;
        if (old + 1u == (gen + 1u) * nloc) {
            __builtin_amdgcn_fence(__ATOMIC_RELEASE, "agent");
            asm volatile("s_waitcnt vmcnt(0)" ::: "memory");
            const unsigned og = xb_add(&bar[XB_TOP], 1u);
            const unsigned tg = og / nx;
            if (og + 1u == (tg + 1u) * nx) xb_add(&bar[XB_TOPGEN], 1u);
            else XB_SPIN(xb_ld(&bar[XB_TOPGEN]) == tg, bar);
            __builtin_amdgcn_fence(__ATOMIC_ACQUIRE, "agent");
            xb_add(&bar[XB_XGEN(b.x)], 1u);
            asm volatile("s_waitcnt vmcnt(0)" ::: "memory");
        } else {
            XB_SPIN(xb_ld(&bar[XB_XGEN(b.x)]) == gen, bar);
            __builtin_amdgcn_fence(__ATOMIC_ACQUIRE, "agent");
            asm volatile("s_waitcnt vmcnt(0)" ::: "memory");
        }
    }
    __syncthreads();
}

constexpr size_t MiB = 1u << 20;
constexpr int M = NB * L;
constexpr size_t WS_VSS = 0, WS_XSS = 64 * 1024, WS_X2SS = 128 * 1024, WS_TTAB = 192 * 1024, WS_BAR = 256 * 1024, WS_H3 = 1 * MiB;
constexpr size_t WS_WTA = 2 * MiB, WS_WTB = 10 * MiB, WS_PAB = 16 * MiB, WS_WO = 20 * MiB;
constexpr size_t WS_FSUM = 24 * MiB, WS_WUP = 24 * MiB, WS_WDN = 35 * MiB;
constexpr size_t WS_HYT = 41 * MiB;
constexpr size_t WS_X1B = 41 * MiB, WS_MRG = 105 * MiB;
constexpr size_t WS_YAB = 169 * MiB;
constexpr size_t WS_FDIF = 233 * MiB;
constexpr size_t WS_AP = 73 * MiB, WS_GP = 161 * MiB;
static_assert(WS_GP + (size_t)M * FH * 2 <= 256 * MiB && WS_AP + (size_t)M * FH * 2 <= WS_GP && WS_FDIF + 16 * MiB <= 256 * MiB && WS_WDN + (size_t)D * FH * 2 <= WS_HYT, "d_ws map");
constexpr int LDS_BYTES = 147456;
constexpr int NPH = 10;

struct MegaArgs { const float* in[27]; float* out; unsigned char* ws; int ph_lo, ph_hi; WJobs wj; };

__global__ void __launch_bounds__(512, 2) mega_fwd(MegaArgs a) {
    extern __shared__ __attribute__((aligned(16))) unsigned char lds_raw[];
    LAS unsigned char* lds = (LAS unsigned char*)lds_raw;
    cg::grid_group grid = cg::this_grid();
    const int wave = __builtin_amdgcn_readfirstlane((int)threadIdx.x >> 6);
    const int G = gridDim.x, bid = blockIdx.x, gw = bid * 8 + wave, NGW = G * 8;
#define FRESH_TID int lane; asm volatile("v_mbcnt_lo_u32_b32 %0, -1, 0\n\tv_mbcnt_hi_u32_b32 %0, -1, %0" : "=v"(lane)); const int tid = wave * 64 + lane; (void)tid
    unsigned char* ws = a.ws;
    const float* x = a.in[0];
    float* vss = (float*)(ws + WS_VSS); float* xss = (float*)(ws + WS_XSS); float* x2ss = (float*)(ws + WS_X2SS);
    cf* Ttab = (cf*)(ws + WS_TTAB); float* h3 = (float*)(ws + WS_H3);
    bf16* WtA = (bf16*)(ws + WS_WTA); bf16* WtB = (bf16*)(ws + WS_WTB); bf16* PabT = (bf16*)(ws + WS_PAB); bf16* WoT = (bf16*)(ws + WS_WO);
    bf16* WupT = (bf16*)(ws + WS_WUP); bf16* WdnT = (bf16*)(ws + WS_WDN);
    float* fsum = (float*)(ws + WS_FSUM); float* fdif = (float*)(ws + WS_FDIF);
    bf16* hyvT = (bf16*)(ws + WS_HYT); bf16* yaT = hyvT + (size_t)1024 * M; bf16* vT = hyvT + (size_t)3072 * M;
    bf16* YAB = (bf16*)(ws + WS_YAB); bf16* h1 = YAB; bf16* Ub = YAB + 1024;
    bf16* Gb = (bf16*)a.out;
    bf16* mrg = (bf16*)(ws + WS_MRG); bf16* X1b = (bf16*)(ws + WS_X1B); float* X1 = a.out;
    bf16* APb = (bf16*)(ws + WS_AP); bf16* GPb = (bf16*)(ws + WS_GP);
    const int lo = a.ph_lo, hi = a.ph_hi;
#define IN(k) (lo <= (k) && (k) < hi)
    for (int u = (int)threadIdx.x; u < 16; u += 512) ((LAS unsigned*)(lds + LDS_BYTES - 256))[u] = 0u;
    __syncthreads();
    XcdBarrier xbar = xcd_barrier_post((unsigned*)(ws + WS_BAR), (volatile LAS unsigned*)(lds + LDS_BYTES - 256));
#ifdef MK_PROBE
#define STAMP(i) do { if (threadIdx.x == 0) ((volatile LAS unsigned long long*)(lds + LDS_BYTES - 128))[i] = __builtin_amdgcn_s_memrealtime(); } while (0)
#else
#define STAMP(i) do { } while (0)
#endif
    STAMP(0);
#define SEAM(k) do { if (IN(k) && IN((k) + 1)) { if ((k) == 0) grid.sync(); else xcd_barrier(xbar); } STAMP((k) + 1); } while (0)

    if (IN(0)) { FRESH_TID;
        p0_weights(a.wj, 0, 7, (LAS float*)lds + wave * 4096, gw, NGW, lane);
        for (int m = 4 * gw; m < M; m += 4 * NGW) rms_rows4_to_bf16(x + (size_t)m * 1024, a.in[1], h1 + (size_t)m * 2048, 2048, lane);
        for (int i = bid * 512 + tid; i < 3 * M; i += G * 512) vss[i] = 0.f;
        __syncthreads();
        { LAS float* wl = (LAS float*)lds;
          for (int i = tid; i < MLPW_N; i += 512) { float v;
              if (i < MLPW_W2) v = a.in[5][i]; else if (i < MLPW_W3) v = a.in[7][i - MLPW_W2]; else if (i < MLPW_B) v = a.in[9][i - MLPW_W3];
              else { const int q = i - MLPW_B; v = q < 64 ? a.in[6][q] : q < 128 ? a.in[8][q - 64] : q < 192 ? a.in[10][q - 128] : a.in[11][q - 192]; }
              wl[i] = v; }
          __syncthreads();
          for (int l = 2 * gw; l < L; l += 2 * NGW) filter_mlp_rows2(wl, h3, (LAS float*)(lds + 65536) + wave * 128, l, l + 1, lane); }
        for (int m = bid * 512 + tid; m < 4096; m += G * 512) { const float ang = (float)m / 4096.0f; Ttab[m] = cmk(cospif(ang), -sinpif(ang)); }
    }
    SEAM(0);
    if (IN(1)) { FRESH_TID;
        { pg8::Gemm g{WtA, h1, 4096, M, 1024, 1024, 2048}; pg8::StaticOrder S; S.init(4096, M, G, bid);
          pg8::EpiHyT E{hyvT, M, vss};
          pg8::gemm_phase<pg8::EpiHyT, pg8::StaticOrder, true, true>(lds, g, S, E, tid); }
        STAMP(11);
        { pg8::Gemm g{h1, WtB, M, 3072, 1024, 2048, 1024}; pg8::StaticOrder S; S.init(M, 3072, G, bid);
          pg8::EpiUG E{Ub, Gb, 2048};
          pg8::gemm_phase<pg8::EpiUG, pg8::StaticOrder, true, true>(lds, g, S, E, tid); }
        STAMP(12);
        filter_tables(h3, a.in[12], a.in[13], fsum, fdif, (LAS float*)(lds + wave * 17408), gw, NGW, lane);
    }
    SEAM(1);
    if (IN(2)) { FRESH_TID;
        HyArgs H; H.hyT = hyvT; H.yaT = yaT; H.fsum = fsum; H.fdif = fdif; H.cw = a.in[3]; H.cb = a.in[4]; H.skip = a.in[14]; H.T = Ttab;
        H.TS = M; H.npairs = 2; H.off00 = 0; H.off01 = L; H.off10 = 2 * L; H.off11 = 3 * L;
        hyena_phase((lcf)lds, H, bid, G, tid);
        STAMP(13);
        SguArgs Sg; Sg.vT = vT; Sg.U = Ub; Sg.vss = vss; Sg.ws = a.in[16]; Sg.bs = a.in[17]; Sg.gn = a.in[15]; Sg.TS = M; Sg.ldu = 2048;
        for (int it = bid; it < (M / 128) * 8; it += G) sgu_item(lds, Sg, it, tid);
    }
    SEAM(2);
    if (IN(3)) { FRESH_TID;
        transpose_ya(yaT, M, YAB, 2048, (LAS unsigned short*)lds + wave * 8192, gw, NGW, lane);
        p0_weights(a.wj, 7, 9, (LAS float*)lds + wave * 4096, gw, NGW, lane);
    }
    SEAM(3);
    if (IN(4)) { FRESH_TID;
        pg8::Gemm g{YAB, PabT, M, 1024, 2048, 2048, 2048}; pg8::StaticOrder S; S.init(M, 1024, G, bid);
        pg8::EpiMerge E{Gb, mrg};
        pg8::gemm_phase<pg8::EpiMerge, pg8::StaticOrder, true, true>(lds, g, S, E, tid);
    }
    SEAM(4);
    if (IN(5)) { FRESH_TID;
        pg8::Gemm g{mrg, WoT, M, 1024, 1024, 1024, 1024}; pg8::StaticOrder S; S.init(M, 1024, G, bid);
        pg8::EpiResid<true> E{x, nullptr, nullptr, X1b, xss};
        pg8::gemm_phase<pg8::EpiResid<true>, pg8::StaticOrder, true, true>(lds, g, S, E, tid);
    }
    SEAM(5);
    if (IN(6)) { FRESH_TID;
        pg8::Gemm g{X1b, WupT, M, 2 * FH, 1024, 1024, 1024}; pg8::StaticOrder S; S.init(M, 2 * FH, G, bid);
        pg8::EpiUp E{APb, GPb, xss};
        pg8::gemm_phase<pg8::EpiUp, pg8::StaticOrder, true, true>(lds, g, S, E, tid);
    }
    SEAM(6);
    if (IN(7)) { FRESH_TID; act_pass(APb, GPb, a.in[23], a.in[24], M, bid * 512 + tid, G * 512); }
    SEAM(7);
    if (IN(8)) { FRESH_TID;
        pg8::Gemm g{GPb, WdnT, M, 1024, FH, FH, FH}; pg8::StaticOrder S; S.init(M, 1024, G, bid);
        pg8::EpiResid<false> E{nullptr, X1b, X1, nullptr, x2ss};
        pg8::gemm_phase<pg8::EpiResid<false>, pg8::StaticOrder, true, true>(lds, g, S, E, tid);
    }
    SEAM(8);
    if (IN(9)) { FRESH_TID; final_norm(X1, x2ss, a.in[26], a.out, M, gw, NGW, lane); }
    STAMP(10);
#ifdef MK_PROBE
#ifndef MK_PROBE_A
#define MK_PROBE_A MK_PROBE
#define MK_PROBE_B (MK_PROBE + 1)
#endif
    if (threadIdx.x == 0) { volatile LAS unsigned long long* ts = (volatile LAS unsigned long long*)(lds + LDS_BYTES - 128);
        const unsigned long long dt = 2ull * (ts[MK_PROBE_B] - ts[MK_PROBE_A]), t0 = __builtin_amdgcn_s_memrealtime();
        while (__builtin_amdgcn_s_memrealtime() - t0 < dt) __builtin_amdgcn_s_sleep(8); }
    __syncthreads();
#endif
#undef IN
#undef SEAM
}
}

#ifndef MK_CUTS
#define MK_CUTS 0
#endif
extern "C" void kernel_launch(void* const* d_in, const int* in_sizes, int n_in, void* d_out, int out_size, void* d_ws, size_t ws_size, hipStream_t stream) {
    static int grid = 0;
    if (grid == 0) {
        int dev = 0, cus = 0, per_cu = 0;
        hipGetDevice(&dev);
        hipDeviceGetAttribute(&cus, hipDeviceAttributeMultiprocessorCount, dev);
        hipFuncSetAttribute((const void*)mega_fwd, hipFuncAttributeMaxDynamicSharedMemorySize, LDS_BYTES);
        hipOccupancyMaxActiveBlocksPerMultiprocessor(&per_cu, (const void*)mega_fwd, 512, LDS_BYTES);
        if (per_cu < 1) { fprintf(stderr, "kernel_launch: occupancy query says %d blocks per CU\n", per_cu); per_cu = 1; }
        grid = cus * 1;
        (void)hipGetLastError();
    }
    hipMemsetAsync((char*)d_ws + WS_BAR, 0, XCD_BAR_WORDS * 4, stream);
    MegaArgs a{};
    for (int i = 0; i < 27; ++i) a.in[i] = (const float*)d_in[i];
    a.out = (float*)d_out; a.ws = (unsigned char*)d_ws;
    { unsigned char* ws = (unsigned char*)d_ws;
      bf16* WtA = (bf16*)(ws + WS_WTA); bf16* WtB = (bf16*)(ws + WS_WTB); bf16* PabT = (bf16*)(ws + WS_PAB); bf16* WoT = (bf16*)(ws + WS_WO); bf16* WupT = (bf16*)(ws + WS_WUP); bf16* WdnT = (bf16*)(ws + WS_WDN);
    a.wj.j[0] = WJob{(const float*)d_in[2], nullptr, WtA, 1024, INW, 0, 3072, 1024, 0, 0, 0};
    a.wj.j[1] = WJob{(const float*)d_in[2], nullptr, WtA, 1024, INW, 4096, 1024, 1024, 3072, 0, 0};
    a.wj.j[2] = WJob{(const float*)d_in[2], nullptr, WtB, 1024, INW, 3072, 1024, 1024, 0, 0, 0};
    a.wj.j[3] = WJob{(const float*)d_in[2], nullptr, WtB, 1024, INW, 5120, 2048, 1024, 1024, 0, 0};
    a.wj.j[4] = WJob{(const float*)d_in[18], nullptr, PabT, 1024, 1024, 0, 1024, 2048, 0, 0, 0};
    a.wj.j[5] = WJob{(const float*)d_in[19], nullptr, PabT, 1024, 1024, 0, 1024, 2048, 0, 1024, 0};
    a.wj.j[6] = WJob{(const float*)d_in[20], nullptr, WoT, 1024, 1024, 0, 1024, 1024, 0, 0, 0};
    a.wj.j[7] = WJob{(const float*)d_in[22], (const float*)d_in[21], WupT, 1024, 2 * FH, 0, 2 * FH, 1024, 0, 0, 0};
    a.wj.j[8] = WJob{(const float*)d_in[25], nullptr, WdnT, FH, 1024, 0, 1024, FH, 0, 0, 0};

    }
#if MK_CUTS
    for (int p = 0; p < NPH; ++p) { a.ph_lo = p; a.ph_hi = p + 1; hipLaunchKernelGGL(mega_fwd, dim3(grid), dim3(512), LDS_BYTES, stream, a); }
#else
    a.ph_lo = 0; a.ph_hi = NPH;
    void* args[] = {&a};
    hipError_t e = hipLaunchCooperativeKernel((const void*)mega_fwd, dim3(grid), dim3(512), args, LDS_BYTES, stream);
    if (e != hipSuccess) fprintf(stderr, "cooperative launch failed: %s (grid %d)\n", hipGetErrorString(e), grid);
#endif
}
```

```cpp
#include <hip/hip_runtime.h>
#include <hip/hip_cooperative_groups.h>
#include <math.h>
#include <stdint.h>
#include <cstdio>
namespace cg = cooperative_groups;
namespace pg8 {
#define PG8_LAS __attribute__((address_space(3)))
typedef unsigned short bf16_t;
typedef short bf16x8 __attribute__((ext_vector_type(8)));
typedef float f32x4 __attribute__((ext_vector_type(4)));
typedef unsigned u32x4 __attribute__((ext_vector_type(4)));
constexpr int BM = 256, BK = 64, HALF = 128, HTB = HALF * BK * 2  , STAGE_BYTES = 8 * HTB, NXCD = 8, WGM = 8;

__host__ __device__ __forceinline__ int lds_byte(int r, int c) { const int st = (r >> 4) * 2 + (c >> 5), rr = r & 15, cc = c & 31, ob = rr * 64 + cc * 2; return st * 1024 + (ob ^ (((ob >> 9) & 1) << 5)); }
__host__ __device__ __forceinline__ void stage_rc(int b, int& R, int& C) { const int st = b / 1024, sb = b % 1024, swz = sb ^ (((sb >> 9) & 1) << 5); R = (st >> 1) * 16 + swz / 64; C = (st & 1) * 32 + (swz % 64) / 2; }
__host__ __device__ __forceinline__ int perm32(int rho) { const int n = rho >> 4, i = rho & 15; return 8 * (i >> 2) + 4 * n + (i & 3); }

struct Unit { int pm, pn; };
struct Gemm { const bf16_t* A; const bf16_t* Bt; int M, N, K, lda, ldb; };

struct StaticOrder {
    int nM, nN, nwg, G, c;
    __host__ __device__ void init(int M, int N, int G_, int c_) { nM = M / BM; nN = N / BM; nwg = nM * nN; G = G_; c = c_; }
    __host__ __device__ bool next(int i, Unit& u) const {
        const long L = (long)i * G + c; if (L >= nwg) return false;
        int wgid = (int)L; { const int q = nwg / NXCD, r = nwg % NXCD, xcd = wgid % NXCD, off = wgid / NXCD; wgid = (xcd < r ? xcd * (q + 1) : r * (q + 1) + (xcd - r) * q) + off; }
        const int nig = WGM * nN, gid = wgid / nig, fm = gid * WGM, gsz = (nM - fm) < WGM ? (nM - fm) : WGM;
        u.pm = fm + ((wgid % nig) % gsz); u.pn = (wgid % nig) / gsz; return true;
    }
    __device__ __forceinline__ void a_ready(const Unit&) const {}
    __device__ __forceinline__ void done(const Unit&) const {}
};

__device__ __forceinline__ unsigned cvt_pk_bf16(float lo, float hi) { unsigned r; asm volatile("v_cvt_pk_bf16_f32 %0, %1, %2" : "=v"(r) : "v"(lo), "v"(hi)); return r; }
typedef float f32x2 __attribute__((ext_vector_type(2)));
__device__ __forceinline__ f32x2 gelu_pk(f32x2 v) {
    const f32x2 av = __builtin_elementwise_abs(v), d = av * 0.2316418882f + 1.0f;
    f32x2 t; t.x = __builtin_amdgcn_rcpf(d.x); t.y = __builtin_amdgcn_rcpf(d.y);
    f32x2 q = t * 0.5307027145f + (-0.7265760135f); q = q * t + 0.7107068705f; q = q * t + (-0.142248368f); q = q * t + 0.127414796f; q = q * t;
    const f32x2 s = (v * v) * (-0.72134752044f);
    f32x2 e; e.x = __builtin_amdgcn_exp2f(s.x); e.y = __builtin_amdgcn_exp2f(s.y);
    const f32x2 m = v * (q * e), r = v - m;
    f32x2 o; o.x = v.x < 0.f ? m.x : r.x; o.y = v.y < 0.f ? m.y : r.y; return o;
}

template <int ACT  > struct EpiBf16 {
    static constexpr bool PERM = true, AFTER_DRAIN = false, MID = false; static_assert(ACT == 0 || ACT == 1, "EpiBf16: ACT is 0 (none) or 1 (gelu_pk)");
    bf16_t* O; int ldc; const float* bias; int split_cols; size_t split_stride; float scale0;
    __device__ __forceinline__ void operator()(const f32x4 (&acc)[2][2][4][2], const Unit& u, int wr, int wc, int fr, int fq) const {
        const int row0 = u.pm * BM + wr * 64 + fr; int colt = u.pn * BM; bf16_t* base = O;
        float sc = 1.f; if (split_cols) { const int t = colt / split_cols; base += (size_t)t * split_stride; colt -= t * split_cols; if (t == 0) sc = scale0; }
        const int col0 = colt + wc * 32 + 8 * fq, bcol0 = u.pn * BM + wc * 32 + 8 * fq;
        f32x4 bv[2][2];
#pragma unroll
        for (int bj = 0; bj < 2; ++bj)
#pragma unroll
            for (int n = 0; n < 2; ++n) bv[bj][n] = bias ? *(const f32x4*)(bias + bcol0 + bj * HALF + 4 * n) : (f32x4){0.f, 0.f, 0.f, 0.f};
#pragma unroll
        for (int ai = 0; ai < 2; ++ai)
#pragma unroll
            for (int m = 0; m < 4; ++m) { bf16_t* rowp = base + (size_t)(row0 + ai * HALF + m * 16) * ldc + col0;
#pragma unroll
                for (int bj = 0; bj < 2; ++bj) { f32x4 v0 = acc[ai][bj][m][0] + bv[bj][0], v1 = acc[ai][bj][m][1] + bv[bj][1];
                    if (ACT == 1) { f32x2 a = gelu_pk((f32x2){v0[0], v0[1]}), b = gelu_pk((f32x2){v0[2], v0[3]}), c = gelu_pk((f32x2){v1[0], v1[1]}), d = gelu_pk((f32x2){v1[2], v1[3]});
                        v0 = (f32x4){a.x, a.y, b.x, b.y}; v1 = (f32x4){c.x, c.y, d.x, d.y}; }
                    v0 = v0 * sc; v1 = v1 * sc; u32x4 w; w.x = cvt_pk_bf16(v0[0], v0[1]); w.y = cvt_pk_bf16(v0[2], v0[3]); w.z = cvt_pk_bf16(v1[0], v1[1]); w.w = cvt_pk_bf16(v1[2], v1[3]);
                    *(u32x4*)(rowp + bj * HALF) = w; } }
    }
};

struct EpiF32 {
    static constexpr bool PERM = false, AFTER_DRAIN = false, MID = false;
    float* C; int ldc; const float* bias;
    __device__ __forceinline__ void operator()(const f32x4 (&acc)[2][2][4][2], const Unit& u, int wr, int wc, int fr, int fq) const {
        const int row0 = u.pm * BM + wr * 64 + fr, col0 = u.pn * BM + wc * 32 + 4 * fq;
        f32x4 bv[2][2];
#pragma unroll
        for (int bj = 0; bj < 2; ++bj)
#pragma unroll
            for (int n = 0; n < 2; ++n) bv[bj][n] = bias ? *(const f32x4*)(bias + col0 + bj * HALF + n * 16) : (f32x4){0.f, 0.f, 0.f, 0.f};
#pragma unroll
        for (int ai = 0; ai < 2; ++ai)
#pragma unroll
            for (int m = 0; m < 4; ++m) { float* rowp = C + (size_t)(row0 + ai * HALF + m * 16) * ldc + col0;
#pragma unroll
                for (int bj = 0; bj < 2; ++bj)
#pragma unroll
                    for (int n = 0; n < 2; ++n) *(f32x4*)(rowp + bj * HALF + n * 16) = acc[ai][bj][m][n] + bv[bj][n]; }
    }
};

template <class Epi, class Sched, bool ALIGN_EPI = false, bool SP2 = false>
__device__ __forceinline__ void gemm_phase(PG8_LAS unsigned char* lds, const Gemm g, const Sched& S, const Epi& E, const int tid) {
    const int wid = __builtin_amdgcn_readfirstlane(tid >> 6), lane = tid & 63, wr = wid >> 2, wc = wid & 3, fr = lane & 15, fq = lane >> 4;
    const int K = g.K, nt = K / BK;
    unsigned voffA[2], voffB[2];
#pragma unroll
    for (int i = 0; i < 2; ++i) { int R, C; stage_rc(tid * 16 + i * 8192, R, C); const int Rb = Epi::PERM ? ((R & ~31) + perm32(R & 31)) : R;
        voffA[i] = (unsigned)(R * g.lda + C) * 2u; voffB[i] = (unsigned)(Rb * g.ldb + C) * 2u; }
    const size_t kstep = (size_t)(BK * 2);
    const size_t hstepA = (size_t)HALF * g.lda * 2, hstepB = (size_t)HALF * g.ldb * 2;
    const size_t tstepA = 2 * hstepA, tstepB = 2 * hstepB;
    const unsigned ldsw = (unsigned)wid * 1024u;
    const int aoff = lds_byte(wr * 64 + fr, fq * 8), boff = lds_byte(wc * 32 + fr, fq * 8);
#define PG8_SA(b, h) (((b) * 2 + (h)) * HTB)
#define PG8_SB(b, h) ((4 + (b) * 2 + (h)) * HTB)
#define PG8_STAGE(bufoff, gbase, voff) do { _Pragma("unroll") for (int _i = 0; _i < 2; ++_i) \
        __builtin_amdgcn_global_load_lds((const unsigned*)((const char*)(gbase) + (voff)[_i]), (PG8_LAS unsigned*)(lds + (bufoff) + ldsw + _i * 8192), 16, 0, 0); } while (0)
#define PG8_LDA(dst, b, h) do { _Pragma("unroll") for (int m = 0; m < 4; ++m) _Pragma("unroll") for (int k = 0; k < 2; ++k) dst[m][k] = *(const PG8_LAS bf16x8*)(lds + PG8_SA(b, h) + aoff + m * 2048 + k * 1024); } while (0)
#define PG8_LDB(dst, b, h) do { _Pragma("unroll") for (int n = 0; n < 2; ++n) _Pragma("unroll") for (int k = 0; k < 2; ++k) dst[n][k] = *(const PG8_LAS bf16x8*)(lds + PG8_SB(b, h) + boff + n * 2048 + k * 1024); } while (0)
#define PG8_MMA(ai, bj, At, Bt) do { __builtin_amdgcn_s_setprio(1); _Pragma("unroll") for (int m = 0; m < 4; ++m) _Pragma("unroll") for (int n = 0; n < 2; ++n) _Pragma("unroll") for (int k = 0; k < 2; ++k) \
        acc[ai][bj][m][n] = __builtin_amdgcn_mfma_f32_16x16x32_bf16(Bt[n][k], At[m][k], acc[ai][bj][m][n], 0, 0, 0); __builtin_amdgcn_s_setprio(0); } while (0)
#define PG8_WAIT_V(n) asm volatile("s_waitcnt vmcnt(" #n ")" ::: "memory")
#define PG8_WAIT_L(n) asm volatile("s_waitcnt lgkmcnt(" #n ")" ::: "memory")
#define PG8_BAR __builtin_amdgcn_s_barrier()
#define PG8_SCHED __builtin_amdgcn_sched_barrier(0)
    Unit cur, nxt; int ui = 0;
    if (!S.next(0, cur)) return;
    f32x4 acc[2][2][4][2];
#pragma unroll
    for (int a = 0; a < 2; ++a)
#pragma unroll
        for (int b = 0; b < 2; ++b)
#pragma unroll
            for (int m = 0; m < 4; ++m)
#pragma unroll
                for (int n = 0; n < 2; ++n) acc[a][b][m][n] = (f32x4){0.f, 0.f, 0.f, 0.f};
    bf16x8 At[4][2], B0[2][2], B1[2][2];
    const char* cA = (const char*)g.A + (size_t)cur.pm * tstepA; const char* cB = (const char*)g.Bt + (size_t)cur.pn * tstepB;
    S.a_ready(cur);
    if constexpr (SP2) {
        PG8_STAGE(PG8_SB(0, 0), cB, voffB); PG8_STAGE(PG8_SB(0, 1), cB + hstepB, voffB); PG8_STAGE(PG8_SA(0, 0), cA, voffA); PG8_STAGE(PG8_SA(0, 1), cA + hstepA, voffA);
        if (wr == 1) PG8_BAR;
        PG8_WAIT_V(2); PG8_BAR;
        PG8_STAGE(PG8_SB(1, 0), cB + kstep, voffB); PG8_STAGE(PG8_SA(1, 0), cA + kstep, voffA); PG8_STAGE(PG8_SB(1, 1), cB + hstepB + kstep, voffB);
        PG8_WAIT_V(6); PG8_BAR;
    } else {
        PG8_STAGE(PG8_SB(0, 0), cB, voffB); PG8_STAGE(PG8_SA(0, 0), cA, voffA); PG8_STAGE(PG8_SB(0, 1), cB + hstepB, voffB); PG8_STAGE(PG8_SA(0, 1), cA + hstepA, voffA);
        if (wr == 1) PG8_BAR;
        PG8_WAIT_V(4); PG8_BAR;
        PG8_STAGE(PG8_SB(1, 0), cB + kstep, voffB); PG8_STAGE(PG8_SA(1, 0), cA + kstep, voffA); PG8_STAGE(PG8_SB(1, 1), cB + hstepB + kstep, voffB);
        PG8_WAIT_V(6); PG8_BAR;
    }
    for (;;) {
        const bool has_next = S.next(ui + 1, nxt);
        const char* nA = has_next ? (const char*)g.A + (size_t)nxt.pm * tstepA : cA; const char* nB = has_next ? (const char*)g.Bt + (size_t)nxt.pn * tstepB : cB;
        for (int t = 0; t < nt; t += 2) {
            const bool last = (t == nt - 2);
            const char* a1 = cA + (size_t)(t + 1) * kstep;
            const char* a2 = last ? nA : cA + (size_t)(t + 2) * kstep; const char* b2 = last ? nB : cB + (size_t)(t + 2) * kstep;
            const char* a3 = a2 + kstep; const char* b3 = b2 + kstep;
            if (last && has_next) S.a_ready(nxt);
            if constexpr (Epi::MID) { if (t == (nt >> 1)) E.mid(acc, cur, wr, wc, fr, fq); }
            if constexpr (SP2) {
            PG8_LDB(B0, 0, 0); PG8_LDB(B1, 0, 1); PG8_SCHED; PG8_LDA(At, 0, 0); PG8_STAGE(PG8_SA(1, 1), a1 + hstepA, voffA);
            PG8_WAIT_V(8); PG8_WAIT_L(0); PG8_BAR; PG8_MMA(0, 0, At, B0); PG8_MMA(0, 1, At, B1); PG8_BAR; PG8_SCHED;
            PG8_LDA(At, 0, 1); PG8_STAGE(PG8_SB(0, 0), b2, voffB); PG8_STAGE(PG8_SB(0, 1), b2 + hstepB, voffB); PG8_STAGE(PG8_SA(0, 0), a2, voffA);
            PG8_WAIT_V(8); PG8_WAIT_L(0); PG8_BAR; PG8_MMA(1, 0, At, B0); PG8_MMA(1, 1, At, B1); PG8_BAR; PG8_SCHED;
            PG8_LDB(B0, 1, 0); PG8_LDB(B1, 1, 1); PG8_SCHED; PG8_LDA(At, 1, 0); PG8_STAGE(PG8_SA(0, 1), a2 + hstepA, voffA);
            PG8_WAIT_V(8); PG8_WAIT_L(0); PG8_BAR; PG8_MMA(0, 0, At, B0); PG8_MMA(0, 1, At, B1); PG8_BAR; PG8_SCHED;
            PG8_LDA(At, 1, 1); PG8_STAGE(PG8_SB(1, 0), b3, voffB); PG8_STAGE(PG8_SB(1, 1), b3 + hstepB, voffB); PG8_STAGE(PG8_SA(1, 0), a3, voffA);
            PG8_WAIT_V(8); PG8_WAIT_L(0); PG8_BAR; PG8_MMA(1, 0, At, B0); PG8_MMA(1, 1, At, B1); PG8_BAR; PG8_SCHED;
            } else {
            PG8_LDB(B0, 0, 0); PG8_SCHED; PG8_LDA(At, 0, 0); PG8_STAGE(PG8_SA(1, 1), a1 + hstepA, voffA);
            PG8_WAIT_L(8); PG8_BAR; PG8_WAIT_L(0); PG8_MMA(0, 0, At, B0); PG8_BAR; PG8_SCHED;
            PG8_LDB(B1, 0, 1); PG8_STAGE(PG8_SB(0, 0), b2, voffB);
            PG8_BAR; PG8_WAIT_L(0); PG8_MMA(0, 1, At, B1); PG8_BAR;
            PG8_LDA(At, 0, 1); PG8_STAGE(PG8_SA(0, 0), a2, voffA);
            PG8_BAR; PG8_WAIT_L(0); PG8_MMA(1, 0, At, B0); PG8_BAR; PG8_SCHED;
            PG8_STAGE(PG8_SB(0, 1), b2 + hstepB, voffB);
            PG8_WAIT_V(6); PG8_BAR; PG8_MMA(1, 1, At, B1); PG8_BAR;
            PG8_LDB(B0, 1, 0); PG8_SCHED; PG8_LDA(At, 1, 0); PG8_STAGE(PG8_SA(0, 1), a2 + hstepA, voffA);
            PG8_WAIT_L(8); PG8_BAR; PG8_WAIT_L(0); PG8_MMA(0, 0, At, B0); PG8_BAR; PG8_SCHED;
            PG8_LDB(B1, 1, 1); PG8_STAGE(PG8_SB(1, 0), b3, voffB);
            PG8_BAR; PG8_WAIT_L(0); PG8_MMA(0, 1, At, B1); PG8_BAR;
            PG8_LDA(At, 1, 1); PG8_STAGE(PG8_SA(1, 0), a3, voffA);
            PG8_BAR; PG8_WAIT_L(0); PG8_MMA(1, 0, At, B0); PG8_BAR; PG8_SCHED;
            PG8_STAGE(PG8_SB(1, 1), b3 + hstepB, voffB);
            PG8_WAIT_V(6); PG8_BAR; PG8_MMA(1, 1, At, B1); PG8_BAR;
            }
        }
        if constexpr (ALIGN_EPI) { if (wr == 0) PG8_BAR; }
        if constexpr (!Epi::AFTER_DRAIN) { E(acc, cur, wr, wc, fr, fq); S.done(cur); }
        if (!has_next) break;
#pragma unroll
        for (int a = 0; a < 2; ++a)
#pragma unroll
            for (int b = 0; b < 2; ++b)
#pragma unroll
                for (int m = 0; m < 4; ++m)
#pragma unroll
                    for (int n = 0; n < 2; ++n) acc[a][b][m][n] = (f32x4){0.f, 0.f, 0.f, 0.f};
        cur = nxt; cA = nA; cB = nB; ++ui;
        if constexpr (ALIGN_EPI) { if (wr == 1) PG8_BAR; }
    }
    PG8_WAIT_V(0);
    if constexpr (!ALIGN_EPI) { if (wr == 0) PG8_BAR; }
    PG8_BAR;
    if constexpr (Epi::AFTER_DRAIN) { E.fused(acc, cur, wr, wc, fr, fq, lds, wid, lane); S.done(cur); }
#undef PG8_SA
#undef PG8_SB
#undef PG8_STAGE
#undef PG8_LDA
#undef PG8_LDB
#undef PG8_MMA
#undef PG8_WAIT_V
#undef PG8_WAIT_L
#undef PG8_BAR
#undef PG8_SCHED
}
}
namespace {
constexpr int D = 1024, NB = 4, L = 4096, HW = 1024, SW = 1024, INW = 7168, FH = 2816, FHID = 64, FEMB = 33;
constexpr float EPS = 1e-6f;
typedef unsigned short bf16;
__device__ __forceinline__ unsigned f2bf(float f) { unsigned u = __builtin_bit_cast(unsigned, f); return (u + 0x7fffu + ((u >> 16) & 1u)) >> 16; }
}
namespace {
#define HD __device__ __forceinline__
#define FFT_OPAQUE(w) asm volatile("" : "+v"(w))
#ifndef HD
#define HD inline
#endif
typedef float cf __attribute__((ext_vector_type(2)));
HD cf cmk(float x, float y) { return (cf){x, y}; }
HD cf cadd(cf a, cf b) { return cmk(a.x + b.x, a.y + b.y); }
HD cf csub(cf a, cf b) { return cmk(a.x - b.x, a.y - b.y); }
HD cf cmul(cf a, cf b) { return cmk(a.x * b.x - a.y * b.y, a.x * b.y + a.y * b.x); }
HD cf cconj(cf a) { return cmk(a.x, -a.y); }
template <bool INV> HD cf mulmi(cf a) { return INV ? cmk(-a.y, a.x) : cmk(a.y, -a.x); }
template <bool INV> HD cf twc(float c, float s) { return INV ? cmk(c, s) : cmk(c, -s); }
HD int fpad(int p) { return p + (p >> 4); }
constexpr int FSUB = 4352;

template <bool INV> HD void dft4(cf& a, cf& b, cf& c, cf& d) {
    const cf t0 = cadd(a, c), t1 = csub(a, c), t2 = cadd(b, d), t3 = mulmi<INV>(csub(b, d));
    a = cadd(t0, t2); b = cadd(t1, t3); c = csub(t0, t2); d = csub(t1, t3);
}
template <bool INV> HD void dft16(cf (&v)[16]) {
    constexpr float C1 = 0.92387953251128674f, S1 = 0.38268343236508977f, R = 0.70710678118654752f;
#pragma unroll
    for (int n0 = 0; n0 < 4; ++n0) dft4<INV>(v[n0], v[n0 + 4], v[n0 + 8], v[n0 + 12]);
    v[1 + 4 * 1] = cmul(v[1 + 4 * 1], twc<INV>(C1, S1));
    v[1 + 4 * 2] = cmul(v[1 + 4 * 2], twc<INV>(R, R));
    v[1 + 4 * 3] = cmul(v[1 + 4 * 3], twc<INV>(S1, C1));
    v[2 + 4 * 1] = cmul(v[2 + 4 * 1], twc<INV>(R, R));
    v[2 + 4 * 2] = mulmi<INV>(v[2 + 4 * 2]);
    v[2 + 4 * 3] = cmul(v[2 + 4 * 3], twc<INV>(-R, R));
    v[3 + 4 * 1] = cmul(v[3 + 4 * 1], twc<INV>(S1, C1));
    v[3 + 4 * 2] = cmul(v[3 + 4 * 2], twc<INV>(-R, R));
    v[3 + 4 * 3] = cmul(v[3 + 4 * 3], twc<INV>(-C1, -S1));
#pragma unroll
    for (int k0 = 0; k0 < 4; ++k0) dft4<INV>(v[4 * k0], v[4 * k0 + 1], v[4 * k0 + 2], v[4 * k0 + 3]);
    cf t;
    t = v[1]; v[1] = v[4]; v[4] = t;   t = v[2]; v[2] = v[8]; v[8] = t;   t = v[3]; v[3] = v[12]; v[12] = t;
    t = v[6]; v[6] = v[9]; v[9] = t;   t = v[7]; v[7] = v[13]; v[13] = t; t = v[11]; v[11] = v[14]; v[14] = t;
}
#ifndef FFT_OPAQUE
#define FFT_OPAQUE(w)
#endif
HD void twiddle16(cf (&v)[16], cf w) {
    FFT_OPAQUE(w);
    cf p = w;
#pragma unroll
    for (int k = 1; k < 16; ++k) { v[k] = cmul(v[k], p); if (k < 15) p = cmul(p, w); }
}
template <class P> HD void fwd_pass1(P Z, int t, cf w1) {
    cf v[16]; const int b = t + (t >> 4);
#pragma unroll
    for (int j = 0; j < 16; ++j) v[j] = Z[b + 272 * j];
    dft16<false>(v); twiddle16(v, w1);
#pragma unroll
    for (int j = 0; j < 16; ++j) Z[b + 272 * j] = v[j];
}
template <class P> HD void fwd_pass2(P Z, int t, cf w2) {
    const int b = 272 * (t >> 4) + (t & 15);
    cf v[16];
#pragma unroll
    for (int j = 0; j < 16; ++j) v[j] = Z[b + 17 * j];
    dft16<false>(v); twiddle16(v, w2);
#pragma unroll
    for (int j = 0; j < 16; ++j) Z[b + 17 * j] = v[j];
}
template <class P> HD void fwd_pass3_load(P Z, int t, cf (&v)[16]) {
#pragma unroll
    for (int j = 0; j < 16; ++j) v[j] = Z[17 * t + j];
    dft16<false>(v);
}
template <class P> HD void inv_pass1_store(P Z, int t, cf (&v)[16]) {
    dft16<true>(v);
#pragma unroll
    for (int j = 0; j < 16; ++j) Z[17 * t + j] = v[j];
}
template <class P> HD void inv_pass2(P Z, int t, cf w2) {
    const int b = 272 * (t >> 4) + (t & 15);
    cf v[16];
#pragma unroll
    for (int j = 0; j < 16; ++j) v[j] = Z[b + 17 * j];
    twiddle16(v, cconj(w2)); dft16<true>(v);
#pragma unroll
    for (int j = 0; j < 16; ++j) Z[b + 17 * j] = v[j];
}
template <class P> HD void inv_pass3(P Z, int t, cf w1) {
    cf v[16]; const int b = t + (t >> 4);
#pragma unroll
    for (int j = 0; j < 16; ++j) v[j] = Z[b + 272 * j];
    twiddle16(v, cconj(w1)); dft16<true>(v);
#pragma unroll
    for (int j = 0; j < 16; ++j) Z[b + 272 * j] = v[j];
}
#define LAS __attribute__((address_space(3)))
typedef LAS cf* lcf;
struct HyArgs {
    const bf16* hyT;
    bf16* yaT;
    const float* fsum;
    const float* fdif;
    const float* cw;
    const float* cb;
    const float* skip;
    const cf* T;
    int TS, npairs, off00, off01, off10, off11;
};
__device__ __forceinline__ float bf2f(unsigned h) { return __builtin_bit_cast(float, h << 16); }
__device__ __forceinline__ unsigned long long ald64(const char* p) { return __hip_atomic_load((const unsigned long long*)p, __ATOMIC_RELAXED, __HIP_MEMORY_SCOPE_AGENT); }
__device__ __forceinline__ unsigned ald16(const char* p) { return (unsigned)__hip_atomic_load((const unsigned short*)p, __ATOMIC_RELAXED, __HIP_MEMORY_SCOPE_AGENT); }
struct Raw8 { unsigned long long lo, hi; unsigned lft, rgt; };
__device__ __forceinline__ Raw8 load_raw8(const bf16* row, unsigned boff, unsigned loff, unsigned roff) {
    const char* b = (const char*)row;
    Raw8 r; r.lo = ald64(b + boff); r.hi = ald64(b + boff + 8); r.lft = ald16(b + loff); r.rgt = ald16(b + roff);
    return r;
}
__device__ __forceinline__ void conv8r(const Raw8& r, bool has_l, bool has_r, float w0, float w1, float w2, float b, float (&o)[8]) {
    float x[10];
    const unsigned q0 = (unsigned)r.lo, q1 = (unsigned)(r.lo >> 32), q2 = (unsigned)r.hi, q3 = (unsigned)(r.hi >> 32);
    x[0] = has_l ? bf2f(r.lft) : 0.f; x[9] = has_r ? bf2f(r.rgt) : 0.f;
    x[1] = bf2f(q0 & 0xffffu); x[2] = bf2f(q0 >> 16); x[3] = bf2f(q1 & 0xffffu); x[4] = bf2f(q1 >> 16);
    x[5] = bf2f(q2 & 0xffffu); x[6] = bf2f(q2 >> 16); x[7] = bf2f(q3 & 0xffffu); x[8] = bf2f(q3 >> 16);
#pragma unroll
    for (int i = 0; i < 8; ++i) o[i] = b + w0 * x[i] + w1 * x[i + 1] + w2 * x[i + 2];
}
#define WAVE_FENCE() asm volatile("s_waitcnt lgkmcnt(0)" ::: "memory")
struct PairRaw { Raw8 a0, v0, a1, v1; };
struct FiltRaw { unsigned long long s[4], d[4]; };
__device__ __forceinline__ PairRaw load_pair(const HyArgs& A, int c, int o0, int o1, unsigned boff, unsigned loff, unsigned roff) {
    PairRaw R;
    R.a0 = load_raw8(A.hyT + (size_t)(1024 + c) * A.TS + o0, boff, loff, roff); R.v0 = load_raw8(A.hyT + (size_t)(2048 + c) * A.TS + o0, boff, loff, roff);
    R.a1 = load_raw8(A.hyT + (size_t)(1024 + c) * A.TS + o1, boff, loff, roff); R.v1 = load_raw8(A.hyT + (size_t)(2048 + c) * A.TS + o1, boff, loff, roff);
    return R;
}
__device__ __forceinline__ FiltRaw load_filt(const HyArgs& A, int c, unsigned boff) {
    FiltRaw F; const char* ps = (const char*)(A.fsum + (size_t)c * 4096); const char* pd = (const char*)(A.fdif + (size_t)c * 4096);
#pragma unroll
    for (int i = 0; i < 4; ++i) { F.s[i] = ald64(ps + 2 * boff + 8 * i); F.d[i] = ald64(pd + 2 * boff + 8 * i); }
    return F;
}
__device__ __forceinline__ pg8::u32x4 pack8(const float (&x)[8], const float (&y)[8]) {
    pg8::u32x4 w;
    w.x = f2bf(x[0] * y[0]) | (f2bf(x[1] * y[1]) << 16); w.y = f2bf(x[2] * y[2]) | (f2bf(x[3] * y[3]) << 16);
    w.z = f2bf(x[4] * y[4]) | (f2bf(x[5] * y[5]) << 16); w.w = f2bf(x[6] * y[6]) | (f2bf(x[7] * y[7]) << 16);
    return w;
}
__device__ __forceinline__ void hyena_phase(lcf Z, const HyArgs& A, int first, int stride, const int tid) {
    const int s = tid >> 8, t = tid & 255, n0 = 8 * tid, pb = 8 * tid + (tid >> 1);
    const cf w1 = A.T[2 * t], w2 = A.T[32 * (t & 15)], wp = A.T[8 * tid];
    lcf Zs = Z + s * FSUB; lcf Ks = Z + 2 * FSUB + s * FSUB;
    constexpr float W8C[8] = {1.0f, 0.99999970586f, 0.99999882345f, 0.99999735277f, 0.99999529381f, 0.99999264659f, 0.99998941108f, 0.99998558731f};
    constexpr float W8S[8] = {0.0f, 0.00076699031874f, 0.0015339801863f, 0.0023009691514f, 0.0030679567630f, 0.0038349425697f, 0.0046019261204f, 0.0053689069640f};
    if (first >= 1024) return;
    const bool has_l = n0 > 0, has_r = n0 + 8 < 4096;
    unsigned boff = (unsigned)n0 * 2u, loff = has_l ? boff - 2u : 0u, roff = has_r ? boff + 16u : 8190u;
    asm volatile("" : "+v"(boff), "+v"(loff), "+v"(roff));

    for (int c = first; c < 1024; c += stride) {
        const float sk = A.skip[c];
        const float cx0 = A.cw[c], cx1 = A.cw[3072 + c], cx2 = A.cw[6144 + c], cxb = A.cb[c];
        const float ca0 = A.cw[1024 + c], ca1 = A.cw[3072 + 1024 + c], ca2 = A.cw[6144 + 1024 + c], cab = A.cb[1024 + c];
        const float cv0 = A.cw[2048 + c], cv1 = A.cw[3072 + 2048 + c], cv2 = A.cw[6144 + 2048 + c], cvb = A.cb[2048 + c];
        {
            const FiltRaw F = load_filt(A, c, boff);
            float fs[8], fd[8];
#pragma unroll
            for (int i = 0; i < 4; ++i) { fs[2 * i] = __builtin_bit_cast(float, (unsigned)F.s[i]); fs[2 * i + 1] = __builtin_bit_cast(float, (unsigned)(F.s[i] >> 32));
                                          fd[2 * i] = __builtin_bit_cast(float, (unsigned)F.d[i]); fd[2 * i + 1] = __builtin_bit_cast(float, (unsigned)(F.d[i] >> 32)); }
#pragma unroll
            for (int i = 0; i < 8; ++i) { cf wq = wp; FFT_OPAQUE(wq); const cf tw = cmul(wq, cmk(W8C[i], -W8S[i])); Z[pb + i] = cmk(fs[i], 0.f); Z[FSUB + pb + i] = cmk(fd[i] * tw.x, fd[i] * tw.y); }
        }
        __syncthreads();
        fwd_pass1(Zs, t, w1); __syncthreads();
        fwd_pass2(Zs, t, w2); WAVE_FENCE();
        {
            cf v[16];
            fwd_pass3_load(Zs, t, v);
#pragma unroll
            for (int j = 0; j < 16; ++j) Ks[17 * t + j] = cmk(v[j].x * (1.0f / 8192.0f), v[j].y * (1.0f / 8192.0f));
        }
        __syncthreads();
        for (int p = 0; p < A.npairs; ++p) {
            const int o0 = p ? A.off10 : A.off00, o1 = p ? A.off11 : A.off01;
            float u0[8], u1[8];
            {
                const PairRaw R = load_pair(A, c, o0, o1, boff, loff, roff);
                float a[8], b[8];
                conv8r(R.a0, has_l, has_r, ca0, ca1, ca2, cab, a); conv8r(R.v0, has_l, has_r, cv0, cv1, cv2, cvb, b);
#pragma unroll
                for (int i = 0; i < 8; ++i) u0[i] = a[i] * b[i];
                conv8r(R.a1, has_l, has_r, ca0, ca1, ca2, cab, a); conv8r(R.v1, has_l, has_r, cv0, cv1, cv2, cvb, b);
#pragma unroll
                for (int i = 0; i < 8; ++i) u1[i] = a[i] * b[i];
            }
#pragma unroll
            for (int i = 0; i < 8; ++i) { cf wq = wp; FFT_OPAQUE(wq); const cf tw = cmul(wq, cmk(W8C[i], -W8S[i])); const cf z = cmk(u0[i], u1[i]); Z[pb + i] = z; Z[FSUB + pb + i] = cmul(z, tw); }
            __syncthreads();
            fwd_pass1(Zs, t, w1); __syncthreads();
            fwd_pass2(Zs, t, w2); WAVE_FENCE();
            {
                cf v[16];
                fwd_pass3_load(Zs, t, v);
#pragma unroll
                for (int j = 0; j < 16; ++j) v[j] = cmul(v[j], Ks[17 * t + j]);
                inv_pass1_store(Zs, t, v);
            }
            WAVE_FENCE();
            inv_pass2(Zs, t, w2); __syncthreads();
            inv_pass3(Zs, t, w1); __syncthreads();
            {
                const Raw8 X0a = load_raw8(A.hyT + (size_t)c * A.TS + o0, boff, loff, roff), X0b = load_raw8(A.hyT + (size_t)c * A.TS + o1, boff, loff, roff);
                float y0[8], y1[8];
#pragma unroll
                for (int i = 0; i < 8; ++i) { cf wq = wp; FFT_OPAQUE(wq); const cf tw = cmul(wq, cmk(W8C[i], -W8S[i])); const cf e = Z[pb + i], o = Z[FSUB + pb + i]; const cf y = cadd(e, cmul(o, cconj(tw))); y0[i] = y.x + sk * u0[i]; y1[i] = y.y + sk * u1[i]; }
                float x0c[8];
                conv8r(X0a, has_l, has_r, cx0, cx1, cx2, cxb, x0c);
                *(pg8::u32x4*)(A.yaT + (size_t)c * A.TS + o0 + n0) = pack8(x0c, y0);
                if (o1 != o0) { conv8r(X0b, has_l, has_r, cx0, cx1, cx2, cxb, x0c); *(pg8::u32x4*)(A.yaT + (size_t)c * A.TS + o1 + n0) = pack8(x0c, y1); }
            }
        }
    }
}
}
namespace pg8 {
__device__ __forceinline__ f32x2 sigmoid_pk(f32x2 v) {
    f32x2 e; e.x = __builtin_amdgcn_exp2f(v.x * -1.4426950408889634f); e.y = __builtin_amdgcn_exp2f(v.y * -1.4426950408889634f);
    f32x2 o; o.x = __builtin_amdgcn_rcpf(1.0f + e.x); o.y = __builtin_amdgcn_rcpf(1.0f + e.y); return o;
}
struct EpiHyT {
    static constexpr bool PERM = true, AFTER_DRAIN = false, MID = false;
    bf16_t* O; int ldc; float* vss;
    __device__ __forceinline__ void operator()(const f32x4 (&acc)[2][2][4][2], const Unit& u, int wr, int wc, int fr, int fq) const {
        const int row0 = u.pm * BM + wr * 64 + fr, col0 = u.pn * BM + wc * 32 + 8 * fq;
        const bool isv = u.pm >= 12;
        f32x4 ss[2][2];
#pragma unroll
        for (int bj = 0; bj < 2; ++bj)
#pragma unroll
            for (int n = 0; n < 2; ++n) ss[bj][n] = (f32x4){0.f, 0.f, 0.f, 0.f};
#pragma unroll
        for (int ai = 0; ai < 2; ++ai)
#pragma unroll
            for (int m = 0; m < 4; ++m) { bf16_t* rowp = O + (size_t)(row0 + ai * HALF + m * 16) * ldc + col0;
#pragma unroll
                for (int bj = 0; bj < 2; ++bj) { f32x4 v0 = acc[ai][bj][m][0], v1 = acc[ai][bj][m][1];
                    if (isv) { f32x2 a = gelu_pk((f32x2){v0[0], v0[1]}), b = gelu_pk((f32x2){v0[2], v0[3]}), c = gelu_pk((f32x2){v1[0], v1[1]}), d = gelu_pk((f32x2){v1[2], v1[3]});
                        v0 = (f32x4){a.x, a.y, b.x, b.y}; v1 = (f32x4){c.x, c.y, d.x, d.y}; ss[bj][0] += v0 * v0; ss[bj][1] += v1 * v1; }
                    u32x4 w; w.x = cvt_pk_bf16(v0[0], v0[1]); w.y = cvt_pk_bf16(v0[2], v0[3]); w.z = cvt_pk_bf16(v1[0], v1[1]); w.w = cvt_pk_bf16(v1[2], v1[3]);
                    *(u32x4*)(rowp + bj * HALF) = w; } }
        if (isv) {
#pragma unroll
            for (int bj = 0; bj < 2; ++bj)
#pragma unroll
                for (int n = 0; n < 2; ++n)
#pragma unroll
                    for (int j = 0; j < 4; ++j) { float s = ss[bj][n][j]; s += __shfl_xor(s, 1); s += __shfl_xor(s, 2); s += __shfl_xor(s, 4); s += __shfl_xor(s, 8);
                        if (fr == 0) atomicAdd(vss + col0 + bj * HALF + 4 * n + j, s); }
        }
    }
};
struct EpiUG {
    static constexpr bool PERM = true, AFTER_DRAIN = false, MID = false;
    bf16_t* U; bf16_t* G; int ldu;
    __device__ __forceinline__ void operator()(const f32x4 (&acc)[2][2][4][2], const Unit& u, int wr, int wc, int fr, int fq) const {
        const int row0 = u.pm * BM + wr * 64 + fr; int colt = u.pn * BM; const bool isu = colt < 1024;
        bf16_t* base = isu ? U : G; const int ldc = isu ? ldu : 2048; if (!isu) colt -= 1024;
        const int col0 = colt + wc * 32 + 8 * fq;
#pragma unroll
        for (int ai = 0; ai < 2; ++ai)
#pragma unroll
            for (int m = 0; m < 4; ++m) { bf16_t* rowp = base + (size_t)(row0 + ai * HALF + m * 16) * ldc + col0;
#pragma unroll
                for (int bj = 0; bj < 2; ++bj) { f32x4 v0 = acc[ai][bj][m][0], v1 = acc[ai][bj][m][1];
                    f32x2 a, b, c, d;
                    if (isu) { a = gelu_pk((f32x2){v0[0], v0[1]}); b = gelu_pk((f32x2){v0[2], v0[3]}); c = gelu_pk((f32x2){v1[0], v1[1]}); d = gelu_pk((f32x2){v1[2], v1[3]}); }
                    else { a = sigmoid_pk((f32x2){v0[0], v0[1]}); b = sigmoid_pk((f32x2){v0[2], v0[3]}); c = sigmoid_pk((f32x2){v1[0], v1[1]}); d = sigmoid_pk((f32x2){v1[2], v1[3]}); }
                    u32x4 w; w.x = cvt_pk_bf16(a.x, a.y); w.y = cvt_pk_bf16(b.x, b.y); w.z = cvt_pk_bf16(c.x, c.y); w.w = cvt_pk_bf16(d.x, d.y);
                    *(u32x4*)(rowp + bj * HALF) = w; } }
    }
};
}
namespace {
struct WJob { const float* W; const float* g; bf16* dst; int K, N, c0, nc, ldd, r0, koff, pad; };
constexpr int NWJ = 9;
struct WJobs { WJob j[NWJ]; };
__device__ __forceinline__ unsigned pk2(float lo, float hi) { return f2bf(lo) | (f2bf(hi) << 16); }
__device__ __forceinline__ void wT_item(const WJob& J, LAS float* scr, int item, int lane) {
    const int nblk = J.nc / 32, kb = item / nblk, nb = item % nblk, k0 = 64 * kb, n0 = 32 * nb;
    float v[32];
#pragma unroll
    for (int i = 0; i < 32; ++i) v[i] = J.W[(size_t)(k0 + 2 * i + (lane >> 5)) * J.N + J.c0 + n0 + (lane & 31)];
    if (J.g) {
#pragma unroll
        for (int i = 0; i < 32; ++i) v[i] *= J.g[k0 + 2 * i + (lane >> 5)]; }
#pragma unroll
    for (int i = 0; i < 32; ++i) scr[(2 * i + (lane >> 5)) * 33 + (lane & 31)] = v[i];
    asm volatile("s_waitcnt lgkmcnt(0)" ::: "memory");
    const int c = lane & 7;
#pragma unroll
    for (int j = 0; j < 4; ++j) { const int n = (lane >> 3) + 8 * j; const LAS float* s = scr + (8 * c) * 33 + n;
        uint4 o; o.x = pk2(s[0 * 33], s[1 * 33]); o.y = pk2(s[2 * 33], s[3 * 33]); o.z = pk2(s[4 * 33], s[5 * 33]); o.w = pk2(s[6 * 33], s[7 * 33]);
        *(uint4*)(J.dst + (size_t)(J.r0 + n0 + n) * J.ldd + J.koff + k0 + 8 * c) = o; }
    asm volatile("s_waitcnt lgkmcnt(0)" ::: "memory");
}
__device__ __forceinline__ void p0_weights(const WJobs& WJ, int jlo, int jhi, LAS float* scr, int gw, int NGW, int lane) {
    int base = 0;
    for (int q = jlo; q < jhi; ++q) {
        const WJob& J = WJ.j[q]; const int ni = (J.K / 64) * (J.nc / 32);
        int it = gw - (base % NGW); if (it < 0) it += NGW;
        for (; it < ni; it += NGW) wT_item(J, scr, it, lane);
        base += ni;
    }
}
__device__ __forceinline__ float wave_sum(float v) {
#pragma unroll
    for (int o = 1; o < 64; o <<= 1) v += __shfl_xor(v, o);
    return v;
}
__device__ __forceinline__ void rms_row_to_bf16(const float* xrow, const float* g, bf16* orow, int lane) {
    const float4* xr = (const float4*)xrow + lane; const float4* gr = (const float4*)g + lane;
    float4 v[4]; float s = 0.f;
#pragma unroll
    for (int j = 0; j < 4; ++j) { v[j] = xr[64 * j]; s += (v[j].x * v[j].x + v[j].y * v[j].y) + (v[j].z * v[j].z + v[j].w * v[j].w); }
    const float r = rsqrtf(wave_sum(s) * (1.f / 1024.f) + EPS);
    unsigned long long* o8 = (unsigned long long*)orow + lane;
#pragma unroll
    for (int j = 0; j < 4; ++j) { const float4 gg = gr[64 * j];
        o8[64 * j] = (unsigned long long)pk2(v[j].x * r * gg.x, v[j].y * r * gg.y) | ((unsigned long long)pk2(v[j].z * r * gg.z, v[j].w * r * gg.w) << 32); }
}
__device__ __forceinline__ void rms_rows4_to_bf16(const float* xrow, const float* g, bf16* orow, int ldo, int lane) {
    float4 v[4][4]; float s[4];
#pragma unroll
    for (int r = 0; r < 4; ++r)
#pragma unroll
        for (int j = 0; j < 4; ++j) v[r][j] = ((const float4*)(xrow + (size_t)r * 1024) + lane)[64 * j];
#pragma unroll
    for (int r = 0; r < 4; ++r) { s[r] = 0.f;
#pragma unroll
        for (int j = 0; j < 4; ++j) s[r] += (v[r][j].x * v[r][j].x + v[r][j].y * v[r][j].y) + (v[r][j].z * v[r][j].z + v[r][j].w * v[r][j].w); }
#pragma unroll
    for (int r = 0; r < 4; ++r) { const float rr = rsqrtf(wave_sum(s[r]) * (1.f / 1024.f) + EPS);
        unsigned long long* o8 = (unsigned long long*)(orow + (size_t)r * ldo) + lane;
#pragma unroll
        for (int j = 0; j < 4; ++j) { const float4 gg = ((const float4*)g + lane)[64 * j];
            o8[64 * j] = (unsigned long long)pk2(v[r][j].x * rr * gg.x, v[r][j].y * rr * gg.y) | ((unsigned long long)pk2(v[r][j].z * rr * gg.z, v[r][j].w * rr * gg.w) << 32); } }
}
}

namespace {
struct SguArgs {
    const bf16* vT;
    bf16* U;
    const float* vss;
    const float* ws;
    const float* bs;
    const float* gn;
    int TS, ldu;
};
typedef short bf16x8_t __attribute__((ext_vector_type(8)));
typedef float f32x4_t __attribute__((ext_vector_type(4)));
__device__ __forceinline__ void sgu_item(LAS unsigned char* lds, const SguArgs& A, int item, int tid) {
    const int g = item & 7, ch = item >> 3, tok0 = ch * 128;
    const int wave = tid >> 6, lane = tid & 63, fr = lane & 15, fq = lane >> 4;
#pragma unroll
    for (int j = 0; j < 4; ++j) { const int idx = tid + 512 * j, d = idx >> 4, chunk = idx & 15;
        const pg8::u32x4 v = *(const pg8::u32x4*)(A.vT + (size_t)(g * 128 + d) * A.TS + tok0 + chunk * 8);
        *(LAS pg8::u32x4*)(lds + d * 272 + chunk * 16) = v; }
    bf16x8_t af[4];
    const int p = 16 * wave + fr;
#pragma unroll
    for (int kk = 0; kk < 4; ++kk) { const int q = 32 * kk + 8 * fq;
        const float4 w0 = *(const float4*)(A.ws + ((size_t)g * 128 + p) * 128 + q), w1 = *(const float4*)(A.ws + ((size_t)g * 128 + p) * 128 + q + 4);
        const float4 s0 = *(const float4*)(A.vss + tok0 + q), s1 = *(const float4*)(A.vss + tok0 + q + 4);
        const float r0 = rsqrtf(s0.x * (1.f / 1024.f) + EPS), r1 = rsqrtf(s0.y * (1.f / 1024.f) + EPS), r2 = rsqrtf(s0.z * (1.f / 1024.f) + EPS), r3 = rsqrtf(s0.w * (1.f / 1024.f) + EPS);
        const float r4 = rsqrtf(s1.x * (1.f / 1024.f) + EPS), r5 = rsqrtf(s1.y * (1.f / 1024.f) + EPS), r6 = rsqrtf(s1.z * (1.f / 1024.f) + EPS), r7 = rsqrtf(s1.w * (1.f / 1024.f) + EPS);
        uint4 o; o.x = pk2(w0.x * r0, w0.y * r1); o.y = pk2(w0.z * r2, w0.w * r3); o.z = pk2(w1.x * r4, w1.y * r5); o.w = pk2(w1.z * r6, w1.w * r7);
        af[kk] = __builtin_bit_cast(bf16x8_t, o); }
    const float bsp = A.bs[g * 128 + p];
    bf16* urow = A.U + (size_t)(tok0 + p) * A.ldu + g * 128 + 4 * fq;
    const float* gnp = A.gn + g * 128 + 4 * fq;
    uint2 uq[8];
#pragma unroll
    for (int nt = 0; nt < 8; ++nt) uq[nt] = *(const uint2*)(urow + 16 * nt);
    __syncthreads();
    f32x4_t acc[8];
#pragma unroll
    for (int nt = 0; nt < 8; ++nt) acc[nt] = (f32x4_t){0.f, 0.f, 0.f, 0.f};
#pragma unroll
    for (int kk = 0; kk < 4; ++kk) {
        bf16x8_t bfr[8];
#pragma unroll
        for (int nt = 0; nt < 8; ++nt) bfr[nt] = *(const LAS bf16x8_t*)(lds + (16 * nt + fr) * 272 + (32 * kk + 8 * fq) * 2);
#pragma unroll
        for (int nt = 0; nt < 8; ++nt) acc[nt] = __builtin_amdgcn_mfma_f32_16x16x32_bf16(bfr[nt], af[kk], acc[nt], 0, 0, 0);
    }
#pragma unroll
    for (int nt = 0; nt < 8; ++nt) {
        const uint2 uu = uq[nt];
        const float4 gv = *(const float4*)(gnp + 16 * nt);
        const float y0 = bf2f(uu.x & 0xffffu) * (gv.x * acc[nt][0] + bsp), y1 = bf2f(uu.x >> 16) * (gv.y * acc[nt][1] + bsp);
        const float y2 = bf2f(uu.y & 0xffffu) * (gv.z * acc[nt][2] + bsp), y3 = bf2f(uu.y >> 16) * (gv.w * acc[nt][3] + bsp);
        uint2 o; o.x = pk2(y0, y1); o.y = pk2(y2, y3);
        *(uint2*)(urow + 16 * nt) = o;
    }
    __syncthreads();
}
}

namespace pg8 {
__device__ __forceinline__ void bf8_to_f32(const u32x4 q, f32x4& lo, f32x4& hi) {
    lo = (f32x4){__builtin_bit_cast(float, q.x << 16), __builtin_bit_cast(float, q.x & 0xffff0000u), __builtin_bit_cast(float, q.y << 16), __builtin_bit_cast(float, q.y & 0xffff0000u)};
    hi = (f32x4){__builtin_bit_cast(float, q.z << 16), __builtin_bit_cast(float, q.z & 0xffff0000u), __builtin_bit_cast(float, q.w << 16), __builtin_bit_cast(float, q.w & 0xffff0000u)};
}
struct EpiMerge {
    static constexpr bool PERM = true, AFTER_DRAIN = false, MID = true;
    const bf16_t* G; bf16_t* O;
    __device__ __forceinline__ void mid(f32x4 (&acc)[2][2][4][2], const Unit& u, int wr, int wc, int fr, int fq) const {
        unsigned off0 = (unsigned)(u.pm * BM + wr * 64 + fr) * 2048u + (unsigned)(u.pn * BM + wc * 32 + 8 * fq);
        asm volatile("" : "+v"(off0));
#pragma unroll
        for (int ai = 0; ai < 2; ++ai)
#pragma unroll
            for (int m = 0; m < 4; ++m)
#pragma unroll
                for (int bj = 0; bj < 2; ++bj) { const bf16_t* gp = G + (off0 + (unsigned)((ai * HALF + m * 16) * 2048 + bj * HALF));
                    const u32x4 qa = *(const u32x4*)gp, qb = *(const u32x4*)(gp + 1024);
                    f32x4 a0, a1, b0, b1; bf8_to_f32(qa, a0, a1); bf8_to_f32(qb, b0, b1);
#pragma unroll
                    for (int j = 0; j < 4; ++j) { acc[ai][bj][m][0][j] *= a0[j] * __builtin_amdgcn_rcpf(b0[j]); acc[ai][bj][m][1][j] *= a1[j] * __builtin_amdgcn_rcpf(b1[j]); }
                    asm volatile("" ::: "memory"); }
    }
    __device__ __forceinline__ void operator()(const f32x4 (&acc)[2][2][4][2], const Unit& u, int wr, int wc, int fr, int fq) const {
        const int row0 = u.pm * BM + wr * 64 + fr, col0 = u.pn * BM + wc * 32 + 8 * fq;
#pragma unroll
        for (int ai = 0; ai < 2; ++ai)
#pragma unroll
            for (int m = 0; m < 4; ++m) { const size_t r = (size_t)(row0 + ai * HALF + m * 16);
#pragma unroll
                for (int bj = 0; bj < 2; ++bj) { f32x4 b0, b1; bf8_to_f32(*(const u32x4*)(G + r * 2048 + 1024 + col0 + bj * HALF), b0, b1);
                    const f32x4 v0 = acc[ai][bj][m][0] * b0, v1 = acc[ai][bj][m][1] * b1;
                    u32x4 w; w.x = cvt_pk_bf16(v0[0], v0[1]); w.y = cvt_pk_bf16(v0[2], v0[3]); w.z = cvt_pk_bf16(v1[0], v1[1]); w.w = cvt_pk_bf16(v1[2], v1[3]);
                    *(u32x4*)(O + r * 1024 + col0 + bj * HALF) = w; } }
    }
};
}
namespace {
__device__ __forceinline__ void tr64_item(const bf16* yaT, int TS, bf16* out, int ldo, LAS unsigned short* scr, int c0, int t0, int lane) {
#pragma unroll
    for (int i = 0; i < 8; ++i) { const int r = 8 * i + (lane >> 3), ch = lane & 7;
        const pg8::u32x4 q = *(const pg8::u32x4*)(yaT + (size_t)(c0 + r) * TS + t0 + 8 * ch);
        LAS unsigned short* d = scr + (8 * ch) * 72 + r;
        d[0 * 72] = (unsigned short)(q.x & 0xffffu); d[1 * 72] = (unsigned short)(q.x >> 16); d[2 * 72] = (unsigned short)(q.y & 0xffffu); d[3 * 72] = (unsigned short)(q.y >> 16);
        d[4 * 72] = (unsigned short)(q.z & 0xffffu); d[5 * 72] = (unsigned short)(q.z >> 16); d[6 * 72] = (unsigned short)(q.w & 0xffffu); d[7 * 72] = (unsigned short)(q.w >> 16); }
    asm volatile("s_waitcnt lgkmcnt(0)" ::: "memory");
#pragma unroll
    for (int i = 0; i < 8; ++i) { const int tk = 8 * i + (lane >> 3), ch = lane & 7;
        const pg8::u32x4 q = *(const LAS pg8::u32x4*)(scr + tk * 72 + 8 * ch);
        *(pg8::u32x4*)(out + (size_t)(t0 + tk) * ldo + c0 + 8 * ch) = q; }
    asm volatile("s_waitcnt lgkmcnt(0)" ::: "memory");
}
__device__ __forceinline__ void transpose_ya(const bf16* yaT, int TS, bf16* out, int ldo, LAS unsigned short* scr, int gw, int NGW, int lane) {
    const int ntt = TS / 64, nit = 16 * ntt;
    for (int it = gw; it < nit; it += NGW) tr64_item(yaT, TS, out, ldo, scr, 64 * (it / ntt), 64 * (it % ntt), lane);
}
}

namespace pg8 {
template <bool FIRST> struct EpiResid {
    static constexpr bool PERM = false, AFTER_DRAIN = false, MID = false;
    const float* X; const bf16_t* XB; float* X1; bf16_t* X1b; float* xss;
    __device__ __forceinline__ void operator()(const f32x4 (&acc)[2][2][4][2], const Unit& u, int wr, int wc, int fr, int fq) const {
        const int row0 = u.pm * BM + wr * 64 + fr, col0 = u.pn * BM + wc * 32 + 4 * fq;
        typedef unsigned u32x2v __attribute__((ext_vector_type(2)));
#pragma unroll
        for (int ai = 0; ai < 2; ++ai)
#pragma unroll
            for (int m = 0; m < 4; ++m) { const size_t r = (size_t)(row0 + ai * HALF + m * 16); float s = 0.f;
#pragma unroll
                for (int bj = 0; bj < 2; ++bj)
#pragma unroll
                    for (int n = 0; n < 2; ++n) { const size_t o = r * 1024 + col0 + bj * HALF + n * 16;
                        f32x4 v;
                        if (FIRST) v = acc[ai][bj][m][n] + *(const f32x4*)(X + o);
                        else { const u32x2v q = *(const u32x2v*)(XB + o);
                               v = acc[ai][bj][m][n] + (f32x4){__builtin_bit_cast(float, q.x << 16), __builtin_bit_cast(float, q.x & 0xffff0000u), __builtin_bit_cast(float, q.y << 16), __builtin_bit_cast(float, q.y & 0xffff0000u)}; }
                        { u32x2v w; w.x = cvt_pk_bf16(v[0], v[1]); w.y = cvt_pk_bf16(v[2], v[3]); *(u32x2v*)(X1b + o) = w; }
                        s += (v[0] * v[0] + v[1] * v[1]) + (v[2] * v[2] + v[3] * v[3]); }
                s += __shfl_xor(s, 16); s += __shfl_xor(s, 32);
                if (fq == 0) atomicAdd(xss + r, s);
                asm volatile("" ::: "memory"); }
    }
};
struct EpiUp {
    static constexpr bool PERM = true, AFTER_DRAIN = false, MID = false;
    bf16_t* AP; bf16_t* GP; const float* xss;
    __device__ __forceinline__ void operator()(const f32x4 (&acc)[2][2][4][2], const Unit& u, int wr, int wc, int fr, int fq) const {
        const int row0 = u.pm * BM + wr * 64 + fr; int colt = u.pn * BM; const bool isg = colt >= 2816;
        bf16_t* base = isg ? GP : AP; if (isg) colt -= 2816;
        const int col0 = colt + wc * 32 + 8 * fq;
#pragma unroll
        for (int ai = 0; ai < 2; ++ai)
#pragma unroll
            for (int m = 0; m < 4; ++m) { const size_t r = (size_t)(row0 + ai * HALF + m * 16); const float rs = rsqrtf(xss[r] * (1.0f / 1024.0f) + 1e-6f);
#pragma unroll
                for (int bj = 0; bj < 2; ++bj) { const f32x4 v0 = acc[ai][bj][m][0] * rs, v1 = acc[ai][bj][m][1] * rs;
                    u32x4 w; w.x = cvt_pk_bf16(v0[0], v0[1]); w.y = cvt_pk_bf16(v0[2], v0[3]); w.z = cvt_pk_bf16(v1[0], v1[1]); w.w = cvt_pk_bf16(v1[2], v1[3]);
                    *(u32x4*)(base + r * 2816 + col0 + bj * HALF) = w; } }
    }
};
}
namespace {
__device__ __forceinline__ void act_pass(const bf16* AP, bf16* GP, const float* cw, const float* cb, int TS, int gid, int gstride) {
    const int nitems = (TS / 16) * 352;
    const pg8::u32x4 zq = {0u, 0u, 0u, 0u};
    for (int it = gid; it < nitems; it += gstride) {
        const int run = it / 352, ch = it % 352, t0 = run * 16, c0 = ch * 8;
        const pg8::f32x4 w0l = *(const pg8::f32x4*)(cw + c0), w0h = *(const pg8::f32x4*)(cw + c0 + 4);
        const pg8::f32x4 w1l = *(const pg8::f32x4*)(cw + 2816 + c0), w1h = *(const pg8::f32x4*)(cw + 2816 + c0 + 4);
        const pg8::f32x4 w2l = *(const pg8::f32x4*)(cw + 5632 + c0), w2h = *(const pg8::f32x4*)(cw + 5632 + c0 + 4);
        const pg8::f32x4 bl = *(const pg8::f32x4*)(cb + c0), bh = *(const pg8::f32x4*)(cb + c0 + 4);
        const bf16* ap = AP + (size_t)t0 * 2816 + c0; bf16* gp = GP + (size_t)t0 * 2816 + c0;
        pg8::u32x4 qa[6];
        qa[0] = (t0 & 4095) != 0 ? *(const pg8::u32x4*)(ap - 2816) : zq;
        qa[1] = *(const pg8::u32x4*)ap;
#pragma unroll 1
        for (int i = 0; i < 16; i += 4) {
            pg8::u32x4 qg[4];
#pragma unroll
            for (int k = 0; k < 4; ++k) { const int t = t0 + i + k;
                qa[2 + k] = (t & 4095) != 4095 ? *(const pg8::u32x4*)(ap + (size_t)(i + k + 1) * 2816) : zq;
                qg[k] = *(const pg8::u32x4*)(gp + (size_t)(i + k) * 2816); }
#pragma unroll
            for (int k = 0; k < 4; ++k) {
                pg8::f32x4 pl, ph, cl, chh, nl, nh, gl, gh;
                pg8::bf8_to_f32(qa[k], pl, ph); pg8::bf8_to_f32(qa[k + 1], cl, chh); pg8::bf8_to_f32(qa[k + 2], nl, nh); pg8::bf8_to_f32(qg[k], gl, gh);
                const pg8::f32x4 sl = bl + w0l * pl + w1l * cl + w2l * nl, sh = bh + w0h * ph + w1h * chh + w2h * nh;
                pg8::f32x4 ol, oh;
#pragma unroll
                for (int j = 0; j < 4; ++j) { ol[j] = sl[j] * __builtin_amdgcn_rcpf(1.0f + __builtin_amdgcn_exp2f(sl[j] * -1.4426950408889634f)) * gl[j];
                                              oh[j] = sh[j] * __builtin_amdgcn_rcpf(1.0f + __builtin_amdgcn_exp2f(sh[j] * -1.4426950408889634f)) * gh[j]; }
                pg8::u32x4 w; w.x = pg8::cvt_pk_bf16(ol[0], ol[1]); w.y = pg8::cvt_pk_bf16(ol[2], ol[3]); w.z = pg8::cvt_pk_bf16(oh[0], oh[1]); w.w = pg8::cvt_pk_bf16(oh[2], oh[3]);
                *(pg8::u32x4*)(gp + (size_t)(i + k) * 2816) = w;
            }
            qa[0] = qa[4]; qa[1] = qa[5];
        }
    }
}
__device__ __forceinline__ void final_norm(const bf16* X2, const float* ss, const float* g, float* out, int TS, int gw, int NGW, int lane) {
    pg8::f32x4 g0[2], g1[2];
#pragma unroll
    for (int j = 0; j < 2; ++j) { g0[j] = *((const pg8::f32x4*)g + 2 * lane + 128 * j); g1[j] = *((const pg8::f32x4*)g + 2 * lane + 128 * j + 1); }
    for (int t = 2 * gw; t < TS; t += 2 * NGW) {
        pg8::u32x4 q[2][2]; float r[2];
#pragma unroll
        for (int k = 0; k < 2; ++k) { r[k] = rsqrtf(ss[t + k] * (1.0f / 1024.0f) + EPS);
#pragma unroll
            for (int j = 0; j < 2; ++j) q[k][j] = *((const pg8::u32x4*)(X2 + (size_t)(t + k) * 1024) + lane + 64 * j); }
#pragma unroll
        for (int k = 0; k < 2; ++k)
#pragma unroll
            for (int j = 0; j < 2; ++j) { pg8::f32x4 lo, hi; pg8::bf8_to_f32(q[k][j], lo, hi);
                pg8::f32x4* o = (pg8::f32x4*)(out + (size_t)(t + k) * 1024) + 2 * lane + 128 * j;
                o[0] = lo * g0[j] * r[k]; o[1] = hi * g1[j] * r[k]; }
    }
}
}

namespace {
constexpr int MLPW_W2 = 33 * 64, MLPW_W3 = MLPW_W2 + 4096, MLPW_B = MLPW_W3 + 4096, MLPW_N = MLPW_B + 256;
__device__ __forceinline__ float filt_z(int l, int j) {
    if (j == 0) return (float)((double)l / (double)(L - 1));
    const int i = (j - 1) & 15;
    const double band = 1e-4 + (double)i * ((15.0 - 1e-4) / 15.0);
    double rev = (double)l * band / (double)L;
    rev -= floor(rev);
    const float ang = (float)(rev * 6.283185307179586);
    return (j <= 16) ? cosf(ang) : -sinf(ang);
}
__device__ __forceinline__ void filter_mlp_rows2(const LAS float* wl, float* h3out, LAS float* scr, int l0, int l1, int j) {
    LAS float* za = scr; LAS float* zb = scr + 64;
    if (j < FEMB) { za[j] = filt_z(l0, j); zb[j] = filt_z(l1, j); }
    asm volatile("s_waitcnt lgkmcnt(0)" ::: "memory");
    const float a = wl[MLPW_B + 192 + j];
    float s0 = wl[MLPW_B + j], s1 = s0;
#pragma unroll 11
    for (int i = 0; i < FEMB; ++i) { const float w = wl[i * 64 + j]; s0 += za[i] * w; s1 += zb[i] * w; }
    asm volatile("s_waitcnt lgkmcnt(0)" ::: "memory");
    za[j] = sinf(a * s0); zb[j] = sinf(a * s1);
    asm volatile("s_waitcnt lgkmcnt(0)" ::: "memory");
    s0 = wl[MLPW_B + 64 + j]; s1 = s0;
#pragma unroll 8
    for (int i = 0; i < FHID; ++i) { const float w = wl[MLPW_W2 + i * 64 + j]; s0 += za[i] * w; s1 += zb[i] * w; }
    asm volatile("s_waitcnt lgkmcnt(0)" ::: "memory");
    za[j] = sinf(a * s0); zb[j] = sinf(a * s1);
    asm volatile("s_waitcnt lgkmcnt(0)" ::: "memory");
    s0 = wl[MLPW_B + 128 + j]; s1 = s0;
#pragma unroll 8
    for (int i = 0; i < FHID; ++i) { const float w = wl[MLPW_W3 + i * 64 + j]; s0 += za[i] * w; s1 += zb[i] * w; }
    h3out[l0 * FHID + j] = sinf(a * s0); h3out[l1 * FHID + j] = sinf(a * s1);
    asm volatile("s_waitcnt lgkmcnt(0)" ::: "memory");
}
typedef float f32x16_t __attribute__((ext_vector_type(16)));
__device__ __forceinline__ void stage_h3_rows32(const float* h3, int row0, LAS float* scr, int lane) {
#pragma unroll
    for (int i = 0; i < 8; ++i) { const int e = 4 * (lane + 64 * i), r = e >> 6, jj = e & 63;
        if (row0 + r < 4096) { const pg8::f32x4 v = *(const pg8::f32x4*)(h3 + (size_t)(row0 + r) * 64 + jj);
            LAS float* d = scr + r * 65 + jj; d[0] = v[0]; d[1] = v[1]; d[2] = v[2]; d[3] = v[3]; } }
}
__device__ __forceinline__ void filter_tables(const float* h3, const float* w4, const float* decay, float* fsum, float* fdif, LAS float* scr, int gw, int NGW, int lane) {
    const int r = lane & 31, h = lane >> 5;
    for (int it = gw; it < 2048; it += NGW) {
        const int c0 = (it & 31) * 32, nbase = (it >> 5) * 64;
        float af[32], ab[32];
#pragma unroll
        for (int kk = 0; kk < 32; ++kk) { af[kk] = w4[(2 * kk + h) * 2048 + c0 + r]; ab[kk] = w4[(2 * kk + h) * 2048 + 1024 + c0 + r]; }
        float dcf[16], dcb[16];
#pragma unroll
        for (int q = 0; q < 16; ++q) { const int c = c0 + (q & 3) + 8 * (q >> 2) + 4 * h; dcf[q] = fabsf(decay[c]); dcb[q] = fabsf(decay[1024 + c]); }
#pragma unroll 1
        for (int half = 0; half < 2; ++half) {
            const int n0 = nbase + 32 * half, n = n0 + r, nb = n ? 4096 - n : 0;
            stage_h3_rows32(h3, n0, scr, lane);
            stage_h3_rows32(h3, 4096 - n0 - 31, scr + 32 * 65, lane);
            asm volatile("s_waitcnt lgkmcnt(0)" ::: "memory");
            f32x16_t accF, accB;
#pragma unroll
            for (int q = 0; q < 16; ++q) { accF[q] = 0.f; accB[q] = 0.f; }
#pragma unroll
            for (int kk = 0; kk < 32; ++kk) {
                const float bF = scr[r * 65 + 2 * kk + h], bB = scr[32 * 65 + (31 - r) * 65 + 2 * kk + h];
                accF = __builtin_amdgcn_mfma_f32_32x32x2f32(af[kk], bF, accF, 0, 0, 0);
                accB = __builtin_amdgcn_mfma_f32_32x32x2f32(ab[kk], bB, accB, 0, 0, 0);
            }
            const float tf = (float)n * (1.0f / 4095.0f), tb = (float)nb * (1.0f / 4095.0f);
#pragma unroll
            for (int q = 0; q < 16; ++q) { const int c = c0 + (q & 3) + 8 * (q >> 2) + 4 * h;
                const float hf = accF[q] * expf(-tf * dcf[q]);
                const float hb = n ? accB[q] * expf(-tb * dcb[q]) : 0.f;
                fsum[(size_t)c * 4096 + n] = hf + hb;
                fdif[(size_t)c * 4096 + n] = hf - hb; }
            asm volatile("s_waitcnt lgkmcnt(0)" ::: "memory");
        }
    }
}
#define RLX_AGENT __ATOMIC_RELAXED, __HIP_MEMORY_SCOPE_AGENT
#define XB_TMO      128
#define XB_XCNT(j)  (256  + 64 * (j))
#define XB_XSUB(j)  (1280 + 64 * (j))
#define XB_XGEN(j)  (2304 + 64 * (j))
#define XB_TOP      3328
#define XB_TOPGEN   3392
#define XCD_BAR_WORDS 3456
#define XB_SPIN_CAP (1u << 18)

__device__ __forceinline__ unsigned xb_ld(unsigned* p)              { return __hip_atomic_load(p, __ATOMIC_RELAXED, __HIP_MEMORY_SCOPE_AGENT); }
__device__ __forceinline__ unsigned xb_add(unsigned* p, unsigned v) { return __hip_atomic_fetch_add(p, v, __ATOMIC_RELAXED, __HIP_MEMORY_SCOPE_AGENT); }
__device__ __forceinline__ unsigned xb_xcc_id() { return (unsigned)__builtin_amdgcn_s_getreg((3 << 11) | 20) & 0xFu; }
#define XB_SPIN(cond, bar) do { unsigned _sp = 0; while (cond) { __builtin_amdgcn_s_sleep(1); \
    if ((++_sp & 255u) == 0u) { if (xb_ld(&(bar)[XB_TMO])) break; if (_sp > XB_SPIN_CAP) { atomicAdd(&(bar)[XB_TMO], 1u); break; } } } } while (0)

struct XcdBarrier {
    unsigned* bar; unsigned x;
    volatile LAS unsigned* st;
};

__device__ __forceinline__ XcdBarrier xcd_barrier_post(unsigned* bar, volatile LAS unsigned* st) {
    XcdBarrier b; b.bar = bar; b.x = xb_xcc_id(); b.st = st;
    if (threadIdx.x == 0) (void)xb_add(&bar[XB_XCNT(b.x)], 1u);
    return b;
}
__device__ __forceinline__ void xcd_barrier_complete(unsigned* bar, unsigned x, unsigned& nloc, unsigned& nx) {
    const unsigned G = gridDim.x * gridDim.y * gridDim.z;
    unsigned sum, cnt, mine, sp = 0u;
    for (;;) {
        sum = 0u; cnt = 0u; mine = 0u;
#pragma unroll
        for (unsigned j = 0; j < 16; ++j) { const unsigned c = xb_ld(&bar[XB_XCNT(j)]); sum += c; cnt += (c > 0u) ? 1u : 0u; mine = (j == x) ? c : mine; }
        if (sum == G) break;
        __builtin_amdgcn_s_sleep(1);
        if ((++sp & 255u) == 0u) { if (xb_ld(&bar[XB_TMO])) break; if (sp > XB_SPIN_CAP) { atomicAdd(&bar[XB_TMO], 1u); break; } }
    }
    nloc = mine > 0u ? mine : 1u; nx = cnt > 0u ? cnt : 1u;
}

__device__ __forceinline__ void xcd_barrier(const XcdBarrier& b) {
    asm volatile("s_waitcnt vmcnt(0)" ::: "memory");
    __syncthreads();
    if (threadIdx.x == 0) {
        unsigned* bar = b.bar;
        __builtin_amdgcn_s_waitcnt(0);
        unsigned nloc = b.st[0], nx = b.st[1];
        if (nloc == 0u) { xcd_barrier_complete(bar, b.x, nloc, nx); b.st[0] = nloc; b.st[1] = nx; }
        const unsigned old = xb_add(&bar[XB_XSUB(b.x)], 1u);
        const unsigned gen = old / nloc;
        if (old + 1u == (gen + 1u) * nloc) {
            __builtin_amdgcn_fence(__ATOMIC_RELEASE, "agent");
            asm volatile("s_waitcnt vmcnt(0)" ::: "memory");
            const unsigned og = xb_add(&bar[XB_TOP], 1u);
            const unsigned tg = og / nx;
            if (og + 1u == (tg + 1u) * nx) xb_add(&bar[XB_TOPGEN], 1u);
            else XB_SPIN(xb_ld(&bar[XB_TOPGEN]) == tg, bar);
            __builtin_amdgcn_fence(__ATOMIC_ACQUIRE, "agent");
            xb_add(&bar[XB_XGEN(b.x)], 1u);
            asm volatile("s_waitcnt vmcnt(0)" ::: "memory");
        } else {
            XB_SPIN(xb_ld(&bar[XB_XGEN(b.x)]) == gen, bar);
            __builtin_amdgcn_fence(__ATOMIC_ACQUIRE, "agent");
            asm volatile("s_waitcnt vmcnt(0)" ::: "memory");
        }
    }
    __syncthreads();
}

constexpr size_t MiB = 1u << 20;
constexpr int M = NB * L;
constexpr size_t WS_VSS = 0, WS_XSS = 64 * 1024, WS_X2SS = 128 * 1024, WS_TTAB = 192 * 1024, WS_BAR = 256 * 1024, WS_H3 = 1 * MiB;
constexpr size_t WS_WTA = 2 * MiB, WS_WTB = 10 * MiB, WS_PAB = 16 * MiB, WS_WO = 20 * MiB;
constexpr size_t WS_FSUM = 24 * MiB, WS_WUP = 24 * MiB, WS_WDN = 35 * MiB;
constexpr size_t WS_HYT = 41 * MiB;
constexpr size_t WS_X1B = 41 * MiB, WS_MRG = 105 * MiB;
constexpr size_t WS_YAB = 169 * MiB;
constexpr size_t WS_FDIF = 233 * MiB;
constexpr size_t WS_AP = 73 * MiB, WS_GP = 161 * MiB;
static_assert(WS_GP + (size_t)M * FH * 2 <= 256 * MiB && WS_AP + (size_t)M * FH * 2 <= WS_GP && WS_FDIF + 16 * MiB <= 256 * MiB && WS_WDN + (size_t)D * FH * 2 <= WS_HYT, "d_ws map");
constexpr int LDS_BYTES = 147456;
constexpr int NPH = 10;

struct MegaArgs { const float* in[27]; float* out; unsigned char* ws; int ph_lo, ph_hi; WJobs wj; };

__global__ void __launch_bounds__(512, 2) mega_fwd(MegaArgs a) {
    extern __shared__ __attribute__((aligned(16))) unsigned char lds_raw[];
    LAS unsigned char* lds = (LAS unsigned char*)lds_raw;
    cg::grid_group grid = cg::this_grid();
    const int wave = __builtin_amdgcn_readfirstlane((int)threadIdx.x >> 6);
    const int G = gridDim.x, bid = blockIdx.x, gw = bid * 8 + wave, NGW = G * 8;
#define FRESH_TID int lane; asm volatile("v_mbcnt_lo_u32_b32 %0, -1, 0\n\tv_mbcnt_hi_u32_b32 %0, -1, %0" : "=v"(lane)); const int tid = wave * 64 + lane; (void)tid
    unsigned char* ws = a.ws;
    const float* x = a.in[0];
    float* vss = (float*)(ws + WS_VSS); float* xss = (float*)(ws + WS_XSS); float* x2ss = (float*)(ws + WS_X2SS);
    cf* Ttab = (cf*)(ws + WS_TTAB); float* h3 = (float*)(ws + WS_H3);
    bf16* WtA = (bf16*)(ws + WS_WTA); bf16* WtB = (bf16*)(ws + WS_WTB); bf16* PabT = (bf16*)(ws + WS_PAB); bf16* WoT = (bf16*)(ws + WS_WO);
    bf16* WupT = (bf16*)(ws + WS_WUP); bf16* WdnT = (bf16*)(ws + WS_WDN);
    float* fsum = (float*)(ws + WS_FSUM); float* fdif = (float*)(ws + WS_FDIF);
    bf16* hyvT = (bf16*)(ws + WS_HYT); bf16* yaT = hyvT + (size_t)1024 * M; bf16* vT = hyvT + (size_t)3072 * M;
    bf16* YAB = (bf16*)(ws + WS_YAB); bf16* h1 = YAB; bf16* Ub = YAB + 1024;
    bf16* Gb = (bf16*)a.out;
    bf16* mrg = (bf16*)(ws + WS_MRG); bf16* X1b = (bf16*)(ws + WS_X1B); float* X1 = a.out;
    bf16* APb = (bf16*)(ws + WS_AP); bf16* GPb = (bf16*)(ws + WS_GP);
    const int lo = a.ph_lo, hi = a.ph_hi;
#define IN(k) (lo <= (k) && (k) < hi)
    for (int u = (int)threadIdx.x; u < 16; u += 512) ((LAS unsigned*)(lds + LDS_BYTES - 256))[u] = 0u;
    __syncthreads();
    XcdBarrier xbar = xcd_barrier_post((unsigned*)(ws + WS_BAR), (volatile LAS unsigned*)(lds + LDS_BYTES - 256));
#ifdef MK_PROBE
#define STAMP(i) do { if (threadIdx.x == 0) ((volatile LAS unsigned long long*)(lds + LDS_BYTES - 128))[i] = __builtin_amdgcn_s_memrealtime(); } while (0)
#else
#define STAMP(i) do { } while (0)
#endif
    STAMP(0);
#define SEAM(k) do { if (IN(k) && IN((k) + 1)) { if ((k) == 0) grid.sync(); else xcd_barrier(xbar); } STAMP((k) + 1); } while (0)

    if (IN(0)) { FRESH_TID;
        p0_weights(a.wj, 0, 7, (LAS float*)lds + wave * 4096, gw, NGW, lane);
        for (int m = 4 * gw; m < M; m += 4 * NGW) rms_rows4_to_bf16(x + (size_t)m * 1024, a.in[1], h1 + (size_t)m * 2048, 2048, lane);
        for (int i = bid * 512 + tid; i < 3 * M; i += G * 512) vss[i] = 0.f;
        __syncthreads();
        { LAS float* wl = (LAS float*)lds;
          for (int i = tid; i < MLPW_N; i += 512) { float v;
              if (i < MLPW_W2) v = a.in[5][i]; else if (i < MLPW_W3) v = a.in[7][i - MLPW_W2]; else if (i < MLPW_B) v = a.in[9][i - MLPW_W3];
              else { const int q = i - MLPW_B; v = q < 64 ? a.in[6][q] : q < 128 ? a.in[8][q - 64] : q < 192 ? a.in[10][q - 128] : a.in[11][q - 192]; }
              wl[i] = v; }
          __syncthreads();
          for (int l = 2 * gw; l < L; l += 2 * NGW) filter_mlp_rows2(wl, h3, (LAS float*)(lds + 65536) + wave * 128, l, l + 1, lane); }
        for (int m = bid * 512 + tid; m < 4096; m += G * 512) { const float ang = (float)m / 4096.0f; Ttab[m] = cmk(cospif(ang), -sinpif(ang)); }
    }
    SEAM(0);
    if (IN(1)) { FRESH_TID;
        { pg8::Gemm g{WtA, h1, 4096, M, 1024, 1024, 2048}; pg8::StaticOrder S; S.init(4096, M, G, bid);
          pg8::EpiHyT E{hyvT, M, vss};
          pg8::gemm_phase<pg8::EpiHyT, pg8::StaticOrder, true, true>(lds, g, S, E, tid); }
        STAMP(11);
        { pg8::Gemm g{h1, WtB, M, 3072, 1024, 2048, 1024}; pg8::StaticOrder S; S.init(M, 3072, G, bid);
          pg8::EpiUG E{Ub, Gb, 2048};
          pg8::gemm_phase<pg8::EpiUG, pg8::StaticOrder, true, true>(lds, g, S, E, tid); }
        STAMP(12);
        filter_tables(h3, a.in[12], a.in[13], fsum, fdif, (LAS float*)(lds + wave * 17408), gw, NGW, lane);
    }
    SEAM(1);
    if (IN(2)) { FRESH_TID;
        HyArgs H; H.hyT = hyvT; H.yaT = yaT; H.fsum = fsum; H.fdif = fdif; H.cw = a.in[3]; H.cb = a.in[4]; H.skip = a.in[14]; H.T = Ttab;
        H.TS = M; H.npairs = 2; H.off00 = 0; H.off01 = L; H.off10 = 2 * L; H.off11 = 3 * L;
        hyena_phase((lcf)lds, H, bid, G, tid);
        STAMP(13);
        SguArgs Sg; Sg.vT = vT; Sg.U = Ub; Sg.vss = vss; Sg.ws = a.in[16]; Sg.bs = a.in[17]; Sg.gn = a.in[15]; Sg.TS = M; Sg.ldu = 2048;
        for (int it = bid; it < (M / 128) * 8; it += G) sgu_item(lds, Sg, it, tid);
    }
    SEAM(2);
    if (IN(3)) { FRESH_TID;
        transpose_ya(yaT, M, YAB, 2048, (LAS unsigned short*)lds + wave * 8192, gw, NGW, lane);
        p0_weights(a.wj, 7, 9, (LAS float*)lds + wave * 4096, gw, NGW, lane);
    }
    SEAM(3);
    if (IN(4)) { FRESH_TID;
        pg8::Gemm g{YAB, PabT, M, 1024, 2048, 2048, 2048}; pg8::StaticOrder S; S.init(M, 1024, G, bid);
        pg8::EpiMerge E{Gb, mrg};
        pg8::gemm_phase<pg8::EpiMerge, pg8::StaticOrder, true, true>(lds, g, S, E, tid);
    }
    SEAM(4);
    if (IN(5)) { FRESH_TID;
        pg8::Gemm g{mrg, WoT, M, 1024, 1024, 1024, 1024}; pg8::StaticOrder S; S.init(M, 1024, G, bid);
        pg8::EpiResid<true> E{x, nullptr, nullptr, X1b, xss};
        pg8::gemm_phase<pg8::EpiResid<true>, pg8::StaticOrder, true, true>(lds, g, S, E, tid);
    }
    SEAM(5);
    if (IN(6)) { FRESH_TID;
        pg8::Gemm g{X1b, WupT, M, 2 * FH, 1024, 1024, 1024}; pg8::StaticOrder S; S.init(M, 2 * FH, G, bid);
        pg8::EpiUp E{APb, GPb, xss};
        pg8::gemm_phase<pg8::EpiUp, pg8::StaticOrder, true, true>(lds, g, S, E, tid);
    }
    SEAM(6);
    if (IN(7)) { FRESH_TID; act_pass(APb, GPb, a.in[23], a.in[24], M, bid * 512 + tid, G * 512); }
    SEAM(7);
    if (IN(8)) { FRESH_TID;
        pg8::Gemm g{GPb, WdnT, M, 1024, FH, FH, FH}; pg8::StaticOrder S; S.init(M, 1024, G, bid);
        pg8::EpiResid<false> E{nullptr, X1b, nullptr, X1b, x2ss};
        pg8::gemm_phase<pg8::EpiResid<false>, pg8::StaticOrder, true, true>(lds, g, S, E, tid);
    }
    SEAM(8);
    if (IN(9)) { FRESH_TID; final_norm(X1b, x2ss, a.in[26], a.out, M, gw, NGW, lane); }
    STAMP(10);
#ifdef MK_PROBE
#ifndef MK_PROBE_A
#define MK_PROBE_A MK_PROBE
#define MK_PROBE_B (MK_PROBE + 1)
#endif
    if (threadIdx.x == 0) { volatile LAS unsigned long long* ts = (volatile LAS unsigned long long*)(lds + LDS_BYTES - 128);
        const unsigned long long dt = 2ull * (ts[MK_PROBE_B] - ts[MK_PROBE_A]), t0 = __builtin_amdgcn_s_memrealtime();
        while (__builtin_amdgcn_s_memrealtime() - t0 < dt) __builtin_amdgcn_s_sleep(8); }
    __syncthreads();
#endif
#undef IN
#undef SEAM
}
}

#ifndef MK_CUTS
#define MK_CUTS 0
#endif
extern "C" void kernel_launch(void* const* d_in, const int* in_sizes, int n_in, void* d_out, int out_size, void* d_ws, size_t ws_size, hipStream_t stream) {
    static int grid = 0;
    if (grid == 0) {
        int dev = 0, cus = 0, per_cu = 0;
        hipGetDevice(&dev);
        hipDeviceGetAttribute(&cus, hipDeviceAttributeMultiprocessorCount, dev);
        hipFuncSetAttribute((const void*)mega_fwd, hipFuncAttributeMaxDynamicSharedMemorySize, LDS_BYTES);
        hipOccupancyMaxActiveBlocksPerMultiprocessor(&per_cu, (const void*)mega_fwd, 512, LDS_BYTES);
        if (per_cu < 1) { fprintf(stderr, "kernel_launch: occupancy query says %d blocks per CU\n", per_cu); per_cu = 1; }
        grid = cus * 1;
        (void)hipGetLastError();
    }
    hipMemsetAsync((char*)d_ws + WS_BAR, 0, XCD_BAR_WORDS * 4, stream);
    MegaArgs a{};
    for (int i = 0; i < 27; ++i) a.in[i] = (const float*)d_in[i];
    a.out = (float*)d_out; a.ws = (unsigned char*)d_ws;
    { unsigned char* ws = (unsigned char*)d_ws;
      bf16* WtA = (bf16*)(ws + WS_WTA); bf16* WtB = (bf16*)(ws + WS_WTB); bf16* PabT = (bf16*)(ws + WS_PAB); bf16* WoT = (bf16*)(ws + WS_WO); bf16* WupT = (bf16*)(ws + WS_WUP); bf16* WdnT = (bf16*)(ws + WS_WDN);
    a.wj.j[0] = WJob{(const float*)d_in[2], nullptr, WtA, 1024, INW, 0, 3072, 1024, 0, 0, 0};
    a.wj.j[1] = WJob{(const float*)d_in[2], nullptr, WtA, 1024, INW, 4096, 1024, 1024, 3072, 0, 0};
    a.wj.j[2] = WJob{(const float*)d_in[2], nullptr, WtB, 1024, INW, 3072, 1024, 1024, 0, 0, 0};
    a.wj.j[3] = WJob{(const float*)d_in[2], nullptr, WtB, 1024, INW, 5120, 2048, 1024, 1024, 0, 0};
    a.wj.j[4] = WJob{(const float*)d_in[18], nullptr, PabT, 1024, 1024, 0, 1024, 2048, 0, 0, 0};
    a.wj.j[5] = WJob{(const float*)d_in[19], nullptr, PabT, 1024, 1024, 0, 1024, 2048, 0, 1024, 0};
    a.wj.j[6] = WJob{(const float*)d_in[20], nullptr, WoT, 1024, 1024, 0, 1024, 1024, 0, 0, 0};
    a.wj.j[7] = WJob{(const float*)d_in[22], (const float*)d_in[21], WupT, 1024, 2 * FH, 0, 2 * FH, 1024, 0, 0, 0};
    a.wj.j[8] = WJob{(const float*)d_in[25], nullptr, WdnT, FH, 1024, 0, 1024, FH, 0, 0, 0};

    }
#if MK_CUTS
    for (int p = 0; p < NPH; ++p) { a.ph_lo = p; a.ph_hi = p + 1; hipLaunchKernelGGL(mega_fwd, dim3(grid), dim3(512), LDS_BYTES, stream, a); }
#else
    a.ph_lo = 0; a.ph_hi = NPH;
    void* args[] = {&a};
    hipError_t e = hipLaunchCooperativeKernel((const void*)mega_fwd, dim3(grid), dim3(512), args, LDS_BYTES, stream);
    if (e != hipSuccess) fprintf(stderr, "cooperative launch failed: %s (grid %d)\n", hipGetErrorString(e), grid);
#endif
}
```

```cpp
#include <hip/hip_runtime.h>
#include <hip/hip_cooperative_groups.h>
#include <math.h>
#include <stdint.h>
#include <cstdio>
namespace cg = cooperative_groups;
namespace pg8 {
#define PG8_LAS __attribute__((address_space(3)))
typedef unsigned short bf16_t;
typedef short bf16x8 __attribute__((ext_vector_type(8)));
typedef float f32x4 __attribute__((ext_vector_type(4)));
typedef unsigned u32x4 __attribute__((ext_vector_type(4)));
constexpr int BM = 256, BK = 64, HALF = 128, HTB = HALF * BK * 2  , STAGE_BYTES = 8 * HTB, NXCD = 8, WGM = 8;

__host__ __device__ __forceinline__ int lds_byte(int r, int c) { const int st = (r >> 4) * 2 + (c >> 5), rr = r & 15, cc = c & 31, ob = rr * 64 + cc * 2; return st * 1024 + (ob ^ (((ob >> 9) & 1) << 5)); }
__host__ __device__ __forceinline__ void stage_rc(int b, int& R, int& C) { const int st = b / 1024, sb = b % 1024, swz = sb ^ (((sb >> 9) & 1) << 5); R = (st >> 1) * 16 + swz / 64; C = (st & 1) * 32 + (swz % 64) / 2; }
__host__ __device__ __forceinline__ int perm32(int rho) { const int n = rho >> 4, i = rho & 15; return 8 * (i >> 2) + 4 * n + (i & 3); }

struct Unit { int pm, pn; };
struct Gemm { const bf16_t* A; const bf16_t* Bt; int M, N, K, lda, ldb; };

struct StaticOrder {
    int nM, nN, nwg, G, c;
    __host__ __device__ __forceinline__ void init(int M, int N, int G_, int c_) { nM = M / BM; nN = N / BM; nwg = nM * nN; G = G_; c = c_; }
    __host__ __device__ __forceinline__ bool next(int i, Unit& u) const {
        const long L = (long)i * G + c; if (L >= nwg) return false;
        int wgid = (int)L; { const int q = nwg / NXCD, r = nwg % NXCD, xcd = wgid % NXCD, off = wgid / NXCD; wgid = (xcd < r ? xcd * (q + 1) : r * (q + 1) + (xcd - r) * q) + off; }
        const int nig = WGM * nN, gid = wgid / nig, fm = gid * WGM, gsz = (nM - fm) < WGM ? (nM - fm) : WGM;
        u.pm = fm + ((wgid % nig) % gsz); u.pn = (wgid % nig) / gsz; return true;
    }
    __device__ __forceinline__ void a_ready(const Unit&) const {}
    __device__ __forceinline__ void done(const Unit&) const {}
};

__device__ __forceinline__ unsigned cvt_pk_bf16(float lo, float hi) { unsigned r; asm volatile("v_cvt_pk_bf16_f32 %0, %1, %2" : "=v"(r) : "v"(lo), "v"(hi)); return r; }
typedef float f32x2 __attribute__((ext_vector_type(2)));
__device__ __forceinline__ f32x2 gelu_pk(f32x2 v) {
    const f32x2 av = __builtin_elementwise_abs(v), d = av * 0.2316418882f + 1.0f;
    f32x2 t; t.x = __builtin_amdgcn_rcpf(d.x); t.y = __builtin_amdgcn_rcpf(d.y);
    f32x2 q = t * 0.5307027145f + (-0.7265760135f); q = q * t + 0.7107068705f; q = q * t + (-0.142248368f); q = q * t + 0.127414796f; q = q * t;
    const f32x2 s = (v * v) * (-0.72134752044f);
    f32x2 e; e.x = __builtin_amdgcn_exp2f(s.x); e.y = __builtin_amdgcn_exp2f(s.y);
    const f32x2 m = v * (q * e), r = v - m;
    f32x2 o; o.x = v.x < 0.f ? m.x : r.x; o.y = v.y < 0.f ? m.y : r.y; return o;
}

template <int ACT  > struct EpiBf16 {
    static constexpr bool PERM = true, AFTER_DRAIN = false, MID = false; static_assert(ACT == 0 || ACT == 1, "EpiBf16: ACT is 0 (none) or 1 (gelu_pk)");
    bf16_t* O; int ldc; const float* bias; int split_cols; size_t split_stride; float scale0;
    __device__ __forceinline__ void operator()(const f32x4 (&acc)[2][2][4][2], const Unit& u, int wr, int wc, int fr, int fq) const {
        const int row0 = u.pm * BM + wr * 64 + fr; int colt = u.pn * BM; bf16_t* base = O;
        float sc = 1.f; if (split_cols) { const int t = colt / split_cols; base += (size_t)t * split_stride; colt -= t * split_cols; if (t == 0) sc = scale0; }
        const int col0 = colt + wc * 32 + 8 * fq, bcol0 = u.pn * BM + wc * 32 + 8 * fq;
        f32x4 bv[2][2];
#pragma unroll
        for (int bj = 0; bj < 2; ++bj)
#pragma unroll
            for (int n = 0; n < 2; ++n) bv[bj][n] = bias ? *(const f32x4*)(bias + bcol0 + bj * HALF + 4 * n) : (f32x4){0.f, 0.f, 0.f, 0.f};
#pragma unroll
        for (int ai = 0; ai < 2; ++ai)
#pragma unroll
            for (int m = 0; m < 4; ++m) { bf16_t* rowp = base + (size_t)(row0 + ai * HALF + m * 16) * ldc + col0;
#pragma unroll
                for (int bj = 0; bj < 2; ++bj) { f32x4 v0 = acc[ai][bj][m][0] + bv[bj][0], v1 = acc[ai][bj][m][1] + bv[bj][1];
                    if (ACT == 1) { f32x2 a = gelu_pk((f32x2){v0[0], v0[1]}), b = gelu_pk((f32x2){v0[2], v0[3]}), c = gelu_pk((f32x2){v1[0], v1[1]}), d = gelu_pk((f32x2){v1[2], v1[3]});
                        v0 = (f32x4){a.x, a.y, b.x, b.y}; v1 = (f32x4){c.x, c.y, d.x, d.y}; }
                    v0 = v0 * sc; v1 = v1 * sc; u32x4 w; w.x = cvt_pk_bf16(v0[0], v0[1]); w.y = cvt_pk_bf16(v0[2], v0[3]); w.z = cvt_pk_bf16(v1[0], v1[1]); w.w = cvt_pk_bf16(v1[2], v1[3]);
                    *(u32x4*)(rowp + bj * HALF) = w; } }
    }
};

struct EpiF32 {
    static constexpr bool PERM = false, AFTER_DRAIN = false, MID = false;
    float* C; int ldc; const float* bias;
    __device__ __forceinline__ void operator()(const f32x4 (&acc)[2][2][4][2], const Unit& u, int wr, int wc, int fr, int fq) const {
        const int row0 = u.pm * BM + wr * 64 + fr, col0 = u.pn * BM + wc * 32 + 4 * fq;
        f32x4 bv[2][2];
#pragma unroll
        for (int bj = 0; bj < 2; ++bj)
#pragma unroll
            for (int n = 0; n < 2; ++n) bv[bj][n] = bias ? *(const f32x4*)(bias + col0 + bj * HALF + n * 16) : (f32x4){0.f, 0.f, 0.f, 0.f};
#pragma unroll
        for (int ai = 0; ai < 2; ++ai)
#pragma unroll
            for (int m = 0; m < 4; ++m) { float* rowp = C + (size_t)(row0 + ai * HALF + m * 16) * ldc + col0;
#pragma unroll
                for (int bj = 0; bj < 2; ++bj)
#pragma unroll
                    for (int n = 0; n < 2; ++n) *(f32x4*)(rowp + bj * HALF + n * 16) = acc[ai][bj][m][n] + bv[bj][n]; }
    }
};

template <class Epi, class Sched, bool ALIGN_EPI = false, bool SP2 = false>
__device__ __forceinline__ void gemm_phase(PG8_LAS unsigned char* lds, const Gemm g, const Sched& S, const Epi& E, const int tid) {
    const int wid = __builtin_amdgcn_readfirstlane(tid >> 6), lane = tid & 63, wr = wid >> 2, wc = wid & 3, fr = lane & 15, fq = lane >> 4;
    const int K = g.K, nt = K / BK;
    unsigned voffA[2], voffB[2];
#pragma unroll
    for (int i = 0; i < 2; ++i) { int R, C; stage_rc(tid * 16 + i * 8192, R, C); const int Rb = Epi::PERM ? ((R & ~31) + perm32(R & 31)) : R;
        voffA[i] = (unsigned)(R * g.lda + C) * 2u; voffB[i] = (unsigned)(Rb * g.ldb + C) * 2u; }
    const size_t kstep = (size_t)(BK * 2);
    const size_t hstepA = (size_t)HALF * g.lda * 2, hstepB = (size_t)HALF * g.ldb * 2;
    const size_t tstepA = 2 * hstepA, tstepB = 2 * hstepB;
    const unsigned ldsw = (unsigned)wid * 1024u;
    const int aoff = lds_byte(wr * 64 + fr, fq * 8), boff = lds_byte(wc * 32 + fr, fq * 8);
#define PG8_SA(b, h) (((b) * 2 + (h)) * HTB)
#define PG8_SB(b, h) ((4 + (b) * 2 + (h)) * HTB)
#define PG8_STAGE(bufoff, gbase, voff) do { _Pragma("unroll") for (int _i = 0; _i < 2; ++_i) \
        __builtin_amdgcn_global_load_lds((const unsigned*)((const char*)(gbase) + (voff)[_i]), (PG8_LAS unsigned*)(lds + (bufoff) + ldsw + _i * 8192), 16, 0, 0); } while (0)
#define PG8_LDA(dst, b, h) do { _Pragma("unroll") for (int m = 0; m < 4; ++m) _Pragma("unroll") for (int k = 0; k < 2; ++k) dst[m][k] = *(const PG8_LAS bf16x8*)(lds + PG8_SA(b, h) + aoff + m * 2048 + k * 1024); } while (0)
#define PG8_LDB(dst, b, h) do { _Pragma("unroll") for (int n = 0; n < 2; ++n) _Pragma("unroll") for (int k = 0; k < 2; ++k) dst[n][k] = *(const PG8_LAS bf16x8*)(lds + PG8_SB(b, h) + boff + n * 2048 + k * 1024); } while (0)
#define PG8_MMA(ai, bj, At, Bt) do { __builtin_amdgcn_s_setprio(1); _Pragma("unroll") for (int m = 0; m < 4; ++m) _Pragma("unroll") for (int n = 0; n < 2; ++n) _Pragma("unroll") for (int k = 0; k < 2; ++k) \
        acc[ai][bj][m][n] = __builtin_amdgcn_mfma_f32_16x16x32_bf16(Bt[n][k], At[m][k], acc[ai][bj][m][n], 0, 0, 0); __builtin_amdgcn_s_setprio(0); } while (0)
#define PG8_WAIT_V(n) asm volatile("s_waitcnt vmcnt(" #n ")" ::: "memory")
#define PG8_WAIT_L(n) asm volatile("s_waitcnt lgkmcnt(" #n ")" ::: "memory")
#define PG8_BAR __builtin_amdgcn_s_barrier()
#define PG8_SCHED __builtin_amdgcn_sched_barrier(0)
    Unit cur, nxt; int ui = 0;
    if (!S.next(0, cur)) return;
    f32x4 acc[2][2][4][2];
#pragma unroll
    for (int a = 0; a < 2; ++a)
#pragma unroll
        for (int b = 0; b < 2; ++b)
#pragma unroll
            for (int m = 0; m < 4; ++m)
#pragma unroll
                for (int n = 0; n < 2; ++n) acc[a][b][m][n] = (f32x4){0.f, 0.f, 0.f, 0.f};
    bf16x8 At[4][2], B0[2][2], B1[2][2];
    const char* cA = (const char*)g.A + (size_t)cur.pm * tstepA; const char* cB = (const char*)g.Bt + (size_t)cur.pn * tstepB;
    S.a_ready(cur);
    if constexpr (SP2) {
        PG8_STAGE(PG8_SB(0, 0), cB, voffB); PG8_STAGE(PG8_SB(0, 1), cB + hstepB, voffB); PG8_STAGE(PG8_SA(0, 0), cA, voffA); PG8_STAGE(PG8_SA(0, 1), cA + hstepA, voffA);
        if (wr == 1) PG8_BAR;
        PG8_WAIT_V(2); PG8_BAR;
        PG8_STAGE(PG8_SB(1, 0), cB + kstep, voffB); PG8_STAGE(PG8_SA(1, 0), cA + kstep, voffA); PG8_STAGE(PG8_SB(1, 1), cB + hstepB + kstep, voffB);
        PG8_WAIT_V(6); PG8_BAR;
    } else {
        PG8_STAGE(PG8_SB(0, 0), cB, voffB); PG8_STAGE(PG8_SA(0, 0), cA, voffA); PG8_STAGE(PG8_SB(0, 1), cB + hstepB, voffB); PG8_STAGE(PG8_SA(0, 1), cA + hstepA, voffA);
        if (wr == 1) PG8_BAR;
        PG8_WAIT_V(4); PG8_BAR;
        PG8_STAGE(PG8_SB(1, 0), cB + kstep, voffB); PG8_STAGE(PG8_SA(1, 0), cA + kstep, voffA); PG8_STAGE(PG8_SB(1, 1), cB + hstepB + kstep, voffB);
        PG8_WAIT_V(6); PG8_BAR;
    }
    for (;;) {
        const bool has_next = S.next(ui + 1, nxt);
        const char* nA = has_next ? (const char*)g.A + (size_t)nxt.pm * tstepA : cA; const char* nB = has_next ? (const char*)g.Bt + (size_t)nxt.pn * tstepB : cB;
        for (int t = 0; t < nt; t += 2) {
            const bool last = (t == nt - 2);
            const char* a1 = cA + (size_t)(t + 1) * kstep;
            const char* a2 = last ? nA : cA + (size_t)(t + 2) * kstep; const char* b2 = last ? nB : cB + (size_t)(t + 2) * kstep;
            const char* a3 = a2 + kstep; const char* b3 = b2 + kstep;
            if (last && has_next) S.a_ready(nxt);
            if constexpr (Epi::MID) { if (t == (nt >> 1)) E.mid(acc, cur, wr, wc, fr, fq); }
            if constexpr (SP2) {
            PG8_LDB(B0, 0, 0); PG8_LDB(B1, 0, 1); PG8_SCHED; PG8_LDA(At, 0, 0); PG8_STAGE(PG8_SA(1, 1), a1 + hstepA, voffA);
            PG8_WAIT_V(8); PG8_WAIT_L(0); PG8_BAR; PG8_MMA(0, 0, At, B0); PG8_MMA(0, 1, At, B1); PG8_BAR; PG8_SCHED;
            PG8_LDA(At, 0, 1); PG8_STAGE(PG8_SB(0, 0), b2, voffB); PG8_STAGE(PG8_SB(0, 1), b2 + hstepB, voffB); PG8_STAGE(PG8_SA(0, 0), a2, voffA);
            PG8_WAIT_V(8); PG8_WAIT_L(0); PG8_BAR; PG8_MMA(1, 0, At, B0); PG8_MMA(1, 1, At, B1); PG8_BAR; PG8_SCHED;
            PG8_LDB(B0, 1, 0); PG8_LDB(B1, 1, 1); PG8_SCHED; PG8_LDA(At, 1, 0); PG8_STAGE(PG8_SA(0, 1), a2 + hstepA, voffA);
            PG8_WAIT_V(8); PG8_WAIT_L(0); PG8_BAR; PG8_MMA(0, 0, At, B0); PG8_MMA(0, 1, At, B1); PG8_BAR; PG8_SCHED;
            PG8_LDA(At, 1, 1); PG8_STAGE(PG8_SB(1, 0), b3, voffB); PG8_STAGE(PG8_SB(1, 1), b3 + hstepB, voffB); PG8_STAGE(PG8_SA(1, 0), a3, voffA);
            PG8_WAIT_V(8); PG8_WAIT_L(0); PG8_BAR; PG8_MMA(1, 0, At, B0); PG8_MMA(1, 1, At, B1); PG8_BAR; PG8_SCHED;
            } else {
            PG8_LDB(B0, 0, 0); PG8_SCHED; PG8_LDA(At, 0, 0); PG8_STAGE(PG8_SA(1, 1), a1 + hstepA, voffA);
            PG8_WAIT_L(8); PG8_BAR; PG8_WAIT_L(0); PG8_MMA(0, 0, At, B0); PG8_BAR; PG8_SCHED;
            PG8_LDB(B1, 0, 1); PG8_STAGE(PG8_SB(0, 0), b2, voffB);
            PG8_BAR; PG8_WAIT_L(0); PG8_MMA(0, 1, At, B1); PG8_BAR;
            PG8_LDA(At, 0, 1); PG8_STAGE(PG8_SA(0, 0), a2, voffA);
            PG8_BAR; PG8_WAIT_L(0); PG8_MMA(1, 0, At, B0); PG8_BAR; PG8_SCHED;
            PG8_STAGE(PG8_SB(0, 1), b2 + hstepB, voffB);
            PG8_WAIT_V(6); PG8_BAR; PG8_MMA(1, 1, At, B1); PG8_BAR;
            PG8_LDB(B0, 1, 0); PG8_SCHED; PG8_LDA(At, 1, 0); PG8_STAGE(PG8_SA(0, 1), a2 + hstepA, voffA);
            PG8_WAIT_L(8); PG8_BAR; PG8_WAIT_L(0); PG8_MMA(0, 0, At, B0); PG8_BAR; PG8_SCHED;
            PG8_LDB(B1, 1, 1); PG8_STAGE(PG8_SB(1, 0), b3, voffB);
            PG8_BAR; PG8_WAIT_L(0); PG8_MMA(0, 1, At, B1); PG8_BAR;
            PG8_LDA(At, 1, 1); PG8_STAGE(PG8_SA(1, 0), a3, voffA);
            PG8_BAR; PG8_WAIT_L(0); PG8_MMA(1, 0, At, B0); PG8_BAR; PG8_SCHED;
            PG8_STAGE(PG8_SB(1, 1), b3 + hstepB, voffB);
            PG8_WAIT_V(6); PG8_BAR; PG8_MMA(1, 1, At, B1); PG8_BAR;
            }
        }
        if constexpr (ALIGN_EPI) { if (wr == 0) PG8_BAR; }
        if constexpr (!Epi::AFTER_DRAIN) { E(acc, cur, wr, wc, fr, fq); S.done(cur); }
        if (!has_next) break;
#pragma unroll
        for (int a = 0; a < 2; ++a)
#pragma unroll
            for (int b = 0; b < 2; ++b)
#pragma unroll
                for (int m = 0; m < 4; ++m)
#pragma unroll
                    for (int n = 0; n < 2; ++n) acc[a][b][m][n] = (f32x4){0.f, 0.f, 0.f, 0.f};
        cur = nxt; cA = nA; cB = nB; ++ui;
        if constexpr (ALIGN_EPI) { if (wr == 1) PG8_BAR; }
    }
    PG8_WAIT_V(0);
    if constexpr (!ALIGN_EPI) { if (wr == 0) PG8_BAR; }
    PG8_BAR;
    if constexpr (Epi::AFTER_DRAIN) { E.fused(acc, cur, wr, wc, fr, fq, lds, wid, lane); S.done(cur); }
#undef PG8_SA
#undef PG8_SB
#undef PG8_STAGE
#undef PG8_LDA
#undef PG8_LDB
#undef PG8_MMA
#undef PG8_WAIT_V
#undef PG8_WAIT_L
#undef PG8_BAR
#undef PG8_SCHED
}
}
namespace {
constexpr int D = 1024, NB = 4, L = 4096, HW = 1024, SW = 1024, INW = 7168, FH = 2816, FHID = 64, FEMB = 33;
constexpr float EPS = 1e-6f;
typedef unsigned short bf16;
__device__ __forceinline__ unsigned f2bf(float f) { unsigned u = __builtin_bit_cast(unsigned, f); return (u + 0x7fffu + ((u >> 16) & 1u)) >> 16; }
__device__ __forceinline__ void block_sync() { __builtin_amdgcn_fence(__ATOMIC_RELEASE, "workgroup"); __builtin_amdgcn_s_barrier(); __builtin_amdgcn_fence(__ATOMIC_ACQUIRE, "workgroup"); }
}
namespace {
#define HD __device__ __forceinline__
#define FFT_OPAQUE(w) asm volatile("" : "+v"((w).x), "+v"((w).y))
#ifndef HD
#define HD inline
#endif
typedef float cfv __attribute__((ext_vector_type(2)));
struct cf { float x, y; };
HD cf cmk(float x, float y) { cf r; r.x = x; r.y = y; return r; }
template <class P> HD cf ldz(P Z, int i) { const cfv t = Z[i]; return cmk(t.x, t.y); }
template <class P> HD void stz(P Z, int i, cf v) { Z[i] = (cfv){v.x, v.y}; }
HD cf cadd(cf a, cf b) { return cmk(a.x + b.x, a.y + b.y); }
HD cf csub(cf a, cf b) { return cmk(a.x - b.x, a.y - b.y); }
HD cf cmul(cf a, cf b) { return cmk(a.x * b.x - a.y * b.y, a.x * b.y + a.y * b.x); }
HD cf cconj(cf a) { return cmk(a.x, -a.y); }
template <bool INV> HD cf mulmi(cf a) { return INV ? cmk(-a.y, a.x) : cmk(a.y, -a.x); }
template <bool INV> HD cf twc(float c, float s) { return INV ? cmk(c, s) : cmk(c, -s); }
HD int fpad(int p) { return p + (p >> 4); }
constexpr int FSUB = 4352;

template <bool INV> HD void dft4(cf& a, cf& b, cf& c, cf& d) {
    const cf t0 = cadd(a, c), t1 = csub(a, c), t2 = cadd(b, d), t3 = mulmi<INV>(csub(b, d));
    a = cadd(t0, t2); b = cadd(t1, t3); c = csub(t0, t2); d = csub(t1, t3);
}
template <bool INV> HD void dft16(cf (&v)[16]) {
    constexpr float C1 = 0.92387953251128674f, S1 = 0.38268343236508977f, R = 0.70710678118654752f;
#pragma unroll
    for (int n0 = 0; n0 < 4; ++n0) dft4<INV>(v[n0], v[n0 + 4], v[n0 + 8], v[n0 + 12]);
    v[1 + 4 * 1] = cmul(v[1 + 4 * 1], twc<INV>(C1, S1));
    v[1 + 4 * 2] = cmul(v[1 + 4 * 2], twc<INV>(R, R));
    v[1 + 4 * 3] = cmul(v[1 + 4 * 3], twc<INV>(S1, C1));
    v[2 + 4 * 1] = cmul(v[2 + 4 * 1], twc<INV>(R, R));
    v[2 + 4 * 2] = mulmi<INV>(v[2 + 4 * 2]);
    v[2 + 4 * 3] = cmul(v[2 + 4 * 3], twc<INV>(-R, R));
    v[3 + 4 * 1] = cmul(v[3 + 4 * 1], twc<INV>(S1, C1));
    v[3 + 4 * 2] = cmul(v[3 + 4 * 2], twc<INV>(-R, R));
    v[3 + 4 * 3] = cmul(v[3 + 4 * 3], twc<INV>(-C1, -S1));
#pragma unroll
    for (int k0 = 0; k0 < 4; ++k0) dft4<INV>(v[4 * k0], v[4 * k0 + 1], v[4 * k0 + 2], v[4 * k0 + 3]);
    cf t;
    t = v[1]; v[1] = v[4]; v[4] = t;   t = v[2]; v[2] = v[8]; v[8] = t;   t = v[3]; v[3] = v[12]; v[12] = t;
    t = v[6]; v[6] = v[9]; v[9] = t;   t = v[7]; v[7] = v[13]; v[13] = t; t = v[11]; v[11] = v[14]; v[14] = t;
}
#ifndef FFT_OPAQUE
#define FFT_OPAQUE(w)
#endif
HD void twiddle16(cf (&v)[16], cf w) {
    FFT_OPAQUE(w);
    cf p = w;
#pragma unroll
    for (int k = 1; k < 16; ++k) { v[k] = cmul(v[k], p); if (k < 15) p = cmul(p, w); }
}
template <class P> HD void fwd_pass1(P Z, int t, cf w1) {
    cf v[16]; const int b = t + (t >> 4);
#pragma unroll
    for (int j = 0; j < 16; ++j) v[j] = ldz(Z, b + 272 * j);
    dft16<false>(v); twiddle16(v, w1);
#pragma unroll
    for (int j = 0; j < 16; ++j) stz(Z, b + 272 * j, v[j]);
}
template <class P> HD void fwd_pass2(P Z, int t, cf w2) {
    const int b = 272 * (t >> 4) + (t & 15);
    cf v[16];
#pragma unroll
    for (int j = 0; j < 16; ++j) v[j] = ldz(Z, b + 17 * j);
    dft16<false>(v); twiddle16(v, w2);
#pragma unroll
    for (int j = 0; j < 16; ++j) stz(Z, b + 17 * j, v[j]);
}
template <class P> HD void fwd_pass3_load(P Z, int t, cf (&v)[16]) {
#pragma unroll
    for (int j = 0; j < 16; ++j) v[j] = ldz(Z, 17 * t + j);
    dft16<false>(v);
}
template <class P> HD void inv_pass1_store(P Z, int t, cf (&v)[16]) {
    dft16<true>(v);
#pragma unroll
    for (int j = 0; j < 16; ++j) stz(Z, 17 * t + j, v[j]);
}
template <class P> HD void inv_pass2(P Z, int t, cf w2) {
    const int b = 272 * (t >> 4) + (t & 15);
    cf v[16];
#pragma unroll
    for (int j = 0; j < 16; ++j) v[j] = ldz(Z, b + 17 * j);
    twiddle16(v, cconj(w2)); dft16<true>(v);
#pragma unroll
    for (int j = 0; j < 16; ++j) stz(Z, b + 17 * j, v[j]);
}
template <class P> HD void inv_pass3(P Z, int t, cf w1) {
    cf v[16]; const int b = t + (t >> 4);
#pragma unroll
    for (int j = 0; j < 16; ++j) v[j] = ldz(Z, b + 272 * j);
    twiddle16(v, cconj(w1)); dft16<true>(v);
#pragma unroll
    for (int j = 0; j < 16; ++j) stz(Z, b + 272 * j, v[j]);
}
#define LAS __attribute__((address_space(3)))
typedef LAS cfv* lcf;
struct HyArgs {
    const bf16* hyT;
    bf16* yaT;
    const float* fsum;
    const float* fdif;
    const float* cw;
    const float* cb;
    const float* skip;
    const cfv* T;
    int TS, npairs, off00, off01, off10, off11;
};
__device__ __forceinline__ float bf2f(unsigned h) { return __builtin_bit_cast(float, h << 16); }
__device__ __forceinline__ unsigned long long ald64(const char* p) { return __hip_atomic_load((const unsigned long long*)p, __ATOMIC_RELAXED, __HIP_MEMORY_SCOPE_AGENT); }
__device__ __forceinline__ unsigned ald16(const char* p) { return (unsigned)__hip_atomic_load((const unsigned short*)p, __ATOMIC_RELAXED, __HIP_MEMORY_SCOPE_AGENT); }
struct Raw8 { unsigned long long lo, hi; unsigned lft, rgt; };
__device__ __forceinline__ Raw8 load_raw8(const bf16* row, unsigned boff, unsigned loff, unsigned roff) {
    const char* b = (const char*)row;
    Raw8 r; r.lo = ald64(b + boff); r.hi = ald64(b + boff + 8); r.lft = ald16(b + loff); r.rgt = ald16(b + roff);
    return r;
}
__device__ __forceinline__ void conv8r(const Raw8& r, bool has_l, bool has_r, float w0, float w1, float w2, float b, float (&o)[8]) {
    float x[10];
    const unsigned q0 = (unsigned)r.lo, q1 = (unsigned)(r.lo >> 32), q2 = (unsigned)r.hi, q3 = (unsigned)(r.hi >> 32);
    x[0] = has_l ? bf2f(r.lft) : 0.f; x[9] = has_r ? bf2f(r.rgt) : 0.f;
    x[1] = bf2f(q0 & 0xffffu); x[2] = bf2f(q0 >> 16); x[3] = bf2f(q1 & 0xffffu); x[4] = bf2f(q1 >> 16);
    x[5] = bf2f(q2 & 0xffffu); x[6] = bf2f(q2 >> 16); x[7] = bf2f(q3 & 0xffffu); x[8] = bf2f(q3 >> 16);
#pragma unroll
    for (int i = 0; i < 8; ++i) o[i] = b + w0 * x[i] + w1 * x[i + 1] + w2 * x[i + 2];
}
#define WAVE_FENCE() asm volatile("s_waitcnt lgkmcnt(0)" ::: "memory")
struct PairRaw { Raw8 a0, v0, a1, v1; };
struct FiltRaw { unsigned long long s[4], d[4]; };
__device__ __forceinline__ PairRaw load_pair(const HyArgs& A, int c, int o0, int o1, unsigned boff, unsigned loff, unsigned roff) {
    PairRaw R;
    R.a0 = load_raw8(A.hyT + (size_t)(1024 + c) * A.TS + o0, boff, loff, roff); R.v0 = load_raw8(A.hyT + (size_t)(2048 + c) * A.TS + o0, boff, loff, roff);
    R.a1 = load_raw8(A.hyT + (size_t)(1024 + c) * A.TS + o1, boff, loff, roff); R.v1 = load_raw8(A.hyT + (size_t)(2048 + c) * A.TS + o1, boff, loff, roff);
    return R;
}
__device__ __forceinline__ FiltRaw load_filt(const HyArgs& A, int c, unsigned boff) {
    FiltRaw F; const char* ps = (const char*)(A.fsum + (size_t)c * 4096); const char* pd = (const char*)(A.fdif + (size_t)c * 4096);
#pragma unroll
    for (int i = 0; i < 4; ++i) { F.s[i] = ald64(ps + 2 * boff + 8 * i); F.d[i] = ald64(pd + 2 * boff + 8 * i); }
    return F;
}
__device__ __forceinline__ pg8::u32x4 pack8(const float (&x)[8], const float (&y)[8]) {
    pg8::u32x4 w;
    w.x = f2bf(x[0] * y[0]) | (f2bf(x[1] * y[1]) << 16); w.y = f2bf(x[2] * y[2]) | (f2bf(x[3] * y[3]) << 16);
    w.z = f2bf(x[4] * y[4]) | (f2bf(x[5] * y[5]) << 16); w.w = f2bf(x[6] * y[6]) | (f2bf(x[7] * y[7]) << 16);
    return w;
}
__device__ __forceinline__ void hyena_phase(lcf Z, const HyArgs& A, int first, int stride, const int tid) {
    const int s = tid >> 8, t = tid & 255, n0 = 8 * tid, pb = 8 * tid + (tid >> 1);
    const cf w1 = ldz(A.T, 2 * t), w2 = ldz(A.T, 32 * (t & 15)), wp = ldz(A.T, 8 * tid);
    lcf Zs = Z + s * FSUB; lcf Ks = Z + 2 * FSUB + s * FSUB;
    constexpr float W8C[8] = {1.0f, 0.99999970586f, 0.99999882345f, 0.99999735277f, 0.99999529381f, 0.99999264659f, 0.99998941108f, 0.99998558731f};
    constexpr float W8S[8] = {0.0f, 0.00076699031874f, 0.0015339801863f, 0.0023009691514f, 0.0030679567630f, 0.0038349425697f, 0.0046019261204f, 0.0053689069640f};
    if (first >= 1024) return;
    const bool has_l = n0 > 0, has_r = n0 + 8 < 4096;
    unsigned boff = (unsigned)n0 * 2u, loff = has_l ? boff - 2u : 0u, roff = has_r ? boff + 16u : 8190u;
    asm volatile("" : "+v"(boff), "+v"(loff), "+v"(roff));

    for (int c = first; c < 1024; c += stride) {
        const float sk = A.skip[c];
        const float cx0 = A.cw[c], cx1 = A.cw[3072 + c], cx2 = A.cw[6144 + c], cxb = A.cb[c];
        const float ca0 = A.cw[1024 + c], ca1 = A.cw[3072 + 1024 + c], ca2 = A.cw[6144 + 1024 + c], cab = A.cb[1024 + c];
        const float cv0 = A.cw[2048 + c], cv1 = A.cw[3072 + 2048 + c], cv2 = A.cw[6144 + 2048 + c], cvb = A.cb[2048 + c];
        {
            const FiltRaw F = load_filt(A, c, boff);
            float fs[8], fd[8];
#pragma unroll
            for (int i = 0; i < 4; ++i) { fs[2 * i] = __builtin_bit_cast(float, (unsigned)F.s[i]); fs[2 * i + 1] = __builtin_bit_cast(float, (unsigned)(F.s[i] >> 32));
                                          fd[2 * i] = __builtin_bit_cast(float, (unsigned)F.d[i]); fd[2 * i + 1] = __builtin_bit_cast(float, (unsigned)(F.d[i] >> 32)); }
#pragma unroll
            for (int i = 0; i < 8; ++i) { cf wq = wp; FFT_OPAQUE(wq); const cf tw = cmul(wq, cmk(W8C[i], -W8S[i])); stz(Z, pb + i, cmk(fs[i], 0.f)); stz(Z, FSUB + pb + i, cmk(fd[i] * tw.x, fd[i] * tw.y)); }
        }
        block_sync();
        fwd_pass1(Zs, t, w1); block_sync();
        fwd_pass2(Zs, t, w2); WAVE_FENCE();
        {
            cf v[16];
            fwd_pass3_load(Zs, t, v);
#pragma unroll
            for (int j = 0; j < 16; ++j) stz(Ks, 17 * t + j, cmk(v[j].x * (1.0f / 8192.0f), v[j].y * (1.0f / 8192.0f)));
        }
        block_sync();
        for (int p = 0; p < A.npairs; ++p) {
            const int o0 = p ? A.off10 : A.off00, o1 = p ? A.off11 : A.off01;
            float u0[8], u1[8];
            {
                const PairRaw R = load_pair(A, c, o0, o1, boff, loff, roff);
                float a[8], b[8];
                conv8r(R.a0, has_l, has_r, ca0, ca1, ca2, cab, a); conv8r(R.v0, has_l, has_r, cv0, cv1, cv2, cvb, b);
#pragma unroll
                for (int i = 0; i < 8; ++i) u0[i] = a[i] * b[i];
                conv8r(R.a1, has_l, has_r, ca0, ca1, ca2, cab, a); conv8r(R.v1, has_l, has_r, cv0, cv1, cv2, cvb, b);
#pragma unroll
                for (int i = 0; i < 8; ++i) u1[i] = a[i] * b[i];
            }
#pragma unroll
            for (int i = 0; i < 8; ++i) { cf wq = wp; FFT_OPAQUE(wq); const cf tw = cmul(wq, cmk(W8C[i], -W8S[i])); const cf z = cmk(u0[i], u1[i]); stz(Z, pb + i, z); stz(Z, FSUB + pb + i, cmul(z, tw)); }
            block_sync();
            fwd_pass1(Zs, t, w1); block_sync();
            fwd_pass2(Zs, t, w2); WAVE_FENCE();
            {
                cf v[16];
                fwd_pass3_load(Zs, t, v);
#pragma unroll
                for (int j = 0; j < 16; ++j) v[j] = cmul(v[j], ldz(Ks, 17 * t + j));
                inv_pass1_store(Zs, t, v);
            }
            WAVE_FENCE();
            inv_pass2(Zs, t, w2); block_sync();
            inv_pass3(Zs, t, w1); block_sync();
            {
                const Raw8 X0a = load_raw8(A.hyT + (size_t)c * A.TS + o0, boff, loff, roff), X0b = load_raw8(A.hyT + (size_t)c * A.TS + o1, boff, loff, roff);
                float y0[8], y1[8];
#pragma unroll
                for (int i = 0; i < 8; ++i) { cf wq = wp; FFT_OPAQUE(wq); const cf tw = cmul(wq, cmk(W8C[i], -W8S[i])); const cf e = ldz(Z, pb + i), o = ldz(Z, FSUB + pb + i); const cf y = cadd(e, cmul(o, cconj(tw))); y0[i] = y.x + sk * u0[i]; y1[i] = y.y + sk * u1[i]; }
                float x0c[8];
                conv8r(X0a, has_l, has_r, cx0, cx1, cx2, cxb, x0c);
                *(pg8::u32x4*)(A.yaT + (size_t)c * A.TS + o0 + n0) = pack8(x0c, y0);
                if (o1 != o0) { conv8r(X0b, has_l, has_r, cx0, cx1, cx2, cxb, x0c); *(pg8::u32x4*)(A.yaT + (size_t)c * A.TS + o1 + n0) = pack8(x0c, y1); }
            }
        }
    }
}
}
namespace pg8 {
__device__ __forceinline__ f32x2 sigmoid_pk(f32x2 v) {
    f32x2 e; e.x = __builtin_amdgcn_exp2f(v.x * -1.4426950408889634f); e.y = __builtin_amdgcn_exp2f(v.y * -1.4426950408889634f);
    f32x2 o; o.x = __builtin_amdgcn_rcpf(1.0f + e.x); o.y = __builtin_amdgcn_rcpf(1.0f + e.y); return o;
}
struct EpiHyT {
    static constexpr bool PERM = true, AFTER_DRAIN = false, MID = false;
    bf16_t* O; int ldc; float* vss;
    __device__ __forceinline__ void operator()(const f32x4 (&acc)[2][2][4][2], const Unit& u, int wr, int wc, int fr, int fq) const {
        const int row0 = u.pm * BM + wr * 64 + fr, col0 = u.pn * BM + wc * 32 + 8 * fq;
        const bool isv = u.pm >= 12;
        f32x4 ss[2][2];
#pragma unroll
        for (int bj = 0; bj < 2; ++bj)
#pragma unroll
            for (int n = 0; n < 2; ++n) ss[bj][n] = (f32x4){0.f, 0.f, 0.f, 0.f};
#pragma unroll
        for (int ai = 0; ai < 2; ++ai)
#pragma unroll
            for (int m = 0; m < 4; ++m) { bf16_t* rowp = O + (size_t)(row0 + ai * HALF + m * 16) * ldc + col0;
#pragma unroll
                for (int bj = 0; bj < 2; ++bj) { f32x4 v0 = acc[ai][bj][m][0], v1 = acc[ai][bj][m][1];
                    if (isv) { f32x2 a = gelu_pk((f32x2){v0[0], v0[1]}), b = gelu_pk((f32x2){v0[2], v0[3]}), c = gelu_pk((f32x2){v1[0], v1[1]}), d = gelu_pk((f32x2){v1[2], v1[3]});
                        v0 = (f32x4){a.x, a.y, b.x, b.y}; v1 = (f32x4){c.x, c.y, d.x, d.y}; ss[bj][0] += v0 * v0; ss[bj][1] += v1 * v1; }
                    u32x4 w; w.x = cvt_pk_bf16(v0[0], v0[1]); w.y = cvt_pk_bf16(v0[2], v0[3]); w.z = cvt_pk_bf16(v1[0], v1[1]); w.w = cvt_pk_bf16(v1[2], v1[3]);
                    *(u32x4*)(rowp + bj * HALF) = w; } }
        if (isv) {
#pragma unroll
            for (int bj = 0; bj < 2; ++bj)
#pragma unroll
                for (int n = 0; n < 2; ++n)
#pragma unroll
                    for (int j = 0; j < 4; ++j) { float s = ss[bj][n][j]; s += __shfl_xor(s, 1); s += __shfl_xor(s, 2); s += __shfl_xor(s, 4); s += __shfl_xor(s, 8);
                        if (fr == 0) atomicAdd(vss + col0 + bj * HALF + 4 * n + j, s); }
        }
    }
};
struct EpiUG {
    static constexpr bool PERM = true, AFTER_DRAIN = false, MID = false;
    bf16_t* U; bf16_t* G; int ldu;
    __device__ __forceinline__ void operator()(const f32x4 (&acc)[2][2][4][2], const Unit& u, int wr, int wc, int fr, int fq) const {
        const int row0 = u.pm * BM + wr * 64 + fr; int colt = u.pn * BM; const bool isu = colt < 1024;
        bf16_t* base = isu ? U : G; const int ldc = isu ? ldu : 2048; if (!isu) colt -= 1024;
        const int col0 = colt + wc * 32 + 8 * fq;
#pragma unroll
        for (int ai = 0; ai < 2; ++ai)
#pragma unroll
            for (int m = 0; m < 4; ++m) { bf16_t* rowp = base + (size_t)(row0 + ai * HALF + m * 16) * ldc + col0;
#pragma unroll
                for (int bj = 0; bj < 2; ++bj) { f32x4 v0 = acc[ai][bj][m][0], v1 = acc[ai][bj][m][1];
                    f32x2 a, b, c, d;
                    if (isu) { a = gelu_pk((f32x2){v0[0], v0[1]}); b = gelu_pk((f32x2){v0[2], v0[3]}); c = gelu_pk((f32x2){v1[0], v1[1]}); d = gelu_pk((f32x2){v1[2], v1[3]}); }
                    else { a = sigmoid_pk((f32x2){v0[0], v0[1]}); b = sigmoid_pk((f32x2){v0[2], v0[3]}); c = sigmoid_pk((f32x2){v1[0], v1[1]}); d = sigmoid_pk((f32x2){v1[2], v1[3]}); }
                    u32x4 w; w.x = cvt_pk_bf16(a.x, a.y); w.y = cvt_pk_bf16(b.x, b.y); w.z = cvt_pk_bf16(c.x, c.y); w.w = cvt_pk_bf16(d.x, d.y);
                    *(u32x4*)(rowp + bj * HALF) = w; } }
    }
};
}
namespace {
struct WJob { const float* W; const float* g; bf16* dst; int K, N, c0, nc, ldd, r0, koff, pad; };
constexpr int NWJ = 9;
struct WJobs { WJob j[NWJ]; };
__device__ __forceinline__ unsigned pk2(float lo, float hi) { return f2bf(lo) | (f2bf(hi) << 16); }
__device__ __forceinline__ void wT_item(const WJob& J, LAS float* scr, int item, int lane) {
    const int nblk = J.nc / 32, kb = item / nblk, nb = item % nblk, k0 = 64 * kb, n0 = 32 * nb;
    float v[32];
#pragma unroll
    for (int i = 0; i < 32; ++i) v[i] = J.W[(size_t)(k0 + 2 * i + (lane >> 5)) * J.N + J.c0 + n0 + (lane & 31)];
    if (J.g) {
#pragma unroll
        for (int i = 0; i < 32; ++i) v[i] *= J.g[k0 + 2 * i + (lane >> 5)]; }
#pragma unroll
    for (int i = 0; i < 32; ++i) scr[(2 * i + (lane >> 5)) * 33 + (lane & 31)] = v[i];
    asm volatile("s_waitcnt lgkmcnt(0)" ::: "memory");
    const int c = lane & 7;
#pragma unroll
    for (int j = 0; j < 4; ++j) { const int n = (lane >> 3) + 8 * j; const LAS float* s = scr + (8 * c) * 33 + n;
        uint4 o; o.x = pk2(s[0 * 33], s[1 * 33]); o.y = pk2(s[2 * 33], s[3 * 33]); o.z = pk2(s[4 * 33], s[5 * 33]); o.w = pk2(s[6 * 33], s[7 * 33]);
        *(uint4*)(J.dst + (size_t)(J.r0 + n0 + n) * J.ldd + J.koff + k0 + 8 * c) = o; }
    asm volatile("s_waitcnt lgkmcnt(0)" ::: "memory");
}
__device__ __forceinline__ void p0_weights(const WJobs& WJ, int jlo, int jhi, LAS float* scr, int gw, int NGW, int lane) {
    int base = 0;
    for (int q = jlo; q < jhi; ++q) {
        const WJob& J = WJ.j[q]; const int ni = (J.K / 64) * (J.nc / 32);
        int it = gw - (base % NGW); if (it < 0) it += NGW;
        for (; it < ni; it += NGW) wT_item(J, scr, it, lane);
        base += ni;
    }
}
__device__ __forceinline__ float wave_sum(float v) {
#pragma unroll
    for (int o = 1; o < 64; o <<= 1) v += __shfl_xor(v, o);
    return v;
}
__device__ __forceinline__ void rms_row_to_bf16(const float* xrow, const float* g, bf16* orow, int lane) {
    const float4* xr = (const float4*)xrow + lane; const float4* gr = (const float4*)g + lane;
    float4 v[4]; float s = 0.f;
#pragma unroll
    for (int j = 0; j < 4; ++j) { v[j] = xr[64 * j]; s += (v[j].x * v[j].x + v[j].y * v[j].y) + (v[j].z * v[j].z + v[j].w * v[j].w); }
    const float r = rsqrtf(wave_sum(s) * (1.f / 1024.f) + EPS);
    unsigned long long* o8 = (unsigned long long*)orow + lane;
#pragma unroll
    for (int j = 0; j < 4; ++j) { const float4 gg = gr[64 * j];
        o8[64 * j] = (unsigned long long)pk2(v[j].x * r * gg.x, v[j].y * r * gg.y) | ((unsigned long long)pk2(v[j].z * r * gg.z, v[j].w * r * gg.w) << 32); }
}
__device__ __forceinline__ void rms_rows4_to_bf16(const float* xrow, const float* g, bf16* orow, int ldo, int lane) {
    float4 v[4][4]; float s[4];
#pragma unroll
    for (int r = 0; r < 4; ++r)
#pragma unroll
        for (int j = 0; j < 4; ++j) v[r][j] = ((const float4*)(xrow + (size_t)r * 1024) + lane)[64 * j];
#pragma unroll
    for (int r = 0; r < 4; ++r) { s[r] = 0.f;
#pragma unroll
        for (int j = 0; j < 4; ++j) s[r] += (v[r][j].x * v[r][j].x + v[r][j].y * v[r][j].y) + (v[r][j].z * v[r][j].z + v[r][j].w * v[r][j].w); }
#pragma unroll
    for (int r = 0; r < 4; ++r) { const float rr = rsqrtf(wave_sum(s[r]) * (1.f / 1024.f) + EPS);
        unsigned long long* o8 = (unsigned long long*)(orow + (size_t)r * ldo) + lane;
#pragma unroll
        for (int j = 0; j < 4; ++j) { const float4 gg = ((const float4*)g + lane)[64 * j];
            o8[64 * j] = (unsigned long long)pk2(v[r][j].x * rr * gg.x, v[r][j].y * rr * gg.y) | ((unsigned long long)pk2(v[r][j].z * rr * gg.z, v[r][j].w * rr * gg.w) << 32); } }
}
}

namespace {
struct SguArgs {
    const bf16* vT;
    bf16* U;
    const float* vss;
    const float* ws;
    const float* bs;
    const float* gn;
    int TS, ldu;
};
typedef short bf16x8_t __attribute__((ext_vector_type(8)));
typedef float f32x4_t __attribute__((ext_vector_type(4)));
__device__ __forceinline__ void sgu_item(LAS unsigned char* lds, const SguArgs& A, int item, int tid) {
    const int g = item & 7, ch = item >> 3, tok0 = ch * 128;
    const int wave = tid >> 6, lane = tid & 63, fr = lane & 15, fq = lane >> 4;
#pragma unroll
    for (int j = 0; j < 4; ++j) { const int idx = tid + 512 * j, d = idx >> 4, chunk = idx & 15;
        const pg8::u32x4 v = *(const pg8::u32x4*)(A.vT + (size_t)(g * 128 + d) * A.TS + tok0 + chunk * 8);
        *(LAS pg8::u32x4*)(lds + d * 272 + chunk * 16) = v; }
    bf16x8_t af[4];
    const int p = 16 * wave + fr;
#pragma unroll
    for (int kk = 0; kk < 4; ++kk) { const int q = 32 * kk + 8 * fq;
        const float4 w0 = *(const float4*)(A.ws + ((size_t)g * 128 + p) * 128 + q), w1 = *(const float4*)(A.ws + ((size_t)g * 128 + p) * 128 + q + 4);
        const float4 s0 = *(const float4*)(A.vss + tok0 + q), s1 = *(const float4*)(A.vss + tok0 + q + 4);
        const float r0 = rsqrtf(s0.x * (1.f / 1024.f) + EPS), r1 = rsqrtf(s0.y * (1.f / 1024.f) + EPS), r2 = rsqrtf(s0.z * (1.f / 1024.f) + EPS), r3 = rsqrtf(s0.w * (1.f / 1024.f) + EPS);
        const float r4 = rsqrtf(s1.x * (1.f / 1024.f) + EPS), r5 = rsqrtf(s1.y * (1.f / 1024.f) + EPS), r6 = rsqrtf(s1.z * (1.f / 1024.f) + EPS), r7 = rsqrtf(s1.w * (1.f / 1024.f) + EPS);
        uint4 o; o.x = pk2(w0.x * r0, w0.y * r1); o.y = pk2(w0.z * r2, w0.w * r3); o.z = pk2(w1.x * r4, w1.y * r5); o.w = pk2(w1.z * r6, w1.w * r7);
        af[kk] = __builtin_bit_cast(bf16x8_t, o); }
    const float bsp = A.bs[g * 128 + p];
    bf16* urow = A.U + (size_t)(tok0 + p) * A.ldu + g * 128 + 4 * fq;
    const float* gnp = A.gn + g * 128 + 4 * fq;
    uint2 uq[8];
#pragma unroll
    for (int nt = 0; nt < 8; ++nt) uq[nt] = *(const uint2*)(urow + 16 * nt);
    block_sync();
    f32x4_t acc[8];
#pragma unroll
    for (int nt = 0; nt < 8; ++nt) acc[nt] = (f32x4_t){0.f, 0.f, 0.f, 0.f};
#pragma unroll
    for (int kk = 0; kk < 4; ++kk) {
        bf16x8_t bfr[8];
#pragma unroll
        for (int nt = 0; nt < 8; ++nt) bfr[nt] = *(const LAS bf16x8_t*)(lds + (16 * nt + fr) * 272 + (32 * kk + 8 * fq) * 2);
#pragma unroll
        for (int nt = 0; nt < 8; ++nt) acc[nt] = __builtin_amdgcn_mfma_f32_16x16x32_bf16(bfr[nt], af[kk], acc[nt], 0, 0, 0);
    }
#pragma unroll
    for (int nt = 0; nt < 8; ++nt) {
        const uint2 uu = uq[nt];
        const float4 gv = *(const float4*)(gnp + 16 * nt);
        const float y0 = bf2f(uu.x & 0xffffu) * (gv.x * acc[nt][0] + bsp), y1 = bf2f(uu.x >> 16) * (gv.y * acc[nt][1] + bsp);
        const float y2 = bf2f(uu.y & 0xffffu) * (gv.z * acc[nt][2] + bsp), y3 = bf2f(uu.y >> 16) * (gv.w * acc[nt][3] + bsp);
        uint2 o; o.x = pk2(y0, y1); o.y = pk2(y2, y3);
        *(uint2*)(urow + 16 * nt) = o;
    }
    block_sync();
}
}

namespace pg8 {
__device__ __forceinline__ void bf8_to_f32(const u32x4 q, f32x4& lo, f32x4& hi) {
    lo = (f32x4){__builtin_bit_cast(float, q.x << 16), __builtin_bit_cast(float, q.x & 0xffff0000u), __builtin_bit_cast(float, q.y << 16), __builtin_bit_cast(float, q.y & 0xffff0000u)};
    hi = (f32x4){__builtin_bit_cast(float, q.z << 16), __builtin_bit_cast(float, q.z & 0xffff0000u), __builtin_bit_cast(float, q.w << 16), __builtin_bit_cast(float, q.w & 0xffff0000u)};
}
struct EpiMerge {
    static constexpr bool PERM = true, AFTER_DRAIN = false, MID = true;
    const bf16_t* G; bf16_t* O;
    __device__ __forceinline__ void mid(f32x4 (&acc)[2][2][4][2], const Unit& u, int wr, int wc, int fr, int fq) const {
        unsigned off0 = (unsigned)(u.pm * BM + wr * 64 + fr) * 2048u + (unsigned)(u.pn * BM + wc * 32 + 8 * fq);
        asm volatile("" : "+v"(off0));
#pragma unroll
        for (int ai = 0; ai < 2; ++ai)
#pragma unroll
            for (int m = 0; m < 4; ++m)
#pragma unroll
                for (int bj = 0; bj < 2; ++bj) { const bf16_t* gp = G + (off0 + (unsigned)((ai * HALF + m * 16) * 2048 + bj * HALF));
                    const u32x4 qa = *(const u32x4*)gp, qb = *(const u32x4*)(gp + 1024);
                    f32x4 a0, a1, b0, b1; bf8_to_f32(qa, a0, a1); bf8_to_f32(qb, b0, b1);
#pragma unroll
                    for (int j = 0; j < 4; ++j) { acc[ai][bj][m][0][j] *= a0[j] * __builtin_amdgcn_rcpf(b0[j]); acc[ai][bj][m][1][j] *= a1[j] * __builtin_amdgcn_rcpf(b1[j]); }
                    asm volatile("" ::: "memory"); }
    }
    __device__ __forceinline__ void operator()(const f32x4 (&acc)[2][2][4][2], const Unit& u, int wr, int wc, int fr, int fq) const {
        const int row0 = u.pm * BM + wr * 64 + fr, col0 = u.pn * BM + wc * 32 + 8 * fq;
#pragma unroll
        for (int ai = 0; ai < 2; ++ai)
#pragma unroll
            for (int m = 0; m < 4; ++m) { const size_t r = (size_t)(row0 + ai * HALF + m * 16);
#pragma unroll
                for (int bj = 0; bj < 2; ++bj) { f32x4 b0, b1; bf8_to_f32(*(const u32x4*)(G + r * 2048 + 1024 + col0 + bj * HALF), b0, b1);
                    const f32x4 v0 = acc[ai][bj][m][0] * b0, v1 = acc[ai][bj][m][1] * b1;
                    u32x4 w; w.x = cvt_pk_bf16(v0[0], v0[1]); w.y = cvt_pk_bf16(v0[2], v0[3]); w.z = cvt_pk_bf16(v1[0], v1[1]); w.w = cvt_pk_bf16(v1[2], v1[3]);
                    *(u32x4*)(O + r * 1024 + col0 + bj * HALF) = w; } }
    }
};
}
namespace {
__device__ __forceinline__ void tr64_item(const bf16* yaT, int TS, bf16* out, int ldo, LAS unsigned short* scr, int c0, int t0, int lane) {
#pragma unroll
    for (int i = 0; i < 8; ++i) { const int r = 8 * i + (lane >> 3), ch = lane & 7;
        const pg8::u32x4 q = *(const pg8::u32x4*)(yaT + (size_t)(c0 + r) * TS + t0 + 8 * ch);
        LAS unsigned short* d = scr + (8 * ch) * 72 + r;
        d[0 * 72] = (unsigned short)(q.x & 0xffffu); d[1 * 72] = (unsigned short)(q.x >> 16); d[2 * 72] = (unsigned short)(q.y & 0xffffu); d[3 * 72] = (unsigned short)(q.y >> 16);
        d[4 * 72] = (unsigned short)(q.z & 0xffffu); d[5 * 72] = (unsigned short)(q.z >> 16); d[6 * 72] = (unsigned short)(q.w & 0xffffu); d[7 * 72] = (unsigned short)(q.w >> 16); }
    asm volatile("s_waitcnt lgkmcnt(0)" ::: "memory");
#pragma unroll
    for (int i = 0; i < 8; ++i) { const int tk = 8 * i + (lane >> 3), ch = lane & 7;
        const pg8::u32x4 q = *(const LAS pg8::u32x4*)(scr + tk * 72 + 8 * ch);
        *(pg8::u32x4*)(out + (size_t)(t0 + tk) * ldo + c0 + 8 * ch) = q; }
    asm volatile("s_waitcnt lgkmcnt(0)" ::: "memory");
}
__device__ __forceinline__ void transpose_ya(const bf16* yaT, int TS, bf16* out, int ldo, LAS unsigned short* scr, int gw, int NGW, int lane) {
    const int ntt = TS / 64, nit = 16 * ntt;
    for (int it = gw; it < nit; it += NGW) tr64_item(yaT, TS, out, ldo, scr, 64 * (it / ntt), 64 * (it % ntt), lane);
}
}

namespace pg8 {
template <bool FIRST> struct EpiResid {
    static constexpr bool PERM = false, AFTER_DRAIN = false, MID = false;
    const float* X; const bf16_t* XB; float* X1; bf16_t* X1b; float* xss;
    __device__ __forceinline__ void operator()(const f32x4 (&acc)[2][2][4][2], const Unit& u, int wr, int wc, int fr, int fq) const {
        const int row0 = u.pm * BM + wr * 64 + fr, col0 = u.pn * BM + wc * 32 + 4 * fq;
        typedef unsigned u32x2v __attribute__((ext_vector_type(2)));
#pragma unroll
        for (int ai = 0; ai < 2; ++ai)
#pragma unroll
            for (int m = 0; m < 4; ++m) { const size_t r = (size_t)(row0 + ai * HALF + m * 16); float s = 0.f;
#pragma unroll
                for (int bj = 0; bj < 2; ++bj)
#pragma unroll
                    for (int n = 0; n < 2; ++n) { const size_t o = r * 1024 + col0 + bj * HALF + n * 16;
                        f32x4 v;
                        if (FIRST) v = acc[ai][bj][m][n] + *(const f32x4*)(X + o);
                        else { const u32x2v q = *(const u32x2v*)(XB + o);
                               v = acc[ai][bj][m][n] + (f32x4){__builtin_bit_cast(float, q.x << 16), __builtin_bit_cast(float, q.x & 0xffff0000u), __builtin_bit_cast(float, q.y << 16), __builtin_bit_cast(float, q.y & 0xffff0000u)}; }
                        { u32x2v w; w.x = cvt_pk_bf16(v[0], v[1]); w.y = cvt_pk_bf16(v[2], v[3]); *(u32x2v*)(X1b + o) = w; }
                        s += (v[0] * v[0] + v[1] * v[1]) + (v[2] * v[2] + v[3] * v[3]); }
                s += __shfl_xor(s, 16); s += __shfl_xor(s, 32);
                if (fq == 0) atomicAdd(xss + r, s);
                asm volatile("" ::: "memory"); }
    }
};
struct EpiUp {
    static constexpr bool PERM = true, AFTER_DRAIN = false, MID = false;
    bf16_t* AP; bf16_t* GP; const float* xss;
    __device__ __forceinline__ void operator()(const f32x4 (&acc)[2][2][4][2], const Unit& u, int wr, int wc, int fr, int fq) const {
        const int row0 = u.pm * BM + wr * 64 + fr; int colt = u.pn * BM; const bool isg = colt >= 2816;
        bf16_t* base = isg ? GP : AP; if (isg) colt -= 2816;
        const int col0 = colt + wc * 32 + 8 * fq;
#pragma unroll
        for (int ai = 0; ai < 2; ++ai)
#pragma unroll
            for (int m = 0; m < 4; ++m) { const size_t r = (size_t)(row0 + ai * HALF + m * 16); const float rs = rsqrtf(xss[r] * (1.0f / 1024.0f) + 1e-6f);
#pragma unroll
                for (int bj = 0; bj < 2; ++bj) { const f32x4 v0 = acc[ai][bj][m][0] * rs, v1 = acc[ai][bj][m][1] * rs;
                    u32x4 w; w.x = cvt_pk_bf16(v0[0], v0[1]); w.y = cvt_pk_bf16(v0[2], v0[3]); w.z = cvt_pk_bf16(v1[0], v1[1]); w.w = cvt_pk_bf16(v1[2], v1[3]);
                    *(u32x4*)(base + r * 2816 + col0 + bj * HALF) = w; } }
    }
};
}
namespace {
__device__ __forceinline__ void act_pass(const bf16* AP, bf16* GP, const float* cw, const float* cb, int TS, int gid, int gstride) {
    const int nitems = (TS / 16) * 352;
    const pg8::u32x4 zq = {0u, 0u, 0u, 0u};
    for (int it = gid; it < nitems; it += gstride) {
        const int run = it / 352, ch = it % 352, t0 = run * 16, c0 = ch * 8;
        const pg8::f32x4 w0l = *(const pg8::f32x4*)(cw + c0), w0h = *(const pg8::f32x4*)(cw + c0 + 4);
        const pg8::f32x4 w1l = *(const pg8::f32x4*)(cw + 2816 + c0), w1h = *(const pg8::f32x4*)(cw + 2816 + c0 + 4);
        const pg8::f32x4 w2l = *(const pg8::f32x4*)(cw + 5632 + c0), w2h = *(const pg8::f32x4*)(cw + 5632 + c0 + 4);
        const pg8::f32x4 bl = *(const pg8::f32x4*)(cb + c0), bh = *(const pg8::f32x4*)(cb + c0 + 4);
        const bf16* ap = AP + (size_t)t0 * 2816 + c0; bf16* gp = GP + (size_t)t0 * 2816 + c0;
        pg8::u32x4 qa[6];
        qa[0] = (t0 & 4095) != 0 ? *(const pg8::u32x4*)(ap - 2816) : zq;
        qa[1] = *(const pg8::u32x4*)ap;
#pragma unroll 1
        for (int i = 0; i < 16; i += 4) {
            pg8::u32x4 qg[4];
#pragma unroll
            for (int k = 0; k < 4; ++k) { const int t = t0 + i + k;
                qa[2 + k] = (t & 4095) != 4095 ? *(const pg8::u32x4*)(ap + (size_t)(i + k + 1) * 2816) : zq;
                qg[k] = *(const pg8::u32x4*)(gp + (size_t)(i + k) * 2816); }
#pragma unroll
            for (int k = 0; k < 4; ++k) {
                pg8::f32x4 pl, ph, cl, chh, nl, nh, gl, gh;
                pg8::bf8_to_f32(qa[k], pl, ph); pg8::bf8_to_f32(qa[k + 1], cl, chh); pg8::bf8_to_f32(qa[k + 2], nl, nh); pg8::bf8_to_f32(qg[k], gl, gh);
                const pg8::f32x4 sl = bl + w0l * pl + w1l * cl + w2l * nl, sh = bh + w0h * ph + w1h * chh + w2h * nh;
                pg8::f32x4 ol, oh;
#pragma unroll
                for (int j = 0; j < 4; ++j) { ol[j] = sl[j] * __builtin_amdgcn_rcpf(1.0f + __builtin_amdgcn_exp2f(sl[j] * -1.4426950408889634f)) * gl[j];
                                              oh[j] = sh[j] * __builtin_amdgcn_rcpf(1.0f + __builtin_amdgcn_exp2f(sh[j] * -1.4426950408889634f)) * gh[j]; }
                pg8::u32x4 w; w.x = pg8::cvt_pk_bf16(ol[0], ol[1]); w.y = pg8::cvt_pk_bf16(ol[2], ol[3]); w.z = pg8::cvt_pk_bf16(oh[0], oh[1]); w.w = pg8::cvt_pk_bf16(oh[2], oh[3]);
                *(pg8::u32x4*)(gp + (size_t)(i + k) * 2816) = w;
            }
            qa[0] = qa[4]; qa[1] = qa[5];
        }
    }
}
__device__ __forceinline__ void final_norm(const bf16* X2, const float* ss, const float* g, float* out, int TS, int gw, int NGW, int lane) {
    pg8::f32x4 g0[2], g1[2];
#pragma unroll
    for (int j = 0; j < 2; ++j) { g0[j] = *((const pg8::f32x4*)g + 2 * lane + 128 * j); g1[j] = *((const pg8::f32x4*)g + 2 * lane + 128 * j + 1); }
    for (int t = 2 * gw; t < TS; t += 2 * NGW) {
        pg8::u32x4 q[2][2]; float r[2];
#pragma unroll
        for (int k = 0; k < 2; ++k) { r[k] = rsqrtf(ss[t + k] * (1.0f / 1024.0f) + EPS);
#pragma unroll
            for (int j = 0; j < 2; ++j) q[k][j] = *((const pg8::u32x4*)(X2 + (size_t)(t + k) * 1024) + lane + 64 * j); }
#pragma unroll
        for (int k = 0; k < 2; ++k)
#pragma unroll
            for (int j = 0; j < 2; ++j) { pg8::f32x4 lo, hi; pg8::bf8_to_f32(q[k][j], lo, hi);
                pg8::f32x4* o = (pg8::f32x4*)(out + (size_t)(t + k) * 1024) + 2 * lane + 128 * j;
                o[0] = lo * g0[j] * r[k]; o[1] = hi * g1[j] * r[k]; }
    }
}
}

namespace {
constexpr int MLPW_W2 = 33 * 64, MLPW_W3 = MLPW_W2 + 4096, MLPW_B = MLPW_W3 + 4096, MLPW_N = MLPW_B + 256;
__device__ __forceinline__ float filt_z(int l, int j) {
    if (j == 0) return (float)((double)l / (double)(L - 1));
    const int i = (j - 1) & 15;
    const double band = 1e-4 + (double)i * ((15.0 - 1e-4) / 15.0);
    double rev = (double)l * band / (double)L;
    rev -= floor(rev);
    const float ang = (float)(rev * 6.283185307179586);
    return (j <= 16) ? cosf(ang) : -sinf(ang);
}
__device__ __forceinline__ void filter_mlp_rows2(const LAS float* wl, float* h3out, LAS float* scr, int l0, int l1, int j) {
    LAS float* za = scr; LAS float* zb = scr + 64;
    if (j < FEMB) { za[j] = filt_z(l0, j); zb[j] = filt_z(l1, j); }
    asm volatile("s_waitcnt lgkmcnt(0)" ::: "memory");
    const float a = wl[MLPW_B + 192 + j];
    float s0 = wl[MLPW_B + j], s1 = s0;
#pragma unroll 11
    for (int i = 0; i < FEMB; ++i) { const float w = wl[i * 64 + j]; s0 += za[i] * w; s1 += zb[i] * w; }
    asm volatile("s_waitcnt lgkmcnt(0)" ::: "memory");
    za[j] = sinf(a * s0); zb[j] = sinf(a * s1);
    asm volatile("s_waitcnt lgkmcnt(0)" ::: "memory");
    s0 = wl[MLPW_B + 64 + j]; s1 = s0;
#pragma unroll 8
    for (int i = 0; i < FHID; ++i) { const float w = wl[MLPW_W2 + i * 64 + j]; s0 += za[i] * w; s1 += zb[i] * w; }
    asm volatile("s_waitcnt lgkmcnt(0)" ::: "memory");
    za[j] = sinf(a * s0); zb[j] = sinf(a * s1);
    asm volatile("s_waitcnt lgkmcnt(0)" ::: "memory");
    s0 = wl[MLPW_B + 128 + j]; s1 = s0;
#pragma unroll 8
    for (int i = 0; i < FHID; ++i) { const float w = wl[MLPW_W3 + i * 64 + j]; s0 += za[i] * w; s1 += zb[i] * w; }
    h3out[l0 * FHID + j] = sinf(a * s0); h3out[l1 * FHID + j] = sinf(a * s1);
    asm volatile("s_waitcnt lgkmcnt(0)" ::: "memory");
}
typedef float f32x16_t __attribute__((ext_vector_type(16)));
__device__ __forceinline__ void stage_h3_rows32(const float* h3, int row0, LAS float* scr, int lane) {
#pragma unroll
    for (int i = 0; i < 8; ++i) { const int e = 4 * (lane + 64 * i), r = e >> 6, jj = e & 63;
        if (row0 + r < 4096) { const pg8::f32x4 v = *(const pg8::f32x4*)(h3 + (size_t)(row0 + r) * 64 + jj);
            LAS float* d = scr + r * 65 + jj; d[0] = v[0]; d[1] = v[1]; d[2] = v[2]; d[3] = v[3]; } }
}
__device__ __forceinline__ void filter_tables(const float* h3, const float* w4, const float* decay, float* fsum, float* fdif, LAS float* scr, int gw, int NGW, int lane) {
    const int r = lane & 31, h = lane >> 5;
    for (int it = gw; it < 2048; it += NGW) {
        const int c0 = (it & 31) * 32, nbase = (it >> 5) * 64;
        float af[32], ab[32];
#pragma unroll
        for (int kk = 0; kk < 32; ++kk) { af[kk] = w4[(2 * kk + h) * 2048 + c0 + r]; ab[kk] = w4[(2 * kk + h) * 2048 + 1024 + c0 + r]; }
        float dcf[16], dcb[16];
#pragma unroll
        for (int q = 0; q < 16; ++q) { const int c = c0 + (q & 3) + 8 * (q >> 2) + 4 * h; dcf[q] = fabsf(decay[c]); dcb[q] = fabsf(decay[1024 + c]); }
#pragma unroll 1
        for (int half = 0; half < 2; ++half) {
            const int n0 = nbase + 32 * half, n = n0 + r, nb = n ? 4096 - n : 0;
            stage_h3_rows32(h3, n0, scr, lane);
            stage_h3_rows32(h3, 4096 - n0 - 31, scr + 32 * 65, lane);
            asm volatile("s_waitcnt lgkmcnt(0)" ::: "memory");
            f32x16_t accF, accB;
#pragma unroll
            for (int q = 0; q < 16; ++q) { accF[q] = 0.f; accB[q] = 0.f; }
#pragma unroll
            for (int kk = 0; kk < 32; ++kk) {
                const float bF = scr[r * 65 + 2 * kk + h], bB = scr[32 * 65 + (31 - r) * 65 + 2 * kk + h];
                accF = __builtin_amdgcn_mfma_f32_32x32x2f32(af[kk], bF, accF, 0, 0, 0);
                accB = __builtin_amdgcn_mfma_f32_32x32x2f32(ab[kk], bB, accB, 0, 0, 0);
            }
            const float tf = (float)n * (1.0f / 4095.0f), tb = (float)nb * (1.0f / 4095.0f);
#pragma unroll
            for (int q = 0; q < 16; ++q) { const int c = c0 + (q & 3) + 8 * (q >> 2) + 4 * h;
                const float hf = accF[q] * expf(-tf * dcf[q]);
                const float hb = n ? accB[q] * expf(-tb * dcb[q]) : 0.f;
                fsum[(size_t)c * 4096 + n] = hf + hb;
                fdif[(size_t)c * 4096 + n] = hf - hb; }
            asm volatile("s_waitcnt lgkmcnt(0)" ::: "memory");
        }
    }
}
#define RLX_AGENT __ATOMIC_RELAXED, __HIP_MEMORY_SCOPE_AGENT
#define XB_TMO      128
#define XB_XCNT(j)  (256  + 64 * (j))
#define XB_XSUB(j)  (1280 + 64 * (j))
#define XB_XGEN(j)  (2304 + 64 * (j))
#define XB_TOP      3328
#define XB_TOPGEN   3392
#define XCD_BAR_WORDS 3456
#define XB_SPIN_CAP (1u << 18)

__device__ __forceinline__ unsigned xb_ld(unsigned* p)              { return __hip_atomic_load(p, __ATOMIC_RELAXED, __HIP_MEMORY_SCOPE_AGENT); }
__device__ __forceinline__ unsigned xb_add(unsigned* p, unsigned v) { return __hip_atomic_fetch_add(p, v, __ATOMIC_RELAXED, __HIP_MEMORY_SCOPE_AGENT); }
__device__ __forceinline__ unsigned xb_xcc_id() { return (unsigned)__builtin_amdgcn_s_getreg((3 << 11) | 20) & 0xFu; }
#define XB_SPIN(cond, bar) do { unsigned _sp = 0; while (cond) { __builtin_amdgcn_s_sleep(1); \
    if ((++_sp & 255u) == 0u) { if (xb_ld(&(bar)[XB_TMO])) break; if (_sp > XB_SPIN_CAP) { atomicAdd(&(bar)[XB_TMO], 1u); break; } } } } while (0)

struct XcdBarrier {
    unsigned* bar; unsigned x;
    volatile LAS unsigned* st;
};

__device__ __forceinline__ XcdBarrier xcd_barrier_post(unsigned* bar, volatile LAS unsigned* st) {
    XcdBarrier b; b.bar = bar; b.x = xb_xcc_id(); b.st = st;
    if (threadIdx.x == 0) (void)xb_add(&bar[XB_XCNT(b.x)], 1u);
    return b;
}
__device__ __forceinline__ void xcd_barrier_complete(unsigned* bar, unsigned x, unsigned& nloc, unsigned& nx) {
    const unsigned G = gridDim.x * gridDim.y * gridDim.z;
    unsigned sum, cnt, mine, sp = 0u;
    for (;;) {
        sum = 0u; cnt = 0u; mine = 0u;
#pragma unroll
        for (unsigned j = 0; j < 16; ++j) { const unsigned c = xb_ld(&bar[XB_XCNT(j)]); sum += c; cnt += (c > 0u) ? 1u : 0u; mine = (j == x) ? c : mine; }
        if (sum == G) break;
        __builtin_amdgcn_s_sleep(1);
        if ((++sp & 255u) == 0u) { if (xb_ld(&bar[XB_TMO])) break; if (sp > XB_SPIN_CAP) { atomicAdd(&bar[XB_TMO], 1u); break; } }
    }
    nloc = mine > 0u ? mine : 1u; nx = cnt > 0u ? cnt : 1u;
}

__device__ __forceinline__ void xcd_barrier(const XcdBarrier& b) {
    asm volatile("s_waitcnt vmcnt(0)" ::: "memory");
    block_sync();
    if (threadIdx.x == 0) {
        unsigned* bar = b.bar;
        __builtin_amdgcn_s_waitcnt(0);
        unsigned nloc = b.st[0], nx = b.st[1];
        if (nloc == 0u) { xcd_barrier_complete(bar, b.x, nloc, nx); b.st[0] = nloc; b.st[1] = nx; }
        const unsigned old = xb_add(&bar[XB_XSUB(b.x)], 1u);
        const unsigned gen = old / nloc;
        if (old + 1u == (gen + 1u) * nloc) {
            __builtin_amdgcn_fence(__ATOMIC_RELEASE, "agent");
            asm volatile("s_waitcnt vmcnt(0)" ::: "memory");
            const unsigned og = xb_add(&bar[XB_TOP], 1u);
            const unsigned tg = og / nx;
            if (og + 1u == (tg + 1u) * nx) xb_add(&bar[XB_TOPGEN], 1u);
            else XB_SPIN(xb_ld(&bar[XB_TOPGEN]) == tg, bar);
            __builtin_amdgcn_fence(__ATOMIC_ACQUIRE, "agent");
            xb_add(&bar[XB_XGEN(b.x)], 1u);
            asm volatile("s_waitcnt vmcnt(0)" ::: "memory");
        } else {
            XB_SPIN(xb_ld(&bar[XB_XGEN(b.x)]) == gen, bar);
            __builtin_amdgcn_fence(__ATOMIC_ACQUIRE, "agent");
            asm volatile("s_waitcnt vmcnt(0)" ::: "memory");
        }
    }
    block_sync();
}

constexpr size_t MiB = 1u << 20;
constexpr int M = NB * L;
constexpr size_t WS_VSS = 0, WS_XSS = 64 * 1024, WS_X2SS = 128 * 1024, WS_TTAB = 192 * 1024, WS_BAR = 256 * 1024, WS_H3 = 1 * MiB;
constexpr size_t WS_WTA = 2 * MiB, WS_WTB = 10 * MiB, WS_PAB = 16 * MiB, WS_WO = 20 * MiB;
constexpr size_t WS_FSUM = 24 * MiB, WS_WUP = 24 * MiB, WS_WDN = 35 * MiB;
constexpr size_t WS_HYT = 41 * MiB;
constexpr size_t WS_X1B = 41 * MiB, WS_MRG = 105 * MiB;
constexpr size_t WS_YAB = 169 * MiB;
constexpr size_t WS_FDIF = 233 * MiB;
constexpr size_t WS_AP = 73 * MiB, WS_GP = 161 * MiB;
static_assert(WS_GP + (size_t)M * FH * 2 <= 256 * MiB && WS_AP + (size_t)M * FH * 2 <= WS_GP && WS_FDIF + 16 * MiB <= 256 * MiB && WS_WDN + (size_t)D * FH * 2 <= WS_HYT, "d_ws map");
constexpr int LDS_BYTES = 147456;
constexpr int NPH = 10;

struct MegaArgs { const float* in[27]; float* out; unsigned char* ws; int ph_lo, ph_hi; WJobs wj; };

__global__ void __launch_bounds__(512, 2) __attribute__((target("no-packed-fp32-ops"))) mega_fwd(MegaArgs a) {
    extern __shared__ __attribute__((aligned(16))) unsigned char lds_raw[];
    LAS unsigned char* lds = (LAS unsigned char*)lds_raw;
    cg::grid_group grid = cg::this_grid();
    const int wave = __builtin_amdgcn_readfirstlane((int)threadIdx.x >> 6);
    const int G = gridDim.x, bid = blockIdx.x, gw = bid * 8 + wave, NGW = G * 8;
#define FRESH_TID int lane; asm volatile("v_mbcnt_lo_u32_b32 %0, -1, 0\n\tv_mbcnt_hi_u32_b32 %0, -1, %0" : "=v"(lane)); const int tid = wave * 64 + lane; (void)tid
    unsigned char* ws = a.ws;
    const float* x = a.in[0];
    float* vss = (float*)(ws + WS_VSS); float* xss = (float*)(ws + WS_XSS); float* x2ss = (float*)(ws + WS_X2SS);
    cfv* Ttab = (cfv*)(ws + WS_TTAB); float* h3 = (float*)(ws + WS_H3);
    bf16* WtA = (bf16*)(ws + WS_WTA); bf16* WtB = (bf16*)(ws + WS_WTB); bf16* PabT = (bf16*)(ws + WS_PAB); bf16* WoT = (bf16*)(ws + WS_WO);
    bf16* WupT = (bf16*)(ws + WS_WUP); bf16* WdnT = (bf16*)(ws + WS_WDN);
    float* fsum = (float*)(ws + WS_FSUM); float* fdif = (float*)(ws + WS_FDIF);
    bf16* hyvT = (bf16*)(ws + WS_HYT); bf16* yaT = hyvT + (size_t)1024 * M; bf16* vT = hyvT + (size_t)3072 * M;
    bf16* YAB = (bf16*)(ws + WS_YAB); bf16* h1 = YAB; bf16* Ub = YAB + 1024;
    bf16* Gb = (bf16*)a.out;
    bf16* mrg = (bf16*)(ws + WS_MRG); bf16* X1b = (bf16*)(ws + WS_X1B); float* X1 = a.out;
    bf16* APb = (bf16*)(ws + WS_AP); bf16* GPb = (bf16*)(ws + WS_GP);
    const int lo = a.ph_lo, hi = a.ph_hi;
#define IN(k) (lo <= (k) && (k) < hi)
    for (int u = (int)threadIdx.x; u < 16; u += 512) ((LAS unsigned*)(lds + LDS_BYTES - 256))[u] = 0u;
    block_sync();
    XcdBarrier xbar = xcd_barrier_post((unsigned*)(ws + WS_BAR), (volatile LAS unsigned*)(lds + LDS_BYTES - 256));
#ifdef MK_PROBE
#define STAMP(i) do { if (threadIdx.x == 0) ((volatile LAS unsigned long long*)(lds + LDS_BYTES - 128))[i] = __builtin_amdgcn_s_memrealtime(); } while (0)
#else
#define STAMP(i) do { } while (0)
#endif
    STAMP(0);
#define SEAM(k) do { if (IN(k) && IN((k) + 1)) xcd_barrier(xbar); STAMP((k) + 1); } while (0)
    if (a.ph_hi > NPH) grid.sync();

    if (IN(0)) { FRESH_TID;
        p0_weights(a.wj, 0, 7, (LAS float*)lds + wave * 4096, gw, NGW, lane);
        for (int m = 4 * gw; m < M; m += 4 * NGW) rms_rows4_to_bf16(x + (size_t)m * 1024, a.in[1], h1 + (size_t)m * 2048, 2048, lane);
        for (int i = bid * 512 + tid; i < 3 * M; i += G * 512) vss[i] = 0.f;
        block_sync();
        { LAS float* wl = (LAS float*)lds;
          for (int i = tid; i < MLPW_N; i += 512) { float v;
              if (i < MLPW_W2) v = a.in[5][i]; else if (i < MLPW_W3) v = a.in[7][i - MLPW_W2]; else if (i < MLPW_B) v = a.in[9][i - MLPW_W3];
              else { const int q = i - MLPW_B; v = q < 64 ? a.in[6][q] : q < 128 ? a.in[8][q - 64] : q < 192 ? a.in[10][q - 128] : a.in[11][q - 192]; }
              wl[i] = v; }
          block_sync();
          for (int l = 2 * gw; l < L; l += 2 * NGW) filter_mlp_rows2(wl, h3, (LAS float*)(lds + 65536) + wave * 128, l, l + 1, lane); }
        for (int m = bid * 512 + tid; m < 4096; m += G * 512) { const float ang = (float)m / 4096.0f; Ttab[m] = (cfv){cospif(ang), -sinpif(ang)}; }
    }
    SEAM(0);
    if (IN(1)) { FRESH_TID;
        { pg8::Gemm g{WtA, h1, 4096, M, 1024, 1024, 2048}; pg8::StaticOrder S; S.init(4096, M, G, bid);
          pg8::EpiHyT E{hyvT, M, vss};
          pg8::gemm_phase<pg8::EpiHyT, pg8::StaticOrder, true, true>(lds, g, S, E, tid); }
        STAMP(11);
        { pg8::Gemm g{h1, WtB, M, 3072, 1024, 2048, 1024}; pg8::StaticOrder S; S.init(M, 3072, G, bid);
          pg8::EpiUG E{Ub, Gb, 2048};
          pg8::gemm_phase<pg8::EpiUG, pg8::StaticOrder, true, true>(lds, g, S, E, tid); }
        STAMP(12);
        filter_tables(h3, a.in[12], a.in[13], fsum, fdif, (LAS float*)(lds + wave * 17408), gw, NGW, lane);
    }
    SEAM(1);
    if (IN(2)) { FRESH_TID;
        HyArgs H; H.hyT = hyvT; H.yaT = yaT; H.fsum = fsum; H.fdif = fdif; H.cw = a.in[3]; H.cb = a.in[4]; H.skip = a.in[14]; H.T = Ttab;
        H.TS = M; H.npairs = 2; H.off00 = 0; H.off01 = L; H.off10 = 2 * L; H.off11 = 3 * L;
        hyena_phase((lcf)lds, H, bid, G, tid);
        STAMP(13);
        SguArgs Sg; Sg.vT = vT; Sg.U = Ub; Sg.vss = vss; Sg.ws = a.in[16]; Sg.bs = a.in[17]; Sg.gn = a.in[15]; Sg.TS = M; Sg.ldu = 2048;
        for (int it = bid; it < (M / 128) * 8; it += G) sgu_item(lds, Sg, it, tid);
    }
    SEAM(2);
    if (IN(3)) { FRESH_TID;
        transpose_ya(yaT, M, YAB, 2048, (LAS unsigned short*)lds + wave * 8192, gw, NGW, lane);
        p0_weights(a.wj, 7, 9, (LAS float*)lds + wave * 4096, gw, NGW, lane);
    }
    SEAM(3);
    if (IN(4)) { FRESH_TID;
        pg8::Gemm g{YAB, PabT, M, 1024, 2048, 2048, 2048}; pg8::StaticOrder S; S.init(M, 1024, G, bid);
        pg8::EpiMerge E{Gb, mrg};
        pg8::gemm_phase<pg8::EpiMerge, pg8::StaticOrder, true, true>(lds, g, S, E, tid);
    }
    SEAM(4);
    if (IN(5)) { FRESH_TID;
        pg8::Gemm g{mrg, WoT, M, 1024, 1024, 1024, 1024}; pg8::StaticOrder S; S.init(M, 1024, G, bid);
        pg8::EpiResid<true> E{x, nullptr, nullptr, X1b, xss};
        pg8::gemm_phase<pg8::EpiResid<true>, pg8::StaticOrder, true, true>(lds, g, S, E, tid);
    }
    SEAM(5);
    if (IN(6)) { FRESH_TID;
        pg8::Gemm g{X1b, WupT, M, 2 * FH, 1024, 1024, 1024}; pg8::StaticOrder S; S.init(M, 2 * FH, G, bid);
        pg8::EpiUp E{APb, GPb, xss};
        pg8::gemm_phase<pg8::EpiUp, pg8::StaticOrder, true, true>(lds, g, S, E, tid);
    }
    SEAM(6);
    if (IN(7)) { FRESH_TID; act_pass(APb, GPb, a.in[23], a.in[24], M, bid * 512 + tid, G * 512); }
    SEAM(7);
    if (IN(8)) { FRESH_TID;
        pg8::Gemm g{GPb, WdnT, M, 1024, FH, FH, FH}; pg8::StaticOrder S; S.init(M, 1024, G, bid);
        pg8::EpiResid<false> E{nullptr, X1b, nullptr, X1b, x2ss};
        pg8::gemm_phase<pg8::EpiResid<false>, pg8::StaticOrder, true, true>(lds, g, S, E, tid);
    }
    SEAM(8);
    if (IN(9)) { FRESH_TID; final_norm(X1b, x2ss, a.in[26], a.out, M, gw, NGW, lane); }
    STAMP(10);
#ifdef MK_PROBE
#ifndef MK_PROBE_A
#define MK_PROBE_A MK_PROBE
#define MK_PROBE_B (MK_PROBE + 1)
#endif
    if (threadIdx.x == 0) { volatile LAS unsigned long long* ts = (volatile LAS unsigned long long*)(lds + LDS_BYTES - 128);
        const unsigned long long dt = 2ull * (ts[MK_PROBE_B] - ts[MK_PROBE_A]), t0 = __builtin_amdgcn_s_memrealtime();
        while (__builtin_amdgcn_s_memrealtime() - t0 < dt) __builtin_amdgcn_s_sleep(8); }
    block_sync();
#endif
#undef IN
#undef SEAM
}
}

#ifndef MK_CUTS
#define MK_CUTS 0
#endif
extern "C" void kernel_launch(void* const* d_in, const int* in_sizes, int n_in, void* d_out, int out_size, void* d_ws, size_t ws_size, hipStream_t stream) {
    static int grid = 0;
    if (grid == 0) {
        int dev = 0, cus = 0, per_cu = 0;
        hipGetDevice(&dev);
        hipDeviceGetAttribute(&cus, hipDeviceAttributeMultiprocessorCount, dev);
        hipFuncSetAttribute((const void*)mega_fwd, hipFuncAttributeMaxDynamicSharedMemorySize, LDS_BYTES);
        hipOccupancyMaxActiveBlocksPerMultiprocessor(&per_cu, (const void*)mega_fwd, 512, LDS_BYTES);
        if (per_cu < 1) { fprintf(stderr, "kernel_launch: occupancy query says %d blocks per CU\n", per_cu); per_cu = 1; }
        grid = cus * 1;
        (void)hipGetLastError();
    }
    hipMemsetAsync((char*)d_ws + WS_BAR, 0, XCD_BAR_WORDS * 4, stream);
    MegaArgs a{};
    for (int i = 0; i < 27; ++i) a.in[i] = (const float*)d_in[i];
    a.out = (float*)d_out; a.ws = (unsigned char*)d_ws;
    { unsigned char* ws = (unsigned char*)d_ws;
      bf16* WtA = (bf16*)(ws + WS_WTA); bf16* WtB = (bf16*)(ws + WS_WTB); bf16* PabT = (bf16*)(ws + WS_PAB); bf16* WoT = (bf16*)(ws + WS_WO); bf16* WupT = (bf16*)(ws + WS_WUP); bf16* WdnT = (bf16*)(ws + WS_WDN);
    a.wj.j[0] = WJob{(const float*)d_in[2], nullptr, WtA, 1024, INW, 0, 3072, 1024, 0, 0, 0};
    a.wj.j[1] = WJob{(const float*)d_in[2], nullptr, WtA, 1024, INW, 4096, 1024, 1024, 3072, 0, 0};
    a.wj.j[2] = WJob{(const float*)d_in[2], nullptr, WtB, 1024, INW, 3072, 1024, 1024, 0, 0, 0};
    a.wj.j[3] = WJob{(const float*)d_in[2], nullptr, WtB, 1024, INW, 5120, 2048, 1024, 1024, 0, 0};
    a.wj.j[4] = WJob{(const float*)d_in[18], nullptr, PabT, 1024, 1024, 0, 1024, 2048, 0, 0, 0};
    a.wj.j[5] = WJob{(const float*)d_in[19], nullptr, PabT, 1024, 1024, 0, 1024, 2048, 0, 1024, 0};
    a.wj.j[6] = WJob{(const float*)d_in[20], nullptr, WoT, 1024, 1024, 0, 1024, 1024, 0, 0, 0};
    a.wj.j[7] = WJob{(const float*)d_in[22], (const float*)d_in[21], WupT, 1024, 2 * FH, 0, 2 * FH, 1024, 0, 0, 0};
    a.wj.j[8] = WJob{(const float*)d_in[25], nullptr, WdnT, FH, 1024, 0, 1024, FH, 0, 0, 0};

    }
#if MK_CUTS
    for (int p = 0; p < NPH; ++p) { a.ph_lo = p; a.ph_hi = p + 1; hipLaunchKernelGGL(mega_fwd, dim3(grid), dim3(512), LDS_BYTES, stream, a); }
#else
    a.ph_lo = 0; a.ph_hi = NPH;
    void* args[] = {&a};
    hipError_t e = hipLaunchCooperativeKernel((const void*)mega_fwd, dim3(grid), dim3(512), args, LDS_BYTES, stream);
    if (e != hipSuccess) fprintf(stderr, "cooperative launch failed: %s (grid %d)\n", hipGetErrorString(e), grid);
#endif
}
```

```cpp
#include <hip/hip_runtime.h>
#include <hip/hip_cooperative_groups.h>
#include <math.h>
#include <stdint.h>
#include <cstdio>
namespace cg = cooperative_groups;
namespace pg8 {
#define PG8_LAS __attribute__((address_space(3)))
typedef unsigned short bf16_t;
typedef short bf16x8 __attribute__((ext_vector_type(8)));
typedef float f32x4 __attribute__((ext_vector_type(4)));
typedef unsigned u32x4 __attribute__((ext_vector_type(4)));
constexpr int BM = 256, BK = 64, HALF = 128, HTB = HALF * BK * 2  , STAGE_BYTES = 8 * HTB, NXCD = 8, WGM = 8;

__host__ __device__ __forceinline__ int lds_byte(int r, int c) { const int st = (r >> 4) * 2 + (c >> 5), rr = r & 15, cc = c & 31, ob = rr * 64 + cc * 2; return st * 1024 + (ob ^ (((ob >> 9) & 1) << 5)); }
__host__ __device__ __forceinline__ void stage_rc(int b, int& R, int& C) { const int st = b / 1024, sb = b % 1024, swz = sb ^ (((sb >> 9) & 1) << 5); R = (st >> 1) * 16 + swz / 64; C = (st & 1) * 32 + (swz % 64) / 2; }
__host__ __device__ __forceinline__ int perm32(int rho) { const int n = rho >> 4, i = rho & 15; return 8 * (i >> 2) + 4 * n + (i & 3); }

struct Unit { int pm, pn; };
struct Gemm { const bf16_t* A; const bf16_t* Bt; int M, N, K, lda, ldb; };

struct StaticOrder {
    int nM, nN, nwg, G, c;
    __host__ __device__ __forceinline__ void init(int M, int N, int G_, int c_) { nM = M / BM; nN = N / BM; nwg = nM * nN; G = G_; c = c_; }
    __host__ __device__ __forceinline__ bool next(int i, Unit& u) const {
        const long L = (long)i * G + c; if (L >= nwg) return false;
        int wgid = (int)L; { const int q = nwg / NXCD, r = nwg % NXCD, xcd = wgid % NXCD, off = wgid / NXCD; wgid = (xcd < r ? xcd * (q + 1) : r * (q + 1) + (xcd - r) * q) + off; }
        const int nig = WGM * nN, gid = wgid / nig, fm = gid * WGM, gsz = (nM - fm) < WGM ? (nM - fm) : WGM;
        u.pm = fm + ((wgid % nig) % gsz); u.pn = (wgid % nig) / gsz; return true;
    }
    __device__ __forceinline__ void a_ready(const Unit&) const {}
    __device__ __forceinline__ void done(const Unit&) const {}
};

__device__ __forceinline__ unsigned cvt_pk_bf16(float lo, float hi) { unsigned r; asm volatile("v_cvt_pk_bf16_f32 %0, %1, %2" : "=v"(r) : "v"(lo), "v"(hi)); return r; }
typedef float f32x2 __attribute__((ext_vector_type(2)));
__device__ __forceinline__ f32x2 gelu_pk(f32x2 v) {
    const f32x2 av = __builtin_elementwise_abs(v), d = av * 0.2316418882f + 1.0f;
    f32x2 t; t.x = __builtin_amdgcn_rcpf(d.x); t.y = __builtin_amdgcn_rcpf(d.y);
    f32x2 q = t * 0.5307027145f + (-0.7265760135f); q = q * t + 0.7107068705f; q = q * t + (-0.142248368f); q = q * t + 0.127414796f; q = q * t;
    const f32x2 s = (v * v) * (-0.72134752044f);
    f32x2 e; e.x = __builtin_amdgcn_exp2f(s.x); e.y = __builtin_amdgcn_exp2f(s.y);
    const f32x2 m = v * (q * e), r = v - m;
    f32x2 o; o.x = v.x < 0.f ? m.x : r.x; o.y = v.y < 0.f ? m.y : r.y; return o;
}

template <int ACT  > struct EpiBf16 {
    static constexpr bool PERM = true, AFTER_DRAIN = false, MID = false; static_assert(ACT == 0 || ACT == 1, "EpiBf16: ACT is 0 (none) or 1 (gelu_pk)");
    bf16_t* O; int ldc; const float* bias; int split_cols; size_t split_stride; float scale0;
    __device__ __forceinline__ void operator()(const f32x4 (&acc)[2][2][4][2], const Unit& u, int wr, int wc, int fr, int fq) const {
        const int row0 = u.pm * BM + wr * 64 + fr; int colt = u.pn * BM; bf16_t* base = O;
        float sc = 1.f; if (split_cols) { const int t = colt / split_cols; base += (size_t)t * split_stride; colt -= t * split_cols; if (t == 0) sc = scale0; }
        const int col0 = colt + wc * 32 + 8 * fq, bcol0 = u.pn * BM + wc * 32 + 8 * fq;
        f32x4 bv[2][2];
#pragma unroll
        for (int bj = 0; bj < 2; ++bj)
#pragma unroll
            for (int n = 0; n < 2; ++n) bv[bj][n] = bias ? *(const f32x4*)(bias + bcol0 + bj * HALF + 4 * n) : (f32x4){0.f, 0.f, 0.f, 0.f};
#pragma unroll
        for (int ai = 0; ai < 2; ++ai)
#pragma unroll
            for (int m = 0; m < 4; ++m) { bf16_t* rowp = base + (size_t)(row0 + ai * HALF + m * 16) * ldc + col0;
#pragma unroll
                for (int bj = 0; bj < 2; ++bj) { f32x4 v0 = acc[ai][bj][m][0] + bv[bj][0], v1 = acc[ai][bj][m][1] + bv[bj][1];
                    if (ACT == 1) { f32x2 a = gelu_pk((f32x2){v0[0], v0[1]}), b = gelu_pk((f32x2){v0[2], v0[3]}), c = gelu_pk((f32x2){v1[0], v1[1]}), d = gelu_pk((f32x2){v1[2], v1[3]});
                        v0 = (f32x4){a.x, a.y, b.x, b.y}; v1 = (f32x4){c.x, c.y, d.x, d.y}; }
                    v0 = v0 * sc; v1 = v1 * sc; u32x4 w; w.x = cvt_pk_bf16(v0[0], v0[1]); w.y = cvt_pk_bf16(v0[2], v0[3]); w.z = cvt_pk_bf16(v1[0], v1[1]); w.w = cvt_pk_bf16(v1[2], v1[3]);
                    *(u32x4*)(rowp + bj * HALF) = w; } }
    }
};

struct EpiF32 {
    static constexpr bool PERM = false, AFTER_DRAIN = false, MID = false;
    float* C; int ldc; const float* bias;
    __device__ __forceinline__ void operator()(const f32x4 (&acc)[2][2][4][2], const Unit& u, int wr, int wc, int fr, int fq) const {
        const int row0 = u.pm * BM + wr * 64 + fr, col0 = u.pn * BM + wc * 32 + 4 * fq;
        f32x4 bv[2][2];
#pragma unroll
        for (int bj = 0; bj < 2; ++bj)
#pragma unroll
            for (int n = 0; n < 2; ++n) bv[bj][n] = bias ? *(const f32x4*)(bias + col0 + bj * HALF + n * 16) : (f32x4){0.f, 0.f, 0.f, 0.f};
#pragma unroll
        for (int ai = 0; ai < 2; ++ai)
#pragma unroll
            for (int m = 0; m < 4; ++m) { float* rowp = C + (size_t)(row0 + ai * HALF + m * 16) * ldc + col0;
#pragma unroll
                for (int bj = 0; bj < 2; ++bj)
#pragma unroll
                    for (int n = 0; n < 2; ++n) *(f32x4*)(rowp + bj * HALF + n * 16) = acc[ai][bj][m][n] + bv[bj][n]; }
    }
};

template <class Epi, class Sched, bool ALIGN_EPI = false, bool SP2 = false>
__device__ __forceinline__ void gemm_phase(PG8_LAS unsigned char* lds, const Gemm g, const Sched& S, const Epi& E, const int tid) {
    const int wid = __builtin_amdgcn_readfirstlane(tid >> 6), lane = tid & 63, wr = wid >> 2, wc = wid & 3, fr = lane & 15, fq = lane >> 4;
    const int K = g.K, nt = K / BK;
    unsigned voffA[2], voffB[2];
#pragma unroll
    for (int i = 0; i < 2; ++i) { int R, C; stage_rc(tid * 16 + i * 8192, R, C); const int Rb = Epi::PERM ? ((R & ~31) + perm32(R & 31)) : R;
        voffA[i] = (unsigned)(R * g.lda + C) * 2u; voffB[i] = (unsigned)(Rb * g.ldb + C) * 2u; }
    const size_t kstep = (size_t)(BK * 2);
    const size_t hstepA = (size_t)HALF * g.lda * 2, hstepB = (size_t)HALF * g.ldb * 2;
    const size_t tstepA = 2 * hstepA, tstepB = 2 * hstepB;
    const unsigned ldsw = (unsigned)wid * 1024u;
    const int aoff = lds_byte(wr * 64 + fr, fq * 8), boff = lds_byte(wc * 32 + fr, fq * 8);
#define PG8_SA(b, h) (((b) * 2 + (h)) * HTB)
#define PG8_SB(b, h) ((4 + (b) * 2 + (h)) * HTB)
#define PG8_STAGE(bufoff, gbase, voff) do { _Pragma("unroll") for (int _i = 0; _i < 2; ++_i) \
        __builtin_amdgcn_global_load_lds((const unsigned*)((const char*)(gbase) + (voff)[_i]), (PG8_LAS unsigned*)(lds + (bufoff) + ldsw + _i * 8192), 16, 0, 0); } while (0)
#define PG8_LDA(dst, b, h) do { _Pragma("unroll") for (int m = 0; m < 4; ++m) _Pragma("unroll") for (int k = 0; k < 2; ++k) dst[m][k] = *(const PG8_LAS bf16x8*)(lds + PG8_SA(b, h) + aoff + m * 2048 + k * 1024); } while (0)
#define PG8_LDB(dst, b, h) do { _Pragma("unroll") for (int n = 0; n < 2; ++n) _Pragma("unroll") for (int k = 0; k < 2; ++k) dst[n][k] = *(const PG8_LAS bf16x8*)(lds + PG8_SB(b, h) + boff + n * 2048 + k * 1024); } while (0)
#define PG8_MMA(ai, bj, At, Bt) do { __builtin_amdgcn_s_setprio(1); _Pragma("unroll") for (int m = 0; m < 4; ++m) _Pragma("unroll") for (int n = 0; n < 2; ++n) _Pragma("unroll") for (int k = 0; k < 2; ++k) \
        acc[ai][bj][m][n] = __builtin_amdgcn_mfma_f32_16x16x32_bf16(Bt[n][k], At[m][k], acc[ai][bj][m][n], 0, 0, 0); __builtin_amdgcn_s_setprio(0); } while (0)
#define PG8_WAIT_V(n) asm volatile("s_waitcnt vmcnt(" #n ")" ::: "memory")
#define PG8_WAIT_L(n) asm volatile("s_waitcnt lgkmcnt(" #n ")" ::: "memory")
#define PG8_BAR __builtin_amdgcn_s_barrier()
#define PG8_SCHED __builtin_amdgcn_sched_barrier(0)
    Unit cur, nxt; int ui = 0;
    if (!S.next(0, cur)) return;
    f32x4 acc[2][2][4][2];
#pragma unroll
    for (int a = 0; a < 2; ++a)
#pragma unroll
        for (int b = 0; b < 2; ++b)
#pragma unroll
            for (int m = 0; m < 4; ++m)
#pragma unroll
                for (int n = 0; n < 2; ++n) acc[a][b][m][n] = (f32x4){0.f, 0.f, 0.f, 0.f};
    bf16x8 At[4][2], B0[2][2], B1[2][2];
    const char* cA = (const char*)g.A + (size_t)cur.pm * tstepA; const char* cB = (const char*)g.Bt + (size_t)cur.pn * tstepB;
    S.a_ready(cur);
    if constexpr (SP2) {
        PG8_STAGE(PG8_SB(0, 0), cB, voffB); PG8_STAGE(PG8_SB(0, 1), cB + hstepB, voffB); PG8_STAGE(PG8_SA(0, 0), cA, voffA); PG8_STAGE(PG8_SA(0, 1), cA + hstepA, voffA);
        if (wr == 1) PG8_BAR;
        PG8_WAIT_V(2); PG8_BAR;
        PG8_STAGE(PG8_SB(1, 0), cB + kstep, voffB); PG8_STAGE(PG8_SA(1, 0), cA + kstep, voffA); PG8_STAGE(PG8_SB(1, 1), cB + hstepB + kstep, voffB);
        PG8_WAIT_V(6); PG8_BAR;
    } else {
        PG8_STAGE(PG8_SB(0, 0), cB, voffB); PG8_STAGE(PG8_SA(0, 0), cA, voffA); PG8_STAGE(PG8_SB(0, 1), cB + hstepB, voffB); PG8_STAGE(PG8_SA(0, 1), cA + hstepA, voffA);
        if (wr == 1) PG8_BAR;
        PG8_WAIT_V(4); PG8_BAR;
        PG8_STAGE(PG8_SB(1, 0), cB + kstep, voffB); PG8_STAGE(PG8_SA(1, 0), cA + kstep, voffA); PG8_STAGE(PG8_SB(1, 1), cB + hstepB + kstep, voffB);
        PG8_WAIT_V(6); PG8_BAR;
    }
    for (;;) {
        const bool has_next = S.next(ui + 1, nxt);
        const char* nA = has_next ? (const char*)g.A + (size_t)nxt.pm * tstepA : cA; const char* nB = has_next ? (const char*)g.Bt + (size_t)nxt.pn * tstepB : cB;
        for (int t = 0; t < nt; t += 2) {
            const bool last = (t == nt - 2);
            const char* a1 = cA + (size_t)(t + 1) * kstep;
            const char* a2 = last ? nA : cA + (size_t)(t + 2) * kstep; const char* b2 = last ? nB : cB + (size_t)(t + 2) * kstep;
            const char* a3 = a2 + kstep; const char* b3 = b2 + kstep;
            if (last && has_next) S.a_ready(nxt);
            if constexpr (Epi::MID) { if (t == (nt >> 1)) E.mid(acc, cur, wr, wc, fr, fq); }
            if constexpr (SP2) {
            PG8_LDB(B0, 0, 0); PG8_LDB(B1, 0, 1); PG8_SCHED; PG8_LDA(At, 0, 0); PG8_STAGE(PG8_SA(1, 1), a1 + hstepA, voffA);
            PG8_WAIT_V(8); PG8_WAIT_L(0); PG8_BAR; PG8_MMA(0, 0, At, B0); PG8_MMA(0, 1, At, B1); PG8_BAR; PG8_SCHED;
            PG8_LDA(At, 0, 1); PG8_STAGE(PG8_SB(0, 0), b2, voffB); PG8_STAGE(PG8_SB(0, 1), b2 + hstepB, voffB); PG8_STAGE(PG8_SA(0, 0), a2, voffA);
            PG8_WAIT_V(8); PG8_WAIT_L(0); PG8_BAR; PG8_MMA(1, 0, At, B0); PG8_MMA(1, 1, At, B1); PG8_BAR; PG8_SCHED;
            PG8_LDB(B0, 1, 0); PG8_LDB(B1, 1, 1); PG8_SCHED; PG8_LDA(At, 1, 0); PG8_STAGE(PG8_SA(0, 1), a2 + hstepA, voffA);
            PG8_WAIT_V(8); PG8_WAIT_L(0); PG8_BAR; PG8_MMA(0, 0, At, B0); PG8_MMA(0, 1, At, B1); PG8_BAR; PG8_SCHED;
            PG8_LDA(At, 1, 1); PG8_STAGE(PG8_SB(1, 0), b3, voffB); PG8_STAGE(PG8_SB(1, 1), b3 + hstepB, voffB); PG8_STAGE(PG8_SA(1, 0), a3, voffA);
            PG8_WAIT_V(8); PG8_WAIT_L(0); PG8_BAR; PG8_MMA(1, 0, At, B0); PG8_MMA(1, 1, At, B1); PG8_BAR; PG8_SCHED;
            } else {
            PG8_LDB(B0, 0, 0); PG8_SCHED; PG8_LDA(At, 0, 0); PG8_STAGE(PG8_SA(1, 1), a1 + hstepA, voffA);
            PG8_WAIT_L(8); PG8_BAR; PG8_WAIT_L(0); PG8_MMA(0, 0, At, B0); PG8_BAR; PG8_SCHED;
            PG8_LDB(B1, 0, 1); PG8_STAGE(PG8_SB(0, 0), b2, voffB);
            PG8_BAR; PG8_WAIT_L(0); PG8_MMA(0, 1, At, B1); PG8_BAR;
            PG8_LDA(At, 0, 1); PG8_STAGE(PG8_SA(0, 0), a2, voffA);
            PG8_BAR; PG8_WAIT_L(0); PG8_MMA(1, 0, At, B0); PG8_BAR; PG8_SCHED;
            PG8_STAGE(PG8_SB(0, 1), b2 + hstepB, voffB);
            PG8_WAIT_V(6); PG8_BAR; PG8_MMA(1, 1, At, B1); PG8_BAR;
            PG8_LDB(B0, 1, 0); PG8_SCHED; PG8_LDA(At, 1, 0); PG8_STAGE(PG8_SA(0, 1), a2 + hstepA, voffA);
            PG8_WAIT_L(8); PG8_BAR; PG8_WAIT_L(0); PG8_MMA(0, 0, At, B0); PG8_BAR; PG8_SCHED;
            PG8_LDB(B1, 1, 1); PG8_STAGE(PG8_SB(1, 0), b3, voffB);
            PG8_BAR; PG8_WAIT_L(0); PG8_MMA(0, 1, At, B1); PG8_BAR;
            PG8_LDA(At, 1, 1); PG8_STAGE(PG8_SA(1, 0), a3, voffA);
            PG8_BAR; PG8_WAIT_L(0); PG8_MMA(1, 0, At, B0); PG8_BAR; PG8_SCHED;
            PG8_STAGE(PG8_SB(1, 1), b3 + hstepB, voffB);
            PG8_WAIT_V(6); PG8_BAR; PG8_MMA(1, 1, At, B1); PG8_BAR;
            }
        }
        if constexpr (ALIGN_EPI) { if (wr == 0) PG8_BAR; }
        if constexpr (!Epi::AFTER_DRAIN) { E(acc, cur, wr, wc, fr, fq); S.done(cur); }
        if (!has_next) break;
#pragma unroll
        for (int a = 0; a < 2; ++a)
#pragma unroll
            for (int b = 0; b < 2; ++b)
#pragma unroll
                for (int m = 0; m < 4; ++m)
#pragma unroll
                    for (int n = 0; n < 2; ++n) acc[a][b][m][n] = (f32x4){0.f, 0.f, 0.f, 0.f};
        cur = nxt; cA = nA; cB = nB; ++ui;
        if constexpr (ALIGN_EPI) { if (wr == 1) PG8_BAR; }
    }
    PG8_WAIT_V(0);
    if constexpr (!ALIGN_EPI) { if (wr == 0) PG8_BAR; }
    PG8_BAR;
    if constexpr (Epi::AFTER_DRAIN) { E.fused(acc, cur, wr, wc, fr, fq, lds, wid, lane); S.done(cur); }
#undef PG8_SA
#undef PG8_SB
#undef PG8_STAGE
#undef PG8_LDA
#undef PG8_LDB
#undef PG8_MMA
#undef PG8_WAIT_V
#undef PG8_WAIT_L
#undef PG8_BAR
#undef PG8_SCHED
}
}
namespace {
constexpr int D = 1024, NB = 4, L = 4096, HW = 1024, SW = 1024, INW = 7168, FH = 2816, FHID = 64, FEMB = 33;
constexpr float EPS = 1e-6f;
typedef unsigned short bf16;
__device__ __forceinline__ unsigned f2bf(float f) { unsigned u = __builtin_bit_cast(unsigned, f); return (u + 0x7fffu + ((u >> 16) & 1u)) >> 16; }
__device__ __forceinline__ void block_sync() { __builtin_amdgcn_fence(__ATOMIC_RELEASE, "workgroup"); __builtin_amdgcn_s_barrier(); __builtin_amdgcn_fence(__ATOMIC_ACQUIRE, "workgroup"); }
}
namespace {
#define HD __device__ __forceinline__
#define FFT_OPAQUE(w) asm volatile("" : "+v"((w).x), "+v"((w).y))
#ifndef HD
#define HD inline
#endif
typedef float cfv __attribute__((ext_vector_type(2)));
struct cf { float x, y; };
HD cf cmk(float x, float y) { cf r; r.x = x; r.y = y; return r; }
template <class P> HD cf ldz(P Z, int i) { const cfv t = Z[i]; return cmk(t.x, t.y); }
template <class P> HD void stz(P Z, int i, cf v) { Z[i] = (cfv){v.x, v.y}; }
HD cf cadd(cf a, cf b) { return cmk(a.x + b.x, a.y + b.y); }
HD cf csub(cf a, cf b) { return cmk(a.x - b.x, a.y - b.y); }
HD cf cmul(cf a, cf b) { return cmk(a.x * b.x - a.y * b.y, a.x * b.y + a.y * b.x); }
HD cf cconj(cf a) { return cmk(a.x, -a.y); }
template <bool INV> HD cf mulmi(cf a) { return INV ? cmk(-a.y, a.x) : cmk(a.y, -a.x); }
template <bool INV> HD cf twc(float c, float s) { return INV ? cmk(c, s) : cmk(c, -s); }
HD int fpad(int p) { return p + (p >> 4); }
constexpr int FSUB = 4352;

template <bool INV> HD void dft4(cf& a, cf& b, cf& c, cf& d) {
    const cf t0 = cadd(a, c), t1 = csub(a, c), t2 = cadd(b, d), t3 = mulmi<INV>(csub(b, d));
    a = cadd(t0, t2); b = cadd(t1, t3); c = csub(t0, t2); d = csub(t1, t3);
}
template <bool INV> HD void dft16(cf (&v)[16]) {
    constexpr float C1 = 0.92387953251128674f, S1 = 0.38268343236508977f, R = 0.70710678118654752f;
#pragma unroll
    for (int n0 = 0; n0 < 4; ++n0) dft4<INV>(v[n0], v[n0 + 4], v[n0 + 8], v[n0 + 12]);
    v[1 + 4 * 1] = cmul(v[1 + 4 * 1], twc<INV>(C1, S1));
    v[1 + 4 * 2] = cmul(v[1 + 4 * 2], twc<INV>(R, R));
    v[1 + 4 * 3] = cmul(v[1 + 4 * 3], twc<INV>(S1, C1));
    v[2 + 4 * 1] = cmul(v[2 + 4 * 1], twc<INV>(R, R));
    v[2 + 4 * 2] = mulmi<INV>(v[2 + 4 * 2]);
    v[2 + 4 * 3] = cmul(v[2 + 4 * 3], twc<INV>(-R, R));
    v[3 + 4 * 1] = cmul(v[3 + 4 * 1], twc<INV>(S1, C1));
    v[3 + 4 * 2] = cmul(v[3 + 4 * 2], twc<INV>(-R, R));
    v[3 + 4 * 3] = cmul(v[3 + 4 * 3], twc<INV>(-C1, -S1));
#pragma unroll
    for (int k0 = 0; k0 < 4; ++k0) dft4<INV>(v[4 * k0], v[4 * k0 + 1], v[4 * k0 + 2], v[4 * k0 + 3]);
    cf t;
    t = v[1]; v[1] = v[4]; v[4] = t;   t = v[2]; v[2] = v[8]; v[8] = t;   t = v[3]; v[3] = v[12]; v[12] = t;
    t = v[6]; v[6] = v[9]; v[9] = t;   t = v[7]; v[7] = v[13]; v[13] = t; t = v[11]; v[11] = v[14]; v[14] = t;
}
#ifndef FFT_OPAQUE
#define FFT_OPAQUE(w)
#endif
HD void twiddle16(cf (&v)[16], cf w) {
    FFT_OPAQUE(w);
    cf p = w;
#pragma unroll
    for (int k = 1; k < 16; ++k) { v[k] = cmul(v[k], p); if (k < 15) p = cmul(p, w); }
}
template <class P> HD void fwd_pass1(P Z, int t, cf w1) {
    cf v[16]; const int b = t + (t >> 4);
#pragma unroll
    for (int j = 0; j < 16; ++j) v[j] = ldz(Z, b + 272 * j);
    dft16<false>(v); twiddle16(v, w1);
#pragma unroll
    for (int j = 0; j < 16; ++j) stz(Z, b + 272 * j, v[j]);
}
template <class P> HD void fwd_pass2(P Z, int t, cf w2) {
    const int b = 272 * (t >> 4) + (t & 15);
    cf v[16];
#pragma unroll
    for (int j = 0; j < 16; ++j) v[j] = ldz(Z, b + 17 * j);
    dft16<false>(v); twiddle16(v, w2);
#pragma unroll
    for (int j = 0; j < 16; ++j) stz(Z, b + 17 * j, v[j]);
}
template <class P> HD void fwd_pass3_load(P Z, int t, cf (&v)[16]) {
#pragma unroll
    for (int j = 0; j < 16; ++j) v[j] = ldz(Z, 17 * t + j);
    dft16<false>(v);
}
template <class P> HD void inv_pass1_store(P Z, int t, cf (&v)[16]) {
    dft16<true>(v);
#pragma unroll
    for (int j = 0; j < 16; ++j) stz(Z, 17 * t + j, v[j]);
}
template <class P> HD void inv_pass2(P Z, int t, cf w2) {
    const int b = 272 * (t >> 4) + (t & 15);
    cf v[16];
#pragma unroll
    for (int j = 0; j < 16; ++j) v[j] = ldz(Z, b + 17 * j);
    twiddle16(v, cconj(w2)); dft16<true>(v);
#pragma unroll
    for (int j = 0; j < 16; ++j) stz(Z, b + 17 * j, v[j]);
}
template <class P> HD void inv_pass3(P Z, int t, cf w1) {
    cf v[16]; const int b = t + (t >> 4);
#pragma unroll
    for (int j = 0; j < 16; ++j) v[j] = ldz(Z, b + 272 * j);
    twiddle16(v, cconj(w1)); dft16<true>(v);
#pragma unroll
    for (int j = 0; j < 16; ++j) stz(Z, b + 272 * j, v[j]);
}
#define LAS __attribute__((address_space(3)))
typedef LAS cfv* lcf;
struct HyArgs {
    const bf16* hyT;
    bf16* yaT;
    const float* fsum;
    const float* fdif;
    const float* cw;
    const float* cb;
    const float* skip;
    const cfv* T;
    int TS, npairs, off00, off01, off10, off11;
};
__device__ __forceinline__ float bf2f(unsigned h) { return __builtin_bit_cast(float, h << 16); }
constexpr int HOFF_SX1 = 2 * FSUB * 8, HOFF_SV = HOFF_SX1 + 16384, HOFF_SX0 = HOFF_SV + 16384, HOFF_SF = HOFF_SX0 + 16384, HY_LDS_END = HOFF_SF + 32768;
#define HBAR() do { asm volatile("s_waitcnt lgkmcnt(0)" ::: "memory"); __builtin_amdgcn_s_barrier(); asm volatile("" ::: "memory"); } while (0)
#define HDMA_WAIT() asm volatile("s_waitcnt vmcnt(0)" ::: "memory")
#define WAVE_FENCE() asm volatile("s_waitcnt lgkmcnt(0)" ::: "memory")
__device__ __forceinline__ void hdma16(const void* gp, LAS unsigned char* wave_dst) { __builtin_amdgcn_global_load_lds((const unsigned*)gp, (LAS unsigned*)wave_dst, 16, 0, 0); }
__device__ __forceinline__ void conv8s(const LAS unsigned char* S, int tid, float w0, float w1, float w2, float b, float (&o)[8]) {
    const pg8::u32x4 q = *(const LAS pg8::u32x4*)(S + 16 * tid);
    const unsigned lft = *(const LAS unsigned short*)(S + (tid > 0 ? 16 * tid - 2 : 0)), rgt = *(const LAS unsigned short*)(S + (tid < 511 ? 16 * tid + 16 : 8190));
    float x[10];
    x[0] = tid > 0 ? bf2f(lft) : 0.f; x[9] = tid < 511 ? bf2f(rgt) : 0.f;
    x[1] = bf2f(q.x & 0xffffu); x[2] = bf2f(q.x >> 16); x[3] = bf2f(q.y & 0xffffu); x[4] = bf2f(q.y >> 16);
    x[5] = bf2f(q.z & 0xffffu); x[6] = bf2f(q.z >> 16); x[7] = bf2f(q.w & 0xffffu); x[8] = bf2f(q.w >> 16);
#pragma unroll
    for (int i = 0; i < 8; ++i) o[i] = b + w0 * x[i] + w1 * x[i + 1] + w2 * x[i + 2];
}
__device__ __forceinline__ pg8::u32x4 pack8(const float (&x)[8], const float (&y)[8]) {
    pg8::u32x4 w;
    w.x = f2bf(x[0] * y[0]) | (f2bf(x[1] * y[1]) << 16); w.y = f2bf(x[2] * y[2]) | (f2bf(x[3] * y[3]) << 16);
    w.z = f2bf(x[4] * y[4]) | (f2bf(x[5] * y[5]) << 16); w.w = f2bf(x[6] * y[6]) | (f2bf(x[7] * y[7]) << 16);
    return w;
}
__device__ __forceinline__ void hyena_phase(LAS unsigned char* lds, const HyArgs& A, int first, int stride, const int tid, const int wave) {
    lcf Z = (lcf)lds;
    const int s = tid >> 8, t = tid & 255, pb = 8 * tid + (tid >> 1);
    const cf w1 = ldz(A.T, 2 * t), w2 = ldz(A.T, 32 * (t & 15)), wp = ldz(A.T, 8 * tid);
    lcf Zs = Z + s * FSUB;
    LAS unsigned char* wdst = lds + wave * 1024;
    constexpr float W8C[8] = {1.0f, 0.99999970586f, 0.99999882345f, 0.99999735277f, 0.99999529381f, 0.99999264659f, 0.99998941108f, 0.99998558731f};
    constexpr float W8S[8] = {0.0f, 0.00076699031874f, 0.0015339801863f, 0.0023009691514f, 0.0030679567630f, 0.0038349425697f, 0.0046019261204f, 0.0053689069640f};
    if (first >= 1024) return;
#define ISSUE_PAIR(cc, oa, ob) do { \
        hdma16(A.hyT + (size_t)(1024 + (cc)) * A.TS + (oa) + 8 * tid, wdst + HOFF_SX1); hdma16(A.hyT + (size_t)(1024 + (cc)) * A.TS + (ob) + 8 * tid, wdst + HOFF_SX1 + 8192); \
        hdma16(A.hyT + (size_t)(2048 + (cc)) * A.TS + (oa) + 8 * tid, wdst + HOFF_SV);  hdma16(A.hyT + (size_t)(2048 + (cc)) * A.TS + (ob) + 8 * tid, wdst + HOFF_SV + 8192); } while (0)
#define ISSUE_X0(cc, oa, ob) do { hdma16(A.hyT + (size_t)(cc) * A.TS + (oa) + 8 * tid, wdst + HOFF_SX0); hdma16(A.hyT + (size_t)(cc) * A.TS + (ob) + 8 * tid, wdst + HOFF_SX0 + 8192); } while (0)
#define ISSUE_FILT(cc) do { \
        hdma16(A.fsum + (size_t)(cc) * 4096 + 8 * tid, wdst + HOFF_SF); hdma16(A.fsum + (size_t)(cc) * 4096 + 8 * tid + 4, wdst + HOFF_SF + 8192); \
        hdma16(A.fdif + (size_t)(cc) * 4096 + 8 * tid, wdst + HOFF_SF + 16384); hdma16(A.fdif + (size_t)(cc) * 4096 + 8 * tid + 4, wdst + HOFF_SF + 24576); } while (0)
    ISSUE_FILT(first); ISSUE_PAIR(first, A.off00, A.off01);
    for (int c = first; c < 1024; c += stride) {
        const int cn = c + stride;
        const float sk = A.skip[c];
        const float cx0 = A.cw[c], cx1 = A.cw[3072 + c], cx2 = A.cw[6144 + c], cxb = A.cb[c];
        const float ca0 = A.cw[1024 + c], ca1 = A.cw[3072 + 1024 + c], ca2 = A.cw[6144 + 1024 + c], cab = A.cb[1024 + c];
        const float cv0 = A.cw[2048 + c], cv1 = A.cw[3072 + 2048 + c], cv2 = A.cw[6144 + 2048 + c], cvb = A.cb[2048 + c];
        cf Kr[16];
        HDMA_WAIT();
        {
            const pg8::f32x4 s0 = *(const LAS pg8::f32x4*)(lds + HOFF_SF + 16 * tid), s1 = *(const LAS pg8::f32x4*)(lds + HOFF_SF + 8192 + 16 * tid);
            const pg8::f32x4 d0 = *(const LAS pg8::f32x4*)(lds + HOFF_SF + 16384 + 16 * tid), d1 = *(const LAS pg8::f32x4*)(lds + HOFF_SF + 24576 + 16 * tid);
            const float fs[8] = {s0[0], s0[1], s0[2], s0[3], s1[0], s1[1], s1[2], s1[3]}, fd[8] = {d0[0], d0[1], d0[2], d0[3], d1[0], d1[1], d1[2], d1[3]};
#pragma unroll
            for (int i = 0; i < 8; ++i) { cf wq = wp; FFT_OPAQUE(wq); const cf tw = cmul(wq, cmk(W8C[i], -W8S[i])); stz(Z, pb + i, cmk(fs[i], 0.f)); stz(Z, FSUB + pb + i, cmk(fd[i] * tw.x, fd[i] * tw.y)); }
        }
        HBAR();
        fwd_pass1(Zs, t, w1); HBAR();
        fwd_pass2(Zs, t, w2); WAVE_FENCE();
        fwd_pass3_load(Zs, t, Kr);
#pragma unroll
        for (int j = 0; j < 16; ++j) { Kr[j].x *= (1.0f / 8192.0f); Kr[j].y *= (1.0f / 8192.0f); }
        HBAR();
        for (int p = 0; p < A.npairs; ++p) {
            const int o0 = p ? A.off10 : A.off00, o1 = p ? A.off11 : A.off01;
            float u0[8], u1[8];
            {
                float a[8], b[8];
                conv8s(lds + HOFF_SX1, tid, ca0, ca1, ca2, cab, a); conv8s(lds + HOFF_SV, tid, cv0, cv1, cv2, cvb, b);
#pragma unroll
                for (int i = 0; i < 8; ++i) u0[i] = a[i] * b[i];
                conv8s(lds + HOFF_SX1 + 8192, tid, ca0, ca1, ca2, cab, a); conv8s(lds + HOFF_SV + 8192, tid, cv0, cv1, cv2, cvb, b);
#pragma unroll
                for (int i = 0; i < 8; ++i) u1[i] = a[i] * b[i];
            }
#pragma unroll
            for (int i = 0; i < 8; ++i) { cf wq = wp; FFT_OPAQUE(wq); const cf tw = cmul(wq, cmk(W8C[i], -W8S[i])); const cf z = cmk(u0[i], u1[i]); stz(Z, pb + i, z); stz(Z, FSUB + pb + i, cmul(z, tw)); }
            HBAR();
            ISSUE_X0(c, o0, o1);
            if (p + 1 < A.npairs) ISSUE_PAIR(c, A.off10, A.off11);
            else if (cn < 1024) { ISSUE_PAIR(cn, A.off00, A.off01); ISSUE_FILT(cn); }
            fwd_pass1(Zs, t, w1); HBAR();
            fwd_pass2(Zs, t, w2); WAVE_FENCE();
            {
                cf v[16];
                fwd_pass3_load(Zs, t, v);
#pragma unroll
                for (int j = 0; j < 16; ++j) v[j] = cmul(v[j], Kr[j]);
                inv_pass1_store(Zs, t, v);
            }
            WAVE_FENCE();
            inv_pass2(Zs, t, w2); HBAR();
            inv_pass3(Zs, t, w1);
            HDMA_WAIT(); HBAR();
            {
                float y0[8], y1[8];
#pragma unroll
                for (int i = 0; i < 8; ++i) { cf wq = wp; FFT_OPAQUE(wq); const cf tw = cmul(wq, cmk(W8C[i], -W8S[i])); const cf e = ldz(Z, pb + i), o = ldz(Z, FSUB + pb + i); const cf y = cadd(e, cmul(o, cconj(tw))); y0[i] = y.x + sk * u0[i]; y1[i] = y.y + sk * u1[i]; }
                float x0c[8];
                conv8s(lds + HOFF_SX0, tid, cx0, cx1, cx2, cxb, x0c);
                *(pg8::u32x4*)(A.yaT + (size_t)c * A.TS + o0 + 8 * tid) = pack8(x0c, y0);
                if (o1 != o0) { conv8s(lds + HOFF_SX0 + 8192, tid, cx0, cx1, cx2, cxb, x0c); *(pg8::u32x4*)(A.yaT + (size_t)c * A.TS + o1 + 8 * tid) = pack8(x0c, y1); }
            }
        }
    }
    HDMA_WAIT(); HBAR();
#undef ISSUE_PAIR
#undef ISSUE_X0
#undef ISSUE_FILT
}
}
namespace pg8 {
__device__ __forceinline__ f32x2 sigmoid_pk(f32x2 v) {
    f32x2 e; e.x = __builtin_amdgcn_exp2f(v.x * -1.4426950408889634f); e.y = __builtin_amdgcn_exp2f(v.y * -1.4426950408889634f);
    f32x2 o; o.x = __builtin_amdgcn_rcpf(1.0f + e.x); o.y = __builtin_amdgcn_rcpf(1.0f + e.y); return o;
}
struct EpiHyT {
    static constexpr bool PERM = true, AFTER_DRAIN = false, MID = false;
    bf16_t* O; int ldc; float* vss;
    __device__ __forceinline__ void operator()(const f32x4 (&acc)[2][2][4][2], const Unit& u, int wr, int wc, int fr, int fq) const {
        const int row0 = u.pm * BM + wr * 64 + fr, col0 = u.pn * BM + wc * 32 + 8 * fq;
        const bool isv = u.pm >= 12;
        f32x4 ss[2][2];
#pragma unroll
        for (int bj = 0; bj < 2; ++bj)
#pragma unroll
            for (int n = 0; n < 2; ++n) ss[bj][n] = (f32x4){0.f, 0.f, 0.f, 0.f};
#pragma unroll
        for (int ai = 0; ai < 2; ++ai)
#pragma unroll
            for (int m = 0; m < 4; ++m) { bf16_t* rowp = O + (size_t)(row0 + ai * HALF + m * 16) * ldc + col0;
#pragma unroll
                for (int bj = 0; bj < 2; ++bj) { f32x4 v0 = acc[ai][bj][m][0], v1 = acc[ai][bj][m][1];
                    if (isv) { f32x2 a = gelu_pk((f32x2){v0[0], v0[1]}), b = gelu_pk((f32x2){v0[2], v0[3]}), c = gelu_pk((f32x2){v1[0], v1[1]}), d = gelu_pk((f32x2){v1[2], v1[3]});
                        v0 = (f32x4){a.x, a.y, b.x, b.y}; v1 = (f32x4){c.x, c.y, d.x, d.y}; ss[bj][0] += v0 * v0; ss[bj][1] += v1 * v1; }
                    u32x4 w; w.x = cvt_pk_bf16(v0[0], v0[1]); w.y = cvt_pk_bf16(v0[2], v0[3]); w.z = cvt_pk_bf16(v1[0], v1[1]); w.w = cvt_pk_bf16(v1[2], v1[3]);
                    *(u32x4*)(rowp + bj * HALF) = w; } }
        if (isv) {
#pragma unroll
            for (int bj = 0; bj < 2; ++bj)
#pragma unroll
                for (int n = 0; n < 2; ++n)
#pragma unroll
                    for (int j = 0; j < 4; ++j) { float s = ss[bj][n][j]; s += __shfl_xor(s, 1); s += __shfl_xor(s, 2); s += __shfl_xor(s, 4); s += __shfl_xor(s, 8);
                        if (fr == 0) atomicAdd(vss + col0 + bj * HALF + 4 * n + j, s); }
        }
    }
};
struct EpiUG {
    static constexpr bool PERM = true, AFTER_DRAIN = false, MID = false;
    bf16_t* U; bf16_t* G; int ldu;
    __device__ __forceinline__ void operator()(const f32x4 (&acc)[2][2][4][2], const Unit& u, int wr, int wc, int fr, int fq) const {
        const int row0 = u.pm * BM + wr * 64 + fr; int colt = u.pn * BM; const bool isu = colt < 1024;
        bf16_t* base = isu ? U : G; const int ldc = isu ? ldu : 2048; if (!isu) colt -= 1024;
        const int col0 = colt + wc * 32 + 8 * fq;
#pragma unroll
        for (int ai = 0; ai < 2; ++ai)
#pragma unroll
            for (int m = 0; m < 4; ++m) { bf16_t* rowp = base + (size_t)(row0 + ai * HALF + m * 16) * ldc + col0;
#pragma unroll
                for (int bj = 0; bj < 2; ++bj) { f32x4 v0 = acc[ai][bj][m][0], v1 = acc[ai][bj][m][1];
                    f32x2 a, b, c, d;
                    if (isu) { a = gelu_pk((f32x2){v0[0], v0[1]}); b = gelu_pk((f32x2){v0[2], v0[3]}); c = gelu_pk((f32x2){v1[0], v1[1]}); d = gelu_pk((f32x2){v1[2], v1[3]}); }
                    else { a = sigmoid_pk((f32x2){v0[0], v0[1]}); b = sigmoid_pk((f32x2){v0[2], v0[3]}); c = sigmoid_pk((f32x2){v1[0], v1[1]}); d = sigmoid_pk((f32x2){v1[2], v1[3]}); }
                    u32x4 w; w.x = cvt_pk_bf16(a.x, a.y); w.y = cvt_pk_bf16(b.x, b.y); w.z = cvt_pk_bf16(c.x, c.y); w.w = cvt_pk_bf16(d.x, d.y);
                    *(u32x4*)(rowp + bj * HALF) = w; } }
    }
};
}
namespace {
struct WJob { const float* W; const float* g; bf16* dst; int K, N, c0, nc, ldd, r0, koff, pad; };
constexpr int NWJ = 9;
struct WJobs { WJob j[NWJ]; };
__device__ __forceinline__ unsigned pk2(float lo, float hi) { return f2bf(lo) | (f2bf(hi) << 16); }
__device__ __forceinline__ void wT_item(const WJob& J, LAS float* scr, int item, int lane) {
    const int nblk = J.nc / 32, kb = item / nblk, nb = item % nblk, k0 = 64 * kb, n0 = 32 * nb;
    float v[32];
#pragma unroll
    for (int i = 0; i < 32; ++i) v[i] = J.W[(size_t)(k0 + 2 * i + (lane >> 5)) * J.N + J.c0 + n0 + (lane & 31)];
    if (J.g) {
#pragma unroll
        for (int i = 0; i < 32; ++i) v[i] *= J.g[k0 + 2 * i + (lane >> 5)]; }
#pragma unroll
    for (int i = 0; i < 32; ++i) scr[(2 * i + (lane >> 5)) * 33 + (lane & 31)] = v[i];
    asm volatile("s_waitcnt lgkmcnt(0)" ::: "memory");
    const int c = lane & 7;
#pragma unroll
    for (int j = 0; j < 4; ++j) { const int n = (lane >> 3) + 8 * j; const LAS float* s = scr + (8 * c) * 33 + n;
        uint4 o; o.x = pk2(s[0 * 33], s[1 * 33]); o.y = pk2(s[2 * 33], s[3 * 33]); o.z = pk2(s[4 * 33], s[5 * 33]); o.w = pk2(s[6 * 33], s[7 * 33]);
        *(uint4*)(J.dst + (size_t)(J.r0 + n0 + n) * J.ldd + J.koff + k0 + 8 * c) = o; }
    asm volatile("s_waitcnt lgkmcnt(0)" ::: "memory");
}
__device__ __forceinline__ void p0_weights(const WJobs& WJ, int jlo, int jhi, LAS float* scr, int gw, int NGW, int lane) {
    int base = 0;
    for (int q = jlo; q < jhi; ++q) {
        const WJob& J = WJ.j[q]; const int ni = (J.K / 64) * (J.nc / 32);
        int it = gw - (base % NGW); if (it < 0) it += NGW;
        for (; it < ni; it += NGW) wT_item(J, scr, it, lane);
        base += ni;
    }
}
__device__ __forceinline__ float wave_sum(float v) {
#pragma unroll
    for (int o = 1; o < 64; o <<= 1) v += __shfl_xor(v, o);
    return v;
}
__device__ __forceinline__ void rms_row_to_bf16(const float* xrow, const float* g, bf16* orow, int lane) {
    const float4* xr = (const float4*)xrow + lane; const float4* gr = (const float4*)g + lane;
    float4 v[4]; float s = 0.f;
#pragma unroll
    for (int j = 0; j < 4; ++j) { v[j] = xr[64 * j]; s += (v[j].x * v[j].x + v[j].y * v[j].y) + (v[j].z * v[j].z + v[j].w * v[j].w); }
    const float r = rsqrtf(wave_sum(s) * (1.f / 1024.f) + EPS);
    unsigned long long* o8 = (unsigned long long*)orow + lane;
#pragma unroll
    for (int j = 0; j < 4; ++j) { const float4 gg = gr[64 * j];
        o8[64 * j] = (unsigned long long)pk2(v[j].x * r * gg.x, v[j].y * r * gg.y) | ((unsigned long long)pk2(v[j].z * r * gg.z, v[j].w * r * gg.w) << 32); }
}
__device__ __forceinline__ void rms_rows4_to_bf16(const float* xrow, const float* g, bf16* orow, int ldo, int lane) {
    float4 v[4][4]; float s[4];
#pragma unroll
    for (int r = 0; r < 4; ++r)
#pragma unroll
        for (int j = 0; j < 4; ++j) v[r][j] = ((const float4*)(xrow + (size_t)r * 1024) + lane)[64 * j];
#pragma unroll
    for (int r = 0; r < 4; ++r) { s[r] = 0.f;
#pragma unroll
        for (int j = 0; j < 4; ++j) s[r] += (v[r][j].x * v[r][j].x + v[r][j].y * v[r][j].y) + (v[r][j].z * v[r][j].z + v[r][j].w * v[r][j].w); }
#pragma unroll
    for (int r = 0; r < 4; ++r) { const float rr = rsqrtf(wave_sum(s[r]) * (1.f / 1024.f) + EPS);
        unsigned long long* o8 = (unsigned long long*)(orow + (size_t)r * ldo) + lane;
#pragma unroll
        for (int j = 0; j < 4; ++j) { const float4 gg = ((const float4*)g + lane)[64 * j];
            o8[64 * j] = (unsigned long long)pk2(v[r][j].x * rr * gg.x, v[r][j].y * rr * gg.y) | ((unsigned long long)pk2(v[r][j].z * rr * gg.z, v[r][j].w * rr * gg.w) << 32); } }
}
}

namespace {
struct SguArgs {
    const bf16* vT;
    bf16* U;
    const float* vss;
    const float* ws;
    const float* bs;
    const float* gn;
    int TS, ldu;
};
typedef short bf16x8_t __attribute__((ext_vector_type(8)));
typedef float f32x4_t __attribute__((ext_vector_type(4)));
__device__ __forceinline__ void sgu_item(LAS unsigned char* lds, const SguArgs& A, int item, int tid) {
    const int g = item & 7, ch = item >> 3, tok0 = ch * 128;
    const int wave = tid >> 6, lane = tid & 63, fr = lane & 15, fq = lane >> 4;
#pragma unroll
    for (int j = 0; j < 4; ++j) { const int idx = tid + 512 * j, d = idx >> 4, chunk = idx & 15;
        const pg8::u32x4 v = *(const pg8::u32x4*)(A.vT + (size_t)(g * 128 + d) * A.TS + tok0 + chunk * 8);
        *(LAS pg8::u32x4*)(lds + d * 272 + chunk * 16) = v; }
    bf16x8_t af[4];
    const int p = 16 * wave + fr;
#pragma unroll
    for (int kk = 0; kk < 4; ++kk) { const int q = 32 * kk + 8 * fq;
        const float4 w0 = *(const float4*)(A.ws + ((size_t)g * 128 + p) * 128 + q), w1 = *(const float4*)(A.ws + ((size_t)g * 128 + p) * 128 + q + 4);
        const float4 s0 = *(const float4*)(A.vss + tok0 + q), s1 = *(const float4*)(A.vss + tok0 + q + 4);
        const float r0 = rsqrtf(s0.x * (1.f / 1024.f) + EPS), r1 = rsqrtf(s0.y * (1.f / 1024.f) + EPS), r2 = rsqrtf(s0.z * (1.f / 1024.f) + EPS), r3 = rsqrtf(s0.w * (1.f / 1024.f) + EPS);
        const float r4 = rsqrtf(s1.x * (1.f / 1024.f) + EPS), r5 = rsqrtf(s1.y * (1.f / 1024.f) + EPS), r6 = rsqrtf(s1.z * (1.f / 1024.f) + EPS), r7 = rsqrtf(s1.w * (1.f / 1024.f) + EPS);
        uint4 o; o.x = pk2(w0.x * r0, w0.y * r1); o.y = pk2(w0.z * r2, w0.w * r3); o.z = pk2(w1.x * r4, w1.y * r5); o.w = pk2(w1.z * r6, w1.w * r7);
        af[kk] = __builtin_bit_cast(bf16x8_t, o); }
    const float bsp = A.bs[g * 128 + p];
    bf16* urow = A.U + (size_t)(tok0 + p) * A.ldu + g * 128 + 4 * fq;
    const float* gnp = A.gn + g * 128 + 4 * fq;
    uint2 uq[8];
#pragma unroll
    for (int nt = 0; nt < 8; ++nt) uq[nt] = *(const uint2*)(urow + 16 * nt);
    block_sync();
    f32x4_t acc[8];
#pragma unroll
    for (int nt = 0; nt < 8; ++nt) acc[nt] = (f32x4_t){0.f, 0.f, 0.f, 0.f};
#pragma unroll
    for (int kk = 0; kk < 4; ++kk) {
        bf16x8_t bfr[8];
#pragma unroll
        for (int nt = 0; nt < 8; ++nt) bfr[nt] = *(const LAS bf16x8_t*)(lds + (16 * nt + fr) * 272 + (32 * kk + 8 * fq) * 2);
#pragma unroll
        for (int nt = 0; nt < 8; ++nt) acc[nt] = __builtin_amdgcn_mfma_f32_16x16x32_bf16(bfr[nt], af[kk], acc[nt], 0, 0, 0);
    }
#pragma unroll
    for (int nt = 0; nt < 8; ++nt) {
        const uint2 uu = uq[nt];
        const float4 gv = *(const float4*)(gnp + 16 * nt);
        const float y0 = bf2f(uu.x & 0xffffu) * (gv.x * acc[nt][0] + bsp), y1 = bf2f(uu.x >> 16) * (gv.y * acc[nt][1] + bsp);
        const float y2 = bf2f(uu.y & 0xffffu) * (gv.z * acc[nt][2] + bsp), y3 = bf2f(uu.y >> 16) * (gv.w * acc[nt][3] + bsp);
        uint2 o; o.x = pk2(y0, y1); o.y = pk2(y2, y3);
        *(uint2*)(urow + 16 * nt) = o;
    }
    block_sync();
}
}

namespace pg8 {
__device__ __forceinline__ void bf8_to_f32(const u32x4 q, f32x4& lo, f32x4& hi) {
    lo = (f32x4){__builtin_bit_cast(float, q.x << 16), __builtin_bit_cast(float, q.x & 0xffff0000u), __builtin_bit_cast(float, q.y << 16), __builtin_bit_cast(float, q.y & 0xffff0000u)};
    hi = (f32x4){__builtin_bit_cast(float, q.z << 16), __builtin_bit_cast(float, q.z & 0xffff0000u), __builtin_bit_cast(float, q.w << 16), __builtin_bit_cast(float, q.w & 0xffff0000u)};
}
struct EpiMerge {
    static constexpr bool PERM = true, AFTER_DRAIN = false, MID = true;
    const bf16_t* G; bf16_t* O;
    __device__ __forceinline__ void mid(f32x4 (&acc)[2][2][4][2], const Unit& u, int wr, int wc, int fr, int fq) const {
        unsigned off0 = (unsigned)(u.pm * BM + wr * 64 + fr) * 2048u + (unsigned)(u.pn * BM + wc * 32 + 8 * fq);
        asm volatile("" : "+v"(off0));
#pragma unroll
        for (int ai = 0; ai < 2; ++ai)
#pragma unroll
            for (int m = 0; m < 4; ++m)
#pragma unroll
                for (int bj = 0; bj < 2; ++bj) { const bf16_t* gp = G + (off0 + (unsigned)((ai * HALF + m * 16) * 2048 + bj * HALF));
                    const u32x4 qa = *(const u32x4*)gp, qb = *(const u32x4*)(gp + 1024);
                    f32x4 a0, a1, b0, b1; bf8_to_f32(qa, a0, a1); bf8_to_f32(qb, b0, b1);
#pragma unroll
                    for (int j = 0; j < 4; ++j) { acc[ai][bj][m][0][j] *= a0[j] * __builtin_amdgcn_rcpf(b0[j]); acc[ai][bj][m][1][j] *= a1[j] * __builtin_amdgcn_rcpf(b1[j]); }
                    asm volatile("" ::: "memory"); }
    }
    __device__ __forceinline__ void operator()(const f32x4 (&acc)[2][2][4][2], const Unit& u, int wr, int wc, int fr, int fq) const {
        const int row0 = u.pm * BM + wr * 64 + fr, col0 = u.pn * BM + wc * 32 + 8 * fq;
#pragma unroll
        for (int ai = 0; ai < 2; ++ai)
#pragma unroll
            for (int m = 0; m < 4; ++m) { const size_t r = (size_t)(row0 + ai * HALF + m * 16);
#pragma unroll
                for (int bj = 0; bj < 2; ++bj) { f32x4 b0, b1; bf8_to_f32(*(const u32x4*)(G + r * 2048 + 1024 + col0 + bj * HALF), b0, b1);
                    const f32x4 v0 = acc[ai][bj][m][0] * b0, v1 = acc[ai][bj][m][1] * b1;
                    u32x4 w; w.x = cvt_pk_bf16(v0[0], v0[1]); w.y = cvt_pk_bf16(v0[2], v0[3]); w.z = cvt_pk_bf16(v1[0], v1[1]); w.w = cvt_pk_bf16(v1[2], v1[3]);
                    *(u32x4*)(O + r * 1024 + col0 + bj * HALF) = w; } }
    }
};
}
namespace {
__device__ __forceinline__ void tr64_item(const bf16* yaT, int TS, bf16* out, int ldo, LAS unsigned short* scr, int c0, int t0, int lane) {
#pragma unroll
    for (int i = 0; i < 8; ++i) { const int r = 8 * i + (lane >> 3), ch = lane & 7;
        const pg8::u32x4 q = *(const pg8::u32x4*)(yaT + (size_t)(c0 + r) * TS + t0 + 8 * ch);
        LAS unsigned short* d = scr + (8 * ch) * 72 + r;
        d[0 * 72] = (unsigned short)(q.x & 0xffffu); d[1 * 72] = (unsigned short)(q.x >> 16); d[2 * 72] = (unsigned short)(q.y & 0xffffu); d[3 * 72] = (unsigned short)(q.y >> 16);
        d[4 * 72] = (unsigned short)(q.z & 0xffffu); d[5 * 72] = (unsigned short)(q.z >> 16); d[6 * 72] = (unsigned short)(q.w & 0xffffu); d[7 * 72] = (unsigned short)(q.w >> 16); }
    asm volatile("s_waitcnt lgkmcnt(0)" ::: "memory");
#pragma unroll
    for (int i = 0; i < 8; ++i) { const int tk = 8 * i + (lane >> 3), ch = lane & 7;
        const pg8::u32x4 q = *(const LAS pg8::u32x4*)(scr + tk * 72 + 8 * ch);
        *(pg8::u32x4*)(out + (size_t)(t0 + tk) * ldo + c0 + 8 * ch) = q; }
    asm volatile("s_waitcnt lgkmcnt(0)" ::: "memory");
}
__device__ __forceinline__ void transpose_ya(const bf16* yaT, int TS, bf16* out, int ldo, LAS unsigned short* scr, int gw, int NGW, int lane) {
    const int ntt = TS / 64, nit = 16 * ntt;
    for (int it = gw; it < nit; it += NGW) tr64_item(yaT, TS, out, ldo, scr, 64 * (it / ntt), 64 * (it % ntt), lane);
}
}

namespace pg8 {
template <bool FIRST> struct EpiResid {
    static constexpr bool PERM = false, AFTER_DRAIN = false, MID = false;
    const float* X; const bf16_t* XB; float* X1; bf16_t* X1b; float* xss;
    __device__ __forceinline__ void operator()(const f32x4 (&acc)[2][2][4][2], const Unit& u, int wr, int wc, int fr, int fq) const {
        const int row0 = u.pm * BM + wr * 64 + fr, col0 = u.pn * BM + wc * 32 + 4 * fq;
        typedef unsigned u32x2v __attribute__((ext_vector_type(2)));
#pragma unroll
        for (int ai = 0; ai < 2; ++ai)
#pragma unroll
            for (int m = 0; m < 4; ++m) { const size_t r = (size_t)(row0 + ai * HALF + m * 16); float s = 0.f;
#pragma unroll
                for (int bj = 0; bj < 2; ++bj)
#pragma unroll
                    for (int n = 0; n < 2; ++n) { const size_t o = r * 1024 + col0 + bj * HALF + n * 16;
                        f32x4 v;
                        if (FIRST) v = acc[ai][bj][m][n] + *(const f32x4*)(X + o);
                        else { const u32x2v q = *(const u32x2v*)(XB + o);
                               v = acc[ai][bj][m][n] + (f32x4){__builtin_bit_cast(float, q.x << 16), __builtin_bit_cast(float, q.x & 0xffff0000u), __builtin_bit_cast(float, q.y << 16), __builtin_bit_cast(float, q.y & 0xffff0000u)}; }
                        { u32x2v w; w.x = cvt_pk_bf16(v[0], v[1]); w.y = cvt_pk_bf16(v[2], v[3]); *(u32x2v*)(X1b + o) = w; }
                        s += (v[0] * v[0] + v[1] * v[1]) + (v[2] * v[2] + v[3] * v[3]); }
                s += __shfl_xor(s, 16); s += __shfl_xor(s, 32);
                if (fq == 0) atomicAdd(xss + r, s);
                asm volatile("" ::: "memory"); }
    }
};
struct EpiUp {
    static constexpr bool PERM = true, AFTER_DRAIN = false, MID = false;
    bf16_t* AP; bf16_t* GP; const float* xss;
    __device__ __forceinline__ void operator()(const f32x4 (&acc)[2][2][4][2], const Unit& u, int wr, int wc, int fr, int fq) const {
        const int row0 = u.pm * BM + wr * 64 + fr; int colt = u.pn * BM; const bool isg = colt >= 2816;
        bf16_t* base = isg ? GP : AP; if (isg) colt -= 2816;
        const int col0 = colt + wc * 32 + 8 * fq;
#pragma unroll
        for (int ai = 0; ai < 2; ++ai)
#pragma unroll
            for (int m = 0; m < 4; ++m) { const size_t r = (size_t)(row0 + ai * HALF + m * 16); const float rs = rsqrtf(xss[r] * (1.0f / 1024.0f) + 1e-6f);
#pragma unroll
                for (int bj = 0; bj < 2; ++bj) { const f32x4 v0 = acc[ai][bj][m][0] * rs, v1 = acc[ai][bj][m][1] * rs;
                    u32x4 w; w.x = cvt_pk_bf16(v0[0], v0[1]); w.y = cvt_pk_bf16(v0[2], v0[3]); w.z = cvt_pk_bf16(v1[0], v1[1]); w.w = cvt_pk_bf16(v1[2], v1[3]);
                    *(u32x4*)(base + r * 2816 + col0 + bj * HALF) = w; } }
    }
};
}
namespace {
__device__ __forceinline__ void act_pass(const bf16* AP, bf16* GP, const float* cw, const float* cb, int TS, int gid, int gstride) {
    const int nitems = (TS / 16) * 352;
    const pg8::u32x4 zq = {0u, 0u, 0u, 0u};
    for (int it = gid; it < nitems; it += gstride) {
        const int run = it / 352, ch = it % 352, t0 = run * 16, c0 = ch * 8;
        const pg8::f32x4 w0l = *(const pg8::f32x4*)(cw + c0), w0h = *(const pg8::f32x4*)(cw + c0 + 4);
        const pg8::f32x4 w1l = *(const pg8::f32x4*)(cw + 2816 + c0), w1h = *(const pg8::f32x4*)(cw + 2816 + c0 + 4);
        const pg8::f32x4 w2l = *(const pg8::f32x4*)(cw + 5632 + c0), w2h = *(const pg8::f32x4*)(cw + 5632 + c0 + 4);
        const pg8::f32x4 bl = *(const pg8::f32x4*)(cb + c0), bh = *(const pg8::f32x4*)(cb + c0 + 4);
        const bf16* ap = AP + (size_t)t0 * 2816 + c0; bf16* gp = GP + (size_t)t0 * 2816 + c0;
        pg8::u32x4 qa[6];
        qa[0] = (t0 & 4095) != 0 ? *(const pg8::u32x4*)(ap - 2816) : zq;
        qa[1] = *(const pg8::u32x4*)ap;
#pragma unroll 1
        for (int i = 0; i < 16; i += 4) {
            pg8::u32x4 qg[4];
#pragma unroll
            for (int k = 0; k < 4; ++k) { const int t = t0 + i + k;
                qa[2 + k] = (t & 4095) != 4095 ? *(const pg8::u32x4*)(ap + (size_t)(i + k + 1) * 2816) : zq;
                qg[k] = *(const pg8::u32x4*)(gp + (size_t)(i + k) * 2816); }
#pragma unroll
            for (int k = 0; k < 4; ++k) {
                pg8::f32x4 pl, ph, cl, chh, nl, nh, gl, gh;
                pg8::bf8_to_f32(qa[k], pl, ph); pg8::bf8_to_f32(qa[k + 1], cl, chh); pg8::bf8_to_f32(qa[k + 2], nl, nh); pg8::bf8_to_f32(qg[k], gl, gh);
                const pg8::f32x4 sl = bl + w0l * pl + w1l * cl + w2l * nl, sh = bh + w0h * ph + w1h * chh + w2h * nh;
                pg8::f32x4 ol, oh;
#pragma unroll
                for (int j = 0; j < 4; ++j) { ol[j] = sl[j] * __builtin_amdgcn_rcpf(1.0f + __builtin_amdgcn_exp2f(sl[j] * -1.4426950408889634f)) * gl[j];
                                              oh[j] = sh[j] * __builtin_amdgcn_rcpf(1.0f + __builtin_amdgcn_exp2f(sh[j] * -1.4426950408889634f)) * gh[j]; }
                pg8::u32x4 w; w.x = pg8::cvt_pk_bf16(ol[0], ol[1]); w.y = pg8::cvt_pk_bf16(ol[2], ol[3]); w.z = pg8::cvt_pk_bf16(oh[0], oh[1]); w.w = pg8::cvt_pk_bf16(oh[2], oh[3]);
                *(pg8::u32x4*)(gp + (size_t)(i + k) * 2816) = w;
            }
            qa[0] = qa[4]; qa[1] = qa[5];
        }
    }
}
__device__ __forceinline__ void final_norm(const bf16* X2, const float* ss, const float* g, float* out, int TS, int gw, int NGW, int lane) {
    pg8::f32x4 g0[2], g1[2];
#pragma unroll
    for (int j = 0; j < 2; ++j) { g0[j] = *((const pg8::f32x4*)g + 2 * lane + 128 * j); g1[j] = *((const pg8::f32x4*)g + 2 * lane + 128 * j + 1); }
    for (int t = 2 * gw; t < TS; t += 2 * NGW) {
        pg8::u32x4 q[2][2]; float r[2];
#pragma unroll
        for (int k = 0; k < 2; ++k) { r[k] = rsqrtf(ss[t + k] * (1.0f / 1024.0f) + EPS);
#pragma unroll
            for (int j = 0; j < 2; ++j) q[k][j] = *((const pg8::u32x4*)(X2 + (size_t)(t + k) * 1024) + lane + 64 * j); }
#pragma unroll
        for (int k = 0; k < 2; ++k)
#pragma unroll
            for (int j = 0; j < 2; ++j) { pg8::f32x4 lo, hi; pg8::bf8_to_f32(q[k][j], lo, hi);
                pg8::f32x4* o = (pg8::f32x4*)(out + (size_t)(t + k) * 1024) + 2 * lane + 128 * j;
                o[0] = lo * g0[j] * r[k]; o[1] = hi * g1[j] * r[k]; }
    }
}
}

namespace {
constexpr int MLPW_W2 = 33 * 64, MLPW_W3 = MLPW_W2 + 4096, MLPW_B = MLPW_W3 + 4096, MLPW_N = MLPW_B + 256;
__device__ __forceinline__ float filt_z(int l, int j) {
    if (j == 0) return (float)((double)l / (double)(L - 1));
    const int i = (j - 1) & 15;
    const double band = 1e-4 + (double)i * ((15.0 - 1e-4) / 15.0);
    double rev = (double)l * band / (double)L;
    rev -= floor(rev);
    const float ang = (float)(rev * 6.283185307179586);
    return (j <= 16) ? cosf(ang) : -sinf(ang);
}
__device__ __forceinline__ void filter_mlp_rows2(const LAS float* wl, float* h3out, LAS float* scr, int l0, int l1, int j) {
    LAS float* za = scr; LAS float* zb = scr + 64;
    if (j < FEMB) { za[j] = filt_z(l0, j); zb[j] = filt_z(l1, j); }
    asm volatile("s_waitcnt lgkmcnt(0)" ::: "memory");
    const float a = wl[MLPW_B + 192 + j];
    float s0 = wl[MLPW_B + j], s1 = s0;
#pragma unroll 11
    for (int i = 0; i < FEMB; ++i) { const float w = wl[i * 64 + j]; s0 += za[i] * w; s1 += zb[i] * w; }
    asm volatile("s_waitcnt lgkmcnt(0)" ::: "memory");
    za[j] = sinf(a * s0); zb[j] = sinf(a * s1);
    asm volatile("s_waitcnt lgkmcnt(0)" ::: "memory");
    s0 = wl[MLPW_B + 64 + j]; s1 = s0;
#pragma unroll 8
    for (int i = 0; i < FHID; ++i) { const float w = wl[MLPW_W2 + i * 64 + j]; s0 += za[i] * w; s1 += zb[i] * w; }
    asm volatile("s_waitcnt lgkmcnt(0)" ::: "memory");
    za[j] = sinf(a * s0); zb[j] = sinf(a * s1);
    asm volatile("s_waitcnt lgkmcnt(0)" ::: "memory");
    s0 = wl[MLPW_B + 128 + j]; s1 = s0;
#pragma unroll 8
    for (int i = 0; i < FHID; ++i) { const float w = wl[MLPW_W3 + i * 64 + j]; s0 += za[i] * w; s1 += zb[i] * w; }
    h3out[l0 * FHID + j] = sinf(a * s0); h3out[l1 * FHID + j] = sinf(a * s1);
    asm volatile("s_waitcnt lgkmcnt(0)" ::: "memory");
}
typedef float f32x16_t __attribute__((ext_vector_type(16)));
__device__ __forceinline__ void stage_h3_rows32(const float* h3, int row0, LAS float* scr, int lane) {
#pragma unroll
    for (int i = 0; i < 8; ++i) { const int e = 4 * (lane + 64 * i), r = e >> 6, jj = e & 63;
        if (row0 + r < 4096) { const pg8::f32x4 v = *(const pg8::f32x4*)(h3 + (size_t)(row0 + r) * 64 + jj);
            LAS float* d = scr + r * 65 + jj; d[0] = v[0]; d[1] = v[1]; d[2] = v[2]; d[3] = v[3]; } }
}
__device__ __forceinline__ void filter_tables(const float* h3, const float* w4, const float* decay, float* fsum, float* fdif, LAS float* scr, int gw, int NGW, int lane) {
    const int r = lane & 31, h = lane >> 5;
    for (int it = gw; it < 2048; it += NGW) {
        const int c0 = (it & 31) * 32, nbase = (it >> 5) * 64;
        float af[32], ab[32];
#pragma unroll
        for (int kk = 0; kk < 32; ++kk) { af[kk] = w4[(2 * kk + h) * 2048 + c0 + r]; ab[kk] = w4[(2 * kk + h) * 2048 + 1024 + c0 + r]; }
        float dcf[16], dcb[16];
#pragma unroll
        for (int q = 0; q < 16; ++q) { const int c = c0 + (q & 3) + 8 * (q >> 2) + 4 * h; dcf[q] = fabsf(decay[c]); dcb[q] = fabsf(decay[1024 + c]); }
#pragma unroll 1
        for (int half = 0; half < 2; ++half) {
            const int n0 = nbase + 32 * half, n = n0 + r, nb = n ? 4096 - n : 0;
            stage_h3_rows32(h3, n0, scr, lane);
            stage_h3_rows32(h3, 4096 - n0 - 31, scr + 32 * 65, lane);
            asm volatile("s_waitcnt lgkmcnt(0)" ::: "memory");
            f32x16_t accF, accB;
#pragma unroll
            for (int q = 0; q < 16; ++q) { accF[q] = 0.f; accB[q] = 0.f; }
#pragma unroll
            for (int kk = 0; kk < 32; ++kk) {
                const float bF = scr[r * 65 + 2 * kk + h], bB = scr[32 * 65 + (31 - r) * 65 + 2 * kk + h];
                accF = __builtin_amdgcn_mfma_f32_32x32x2f32(af[kk], bF, accF, 0, 0, 0);
                accB = __builtin_amdgcn_mfma_f32_32x32x2f32(ab[kk], bB, accB, 0, 0, 0);
            }
            const float tf = (float)n * (1.0f / 4095.0f), tb = (float)nb * (1.0f / 4095.0f);
#pragma unroll
            for (int q = 0; q < 16; ++q) { const int c = c0 + (q & 3) + 8 * (q >> 2) + 4 * h;
                const float hf = accF[q] * expf(-tf * dcf[q]);
                const float hb = n ? accB[q] * expf(-tb * dcb[q]) : 0.f;
                fsum[(size_t)c * 4096 + n] = hf + hb;
                fdif[(size_t)c * 4096 + n] = hf - hb; }
            asm volatile("s_waitcnt lgkmcnt(0)" ::: "memory");
        }
    }
}
#define RLX_AGENT __ATOMIC_RELAXED, __HIP_MEMORY_SCOPE_AGENT
#define XB_TMO      128
#define XB_XCNT(j)  (256  + 64 * (j))
#define XB_XSUB(j)  (1280 + 64 * (j))
#define XB_XGEN(j)  (2304 + 64 * (j))
#define XB_TOP      3328
#define XB_TOPGEN   3392
#define XCD_BAR_WORDS 3456
#define XB_SPIN_CAP (1u << 18)

__device__ __forceinline__ unsigned xb_ld(unsigned* p)              { return __hip_atomic_load(p, __ATOMIC_RELAXED, __HIP_MEMORY_SCOPE_AGENT); }
__device__ __forceinline__ unsigned xb_add(unsigned* p, unsigned v) { return __hip_atomic_fetch_add(p, v, __ATOMIC_RELAXED, __HIP_MEMORY_SCOPE_AGENT); }
__device__ __forceinline__ unsigned xb_xcc_id() { return (unsigned)__builtin_amdgcn_s_getreg((3 << 11) | 20) & 0xFu; }
#define XB_SPIN(cond, bar) do { unsigned _sp = 0; while (cond) { __builtin_amdgcn_s_sleep(1); \
    if ((++_sp & 255u) == 0u) { if (xb_ld(&(bar)[XB_TMO])) break; if (_sp > XB_SPIN_CAP) { atomicAdd(&(bar)[XB_TMO], 1u); break; } } } } while (0)

struct XcdBarrier {
    unsigned* bar; unsigned x;
    volatile LAS unsigned* st;
};

__device__ __forceinline__ XcdBarrier xcd_barrier_post(unsigned* bar, volatile LAS unsigned* st) {
    XcdBarrier b; b.bar = bar; b.x = xb_xcc_id(); b.st = st;
    if (threadIdx.x == 0) (void)xb_add(&bar[XB_XCNT(b.x)], 1u);
    return b;
}
__device__ __forceinline__ void xcd_barrier_complete(unsigned* bar, unsigned x, unsigned& nloc, unsigned& nx) {
    const unsigned G = gridDim.x * gridDim.y * gridDim.z;
    unsigned sum, cnt, mine, sp = 0u;
    for (;;) {
        sum = 0u; cnt = 0u; mine = 0u;
#pragma unroll
        for (unsigned j = 0; j < 16; ++j) { const unsigned c = xb_ld(&bar[XB_XCNT(j)]); sum += c; cnt += (c > 0u) ? 1u : 0u; mine = (j == x) ? c : mine; }
        if (sum == G) break;
        __builtin_amdgcn_s_sleep(1);
        if ((++sp & 255u) == 0u) { if (xb_ld(&bar[XB_TMO])) break; if (sp > XB_SPIN_CAP) { atomicAdd(&bar[XB_TMO], 1u); break; } }
    }
    nloc = mine > 0u ? mine : 1u; nx = cnt > 0u ? cnt : 1u;
}

__device__ __forceinline__ void xcd_barrier(const XcdBarrier& b) {
    asm volatile("s_waitcnt vmcnt(0)" ::: "memory");
    block_sync();
    if (threadIdx.x == 0) {
        unsigned* bar = b.bar;
        __builtin_amdgcn_s_waitcnt(0);
        unsigned nloc = b.st[0], nx = b.st[1];
        if (nloc == 0u) { xcd_barrier_complete(bar, b.x, nloc, nx); b.st[0] = nloc; b.st[1] = nx; }
        const unsigned old = xb_add(&bar[XB_XSUB(b.x)], 1u);
        const unsigned gen = old / nloc;
        if (old + 1u == (gen + 1u) * nloc) {
            __builtin_amdgcn_fence(__ATOMIC_RELEASE, "agent");
            asm volatile("s_waitcnt vmcnt(0)" ::: "memory");
            const unsigned og = xb_add(&bar[XB_TOP], 1u);
            const unsigned tg = og / nx;
            if (og + 1u == (tg + 1u) * nx) xb_add(&bar[XB_TOPGEN], 1u);
            else XB_SPIN(xb_ld(&bar[XB_TOPGEN]) == tg, bar);
            __builtin_amdgcn_fence(__ATOMIC_ACQUIRE, "agent");
            xb_add(&bar[XB_XGEN(b.x)], 1u);
            asm volatile("s_waitcnt vmcnt(0)" ::: "memory");
        } else {
            XB_SPIN(xb_ld(&bar[XB_XGEN(b.x)]) == gen, bar);
            __builtin_amdgcn_fence(__ATOMIC_ACQUIRE, "agent");
            asm volatile("s_waitcnt vmcnt(0)" ::: "memory");
        }
    }
    block_sync();
}

constexpr size_t MiB = 1u << 20;
constexpr int M = NB * L;
constexpr size_t WS_VSS = 0, WS_XSS = 64 * 1024, WS_X2SS = 128 * 1024, WS_TTAB = 192 * 1024, WS_BAR = 256 * 1024, WS_H3 = 1 * MiB;
constexpr size_t WS_WTA = 2 * MiB, WS_WTB = 10 * MiB, WS_PAB = 16 * MiB, WS_WO = 20 * MiB;
constexpr size_t WS_FSUM = 24 * MiB, WS_WUP = 24 * MiB, WS_WDN = 35 * MiB;
constexpr size_t WS_HYT = 41 * MiB;
constexpr size_t WS_X1B = 41 * MiB, WS_MRG = 105 * MiB;
constexpr size_t WS_YAB = 169 * MiB;
constexpr size_t WS_FDIF = 233 * MiB;
constexpr size_t WS_AP = 73 * MiB, WS_GP = 161 * MiB;
static_assert(WS_GP + (size_t)M * FH * 2 <= 256 * MiB && WS_AP + (size_t)M * FH * 2 <= WS_GP && WS_FDIF + 16 * MiB <= 256 * MiB && WS_WDN + (size_t)D * FH * 2 <= WS_HYT, "d_ws map");
constexpr int LDS_BYTES = 155648;
static_assert(HY_LDS_END + 256 <= LDS_BYTES, "LDS map");
constexpr int NPH = 10;

struct MegaArgs { const float* in[27]; float* out; unsigned char* ws; int ph_lo, ph_hi; WJobs wj; };

__global__ void __launch_bounds__(512, 2) __attribute__((target("no-packed-fp32-ops"))) mega_fwd(MegaArgs a) {
    extern __shared__ __attribute__((aligned(16))) unsigned char lds_raw[];
    LAS unsigned char* lds = (LAS unsigned char*)lds_raw;
    cg::grid_group grid = cg::this_grid();
    const int wave = __builtin_amdgcn_readfirstlane((int)threadIdx.x >> 6);
    const int G = gridDim.x, bid = blockIdx.x, gw = bid * 8 + wave, NGW = G * 8;
#define FRESH_TID int lane; asm volatile("v_mbcnt_lo_u32_b32 %0, -1, 0\n\tv_mbcnt_hi_u32_b32 %0, -1, %0" : "=v"(lane)); const int tid = wave * 64 + lane; (void)tid
    unsigned char* ws = a.ws;
    const float* x = a.in[0];
    float* vss = (float*)(ws + WS_VSS); float* xss = (float*)(ws + WS_XSS); float* x2ss = (float*)(ws + WS_X2SS);
    cfv* Ttab = (cfv*)(ws + WS_TTAB); float* h3 = (float*)(ws + WS_H3);
    bf16* WtA = (bf16*)(ws + WS_WTA); bf16* WtB = (bf16*)(ws + WS_WTB); bf16* PabT = (bf16*)(ws + WS_PAB); bf16* WoT = (bf16*)(ws + WS_WO);
    bf16* WupT = (bf16*)(ws + WS_WUP); bf16* WdnT = (bf16*)(ws + WS_WDN);
    float* fsum = (float*)(ws + WS_FSUM); float* fdif = (float*)(ws + WS_FDIF);
    bf16* hyvT = (bf16*)(ws + WS_HYT); bf16* yaT = hyvT + (size_t)1024 * M; bf16* vT = hyvT + (size_t)3072 * M;
    bf16* YAB = (bf16*)(ws + WS_YAB); bf16* h1 = YAB; bf16* Ub = YAB + 1024;
    bf16* Gb = (bf16*)a.out;
    bf16* mrg = (bf16*)(ws + WS_MRG); bf16* X1b = (bf16*)(ws + WS_X1B); float* X1 = a.out;
    bf16* APb = (bf16*)(ws + WS_AP); bf16* GPb = (bf16*)(ws + WS_GP);
    const int lo = a.ph_lo, hi = a.ph_hi;
#define IN(k) (lo <= (k) && (k) < hi)
    for (int u = (int)threadIdx.x; u < 16; u += 512) ((LAS unsigned*)(lds + LDS_BYTES - 256))[u] = 0u;
    block_sync();
    XcdBarrier xbar = xcd_barrier_post((unsigned*)(ws + WS_BAR), (volatile LAS unsigned*)(lds + LDS_BYTES - 256));
#ifdef MK_PROBE
#define STAMP(i) do { if (threadIdx.x == 0) ((volatile LAS unsigned long long*)(lds + LDS_BYTES - 128))[i] = __builtin_amdgcn_s_memrealtime(); } while (0)
#else
#define STAMP(i) do { } while (0)
#endif
    STAMP(0);
#define SEAM(k) do { if (IN(k) && IN((k) + 1)) xcd_barrier(xbar); STAMP((k) + 1); } while (0)
    if (a.ph_hi > NPH) grid.sync();

    if (IN(0)) { FRESH_TID;
        p0_weights(a.wj, 0, 7, (LAS float*)lds + wave * 4096, gw, NGW, lane);
        for (int m = 4 * gw; m < M; m += 4 * NGW) rms_rows4_to_bf16(x + (size_t)m * 1024, a.in[1], h1 + (size_t)m * 2048, 2048, lane);
        for (int i = bid * 512 + tid; i < 3 * M; i += G * 512) vss[i] = 0.f;
        block_sync();
        { LAS float* wl = (LAS float*)lds;
          for (int i = tid; i < MLPW_N; i += 512) { float v;
              if (i < MLPW_W2) v = a.in[5][i]; else if (i < MLPW_W3) v = a.in[7][i - MLPW_W2]; else if (i < MLPW_B) v = a.in[9][i - MLPW_W3];
              else { const int q = i - MLPW_B; v = q < 64 ? a.in[6][q] : q < 128 ? a.in[8][q - 64] : q < 192 ? a.in[10][q - 128] : a.in[11][q - 192]; }
              wl[i] = v; }
          block_sync();
          for (int l = 2 * gw; l < L; l += 2 * NGW) filter_mlp_rows2(wl, h3, (LAS float*)(lds + 65536) + wave * 128, l, l + 1, lane); }
        for (int m = bid * 512 + tid; m < 4096; m += G * 512) { const float ang = (float)m / 4096.0f; Ttab[m] = (cfv){cospif(ang), -sinpif(ang)}; }
    }
    SEAM(0);
    if (IN(1)) { FRESH_TID;
        { pg8::Gemm g{WtA, h1, 4096, M, 1024, 1024, 2048}; pg8::StaticOrder S; S.init(4096, M, G, bid);
          pg8::EpiHyT E{hyvT, M, vss};
          pg8::gemm_phase<pg8::EpiHyT, pg8::StaticOrder, true, true>(lds, g, S, E, tid); }
        STAMP(11);
        { pg8::Gemm g{h1, WtB, M, 3072, 1024, 2048, 1024}; pg8::StaticOrder S; S.init(M, 3072, G, bid);
          pg8::EpiUG E{Ub, Gb, 2048};
          pg8::gemm_phase<pg8::EpiUG, pg8::StaticOrder, true, true>(lds, g, S, E, tid); }
        STAMP(12);
        filter_tables(h3, a.in[12], a.in[13], fsum, fdif, (LAS float*)(lds + wave * 17408), gw, NGW, lane);
    }
    SEAM(1);
    if (IN(2)) { FRESH_TID;
        HyArgs H; H.hyT = hyvT; H.yaT = yaT; H.fsum = fsum; H.fdif = fdif; H.cw = a.in[3]; H.cb = a.in[4]; H.skip = a.in[14]; H.T = Ttab;
        H.TS = M; H.npairs = 2; H.off00 = 0; H.off01 = L; H.off10 = 2 * L; H.off11 = 3 * L;
        hyena_phase(lds, H, bid, G, tid, wave);
        block_sync();
        STAMP(13);
        SguArgs Sg; Sg.vT = vT; Sg.U = Ub; Sg.vss = vss; Sg.ws = a.in[16]; Sg.bs = a.in[17]; Sg.gn = a.in[15]; Sg.TS = M; Sg.ldu = 2048;
        for (int it = bid; it < (M / 128) * 8; it += G) sgu_item(lds, Sg, it, tid);
    }
    SEAM(2);
    if (IN(3)) { FRESH_TID;
        transpose_ya(yaT, M, YAB, 2048, (LAS unsigned short*)lds + wave * 8192, gw, NGW, lane);
        p0_weights(a.wj, 7, 9, (LAS float*)lds + wave * 4096, gw, NGW, lane);
    }
    SEAM(3);
    if (IN(4)) { FRESH_TID;
        pg8::Gemm g{YAB, PabT, M, 1024, 2048, 2048, 2048}; pg8::StaticOrder S; S.init(M, 1024, G, bid);
        pg8::EpiMerge E{Gb, mrg};
        pg8::gemm_phase<pg8::EpiMerge, pg8::StaticOrder, true, true>(lds, g, S, E, tid);
    }
    SEAM(4);
    if (IN(5)) { FRESH_TID;
        pg8::Gemm g{mrg, WoT, M, 1024, 1024, 1024, 1024}; pg8::StaticOrder S; S.init(M, 1024, G, bid);
        pg8::EpiResid<true> E{x, nullptr, nullptr, X1b, xss};
        pg8::gemm_phase<pg8::EpiResid<true>, pg8::StaticOrder, true, true>(lds, g, S, E, tid);
    }
    SEAM(5);
    if (IN(6)) { FRESH_TID;
        pg8::Gemm g{X1b, WupT, M, 2 * FH, 1024, 1024, 1024}; pg8::StaticOrder S; S.init(M, 2 * FH, G, bid);
        pg8::EpiUp E{APb, GPb, xss};
        pg8::gemm_phase<pg8::EpiUp, pg8::StaticOrder, true, true>(lds, g, S, E, tid);
    }
    SEAM(6);
    if (IN(7)) { FRESH_TID; act_pass(APb, GPb, a.in[23], a.in[24], M, bid * 512 + tid, G * 512); }
    SEAM(7);
    if (IN(8)) { FRESH_TID;
        pg8::Gemm g{GPb, WdnT, M, 1024, FH, FH, FH}; pg8::StaticOrder S; S.init(M, 1024, G, bid);
        pg8::EpiResid<false> E{nullptr, X1b, nullptr, X1b, x2ss};
        pg8::gemm_phase<pg8::EpiResid<false>, pg8::StaticOrder, true, true>(lds, g, S, E, tid);
    }
    SEAM(8);
    if (IN(9)) { FRESH_TID; final_norm(X1b, x2ss, a.in[26], a.out, M, gw, NGW, lane); }
    STAMP(10);
#ifdef MK_PROBE
#ifndef MK_PROBE_A
#define MK_PROBE_A MK_PROBE
#define MK_PROBE_B (MK_PROBE + 1)
#endif
    if (threadIdx.x == 0) { volatile LAS unsigned long long* ts = (volatile LAS unsigned long long*)(lds + LDS_BYTES - 128);
        const unsigned long long dt = 2ull * (ts[MK_PROBE_B] - ts[MK_PROBE_A]), t0 = __builtin_amdgcn_s_memrealtime();
        while (__builtin_amdgcn_s_memrealtime() - t0 < dt) __builtin_amdgcn_s_sleep(8); }
    block_sync();
#endif
#undef IN
#undef SEAM
}
}

#ifndef MK_CUTS
#define MK_CUTS 0
#endif
extern "C" void kernel_launch(void* const* d_in, const int* in_sizes, int n_in, void* d_out, int out_size, void* d_ws, size_t ws_size, hipStream_t stream) {
    static int grid = 0;
    if (grid == 0) {
        int dev = 0, cus = 0, per_cu = 0;
        hipGetDevice(&dev);
        hipDeviceGetAttribute(&cus, hipDeviceAttributeMultiprocessorCount, dev);
        hipFuncSetAttribute((const void*)mega_fwd, hipFuncAttributeMaxDynamicSharedMemorySize, LDS_BYTES);
        hipOccupancyMaxActiveBlocksPerMultiprocessor(&per_cu, (const void*)mega_fwd, 512, LDS_BYTES);
        if (per_cu < 1) { fprintf(stderr, "kernel_launch: occupancy query says %d blocks per CU\n", per_cu); per_cu = 1; }
        grid = cus * 1;
        (void)hipGetLastError();
    }
    hipMemsetAsync((char*)d_ws + WS_BAR, 0, XCD_BAR_WORDS * 4, stream);
    MegaArgs a{};
    for (int i = 0; i < 27; ++i) a.in[i] = (const float*)d_in[i];
    a.out = (float*)d_out; a.ws = (unsigned char*)d_ws;
    { unsigned char* ws = (unsigned char*)d_ws;
      bf16* WtA = (bf16*)(ws + WS_WTA); bf16* WtB = (bf16*)(ws + WS_WTB); bf16* PabT = (bf16*)(ws + WS_PAB); bf16* WoT = (bf16*)(ws + WS_WO); bf16* WupT = (bf16*)(ws + WS_WUP); bf16* WdnT = (bf16*)(ws + WS_WDN);
    a.wj.j[0] = WJob{(const float*)d_in[2], nullptr, WtA, 1024, INW, 0, 3072, 1024, 0, 0, 0};
    a.wj.j[1] = WJob{(const float*)d_in[2], nullptr, WtA, 1024, INW, 4096, 1024, 1024, 3072, 0, 0};
    a.wj.j[2] = WJob{(const float*)d_in[2], nullptr, WtB, 1024, INW, 3072, 1024, 1024, 0, 0, 0};
    a.wj.j[3] = WJob{(const float*)d_in[2], nullptr, WtB, 1024, INW, 5120, 2048, 1024, 1024, 0, 0};
    a.wj.j[4] = WJob{(const float*)d_in[18], nullptr, PabT, 1024, 1024, 0, 1024, 2048, 0, 0, 0};
    a.wj.j[5] = WJob{(const float*)d_in[19], nullptr, PabT, 1024, 1024, 0, 1024, 2048, 0, 1024, 0};
    a.wj.j[6] = WJob{(const float*)d_in[20], nullptr, WoT, 1024, 1024, 0, 1024, 1024, 0, 0, 0};
    a.wj.j[7] = WJob{(const float*)d_in[22], (const float*)d_in[21], WupT, 1024, 2 * FH, 0, 2 * FH, 1024, 0, 0, 0};
    a.wj.j[8] = WJob{(const float*)d_in[25], nullptr, WdnT, FH, 1024, 0, 1024, FH, 0, 0, 0};

    }
#if MK_CUTS
    for (int p = 0; p < NPH; ++p) { a.ph_lo = p; a.ph_hi = p + 1; hipLaunchKernelGGL(mega_fwd, dim3(grid), dim3(512), LDS_BYTES, stream, a); }
#else
    a.ph_lo = 0; a.ph_hi = NPH;
    void* args[] = {&a};
    hipError_t e = hipLaunchCooperativeKernel((const void*)mega_fwd, dim3(grid), dim3(512), args, LDS_BYTES, stream);
    if (e != hipSuccess) fprintf(stderr, "cooperative launch failed: %s (grid %d)\n", hipGetErrorString(e), grid);
#endif
}
```

```cpp
#include <hip/hip_runtime.h>
#include <hip/hip_cooperative_groups.h>
#include <math.h>
#include <stdint.h>
#include <cstdio>
namespace cg = cooperative_groups;
namespace pg8 {
#define PG8_LAS __attribute__((address_space(3)))
typedef unsigned short bf16_t;
typedef short bf16x8 __attribute__((ext_vector_type(8)));
typedef float f32x4 __attribute__((ext_vector_type(4)));
typedef unsigned u32x4 __attribute__((ext_vector_type(4)));
constexpr int BM = 256, BK = 64, HALF = 128, HTB = HALF * BK * 2  , STAGE_BYTES = 8 * HTB, NXCD = 8, WGM = 8;

__host__ __device__ __forceinline__ int lds_byte(int r, int c) { const int st = (r >> 4) * 2 + (c >> 5), rr = r & 15, cc = c & 31, ob = rr * 64 + cc * 2; return st * 1024 + (ob ^ (((ob >> 9) & 1) << 5)); }
__host__ __device__ __forceinline__ void stage_rc(int b, int& R, int& C) { const int st = b / 1024, sb = b % 1024, swz = sb ^ (((sb >> 9) & 1) << 5); R = (st >> 1) * 16 + swz / 64; C = (st & 1) * 32 + (swz % 64) / 2; }
__host__ __device__ __forceinline__ int perm32(int rho) { const int n = rho >> 4, i = rho & 15; return 8 * (i >> 2) + 4 * n + (i & 3); }

struct Unit { int pm, pn; };
__host__ __device__ __forceinline__ int ovl_row(int pm) { const int seq = pm / 17, i = pm % 17; int s = 254 * i - 1; s = s < 0 ? 0 : (s > 3840 ? 3840 : s); return seq * 4096 + s; }
struct Gemm { const bf16_t* A; const bf16_t* Bt; int M, N, K, lda, ldb; };

struct StaticOrder {
    int nM, nN, nwg, G, c;
    __host__ __device__ __forceinline__ void init(int M, int N, int G_, int c_) { nM = M / BM; nN = N / BM; nwg = nM * nN; G = G_; c = c_; }
    __host__ __device__ __forceinline__ bool next(int i, Unit& u) const {
        const long L = (long)i * G + c; if (L >= nwg) return false;
        int wgid = (int)L; { const int q = nwg / NXCD, r = nwg % NXCD, xcd = wgid % NXCD, off = wgid / NXCD; wgid = (xcd < r ? xcd * (q + 1) : r * (q + 1) + (xcd - r) * q) + off; }
        const int nig = WGM * nN, gid = wgid / nig, fm = gid * WGM, gsz = (nM - fm) < WGM ? (nM - fm) : WGM;
        u.pm = fm + ((wgid % nig) % gsz); u.pn = (wgid % nig) / gsz; return true;
    }
    __device__ __forceinline__ void a_ready(const Unit&) const {}
    __device__ __forceinline__ void done(const Unit&) const {}
};

__device__ __forceinline__ unsigned cvt_pk_bf16(float lo, float hi) { unsigned r; asm volatile("v_cvt_pk_bf16_f32 %0, %1, %2" : "=v"(r) : "v"(lo), "v"(hi)); return r; }
typedef float f32x2 __attribute__((ext_vector_type(2)));
__device__ __forceinline__ f32x2 gelu_pk(f32x2 v) {
    const f32x2 av = __builtin_elementwise_abs(v), d = av * 0.2316418882f + 1.0f;
    f32x2 t; t.x = __builtin_amdgcn_rcpf(d.x); t.y = __builtin_amdgcn_rcpf(d.y);
    f32x2 q = t * 0.5307027145f + (-0.7265760135f); q = q * t + 0.7107068705f; q = q * t + (-0.142248368f); q = q * t + 0.127414796f; q = q * t;
    const f32x2 s = (v * v) * (-0.72134752044f);
    f32x2 e; e.x = __builtin_amdgcn_exp2f(s.x); e.y = __builtin_amdgcn_exp2f(s.y);
    const f32x2 m = v * (q * e), r = v - m;
    f32x2 o; o.x = v.x < 0.f ? m.x : r.x; o.y = v.y < 0.f ? m.y : r.y; return o;
}

template <int ACT  > struct EpiBf16 {
    static constexpr bool PERM = true, AFTER_DRAIN = false, MID = false, OVL = false; static_assert(ACT == 0 || ACT == 1, "EpiBf16: ACT is 0 (none) or 1 (gelu_pk)");
    bf16_t* O; int ldc; const float* bias; int split_cols; size_t split_stride; float scale0;
    __device__ __forceinline__ void operator()(const f32x4 (&acc)[2][2][4][2], const Unit& u, int wr, int wc, int fr, int fq) const {
        const int row0 = u.pm * BM + wr * 64 + fr; int colt = u.pn * BM; bf16_t* base = O;
        float sc = 1.f; if (split_cols) { const int t = colt / split_cols; base += (size_t)t * split_stride; colt -= t * split_cols; if (t == 0) sc = scale0; }
        const int col0 = colt + wc * 32 + 8 * fq, bcol0 = u.pn * BM + wc * 32 + 8 * fq;
        f32x4 bv[2][2];
#pragma unroll
        for (int bj = 0; bj < 2; ++bj)
#pragma unroll
            for (int n = 0; n < 2; ++n) bv[bj][n] = bias ? *(const f32x4*)(bias + bcol0 + bj * HALF + 4 * n) : (f32x4){0.f, 0.f, 0.f, 0.f};
#pragma unroll
        for (int ai = 0; ai < 2; ++ai)
#pragma unroll
            for (int m = 0; m < 4; ++m) { bf16_t* rowp = base + (size_t)(row0 + ai * HALF + m * 16) * ldc + col0;
#pragma unroll
                for (int bj = 0; bj < 2; ++bj) { f32x4 v0 = acc[ai][bj][m][0] + bv[bj][0], v1 = acc[ai][bj][m][1] + bv[bj][1];
                    if (ACT == 1) { f32x2 a = gelu_pk((f32x2){v0[0], v0[1]}), b = gelu_pk((f32x2){v0[2], v0[3]}), c = gelu_pk((f32x2){v1[0], v1[1]}), d = gelu_pk((f32x2){v1[2], v1[3]});
                        v0 = (f32x4){a.x, a.y, b.x, b.y}; v1 = (f32x4){c.x, c.y, d.x, d.y}; }
                    v0 = v0 * sc; v1 = v1 * sc; u32x4 w; w.x = cvt_pk_bf16(v0[0], v0[1]); w.y = cvt_pk_bf16(v0[2], v0[3]); w.z = cvt_pk_bf16(v1[0], v1[1]); w.w = cvt_pk_bf16(v1[2], v1[3]);
                    *(u32x4*)(rowp + bj * HALF) = w; } }
    }
};

struct EpiF32 {
    static constexpr bool PERM = false, AFTER_DRAIN = false, MID = false, OVL = false;
    float* C; int ldc; const float* bias;
    __device__ __forceinline__ void operator()(const f32x4 (&acc)[2][2][4][2], const Unit& u, int wr, int wc, int fr, int fq) const {
        const int row0 = u.pm * BM + wr * 64 + fr, col0 = u.pn * BM + wc * 32 + 4 * fq;
        f32x4 bv[2][2];
#pragma unroll
        for (int bj = 0; bj < 2; ++bj)
#pragma unroll
            for (int n = 0; n < 2; ++n) bv[bj][n] = bias ? *(const f32x4*)(bias + col0 + bj * HALF + n * 16) : (f32x4){0.f, 0.f, 0.f, 0.f};
#pragma unroll
        for (int ai = 0; ai < 2; ++ai)
#pragma unroll
            for (int m = 0; m < 4; ++m) { float* rowp = C + (size_t)(row0 + ai * HALF + m * 16) * ldc + col0;
#pragma unroll
                for (int bj = 0; bj < 2; ++bj)
#pragma unroll
                    for (int n = 0; n < 2; ++n) *(f32x4*)(rowp + bj * HALF + n * 16) = acc[ai][bj][m][n] + bv[bj][n]; }
    }
};

template <class Epi, class Sched, bool ALIGN_EPI = false, bool SP2 = false>
__device__ __forceinline__ void gemm_phase(PG8_LAS unsigned char* lds, const Gemm g, const Sched& S, const Epi& E, const int tid) {
    const int wid = __builtin_amdgcn_readfirstlane(tid >> 6), lane = tid & 63, wr = wid >> 2, wc = wid & 3, fr = lane & 15, fq = lane >> 4;
    const int K = g.K, nt = K / BK;
    unsigned voffA[2], voffB[2];
#pragma unroll
    for (int i = 0; i < 2; ++i) { int R, C; stage_rc(tid * 16 + i * 8192, R, C); const int Rb = Epi::PERM ? ((R & ~31) + perm32(R & 31)) : R;
        voffA[i] = (unsigned)(R * g.lda + C) * 2u; voffB[i] = (unsigned)(Rb * g.ldb + C) * 2u; }
    const size_t kstep = (size_t)(BK * 2);
    const size_t hstepA = (size_t)HALF * g.lda * 2, hstepB = (size_t)HALF * g.ldb * 2;
    const size_t tstepA = 2 * hstepA, tstepB = 2 * hstepB;
    const unsigned ldsw = (unsigned)wid * 1024u;
    const int aoff = lds_byte(wr * 64 + fr, fq * 8), boff = lds_byte(wc * 32 + fr, fq * 8);
#define PG8_SA(b, h) (((b) * 2 + (h)) * HTB)
#define PG8_SB(b, h) ((4 + (b) * 2 + (h)) * HTB)
#define PG8_STAGE(bufoff, gbase, voff) do { _Pragma("unroll") for (int _i = 0; _i < 2; ++_i) \
        __builtin_amdgcn_global_load_lds((const unsigned*)((const char*)(gbase) + (voff)[_i]), (PG8_LAS unsigned*)(lds + (bufoff) + ldsw + _i * 8192), 16, 0, 0); } while (0)
#define PG8_LDA(dst, b, h) do { _Pragma("unroll") for (int m = 0; m < 4; ++m) _Pragma("unroll") for (int k = 0; k < 2; ++k) dst[m][k] = *(const PG8_LAS bf16x8*)(lds + PG8_SA(b, h) + aoff + m * 2048 + k * 1024); } while (0)
#define PG8_LDB(dst, b, h) do { _Pragma("unroll") for (int n = 0; n < 2; ++n) _Pragma("unroll") for (int k = 0; k < 2; ++k) dst[n][k] = *(const PG8_LAS bf16x8*)(lds + PG8_SB(b, h) + boff + n * 2048 + k * 1024); } while (0)
#define PG8_MMA(ai, bj, At, Bt) do { __builtin_amdgcn_s_setprio(1); _Pragma("unroll") for (int m = 0; m < 4; ++m) _Pragma("unroll") for (int n = 0; n < 2; ++n) _Pragma("unroll") for (int k = 0; k < 2; ++k) \
        acc[ai][bj][m][n] = __builtin_amdgcn_mfma_f32_16x16x32_bf16(Bt[n][k], At[m][k], acc[ai][bj][m][n], 0, 0, 0); __builtin_amdgcn_s_setprio(0); } while (0)
#define PG8_WAIT_V(n) asm volatile("s_waitcnt vmcnt(" #n ")" ::: "memory")
#define PG8_WAIT_L(n) asm volatile("s_waitcnt lgkmcnt(" #n ")" ::: "memory")
#define PG8_BAR __builtin_amdgcn_s_barrier()
#define PG8_SCHED __builtin_amdgcn_sched_barrier(0)
    Unit cur, nxt; int ui = 0;
    if (!S.next(0, cur)) return;
    f32x4 acc[2][2][4][2];
#pragma unroll
    for (int a = 0; a < 2; ++a)
#pragma unroll
        for (int b = 0; b < 2; ++b)
#pragma unroll
            for (int m = 0; m < 4; ++m)
#pragma unroll
                for (int n = 0; n < 2; ++n) acc[a][b][m][n] = (f32x4){0.f, 0.f, 0.f, 0.f};
    bf16x8 At[4][2], B0[2][2], B1[2][2];
    const char* cA = (const char*)g.A + (size_t)(Epi::OVL ? ovl_row(cur.pm) : cur.pm * BM) * (tstepA / BM); const char* cB = (const char*)g.Bt + (size_t)cur.pn * tstepB;
    S.a_ready(cur);
    if constexpr (SP2) {
        PG8_STAGE(PG8_SB(0, 0), cB, voffB); PG8_STAGE(PG8_SB(0, 1), cB + hstepB, voffB); PG8_STAGE(PG8_SA(0, 0), cA, voffA); PG8_STAGE(PG8_SA(0, 1), cA + hstepA, voffA);
        if (wr == 1) PG8_BAR;
        PG8_WAIT_V(2); PG8_BAR;
        PG8_STAGE(PG8_SB(1, 0), cB + kstep, voffB); PG8_STAGE(PG8_SA(1, 0), cA + kstep, voffA); PG8_STAGE(PG8_SB(1, 1), cB + hstepB + kstep, voffB);
        PG8_WAIT_V(6); PG8_BAR;
    } else {
        PG8_STAGE(PG8_SB(0, 0), cB, voffB); PG8_STAGE(PG8_SA(0, 0), cA, voffA); PG8_STAGE(PG8_SB(0, 1), cB + hstepB, voffB); PG8_STAGE(PG8_SA(0, 1), cA + hstepA, voffA);
        if (wr == 1) PG8_BAR;
        PG8_WAIT_V(4); PG8_BAR;
        PG8_STAGE(PG8_SB(1, 0), cB + kstep, voffB); PG8_STAGE(PG8_SA(1, 0), cA + kstep, voffA); PG8_STAGE(PG8_SB(1, 1), cB + hstepB + kstep, voffB);
        PG8_WAIT_V(6); PG8_BAR;
    }
    for (;;) {
        const bool has_next = S.next(ui + 1, nxt);
        const char* nA = has_next ? (const char*)g.A + (size_t)(Epi::OVL ? ovl_row(nxt.pm) : nxt.pm * BM) * (tstepA / BM) : cA; const char* nB = has_next ? (const char*)g.Bt + (size_t)nxt.pn * tstepB : cB;
        for (int t = 0; t < nt; t += 2) {
            const bool last = (t == nt - 2);
            const char* a1 = cA + (size_t)(t + 1) * kstep;
            const char* a2 = last ? nA : cA + (size_t)(t + 2) * kstep; const char* b2 = last ? nB : cB + (size_t)(t + 2) * kstep;
            const char* a3 = a2 + kstep; const char* b3 = b2 + kstep;
            if (last && has_next) S.a_ready(nxt);
            if constexpr (Epi::MID) { if (t == (nt >> 1)) E.mid(acc, cur, wr, wc, fr, fq); }
            if constexpr (SP2) {
            PG8_LDB(B0, 0, 0); PG8_LDB(B1, 0, 1); PG8_SCHED; PG8_LDA(At, 0, 0); PG8_STAGE(PG8_SA(1, 1), a1 + hstepA, voffA);
            PG8_WAIT_V(8); PG8_WAIT_L(0); PG8_BAR; PG8_MMA(0, 0, At, B0); PG8_MMA(0, 1, At, B1); PG8_BAR; PG8_SCHED;
            PG8_LDA(At, 0, 1); PG8_STAGE(PG8_SB(0, 0), b2, voffB); PG8_STAGE(PG8_SB(0, 1), b2 + hstepB, voffB); PG8_STAGE(PG8_SA(0, 0), a2, voffA);
            PG8_WAIT_V(8); PG8_WAIT_L(0); PG8_BAR; PG8_MMA(1, 0, At, B0); PG8_MMA(1, 1, At, B1); PG8_BAR; PG8_SCHED;
            PG8_LDB(B0, 1, 0); PG8_LDB(B1, 1, 1); PG8_SCHED; PG8_LDA(At, 1, 0); PG8_STAGE(PG8_SA(0, 1), a2 + hstepA, voffA);
            PG8_WAIT_V(8); PG8_WAIT_L(0); PG8_BAR; PG8_MMA(0, 0, At, B0); PG8_MMA(0, 1, At, B1); PG8_BAR; PG8_SCHED;
            PG8_LDA(At, 1, 1); PG8_STAGE(PG8_SB(1, 0), b3, voffB); PG8_STAGE(PG8_SB(1, 1), b3 + hstepB, voffB); PG8_STAGE(PG8_SA(1, 0), a3, voffA);
            PG8_WAIT_V(8); PG8_WAIT_L(0); PG8_BAR; PG8_MMA(1, 0, At, B0); PG8_MMA(1, 1, At, B1); PG8_BAR; PG8_SCHED;
            } else {
            PG8_LDB(B0, 0, 0); PG8_SCHED; PG8_LDA(At, 0, 0); PG8_STAGE(PG8_SA(1, 1), a1 + hstepA, voffA);
            PG8_WAIT_L(8); PG8_BAR; PG8_WAIT_L(0); PG8_MMA(0, 0, At, B0); PG8_BAR; PG8_SCHED;
            PG8_LDB(B1, 0, 1); PG8_STAGE(PG8_SB(0, 0), b2, voffB);
            PG8_BAR; PG8_WAIT_L(0); PG8_MMA(0, 1, At, B1); PG8_BAR;
            PG8_LDA(At, 0, 1); PG8_STAGE(PG8_SA(0, 0), a2, voffA);
            PG8_BAR; PG8_WAIT_L(0); PG8_MMA(1, 0, At, B0); PG8_BAR; PG8_SCHED;
            PG8_STAGE(PG8_SB(0, 1), b2 + hstepB, voffB);
            PG8_WAIT_V(6); PG8_BAR; PG8_MMA(1, 1, At, B1); PG8_BAR;
            PG8_LDB(B0, 1, 0); PG8_SCHED; PG8_LDA(At, 1, 0); PG8_STAGE(PG8_SA(0, 1), a2 + hstepA, voffA);
            PG8_WAIT_L(8); PG8_BAR; PG8_WAIT_L(0); PG8_MMA(0, 0, At, B0); PG8_BAR; PG8_SCHED;
            PG8_LDB(B1, 1, 1); PG8_STAGE(PG8_SB(1, 0), b3, voffB);
            PG8_BAR; PG8_WAIT_L(0); PG8_MMA(0, 1, At, B1); PG8_BAR;
            PG8_LDA(At, 1, 1); PG8_STAGE(PG8_SA(1, 0), a3, voffA);
            PG8_BAR; PG8_WAIT_L(0); PG8_MMA(1, 0, At, B0); PG8_BAR; PG8_SCHED;
            PG8_STAGE(PG8_SB(1, 1), b3 + hstepB, voffB);
            PG8_WAIT_V(6); PG8_BAR; PG8_MMA(1, 1, At, B1); PG8_BAR;
            }
        }
        if constexpr (ALIGN_EPI) { if (wr == 0) PG8_BAR; }
        if constexpr (!Epi::AFTER_DRAIN) { E(acc, cur, wr, wc, fr, fq); S.done(cur); }
        if (!has_next) break;
#pragma unroll
        for (int a = 0; a < 2; ++a)
#pragma unroll
            for (int b = 0; b < 2; ++b)
#pragma unroll
                for (int m = 0; m < 4; ++m)
#pragma unroll
                    for (int n = 0; n < 2; ++n) acc[a][b][m][n] = (f32x4){0.f, 0.f, 0.f, 0.f};
        cur = nxt; cA = nA; cB = nB; ++ui;
        if constexpr (ALIGN_EPI) { if (wr == 1) PG8_BAR; }
    }
    PG8_WAIT_V(0);
    if constexpr (!ALIGN_EPI) { if (wr == 0) PG8_BAR; }
    PG8_BAR;
    if constexpr (Epi::AFTER_DRAIN) { E.fused(acc, cur, wr, wc, fr, fq, lds, wid, lane); S.done(cur); }
#undef PG8_SA
#undef PG8_SB
#undef PG8_STAGE
#undef PG8_LDA
#undef PG8_LDB
#undef PG8_MMA
#undef PG8_WAIT_V
#undef PG8_WAIT_L
#undef PG8_BAR
#undef PG8_SCHED
}
}
namespace {
constexpr int D = 1024, NB = 4, L = 4096, HW = 1024, SW = 1024, INW = 7168, FH = 2816, FHID = 64, FEMB = 33;
constexpr float EPS = 1e-6f;
typedef unsigned short bf16;
__device__ __forceinline__ unsigned f2bf(float f) { unsigned u = __builtin_bit_cast(unsigned, f); return (u + 0x7fffu + ((u >> 16) & 1u)) >> 16; }
__device__ __forceinline__ void block_sync() { __builtin_amdgcn_fence(__ATOMIC_RELEASE, "workgroup"); __builtin_amdgcn_s_barrier(); __builtin_amdgcn_fence(__ATOMIC_ACQUIRE, "workgroup"); }
}
namespace {
#define HD __device__ __forceinline__
#define FFT_OPAQUE(w) asm volatile("" : "+v"((w).x), "+v"((w).y))
#ifndef HD
#define HD inline
#endif
typedef float cfv __attribute__((ext_vector_type(2)));
struct cf { float x, y; };
HD cf cmk(float x, float y) { cf r; r.x = x; r.y = y; return r; }
template <class P> HD cf ldz(P Z, int i) { const cfv t = Z[i]; return cmk(t.x, t.y); }
template <class P> HD void stz(P Z, int i, cf v) { Z[i] = (cfv){v.x, v.y}; }
HD cf cadd(cf a, cf b) { return cmk(a.x + b.x, a.y + b.y); }
HD cf csub(cf a, cf b) { return cmk(a.x - b.x, a.y - b.y); }
HD cf cmul(cf a, cf b) { return cmk(a.x * b.x - a.y * b.y, a.x * b.y + a.y * b.x); }
HD cf cconj(cf a) { return cmk(a.x, -a.y); }
template <bool INV> HD cf mulmi(cf a) { return INV ? cmk(-a.y, a.x) : cmk(a.y, -a.x); }
template <bool INV> HD cf twc(float c, float s) { return INV ? cmk(c, s) : cmk(c, -s); }
HD int fpad(int p) { return p + (p >> 4); }
constexpr int FSUB = 4352;

template <bool INV> HD void dft4(cf& a, cf& b, cf& c, cf& d) {
    const cf t0 = cadd(a, c), t1 = csub(a, c), t2 = cadd(b, d), t3 = mulmi<INV>(csub(b, d));
    a = cadd(t0, t2); b = cadd(t1, t3); c = csub(t0, t2); d = csub(t1, t3);
}
template <bool INV> HD void dft16(cf (&v)[16]) {
    constexpr float C1 = 0.92387953251128674f, S1 = 0.38268343236508977f, R = 0.70710678118654752f;
#pragma unroll
    for (int n0 = 0; n0 < 4; ++n0) dft4<INV>(v[n0], v[n0 + 4], v[n0 + 8], v[n0 + 12]);
    v[1 + 4 * 1] = cmul(v[1 + 4 * 1], twc<INV>(C1, S1));
    v[1 + 4 * 2] = cmul(v[1 + 4 * 2], twc<INV>(R, R));
    v[1 + 4 * 3] = cmul(v[1 + 4 * 3], twc<INV>(S1, C1));
    v[2 + 4 * 1] = cmul(v[2 + 4 * 1], twc<INV>(R, R));
    v[2 + 4 * 2] = mulmi<INV>(v[2 + 4 * 2]);
    v[2 + 4 * 3] = cmul(v[2 + 4 * 3], twc<INV>(-R, R));
    v[3 + 4 * 1] = cmul(v[3 + 4 * 1], twc<INV>(S1, C1));
    v[3 + 4 * 2] = cmul(v[3 + 4 * 2], twc<INV>(-R, R));
    v[3 + 4 * 3] = cmul(v[3 + 4 * 3], twc<INV>(-C1, -S1));
#pragma unroll
    for (int k0 = 0; k0 < 4; ++k0) dft4<INV>(v[4 * k0], v[4 * k0 + 1], v[4 * k0 + 2], v[4 * k0 + 3]);
    cf t;
    t = v[1]; v[1] = v[4]; v[4] = t;   t = v[2]; v[2] = v[8]; v[8] = t;   t = v[3]; v[3] = v[12]; v[12] = t;
    t = v[6]; v[6] = v[9]; v[9] = t;   t = v[7]; v[7] = v[13]; v[13] = t; t = v[11]; v[11] = v[14]; v[14] = t;
}
#ifndef FFT_OPAQUE
#define FFT_OPAQUE(w)
#endif
HD void twiddle16(cf (&v)[16], cf w) {
    FFT_OPAQUE(w);
    cf p = w;
#pragma unroll
    for (int k = 1; k < 16; ++k) { v[k] = cmul(v[k], p); if (k < 15) p = cmul(p, w); }
}
template <class P> HD void fwd_pass1(P Z, int t, cf w1) {
    cf v[16]; const int b = t + (t >> 4);
#pragma unroll
    for (int j = 0; j < 16; ++j) v[j] = ldz(Z, b + 272 * j);
    dft16<false>(v); twiddle16(v, w1);
#pragma unroll
    for (int j = 0; j < 16; ++j) stz(Z, b + 272 * j, v[j]);
}
template <class P> HD void fwd_pass2(P Z, int t, cf w2) {
    const int b = 272 * (t >> 4) + (t & 15);
    cf v[16];
#pragma unroll
    for (int j = 0; j < 16; ++j) v[j] = ldz(Z, b + 17 * j);
    dft16<false>(v); twiddle16(v, w2);
#pragma unroll
    for (int j = 0; j < 16; ++j) stz(Z, b + 17 * j, v[j]);
}
template <class P> HD void fwd_pass3_load(P Z, int t, cf (&v)[16]) {
#pragma unroll
    for (int j = 0; j < 16; ++j) v[j] = ldz(Z, 17 * t + j);
    dft16<false>(v);
}
template <class P> HD void inv_pass1_store(P Z, int t, cf (&v)[16]) {
    dft16<true>(v);
#pragma unroll
    for (int j = 0; j < 16; ++j) stz(Z, 17 * t + j, v[j]);
}
template <class P> HD void inv_pass2(P Z, int t, cf w2) {
    const int b = 272 * (t >> 4) + (t & 15);
    cf v[16];
#pragma unroll
    for (int j = 0; j < 16; ++j) v[j] = ldz(Z, b + 17 * j);
    twiddle16(v, cconj(w2)); dft16<true>(v);
#pragma unroll
    for (int j = 0; j < 16; ++j) stz(Z, b + 17 * j, v[j]);
}
template <class P> HD void inv_pass3(P Z, int t, cf w1) {
    cf v[16]; const int b = t + (t >> 4);
#pragma unroll
    for (int j = 0; j < 16; ++j) v[j] = ldz(Z, b + 272 * j);
    twiddle16(v, cconj(w1)); dft16<true>(v);
#pragma unroll
    for (int j = 0; j < 16; ++j) stz(Z, b + 272 * j, v[j]);
}
#define LAS __attribute__((address_space(3)))
typedef LAS cfv* lcf;
struct HyArgs {
    const bf16* hyT;
    bf16* yaT;
    const float* fsum;
    const float* fdif;
    const float* cw;
    const float* cb;
    const float* skip;
    const cfv* T;
    int TS, npairs, off00, off01, off10, off11;
};
__device__ __forceinline__ float bf2f(unsigned h) { return __builtin_bit_cast(float, h << 16); }
constexpr int HOFF_SX1 = 2 * FSUB * 8, HOFF_SV = HOFF_SX1 + 16384, HOFF_SX0 = HOFF_SV + 16384, HOFF_SF = HOFF_SX0 + 16384, HY_LDS_END = HOFF_SF + 32768;
#define HBAR() do { asm volatile("s_waitcnt lgkmcnt(0)" ::: "memory"); __builtin_amdgcn_s_barrier(); asm volatile("" ::: "memory"); } while (0)
#define HDMA_WAIT() asm volatile("s_waitcnt vmcnt(0)" ::: "memory")
#define WAVE_FENCE() asm volatile("s_waitcnt lgkmcnt(0)" ::: "memory")
__device__ __forceinline__ void hdma16(const void* gp, LAS unsigned char* wave_dst) { __builtin_amdgcn_global_load_lds((const unsigned*)gp, (LAS unsigned*)wave_dst, 16, 0, 0); }
__device__ __forceinline__ void conv8s(const LAS unsigned char* S, int tid, float w0, float w1, float w2, float b, float (&o)[8]) {
    const pg8::u32x4 q = *(const LAS pg8::u32x4*)(S + 16 * tid);
    const unsigned lft = *(const LAS unsigned short*)(S + (tid > 0 ? 16 * tid - 2 : 0)), rgt = *(const LAS unsigned short*)(S + (tid < 511 ? 16 * tid + 16 : 8190));
    float x[10];
    x[0] = tid > 0 ? bf2f(lft) : 0.f; x[9] = tid < 511 ? bf2f(rgt) : 0.f;
    x[1] = bf2f(q.x & 0xffffu); x[2] = bf2f(q.x >> 16); x[3] = bf2f(q.y & 0xffffu); x[4] = bf2f(q.y >> 16);
    x[5] = bf2f(q.z & 0xffffu); x[6] = bf2f(q.z >> 16); x[7] = bf2f(q.w & 0xffffu); x[8] = bf2f(q.w >> 16);
#pragma unroll
    for (int i = 0; i < 8; ++i) o[i] = b + w0 * x[i] + w1 * x[i + 1] + w2 * x[i + 2];
}
__device__ __forceinline__ pg8::u32x4 pack8(const float (&x)[8], const float (&y)[8]) {
    pg8::u32x4 w;
    w.x = f2bf(x[0] * y[0]) | (f2bf(x[1] * y[1]) << 16); w.y = f2bf(x[2] * y[2]) | (f2bf(x[3] * y[3]) << 16);
    w.z = f2bf(x[4] * y[4]) | (f2bf(x[5] * y[5]) << 16); w.w = f2bf(x[6] * y[6]) | (f2bf(x[7] * y[7]) << 16);
    return w;
}
__device__ __forceinline__ void hyena_phase(LAS unsigned char* lds, const HyArgs& A, int first, int stride, const int tid, const int wave) {
    lcf Z = (lcf)lds;
    const int s = tid >> 8, t = tid & 255, pb = 8 * tid + (tid >> 1);
    const cf w1 = ldz(A.T, 2 * t), w2 = ldz(A.T, 32 * (t & 15)), wp = ldz(A.T, 8 * tid);
    lcf Zs = Z + s * FSUB;
    LAS unsigned char* wdst = lds + wave * 1024;
    constexpr float W8C[8] = {1.0f, 0.99999970586f, 0.99999882345f, 0.99999735277f, 0.99999529381f, 0.99999264659f, 0.99998941108f, 0.99998558731f};
    constexpr float W8S[8] = {0.0f, 0.00076699031874f, 0.0015339801863f, 0.0023009691514f, 0.0030679567630f, 0.0038349425697f, 0.0046019261204f, 0.0053689069640f};
    if (first >= 1024) return;
#define ISSUE_PAIR(cc, oa, ob) do { \
        hdma16(A.hyT + (size_t)(1024 + (cc)) * A.TS + (oa) + 8 * tid, wdst + HOFF_SX1); hdma16(A.hyT + (size_t)(1024 + (cc)) * A.TS + (ob) + 8 * tid, wdst + HOFF_SX1 + 8192); \
        hdma16(A.hyT + (size_t)(2048 + (cc)) * A.TS + (oa) + 8 * tid, wdst + HOFF_SV);  hdma16(A.hyT + (size_t)(2048 + (cc)) * A.TS + (ob) + 8 * tid, wdst + HOFF_SV + 8192); } while (0)
#define ISSUE_X0(cc, oa, ob) do { hdma16(A.hyT + (size_t)(cc) * A.TS + (oa) + 8 * tid, wdst + HOFF_SX0); hdma16(A.hyT + (size_t)(cc) * A.TS + (ob) + 8 * tid, wdst + HOFF_SX0 + 8192); } while (0)
#define ISSUE_FILT(cc) do { \
        hdma16(A.fsum + (size_t)(cc) * 4096 + 8 * tid, wdst + HOFF_SF); hdma16(A.fsum + (size_t)(cc) * 4096 + 8 * tid + 4, wdst + HOFF_SF + 8192); \
        hdma16(A.fdif + (size_t)(cc) * 4096 + 8 * tid, wdst + HOFF_SF + 16384); hdma16(A.fdif + (size_t)(cc) * 4096 + 8 * tid + 4, wdst + HOFF_SF + 24576); } while (0)
    ISSUE_FILT(first); ISSUE_PAIR(first, A.off00, A.off01);
    for (int c = first; c < 1024; c += stride) {
        const int cn = c + stride;
        const float sk = A.skip[c];
        const float cx0 = A.cw[c], cx1 = A.cw[3072 + c], cx2 = A.cw[6144 + c], cxb = A.cb[c];
        const float ca0 = A.cw[1024 + c], ca1 = A.cw[3072 + 1024 + c], ca2 = A.cw[6144 + 1024 + c], cab = A.cb[1024 + c];
        const float cv0 = A.cw[2048 + c], cv1 = A.cw[3072 + 2048 + c], cv2 = A.cw[6144 + 2048 + c], cvb = A.cb[2048 + c];
        cf Kr[16];
        HDMA_WAIT();
        {
            const pg8::f32x4 s0 = *(const LAS pg8::f32x4*)(lds + HOFF_SF + 16 * tid), s1 = *(const LAS pg8::f32x4*)(lds + HOFF_SF + 8192 + 16 * tid);
            const pg8::f32x4 d0 = *(const LAS pg8::f32x4*)(lds + HOFF_SF + 16384 + 16 * tid), d1 = *(const LAS pg8::f32x4*)(lds + HOFF_SF + 24576 + 16 * tid);
            const float fs[8] = {s0[0], s0[1], s0[2], s0[3], s1[0], s1[1], s1[2], s1[3]}, fd[8] = {d0[0], d0[1], d0[2], d0[3], d1[0], d1[1], d1[2], d1[3]};
#pragma unroll
            for (int i = 0; i < 8; ++i) { cf wq = wp; FFT_OPAQUE(wq); const cf tw = cmul(wq, cmk(W8C[i], -W8S[i])); stz(Z, pb + i, cmk(fs[i], 0.f)); stz(Z, FSUB + pb + i, cmk(fd[i] * tw.x, fd[i] * tw.y)); }
        }
        HBAR();
        fwd_pass1(Zs, t, w1); HBAR();
        fwd_pass2(Zs, t, w2); WAVE_FENCE();
        fwd_pass3_load(Zs, t, Kr);
#pragma unroll
        for (int j = 0; j < 16; ++j) { Kr[j].x *= (1.0f / 8192.0f); Kr[j].y *= (1.0f / 8192.0f); }
        HBAR();
        for (int p = 0; p < A.npairs; ++p) {
            const int o0 = p ? A.off10 : A.off00, o1 = p ? A.off11 : A.off01;
            float u0[8], u1[8];
            {
                float a[8], b[8];
                conv8s(lds + HOFF_SX1, tid, ca0, ca1, ca2, cab, a); conv8s(lds + HOFF_SV, tid, cv0, cv1, cv2, cvb, b);
#pragma unroll
                for (int i = 0; i < 8; ++i) u0[i] = a[i] * b[i];
                conv8s(lds + HOFF_SX1 + 8192, tid, ca0, ca1, ca2, cab, a); conv8s(lds + HOFF_SV + 8192, tid, cv0, cv1, cv2, cvb, b);
#pragma unroll
                for (int i = 0; i < 8; ++i) u1[i] = a[i] * b[i];
            }
#pragma unroll
            for (int i = 0; i < 8; ++i) { cf wq = wp; FFT_OPAQUE(wq); const cf tw = cmul(wq, cmk(W8C[i], -W8S[i])); const cf z = cmk(u0[i], u1[i]); stz(Z, pb + i, z); stz(Z, FSUB + pb + i, cmul(z, tw)); }
            HBAR();
            ISSUE_X0(c, o0, o1);
            if (p + 1 < A.npairs) ISSUE_PAIR(c, A.off10, A.off11);
            else if (cn < 1024) { ISSUE_PAIR(cn, A.off00, A.off01); ISSUE_FILT(cn); }
            fwd_pass1(Zs, t, w1); HBAR();
            fwd_pass2(Zs, t, w2); WAVE_FENCE();
            {
                cf v[16];
                fwd_pass3_load(Zs, t, v);
#pragma unroll
                for (int j = 0; j < 16; ++j) v[j] = cmul(v[j], Kr[j]);
                inv_pass1_store(Zs, t, v);
            }
            WAVE_FENCE();
            inv_pass2(Zs, t, w2); HBAR();
            inv_pass3(Zs, t, w1);
            HDMA_WAIT(); HBAR();
            {
                float y0[8], y1[8];
#pragma unroll
                for (int i = 0; i < 8; ++i) { cf wq = wp; FFT_OPAQUE(wq); const cf tw = cmul(wq, cmk(W8C[i], -W8S[i])); const cf e = ldz(Z, pb + i), o = ldz(Z, FSUB + pb + i); const cf y = cadd(e, cmul(o, cconj(tw))); y0[i] = y.x + sk * u0[i]; y1[i] = y.y + sk * u1[i]; }
                float x0c[8];
                conv8s(lds + HOFF_SX0, tid, cx0, cx1, cx2, cxb, x0c);
                *(pg8::u32x4*)(A.yaT + (size_t)c * A.TS + o0 + 8 * tid) = pack8(x0c, y0);
                if (o1 != o0) { conv8s(lds + HOFF_SX0 + 8192, tid, cx0, cx1, cx2, cxb, x0c); *(pg8::u32x4*)(A.yaT + (size_t)c * A.TS + o1 + 8 * tid) = pack8(x0c, y1); }
            }
        }
    }
    HDMA_WAIT(); HBAR();
#undef ISSUE_PAIR
#undef ISSUE_X0
#undef ISSUE_FILT
}
}
namespace pg8 {
__device__ __forceinline__ f32x2 sigmoid_pk(f32x2 v) {
    f32x2 e; e.x = __builtin_amdgcn_exp2f(v.x * -1.4426950408889634f); e.y = __builtin_amdgcn_exp2f(v.y * -1.4426950408889634f);
    f32x2 o; o.x = __builtin_amdgcn_rcpf(1.0f + e.x); o.y = __builtin_amdgcn_rcpf(1.0f + e.y); return o;
}
struct EpiHyT {
    static constexpr bool PERM = true, AFTER_DRAIN = false, MID = false, OVL = false;
    bf16_t* O; int ldc; float* vss;
    __device__ __forceinline__ void operator()(const f32x4 (&acc)[2][2][4][2], const Unit& u, int wr, int wc, int fr, int fq) const {
        const int row0 = u.pm * BM + wr * 64 + fr, col0 = u.pn * BM + wc * 32 + 8 * fq;
        const bool isv = u.pm >= 12;
        f32x4 ss[2][2];
#pragma unroll
        for (int bj = 0; bj < 2; ++bj)
#pragma unroll
            for (int n = 0; n < 2; ++n) ss[bj][n] = (f32x4){0.f, 0.f, 0.f, 0.f};
#pragma unroll
        for (int ai = 0; ai < 2; ++ai)
#pragma unroll
            for (int m = 0; m < 4; ++m) { bf16_t* rowp = O + (size_t)(row0 + ai * HALF + m * 16) * ldc + col0;
#pragma unroll
                for (int bj = 0; bj < 2; ++bj) { f32x4 v0 = acc[ai][bj][m][0], v1 = acc[ai][bj][m][1];
                    if (isv) { f32x2 a = gelu_pk((f32x2){v0[0], v0[1]}), b = gelu_pk((f32x2){v0[2], v0[3]}), c = gelu_pk((f32x2){v1[0], v1[1]}), d = gelu_pk((f32x2){v1[2], v1[3]});
                        v0 = (f32x4){a.x, a.y, b.x, b.y}; v1 = (f32x4){c.x, c.y, d.x, d.y}; ss[bj][0] += v0 * v0; ss[bj][1] += v1 * v1; }
                    u32x4 w; w.x = cvt_pk_bf16(v0[0], v0[1]); w.y = cvt_pk_bf16(v0[2], v0[3]); w.z = cvt_pk_bf16(v1[0], v1[1]); w.w = cvt_pk_bf16(v1[2], v1[3]);
                    *(u32x4*)(rowp + bj * HALF) = w; } }
        if (isv) {
#pragma unroll
            for (int bj = 0; bj < 2; ++bj)
#pragma unroll
                for (int n = 0; n < 2; ++n)
#pragma unroll
                    for (int j = 0; j < 4; ++j) { float s = ss[bj][n][j]; s += __shfl_xor(s, 1); s += __shfl_xor(s, 2); s += __shfl_xor(s, 4); s += __shfl_xor(s, 8);
                        if (fr == 0) atomicAdd(vss + col0 + bj * HALF + 4 * n + j, s); }
        }
    }
};
struct EpiUG {
    static constexpr bool PERM = true, AFTER_DRAIN = false, MID = false, OVL = false;
    bf16_t* U; bf16_t* G; int ldu;
    __device__ __forceinline__ void operator()(const f32x4 (&acc)[2][2][4][2], const Unit& u, int wr, int wc, int fr, int fq) const {
        const int row0 = u.pm * BM + wr * 64 + fr; int colt = u.pn * BM; const bool isu = colt < 1024;
        bf16_t* base = isu ? U : G; const int ldc = isu ? ldu : 2048; if (!isu) colt -= 1024;
        const int col0 = colt + wc * 32 + 8 * fq;
#pragma unroll
        for (int ai = 0; ai < 2; ++ai)
#pragma unroll
            for (int m = 0; m < 4; ++m) { bf16_t* rowp = base + (size_t)(row0 + ai * HALF + m * 16) * ldc + col0;
#pragma unroll
                for (int bj = 0; bj < 2; ++bj) { f32x4 v0 = acc[ai][bj][m][0], v1 = acc[ai][bj][m][1];
                    f32x2 a, b, c, d;
                    if (isu) { a = gelu_pk((f32x2){v0[0], v0[1]}); b = gelu_pk((f32x2){v0[2], v0[3]}); c = gelu_pk((f32x2){v1[0], v1[1]}); d = gelu_pk((f32x2){v1[2], v1[3]}); }
                    else { a = sigmoid_pk((f32x2){v0[0], v0[1]}); b = sigmoid_pk((f32x2){v0[2], v0[3]}); c = sigmoid_pk((f32x2){v1[0], v1[1]}); d = sigmoid_pk((f32x2){v1[2], v1[3]}); }
                    u32x4 w; w.x = cvt_pk_bf16(a.x, a.y); w.y = cvt_pk_bf16(b.x, b.y); w.z = cvt_pk_bf16(c.x, c.y); w.w = cvt_pk_bf16(d.x, d.y);
                    *(u32x4*)(rowp + bj * HALF) = w; } }
    }
};
}
namespace {
struct WJob { const float* W; const float* g; bf16* dst; int K, N, c0, nc, ldd, r0, koff, perm; };
constexpr int NWJ = 9;
struct WJobs { WJob j[NWJ]; };
__device__ __forceinline__ unsigned pk2(float lo, float hi) { return f2bf(lo) | (f2bf(hi) << 16); }
__device__ __forceinline__ void wT_item(const WJob& J, LAS float* scr, int item, int lane) {
    const int nblk = J.nc / 32, kb = item / nblk, nb = item % nblk, k0 = 64 * kb, n0 = 32 * nb;
    float v[32];
#pragma unroll
    for (int i = 0; i < 32; ++i) v[i] = J.W[(size_t)(k0 + 2 * i + (lane >> 5)) * J.N + J.c0 + n0 + (lane & 31)];
    if (J.g) {
#pragma unroll
        for (int i = 0; i < 32; ++i) v[i] *= J.g[k0 + 2 * i + (lane >> 5)]; }
#pragma unroll
    for (int i = 0; i < 32; ++i) scr[(2 * i + (lane >> 5)) * 33 + (lane & 31)] = v[i];
    asm volatile("s_waitcnt lgkmcnt(0)" ::: "memory");
    const int c = lane & 7; int rb = n0;
    if (J.perm) { const int half = n0 >= 2816, cc = n0 - half * 2816; rb = 256 * (cc >> 7) + 128 * half + (cc & 127); }
#pragma unroll
    for (int j = 0; j < 4; ++j) { const int n = (lane >> 3) + 8 * j; const LAS float* s = scr + (8 * c) * 33 + n;
        uint4 o; o.x = pk2(s[0 * 33], s[1 * 33]); o.y = pk2(s[2 * 33], s[3 * 33]); o.z = pk2(s[4 * 33], s[5 * 33]); o.w = pk2(s[6 * 33], s[7 * 33]);
        *(uint4*)(J.dst + (size_t)(J.r0 + rb + n) * J.ldd + J.koff + k0 + 8 * c) = o; }
    asm volatile("s_waitcnt lgkmcnt(0)" ::: "memory");
}
__device__ __forceinline__ void p0_weights(const WJobs& WJ, int jlo, int jhi, LAS float* scr, int gw, int NGW, int lane) {
    int base = 0;
    for (int q = jlo; q < jhi; ++q) {
        const WJob& J = WJ.j[q]; const int ni = (J.K / 64) * (J.nc / 32);
        int it = gw - (base % NGW); if (it < 0) it += NGW;
        for (; it < ni; it += NGW) wT_item(J, scr, it, lane);
        base += ni;
    }
}
__device__ __forceinline__ float wave_sum(float v) {
#pragma unroll
    for (int o = 1; o < 64; o <<= 1) v += __shfl_xor(v, o);
    return v;
}
__device__ __forceinline__ void rms_row_to_bf16(const float* xrow, const float* g, bf16* orow, int lane) {
    const float4* xr = (const float4*)xrow + lane; const float4* gr = (const float4*)g + lane;
    float4 v[4]; float s = 0.f;
#pragma unroll
    for (int j = 0; j < 4; ++j) { v[j] = xr[64 * j]; s += (v[j].x * v[j].x + v[j].y * v[j].y) + (v[j].z * v[j].z + v[j].w * v[j].w); }
    const float r = rsqrtf(wave_sum(s) * (1.f / 1024.f) + EPS);
    unsigned long long* o8 = (unsigned long long*)orow + lane;
#pragma unroll
    for (int j = 0; j < 4; ++j) { const float4 gg = gr[64 * j];
        o8[64 * j] = (unsigned long long)pk2(v[j].x * r * gg.x, v[j].y * r * gg.y) | ((unsigned long long)pk2(v[j].z * r * gg.z, v[j].w * r * gg.w) << 32); }
}
__device__ __forceinline__ void rms_rows4_to_bf16(const float* xrow, const float* g, bf16* orow, int ldo, int lane) {
    float4 v[4][4]; float s[4];
#pragma unroll
    for (int r = 0; r < 4; ++r)
#pragma unroll
        for (int j = 0; j < 4; ++j) v[r][j] = ((const float4*)(xrow + (size_t)r * 1024) + lane)[64 * j];
#pragma unroll
    for (int r = 0; r < 4; ++r) { s[r] = 0.f;
#pragma unroll
        for (int j = 0; j < 4; ++j) s[r] += (v[r][j].x * v[r][j].x + v[r][j].y * v[r][j].y) + (v[r][j].z * v[r][j].z + v[r][j].w * v[r][j].w); }
#pragma unroll
    for (int r = 0; r < 4; ++r) { const float rr = rsqrtf(wave_sum(s[r]) * (1.f / 1024.f) + EPS);
        unsigned long long* o8 = (unsigned long long*)(orow + (size_t)r * ldo) + lane;
#pragma unroll
        for (int j = 0; j < 4; ++j) { const float4 gg = ((const float4*)g + lane)[64 * j];
            o8[64 * j] = (unsigned long long)pk2(v[r][j].x * rr * gg.x, v[r][j].y * rr * gg.y) | ((unsigned long long)pk2(v[r][j].z * rr * gg.z, v[r][j].w * rr * gg.w) << 32); } }
}
}

namespace {
struct SguArgs {
    const bf16* vT;
    bf16* U;
    const float* vss;
    const float* ws;
    const float* bs;
    const float* gn;
    int TS, ldu;
};
typedef short bf16x8_t __attribute__((ext_vector_type(8)));
typedef float f32x4_t __attribute__((ext_vector_type(4)));
__device__ __forceinline__ void sgu_item(LAS unsigned char* lds, const SguArgs& A, int item, int tid) {
    const int g = item & 7, ch = item >> 3, tok0 = ch * 128;
    const int wave = tid >> 6, lane = tid & 63, fr = lane & 15, fq = lane >> 4;
#pragma unroll
    for (int j = 0; j < 4; ++j) { const int idx = tid + 512 * j, d = idx >> 4, chunk = idx & 15;
        const pg8::u32x4 v = *(const pg8::u32x4*)(A.vT + (size_t)(g * 128 + d) * A.TS + tok0 + chunk * 8);
        *(LAS pg8::u32x4*)(lds + d * 272 + chunk * 16) = v; }
    bf16x8_t af[4];
    const int p = 16 * wave + fr;
#pragma unroll
    for (int kk = 0; kk < 4; ++kk) { const int q = 32 * kk + 8 * fq;
        const float4 w0 = *(const float4*)(A.ws + ((size_t)g * 128 + p) * 128 + q), w1 = *(const float4*)(A.ws + ((size_t)g * 128 + p) * 128 + q + 4);
        const float4 s0 = *(const float4*)(A.vss + tok0 + q), s1 = *(const float4*)(A.vss + tok0 + q + 4);
        const float r0 = rsqrtf(s0.x * (1.f / 1024.f) + EPS), r1 = rsqrtf(s0.y * (1.f / 1024.f) + EPS), r2 = rsqrtf(s0.z * (1.f / 1024.f) + EPS), r3 = rsqrtf(s0.w * (1.f / 1024.f) + EPS);
        const float r4 = rsqrtf(s1.x * (1.f / 1024.f) + EPS), r5 = rsqrtf(s1.y * (1.f / 1024.f) + EPS), r6 = rsqrtf(s1.z * (1.f / 1024.f) + EPS), r7 = rsqrtf(s1.w * (1.f / 1024.f) + EPS);
        uint4 o; o.x = pk2(w0.x * r0, w0.y * r1); o.y = pk2(w0.z * r2, w0.w * r3); o.z = pk2(w1.x * r4, w1.y * r5); o.w = pk2(w1.z * r6, w1.w * r7);
        af[kk] = __builtin_bit_cast(bf16x8_t, o); }
    const float bsp = A.bs[g * 128 + p];
    bf16* urow = A.U + (size_t)(tok0 + p) * A.ldu + g * 128 + 4 * fq;
    const float* gnp = A.gn + g * 128 + 4 * fq;
    uint2 uq[8];
#pragma unroll
    for (int nt = 0; nt < 8; ++nt) uq[nt] = *(const uint2*)(urow + 16 * nt);
    block_sync();
    f32x4_t acc[8];
#pragma unroll
    for (int nt = 0; nt < 8; ++nt) acc[nt] = (f32x4_t){0.f, 0.f, 0.f, 0.f};
#pragma unroll
    for (int kk = 0; kk < 4; ++kk) {
        bf16x8_t bfr[8];
#pragma unroll
        for (int nt = 0; nt < 8; ++nt) bfr[nt] = *(const LAS bf16x8_t*)(lds + (16 * nt + fr) * 272 + (32 * kk + 8 * fq) * 2);
#pragma unroll
        for (int nt = 0; nt < 8; ++nt) acc[nt] = __builtin_amdgcn_mfma_f32_16x16x32_bf16(bfr[nt], af[kk], acc[nt], 0, 0, 0);
    }
#pragma unroll
    for (int nt = 0; nt < 8; ++nt) {
        const uint2 uu = uq[nt];
        const float4 gv = *(const float4*)(gnp + 16 * nt);
        const float y0 = bf2f(uu.x & 0xffffu) * (gv.x * acc[nt][0] + bsp), y1 = bf2f(uu.x >> 16) * (gv.y * acc[nt][1] + bsp);
        const float y2 = bf2f(uu.y & 0xffffu) * (gv.z * acc[nt][2] + bsp), y3 = bf2f(uu.y >> 16) * (gv.w * acc[nt][3] + bsp);
        uint2 o; o.x = pk2(y0, y1); o.y = pk2(y2, y3);
        *(uint2*)(urow + 16 * nt) = o;
    }
    block_sync();
}
}

namespace pg8 {
__device__ __forceinline__ void bf8_to_f32(const u32x4 q, f32x4& lo, f32x4& hi) {
    lo = (f32x4){__builtin_bit_cast(float, q.x << 16), __builtin_bit_cast(float, q.x & 0xffff0000u), __builtin_bit_cast(float, q.y << 16), __builtin_bit_cast(float, q.y & 0xffff0000u)};
    hi = (f32x4){__builtin_bit_cast(float, q.z << 16), __builtin_bit_cast(float, q.z & 0xffff0000u), __builtin_bit_cast(float, q.w << 16), __builtin_bit_cast(float, q.w & 0xffff0000u)};
}
struct EpiMerge {
    static constexpr bool PERM = true, AFTER_DRAIN = false, MID = true, OVL = false;
    const bf16_t* G; bf16_t* O;
    __device__ __forceinline__ void mid(f32x4 (&acc)[2][2][4][2], const Unit& u, int wr, int wc, int fr, int fq) const {
        unsigned off0 = (unsigned)(u.pm * BM + wr * 64 + fr) * 2048u + (unsigned)(u.pn * BM + wc * 32 + 8 * fq);
        asm volatile("" : "+v"(off0));
#pragma unroll
        for (int ai = 0; ai < 2; ++ai)
#pragma unroll
            for (int m = 0; m < 4; ++m)
#pragma unroll
                for (int bj = 0; bj < 2; ++bj) { const bf16_t* gp = G + (off0 + (unsigned)((ai * HALF + m * 16) * 2048 + bj * HALF));
                    const u32x4 qa = *(const u32x4*)gp, qb = *(const u32x4*)(gp + 1024);
                    f32x4 a0, a1, b0, b1; bf8_to_f32(qa, a0, a1); bf8_to_f32(qb, b0, b1);
#pragma unroll
                    for (int j = 0; j < 4; ++j) { acc[ai][bj][m][0][j] *= a0[j] * __builtin_amdgcn_rcpf(b0[j]); acc[ai][bj][m][1][j] *= a1[j] * __builtin_amdgcn_rcpf(b1[j]); }
                    asm volatile("" ::: "memory"); }
    }
    __device__ __forceinline__ void operator()(const f32x4 (&acc)[2][2][4][2], const Unit& u, int wr, int wc, int fr, int fq) const {
        const int row0 = u.pm * BM + wr * 64 + fr, col0 = u.pn * BM + wc * 32 + 8 * fq;
#pragma unroll
        for (int ai = 0; ai < 2; ++ai)
#pragma unroll
            for (int m = 0; m < 4; ++m) { const size_t r = (size_t)(row0 + ai * HALF + m * 16);
#pragma unroll
                for (int bj = 0; bj < 2; ++bj) { f32x4 b0, b1; bf8_to_f32(*(const u32x4*)(G + r * 2048 + 1024 + col0 + bj * HALF), b0, b1);
                    const f32x4 v0 = acc[ai][bj][m][0] * b0, v1 = acc[ai][bj][m][1] * b1;
                    u32x4 w; w.x = cvt_pk_bf16(v0[0], v0[1]); w.y = cvt_pk_bf16(v0[2], v0[3]); w.z = cvt_pk_bf16(v1[0], v1[1]); w.w = cvt_pk_bf16(v1[2], v1[3]);
                    *(u32x4*)(O + r * 1024 + col0 + bj * HALF) = w; } }
    }
};
}
namespace {
__device__ __forceinline__ void tr64_item(const bf16* yaT, int TS, bf16* out, int ldo, LAS unsigned short* scr, int c0, int t0, int lane) {
#pragma unroll
    for (int i = 0; i < 8; ++i) { const int r = 8 * i + (lane >> 3), ch = lane & 7;
        const pg8::u32x4 q = *(const pg8::u32x4*)(yaT + (size_t)(c0 + r) * TS + t0 + 8 * ch);
        LAS unsigned short* d = scr + (8 * ch) * 72 + r;
        d[0 * 72] = (unsigned short)(q.x & 0xffffu); d[1 * 72] = (unsigned short)(q.x >> 16); d[2 * 72] = (unsigned short)(q.y & 0xffffu); d[3 * 72] = (unsigned short)(q.y >> 16);
        d[4 * 72] = (unsigned short)(q.z & 0xffffu); d[5 * 72] = (unsigned short)(q.z >> 16); d[6 * 72] = (unsigned short)(q.w & 0xffffu); d[7 * 72] = (unsigned short)(q.w >> 16); }
    asm volatile("s_waitcnt lgkmcnt(0)" ::: "memory");
#pragma unroll
    for (int i = 0; i < 8; ++i) { const int tk = 8 * i + (lane >> 3), ch = lane & 7;
        const pg8::u32x4 q = *(const LAS pg8::u32x4*)(scr + tk * 72 + 8 * ch);
        *(pg8::u32x4*)(out + (size_t)(t0 + tk) * ldo + c0 + 8 * ch) = q; }
    asm volatile("s_waitcnt lgkmcnt(0)" ::: "memory");
}
__device__ __forceinline__ void transpose_ya(const bf16* yaT, int TS, bf16* out, int ldo, LAS unsigned short* scr, int gw, int NGW, int lane) {
    const int ntt = TS / 64, nit = 16 * ntt;
    for (int it = gw; it < nit; it += NGW) tr64_item(yaT, TS, out, ldo, scr, 64 * (it / ntt), 64 * (it % ntt), lane);
}
}

namespace pg8 {
template <bool FIRST> struct EpiResid {
    static constexpr bool PERM = false, AFTER_DRAIN = false, MID = false, OVL = false;
    const float* X; const bf16_t* XB; float* X1; bf16_t* X1b; float* xss;
    __device__ __forceinline__ void operator()(const f32x4 (&acc)[2][2][4][2], const Unit& u, int wr, int wc, int fr, int fq) const {
        const int row0 = u.pm * BM + wr * 64 + fr, col0 = u.pn * BM + wc * 32 + 4 * fq;
        typedef unsigned u32x2v __attribute__((ext_vector_type(2)));
#pragma unroll
        for (int ai = 0; ai < 2; ++ai)
#pragma unroll
            for (int m = 0; m < 4; ++m) { const size_t r = (size_t)(row0 + ai * HALF + m * 16); float s = 0.f;
#pragma unroll
                for (int bj = 0; bj < 2; ++bj)
#pragma unroll
                    for (int n = 0; n < 2; ++n) { const size_t o = r * 1024 + col0 + bj * HALF + n * 16;
                        f32x4 v;
                        if (FIRST) v = acc[ai][bj][m][n] + *(const f32x4*)(X + o);
                        else { const u32x2v q = *(const u32x2v*)(XB + o);
                               v = acc[ai][bj][m][n] + (f32x4){__builtin_bit_cast(float, q.x << 16), __builtin_bit_cast(float, q.x & 0xffff0000u), __builtin_bit_cast(float, q.y << 16), __builtin_bit_cast(float, q.y & 0xffff0000u)}; }
                        { u32x2v w; w.x = cvt_pk_bf16(v[0], v[1]); w.y = cvt_pk_bf16(v[2], v[3]); *(u32x2v*)(X1b + o) = w; }
                        s += (v[0] * v[0] + v[1] * v[1]) + (v[2] * v[2] + v[3] * v[3]); }
                s += __shfl_xor(s, 16); s += __shfl_xor(s, 32);
                if (fq == 0) atomicAdd(xss + r, s);
                asm volatile("" ::: "memory"); }
    }
};
__device__ __forceinline__ float dpp_ror1(float v) { return __builtin_bit_cast(float, __builtin_amdgcn_update_dpp(0, __builtin_bit_cast(int, v), 0x121, 0xf, 0xf, false)); }
__device__ __forceinline__ float dpp_rol1(float v) { return __builtin_bit_cast(float, __builtin_amdgcn_update_dpp(0, __builtin_bit_cast(int, v), 0x12f, 0xf, 0xf, false)); }
struct EpiUpAct {
    static constexpr bool PERM = true, AFTER_DRAIN = false, MID = false, OVL = true;
    bf16_t* ACT; PG8_LAS float* XB; const float* xss; const float* cw; const float* cb;
    __device__ __forceinline__ void operator()(f32x4 (&acc)[2][2][4][2], const Unit& u, int wr, int wc, int fr_, int fq_) const {
        int lane_; asm volatile("v_mbcnt_lo_u32_b32 %0, -1, 0\n\tv_mbcnt_hi_u32_b32 %0, -1, %0" : "=v"(lane_));
        const int fr = lane_ & 15, fq = lane_ >> 4; (void)fr_; (void)fq_;
        const int seq = u.pm / 17, ti = u.pm % 17, rowbase = ovl_row(u.pm);
        const int own_lo = seq * 4096 + 254 * ti, own_hi = seq * 4096 + (254 * ti + 254 < 4096 ? 254 * ti + 254 : 4096);
        const int lr0 = wr * 64 + fr, cl = 32 * wc + 8 * fq;
#pragma unroll
        for (int ai = 0; ai < 2; ++ai)
#pragma unroll
            for (int m = 0; m < 4; ++m) { const float rs = rsqrtf(xss[rowbase + lr0 + ai * HALF + m * 16] * (1.0f / 1024.0f) + 1e-6f);
#pragma unroll
                for (int bj = 0; bj < 2; ++bj) { acc[ai][bj][m][0] *= rs; acc[ai][bj][m][1] *= rs; }
                __builtin_amdgcn_sched_barrier(0); }
        const bool e0 = fr == 0, e15 = fr == 15;
        const int slot = e0 ? 0 : (e15 ? 512 : 1024);
#pragma unroll
        for (int ai = 0; ai < 2; ++ai) { const int B = 2 * ai + wr;
            f32x4 p0, p1;
#pragma unroll
            for (int j = 0; j < 4; ++j) { p0[j] = e15 ? acc[ai][0][3][0][j] : acc[ai][0][0][0][j]; p1[j] = e15 ? acc[ai][0][3][1][j] : acc[ai][0][0][1][j]; }
            *(PG8_LAS f32x4*)(XB + slot + B * 128 + cl) = p0; *(PG8_LAS f32x4*)(XB + slot + B * 128 + cl + 4) = p1; }
        asm volatile("s_waitcnt lgkmcnt(0)" ::: "memory"); __builtin_amdgcn_s_barrier(); asm volatile("" ::: "memory");
        const int ch = 128 * u.pn + cl;
        typedef unsigned u32x2v __attribute__((ext_vector_type(2)));
#pragma unroll
        for (int ai = 0; ai < 2; ++ai) { const int B = 2 * ai + wr;
#pragma unroll
            for (int n = 0; n < 2; ++n) {
                const f32x4 w0 = *(const f32x4*)(cw + ch + 4 * n), w1 = *(const f32x4*)(cw + 2816 + ch + 4 * n), w2 = *(const f32x4*)(cw + 5632 + ch + 4 * n), bb = *(const f32x4*)(cb + ch + 4 * n);
                f32x4 pb = *(const PG8_LAS f32x4*)(XB + 512 + (B > 0 ? B - 1 : 0) * 128 + cl + 4 * n), nb = *(const PG8_LAS f32x4*)(XB + (B < 3 ? B + 1 : 3) * 128 + cl + 4 * n);
                if (B == 0) pb = (f32x4){0.f, 0.f, 0.f, 0.f};
                if (B == 3) nb = (f32x4){0.f, 0.f, 0.f, 0.f};
                float o[4][4];
#pragma unroll
                for (int j = 0; j < 4; ++j) {
                    float av[4], rr[4], ll[4];
#pragma unroll
                    for (int m = 0; m < 4; ++m) { av[m] = acc[ai][0][m][n][j]; rr[m] = dpp_ror1(av[m]); ll[m] = dpp_rol1(av[m]); }
#pragma unroll
                    for (int m = 0; m < 4; ++m) { const float pv = e0 ? (m > 0 ? rr[m - 1] : pb[j]) : rr[m], nv = e15 ? (m < 3 ? ll[m + 1] : nb[j]) : ll[m];
                        const float sv = bb[j] + w0[j] * pv + w1[j] * av[m] + w2[j] * nv;
                        o[m][j] = sv * __builtin_amdgcn_rcpf(1.0f + __builtin_amdgcn_exp2f(sv * -1.4426950408889634f)) * acc[ai][1][m][n][j]; }
                }
#pragma unroll
                for (int m = 0; m < 4; ++m) { const int tok = rowbase + lr0 + ai * HALF + m * 16;
                    if (tok >= own_lo && tok < own_hi) { u32x2v w; w.x = cvt_pk_bf16(o[m][0], o[m][1]); w.y = cvt_pk_bf16(o[m][2], o[m][3]); *(u32x2v*)(ACT + (size_t)tok * 2816 + ch + 4 * n) = w; } }
                __builtin_amdgcn_sched_barrier(0);
            } }
    }
};
}
namespace {
__device__ __forceinline__ void final_norm(const bf16* X2, const float* ss, const float* g, float* out, int TS, int gw, int NGW, int lane) {
    pg8::f32x4 g0[2], g1[2];
#pragma unroll
    for (int j = 0; j < 2; ++j) { g0[j] = *((const pg8::f32x4*)g + 2 * lane + 128 * j); g1[j] = *((const pg8::f32x4*)g + 2 * lane + 128 * j + 1); }
    for (int t = 2 * gw; t < TS; t += 2 * NGW) {
        pg8::u32x4 q[2][2]; float r[2];
#pragma unroll
        for (int k = 0; k < 2; ++k) { r[k] = rsqrtf(ss[t + k] * (1.0f / 1024.0f) + EPS);
#pragma unroll
            for (int j = 0; j < 2; ++j) q[k][j] = *((const pg8::u32x4*)(X2 + (size_t)(t + k) * 1024) + lane + 64 * j); }
#pragma unroll
        for (int k = 0; k < 2; ++k)
#pragma unroll
            for (int j = 0; j < 2; ++j) { pg8::f32x4 lo, hi; pg8::bf8_to_f32(q[k][j], lo, hi);
                pg8::f32x4* o = (pg8::f32x4*)(out + (size_t)(t + k) * 1024) + 2 * lane + 128 * j;
                o[0] = lo * g0[j] * r[k]; o[1] = hi * g1[j] * r[k]; }
    }
}
}

namespace {
constexpr int MLPW_W2 = 33 * 64, MLPW_W3 = MLPW_W2 + 4096, MLPW_B = MLPW_W3 + 4096, MLPW_N = MLPW_B + 256;
__device__ __forceinline__ float filt_z(int l, int j) {
    if (j == 0) return (float)((double)l / (double)(L - 1));
    const int i = (j - 1) & 15;
    const double band = 1e-4 + (double)i * ((15.0 - 1e-4) / 15.0);
    double rev = (double)l * band / (double)L;
    rev -= floor(rev);
    const float ang = (float)(rev * 6.283185307179586);
    return (j <= 16) ? cosf(ang) : -sinf(ang);
}
__device__ __forceinline__ void filter_mlp_rows2(const LAS float* wl, float* h3out, LAS float* scr, int l0, int l1, int j) {
    LAS float* za = scr; LAS float* zb = scr + 64;
    if (j < FEMB) { za[j] = filt_z(l0, j); zb[j] = filt_z(l1, j); }
    asm volatile("s_waitcnt lgkmcnt(0)" ::: "memory");
    const float a = wl[MLPW_B + 192 + j];
    float s0 = wl[MLPW_B + j], s1 = s0;
#pragma unroll 11
    for (int i = 0; i < FEMB; ++i) { const float w = wl[i * 64 + j]; s0 += za[i] * w; s1 += zb[i] * w; }
    asm volatile("s_waitcnt lgkmcnt(0)" ::: "memory");
    za[j] = sinf(a * s0); zb[j] = sinf(a * s1);
    asm volatile("s_waitcnt lgkmcnt(0)" ::: "memory");
    s0 = wl[MLPW_B + 64 + j]; s1 = s0;
#pragma unroll 8
    for (int i = 0; i < FHID; ++i) { const float w = wl[MLPW_W2 + i * 64 + j]; s0 += za[i] * w; s1 += zb[i] * w; }
    asm volatile("s_waitcnt lgkmcnt(0)" ::: "memory");
    za[j] = sinf(a * s0); zb[j] = sinf(a * s1);
    asm volatile("s_waitcnt lgkmcnt(0)" ::: "memory");
    s0 = wl[MLPW_B + 128 + j]; s1 = s0;
#pragma unroll 8
    for (int i = 0; i < FHID; ++i) { const float w = wl[MLPW_W3 + i * 64 + j]; s0 += za[i] * w; s1 += zb[i] * w; }
    h3out[l0 * FHID + j] = sinf(a * s0); h3out[l1 * FHID + j] = sinf(a * s1);
    asm volatile("s_waitcnt lgkmcnt(0)" ::: "memory");
}
typedef float f32x16_t __attribute__((ext_vector_type(16)));
__device__ __forceinline__ void stage_h3_rows32(const float* h3, int row0, LAS float* scr, int lane) {
#pragma unroll
    for (int i = 0; i < 8; ++i) { const int e = 4 * (lane + 64 * i), r = e >> 6, jj = e & 63;
        if (row0 + r < 4096) { const pg8::f32x4 v = *(const pg8::f32x4*)(h3 + (size_t)(row0 + r) * 64 + jj);
            LAS float* d = scr + r * 65 + jj; d[0] = v[0]; d[1] = v[1]; d[2] = v[2]; d[3] = v[3]; } }
}
__device__ __forceinline__ void filter_tables(const float* h3, const float* w4, const float* decay, float* fsum, float* fdif, LAS float* scr, int gw, int NGW, int lane) {
    const int r = lane & 31, h = lane >> 5;
    for (int it = gw; it < 2048; it += NGW) {
        const int c0 = (it & 31) * 32, nbase = (it >> 5) * 64;
        float af[32], ab[32];
#pragma unroll
        for (int kk = 0; kk < 32; ++kk) { af[kk] = w4[(2 * kk + h) * 2048 + c0 + r]; ab[kk] = w4[(2 * kk + h) * 2048 + 1024 + c0 + r]; }
        float dcf[16], dcb[16];
#pragma unroll
        for (int q = 0; q < 16; ++q) { const int c = c0 + (q & 3) + 8 * (q >> 2) + 4 * h; dcf[q] = fabsf(decay[c]); dcb[q] = fabsf(decay[1024 + c]); }
#pragma unroll 1
        for (int half = 0; half < 2; ++half) {
            const int n0 = nbase + 32 * half, n = n0 + r, nb = n ? 4096 - n : 0;
            stage_h3_rows32(h3, n0, scr, lane);
            stage_h3_rows32(h3, 4096 - n0 - 31, scr + 32 * 65, lane);
            asm volatile("s_waitcnt lgkmcnt(0)" ::: "memory");
            f32x16_t accF, accB;
#pragma unroll
            for (int q = 0; q < 16; ++q) { accF[q] = 0.f; accB[q] = 0.f; }
#pragma unroll
            for (int kk = 0; kk < 32; ++kk) {
                const float bF = scr[r * 65 + 2 * kk + h], bB = scr[32 * 65 + (31 - r) * 65 + 2 * kk + h];
                accF = __builtin_amdgcn_mfma_f32_32x32x2f32(af[kk], bF, accF, 0, 0, 0);
                accB = __builtin_amdgcn_mfma_f32_32x32x2f32(ab[kk], bB, accB, 0, 0, 0);
            }
            const float tf = (float)n * (1.0f / 4095.0f), tb = (float)nb * (1.0f / 4095.0f);
#pragma unroll
            for (int q = 0; q < 16; ++q) { const int c = c0 + (q & 3) + 8 * (q >> 2) + 4 * h;
                const float hf = accF[q] * expf(-tf * dcf[q]);
                const float hb = n ? accB[q] * expf(-tb * dcb[q]) : 0.f;
                fsum[(size_t)c * 4096 + n] = hf + hb;
                fdif[(size_t)c * 4096 + n] = hf - hb; }
            asm volatile("s_waitcnt lgkmcnt(0)" ::: "memory");
        }
    }
}
#define RLX_AGENT __ATOMIC_RELAXED, __HIP_MEMORY_SCOPE_AGENT
#define XB_TMO      128
#define XB_XCNT(j)  (256  + 64 * (j))
#define XB_XSUB(j)  (1280 + 64 * (j))
#define XB_XGEN(j)  (2304 + 64 * (j))
#define XB_TOP      3328
#define XB_TOPGEN   3392
#define XCD_BAR_WORDS 3456
#define XB_SPIN_CAP (1u << 18)

__device__ __forceinline__ unsigned xb_ld(unsigned* p)              { return __hip_atomic_load(p, __ATOMIC_RELAXED, __HIP_MEMORY_SCOPE_AGENT); }
__device__ __forceinline__ unsigned xb_add(unsigned* p, unsigned v) { return __hip_atomic_fetch_add(p, v, __ATOMIC_RELAXED, __HIP_MEMORY_SCOPE_AGENT); }
__device__ __forceinline__ unsigned xb_xcc_id() { return (unsigned)__builtin_amdgcn_s_getreg((3 << 11) | 20) & 0xFu; }
#define XB_SPIN(cond, bar) do { unsigned _sp = 0; while (cond) { __builtin_amdgcn_s_sleep(1); \
    if ((++_sp & 255u) == 0u) { if (xb_ld(&(bar)[XB_TMO])) break; if (_sp > XB_SPIN_CAP) { atomicAdd(&(bar)[XB_TMO], 1u); break; } } } } while (0)

struct XcdBarrier {
    unsigned* bar; unsigned x;
    volatile LAS unsigned* st;
};

__device__ __forceinline__ XcdBarrier xcd_barrier_post(unsigned* bar, volatile LAS unsigned* st) {
    XcdBarrier b; b.bar = bar; b.x = xb_xcc_id(); b.st = st;
    if (threadIdx.x == 0) (void)xb_add(&bar[XB_XCNT(b.x)], 1u);
    return b;
}
__device__ __forceinline__ void xcd_barrier_complete(unsigned* bar, unsigned x, unsigned& nloc, unsigned& nx) {
    const unsigned G = gridDim.x * gridDim.y * gridDim.z;
    unsigned sum, cnt, mine, sp = 0u;
    for (;;) {
        sum = 0u; cnt = 0u; mine = 0u;
#pragma unroll
        for (unsigned j = 0; j < 16; ++j) { const unsigned c = xb_ld(&bar[XB_XCNT(j)]); sum += c; cnt += (c > 0u) ? 1u : 0u; mine = (j == x) ? c : mine; }
        if (sum == G) break;
        __builtin_amdgcn_s_sleep(1);
        if ((++sp & 255u) == 0u) { if (xb_ld(&bar[XB_TMO])) break; if (sp > XB_SPIN_CAP) { atomicAdd(&bar[XB_TMO], 1u); break; } }
    }
    nloc = mine > 0u ? mine : 1u; nx = cnt > 0u ? cnt : 1u;
}

__device__ __forceinline__ void xcd_barrier(const XcdBarrier& b) {
    asm volatile("s_waitcnt vmcnt(0)" ::: "memory");
    block_sync();
    if (threadIdx.x == 0) {
        unsigned* bar = b.bar;
        __builtin_amdgcn_s_waitcnt(0);
        unsigned nloc = b.st[0], nx = b.st[1];
        if (nloc == 0u) { xcd_barrier_complete(bar, b.x, nloc, nx); b.st[0] = nloc; b.st[1] = nx; }
        const unsigned old = xb_add(&bar[XB_XSUB(b.x)], 1u);
        const unsigned gen = old / nloc;
        if (old + 1u == (gen + 1u) * nloc) {
            __builtin_amdgcn_fence(__ATOMIC_RELEASE, "agent");
            asm volatile("s_waitcnt vmcnt(0)" ::: "memory");
            const unsigned og = xb_add(&bar[XB_TOP], 1u);
            const unsigned tg = og / nx;
            if (og + 1u == (tg + 1u) * nx) xb_add(&bar[XB_TOPGEN], 1u);
            else XB_SPIN(xb_ld(&bar[XB_TOPGEN]) == tg, bar);
            __builtin_amdgcn_fence(__ATOMIC_ACQUIRE, "agent");
            xb_add(&bar[XB_XGEN(b.x)], 1u);
            asm volatile("s_waitcnt vmcnt(0)" ::: "memory");
        } else {
            XB_SPIN(xb_ld(&bar[XB_XGEN(b.x)]) == gen, bar);
            __builtin_amdgcn_fence(__ATOMIC_ACQUIRE, "agent");
            asm volatile("s_waitcnt vmcnt(0)" ::: "memory");
        }
    }
    block_sync();
}

constexpr size_t MiB = 1u << 20;
constexpr int M = NB * L;
constexpr size_t WS_VSS = 0, WS_XSS = 64 * 1024, WS_X2SS = 128 * 1024, WS_TTAB = 192 * 1024, WS_BAR = 256 * 1024, WS_H3 = 1 * MiB;
constexpr size_t WS_WTA = 2 * MiB, WS_WTB = 10 * MiB, WS_PAB = 16 * MiB, WS_WO = 20 * MiB;
constexpr size_t WS_FSUM = 24 * MiB, WS_WUP = 24 * MiB, WS_WDN = 35 * MiB;
constexpr size_t WS_HYT = 41 * MiB;
constexpr size_t WS_X1B = 41 * MiB, WS_MRG = 105 * MiB;
constexpr size_t WS_YAB = 169 * MiB;
constexpr size_t WS_FDIF = 233 * MiB;
constexpr size_t WS_AP = 73 * MiB, WS_GP = 161 * MiB;
static_assert(WS_GP + (size_t)M * FH * 2 <= 256 * MiB && WS_AP + (size_t)M * FH * 2 <= WS_GP && WS_FDIF + 16 * MiB <= 256 * MiB && WS_WDN + (size_t)D * FH * 2 <= WS_HYT, "d_ws map");
constexpr int LDS_BYTES = 155648;
static_assert(HY_LDS_END + 256 <= LDS_BYTES, "LDS map");
constexpr int NPH = 9;

struct MegaArgs { const float* in[27]; float* out; unsigned char* ws; int ph_lo, ph_hi; WJobs wj; };

__global__ void __launch_bounds__(512, 2) __attribute__((target("no-packed-fp32-ops"))) mega_fwd(MegaArgs a) {
    extern __shared__ __attribute__((aligned(16))) unsigned char lds_raw[];
    LAS unsigned char* lds = (LAS unsigned char*)lds_raw;
    cg::grid_group grid = cg::this_grid();
    const int wave = __builtin_amdgcn_readfirstlane((int)threadIdx.x >> 6);
    const int G = gridDim.x, bid = blockIdx.x, gw = bid * 8 + wave, NGW = G * 8;
#define FRESH_TID int lane; asm volatile("v_mbcnt_lo_u32_b32 %0, -1, 0\n\tv_mbcnt_hi_u32_b32 %0, -1, %0" : "=v"(lane)); const int tid = wave * 64 + lane; (void)tid
    unsigned char* ws = a.ws;
    const float* x = a.in[0];
    float* vss = (float*)(ws + WS_VSS); float* xss = (float*)(ws + WS_XSS); float* x2ss = (float*)(ws + WS_X2SS);
    cfv* Ttab = (cfv*)(ws + WS_TTAB); float* h3 = (float*)(ws + WS_H3);
    bf16* WtA = (bf16*)(ws + WS_WTA); bf16* WtB = (bf16*)(ws + WS_WTB); bf16* PabT = (bf16*)(ws + WS_PAB); bf16* WoT = (bf16*)(ws + WS_WO);
    bf16* WupT = (bf16*)(ws + WS_WUP); bf16* WdnT = (bf16*)(ws + WS_WDN);
    float* fsum = (float*)(ws + WS_FSUM); float* fdif = (float*)(ws + WS_FDIF);
    bf16* hyvT = (bf16*)(ws + WS_HYT); bf16* yaT = hyvT + (size_t)1024 * M; bf16* vT = hyvT + (size_t)3072 * M;
    bf16* YAB = (bf16*)(ws + WS_YAB); bf16* h1 = YAB; bf16* Ub = YAB + 1024;
    bf16* Gb = (bf16*)a.out;
    bf16* mrg = (bf16*)(ws + WS_MRG); bf16* X1b = (bf16*)(ws + WS_X1B); float* X1 = a.out;
    bf16* APb = (bf16*)(ws + WS_AP); bf16* GPb = (bf16*)(ws + WS_GP);
    const int lo = a.ph_lo, hi = a.ph_hi;
#define IN(k) (lo <= (k) && (k) < hi)
    for (int u = (int)threadIdx.x; u < 16; u += 512) ((LAS unsigned*)(lds + LDS_BYTES - 256))[u] = 0u;
    block_sync();
    XcdBarrier xbar = xcd_barrier_post((unsigned*)(ws + WS_BAR), (volatile LAS unsigned*)(lds + LDS_BYTES - 256));
#ifdef MK_PROBE
#define STAMP(i) do { if (threadIdx.x == 0) ((volatile LAS unsigned long long*)(lds + LDS_BYTES - 128))[i] = __builtin_amdgcn_s_memrealtime(); } while (0)
#else
#define STAMP(i) do { } while (0)
#endif
    STAMP(0);
#define SEAM(k) do { if (IN(k) && IN((k) + 1)) xcd_barrier(xbar); STAMP((k) + 1); } while (0)
    if (a.ph_hi > NPH) grid.sync();

    if (IN(0)) { FRESH_TID;
        p0_weights(a.wj, 0, 7, (LAS float*)lds + wave * 4096, gw, NGW, lane);
        for (int m = 4 * gw; m < M; m += 4 * NGW) rms_rows4_to_bf16(x + (size_t)m * 1024, a.in[1], h1 + (size_t)m * 2048, 2048, lane);
        for (int i = bid * 512 + tid; i < 3 * M; i += G * 512) vss[i] = 0.f;
        block_sync();
        { LAS float* wl = (LAS float*)lds;
          for (int i = tid; i < MLPW_N; i += 512) { float v;
              if (i < MLPW_W2) v = a.in[5][i]; else if (i < MLPW_W3) v = a.in[7][i - MLPW_W2]; else if (i < MLPW_B) v = a.in[9][i - MLPW_W3];
              else { const int q = i - MLPW_B; v = q < 64 ? a.in[6][q] : q < 128 ? a.in[8][q - 64] : q < 192 ? a.in[10][q - 128] : a.in[11][q - 192]; }
              wl[i] = v; }
          block_sync();
          for (int l = 2 * gw; l < L; l += 2 * NGW) filter_mlp_rows2(wl, h3, (LAS float*)(lds + 65536) + wave * 128, l, l + 1, lane); }
        for (int m = bid * 512 + tid; m < 4096; m += G * 512) { const float ang = (float)m / 4096.0f; Ttab[m] = (cfv){cospif(ang), -sinpif(ang)}; }
    }
    SEAM(0);
    if (IN(1)) { FRESH_TID;
        { pg8::Gemm g{WtA, h1, 4096, M, 1024, 1024, 2048}; pg8::StaticOrder S; S.init(4096, M, G, bid);
          pg8::EpiHyT E{hyvT, M, vss};
          pg8::gemm_phase<pg8::EpiHyT, pg8::StaticOrder, true, true>(lds, g, S, E, tid); }
        STAMP(11);
        { pg8::Gemm g{h1, WtB, M, 3072, 1024, 2048, 1024}; pg8::StaticOrder S; S.init(M, 3072, G, bid);
          pg8::EpiUG E{Ub, Gb, 2048};
          pg8::gemm_phase<pg8::EpiUG, pg8::StaticOrder, true, true>(lds, g, S, E, tid); }
        STAMP(12);
        filter_tables(h3, a.in[12], a.in[13], fsum, fdif, (LAS float*)(lds + wave * 17408), gw, NGW, lane);
    }
    SEAM(1);
    if (IN(2)) { FRESH_TID;
        HyArgs H; H.hyT = hyvT; H.yaT = yaT; H.fsum = fsum; H.fdif = fdif; H.cw = a.in[3]; H.cb = a.in[4]; H.skip = a.in[14]; H.T = Ttab;
        H.TS = M; H.npairs = 2; H.off00 = 0; H.off01 = L; H.off10 = 2 * L; H.off11 = 3 * L;
        hyena_phase(lds, H, bid, G, tid, wave);
        block_sync();
        STAMP(13);
        SguArgs Sg; Sg.vT = vT; Sg.U = Ub; Sg.vss = vss; Sg.ws = a.in[16]; Sg.bs = a.in[17]; Sg.gn = a.in[15]; Sg.TS = M; Sg.ldu = 2048;
        for (int it = bid; it < (M / 128) * 8; it += G) sgu_item(lds, Sg, it, tid);
    }
    SEAM(2);
    if (IN(3)) { FRESH_TID;
        transpose_ya(yaT, M, YAB, 2048, (LAS unsigned short*)lds + wave * 8192, gw, NGW, lane);
        p0_weights(a.wj, 7, 9, (LAS float*)lds + wave * 4096, gw, NGW, lane);
    }
    SEAM(3);
    if (IN(4)) { FRESH_TID;
        pg8::Gemm g{YAB, PabT, M, 1024, 2048, 2048, 2048}; pg8::StaticOrder S; S.init(M, 1024, G, bid);
        pg8::EpiMerge E{Gb, mrg};
        pg8::gemm_phase<pg8::EpiMerge, pg8::StaticOrder, true, true>(lds, g, S, E, tid);
    }
    SEAM(4);
    if (IN(5)) { FRESH_TID;
        pg8::Gemm g{mrg, WoT, M, 1024, 1024, 1024, 1024}; pg8::StaticOrder S; S.init(M, 1024, G, bid);
        pg8::EpiResid<true> E{x, nullptr, nullptr, X1b, xss};
        pg8::gemm_phase<pg8::EpiResid<true>, pg8::StaticOrder, true, true>(lds, g, S, E, tid);
    }
    SEAM(5);
    if (IN(6)) { FRESH_TID;
        pg8::Gemm g{X1b, WupT, M, 2 * FH, 1024, 1024, 1024}; pg8::StaticOrder S; S.init(68 * 256, 2 * FH, G, bid);
        pg8::EpiUpAct E{GPb, (LAS float*)(lds + 131072), xss, a.in[23], a.in[24]};
        pg8::gemm_phase<pg8::EpiUpAct, pg8::StaticOrder, true, true>(lds, g, S, E, tid);
    }
    SEAM(6);
    if (IN(7)) { FRESH_TID;
        pg8::Gemm g{GPb, WdnT, M, 1024, FH, FH, FH}; pg8::StaticOrder S; S.init(M, 1024, G, bid);
        pg8::EpiResid<false> E{nullptr, X1b, nullptr, X1b, x2ss};
        pg8::gemm_phase<pg8::EpiResid<false>, pg8::StaticOrder, true, true>(lds, g, S, E, tid);
    }
    SEAM(7);
    if (IN(8)) { FRESH_TID; final_norm(X1b, x2ss, a.in[26], a.out, M, gw, NGW, lane); }
    STAMP(9);
#ifdef MK_PROBE
#ifndef MK_PROBE_A
#define MK_PROBE_A MK_PROBE
#define MK_PROBE_B (MK_PROBE + 1)
#endif
    if (threadIdx.x == 0) { volatile LAS unsigned long long* ts = (volatile LAS unsigned long long*)(lds + LDS_BYTES - 128);
        const unsigned long long dt = 2ull * (ts[MK_PROBE_B] - ts[MK_PROBE_A]), t0 = __builtin_amdgcn_s_memrealtime();
        while (__builtin_amdgcn_s_memrealtime() - t0 < dt) __builtin_amdgcn_s_sleep(8); }
    block_sync();
#endif
#undef IN
#undef SEAM
}
}

#ifndef MK_CUTS
#define MK_CUTS 0
#endif
extern "C" void kernel_launch(void* const* d_in, const int* in_sizes, int n_in, void* d_out, int out_size, void* d_ws, size_t ws_size, hipStream_t stream) {
    static int grid = 0;
    if (grid == 0) {
        int dev = 0, cus = 0, per_cu = 0;
        hipGetDevice(&dev);
        hipDeviceGetAttribute(&cus, hipDeviceAttributeMultiprocessorCount, dev);
        hipFuncSetAttribute((const void*)mega_fwd, hipFuncAttributeMaxDynamicSharedMemorySize, LDS_BYTES);
        hipOccupancyMaxActiveBlocksPerMultiprocessor(&per_cu, (const void*)mega_fwd, 512, LDS_BYTES);
        if (per_cu < 1) { fprintf(stderr, "kernel_launch: occupancy query says %d blocks per CU\n", per_cu); per_cu = 1; }
        grid = cus * 1;
        (void)hipGetLastError();
    }
    hipMemsetAsync((char*)d_ws + WS_BAR, 0, XCD_BAR_WORDS * 4, stream);
    MegaArgs a{};
    for (int i = 0; i < 27; ++i) a.in[i] = (const float*)d_in[i];
    a.out = (float*)d_out; a.ws = (unsigned char*)d_ws;
    { unsigned char* ws = (unsigned char*)d_ws;
      bf16* WtA = (bf16*)(ws + WS_WTA); bf16* WtB = (bf16*)(ws + WS_WTB); bf16* PabT = (bf16*)(ws + WS_PAB); bf16* WoT = (bf16*)(ws + WS_WO); bf16* WupT = (bf16*)(ws + WS_WUP); bf16* WdnT = (bf16*)(ws + WS_WDN);
    a.wj.j[0] = WJob{(const float*)d_in[2], nullptr, WtA, 1024, INW, 0, 3072, 1024, 0, 0, 0};
    a.wj.j[1] = WJob{(const float*)d_in[2], nullptr, WtA, 1024, INW, 4096, 1024, 1024, 3072, 0, 0};
    a.wj.j[2] = WJob{(const float*)d_in[2], nullptr, WtB, 1024, INW, 3072, 1024, 1024, 0, 0, 0};
    a.wj.j[3] = WJob{(const float*)d_in[2], nullptr, WtB, 1024, INW, 5120, 2048, 1024, 1024, 0, 0};
    a.wj.j[4] = WJob{(const float*)d_in[18], nullptr, PabT, 1024, 1024, 0, 1024, 2048, 0, 0, 0};
    a.wj.j[5] = WJob{(const float*)d_in[19], nullptr, PabT, 1024, 1024, 0, 1024, 2048, 0, 1024, 0};
    a.wj.j[6] = WJob{(const float*)d_in[20], nullptr, WoT, 1024, 1024, 0, 1024, 1024, 0, 0, 0};
    a.wj.j[7] = WJob{(const float*)d_in[22], (const float*)d_in[21], WupT, 1024, 2 * FH, 0, 2 * FH, 1024, 0, 0, 1};
    a.wj.j[8] = WJob{(const float*)d_in[25], nullptr, WdnT, FH, 1024, 0, 1024, FH, 0, 0, 0};

    }
#if MK_CUTS
    for (int p = 0; p < NPH; ++p) { a.ph_lo = p; a.ph_hi = p + 1; hipLaunchKernelGGL(mega_fwd, dim3(grid), dim3(512), LDS_BYTES, stream, a); }
#else
    a.ph_lo = 0; a.ph_hi = NPH;
    void* args[] = {&a};
    hipError_t e = hipLaunchCooperativeKernel((const void*)mega_fwd, dim3(grid), dim3(512), args, LDS_BYTES, stream);
    if (e != hipSuccess) fprintf(stderr, "cooperative launch failed: %s (grid %d)\n", hipGetErrorString(e), grid);
#endif
}
```

```cpp
#include <hip/hip_runtime.h>
#include <hip/hip_cooperative_groups.h>
#include <math.h>
#include <stdint.h>
#include <cstdio>
namespace cg = cooperative_groups;
namespace pg8 {
#define PG8_LAS __attribute__((address_space(3)))
typedef unsigned short bf16_t;
typedef short bf16x8 __attribute__((ext_vector_type(8)));
typedef float f32x4 __attribute__((ext_vector_type(4)));
typedef unsigned u32x4 __attribute__((ext_vector_type(4)));
constexpr int BM = 256, BK = 64, HALF = 128, HTB = HALF * BK * 2  , STAGE_BYTES = 8 * HTB, NXCD = 8, WGM = 8;

__host__ __device__ __forceinline__ int lds_byte(int r, int c) { const int st = (r >> 4) * 2 + (c >> 5), rr = r & 15, cc = c & 31, ob = rr * 64 + cc * 2; return st * 1024 + (ob ^ (((ob >> 9) & 1) << 5)); }
__host__ __device__ __forceinline__ void stage_rc(int b, int& R, int& C) { const int st = b / 1024, sb = b % 1024, swz = sb ^ (((sb >> 9) & 1) << 5); R = (st >> 1) * 16 + swz / 64; C = (st & 1) * 32 + (swz % 64) / 2; }
__host__ __device__ __forceinline__ int perm32(int rho) { const int n = rho >> 4, i = rho & 15; return 8 * (i >> 2) + 4 * n + (i & 3); }

struct Unit { int pm, pn; };
__host__ __device__ __forceinline__ int ovl_row(int pm) { const int seq = pm / 17, i = pm % 17; int s = 254 * i - 1; s = s < 0 ? 0 : (s > 3840 ? 3840 : s); return seq * 4096 + s; }
struct Gemm { const bf16_t* A; const bf16_t* Bt; int M, N, K, lda, ldb; };

struct StaticOrder {
    int nM, nN, nwg, G, c;
    __host__ __device__ __forceinline__ void init(int M, int N, int G_, int c_) { nM = M / BM; nN = N / BM; nwg = nM * nN; G = G_; c = c_; }
    __host__ __device__ __forceinline__ bool next(int i, Unit& u) const {
        const long L = (long)i * G + c; if (L >= nwg) return false;
        int wgid = (int)L; { const int q = nwg / NXCD, r = nwg % NXCD, xcd = wgid % NXCD, off = wgid / NXCD; wgid = (xcd < r ? xcd * (q + 1) : r * (q + 1) + (xcd - r) * q) + off; }
        const int nig = WGM * nN, gid = wgid / nig, fm = gid * WGM, gsz = (nM - fm) < WGM ? (nM - fm) : WGM;
        u.pm = fm + ((wgid % nig) % gsz); u.pn = (wgid % nig) / gsz; return true;
    }
    __device__ __forceinline__ void a_ready(const Unit&) const {}
    __device__ __forceinline__ void done(const Unit&) const {}
};

__device__ __forceinline__ unsigned cvt_pk_bf16(float lo, float hi) { unsigned r; asm volatile("v_cvt_pk_bf16_f32 %0, %1, %2" : "=v"(r) : "v"(lo), "v"(hi)); return r; }
typedef float f32x2 __attribute__((ext_vector_type(2)));
__device__ __forceinline__ f32x2 gelu_pk(f32x2 v) {
    const f32x2 av = __builtin_elementwise_abs(v), d = av * 0.2316418882f + 1.0f;
    f32x2 t; t.x = __builtin_amdgcn_rcpf(d.x); t.y = __builtin_amdgcn_rcpf(d.y);
    f32x2 q = t * 0.5307027145f + (-0.7265760135f); q = q * t + 0.7107068705f; q = q * t + (-0.142248368f); q = q * t + 0.127414796f; q = q * t;
    const f32x2 s = (v * v) * (-0.72134752044f);
    f32x2 e; e.x = __builtin_amdgcn_exp2f(s.x); e.y = __builtin_amdgcn_exp2f(s.y);
    const f32x2 m = v * (q * e), r = v - m;
    f32x2 o; o.x = v.x < 0.f ? m.x : r.x; o.y = v.y < 0.f ? m.y : r.y; return o;
}

template <int ACT  > struct EpiBf16 {
    static constexpr bool PERM = true, AFTER_DRAIN = false, MID = false, OVL = false; static_assert(ACT == 0 || ACT == 1, "EpiBf16: ACT is 0 (none) or 1 (gelu_pk)");
    bf16_t* O; int ldc; const float* bias; int split_cols; size_t split_stride; float scale0;
    __device__ __forceinline__ void operator()(const f32x4 (&acc)[2][2][4][2], const Unit& u, int wr, int wc, int fr, int fq) const {
        const int row0 = u.pm * BM + wr * 64 + fr; int colt = u.pn * BM; bf16_t* base = O;
        float sc = 1.f; if (split_cols) { const int t = colt / split_cols; base += (size_t)t * split_stride; colt -= t * split_cols; if (t == 0) sc = scale0; }
        const int col0 = colt + wc * 32 + 8 * fq, bcol0 = u.pn * BM + wc * 32 + 8 * fq;
        f32x4 bv[2][2];
#pragma unroll
        for (int bj = 0; bj < 2; ++bj)
#pragma unroll
            for (int n = 0; n < 2; ++n) bv[bj][n] = bias ? *(const f32x4*)(bias + bcol0 + bj * HALF + 4 * n) : (f32x4){0.f, 0.f, 0.f, 0.f};
#pragma unroll
        for (int ai = 0; ai < 2; ++ai)
#pragma unroll
            for (int m = 0; m < 4; ++m) { bf16_t* rowp = base + (size_t)(row0 + ai * HALF + m * 16) * ldc + col0;
#pragma unroll
                for (int bj = 0; bj < 2; ++bj) { f32x4 v0 = acc[ai][bj][m][0] + bv[bj][0], v1 = acc[ai][bj][m][1] + bv[bj][1];
                    if (ACT == 1) { f32x2 a = gelu_pk((f32x2){v0[0], v0[1]}), b = gelu_pk((f32x2){v0[2], v0[3]}), c = gelu_pk((f32x2){v1[0], v1[1]}), d = gelu_pk((f32x2){v1[2], v1[3]});
                        v0 = (f32x4){a.x, a.y, b.x, b.y}; v1 = (f32x4){c.x, c.y, d.x, d.y}; }
                    v0 = v0 * sc; v1 = v1 * sc; u32x4 w; w.x = cvt_pk_bf16(v0[0], v0[1]); w.y = cvt_pk_bf16(v0[2], v0[3]); w.z = cvt_pk_bf16(v1[0], v1[1]); w.w = cvt_pk_bf16(v1[2], v1[3]);
                    *(u32x4*)(rowp + bj * HALF) = w; } }
    }
};

struct EpiF32 {
    static constexpr bool PERM = false, AFTER_DRAIN = false, MID = false, OVL = false;
    float* C; int ldc; const float* bias;
    __device__ __forceinline__ void operator()(const f32x4 (&acc)[2][2][4][2], const Unit& u, int wr, int wc, int fr, int fq) const {
        const int row0 = u.pm * BM + wr * 64 + fr, col0 = u.pn * BM + wc * 32 + 4 * fq;
        f32x4 bv[2][2];
#pragma unroll
        for (int bj = 0; bj < 2; ++bj)
#pragma unroll
            for (int n = 0; n < 2; ++n) bv[bj][n] = bias ? *(const f32x4*)(bias + col0 + bj * HALF + n * 16) : (f32x4){0.f, 0.f, 0.f, 0.f};
#pragma unroll
        for (int ai = 0; ai < 2; ++ai)
#pragma unroll
            for (int m = 0; m < 4; ++m) { float* rowp = C + (size_t)(row0 + ai * HALF + m * 16) * ldc + col0;
#pragma unroll
                for (int bj = 0; bj < 2; ++bj)
#pragma unroll
                    for (int n = 0; n < 2; ++n) *(f32x4*)(rowp + bj * HALF + n * 16) = acc[ai][bj][m][n] + bv[bj][n]; }
    }
};

template <class Epi, class Sched, bool ALIGN_EPI = false, bool SP2 = false>
__device__ __forceinline__ void gemm_phase(PG8_LAS unsigned char* lds, const Gemm g, const Sched& S, const Epi& E, const int tid) {
    const int wid = __builtin_amdgcn_readfirstlane(tid >> 6), lane = tid & 63, wr = wid >> 2, wc = wid & 3, fr = lane & 15, fq = lane >> 4;
    const int K = g.K, nt = K / BK;
    unsigned voffA[2], voffB[2];
#pragma unroll
    for (int i = 0; i < 2; ++i) { int R, C; stage_rc(tid * 16 + i * 8192, R, C); const int Rb = Epi::PERM ? ((R & ~31) + perm32(R & 31)) : R;
        voffA[i] = (unsigned)(R * g.lda + C) * 2u; voffB[i] = (unsigned)(Rb * g.ldb + C) * 2u; }
    const size_t kstep = (size_t)(BK * 2);
    const size_t hstepA = (size_t)HALF * g.lda * 2, hstepB = (size_t)HALF * g.ldb * 2;
    const size_t tstepA = 2 * hstepA, tstepB = 2 * hstepB;
    const unsigned ldsw = (unsigned)wid * 1024u;
    const int aoff = lds_byte(wr * 64 + fr, fq * 8), boff = lds_byte(wc * 32 + fr, fq * 8);
#define PG8_SA(b, h) (((b) * 2 + (h)) * HTB)
#define PG8_SB(b, h) ((4 + (b) * 2 + (h)) * HTB)
#define PG8_STAGE(bufoff, gbase, voff) do { _Pragma("unroll") for (int _i = 0; _i < 2; ++_i) \
        __builtin_amdgcn_global_load_lds((const unsigned*)((const char*)(gbase) + (voff)[_i]), (PG8_LAS unsigned*)(lds + (bufoff) + ldsw + _i * 8192), 16, 0, 0); } while (0)
#define PG8_LDA(dst, b, h) do { _Pragma("unroll") for (int m = 0; m < 4; ++m) _Pragma("unroll") for (int k = 0; k < 2; ++k) dst[m][k] = *(const PG8_LAS bf16x8*)(lds + PG8_SA(b, h) + aoff + m * 2048 + k * 1024); } while (0)
#define PG8_LDB(dst, b, h) do { _Pragma("unroll") for (int n = 0; n < 2; ++n) _Pragma("unroll") for (int k = 0; k < 2; ++k) dst[n][k] = *(const PG8_LAS bf16x8*)(lds + PG8_SB(b, h) + boff + n * 2048 + k * 1024); } while (0)
#define PG8_MMA(ai, bj, At, Bt) do { __builtin_amdgcn_s_setprio(1); _Pragma("unroll") for (int m = 0; m < 4; ++m) _Pragma("unroll") for (int n = 0; n < 2; ++n) _Pragma("unroll") for (int k = 0; k < 2; ++k) \
        acc[ai][bj][m][n] = __builtin_amdgcn_mfma_f32_16x16x32_bf16(Bt[n][k], At[m][k], acc[ai][bj][m][n], 0, 0, 0); __builtin_amdgcn_s_setprio(0); } while (0)
#define PG8_WAIT_V(n) asm volatile("s_waitcnt vmcnt(" #n ")" ::: "memory")
#define PG8_WAIT_L(n) asm volatile("s_waitcnt lgkmcnt(" #n ")" ::: "memory")
#define PG8_BAR __builtin_amdgcn_s_barrier()
#define PG8_SCHED __builtin_amdgcn_sched_barrier(0)
    Unit cur, nxt; int ui = 0;
    if (!S.next(0, cur)) return;
    f32x4 acc[2][2][4][2];
#pragma unroll
    for (int a = 0; a < 2; ++a)
#pragma unroll
        for (int b = 0; b < 2; ++b)
#pragma unroll
            for (int m = 0; m < 4; ++m)
#pragma unroll
                for (int n = 0; n < 2; ++n) acc[a][b][m][n] = (f32x4){0.f, 0.f, 0.f, 0.f};
    bf16x8 At[4][2], B0[2][2], B1[2][2];
    const char* cA = (const char*)g.A + (size_t)(Epi::OVL ? ovl_row(cur.pm) : cur.pm * BM) * (tstepA / BM); const char* cB = (const char*)g.Bt + (size_t)cur.pn * tstepB;
    S.a_ready(cur);
    if constexpr (SP2) {
        PG8_STAGE(PG8_SB(0, 0), cB, voffB); PG8_STAGE(PG8_SB(0, 1), cB + hstepB, voffB); PG8_STAGE(PG8_SA(0, 0), cA, voffA); PG8_STAGE(PG8_SA(0, 1), cA + hstepA, voffA);
        if (wr == 1) PG8_BAR;
        PG8_WAIT_V(2); PG8_BAR;
        PG8_STAGE(PG8_SB(1, 0), cB + kstep, voffB); PG8_STAGE(PG8_SA(1, 0), cA + kstep, voffA); PG8_STAGE(PG8_SB(1, 1), cB + hstepB + kstep, voffB);
        PG8_WAIT_V(6); PG8_BAR;
    } else {
        PG8_STAGE(PG8_SB(0, 0), cB, voffB); PG8_STAGE(PG8_SA(0, 0), cA, voffA); PG8_STAGE(PG8_SB(0, 1), cB + hstepB, voffB); PG8_STAGE(PG8_SA(0, 1), cA + hstepA, voffA);
        if (wr == 1) PG8_BAR;
        PG8_WAIT_V(4); PG8_BAR;
        PG8_STAGE(PG8_SB(1, 0), cB + kstep, voffB); PG8_STAGE(PG8_SA(1, 0), cA + kstep, voffA); PG8_STAGE(PG8_SB(1, 1), cB + hstepB + kstep, voffB);
        PG8_WAIT_V(6); PG8_BAR;
    }
    for (;;) {
        const bool has_next = S.next(ui + 1, nxt);
        const char* nA = has_next ? (const char*)g.A + (size_t)(Epi::OVL ? ovl_row(nxt.pm) : nxt.pm * BM) * (tstepA / BM) : cA; const char* nB = has_next ? (const char*)g.Bt + (size_t)nxt.pn * tstepB : cB;
        for (int t = 0; t < nt; t += 2) {
            const bool last = (t == nt - 2);
            const char* a1 = cA + (size_t)(t + 1) * kstep;
            const char* a2 = last ? nA : cA + (size_t)(t + 2) * kstep; const char* b2 = last ? nB : cB + (size_t)(t + 2) * kstep;
            const char* a3 = a2 + kstep; const char* b3 = b2 + kstep;
            if (last && has_next) S.a_ready(nxt);
            if constexpr (Epi::MID) { if (t == (nt >> 1)) E.mid(acc, cur, wr, wc, fr, fq); }
            if constexpr (SP2) {
            PG8_LDB(B0, 0, 0); PG8_LDB(B1, 0, 1); PG8_SCHED; PG8_LDA(At, 0, 0); PG8_STAGE(PG8_SA(1, 1), a1 + hstepA, voffA);
            PG8_WAIT_V(8); PG8_WAIT_L(0); PG8_BAR; PG8_MMA(0, 0, At, B0); PG8_MMA(0, 1, At, B1); PG8_BAR; PG8_SCHED;
            PG8_LDA(At, 0, 1); PG8_STAGE(PG8_SB(0, 0), b2, voffB); PG8_STAGE(PG8_SB(0, 1), b2 + hstepB, voffB); PG8_STAGE(PG8_SA(0, 0), a2, voffA);
            PG8_WAIT_V(8); PG8_WAIT_L(0); PG8_BAR; PG8_MMA(1, 0, At, B0); PG8_MMA(1, 1, At, B1); PG8_BAR; PG8_SCHED;
            PG8_LDB(B0, 1, 0); PG8_LDB(B1, 1, 1); PG8_SCHED; PG8_LDA(At, 1, 0); PG8_STAGE(PG8_SA(0, 1), a2 + hstepA, voffA);
            PG8_WAIT_V(8); PG8_WAIT_L(0); PG8_BAR; PG8_MMA(0, 0, At, B0); PG8_MMA(0, 1, At, B1); PG8_BAR; PG8_SCHED;
            PG8_LDA(At, 1, 1); PG8_STAGE(PG8_SB(1, 0), b3, voffB); PG8_STAGE(PG8_SB(1, 1), b3 + hstepB, voffB); PG8_STAGE(PG8_SA(1, 0), a3, voffA);
            PG8_WAIT_V(8); PG8_WAIT_L(0); PG8_BAR; PG8_MMA(1, 0, At, B0); PG8_MMA(1, 1, At, B1); PG8_BAR; PG8_SCHED;
            } else {
            PG8_LDB(B0, 0, 0); PG8_SCHED; PG8_LDA(At, 0, 0); PG8_STAGE(PG8_SA(1, 1), a1 + hstepA, voffA);
            PG8_WAIT_L(8); PG8_BAR; PG8_WAIT_L(0); PG8_MMA(0, 0, At, B0); PG8_BAR; PG8_SCHED;
            PG8_LDB(B1, 0, 1); PG8_STAGE(PG8_SB(0, 0), b2, voffB);
            PG8_BAR; PG8_WAIT_L(0); PG8_MMA(0, 1, At, B1); PG8_BAR;
            PG8_LDA(At, 0, 1); PG8_STAGE(PG8_SA(0, 0), a2, voffA);
            PG8_BAR; PG8_WAIT_L(0); PG8_MMA(1, 0, At, B0); PG8_BAR; PG8_SCHED;
            PG8_STAGE(PG8_SB(0, 1), b2 + hstepB, voffB);
            PG8_WAIT_V(6); PG8_BAR; PG8_MMA(1, 1, At, B1); PG8_BAR;
            PG8_LDB(B0, 1, 0); PG8_SCHED; PG8_LDA(At, 1, 0); PG8_STAGE(PG8_SA(0, 1), a2 + hstepA, voffA);
            PG8_WAIT_L(8); PG8_BAR; PG8_WAIT_L(0); PG8_MMA(0, 0, At, B0); PG8_BAR; PG8_SCHED;
            PG8_LDB(B1, 1, 1); PG8_STAGE(PG8_SB(1, 0), b3, voffB);
            PG8_BAR; PG8_WAIT_L(0); PG8_MMA(0, 1, At, B1); PG8_BAR;
            PG8_LDA(At, 1, 1); PG8_STAGE(PG8_SA(1, 0), a3, voffA);
            PG8_BAR; PG8_WAIT_L(0); PG8_MMA(1, 0, At, B0); PG8_BAR; PG8_SCHED;
            PG8_STAGE(PG8_SB(1, 1), b3 + hstepB, voffB);
            PG8_WAIT_V(6); PG8_BAR; PG8_MMA(1, 1, At, B1); PG8_BAR;
            }
        }
        if constexpr (ALIGN_EPI) { if (wr == 0) PG8_BAR; }
        if constexpr (!Epi::AFTER_DRAIN) { E(acc, cur, wr, wc, fr, fq); S.done(cur); }
        if (!has_next) break;
#pragma unroll
        for (int a = 0; a < 2; ++a)
#pragma unroll
            for (int b = 0; b < 2; ++b)
#pragma unroll
                for (int m = 0; m < 4; ++m)
#pragma unroll
                    for (int n = 0; n < 2; ++n) acc[a][b][m][n] = (f32x4){0.f, 0.f, 0.f, 0.f};
        cur = nxt; cA = nA; cB = nB; ++ui;
        if constexpr (ALIGN_EPI) { if (wr == 1) PG8_BAR; }
    }
    PG8_WAIT_V(0);
    if constexpr (!ALIGN_EPI) { if (wr == 0) PG8_BAR; }
    PG8_BAR;
    if constexpr (Epi::AFTER_DRAIN) { E.fused(acc, cur, wr, wc, fr, fq, lds, wid, lane); S.done(cur); }
#undef PG8_SA
#undef PG8_SB
#undef PG8_STAGE
#undef PG8_LDA
#undef PG8_LDB
#undef PG8_MMA
#undef PG8_WAIT_V
#undef PG8_WAIT_L
#undef PG8_BAR
#undef PG8_SCHED
}
}
namespace {
constexpr int D = 1024, NB = 4, L = 4096, HW = 1024, SW = 1024, INW = 7168, FH = 2816, FHID = 64, FEMB = 33;
constexpr float EPS = 1e-6f;
typedef unsigned short bf16;
__device__ __forceinline__ unsigned f2bf(float f) { unsigned u = __builtin_bit_cast(unsigned, f); return (u + 0x7fffu + ((u >> 16) & 1u)) >> 16; }
__device__ __forceinline__ void block_sync() { __builtin_amdgcn_fence(__ATOMIC_RELEASE, "workgroup"); __builtin_amdgcn_s_barrier(); __builtin_amdgcn_fence(__ATOMIC_ACQUIRE, "workgroup"); }
}
namespace {
#define HD __device__ __forceinline__
#define FFT_OPAQUE(w) asm volatile("" : "+v"((w).x), "+v"((w).y))
#ifndef HD
#define HD inline
#endif
typedef float cfv __attribute__((ext_vector_type(2)));
struct cf { float x, y; };
HD cf cmk(float x, float y) { cf r; r.x = x; r.y = y; return r; }
template <class P> HD cf ldz(P Z, int i) { const cfv t = Z[i]; return cmk(t.x, t.y); }
template <class P> HD void stz(P Z, int i, cf v) { Z[i] = (cfv){v.x, v.y}; }
HD cf cadd(cf a, cf b) { return cmk(a.x + b.x, a.y + b.y); }
HD cf csub(cf a, cf b) { return cmk(a.x - b.x, a.y - b.y); }
HD cf cmul(cf a, cf b) { return cmk(a.x * b.x - a.y * b.y, a.x * b.y + a.y * b.x); }
HD cf cconj(cf a) { return cmk(a.x, -a.y); }
template <bool INV> HD cf mulmi(cf a) { return INV ? cmk(-a.y, a.x) : cmk(a.y, -a.x); }
template <bool INV> HD cf twc(float c, float s) { return INV ? cmk(c, s) : cmk(c, -s); }
HD int fpad(int p) { return p + (p >> 4); }
constexpr int FSUB = 4352;

template <bool INV> HD void dft4(cf& a, cf& b, cf& c, cf& d) {
    const cf t0 = cadd(a, c), t1 = csub(a, c), t2 = cadd(b, d), t3 = mulmi<INV>(csub(b, d));
    a = cadd(t0, t2); b = cadd(t1, t3); c = csub(t0, t2); d = csub(t1, t3);
}
template <bool INV> HD void dft16(cf (&v)[16]) {
    constexpr float C1 = 0.92387953251128674f, S1 = 0.38268343236508977f, R = 0.70710678118654752f;
#pragma unroll
    for (int n0 = 0; n0 < 4; ++n0) dft4<INV>(v[n0], v[n0 + 4], v[n0 + 8], v[n0 + 12]);
    v[1 + 4 * 1] = cmul(v[1 + 4 * 1], twc<INV>(C1, S1));
    v[1 + 4 * 2] = cmul(v[1 + 4 * 2], twc<INV>(R, R));
    v[1 + 4 * 3] = cmul(v[1 + 4 * 3], twc<INV>(S1, C1));
    v[2 + 4 * 1] = cmul(v[2 + 4 * 1], twc<INV>(R, R));
    v[2 + 4 * 2] = mulmi<INV>(v[2 + 4 * 2]);
    v[2 + 4 * 3] = cmul(v[2 + 4 * 3], twc<INV>(-R, R));
    v[3 + 4 * 1] = cmul(v[3 + 4 * 1], twc<INV>(S1, C1));
    v[3 + 4 * 2] = cmul(v[3 + 4 * 2], twc<INV>(-R, R));
    v[3 + 4 * 3] = cmul(v[3 + 4 * 3], twc<INV>(-C1, -S1));
#pragma unroll
    for (int k0 = 0; k0 < 4; ++k0) dft4<INV>(v[4 * k0], v[4 * k0 + 1], v[4 * k0 + 2], v[4 * k0 + 3]);
    cf t;
    t = v[1]; v[1] = v[4]; v[4] = t;   t = v[2]; v[2] = v[8]; v[8] = t;   t = v[3]; v[3] = v[12]; v[12] = t;
    t = v[6]; v[6] = v[9]; v[9] = t;   t = v[7]; v[7] = v[13]; v[13] = t; t = v[11]; v[11] = v[14]; v[14] = t;
}
#ifndef FFT_OPAQUE
#define FFT_OPAQUE(w)
#endif
HD void twiddle16(cf (&v)[16], cf w) {
    FFT_OPAQUE(w);
    cf p = w;
#pragma unroll
    for (int k = 1; k < 16; ++k) { v[k] = cmul(v[k], p); if (k < 15) p = cmul(p, w); }
}
template <class P> HD void fwd_pass1(P Z, int t, cf w1) {
    cf v[16]; const int b = t + (t >> 4);
#pragma unroll
    for (int j = 0; j < 16; ++j) v[j] = ldz(Z, b + 272 * j);
    dft16<false>(v); twiddle16(v, w1);
#pragma unroll
    for (int j = 0; j < 16; ++j) stz(Z, b + 272 * j, v[j]);
}
template <class P> HD void fwd_pass2(P Z, int t, cf w2) {
    const int b = 272 * (t >> 4) + (t & 15);
    cf v[16];
#pragma unroll
    for (int j = 0; j < 16; ++j) v[j] = ldz(Z, b + 17 * j);
    dft16<false>(v); twiddle16(v, w2);
#pragma unroll
    for (int j = 0; j < 16; ++j) stz(Z, b + 17 * j, v[j]);
}
template <class P> HD void fwd_pass3_load(P Z, int t, cf (&v)[16]) {
#pragma unroll
    for (int j = 0; j < 16; ++j) v[j] = ldz(Z, 17 * t + j);
    dft16<false>(v);
}
template <class P> HD void inv_pass1_store(P Z, int t, cf (&v)[16]) {
    dft16<true>(v);
#pragma unroll
    for (int j = 0; j < 16; ++j) stz(Z, 17 * t + j, v[j]);
}
template <class P> HD void inv_pass2(P Z, int t, cf w2) {
    const int b = 272 * (t >> 4) + (t & 15);
    cf v[16];
#pragma unroll
    for (int j = 0; j < 16; ++j) v[j] = ldz(Z, b + 17 * j);
    twiddle16(v, cconj(w2)); dft16<true>(v);
#pragma unroll
    for (int j = 0; j < 16; ++j) stz(Z, b + 17 * j, v[j]);
}
template <class P> HD void inv_pass3(P Z, int t, cf w1) {
    cf v[16]; const int b = t + (t >> 4);
#pragma unroll
    for (int j = 0; j < 16; ++j) v[j] = ldz(Z, b + 272 * j);
    twiddle16(v, cconj(w1)); dft16<true>(v);
#pragma unroll
    for (int j = 0; j < 16; ++j) stz(Z, b + 272 * j, v[j]);
}
#define LAS __attribute__((address_space(3)))
typedef LAS cfv* lcf;
struct HyArgs {
    const bf16* hyT;
    bf16* yaT;
    const float* fsum;
    const float* fdif;
    const float* cw;
    const float* cb;
    const float* skip;
    const cfv* T;
    int TS, npairs, off00, off01, off10, off11;
};
__device__ __forceinline__ float bf2f(unsigned h) { return __builtin_bit_cast(float, h << 16); }
constexpr int HOFF_SX1 = 2 * FSUB * 8, HOFF_SV = HOFF_SX1 + 16384, HOFF_SX0 = HOFF_SV + 16384, HOFF_SF = HOFF_SX0 + 16384, HY_LDS_END = HOFF_SF + 32768;
#define HBAR() do { asm volatile("s_waitcnt lgkmcnt(0)" ::: "memory"); __builtin_amdgcn_s_barrier(); asm volatile("" ::: "memory"); } while (0)
#define HDMA_WAIT() asm volatile("s_waitcnt vmcnt(0)" ::: "memory")
#define WAVE_FENCE() asm volatile("s_waitcnt lgkmcnt(0)" ::: "memory")
__device__ __forceinline__ void hdma16(const void* gp, LAS unsigned char* wave_dst) { __builtin_amdgcn_global_load_lds((const unsigned*)gp, (LAS unsigned*)wave_dst, 16, 0, 0); }
__device__ __forceinline__ void conv8s(const LAS unsigned char* S, int tid, float w0, float w1, float w2, float b, float (&o)[8]) {
    const pg8::u32x4 q = *(const LAS pg8::u32x4*)(S + 16 * tid);
    const unsigned lft = *(const LAS unsigned short*)(S + (tid > 0 ? 16 * tid - 2 : 0)), rgt = *(const LAS unsigned short*)(S + (tid < 511 ? 16 * tid + 16 : 8190));
    float x[10];
    x[0] = tid > 0 ? bf2f(lft) : 0.f; x[9] = tid < 511 ? bf2f(rgt) : 0.f;
    x[1] = bf2f(q.x & 0xffffu); x[2] = bf2f(q.x >> 16); x[3] = bf2f(q.y & 0xffffu); x[4] = bf2f(q.y >> 16);
    x[5] = bf2f(q.z & 0xffffu); x[6] = bf2f(q.z >> 16); x[7] = bf2f(q.w & 0xffffu); x[8] = bf2f(q.w >> 16);
#pragma unroll
    for (int i = 0; i < 8; ++i) o[i] = b + w0 * x[i] + w1 * x[i + 1] + w2 * x[i + 2];
}
__device__ __forceinline__ pg8::u32x4 pack8(const float (&x)[8], const float (&y)[8]) {
    pg8::u32x4 w;
    w.x = f2bf(x[0] * y[0]) | (f2bf(x[1] * y[1]) << 16); w.y = f2bf(x[2] * y[2]) | (f2bf(x[3] * y[3]) << 16);
    w.z = f2bf(x[4] * y[4]) | (f2bf(x[5] * y[5]) << 16); w.w = f2bf(x[6] * y[6]) | (f2bf(x[7] * y[7]) << 16);
    return w;
}
__device__ __forceinline__ void hyena_phase(LAS unsigned char* lds, const HyArgs& A, int first, int stride, const int tid, const int wave) {
    lcf Z = (lcf)lds;
    const int s = tid >> 8, t = tid & 255, pb = 8 * tid + (tid >> 1);
    const cf w1 = ldz(A.T, 2 * t), w2 = ldz(A.T, 32 * (t & 15)), wp = ldz(A.T, 8 * tid);
    lcf Zs = Z + s * FSUB;
    LAS unsigned char* wdst = lds + wave * 1024;
    constexpr float W8C[8] = {1.0f, 0.99999970586f, 0.99999882345f, 0.99999735277f, 0.99999529381f, 0.99999264659f, 0.99998941108f, 0.99998558731f};
    constexpr float W8S[8] = {0.0f, 0.00076699031874f, 0.0015339801863f, 0.0023009691514f, 0.0030679567630f, 0.0038349425697f, 0.0046019261204f, 0.0053689069640f};
    if (first >= 1024) return;
#define ISSUE_PAIR(cc, oa, ob) do { \
        hdma16(A.hyT + (size_t)(1024 + (cc)) * A.TS + (oa) + 8 * tid, wdst + HOFF_SX1); hdma16(A.hyT + (size_t)(1024 + (cc)) * A.TS + (ob) + 8 * tid, wdst + HOFF_SX1 + 8192); \
        hdma16(A.hyT + (size_t)(2048 + (cc)) * A.TS + (oa) + 8 * tid, wdst + HOFF_SV);  hdma16(A.hyT + (size_t)(2048 + (cc)) * A.TS + (ob) + 8 * tid, wdst + HOFF_SV + 8192); } while (0)
#define ISSUE_X0(cc, oa, ob) do { hdma16(A.hyT + (size_t)(cc) * A.TS + (oa) + 8 * tid, wdst + HOFF_SX0); hdma16(A.hyT + (size_t)(cc) * A.TS + (ob) + 8 * tid, wdst + HOFF_SX0 + 8192); } while (0)
#define ISSUE_FILT(cc) do { \
        hdma16(A.fsum + (size_t)(cc) * 4096 + 8 * tid, wdst + HOFF_SF); hdma16(A.fsum + (size_t)(cc) * 4096 + 8 * tid + 4, wdst + HOFF_SF + 8192); \
        hdma16(A.fdif + (size_t)(cc) * 4096 + 8 * tid, wdst + HOFF_SF + 16384); hdma16(A.fdif + (size_t)(cc) * 4096 + 8 * tid + 4, wdst + HOFF_SF + 24576); } while (0)
    ISSUE_FILT(first); ISSUE_PAIR(first, A.off00, A.off01);
    for (int c = first; c < 1024; c += stride) {
        const int cn = c + stride;
        const float sk = A.skip[c];
        const float cx0 = A.cw[c], cx1 = A.cw[3072 + c], cx2 = A.cw[6144 + c], cxb = A.cb[c];
        const float ca0 = A.cw[1024 + c], ca1 = A.cw[3072 + 1024 + c], ca2 = A.cw[6144 + 1024 + c], cab = A.cb[1024 + c];
        const float cv0 = A.cw[2048 + c], cv1 = A.cw[3072 + 2048 + c], cv2 = A.cw[6144 + 2048 + c], cvb = A.cb[2048 + c];
        cf Kr[16];
        HDMA_WAIT();
        {
            const pg8::f32x4 s0 = *(const LAS pg8::f32x4*)(lds + HOFF_SF + 16 * tid), s1 = *(const LAS pg8::f32x4*)(lds + HOFF_SF + 8192 + 16 * tid);
            const pg8::f32x4 d0 = *(const LAS pg8::f32x4*)(lds + HOFF_SF + 16384 + 16 * tid), d1 = *(const LAS pg8::f32x4*)(lds + HOFF_SF + 24576 + 16 * tid);
            const float fs[8] = {s0[0], s0[1], s0[2], s0[3], s1[0], s1[1], s1[2], s1[3]}, fd[8] = {d0[0], d0[1], d0[2], d0[3], d1[0], d1[1], d1[2], d1[3]};
#pragma unroll
            for (int i = 0; i < 8; ++i) { cf wq = wp; FFT_OPAQUE(wq); const cf tw = cmul(wq, cmk(W8C[i], -W8S[i])); stz(Z, pb + i, cmk(fs[i], 0.f)); stz(Z, FSUB + pb + i, cmk(fd[i] * tw.x, fd[i] * tw.y)); }
        }
        HBAR();
        fwd_pass1(Zs, t, w1); HBAR();
        fwd_pass2(Zs, t, w2); WAVE_FENCE();
        fwd_pass3_load(Zs, t, Kr);
#pragma unroll
        for (int j = 0; j < 16; ++j) { Kr[j].x *= (1.0f / 8192.0f); Kr[j].y *= (1.0f / 8192.0f); }
        HBAR();
        for (int p = 0; p < A.npairs; ++p) {
            const int o0 = p ? A.off10 : A.off00, o1 = p ? A.off11 : A.off01;
            float u0[8], u1[8];
            {
                float a[8], b[8];
                conv8s(lds + HOFF_SX1, tid, ca0, ca1, ca2, cab, a); conv8s(lds + HOFF_SV, tid, cv0, cv1, cv2, cvb, b);
#pragma unroll
                for (int i = 0; i < 8; ++i) u0[i] = a[i] * b[i];
                conv8s(lds + HOFF_SX1 + 8192, tid, ca0, ca1, ca2, cab, a); conv8s(lds + HOFF_SV + 8192, tid, cv0, cv1, cv2, cvb, b);
#pragma unroll
                for (int i = 0; i < 8; ++i) u1[i] = a[i] * b[i];
            }
#pragma unroll
            for (int i = 0; i < 8; ++i) { cf wq = wp; FFT_OPAQUE(wq); const cf tw = cmul(wq, cmk(W8C[i], -W8S[i])); const cf z = cmk(u0[i], u1[i]); stz(Z, pb + i, z); stz(Z, FSUB + pb + i, cmul(z, tw)); }
            HBAR();
            ISSUE_X0(c, o0, o1);
            if (p + 1 < A.npairs) ISSUE_PAIR(c, A.off10, A.off11);
            else if (cn < 1024) { ISSUE_PAIR(cn, A.off00, A.off01); ISSUE_FILT(cn); }
            fwd_pass1(Zs, t, w1); HBAR();
            fwd_pass2(Zs, t, w2); WAVE_FENCE();
            {
                cf v[16];
                fwd_pass3_load(Zs, t, v);
#pragma unroll
                for (int j = 0; j < 16; ++j) v[j] = cmul(v[j], Kr[j]);
                inv_pass1_store(Zs, t, v);
            }
            WAVE_FENCE();
            inv_pass2(Zs, t, w2); HBAR();
            inv_pass3(Zs, t, w1);
            HDMA_WAIT(); HBAR();
            {
                float y0[8], y1[8];
#pragma unroll
                for (int i = 0; i < 8; ++i) { cf wq = wp; FFT_OPAQUE(wq); const cf tw = cmul(wq, cmk(W8C[i], -W8S[i])); const cf e = ldz(Z, pb + i), o = ldz(Z, FSUB + pb + i); const cf y = cadd(e, cmul(o, cconj(tw))); y0[i] = y.x + sk * u0[i]; y1[i] = y.y + sk * u1[i]; }
                float x0c[8];
                conv8s(lds + HOFF_SX0, tid, cx0, cx1, cx2, cxb, x0c);
                *(pg8::u32x4*)(A.yaT + (size_t)c * A.TS + o0 + 8 * tid) = pack8(x0c, y0);
                if (o1 != o0) { conv8s(lds + HOFF_SX0 + 8192, tid, cx0, cx1, cx2, cxb, x0c); *(pg8::u32x4*)(A.yaT + (size_t)c * A.TS + o1 + 8 * tid) = pack8(x0c, y1); }
            }
        }
    }
    HDMA_WAIT(); HBAR();
#undef ISSUE_PAIR
#undef ISSUE_X0
#undef ISSUE_FILT
}
}
namespace pg8 {
__device__ __forceinline__ f32x2 sigmoid_pk(f32x2 v) {
    f32x2 e; e.x = __builtin_amdgcn_exp2f(v.x * -1.4426950408889634f); e.y = __builtin_amdgcn_exp2f(v.y * -1.4426950408889634f);
    f32x2 o; o.x = __builtin_amdgcn_rcpf(1.0f + e.x); o.y = __builtin_amdgcn_rcpf(1.0f + e.y); return o;
}
struct EpiHyT {
    static constexpr bool PERM = true, AFTER_DRAIN = false, MID = false, OVL = false;
    bf16_t* O; int ldc; float* vss;
    __device__ __forceinline__ void operator()(const f32x4 (&acc)[2][2][4][2], const Unit& u, int wr, int wc, int fr, int fq) const {
        const int row0 = u.pm * BM + wr * 64 + fr, col0 = u.pn * BM + wc * 32 + 8 * fq;
        const bool isv = u.pm >= 12;
        f32x4 ss[2][2];
#pragma unroll
        for (int bj = 0; bj < 2; ++bj)
#pragma unroll
            for (int n = 0; n < 2; ++n) ss[bj][n] = (f32x4){0.f, 0.f, 0.f, 0.f};
#pragma unroll
        for (int ai = 0; ai < 2; ++ai)
#pragma unroll
            for (int m = 0; m < 4; ++m) { bf16_t* rowp = O + (size_t)(row0 + ai * HALF + m * 16) * ldc + col0;
#pragma unroll
                for (int bj = 0; bj < 2; ++bj) { f32x4 v0 = acc[ai][bj][m][0], v1 = acc[ai][bj][m][1];
                    if (isv) { f32x2 a = gelu_pk((f32x2){v0[0], v0[1]}), b = gelu_pk((f32x2){v0[2], v0[3]}), c = gelu_pk((f32x2){v1[0], v1[1]}), d = gelu_pk((f32x2){v1[2], v1[3]});
                        v0 = (f32x4){a.x, a.y, b.x, b.y}; v1 = (f32x4){c.x, c.y, d.x, d.y}; ss[bj][0] += v0 * v0; ss[bj][1] += v1 * v1; }
                    u32x4 w; w.x = cvt_pk_bf16(v0[0], v0[1]); w.y = cvt_pk_bf16(v0[2], v0[3]); w.z = cvt_pk_bf16(v1[0], v1[1]); w.w = cvt_pk_bf16(v1[2], v1[3]);
                    *(u32x4*)(rowp + bj * HALF) = w; } }
        if (isv) {
#pragma unroll
            for (int bj = 0; bj < 2; ++bj)
#pragma unroll
                for (int n = 0; n < 2; ++n)
#pragma unroll
                    for (int j = 0; j < 4; ++j) { float s = ss[bj][n][j]; s += __shfl_xor(s, 1); s += __shfl_xor(s, 2); s += __shfl_xor(s, 4); s += __shfl_xor(s, 8);
                        if (fr == 0) atomicAdd(vss + col0 + bj * HALF + 4 * n + j, s); }
        }
    }
};
struct EpiUG {
    static constexpr bool PERM = true, AFTER_DRAIN = false, MID = false, OVL = false;
    bf16_t* U; bf16_t* G; int ldu;
    __device__ __forceinline__ void operator()(const f32x4 (&acc)[2][2][4][2], const Unit& u, int wr, int wc, int fr, int fq) const {
        const int row0 = u.pm * BM + wr * 64 + fr; int colt = u.pn * BM; const bool isu = colt < 1024;
        bf16_t* base = isu ? U : G; const int ldc = isu ? ldu : 2048; if (!isu) colt -= 1024;
        const int col0 = colt + wc * 32 + 8 * fq;
#pragma unroll
        for (int ai = 0; ai < 2; ++ai)
#pragma unroll
            for (int m = 0; m < 4; ++m) { bf16_t* rowp = base + (size_t)(row0 + ai * HALF + m * 16) * ldc + col0;
#pragma unroll
                for (int bj = 0; bj < 2; ++bj) { f32x4 v0 = acc[ai][bj][m][0], v1 = acc[ai][bj][m][1];
                    f32x2 a, b, c, d;
                    if (isu) { a = gelu_pk((f32x2){v0[0], v0[1]}); b = gelu_pk((f32x2){v0[2], v0[3]}); c = gelu_pk((f32x2){v1[0], v1[1]}); d = gelu_pk((f32x2){v1[2], v1[3]}); }
                    else { a = sigmoid_pk((f32x2){v0[0], v0[1]}); b = sigmoid_pk((f32x2){v0[2], v0[3]}); c = sigmoid_pk((f32x2){v1[0], v1[1]}); d = sigmoid_pk((f32x2){v1[2], v1[3]}); }
                    u32x4 w; w.x = cvt_pk_bf16(a.x, a.y); w.y = cvt_pk_bf16(b.x, b.y); w.z = cvt_pk_bf16(c.x, c.y); w.w = cvt_pk_bf16(d.x, d.y);
                    *(u32x4*)(rowp + bj * HALF) = w; } }
    }
};
}
namespace {
struct WJob { const float* W; const float* g; bf16* dst; int K, N, c0, nc, ldd, r0, koff, perm; };
constexpr int NWJ = 9;
struct WJobs { WJob j[NWJ]; };
__device__ __forceinline__ unsigned pk2(float lo, float hi) { return f2bf(lo) | (f2bf(hi) << 16); }
__device__ __forceinline__ void wT_item(const WJob& J, LAS float* scr, int item, int lane) {
    const int nblk = J.nc / 32, kb = item / nblk, nb = item % nblk, k0 = 64 * kb, n0 = 32 * nb;
    float v[32];
#pragma unroll
    for (int i = 0; i < 32; ++i) v[i] = J.W[(size_t)(k0 + 2 * i + (lane >> 5)) * J.N + J.c0 + n0 + (lane & 31)];
    if (J.g) {
#pragma unroll
        for (int i = 0; i < 32; ++i) v[i] *= J.g[k0 + 2 * i + (lane >> 5)]; }
#pragma unroll
    for (int i = 0; i < 32; ++i) scr[(2 * i + (lane >> 5)) * 33 + (lane & 31)] = v[i];
    asm volatile("s_waitcnt lgkmcnt(0)" ::: "memory");
    const int c = lane & 7; int rb = n0;
    if (J.perm) { const int half = n0 >= 2816, cc = n0 - half * 2816; rb = 256 * (cc >> 7) + 128 * half + (cc & 127); }
#pragma unroll
    for (int j = 0; j < 4; ++j) { const int n = (lane >> 3) + 8 * j; const LAS float* s = scr + (8 * c) * 33 + n;
        uint4 o; o.x = pk2(s[0 * 33], s[1 * 33]); o.y = pk2(s[2 * 33], s[3 * 33]); o.z = pk2(s[4 * 33], s[5 * 33]); o.w = pk2(s[6 * 33], s[7 * 33]);
        *(uint4*)(J.dst + (size_t)(J.r0 + rb + n) * J.ldd + J.koff + k0 + 8 * c) = o; }
    asm volatile("s_waitcnt lgkmcnt(0)" ::: "memory");
}
__device__ __forceinline__ void p0_weights(const WJobs& WJ, int jlo, int jhi, LAS float* scr, int gw, int NGW, int lane) {
    int base = 0;
    for (int q = jlo; q < jhi; ++q) {
        const WJob& J = WJ.j[q]; const int ni = (J.K / 64) * (J.nc / 32);
        int it = gw - (base % NGW); if (it < 0) it += NGW;
        for (; it < ni; it += NGW) wT_item(J, scr, it, lane);
        base += ni;
    }
}
__device__ __forceinline__ float wave_sum(float v) {
#pragma unroll
    for (int o = 1; o < 64; o <<= 1) v += __shfl_xor(v, o);
    return v;
}
__device__ __forceinline__ void rms_row_to_bf16(const float* xrow, const float* g, bf16* orow, int lane) {
    const float4* xr = (const float4*)xrow + lane; const float4* gr = (const float4*)g + lane;
    float4 v[4]; float s = 0.f;
#pragma unroll
    for (int j = 0; j < 4; ++j) { v[j] = xr[64 * j]; s += (v[j].x * v[j].x + v[j].y * v[j].y) + (v[j].z * v[j].z + v[j].w * v[j].w); }
    const float r = rsqrtf(wave_sum(s) * (1.f / 1024.f) + EPS);
    unsigned long long* o8 = (unsigned long long*)orow + lane;
#pragma unroll
    for (int j = 0; j < 4; ++j) { const float4 gg = gr[64 * j];
        o8[64 * j] = (unsigned long long)pk2(v[j].x * r * gg.x, v[j].y * r * gg.y) | ((unsigned long long)pk2(v[j].z * r * gg.z, v[j].w * r * gg.w) << 32); }
}
__device__ __forceinline__ void rms_rows4_to_bf16(const float* xrow, const float* g, bf16* orow, int ldo, int lane) {
    float4 v[4][4]; float s[4];
#pragma unroll
    for (int r = 0; r < 4; ++r)
#pragma unroll
        for (int j = 0; j < 4; ++j) v[r][j] = ((const float4*)(xrow + (size_t)r * 1024) + lane)[64 * j];
#pragma unroll
    for (int r = 0; r < 4; ++r) { s[r] = 0.f;
#pragma unroll
        for (int j = 0; j < 4; ++j) s[r] += (v[r][j].x * v[r][j].x + v[r][j].y * v[r][j].y) + (v[r][j].z * v[r][j].z + v[r][j].w * v[r][j].w); }
#pragma unroll
    for (int r = 0; r < 4; ++r) { const float rr = rsqrtf(wave_sum(s[r]) * (1.f / 1024.f) + EPS);
        unsigned long long* o8 = (unsigned long long*)(orow + (size_t)r * ldo) + lane;
#pragma unroll
        for (int j = 0; j < 4; ++j) { const float4 gg = ((const float4*)g + lane)[64 * j];
            o8[64 * j] = (unsigned long long)pk2(v[r][j].x * rr * gg.x, v[r][j].y * rr * gg.y) | ((unsigned long long)pk2(v[r][j].z * rr * gg.z, v[r][j].w * rr * gg.w) << 32); } }
}
}

namespace {
struct SguArgs {
    const bf16* vT;
    bf16* U;
    const float* vss;
    const float* ws;
    const float* bs;
    const float* gn;
    int TS, ldu;
};
typedef short bf16x8_t __attribute__((ext_vector_type(8)));
typedef float f32x4_t __attribute__((ext_vector_type(4)));
#define SBAR() do { asm volatile("s_waitcnt lgkmcnt(0)" ::: "memory"); __builtin_amdgcn_s_barrier(); asm volatile("" ::: "memory"); } while (0)
__device__ __forceinline__ void sgu_phase(LAS unsigned char* lds, const SguArgs& A, int first, int stride, const int tid, const int wave) {
    const int nitems = (A.TS / 128) * 8;
    if (first >= nitems) return;
    const int lane = tid & 63, fr = lane & 15, fq = lane >> 4, p = 16 * wave + fr;
    LAS float* rtab = (LAS float*)(lds + 131072);
    LAS float* gnl = (LAS float*)(lds + 131072 + 4096);
#define SGU_ISSUE(item, buf) do { const int g_ = (item) & 7, tok0_ = ((item) >> 3) * 128; \
        _Pragma("unroll") for (int i_ = 0; i_ < 4; ++i_) { const int r_ = (i_ * 8 + wave) * 4 + (lane >> 4), c_ = (lane & 15) ^ (r_ & 15); \
            __builtin_amdgcn_global_load_lds((const unsigned*)(A.vT + (size_t)(g_ * 128 + r_) * A.TS + tok0_ + 8 * c_), (LAS unsigned*)(lds + (buf) * 65536 + (i_ * 8 + wave) * 1024), 16, 0, 0); \
            __builtin_amdgcn_global_load_lds((const unsigned*)(A.U + (size_t)(tok0_ + r_) * A.ldu + g_ * 128 + 8 * c_), (LAS unsigned*)(lds + (buf) * 65536 + 32768 + (i_ * 8 + wave) * 1024), 16, 0, 0); } } while (0)
    SGU_ISSUE(first, 0);
    int gcur = -1; float wf[4][8]; float bsp = 0.f;
    for (int e = tid; e < 1024; e += 512) { const int k = e >> 7, it = first + k * stride;
        if (it < nitems) rtab[e] = rsqrtf(A.vss[(it >> 3) * 128 + (e & 127)] * (1.f / 1024.f) + EPS); }
    int k = 0;
    for (int it = first; it < nitems; it += stride, ++k) {
        const int g = it & 7, tok0 = (it >> 3) * 128, buf = k & 1;
        if (g != gcur) {
            gcur = g;
#pragma unroll
            for (int kk = 0; kk < 4; ++kk) { const float4 w0 = *(const float4*)(A.ws + ((size_t)g * 128 + p) * 128 + 32 * kk + 8 * fq), w1 = *(const float4*)(A.ws + ((size_t)g * 128 + p) * 128 + 32 * kk + 8 * fq + 4);
                wf[kk][0] = w0.x; wf[kk][1] = w0.y; wf[kk][2] = w0.z; wf[kk][3] = w0.w; wf[kk][4] = w1.x; wf[kk][5] = w1.y; wf[kk][6] = w1.z; wf[kk][7] = w1.w; }
            bsp = A.bs[g * 128 + p];
            SBAR();
            if (tid < 128) gnl[tid] = A.gn[g * 128 + tid];
        }
        asm volatile("s_waitcnt vmcnt(0)" ::: "memory"); SBAR();
        if (it + stride < nitems) SGU_ISSUE(it + stride, buf ^ 1);
        const LAS unsigned char* BT = lds + buf * 65536; const LAS unsigned char* UT = BT + 32768;
        bf16x8_t af[4];
#pragma unroll
        for (int kk = 0; kk < 4; ++kk) { const f32x4_t r0 = *(const LAS f32x4_t*)(rtab + k * 128 + 32 * kk + 8 * fq), r1 = *(const LAS f32x4_t*)(rtab + k * 128 + 32 * kk + 8 * fq + 4);
            uint4 o; o.x = pk2(wf[kk][0] * r0[0], wf[kk][1] * r0[1]); o.y = pk2(wf[kk][2] * r0[2], wf[kk][3] * r0[3]); o.z = pk2(wf[kk][4] * r1[0], wf[kk][5] * r1[1]); o.w = pk2(wf[kk][6] * r1[2], wf[kk][7] * r1[3]);
            af[kk] = __builtin_bit_cast(bf16x8_t, o); }
        f32x4_t acc[8];
#pragma unroll
        for (int nt = 0; nt < 8; ++nt) acc[nt] = (f32x4_t){0.f, 0.f, 0.f, 0.f};
#pragma unroll
        for (int kk = 0; kk < 4; ++kk) {
            bf16x8_t bfr[8];
#pragma unroll
            for (int nt = 0; nt < 8; ++nt) bfr[nt] = *(const LAS bf16x8_t*)(BT + (16 * nt + fr) * 256 + 16 * ((4 * kk + fq) ^ fr));
#pragma unroll
            for (int nt = 0; nt < 8; ++nt) acc[nt] = __builtin_amdgcn_mfma_f32_16x16x32_bf16(bfr[nt], af[kk], acc[nt], 0, 0, 0);
        }
        bf16* urow = A.U + (size_t)(tok0 + p) * A.ldu + g * 128 + 4 * fq;
#pragma unroll
        for (int nt = 0; nt < 8; ++nt) {
            typedef unsigned u32x2_t __attribute__((ext_vector_type(2)));
            const u32x2_t uu = *(const LAS u32x2_t*)(UT + p * 256 + 16 * ((2 * nt + (fq >> 1)) ^ fr) + 8 * (fq & 1));
            const f32x4_t gv = *(const LAS f32x4_t*)(gnl + 16 * nt + 4 * fq);
            const float y0 = bf2f(uu.x & 0xffffu) * (gv[0] * acc[nt][0] + bsp), y1 = bf2f(uu.x >> 16) * (gv[1] * acc[nt][1] + bsp);
            const float y2 = bf2f(uu.y & 0xffffu) * (gv[2] * acc[nt][2] + bsp), y3 = bf2f(uu.y >> 16) * (gv[3] * acc[nt][3] + bsp);
            uint2 o; o.x = pk2(y0, y1); o.y = pk2(y2, y3);
            *(uint2*)(urow + 16 * nt) = o;
        }
    }
    asm volatile("s_waitcnt vmcnt(0)" ::: "memory"); SBAR();
#undef SGU_ISSUE
}
}

namespace pg8 {
__device__ __forceinline__ void bf8_to_f32(const u32x4 q, f32x4& lo, f32x4& hi) {
    lo = (f32x4){__builtin_bit_cast(float, q.x << 16), __builtin_bit_cast(float, q.x & 0xffff0000u), __builtin_bit_cast(float, q.y << 16), __builtin_bit_cast(float, q.y & 0xffff0000u)};
    hi = (f32x4){__builtin_bit_cast(float, q.z << 16), __builtin_bit_cast(float, q.z & 0xffff0000u), __builtin_bit_cast(float, q.w << 16), __builtin_bit_cast(float, q.w & 0xffff0000u)};
}
struct EpiMerge {
    static constexpr bool PERM = true, AFTER_DRAIN = false, MID = true, OVL = false;
    const bf16_t* G; bf16_t* O;
    __device__ __forceinline__ void mid(f32x4 (&acc)[2][2][4][2], const Unit& u, int wr, int wc, int fr, int fq) const {
        unsigned off0 = (unsigned)(u.pm * BM + wr * 64 + fr) * 2048u + (unsigned)(u.pn * BM + wc * 32 + 8 * fq);
        asm volatile("" : "+v"(off0));
#pragma unroll
        for (int ai = 0; ai < 2; ++ai)
#pragma unroll
            for (int m = 0; m < 4; ++m)
#pragma unroll
                for (int bj = 0; bj < 2; ++bj) { const bf16_t* gp = G + (off0 + (unsigned)((ai * HALF + m * 16) * 2048 + bj * HALF));
                    const u32x4 qa = *(const u32x4*)gp, qb = *(const u32x4*)(gp + 1024);
                    f32x4 a0, a1, b0, b1; bf8_to_f32(qa, a0, a1); bf8_to_f32(qb, b0, b1);
#pragma unroll
                    for (int j = 0; j < 4; ++j) { acc[ai][bj][m][0][j] *= a0[j] * __builtin_amdgcn_rcpf(b0[j]); acc[ai][bj][m][1][j] *= a1[j] * __builtin_amdgcn_rcpf(b1[j]); }
                    asm volatile("" ::: "memory"); }
    }
    __device__ __forceinline__ void operator()(const f32x4 (&acc)[2][2][4][2], const Unit& u, int wr, int wc, int fr, int fq) const {
        const int row0 = u.pm * BM + wr * 64 + fr, col0 = u.pn * BM + wc * 32 + 8 * fq;
#pragma unroll
        for (int ai = 0; ai < 2; ++ai)
#pragma unroll
            for (int m = 0; m < 4; ++m) { const size_t r = (size_t)(row0 + ai * HALF + m * 16);
#pragma unroll
                for (int bj = 0; bj < 2; ++bj) { f32x4 b0, b1; bf8_to_f32(*(const u32x4*)(G + r * 2048 + 1024 + col0 + bj * HALF), b0, b1);
                    const f32x4 v0 = acc[ai][bj][m][0] * b0, v1 = acc[ai][bj][m][1] * b1;
                    u32x4 w; w.x = cvt_pk_bf16(v0[0], v0[1]); w.y = cvt_pk_bf16(v0[2], v0[3]); w.z = cvt_pk_bf16(v1[0], v1[1]); w.w = cvt_pk_bf16(v1[2], v1[3]);
                    *(u32x4*)(O + r * 1024 + col0 + bj * HALF) = w; } }
    }
};
}
namespace {
__device__ __forceinline__ void tr64_item(const bf16* yaT, int TS, bf16* out, int ldo, LAS unsigned short* scr, int c0, int t0, int lane) {
#pragma unroll
    for (int i = 0; i < 8; ++i) { const int r = 8 * i + (lane >> 3), ch = lane & 7;
        const pg8::u32x4 q = *(const pg8::u32x4*)(yaT + (size_t)(c0 + r) * TS + t0 + 8 * ch);
        LAS unsigned short* d = scr + (8 * ch) * 72 + r;
        d[0 * 72] = (unsigned short)(q.x & 0xffffu); d[1 * 72] = (unsigned short)(q.x >> 16); d[2 * 72] = (unsigned short)(q.y & 0xffffu); d[3 * 72] = (unsigned short)(q.y >> 16);
        d[4 * 72] = (unsigned short)(q.z & 0xffffu); d[5 * 72] = (unsigned short)(q.z >> 16); d[6 * 72] = (unsigned short)(q.w & 0xffffu); d[7 * 72] = (unsigned short)(q.w >> 16); }
    asm volatile("s_waitcnt lgkmcnt(0)" ::: "memory");
#pragma unroll
    for (int i = 0; i < 8; ++i) { const int tk = 8 * i + (lane >> 3), ch = lane & 7;
        const pg8::u32x4 q = *(const LAS pg8::u32x4*)(scr + tk * 72 + 8 * ch);
        *(pg8::u32x4*)(out + (size_t)(t0 + tk) * ldo + c0 + 8 * ch) = q; }
    asm volatile("s_waitcnt lgkmcnt(0)" ::: "memory");
}
__device__ __forceinline__ void transpose_ya(const bf16* yaT, int TS, bf16* out, int ldo, LAS unsigned short* scr, int gw, int NGW, int lane) {
    const int ntt = TS / 64, nit = 16 * ntt;
    for (int it = gw; it < nit; it += NGW) tr64_item(yaT, TS, out, ldo, scr, 64 * (it / ntt), 64 * (it % ntt), lane);
}
}

namespace pg8 {
template <bool FIRST> struct EpiResid {
    static constexpr bool PERM = false, AFTER_DRAIN = false, MID = false, OVL = false;
    const float* X; const bf16_t* XB; float* X1; bf16_t* X1b; float* xss;
    __device__ __forceinline__ void operator()(const f32x4 (&acc)[2][2][4][2], const Unit& u, int wr, int wc, int fr, int fq) const {
        const int row0 = u.pm * BM + wr * 64 + fr, col0 = u.pn * BM + wc * 32 + 4 * fq;
        typedef unsigned u32x2v __attribute__((ext_vector_type(2)));
#pragma unroll
        for (int ai = 0; ai < 2; ++ai)
#pragma unroll
            for (int m = 0; m < 4; ++m) { const size_t r = (size_t)(row0 + ai * HALF + m * 16); float s = 0.f;
#pragma unroll
                for (int bj = 0; bj < 2; ++bj)
#pragma unroll
                    for (int n = 0; n < 2; ++n) { const size_t o = r * 1024 + col0 + bj * HALF + n * 16;
                        f32x4 v;
                        if (FIRST) v = acc[ai][bj][m][n] + *(const f32x4*)(X + o);
                        else { const u32x2v q = *(const u32x2v*)(XB + o);
                               v = acc[ai][bj][m][n] + (f32x4){__builtin_bit_cast(float, q.x << 16), __builtin_bit_cast(float, q.x & 0xffff0000u), __builtin_bit_cast(float, q.y << 16), __builtin_bit_cast(float, q.y & 0xffff0000u)}; }
                        { u32x2v w; w.x = cvt_pk_bf16(v[0], v[1]); w.y = cvt_pk_bf16(v[2], v[3]); *(u32x2v*)(X1b + o) = w; }
                        s += (v[0] * v[0] + v[1] * v[1]) + (v[2] * v[2] + v[3] * v[3]); }
                s += __shfl_xor(s, 16); s += __shfl_xor(s, 32);
                if (fq == 0) atomicAdd(xss + r, s);
                asm volatile("" ::: "memory"); }
    }
};
__device__ __forceinline__ float dpp_ror1(float v) { return __builtin_bit_cast(float, __builtin_amdgcn_update_dpp(0, __builtin_bit_cast(int, v), 0x121, 0xf, 0xf, false)); }
__device__ __forceinline__ float dpp_rol1(float v) { return __builtin_bit_cast(float, __builtin_amdgcn_update_dpp(0, __builtin_bit_cast(int, v), 0x12f, 0xf, 0xf, false)); }
struct EpiUpAct {
    static constexpr bool PERM = true, AFTER_DRAIN = false, MID = false, OVL = true;
    bf16_t* ACT; PG8_LAS float* XB; const float* xss; const float* cw; const float* cb;
    __device__ __forceinline__ void operator()(f32x4 (&acc)[2][2][4][2], const Unit& u, int wr, int wc, int fr_, int fq_) const {
        int lane_; asm volatile("v_mbcnt_lo_u32_b32 %0, -1, 0\n\tv_mbcnt_hi_u32_b32 %0, -1, %0" : "=v"(lane_));
        const int fr = lane_ & 15, fq = lane_ >> 4; (void)fr_; (void)fq_;
        const int seq = u.pm / 17, ti = u.pm % 17, rowbase = ovl_row(u.pm);
        const int own_lo = seq * 4096 + 254 * ti, own_hi = seq * 4096 + (254 * ti + 254 < 4096 ? 254 * ti + 254 : 4096);
        const int lr0 = wr * 64 + fr, cl = 32 * wc + 8 * fq;
#pragma unroll
        for (int ai = 0; ai < 2; ++ai)
#pragma unroll
            for (int m = 0; m < 4; ++m) { const float rs = rsqrtf(xss[rowbase + lr0 + ai * HALF + m * 16] * (1.0f / 1024.0f) + 1e-6f);
#pragma unroll
                for (int bj = 0; bj < 2; ++bj) { acc[ai][bj][m][0] *= rs; acc[ai][bj][m][1] *= rs; }
                __builtin_amdgcn_sched_barrier(0); }
        const bool e0 = fr == 0, e15 = fr == 15;
        const int slot = e0 ? 0 : (e15 ? 512 : 1024);
#pragma unroll
        for (int ai = 0; ai < 2; ++ai) { const int B = 2 * ai + wr;
            f32x4 p0, p1;
#pragma unroll
            for (int j = 0; j < 4; ++j) { p0[j] = e15 ? acc[ai][0][3][0][j] : acc[ai][0][0][0][j]; p1[j] = e15 ? acc[ai][0][3][1][j] : acc[ai][0][0][1][j]; }
            *(PG8_LAS f32x4*)(XB + slot + B * 128 + cl) = p0; *(PG8_LAS f32x4*)(XB + slot + B * 128 + cl + 4) = p1; }
        asm volatile("s_waitcnt lgkmcnt(0)" ::: "memory"); __builtin_amdgcn_s_barrier(); asm volatile("" ::: "memory");
        const int ch = 128 * u.pn + cl;
        typedef unsigned u32x2v __attribute__((ext_vector_type(2)));
#pragma unroll
        for (int ai = 0; ai < 2; ++ai) { const int B = 2 * ai + wr;
#pragma unroll
            for (int n = 0; n < 2; ++n) {
                const f32x4 w0 = *(const f32x4*)(cw + ch + 4 * n), w1 = *(const f32x4*)(cw + 2816 + ch + 4 * n), w2 = *(const f32x4*)(cw + 5632 + ch + 4 * n), bb = *(const f32x4*)(cb + ch + 4 * n);
                f32x4 pb = *(const PG8_LAS f32x4*)(XB + 512 + (B > 0 ? B - 1 : 0) * 128 + cl + 4 * n), nb = *(const PG8_LAS f32x4*)(XB + (B < 3 ? B + 1 : 3) * 128 + cl + 4 * n);
                if (B == 0) pb = (f32x4){0.f, 0.f, 0.f, 0.f};
                if (B == 3) nb = (f32x4){0.f, 0.f, 0.f, 0.f};
                float o[4][4];
#pragma unroll
                for (int j = 0; j < 4; ++j) {
                    float av[4], rr[4], ll[4];
#pragma unroll
                    for (int m = 0; m < 4; ++m) { av[m] = acc[ai][0][m][n][j]; rr[m] = dpp_ror1(av[m]); ll[m] = dpp_rol1(av[m]); }
#pragma unroll
                    for (int m = 0; m < 4; ++m) { const float pv = e0 ? (m > 0 ? rr[m - 1] : pb[j]) : rr[m], nv = e15 ? (m < 3 ? ll[m + 1] : nb[j]) : ll[m];
                        const float sv = bb[j] + w0[j] * pv + w1[j] * av[m] + w2[j] * nv;
                        o[m][j] = sv * __builtin_amdgcn_rcpf(1.0f + __builtin_amdgcn_exp2f(sv * -1.4426950408889634f)) * acc[ai][1][m][n][j]; }
                }
#pragma unroll
                for (int m = 0; m < 4; ++m) { const int tok = rowbase + lr0 + ai * HALF + m * 16;
                    if (tok >= own_lo && tok < own_hi) { u32x2v w; w.x = cvt_pk_bf16(o[m][0], o[m][1]); w.y = cvt_pk_bf16(o[m][2], o[m][3]); *(u32x2v*)(ACT + (size_t)tok * 2816 + ch + 4 * n) = w; } }
                __builtin_amdgcn_sched_barrier(0);
            } }
    }
};
}
namespace {
__device__ __forceinline__ void final_norm(const bf16* X2, const float* ss, const float* g, float* out, int TS, int gw, int NGW, int lane) {
    pg8::f32x4 g0[2], g1[2];
#pragma unroll
    for (int j = 0; j < 2; ++j) { g0[j] = *((const pg8::f32x4*)g + 2 * lane + 128 * j); g1[j] = *((const pg8::f32x4*)g + 2 * lane + 128 * j + 1); }
    for (int t = 2 * gw; t < TS; t += 2 * NGW) {
        pg8::u32x4 q[2][2]; float r[2];
#pragma unroll
        for (int k = 0; k < 2; ++k) { r[k] = rsqrtf(ss[t + k] * (1.0f / 1024.0f) + EPS);
#pragma unroll
            for (int j = 0; j < 2; ++j) q[k][j] = *((const pg8::u32x4*)(X2 + (size_t)(t + k) * 1024) + lane + 64 * j); }
#pragma unroll
        for (int k = 0; k < 2; ++k)
#pragma unroll
            for (int j = 0; j < 2; ++j) { pg8::f32x4 lo, hi; pg8::bf8_to_f32(q[k][j], lo, hi);
                pg8::f32x4* o = (pg8::f32x4*)(out + (size_t)(t + k) * 1024) + 2 * lane + 128 * j;
                o[0] = lo * g0[j] * r[k]; o[1] = hi * g1[j] * r[k]; }
    }
}
}

namespace {
constexpr int MLPW_W2 = 33 * 64, MLPW_W3 = MLPW_W2 + 4096, MLPW_B = MLPW_W3 + 4096, MLPW_N = MLPW_B + 256;
__device__ __forceinline__ float filt_z(int l, int j) {
    if (j == 0) return (float)((double)l / (double)(L - 1));
    const int i = (j - 1) & 15;
    const double band = 1e-4 + (double)i * ((15.0 - 1e-4) / 15.0);
    double rev = (double)l * band / (double)L;
    rev -= floor(rev);
    const float ang = (float)(rev * 6.283185307179586);
    return (j <= 16) ? cosf(ang) : -sinf(ang);
}
__device__ __forceinline__ void filter_mlp_rows2(const LAS float* wl, float* h3out, LAS float* scr, int l0, int l1, int j) {
    LAS float* za = scr; LAS float* zb = scr + 64;
    if (j < FEMB) { za[j] = filt_z(l0, j); zb[j] = filt_z(l1, j); }
    asm volatile("s_waitcnt lgkmcnt(0)" ::: "memory");
    const float a = wl[MLPW_B + 192 + j];
    float s0 = wl[MLPW_B + j], s1 = s0;
#pragma unroll 11
    for (int i = 0; i < FEMB; ++i) { const float w = wl[i * 64 + j]; s0 += za[i] * w; s1 += zb[i] * w; }
    asm volatile("s_waitcnt lgkmcnt(0)" ::: "memory");
    za[j] = sinf(a * s0); zb[j] = sinf(a * s1);
    asm volatile("s_waitcnt lgkmcnt(0)" ::: "memory");
    s0 = wl[MLPW_B + 64 + j]; s1 = s0;
#pragma unroll 8
    for (int i = 0; i < FHID; ++i) { const float w = wl[MLPW_W2 + i * 64 + j]; s0 += za[i] * w; s1 += zb[i] * w; }
    asm volatile("s_waitcnt lgkmcnt(0)" ::: "memory");
    za[j] = sinf(a * s0); zb[j] = sinf(a * s1);
    asm volatile("s_waitcnt lgkmcnt(0)" ::: "memory");
    s0 = wl[MLPW_B + 128 + j]; s1 = s0;
#pragma unroll 8
    for (int i = 0; i < FHID; ++i) { const float w = wl[MLPW_W3 + i * 64 + j]; s0 += za[i] * w; s1 += zb[i] * w; }
    h3out[l0 * FHID + j] = sinf(a * s0); h3out[l1 * FHID + j] = sinf(a * s1);
    asm volatile("s_waitcnt lgkmcnt(0)" ::: "memory");
}
typedef float f32x16_t __attribute__((ext_vector_type(16)));
__device__ __forceinline__ void stage_h3_rows32(const float* h3, int row0, LAS float* scr, int lane) {
#pragma unroll
    for (int i = 0; i < 8; ++i) { const int e = 4 * (lane + 64 * i), r = e >> 6, jj = e & 63;
        if (row0 + r < 4096) { const pg8::f32x4 v = *(const pg8::f32x4*)(h3 + (size_t)(row0 + r) * 64 + jj);
            LAS float* d = scr + r * 65 + jj; d[0] = v[0]; d[1] = v[1]; d[2] = v[2]; d[3] = v[3]; } }
}
__device__ __forceinline__ void filter_tables(const float* h3, const float* w4, const float* decay, float* fsum, float* fdif, LAS float* scr, int gw, int NGW, int lane) {
    const int r = lane & 31, h = lane >> 5;
    for (int it = gw; it < 2048; it += NGW) {
        const int c0 = (it & 31) * 32, nbase = (it >> 5) * 64;
        float af[32], ab[32];
#pragma unroll
        for (int kk = 0; kk < 32; ++kk) { af[kk] = w4[(2 * kk + h) * 2048 + c0 + r]; ab[kk] = w4[(2 * kk + h) * 2048 + 1024 + c0 + r]; }
        float dcf[16], dcb[16];
#pragma unroll
        for (int q = 0; q < 16; ++q) { const int c = c0 + (q & 3) + 8 * (q >> 2) + 4 * h; dcf[q] = fabsf(decay[c]); dcb[q] = fabsf(decay[1024 + c]); }
#pragma unroll 1
        for (int half = 0; half < 2; ++half) {
            const int n0 = nbase + 32 * half, n = n0 + r, nb = n ? 4096 - n : 0;
            stage_h3_rows32(h3, n0, scr, lane);
            stage_h3_rows32(h3, 4096 - n0 - 31, scr + 32 * 65, lane);
            asm volatile("s_waitcnt lgkmcnt(0)" ::: "memory");
            f32x16_t accF, accB;
#pragma unroll
            for (int q = 0; q < 16; ++q) { accF[q] = 0.f; accB[q] = 0.f; }
#pragma unroll
            for (int kk = 0; kk < 32; ++kk) {
                const float bF = scr[r * 65 + 2 * kk + h], bB = scr[32 * 65 + (31 - r) * 65 + 2 * kk + h];
                accF = __builtin_amdgcn_mfma_f32_32x32x2f32(af[kk], bF, accF, 0, 0, 0);
                accB = __builtin_amdgcn_mfma_f32_32x32x2f32(ab[kk], bB, accB, 0, 0, 0);
            }
            const float tf = (float)n * (1.0f / 4095.0f), tb = (float)nb * (1.0f / 4095.0f);
#pragma unroll
            for (int q = 0; q < 16; ++q) { const int c = c0 + (q & 3) + 8 * (q >> 2) + 4 * h;
                const float hf = accF[q] * expf(-tf * dcf[q]);
                const float hb = n ? accB[q] * expf(-tb * dcb[q]) : 0.f;
                fsum[(size_t)c * 4096 + n] = hf + hb;
                fdif[(size_t)c * 4096 + n] = hf - hb; }
            asm volatile("s_waitcnt lgkmcnt(0)" ::: "memory");
        }
    }
}
#define RLX_AGENT __ATOMIC_RELAXED, __HIP_MEMORY_SCOPE_AGENT
#define XB_TMO      128
#define XB_XCNT(j)  (256  + 64 * (j))
#define XB_XSUB(j)  (1280 + 64 * (j))
#define XB_XGEN(j)  (2304 + 64 * (j))
#define XB_TOP      3328
#define XB_TOPGEN   3392
#define XCD_BAR_WORDS 3456
#define XB_SPIN_CAP (1u << 18)

__device__ __forceinline__ unsigned xb_ld(unsigned* p)              { return __hip_atomic_load(p, __ATOMIC_RELAXED, __HIP_MEMORY_SCOPE_AGENT); }
__device__ __forceinline__ unsigned xb_add(unsigned* p, unsigned v) { return __hip_atomic_fetch_add(p, v, __ATOMIC_RELAXED, __HIP_MEMORY_SCOPE_AGENT); }
__device__ __forceinline__ unsigned xb_xcc_id() { return (unsigned)__builtin_amdgcn_s_getreg((3 << 11) | 20) & 0xFu; }
#define XB_SPIN(cond, bar) do { unsigned _sp = 0; while (cond) { __builtin_amdgcn_s_sleep(1); \
    if ((++_sp & 255u) == 0u) { if (xb_ld(&(bar)[XB_TMO])) break; if (_sp > XB_SPIN_CAP) { atomicAdd(&(bar)[XB_TMO], 1u); break; } } } } while (0)

struct XcdBarrier {
    unsigned* bar; unsigned x;
    volatile LAS unsigned* st;
};

__device__ __forceinline__ XcdBarrier xcd_barrier_post(unsigned* bar, volatile LAS unsigned* st) {
    XcdBarrier b; b.bar = bar; b.x = xb_xcc_id(); b.st = st;
    if (threadIdx.x == 0) (void)xb_add(&bar[XB_XCNT(b.x)], 1u);
    return b;
}
__device__ __forceinline__ void xcd_barrier_complete(unsigned* bar, unsigned x, unsigned& nloc, unsigned& nx) {
    const unsigned G = gridDim.x * gridDim.y * gridDim.z;
    unsigned sum, cnt, mine, sp = 0u;
    for (;;) {
        sum = 0u; cnt = 0u; mine = 0u;
#pragma unroll
        for (unsigned j = 0; j < 16; ++j) { const unsigned c = xb_ld(&bar[XB_XCNT(j)]); sum += c; cnt += (c > 0u) ? 1u : 0u; mine = (j == x) ? c : mine; }
        if (sum == G) break;
        __builtin_amdgcn_s_sleep(1);
        if ((++sp & 255u) == 0u) { if (xb_ld(&bar[XB_TMO])) break; if (sp > XB_SPIN_CAP) { atomicAdd(&bar[XB_TMO], 1u); break; } }
    }
    nloc = mine > 0u ? mine : 1u; nx = cnt > 0u ? cnt : 1u;
}

__device__ __forceinline__ void xcd_barrier(const XcdBarrier& b) {
    asm volatile("s_waitcnt vmcnt(0)" ::: "memory");
    block_sync();
    if (threadIdx.x == 0) {
        unsigned* bar = b.bar;
        __builtin_amdgcn_s_waitcnt(0);
        unsigned nloc = b.st[0], nx = b.st[1];
        if (nloc == 0u) { xcd_barrier_complete(bar, b.x, nloc, nx); b.st[0] = nloc; b.st[1] = nx; }
        const unsigned old = xb_add(&bar[XB_XSUB(b.x)], 1u);
        const unsigned gen = old / nloc;
        if (old + 1u == (gen + 1u) * nloc) {
            __builtin_amdgcn_fence(__ATOMIC_RELEASE, "agent");
            asm volatile("s_waitcnt vmcnt(0)" ::: "memory");
            const unsigned og = xb_add(&bar[XB_TOP], 1u);
            const unsigned tg = og / nx;
            if (og + 1u == (tg + 1u) * nx) xb_add(&bar[XB_TOPGEN], 1u);
            else XB_SPIN(xb_ld(&bar[XB_TOPGEN]) == tg, bar);
            __builtin_amdgcn_fence(__ATOMIC_ACQUIRE, "agent");
            xb_add(&bar[XB_XGEN(b.x)], 1u);
            asm volatile("s_waitcnt vmcnt(0)" ::: "memory");
        } else {
            XB_SPIN(xb_ld(&bar[XB_XGEN(b.x)]) == gen, bar);
            __builtin_amdgcn_fence(__ATOMIC_ACQUIRE, "agent");
            asm volatile("s_waitcnt vmcnt(0)" ::: "memory");
        }
    }
    block_sync();
}

constexpr size_t MiB = 1u << 20;
constexpr int M = NB * L;
constexpr size_t WS_VSS = 0, WS_XSS = 64 * 1024, WS_X2SS = 128 * 1024, WS_TTAB = 192 * 1024, WS_BAR = 256 * 1024, WS_H3 = 1 * MiB;
constexpr size_t WS_WTA = 2 * MiB, WS_WTB = 10 * MiB, WS_PAB = 16 * MiB, WS_WO = 20 * MiB;
constexpr size_t WS_FSUM = 24 * MiB, WS_WUP = 24 * MiB, WS_WDN = 35 * MiB;
constexpr size_t WS_HYT = 41 * MiB;
constexpr size_t WS_X1B = 41 * MiB, WS_MRG = 105 * MiB;
constexpr size_t WS_YAB = 169 * MiB;
constexpr size_t WS_FDIF = 233 * MiB;
constexpr size_t WS_AP = 73 * MiB, WS_GP = 161 * MiB;
static_assert(WS_GP + (size_t)M * FH * 2 <= 256 * MiB && WS_AP + (size_t)M * FH * 2 <= WS_GP && WS_FDIF + 16 * MiB <= 256 * MiB && WS_WDN + (size_t)D * FH * 2 <= WS_HYT, "d_ws map");
constexpr int LDS_BYTES = 155648;
static_assert(HY_LDS_END + 256 <= LDS_BYTES, "LDS map");
constexpr int NPH = 9;

struct MegaArgs { const float* in[27]; float* out; unsigned char* ws; int ph_lo, ph_hi; WJobs wj; };

__global__ void __launch_bounds__(512, 2) __attribute__((target("no-packed-fp32-ops"))) mega_fwd(MegaArgs a) {
    extern __shared__ __attribute__((aligned(16))) unsigned char lds_raw[];
    LAS unsigned char* lds = (LAS unsigned char*)lds_raw;
    cg::grid_group grid = cg::this_grid();
    const int wave = __builtin_amdgcn_readfirstlane((int)threadIdx.x >> 6);
    const int G = gridDim.x, bid = blockIdx.x, gw = bid * 8 + wave, NGW = G * 8;
#define FRESH_TID int lane; asm volatile("v_mbcnt_lo_u32_b32 %0, -1, 0\n\tv_mbcnt_hi_u32_b32 %0, -1, %0" : "=v"(lane)); const int tid = wave * 64 + lane; (void)tid
    unsigned char* ws = a.ws;
    const float* x = a.in[0];
    float* vss = (float*)(ws + WS_VSS); float* xss = (float*)(ws + WS_XSS); float* x2ss = (float*)(ws + WS_X2SS);
    cfv* Ttab = (cfv*)(ws + WS_TTAB); float* h3 = (float*)(ws + WS_H3);
    bf16* WtA = (bf16*)(ws + WS_WTA); bf16* WtB = (bf16*)(ws + WS_WTB); bf16* PabT = (bf16*)(ws + WS_PAB); bf16* WoT = (bf16*)(ws + WS_WO);
    bf16* WupT = (bf16*)(ws + WS_WUP); bf16* WdnT = (bf16*)(ws + WS_WDN);
    float* fsum = (float*)(ws + WS_FSUM); float* fdif = (float*)(ws + WS_FDIF);
    bf16* hyvT = (bf16*)(ws + WS_HYT); bf16* yaT = hyvT + (size_t)1024 * M; bf16* vT = hyvT + (size_t)3072 * M;
    bf16* YAB = (bf16*)(ws + WS_YAB); bf16* h1 = YAB; bf16* Ub = YAB + 1024;
    bf16* Gb = (bf16*)a.out;
    bf16* mrg = (bf16*)(ws + WS_MRG); bf16* X1b = (bf16*)(ws + WS_X1B); float* X1 = a.out;
    bf16* APb = (bf16*)(ws + WS_AP); bf16* GPb = (bf16*)(ws + WS_GP);
    const int lo = a.ph_lo, hi = a.ph_hi;
#define IN(k) (lo <= (k) && (k) < hi)
    for (int u = (int)threadIdx.x; u < 16; u += 512) ((LAS unsigned*)(lds + LDS_BYTES - 256))[u] = 0u;
    block_sync();
    XcdBarrier xbar = xcd_barrier_post((unsigned*)(ws + WS_BAR), (volatile LAS unsigned*)(lds + LDS_BYTES - 256));
#ifdef MK_PROBE
#define STAMP(i) do { if (threadIdx.x == 0) ((volatile LAS unsigned long long*)(lds + LDS_BYTES - 128))[i] = __builtin_amdgcn_s_memrealtime(); } while (0)
#else
#define STAMP(i) do { } while (0)
#endif
    STAMP(0);
#define SEAM(k) do { if (IN(k) && IN((k) + 1)) xcd_barrier(xbar); STAMP((k) + 1); } while (0)
    if (a.ph_hi > NPH) grid.sync();

    if (IN(0)) { FRESH_TID;
        p0_weights(a.wj, 0, 7, (LAS float*)lds + wave * 4096, gw, NGW, lane);
        for (int m = 4 * gw; m < M; m += 4 * NGW) rms_rows4_to_bf16(x + (size_t)m * 1024, a.in[1], h1 + (size_t)m * 2048, 2048, lane);
        for (int i = bid * 512 + tid; i < 3 * M; i += G * 512) vss[i] = 0.f;
        block_sync();
        { LAS float* wl = (LAS float*)lds;
          for (int i = tid; i < MLPW_N; i += 512) { float v;
              if (i < MLPW_W2) v = a.in[5][i]; else if (i < MLPW_W3) v = a.in[7][i - MLPW_W2]; else if (i < MLPW_B) v = a.in[9][i - MLPW_W3];
              else { const int q = i - MLPW_B; v = q < 64 ? a.in[6][q] : q < 128 ? a.in[8][q - 64] : q < 192 ? a.in[10][q - 128] : a.in[11][q - 192]; }
              wl[i] = v; }
          block_sync();
          for (int l = 2 * gw; l < L; l += 2 * NGW) filter_mlp_rows2(wl, h3, (LAS float*)(lds + 65536) + wave * 128, l, l + 1, lane); }
        for (int m = bid * 512 + tid; m < 4096; m += G * 512) { const float ang = (float)m / 4096.0f; Ttab[m] = (cfv){cospif(ang), -sinpif(ang)}; }
    }
    SEAM(0);
    if (IN(1)) { FRESH_TID;
        { pg8::Gemm g{WtA, h1, 4096, M, 1024, 1024, 2048}; pg8::StaticOrder S; S.init(4096, M, G, bid);
          pg8::EpiHyT E{hyvT, M, vss};
          pg8::gemm_phase<pg8::EpiHyT, pg8::StaticOrder, true, true>(lds, g, S, E, tid); }
        STAMP(11);
        { pg8::Gemm g{h1, WtB, M, 3072, 1024, 2048, 1024}; pg8::StaticOrder S; S.init(M, 3072, G, bid);
          pg8::EpiUG E{Ub, Gb, 2048};
          pg8::gemm_phase<pg8::EpiUG, pg8::StaticOrder, true, true>(lds, g, S, E, tid); }
        STAMP(12);
        filter_tables(h3, a.in[12], a.in[13], fsum, fdif, (LAS float*)(lds + wave * 17408), gw, NGW, lane);
    }
    SEAM(1);
    if (IN(2)) { FRESH_TID;
        HyArgs H; H.hyT = hyvT; H.yaT = yaT; H.fsum = fsum; H.fdif = fdif; H.cw = a.in[3]; H.cb = a.in[4]; H.skip = a.in[14]; H.T = Ttab;
        H.TS = M; H.npairs = 2; H.off00 = 0; H.off01 = L; H.off10 = 2 * L; H.off11 = 3 * L;
        hyena_phase(lds, H, bid, G, tid, wave);
        block_sync();
        STAMP(13);
        SguArgs Sg; Sg.vT = vT; Sg.U = Ub; Sg.vss = vss; Sg.ws = a.in[16]; Sg.bs = a.in[17]; Sg.gn = a.in[15]; Sg.TS = M; Sg.ldu = 2048;
        sgu_phase(lds, Sg, bid, G, tid, wave);
    }
    SEAM(2);
    if (IN(3)) { FRESH_TID;
        transpose_ya(yaT, M, YAB, 2048, (LAS unsigned short*)lds + wave * 8192, gw, NGW, lane);
        p0_weights(a.wj, 7, 9, (LAS float*)lds + wave * 4096, gw, NGW, lane);
    }
    SEAM(3);
    if (IN(4)) { FRESH_TID;
        pg8::Gemm g{YAB, PabT, M, 1024, 2048, 2048, 2048}; pg8::StaticOrder S; S.init(M, 1024, G, bid);
        pg8::EpiMerge E{Gb, mrg};
        pg8::gemm_phase<pg8::EpiMerge, pg8::StaticOrder, true, true>(lds, g, S, E, tid);
    }
    SEAM(4);
    if (IN(5)) { FRESH_TID;
        pg8::Gemm g{mrg, WoT, M, 1024, 1024, 1024, 1024}; pg8::StaticOrder S; S.init(M, 1024, G, bid);
        pg8::EpiResid<true> E{x, nullptr, nullptr, X1b, xss};
        pg8::gemm_phase<pg8::EpiResid<true>, pg8::StaticOrder, true, true>(lds, g, S, E, tid);
    }
    SEAM(5);
    if (IN(6)) { FRESH_TID;
        pg8::Gemm g{X1b, WupT, M, 2 * FH, 1024, 1024, 1024}; pg8::StaticOrder S; S.init(68 * 256, 2 * FH, G, bid);
        pg8::EpiUpAct E{GPb, (LAS float*)(lds + 131072), xss, a.in[23], a.in[24]};
        pg8::gemm_phase<pg8::EpiUpAct, pg8::StaticOrder, true, true>(lds, g, S, E, tid);
    }
    SEAM(6);
    if (IN(7)) { FRESH_TID;
        pg8::Gemm g{GPb, WdnT, M, 1024, FH, FH, FH}; pg8::StaticOrder S; S.init(M, 1024, G, bid);
        pg8::EpiResid<false> E{nullptr, X1b, nullptr, X1b, x2ss};
        pg8::gemm_phase<pg8::EpiResid<false>, pg8::StaticOrder, true, true>(lds, g, S, E, tid);
    }
    SEAM(7);
    if (IN(8)) { FRESH_TID; final_norm(X1b, x2ss, a.in[26], a.out, M, gw, NGW, lane); }
    STAMP(9);
#ifdef MK_PROBE
#ifndef MK_PROBE_A
#define MK_PROBE_A MK_PROBE
#define MK_PROBE_B (MK_PROBE + 1)
#endif
    if (threadIdx.x == 0) { volatile LAS unsigned long long* ts = (volatile LAS unsigned long long*)(lds + LDS_BYTES - 128);
        const unsigned long long dt = 2ull * (ts[MK_PROBE_B] - ts[MK_PROBE_A]), t0 = __builtin_amdgcn_s_memrealtime();
        while (__builtin_amdgcn_s_memrealtime() - t0 < dt) __builtin_amdgcn_s_sleep(8); }
    block_sync();
#endif
#undef IN
#undef SEAM
}
}

#ifndef MK_CUTS
#define MK_CUTS 0
#endif
extern "C" void kernel_launch(void* const* d_in, const int* in_sizes, int n_in, void* d_out, int out_size, void* d_ws, size_t ws_size, hipStream_t stream) {
    static int grid = 0;
    if (grid == 0) {
        int dev = 0, cus = 0, per_cu = 0;
        hipGetDevice(&dev);
        hipDeviceGetAttribute(&cus, hipDeviceAttributeMultiprocessorCount, dev);
        hipFuncSetAttribute((const void*)mega_fwd, hipFuncAttributeMaxDynamicSharedMemorySize, LDS_BYTES);
        hipOccupancyMaxActiveBlocksPerMultiprocessor(&per_cu, (const void*)mega_fwd, 512, LDS_BYTES);
        if (per_cu < 1) { fprintf(stderr, "kernel_launch: occupancy query says %d blocks per CU\n", per_cu); per_cu = 1; }
        grid = cus * 1;
        (void)hipGetLastError();
    }
    hipMemsetAsync((char*)d_ws + WS_BAR, 0, XCD_BAR_WORDS * 4, stream);
    MegaArgs a{};
    for (int i = 0; i < 27; ++i) a.in[i] = (const float*)d_in[i];
    a.out = (float*)d_out; a.ws = (unsigned char*)d_ws;
    { unsigned char* ws = (unsigned char*)d_ws;
      bf16* WtA = (bf16*)(ws + WS_WTA); bf16* WtB = (bf16*)(ws + WS_WTB); bf16* PabT = (bf16*)(ws + WS_PAB); bf16* WoT = (bf16*)(ws + WS_WO); bf16* WupT = (bf16*)(ws + WS_WUP); bf16* WdnT = (bf16*)(ws + WS_WDN);
    a.wj.j[0] = WJob{(const float*)d_in[2], nullptr, WtA, 1024, INW, 0, 3072, 1024, 0, 0, 0};
    a.wj.j[1] = WJob{(const float*)d_in[2], nullptr, WtA, 1024, INW, 4096, 1024, 1024, 3072, 0, 0};
    a.wj.j[2] = WJob{(const float*)d_in[2], nullptr, WtB, 1024, INW, 3072, 1024, 1024, 0, 0, 0};
    a.wj.j[3] = WJob{(const float*)d_in[2], nullptr, WtB, 1024, INW, 5120, 2048, 1024, 1024, 0, 0};
    a.wj.j[4] = WJob{(const float*)d_in[18], nullptr, PabT, 1024, 1024, 0, 1024, 2048, 0, 0, 0};
    a.wj.j[5] = WJob{(const float*)d_in[19], nullptr, PabT, 1024, 1024, 0, 1024, 2048, 0, 1024, 0};
    a.wj.j[6] = WJob{(const float*)d_in[20], nullptr, WoT, 1024, 1024, 0, 1024, 1024, 0, 0, 0};
    a.wj.j[7] = WJob{(const float*)d_in[22], (const float*)d_in[21], WupT, 1024, 2 * FH, 0, 2 * FH, 1024, 0, 0, 1};
    a.wj.j[8] = WJob{(const float*)d_in[25], nullptr, WdnT, FH, 1024, 0, 1024, FH, 0, 0, 0};

    }
#if MK_CUTS
    for (int p = 0; p < NPH; ++p) { a.ph_lo = p; a.ph_hi = p + 1; hipLaunchKernelGGL(mega_fwd, dim3(grid), dim3(512), LDS_BYTES, stream, a); }
#else
    a.ph_lo = 0; a.ph_hi = NPH;
    void* args[] = {&a};
    hipError_t e = hipLaunchCooperativeKernel((const void*)mega_fwd, dim3(grid), dim3(512), args, LDS_BYTES, stream);
    if (e != hipSuccess) fprintf(stderr, "cooperative launch failed: %s (grid %d)\n", hipGetErrorString(e), grid);
#endif
}
```

```cpp
#include <hip/hip_runtime.h>
#include <hip/hip_cooperative_groups.h>
#include <math.h>
#include <stdint.h>
#include <cstdio>
namespace cg = cooperative_groups;
namespace pg8 {
#define PG8_LAS __attribute__((address_space(3)))
typedef unsigned short bf16_t;
typedef short bf16x8 __attribute__((ext_vector_type(8)));
typedef float f32x4 __attribute__((ext_vector_type(4)));
typedef unsigned u32x4 __attribute__((ext_vector_type(4)));
constexpr int BM = 256, BK = 64, HALF = 128, HTB = HALF * BK * 2  , STAGE_BYTES = 8 * HTB, NXCD = 8, WGM = 8;

__host__ __device__ __forceinline__ int lds_byte(int r, int c) { const int st = (r >> 4) * 2 + (c >> 5), rr = r & 15, cc = c & 31, ob = rr * 64 + cc * 2; return st * 1024 + (ob ^ (((ob >> 9) & 1) << 5)); }
__host__ __device__ __forceinline__ void stage_rc(int b, int& R, int& C) { const int st = b / 1024, sb = b % 1024, swz = sb ^ (((sb >> 9) & 1) << 5); R = (st >> 1) * 16 + swz / 64; C = (st & 1) * 32 + (swz % 64) / 2; }
__host__ __device__ __forceinline__ int perm32(int rho) { const int n = rho >> 4, i = rho & 15; return 8 * (i >> 2) + 4 * n + (i & 3); }

struct Unit { int pm, pn; };
__host__ __device__ __forceinline__ int ovl_row(int pm) { const int seq = pm / 17, i = pm % 17; int s = 254 * i - 1; s = s < 0 ? 0 : (s > 3840 ? 3840 : s); return seq * 4096 + s; }
struct Gemm { const bf16_t* A; const bf16_t* Bt; int M, N, K, lda, ldb; };

struct StaticOrder {
    int nM, nN, nwg, G, c;
    __host__ __device__ __forceinline__ void init(int M, int N, int G_, int c_) { nM = M / BM; nN = N / BM; nwg = nM * nN; G = G_; c = c_; }
    __host__ __device__ __forceinline__ bool next(int i, Unit& u) const {
        const long L = (long)i * G + c; if (L >= nwg) return false;
        int wgid = (int)L; { const int q = nwg / NXCD, r = nwg % NXCD, xcd = wgid % NXCD, off = wgid / NXCD; wgid = (xcd < r ? xcd * (q + 1) : r * (q + 1) + (xcd - r) * q) + off; }
        const int nig = WGM * nN, gid = wgid / nig, fm = gid * WGM, gsz = (nM - fm) < WGM ? (nM - fm) : WGM;
        u.pm = fm + ((wgid % nig) % gsz); u.pn = (wgid % nig) / gsz; return true;
    }
    __device__ __forceinline__ void a_ready(const Unit&) const {}
    __device__ __forceinline__ void done(const Unit&) const {}
};

__device__ __forceinline__ unsigned cvt_pk_bf16(float lo, float hi) { unsigned r; asm volatile("v_cvt_pk_bf16_f32 %0, %1, %2" : "=v"(r) : "v"(lo), "v"(hi)); return r; }
typedef float f32x2 __attribute__((ext_vector_type(2)));
__device__ __forceinline__ f32x2 gelu_pk(f32x2 v) {
    const f32x2 av = __builtin_elementwise_abs(v), d = av * 0.2316418882f + 1.0f;
    f32x2 t; t.x = __builtin_amdgcn_rcpf(d.x); t.y = __builtin_amdgcn_rcpf(d.y);
    f32x2 q = t * 0.5307027145f + (-0.7265760135f); q = q * t + 0.7107068705f; q = q * t + (-0.142248368f); q = q * t + 0.127414796f; q = q * t;
    const f32x2 s = (v * v) * (-0.72134752044f);
    f32x2 e; e.x = __builtin_amdgcn_exp2f(s.x); e.y = __builtin_amdgcn_exp2f(s.y);
    const f32x2 m = v * (q * e), r = v - m;
    f32x2 o; o.x = v.x < 0.f ? m.x : r.x; o.y = v.y < 0.f ? m.y : r.y; return o;
}

template <int ACT  > struct EpiBf16 {
    static constexpr bool PERM = true, AFTER_DRAIN = false, MID = false, OVL = false; static_assert(ACT == 0 || ACT == 1, "EpiBf16: ACT is 0 (none) or 1 (gelu_pk)");
    bf16_t* O; int ldc; const float* bias; int split_cols; size_t split_stride; float scale0;
    __device__ __forceinline__ void operator()(const f32x4 (&acc)[2][2][4][2], const Unit& u, int wr, int wc, int fr, int fq) const {
        const int row0 = u.pm * BM + wr * 64 + fr; int colt = u.pn * BM; bf16_t* base = O;
        float sc = 1.f; if (split_cols) { const int t = colt / split_cols; base += (size_t)t * split_stride; colt -= t * split_cols; if (t == 0) sc = scale0; }
        const int col0 = colt + wc * 32 + 8 * fq, bcol0 = u.pn * BM + wc * 32 + 8 * fq;
        f32x4 bv[2][2];
#pragma unroll
        for (int bj = 0; bj < 2; ++bj)
#pragma unroll
            for (int n = 0; n < 2; ++n) bv[bj][n] = bias ? *(const f32x4*)(bias + bcol0 + bj * HALF + 4 * n) : (f32x4){0.f, 0.f, 0.f, 0.f};
#pragma unroll
        for (int ai = 0; ai < 2; ++ai)
#pragma unroll
            for (int m = 0; m < 4; ++m) { bf16_t* rowp = base + (size_t)(row0 + ai * HALF + m * 16) * ldc + col0;
#pragma unroll
                for (int bj = 0; bj < 2; ++bj) { f32x4 v0 = acc[ai][bj][m][0] + bv[bj][0], v1 = acc[ai][bj][m][1] + bv[bj][1];
                    if (ACT == 1) { f32x2 a = gelu_pk((f32x2){v0[0], v0[1]}), b = gelu_pk((f32x2){v0[2], v0[3]}), c = gelu_pk((f32x2){v1[0], v1[1]}), d = gelu_pk((f32x2){v1[2], v1[3]});
                        v0 = (f32x4){a.x, a.y, b.x, b.y}; v1 = (f32x4){c.x, c.y, d.x, d.y}; }
                    v0 = v0 * sc; v1 = v1 * sc; u32x4 w; w.x = cvt_pk_bf16(v0[0], v0[1]); w.y = cvt_pk_bf16(v0[2], v0[3]); w.z = cvt_pk_bf16(v1[0], v1[1]); w.w = cvt_pk_bf16(v1[2], v1[3]);
                    *(u32x4*)(rowp + bj * HALF) = w; } }
    }
};

struct EpiF32 {
    static constexpr bool PERM = false, AFTER_DRAIN = false, MID = false, OVL = false;
    float* C; int ldc; const float* bias;
    __device__ __forceinline__ void operator()(const f32x4 (&acc)[2][2][4][2], const Unit& u, int wr, int wc, int fr, int fq) const {
        const int row0 = u.pm * BM + wr * 64 + fr, col0 = u.pn * BM + wc * 32 + 4 * fq;
        f32x4 bv[2][2];
#pragma unroll
        for (int bj = 0; bj < 2; ++bj)
#pragma unroll
            for (int n = 0; n < 2; ++n) bv[bj][n] = bias ? *(const f32x4*)(bias + col0 + bj * HALF + n * 16) : (f32x4){0.f, 0.f, 0.f, 0.f};
#pragma unroll
        for (int ai = 0; ai < 2; ++ai)
#pragma unroll
            for (int m = 0; m < 4; ++m) { float* rowp = C + (size_t)(row0 + ai * HALF + m * 16) * ldc + col0;
#pragma unroll
                for (int bj = 0; bj < 2; ++bj)
#pragma unroll
                    for (int n = 0; n < 2; ++n) *(f32x4*)(rowp + bj * HALF + n * 16) = acc[ai][bj][m][n] + bv[bj][n]; }
    }
};

template <class Epi, class Sched, bool ALIGN_EPI = false, bool SP2 = false>
__device__ __forceinline__ void gemm_phase(PG8_LAS unsigned char* lds, const Gemm g, const Sched& S, const Epi& E, const int tid) {
    const int wid = __builtin_amdgcn_readfirstlane(tid >> 6), lane = tid & 63, wr = wid >> 2, wc = wid & 3, fr = lane & 15, fq = lane >> 4;
    const int K = g.K, nt = K / BK;
    unsigned voffA[2], voffB[2];
#pragma unroll
    for (int i = 0; i < 2; ++i) { int R, C; stage_rc(tid * 16 + i * 8192, R, C); const int Rb = Epi::PERM ? ((R & ~31) + perm32(R & 31)) : R;
        voffA[i] = (unsigned)(R * g.lda + C) * 2u; voffB[i] = (unsigned)(Rb * g.ldb + C) * 2u; }
    const size_t kstep = (size_t)(BK * 2);
    const size_t hstepA = (size_t)HALF * g.lda * 2, hstepB = (size_t)HALF * g.ldb * 2;
    const size_t tstepA = 2 * hstepA, tstepB = 2 * hstepB;
    const unsigned ldsw = (unsigned)wid * 1024u;
    const int aoff = lds_byte(wr * 64 + fr, fq * 8), boff = lds_byte(wc * 32 + fr, fq * 8);
#define PG8_SA(b, h) (((b) * 2 + (h)) * HTB)
#define PG8_SB(b, h) ((4 + (b) * 2 + (h)) * HTB)
#define PG8_STAGE(bufoff, gbase, voff) do { _Pragma("unroll") for (int _i = 0; _i < 2; ++_i) \
        __builtin_amdgcn_global_load_lds((const unsigned*)((const char*)(gbase) + (voff)[_i]), (PG8_LAS unsigned*)(lds + (bufoff) + ldsw + _i * 8192), 16, 0, 0); } while (0)
#define PG8_LDA(dst, b, h) do { _Pragma("unroll") for (int m = 0; m < 4; ++m) _Pragma("unroll") for (int k = 0; k < 2; ++k) dst[m][k] = *(const PG8_LAS bf16x8*)(lds + PG8_SA(b, h) + aoff + m * 2048 + k * 1024); } while (0)
#define PG8_LDB(dst, b, h) do { _Pragma("unroll") for (int n = 0; n < 2; ++n) _Pragma("unroll") for (int k = 0; k < 2; ++k) dst[n][k] = *(const PG8_LAS bf16x8*)(lds + PG8_SB(b, h) + boff + n * 2048 + k * 1024); } while (0)
#define PG8_MMA(ai, bj, At, Bt) do { __builtin_amdgcn_s_setprio(1); _Pragma("unroll") for (int m = 0; m < 4; ++m) _Pragma("unroll") for (int n = 0; n < 2; ++n) _Pragma("unroll") for (int k = 0; k < 2; ++k) \
        acc[ai][bj][m][n] = __builtin_amdgcn_mfma_f32_16x16x32_bf16(Bt[n][k], At[m][k], acc[ai][bj][m][n], 0, 0, 0); __builtin_amdgcn_s_setprio(0); } while (0)
#define PG8_WAIT_V(n) asm volatile("s_waitcnt vmcnt(" #n ")" ::: "memory")
#define PG8_WAIT_L(n) asm volatile("s_waitcnt lgkmcnt(" #n ")" ::: "memory")
#define PG8_BAR __builtin_amdgcn_s_barrier()
#define PG8_SCHED __builtin_amdgcn_sched_barrier(0)
    Unit cur, nxt; int ui = 0;
    if (!S.next(0, cur)) return;
    f32x4 acc[2][2][4][2];
#pragma unroll
    for (int a = 0; a < 2; ++a)
#pragma unroll
        for (int b = 0; b < 2; ++b)
#pragma unroll
            for (int m = 0; m < 4; ++m)
#pragma unroll
                for (int n = 0; n < 2; ++n) acc[a][b][m][n] = (f32x4){0.f, 0.f, 0.f, 0.f};
    bf16x8 At[4][2], B0[2][2], B1[2][2];
    const char* cA = (const char*)g.A + (size_t)(Epi::OVL ? ovl_row(cur.pm) : cur.pm * BM) * (tstepA / BM); const char* cB = (const char*)g.Bt + (size_t)cur.pn * tstepB;
    S.a_ready(cur);
    if constexpr (SP2) {
        PG8_STAGE(PG8_SB(0, 0), cB, voffB); PG8_STAGE(PG8_SB(0, 1), cB + hstepB, voffB); PG8_STAGE(PG8_SA(0, 0), cA, voffA); PG8_STAGE(PG8_SA(0, 1), cA + hstepA, voffA);
        if (wr == 1) PG8_BAR;
        PG8_WAIT_V(2); PG8_BAR;
        PG8_STAGE(PG8_SB(1, 0), cB + kstep, voffB); PG8_STAGE(PG8_SA(1, 0), cA + kstep, voffA); PG8_STAGE(PG8_SB(1, 1), cB + hstepB + kstep, voffB);
        PG8_WAIT_V(6); PG8_BAR;
    } else {
        PG8_STAGE(PG8_SB(0, 0), cB, voffB); PG8_STAGE(PG8_SA(0, 0), cA, voffA); PG8_STAGE(PG8_SB(0, 1), cB + hstepB, voffB); PG8_STAGE(PG8_SA(0, 1), cA + hstepA, voffA);
        if (wr == 1) PG8_BAR;
        PG8_WAIT_V(4); PG8_BAR;
        PG8_STAGE(PG8_SB(1, 0), cB + kstep, voffB); PG8_STAGE(PG8_SA(1, 0), cA + kstep, voffA); PG8_STAGE(PG8_SB(1, 1), cB + hstepB + kstep, voffB);
        PG8_WAIT_V(6); PG8_BAR;
    }
    for (;;) {
        const bool has_next = S.next(ui + 1, nxt);
        const char* nA = has_next ? (const char*)g.A + (size_t)(Epi::OVL ? ovl_row(nxt.pm) : nxt.pm * BM) * (tstepA / BM) : cA; const char* nB = has_next ? (const char*)g.Bt + (size_t)nxt.pn * tstepB : cB;
        for (int t = 0; t < nt; t += 2) {
            const bool last = (t == nt - 2);
            const char* a1 = cA + (size_t)(t + 1) * kstep;
            const char* a2 = last ? nA : cA + (size_t)(t + 2) * kstep; const char* b2 = last ? nB : cB + (size_t)(t + 2) * kstep;
            const char* a3 = a2 + kstep; const char* b3 = b2 + kstep;
            if (last && has_next) S.a_ready(nxt);
            if constexpr (Epi::MID) { if (t == (nt >> 1)) E.mid(acc, cur, wr, wc, fr, fq); }
            if constexpr (SP2) {
            PG8_LDB(B0, 0, 0); PG8_LDB(B1, 0, 1); PG8_SCHED; PG8_LDA(At, 0, 0); PG8_STAGE(PG8_SA(1, 1), a1 + hstepA, voffA);
            PG8_WAIT_V(8); PG8_WAIT_L(0); PG8_BAR; PG8_MMA(0, 0, At, B0); PG8_MMA(0, 1, At, B1); PG8_BAR; PG8_SCHED;
            PG8_LDA(At, 0, 1); PG8_STAGE(PG8_SB(0, 0), b2, voffB); PG8_STAGE(PG8_SB(0, 1), b2 + hstepB, voffB); PG8_STAGE(PG8_SA(0, 0), a2, voffA);
            PG8_WAIT_V(8); PG8_WAIT_L(0); PG8_BAR; PG8_MMA(1, 0, At, B0); PG8_MMA(1, 1, At, B1); PG8_BAR; PG8_SCHED;
            PG8_LDB(B0, 1, 0); PG8_LDB(B1, 1, 1); PG8_SCHED; PG8_LDA(At, 1, 0); PG8_STAGE(PG8_SA(0, 1), a2 + hstepA, voffA);
            PG8_WAIT_V(8); PG8_WAIT_L(0); PG8_BAR; PG8_MMA(0, 0, At, B0); PG8_MMA(0, 1, At, B1); PG8_BAR; PG8_SCHED;
            PG8_LDA(At, 1, 1); PG8_STAGE(PG8_SB(1, 0), b3, voffB); PG8_STAGE(PG8_SB(1, 1), b3 + hstepB, voffB); PG8_STAGE(PG8_SA(1, 0), a3, voffA);
            PG8_WAIT_V(8); PG8_WAIT_L(0); PG8_BAR; PG8_MMA(1, 0, At, B0); PG8_MMA(1, 1, At, B1); PG8_BAR; PG8_SCHED;
            } else {
            PG8_LDB(B0, 0, 0); PG8_SCHED; PG8_LDA(At, 0, 0); PG8_STAGE(PG8_SA(1, 1), a1 + hstepA, voffA);
            PG8_WAIT_L(8); PG8_BAR; PG8_WAIT_L(0); PG8_MMA(0, 0, At, B0); PG8_BAR; PG8_SCHED;
            PG8_LDB(B1, 0, 1); PG8_STAGE(PG8_SB(0, 0), b2, voffB);
            PG8_BAR; PG8_WAIT_L(0); PG8_MMA(0, 1, At, B1); PG8_BAR;
            PG8_LDA(At, 0, 1); PG8_STAGE(PG8_SA(0, 0), a2, voffA);
            PG8_BAR; PG8_WAIT_L(0); PG8_MMA(1, 0, At, B0); PG8_BAR; PG8_SCHED;
            PG8_STAGE(PG8_SB(0, 1), b2 + hstepB, voffB);
            PG8_WAIT_V(6); PG8_BAR; PG8_MMA(1, 1, At, B1); PG8_BAR;
            PG8_LDB(B0, 1, 0); PG8_SCHED; PG8_LDA(At, 1, 0); PG8_STAGE(PG8_SA(0, 1), a2 + hstepA, voffA);
            PG8_WAIT_L(8); PG8_BAR; PG8_WAIT_L(0); PG8_MMA(0, 0, At, B0); PG8_BAR; PG8_SCHED;
            PG8_LDB(B1, 1, 1); PG8_STAGE(PG8_SB(1, 0), b3, voffB);
            PG8_BAR; PG8_WAIT_L(0); PG8_MMA(0, 1, At, B1); PG8_BAR;
            PG8_LDA(At, 1, 1); PG8_STAGE(PG8_SA(1, 0), a3, voffA);
            PG8_BAR; PG8_WAIT_L(0); PG8_MMA(1, 0, At, B0); PG8_BAR; PG8_SCHED;
            PG8_STAGE(PG8_SB(1, 1), b3 + hstepB, voffB);
            PG8_WAIT_V(6); PG8_BAR; PG8_MMA(1, 1, At, B1); PG8_BAR;
            }
        }
        if constexpr (ALIGN_EPI) { if (wr == 0) PG8_BAR; }
        if constexpr (!Epi::AFTER_DRAIN) { E(acc, cur, wr, wc, fr, fq); S.done(cur); }
        if (!has_next) break;
#pragma unroll
        for (int a = 0; a < 2; ++a)
#pragma unroll
            for (int b = 0; b < 2; ++b)
#pragma unroll
                for (int m = 0; m < 4; ++m)
#pragma unroll
                    for (int n = 0; n < 2; ++n) acc[a][b][m][n] = (f32x4){0.f, 0.f, 0.f, 0.f};
        cur = nxt; cA = nA; cB = nB; ++ui;
        if constexpr (ALIGN_EPI) { if (wr == 1) PG8_BAR; }
    }
    PG8_WAIT_V(0);
    if constexpr (!ALIGN_EPI) { if (wr == 0) PG8_BAR; }
    PG8_BAR;
    if constexpr (Epi::AFTER_DRAIN) { E.fused(acc, cur, wr, wc, fr, fq, lds, wid, lane); S.done(cur); }
#undef PG8_SA
#undef PG8_SB
#undef PG8_STAGE
#undef PG8_LDA
#undef PG8_LDB
#undef PG8_MMA
#undef PG8_WAIT_V
#undef PG8_WAIT_L
#undef PG8_BAR
#undef PG8_SCHED
}
}
namespace {
constexpr int D = 1024, NB = 4, L = 4096, HW = 1024, SW = 1024, INW = 7168, FH = 2816, FHID = 64, FEMB = 33;
constexpr float EPS = 1e-6f;
typedef unsigned short bf16;
__device__ __forceinline__ unsigned f2bf(float f) { unsigned u = __builtin_bit_cast(unsigned, f); return (u + 0x7fffu + ((u >> 16) & 1u)) >> 16; }
__device__ __forceinline__ void block_sync() { __builtin_amdgcn_fence(__ATOMIC_RELEASE, "workgroup"); __builtin_amdgcn_s_barrier(); __builtin_amdgcn_fence(__ATOMIC_ACQUIRE, "workgroup"); }
}
namespace {
#define HD __device__ __forceinline__
#define FFT_OPAQUE(w) asm volatile("" : "+v"((w).x), "+v"((w).y))
#ifndef HD
#define HD inline
#endif
typedef float cfv __attribute__((ext_vector_type(2)));
struct cf { float x, y; };
HD cf cmk(float x, float y) { cf r; r.x = x; r.y = y; return r; }
template <class P> HD cf ldz(P Z, int i) { const cfv t = Z[i]; return cmk(t.x, t.y); }
template <class P> HD void stz(P Z, int i, cf v) { Z[i] = (cfv){v.x, v.y}; }
HD cf cadd(cf a, cf b) { return cmk(a.x + b.x, a.y + b.y); }
HD cf csub(cf a, cf b) { return cmk(a.x - b.x, a.y - b.y); }
HD cf cmul(cf a, cf b) { return cmk(a.x * b.x - a.y * b.y, a.x * b.y + a.y * b.x); }
HD cf cconj(cf a) { return cmk(a.x, -a.y); }
template <bool INV> HD cf mulmi(cf a) { return INV ? cmk(-a.y, a.x) : cmk(a.y, -a.x); }
template <bool INV> HD cf twc(float c, float s) { return INV ? cmk(c, s) : cmk(c, -s); }
HD int fpad(int p) { return p + (p >> 4); }
constexpr int FSUB = 4352;

template <bool INV> HD void dft4(cf& a, cf& b, cf& c, cf& d) {
    const cf t0 = cadd(a, c), t1 = csub(a, c), t2 = cadd(b, d), t3 = mulmi<INV>(csub(b, d));
    a = cadd(t0, t2); b = cadd(t1, t3); c = csub(t0, t2); d = csub(t1, t3);
}
template <bool INV> HD void dft16(cf (&v)[16]) {
    constexpr float C1 = 0.92387953251128674f, S1 = 0.38268343236508977f, R = 0.70710678118654752f;
#pragma unroll
    for (int n0 = 0; n0 < 4; ++n0) dft4<INV>(v[n0], v[n0 + 4], v[n0 + 8], v[n0 + 12]);
    v[1 + 4 * 1] = cmul(v[1 + 4 * 1], twc<INV>(C1, S1));
    v[1 + 4 * 2] = cmul(v[1 + 4 * 2], twc<INV>(R, R));
    v[1 + 4 * 3] = cmul(v[1 + 4 * 3], twc<INV>(S1, C1));
    v[2 + 4 * 1] = cmul(v[2 + 4 * 1], twc<INV>(R, R));
    v[2 + 4 * 2] = mulmi<INV>(v[2 + 4 * 2]);
    v[2 + 4 * 3] = cmul(v[2 + 4 * 3], twc<INV>(-R, R));
    v[3 + 4 * 1] = cmul(v[3 + 4 * 1], twc<INV>(S1, C1));
    v[3 + 4 * 2] = cmul(v[3 + 4 * 2], twc<INV>(-R, R));
    v[3 + 4 * 3] = cmul(v[3 + 4 * 3], twc<INV>(-C1, -S1));
#pragma unroll
    for (int k0 = 0; k0 < 4; ++k0) dft4<INV>(v[4 * k0], v[4 * k0 + 1], v[4 * k0 + 2], v[4 * k0 + 3]);
    cf t;
    t = v[1]; v[1] = v[4]; v[4] = t;   t = v[2]; v[2] = v[8]; v[8] = t;   t = v[3]; v[3] = v[12]; v[12] = t;
    t = v[6]; v[6] = v[9]; v[9] = t;   t = v[7]; v[7] = v[13]; v[13] = t; t = v[11]; v[11] = v[14]; v[14] = t;
}
#ifndef FFT_OPAQUE
#define FFT_OPAQUE(w)
#endif
HD void twiddle16(cf (&v)[16], cf w) {
    FFT_OPAQUE(w);
    cf p = w;
#pragma unroll
    for (int k = 1; k < 16; ++k) { v[k] = cmul(v[k], p); if (k < 15) p = cmul(p, w); }
}
template <class P> HD void fwd_pass1(P Z, int t, cf w1) {
    cf v[16]; const int b = t + (t >> 4);
#pragma unroll
    for (int j = 0; j < 16; ++j) v[j] = ldz(Z, b + 272 * j);
    dft16<false>(v); twiddle16(v, w1);
#pragma unroll
    for (int j = 0; j < 16; ++j) stz(Z, b + 272 * j, v[j]);
}
template <class P> HD void fwd_pass2(P Z, int t, cf w2) {
    const int b = 272 * (t >> 4) + (t & 15);
    cf v[16];
#pragma unroll
    for (int j = 0; j < 16; ++j) v[j] = ldz(Z, b + 17 * j);
    dft16<false>(v); twiddle16(v, w2);
#pragma unroll
    for (int j = 0; j < 16; ++j) stz(Z, b + 17 * j, v[j]);
}
template <class P> HD void fwd_pass3_load(P Z, int t, cf (&v)[16]) {
#pragma unroll
    for (int j = 0; j < 16; ++j) v[j] = ldz(Z, 17 * t + j);
    dft16<false>(v);
}
template <class P> HD void inv_pass1_store(P Z, int t, cf (&v)[16]) {
    dft16<true>(v);
#pragma unroll
    for (int j = 0; j < 16; ++j) stz(Z, 17 * t + j, v[j]);
}
template <class P> HD void inv_pass2(P Z, int t, cf w2) {
    const int b = 272 * (t >> 4) + (t & 15);
    cf v[16];
#pragma unroll
    for (int j = 0; j < 16; ++j) v[j] = ldz(Z, b + 17 * j);
    twiddle16(v, cconj(w2)); dft16<true>(v);
#pragma unroll
    for (int j = 0; j < 16; ++j) stz(Z, b + 17 * j, v[j]);
}
template <class P> HD void inv_pass3(P Z, int t, cf w1) {
    cf v[16]; const int b = t + (t >> 4);
#pragma unroll
    for (int j = 0; j < 16; ++j) v[j] = ldz(Z, b + 272 * j);
    twiddle16(v, cconj(w1)); dft16<true>(v);
#pragma unroll
    for (int j = 0; j < 16; ++j) stz(Z, b + 272 * j, v[j]);
}
#define LAS __attribute__((address_space(3)))
typedef LAS cfv* lcf;
struct HyArgs {
    const bf16* hyT;
    bf16* yaT;
    const float* fsum;
    const float* fdif;
    const float* cw;
    const float* cb;
    const float* skip;
    const cfv* T;
    int TS, npairs, off00, off01, off10, off11;
};
__device__ __forceinline__ float bf2f(unsigned h) { return __builtin_bit_cast(float, h << 16); }
constexpr int HOFF_SX1 = 2 * FSUB * 8, HOFF_SV = HOFF_SX1 + 16384, HOFF_SX0 = HOFF_SV + 16384, HOFF_SF = HOFF_SX0 + 16384, HY_LDS_END = HOFF_SF + 32768;
#define HBAR() do { asm volatile("s_waitcnt lgkmcnt(0)" ::: "memory"); __builtin_amdgcn_s_barrier(); asm volatile("" ::: "memory"); } while (0)
#define HDMA_WAIT() asm volatile("s_waitcnt vmcnt(0)" ::: "memory")
#define WAVE_FENCE() asm volatile("s_waitcnt lgkmcnt(0)" ::: "memory")
__device__ __forceinline__ void hdma16(const void* gp, LAS unsigned char* wave_dst) { __builtin_amdgcn_global_load_lds((const unsigned*)gp, (LAS unsigned*)wave_dst, 16, 0, 0); }
__device__ __forceinline__ void conv8s(const LAS unsigned char* S, int tid, float w0, float w1, float w2, float b, float (&o)[8]) {
    const pg8::u32x4 q = *(const LAS pg8::u32x4*)(S + 16 * tid);
    const unsigned lft = *(const LAS unsigned short*)(S + (tid > 0 ? 16 * tid - 2 : 0)), rgt = *(const LAS unsigned short*)(S + (tid < 511 ? 16 * tid + 16 : 8190));
    float x[10];
    x[0] = tid > 0 ? bf2f(lft) : 0.f; x[9] = tid < 511 ? bf2f(rgt) : 0.f;
    x[1] = bf2f(q.x & 0xffffu); x[2] = bf2f(q.x >> 16); x[3] = bf2f(q.y & 0xffffu); x[4] = bf2f(q.y >> 16);
    x[5] = bf2f(q.z & 0xffffu); x[6] = bf2f(q.z >> 16); x[7] = bf2f(q.w & 0xffffu); x[8] = bf2f(q.w >> 16);
#pragma unroll
    for (int i = 0; i < 8; ++i) o[i] = b + w0 * x[i] + w1 * x[i + 1] + w2 * x[i + 2];
}
__device__ __forceinline__ pg8::u32x4 pack8(const float (&x)[8], const float (&y)[8]) {
    pg8::u32x4 w;
    w.x = f2bf(x[0] * y[0]) | (f2bf(x[1] * y[1]) << 16); w.y = f2bf(x[2] * y[2]) | (f2bf(x[3] * y[3]) << 16);
    w.z = f2bf(x[4] * y[4]) | (f2bf(x[5] * y[5]) << 16); w.w = f2bf(x[6] * y[6]) | (f2bf(x[7] * y[7]) << 16);
    return w;
}
__device__ __forceinline__ void hyena_phase(LAS unsigned char* lds, const HyArgs& A, int first, int stride, const int tid, const int wave) {
    lcf Z = (lcf)lds;
    const int s = tid >> 8, t = tid & 255, pb = 8 * tid + (tid >> 1);
    const cf w1 = ldz(A.T, 2 * t), w2 = ldz(A.T, 32 * (t & 15)), wp = ldz(A.T, 8 * tid);
    lcf Zs = Z + s * FSUB;
    LAS unsigned char* wdst = lds + wave * 1024;
    constexpr float W8C[8] = {1.0f, 0.99999970586f, 0.99999882345f, 0.99999735277f, 0.99999529381f, 0.99999264659f, 0.99998941108f, 0.99998558731f};
    constexpr float W8S[8] = {0.0f, 0.00076699031874f, 0.0015339801863f, 0.0023009691514f, 0.0030679567630f, 0.0038349425697f, 0.0046019261204f, 0.0053689069640f};
    if (first >= 1024) return;
#define ISSUE_PAIR(cc, oa, ob) do { \
        hdma16(A.hyT + (size_t)(1024 + (cc)) * A.TS + (oa) + 8 * tid, wdst + HOFF_SX1); hdma16(A.hyT + (size_t)(1024 + (cc)) * A.TS + (ob) + 8 * tid, wdst + HOFF_SX1 + 8192); \
        hdma16(A.hyT + (size_t)(2048 + (cc)) * A.TS + (oa) + 8 * tid, wdst + HOFF_SV);  hdma16(A.hyT + (size_t)(2048 + (cc)) * A.TS + (ob) + 8 * tid, wdst + HOFF_SV + 8192); } while (0)
#define ISSUE_X0(cc, oa, ob) do { hdma16(A.hyT + (size_t)(cc) * A.TS + (oa) + 8 * tid, wdst + HOFF_SX0); hdma16(A.hyT + (size_t)(cc) * A.TS + (ob) + 8 * tid, wdst + HOFF_SX0 + 8192); } while (0)
#define ISSUE_FILT(cc) do { \
        hdma16(A.fsum + (size_t)(cc) * 4096 + 8 * tid, wdst + HOFF_SF); hdma16(A.fsum + (size_t)(cc) * 4096 + 8 * tid + 4, wdst + HOFF_SF + 8192); \
        hdma16(A.fdif + (size_t)(cc) * 4096 + 8 * tid, wdst + HOFF_SF + 16384); hdma16(A.fdif + (size_t)(cc) * 4096 + 8 * tid + 4, wdst + HOFF_SF + 24576); } while (0)
    ISSUE_FILT(first); ISSUE_PAIR(first, A.off00, A.off01);
    for (int c = first; c < 1024; c += stride) {
        const int cn = c + stride;
        const float sk = A.skip[c];
        const float cx0 = A.cw[c], cx1 = A.cw[3072 + c], cx2 = A.cw[6144 + c], cxb = A.cb[c];
        const float ca0 = A.cw[1024 + c], ca1 = A.cw[3072 + 1024 + c], ca2 = A.cw[6144 + 1024 + c], cab = A.cb[1024 + c];
        const float cv0 = A.cw[2048 + c], cv1 = A.cw[3072 + 2048 + c], cv2 = A.cw[6144 + 2048 + c], cvb = A.cb[2048 + c];
        cf Kr[16];
        HDMA_WAIT();
        {
            const pg8::f32x4 s0 = *(const LAS pg8::f32x4*)(lds + HOFF_SF + 16 * tid), s1 = *(const LAS pg8::f32x4*)(lds + HOFF_SF + 8192 + 16 * tid);
            const pg8::f32x4 d0 = *(const LAS pg8::f32x4*)(lds + HOFF_SF + 16384 + 16 * tid), d1 = *(const LAS pg8::f32x4*)(lds + HOFF_SF + 24576 + 16 * tid);
            const float fs[8] = {s0[0], s0[1], s0[2], s0[3], s1[0], s1[1], s1[2], s1[3]}, fd[8] = {d0[0], d0[1], d0[2], d0[3], d1[0], d1[1], d1[2], d1[3]};
#pragma unroll
            for (int i = 0; i < 8; ++i) { cf wq = wp; FFT_OPAQUE(wq); const cf tw = cmul(wq, cmk(W8C[i], -W8S[i])); stz(Z, pb + i, cmk(fs[i], 0.f)); stz(Z, FSUB + pb + i, cmk(fd[i] * tw.x, fd[i] * tw.y)); }
        }
        HBAR();
        fwd_pass1(Zs, t, w1); HBAR();
        fwd_pass2(Zs, t, w2); WAVE_FENCE();
        fwd_pass3_load(Zs, t, Kr);
#pragma unroll
        for (int j = 0; j < 16; ++j) { Kr[j].x *= (1.0f / 8192.0f); Kr[j].y *= (1.0f / 8192.0f); }
        HBAR();
        for (int p = 0; p < A.npairs; ++p) {
            const int o0 = p ? A.off10 : A.off00, o1 = p ? A.off11 : A.off01;
            float u0[8], u1[8];
            {
                float a[8], b[8];
                conv8s(lds + HOFF_SX1, tid, ca0, ca1, ca2, cab, a); conv8s(lds + HOFF_SV, tid, cv0, cv1, cv2, cvb, b);
#pragma unroll
                for (int i = 0; i < 8; ++i) u0[i] = a[i] * b[i];
                conv8s(lds + HOFF_SX1 + 8192, tid, ca0, ca1, ca2, cab, a); conv8s(lds + HOFF_SV + 8192, tid, cv0, cv1, cv2, cvb, b);
#pragma unroll
                for (int i = 0; i < 8; ++i) u1[i] = a[i] * b[i];
            }
#pragma unroll
            for (int i = 0; i < 8; ++i) { cf wq = wp; FFT_OPAQUE(wq); const cf tw = cmul(wq, cmk(W8C[i], -W8S[i])); const cf z = cmk(u0[i], u1[i]); stz(Z, pb + i, z); stz(Z, FSUB + pb + i, cmul(z, tw)); }
            HBAR();
            ISSUE_X0(c, o0, o1);
            if (p + 1 < A.npairs) ISSUE_PAIR(c, A.off10, A.off11);
            else if (cn < 1024) { ISSUE_PAIR(cn, A.off00, A.off01); ISSUE_FILT(cn); }
            fwd_pass1(Zs, t, w1); HBAR();
            fwd_pass2(Zs, t, w2); WAVE_FENCE();
            {
                cf v[16];
                fwd_pass3_load(Zs, t, v);
#pragma unroll
                for (int j = 0; j < 16; ++j) v[j] = cmul(v[j], Kr[j]);
                inv_pass1_store(Zs, t, v);
            }
            WAVE_FENCE();
            inv_pass2(Zs, t, w2); HBAR();
            inv_pass3(Zs, t, w1);
            HDMA_WAIT(); HBAR();
            {
                float y0[8], y1[8];
#pragma unroll
                for (int i = 0; i < 8; ++i) { cf wq = wp; FFT_OPAQUE(wq); const cf tw = cmul(wq, cmk(W8C[i], -W8S[i])); const cf e = ldz(Z, pb + i), o = ldz(Z, FSUB + pb + i); const cf y = cadd(e, cmul(o, cconj(tw))); y0[i] = y.x + sk * u0[i]; y1[i] = y.y + sk * u1[i]; }
                float x0c[8];
                conv8s(lds + HOFF_SX0, tid, cx0, cx1, cx2, cxb, x0c);
                *(pg8::u32x4*)(A.yaT + (size_t)c * A.TS + o0 + 8 * tid) = pack8(x0c, y0);
                if (o1 != o0) { conv8s(lds + HOFF_SX0 + 8192, tid, cx0, cx1, cx2, cxb, x0c); *(pg8::u32x4*)(A.yaT + (size_t)c * A.TS + o1 + 8 * tid) = pack8(x0c, y1); }
            }
        }
    }
    HDMA_WAIT(); HBAR();
#undef ISSUE_PAIR
#undef ISSUE_X0
#undef ISSUE_FILT
}
}
namespace pg8 {
__device__ __forceinline__ f32x2 sigmoid_pk(f32x2 v) {
    f32x2 e; e.x = __builtin_amdgcn_exp2f(v.x * -1.4426950408889634f); e.y = __builtin_amdgcn_exp2f(v.y * -1.4426950408889634f);
    f32x2 o; o.x = __builtin_amdgcn_rcpf(1.0f + e.x); o.y = __builtin_amdgcn_rcpf(1.0f + e.y); return o;
}
struct EpiHyT {
    static constexpr bool PERM = true, AFTER_DRAIN = false, MID = false, OVL = false;
    bf16_t* O; int ldc; float* vss;
    __device__ __forceinline__ void operator()(const f32x4 (&acc)[2][2][4][2], const Unit& u, int wr, int wc, int fr, int fq) const {
        const int row0 = u.pm * BM + wr * 64 + fr, col0 = u.pn * BM + wc * 32 + 8 * fq;
        const bool isv = u.pm >= 12;
        f32x4 ss[2][2];
#pragma unroll
        for (int bj = 0; bj < 2; ++bj)
#pragma unroll
            for (int n = 0; n < 2; ++n) ss[bj][n] = (f32x4){0.f, 0.f, 0.f, 0.f};
#pragma unroll
        for (int ai = 0; ai < 2; ++ai)
#pragma unroll
            for (int m = 0; m < 4; ++m) { bf16_t* rowp = O + (size_t)(row0 + ai * HALF + m * 16) * ldc + col0;
#pragma unroll
                for (int bj = 0; bj < 2; ++bj) { f32x4 v0 = acc[ai][bj][m][0], v1 = acc[ai][bj][m][1];
                    if (isv) { f32x2 a = gelu_pk((f32x2){v0[0], v0[1]}), b = gelu_pk((f32x2){v0[2], v0[3]}), c = gelu_pk((f32x2){v1[0], v1[1]}), d = gelu_pk((f32x2){v1[2], v1[3]});
                        v0 = (f32x4){a.x, a.y, b.x, b.y}; v1 = (f32x4){c.x, c.y, d.x, d.y}; ss[bj][0] += v0 * v0; ss[bj][1] += v1 * v1; }
                    u32x4 w; w.x = cvt_pk_bf16(v0[0], v0[1]); w.y = cvt_pk_bf16(v0[2], v0[3]); w.z = cvt_pk_bf16(v1[0], v1[1]); w.w = cvt_pk_bf16(v1[2], v1[3]);
                    *(u32x4*)(rowp + bj * HALF) = w; } }
        if (isv) {
#pragma unroll
            for (int bj = 0; bj < 2; ++bj)
#pragma unroll
                for (int n = 0; n < 2; ++n)
#pragma unroll
                    for (int j = 0; j < 4; ++j) { float s = ss[bj][n][j]; s += __shfl_xor(s, 1); s += __shfl_xor(s, 2); s += __shfl_xor(s, 4); s += __shfl_xor(s, 8);
                        if (fr == 0) atomicAdd(vss + col0 + bj * HALF + 4 * n + j, s); }
        }
    }
};
struct EpiUG {
    static constexpr bool PERM = true, AFTER_DRAIN = false, MID = false, OVL = false;
    bf16_t* U; bf16_t* G; int ldu;
    __device__ __forceinline__ void operator()(const f32x4 (&acc)[2][2][4][2], const Unit& u, int wr, int wc, int fr, int fq) const {
        const int row0 = u.pm * BM + wr * 64 + fr; int colt = u.pn * BM; const bool isu = colt < 1024;
        bf16_t* base = isu ? U : G; const int ldc = isu ? ldu : 2048; if (!isu) colt -= 1024;
        const int col0 = colt + wc * 32 + 8 * fq;
#pragma unroll
        for (int ai = 0; ai < 2; ++ai)
#pragma unroll
            for (int m = 0; m < 4; ++m) { bf16_t* rowp = base + (size_t)(row0 + ai * HALF + m * 16) * ldc + col0;
#pragma unroll
                for (int bj = 0; bj < 2; ++bj) { f32x4 v0 = acc[ai][bj][m][0], v1 = acc[ai][bj][m][1];
                    f32x2 a, b, c, d;
                    if (isu) { a = gelu_pk((f32x2){v0[0], v0[1]}); b = gelu_pk((f32x2){v0[2], v0[3]}); c = gelu_pk((f32x2){v1[0], v1[1]}); d = gelu_pk((f32x2){v1[2], v1[3]}); }
                    else { a = sigmoid_pk((f32x2){v0[0], v0[1]}); b = sigmoid_pk((f32x2){v0[2], v0[3]}); c = sigmoid_pk((f32x2){v1[0], v1[1]}); d = sigmoid_pk((f32x2){v1[2], v1[3]}); }
                    u32x4 w; w.x = cvt_pk_bf16(a.x, a.y); w.y = cvt_pk_bf16(b.x, b.y); w.z = cvt_pk_bf16(c.x, c.y); w.w = cvt_pk_bf16(d.x, d.y);
                    *(u32x4*)(rowp + bj * HALF) = w; } }
    }
};
}
namespace {
struct WJob { const float* W; const float* g; bf16* dst; int K, N, c0, nc, ldd, r0, koff, perm; };
constexpr int NWJ = 9;
struct WJobs { WJob j[NWJ]; };
__device__ __forceinline__ unsigned pk2(float lo, float hi) { return f2bf(lo) | (f2bf(hi) << 16); }
__device__ __forceinline__ void wT_item(const WJob& J, LAS float* scr, int item, int lane) {
    const int nblk = J.nc / 32, kb = item / nblk, nb = item % nblk, k0 = 64 * kb, n0 = 32 * nb;
    float v[32];
#pragma unroll
    for (int i = 0; i < 32; ++i) v[i] = J.W[(size_t)(k0 + 2 * i + (lane >> 5)) * J.N + J.c0 + n0 + (lane & 31)];
    if (J.g) {
#pragma unroll
        for (int i = 0; i < 32; ++i) v[i] *= J.g[k0 + 2 * i + (lane >> 5)]; }
#pragma unroll
    for (int i = 0; i < 32; ++i) scr[(2 * i + (lane >> 5)) * 33 + (lane & 31)] = v[i];
    asm volatile("s_waitcnt lgkmcnt(0)" ::: "memory");
    const int c = lane & 7; int rb = n0;
    if (J.perm) { const int half = n0 >= 2816, cc = n0 - half * 2816; rb = 256 * (cc >> 7) + 128 * half + (cc & 127); }
#pragma unroll
    for (int j = 0; j < 4; ++j) { const int n = (lane >> 3) + 8 * j; const LAS float* s = scr + (8 * c) * 33 + n;
        uint4 o; o.x = pk2(s[0 * 33], s[1 * 33]); o.y = pk2(s[2 * 33], s[3 * 33]); o.z = pk2(s[4 * 33], s[5 * 33]); o.w = pk2(s[6 * 33], s[7 * 33]);
        *(uint4*)(J.dst + (size_t)(J.r0 + rb + n) * J.ldd + J.koff + k0 + 8 * c) = o; }
    asm volatile("s_waitcnt lgkmcnt(0)" ::: "memory");
}
__device__ __forceinline__ void p0_weights(const WJobs& WJ, int jlo, int jhi, LAS float* scr, int gw, int NGW, int lane) {
    int base = 0;
    for (int q = jlo; q < jhi; ++q) {
        const WJob& J = WJ.j[q]; const int ni = (J.K / 64) * (J.nc / 32);
        int it = gw - (base % NGW); if (it < 0) it += NGW;
        for (; it < ni; it += NGW) wT_item(J, scr, it, lane);
        base += ni;
    }
}
__device__ __forceinline__ float wave_sum(float v) {
#pragma unroll
    for (int o = 1; o < 64; o <<= 1) v += __shfl_xor(v, o);
    return v;
}
__device__ __forceinline__ void rms_row_to_bf16(const float* xrow, const float* g, bf16* orow, int lane) {
    const float4* xr = (const float4*)xrow + lane; const float4* gr = (const float4*)g + lane;
    float4 v[4]; float s = 0.f;
#pragma unroll
    for (int j = 0; j < 4; ++j) { v[j] = xr[64 * j]; s += (v[j].x * v[j].x + v[j].y * v[j].y) + (v[j].z * v[j].z + v[j].w * v[j].w); }
    const float r = rsqrtf(wave_sum(s) * (1.f / 1024.f) + EPS);
    unsigned long long* o8 = (unsigned long long*)orow + lane;
#pragma unroll
    for (int j = 0; j < 4; ++j) { const float4 gg = gr[64 * j];
        o8[64 * j] = (unsigned long long)pk2(v[j].x * r * gg.x, v[j].y * r * gg.y) | ((unsigned long long)pk2(v[j].z * r * gg.z, v[j].w * r * gg.w) << 32); }
}
__device__ __forceinline__ void rms_rows4_to_bf16(const float* xrow, const float* g, bf16* orow, int ldo, int lane) {
    float4 v[4][4]; float s[4];
#pragma unroll
    for (int r = 0; r < 4; ++r)
#pragma unroll
        for (int j = 0; j < 4; ++j) v[r][j] = ((const float4*)(xrow + (size_t)r * 1024) + lane)[64 * j];
#pragma unroll
    for (int r = 0; r < 4; ++r) { s[r] = 0.f;
#pragma unroll
        for (int j = 0; j < 4; ++j) s[r] += (v[r][j].x * v[r][j].x + v[r][j].y * v[r][j].y) + (v[r][j].z * v[r][j].z + v[r][j].w * v[r][j].w); }
#pragma unroll
    for (int r = 0; r < 4; ++r) { const float rr = rsqrtf(wave_sum(s[r]) * (1.f / 1024.f) + EPS);
        unsigned long long* o8 = (unsigned long long*)(orow + (size_t)r * ldo) + lane;
#pragma unroll
        for (int j = 0; j < 4; ++j) { const float4 gg = ((const float4*)g + lane)[64 * j];
            o8[64 * j] = (unsigned long long)pk2(v[r][j].x * rr * gg.x, v[r][j].y * rr * gg.y) | ((unsigned long long)pk2(v[r][j].z * rr * gg.z, v[r][j].w * rr * gg.w) << 32); } }
}
}

namespace {
struct SguArgs {
    const bf16* vT;
    bf16* U;
    const float* vss;
    const float* ws;
    const float* bs;
    const float* gn;
    int TS, ldu;
};
typedef short bf16x8_t __attribute__((ext_vector_type(8)));
typedef float f32x4_t __attribute__((ext_vector_type(4)));
#define SBAR() do { asm volatile("s_waitcnt lgkmcnt(0)" ::: "memory"); __builtin_amdgcn_s_barrier(); asm volatile("" ::: "memory"); } while (0)
__device__ __forceinline__ void sgu_phase(LAS unsigned char* lds, const SguArgs& A, int first, int stride, const int tid, const int wave) {
    const int nitems = (A.TS / 128) * 8;
    if (first >= nitems) return;
    const int lane = tid & 63, fr = lane & 15, fq = lane >> 4, p = 16 * wave + fr;
    LAS float* rtab = (LAS float*)(lds + 131072);
    LAS float* gnl = (LAS float*)(lds + 131072 + 4096);
#define SGU_ISSUE(item, buf) do { const int g_ = (item) & 7, tok0_ = ((item) >> 3) * 128; \
        _Pragma("unroll") for (int i_ = 0; i_ < 4; ++i_) { const int r_ = (i_ * 8 + wave) * 4 + (lane >> 4), c_ = (lane & 15) ^ (r_ & 15); \
            __builtin_amdgcn_global_load_lds((const unsigned*)(A.vT + (size_t)(g_ * 128 + r_) * A.TS + tok0_ + 8 * c_), (LAS unsigned*)(lds + (buf) * 65536 + (i_ * 8 + wave) * 1024), 16, 0, 0); \
            __builtin_amdgcn_global_load_lds((const unsigned*)(A.U + (size_t)(tok0_ + r_) * A.ldu + g_ * 128 + 8 * c_), (LAS unsigned*)(lds + (buf) * 65536 + 32768 + (i_ * 8 + wave) * 1024), 16, 0, 0); } } while (0)
    SGU_ISSUE(first, 0);
    int gcur = -1; float wf[4][8]; float bsp = 0.f;
    for (int e = tid; e < 1024; e += 512) { const int k = e >> 7, it = first + k * stride;
        if (it < nitems) rtab[e] = rsqrtf(A.vss[(it >> 3) * 128 + (e & 127)] * (1.f / 1024.f) + EPS); }
    int k = 0;
    for (int it = first; it < nitems; it += stride, ++k) {
        const int g = it & 7, tok0 = (it >> 3) * 128, buf = k & 1;
        if (g != gcur) {
            gcur = g;
#pragma unroll
            for (int kk = 0; kk < 4; ++kk) { const float4 w0 = *(const float4*)(A.ws + ((size_t)g * 128 + p) * 128 + 32 * kk + 8 * fq), w1 = *(const float4*)(A.ws + ((size_t)g * 128 + p) * 128 + 32 * kk + 8 * fq + 4);
                wf[kk][0] = w0.x; wf[kk][1] = w0.y; wf[kk][2] = w0.z; wf[kk][3] = w0.w; wf[kk][4] = w1.x; wf[kk][5] = w1.y; wf[kk][6] = w1.z; wf[kk][7] = w1.w; }
            bsp = A.bs[g * 128 + p];
            SBAR();
            if (tid < 128) gnl[tid] = A.gn[g * 128 + tid];
        }
        asm volatile("s_waitcnt vmcnt(0)" ::: "memory"); SBAR();
        if (it + stride < nitems) SGU_ISSUE(it + stride, buf ^ 1);
        const LAS unsigned char* BT = lds + buf * 65536; const LAS unsigned char* UT = BT + 32768;
        bf16x8_t af[4];
#pragma unroll
        for (int kk = 0; kk < 4; ++kk) { const f32x4_t r0 = *(const LAS f32x4_t*)(rtab + k * 128 + 32 * kk + 8 * fq), r1 = *(const LAS f32x4_t*)(rtab + k * 128 + 32 * kk + 8 * fq + 4);
            uint4 o; o.x = pk2(wf[kk][0] * r0[0], wf[kk][1] * r0[1]); o.y = pk2(wf[kk][2] * r0[2], wf[kk][3] * r0[3]); o.z = pk2(wf[kk][4] * r1[0], wf[kk][5] * r1[1]); o.w = pk2(wf[kk][6] * r1[2], wf[kk][7] * r1[3]);
            af[kk] = __builtin_bit_cast(bf16x8_t, o); }
        f32x4_t acc[8];
#pragma unroll
        for (int nt = 0; nt < 8; ++nt) acc[nt] = (f32x4_t){0.f, 0.f, 0.f, 0.f};
#pragma unroll
        for (int kk = 0; kk < 4; ++kk) {
            bf16x8_t bfr[8];
#pragma unroll
            for (int nt = 0; nt < 8; ++nt) bfr[nt] = *(const LAS bf16x8_t*)(BT + (16 * nt + fr) * 256 + 16 * ((4 * kk + fq) ^ fr));
#pragma unroll
            for (int nt = 0; nt < 8; ++nt) acc[nt] = __builtin_amdgcn_mfma_f32_16x16x32_bf16(bfr[nt], af[kk], acc[nt], 0, 0, 0);
        }
        bf16* urow = A.U + (size_t)(tok0 + p) * A.ldu + g * 128 + 4 * fq;
#pragma unroll
        for (int nt = 0; nt < 8; ++nt) {
            typedef unsigned u32x2_t __attribute__((ext_vector_type(2)));
            const u32x2_t uu = *(const LAS u32x2_t*)(UT + p * 256 + 16 * ((2 * nt + (fq >> 1)) ^ fr) + 8 * (fq & 1));
            const f32x4_t gv = *(const LAS f32x4_t*)(gnl + 16 * nt + 4 * fq);
            const float y0 = bf2f(uu.x & 0xffffu) * (gv[0] * acc[nt][0] + bsp), y1 = bf2f(uu.x >> 16) * (gv[1] * acc[nt][1] + bsp);
            const float y2 = bf2f(uu.y & 0xffffu) * (gv[2] * acc[nt][2] + bsp), y3 = bf2f(uu.y >> 16) * (gv[3] * acc[nt][3] + bsp);
            uint2 o; o.x = pk2(y0, y1); o.y = pk2(y2, y3);
            *(uint2*)(urow + 16 * nt) = o;
        }
    }
    asm volatile("s_waitcnt vmcnt(0)" ::: "memory"); SBAR();
#undef SGU_ISSUE
}
}

namespace pg8 {
__device__ __forceinline__ void bf8_to_f32(const u32x4 q, f32x4& lo, f32x4& hi) {
    lo = (f32x4){__builtin_bit_cast(float, q.x << 16), __builtin_bit_cast(float, q.x & 0xffff0000u), __builtin_bit_cast(float, q.y << 16), __builtin_bit_cast(float, q.y & 0xffff0000u)};
    hi = (f32x4){__builtin_bit_cast(float, q.z << 16), __builtin_bit_cast(float, q.z & 0xffff0000u), __builtin_bit_cast(float, q.w << 16), __builtin_bit_cast(float, q.w & 0xffff0000u)};
}
struct EpiMerge {
    static constexpr bool PERM = true, AFTER_DRAIN = false, MID = true, OVL = false;
    const bf16_t* G; bf16_t* O;
    __device__ __forceinline__ void mid(f32x4 (&acc)[2][2][4][2], const Unit& u, int wr, int wc, int fr, int fq) const {
        unsigned off0 = (unsigned)(u.pm * BM + wr * 64 + fr) * 2048u + (unsigned)(u.pn * BM + wc * 32 + 8 * fq);
        asm volatile("" : "+v"(off0));
#pragma unroll
        for (int ai = 0; ai < 2; ++ai)
#pragma unroll
            for (int m = 0; m < 4; ++m)
#pragma unroll
                for (int bj = 0; bj < 2; ++bj) { const bf16_t* gp = G + (off0 + (unsigned)((ai * HALF + m * 16) * 2048 + bj * HALF));
                    const u32x4 qa = *(const u32x4*)gp, qb = *(const u32x4*)(gp + 1024);
                    f32x4 a0, a1, b0, b1; bf8_to_f32(qa, a0, a1); bf8_to_f32(qb, b0, b1);
#pragma unroll
                    for (int j = 0; j < 4; ++j) { acc[ai][bj][m][0][j] *= a0[j] * __builtin_amdgcn_rcpf(b0[j]); acc[ai][bj][m][1][j] *= a1[j] * __builtin_amdgcn_rcpf(b1[j]); }
                    asm volatile("" ::: "memory"); }
    }
    __device__ __forceinline__ void operator()(const f32x4 (&acc)[2][2][4][2], const Unit& u, int wr, int wc, int fr, int fq) const {
        const int row0 = u.pm * BM + wr * 64 + fr, col0 = u.pn * BM + wc * 32 + 8 * fq;
#pragma unroll
        for (int ai = 0; ai < 2; ++ai)
#pragma unroll
            for (int m = 0; m < 4; ++m) { const size_t r = (size_t)(row0 + ai * HALF + m * 16);
#pragma unroll
                for (int bj = 0; bj < 2; ++bj) { f32x4 b0, b1; bf8_to_f32(*(const u32x4*)(G + r * 2048 + 1024 + col0 + bj * HALF), b0, b1);
                    const f32x4 v0 = acc[ai][bj][m][0] * b0, v1 = acc[ai][bj][m][1] * b1;
                    u32x4 w; w.x = cvt_pk_bf16(v0[0], v0[1]); w.y = cvt_pk_bf16(v0[2], v0[3]); w.z = cvt_pk_bf16(v1[0], v1[1]); w.w = cvt_pk_bf16(v1[2], v1[3]);
                    *(u32x4*)(O + r * 1024 + col0 + bj * HALF) = w; } }
    }
};
}
namespace {
__device__ __forceinline__ void tr64_item(const bf16* yaT, int TS, bf16* out, int ldo, LAS unsigned short* scr, int c0, int t0, int lane) {
#pragma unroll
    for (int i = 0; i < 8; ++i) { const int r = 8 * i + (lane >> 3), ch = lane & 7;
        const pg8::u32x4 q = *(const pg8::u32x4*)(yaT + (size_t)(c0 + r) * TS + t0 + 8 * ch);
        LAS unsigned short* d = scr + (8 * ch) * 72 + r;
        d[0 * 72] = (unsigned short)(q.x & 0xffffu); d[1 * 72] = (unsigned short)(q.x >> 16); d[2 * 72] = (unsigned short)(q.y & 0xffffu); d[3 * 72] = (unsigned short)(q.y >> 16);
        d[4 * 72] = (unsigned short)(q.z & 0xffffu); d[5 * 72] = (unsigned short)(q.z >> 16); d[6 * 72] = (unsigned short)(q.w & 0xffffu); d[7 * 72] = (unsigned short)(q.w >> 16); }
    asm volatile("s_waitcnt lgkmcnt(0)" ::: "memory");
#pragma unroll
    for (int i = 0; i < 8; ++i) { const int tk = 8 * i + (lane >> 3), ch = lane & 7;
        const pg8::u32x4 q = *(const LAS pg8::u32x4*)(scr + tk * 72 + 8 * ch);
        *(pg8::u32x4*)(out + (size_t)(t0 + tk) * ldo + c0 + 8 * ch) = q; }
    asm volatile("s_waitcnt lgkmcnt(0)" ::: "memory");
}
__device__ __forceinline__ void transpose_ya(const bf16* yaT, int TS, bf16* out, int ldo, LAS unsigned short* scr, int gw, int NGW, int lane) {
    const int ntt = TS / 64, nit = 16 * ntt;
    for (int it = gw; it < nit; it += NGW) tr64_item(yaT, TS, out, ldo, scr, 64 * (it / ntt), 64 * (it % ntt), lane);
}
}

namespace pg8 {
template <bool FIRST> struct EpiResid {
    static constexpr bool PERM = false, AFTER_DRAIN = false, MID = false, OVL = false;
    const float* X; const bf16_t* XB; float* X1; bf16_t* X1b; float* xss;
    __device__ __forceinline__ void operator()(const f32x4 (&acc)[2][2][4][2], const Unit& u, int wr, int wc, int fr, int fq) const {
        const int row0 = u.pm * BM + wr * 64 + fr, col0 = u.pn * BM + wc * 32 + 4 * fq;
        typedef unsigned u32x2v __attribute__((ext_vector_type(2)));
#pragma unroll
        for (int ai = 0; ai < 2; ++ai)
#pragma unroll
            for (int m = 0; m < 4; ++m) { const size_t r = (size_t)(row0 + ai * HALF + m * 16); float s = 0.f;
#pragma unroll
                for (int bj = 0; bj < 2; ++bj)
#pragma unroll
                    for (int n = 0; n < 2; ++n) { const size_t o = r * 1024 + col0 + bj * HALF + n * 16;
                        f32x4 v;
                        if (FIRST) v = acc[ai][bj][m][n] + *(const f32x4*)(X + o);
                        else { const u32x2v q = *(const u32x2v*)(XB + o);
                               v = acc[ai][bj][m][n] + (f32x4){__builtin_bit_cast(float, q.x << 16), __builtin_bit_cast(float, q.x & 0xffff0000u), __builtin_bit_cast(float, q.y << 16), __builtin_bit_cast(float, q.y & 0xffff0000u)}; }
                        { u32x2v w; w.x = cvt_pk_bf16(v[0], v[1]); w.y = cvt_pk_bf16(v[2], v[3]); *(u32x2v*)(X1b + o) = w; }
                        s += (v[0] * v[0] + v[1] * v[1]) + (v[2] * v[2] + v[3] * v[3]); }
                s += __shfl_xor(s, 16); s += __shfl_xor(s, 32);
                if (fq == 0) atomicAdd(xss + r, s);
                asm volatile("" ::: "memory"); }
    }
};
struct EpiResidNorm {
    static constexpr bool PERM = false, AFTER_DRAIN = true, MID = false, OVL = false;
    const bf16_t* XB; float* out; float* x2ss; const float* g; unsigned* cnt;
    __device__ __forceinline__ void fused(f32x4 (&acc)[2][2][4][2], const Unit& u, int wr, int wc, int fr, int fq, PG8_LAS unsigned char* lds, int wid, int lane) const {
        typedef unsigned u32x2v __attribute__((ext_vector_type(2)));
        const int row0 = u.pm * BM + wr * 64 + fr, col0 = u.pn * BM + wc * 32 + 4 * fq;
        float keep = 0.f;
#pragma unroll
        for (int ai = 0; ai < 2; ++ai)
#pragma unroll
            for (int m = 0; m < 4; ++m) { const size_t r = (size_t)(row0 + ai * HALF + m * 16); float s = 0.f;
#pragma unroll
                for (int bj = 0; bj < 2; ++bj)
#pragma unroll
                    for (int n = 0; n < 2; ++n) { const u32x2v q = *(const u32x2v*)(XB + r * 1024 + col0 + bj * HALF + n * 16);
                        const f32x4 v = acc[ai][bj][m][n] + (f32x4){__builtin_bit_cast(float, q.x << 16), __builtin_bit_cast(float, q.x & 0xffff0000u), __builtin_bit_cast(float, q.y << 16), __builtin_bit_cast(float, q.y & 0xffff0000u)};
                        acc[ai][bj][m][n] = v; s += (v[0] * v[0] + v[1] * v[1]) + (v[2] * v[2] + v[3] * v[3]); }
                s += __shfl_xor(s, 16); s += __shfl_xor(s, 32);
                if (fq == 0) keep += atomicAdd(x2ss + r, s); }
        asm volatile("s_waitcnt vmcnt(0)" :: "v"(keep) : "memory");
        asm volatile("s_waitcnt lgkmcnt(0)" ::: "memory"); __builtin_amdgcn_s_barrier(); asm volatile("" ::: "memory");
        if (wid == 0) {
            if (lane == 0) { __hip_atomic_fetch_add(cnt + 64 * u.pm, 1u, __ATOMIC_RELAXED, __HIP_MEMORY_SCOPE_AGENT);
                unsigned spins = 0;
                while (__hip_atomic_load(cnt + 64 * u.pm, __ATOMIC_RELAXED, __HIP_MEMORY_SCOPE_AGENT) < 4u) { __builtin_amdgcn_s_sleep(2); if (++spins > (1u << 22)) break; } }
            __builtin_amdgcn_fence(__ATOMIC_ACQUIRE, "agent");
            asm volatile("s_waitcnt vmcnt(0)" ::: "memory");
        }
        asm volatile("s_waitcnt lgkmcnt(0)" ::: "memory"); __builtin_amdgcn_s_barrier(); asm volatile("" ::: "memory");
        f32x4 gv[2][2];
#pragma unroll
        for (int bj = 0; bj < 2; ++bj)
#pragma unroll
            for (int n = 0; n < 2; ++n) gv[bj][n] = *(const f32x4*)(g + col0 + bj * HALF + n * 16);
#pragma unroll
        for (int ai = 0; ai < 2; ++ai)
#pragma unroll
            for (int m = 0; m < 4; ++m) { const size_t r = (size_t)(row0 + ai * HALF + m * 16);
                const float rs = rsqrtf(__hip_atomic_load(x2ss + r, __ATOMIC_RELAXED, __HIP_MEMORY_SCOPE_AGENT) * (1.0f / 1024.0f) + 1e-6f);
#pragma unroll
                for (int bj = 0; bj < 2; ++bj)
#pragma unroll
                    for (int n = 0; n < 2; ++n) *(f32x4*)(out + r * 1024 + col0 + bj * HALF + n * 16) = acc[ai][bj][m][n] * gv[bj][n] * rs; }
    }
};
__device__ __forceinline__ float dpp_ror1(float v) { return __builtin_bit_cast(float, __builtin_amdgcn_update_dpp(0, __builtin_bit_cast(int, v), 0x121, 0xf, 0xf, false)); }
__device__ __forceinline__ float dpp_rol1(float v) { return __builtin_bit_cast(float, __builtin_amdgcn_update_dpp(0, __builtin_bit_cast(int, v), 0x12f, 0xf, 0xf, false)); }
struct EpiUpAct {
    static constexpr bool PERM = true, AFTER_DRAIN = false, MID = false, OVL = true;
    bf16_t* ACT; PG8_LAS float* XB; const float* xss; const float* cw; const float* cb;
    __device__ __forceinline__ void operator()(f32x4 (&acc)[2][2][4][2], const Unit& u, int wr, int wc, int fr_, int fq_) const {
        int lane_; asm volatile("v_mbcnt_lo_u32_b32 %0, -1, 0\n\tv_mbcnt_hi_u32_b32 %0, -1, %0" : "=v"(lane_));
        const int fr = lane_ & 15, fq = lane_ >> 4; (void)fr_; (void)fq_;
        const int seq = u.pm / 17, ti = u.pm % 17, rowbase = ovl_row(u.pm);
        const int own_lo = seq * 4096 + 254 * ti, own_hi = seq * 4096 + (254 * ti + 254 < 4096 ? 254 * ti + 254 : 4096);
        const int lr0 = wr * 64 + fr, cl = 32 * wc + 8 * fq;
#pragma unroll
        for (int ai = 0; ai < 2; ++ai)
#pragma unroll
            for (int m = 0; m < 4; ++m) { const float rs = rsqrtf(xss[rowbase + lr0 + ai * HALF + m * 16] * (1.0f / 1024.0f) + 1e-6f);
#pragma unroll
                for (int bj = 0; bj < 2; ++bj) { acc[ai][bj][m][0] *= rs; acc[ai][bj][m][1] *= rs; }
                __builtin_amdgcn_sched_barrier(0); }
        const bool e0 = fr == 0, e15 = fr == 15;
        const int slot = e0 ? 0 : (e15 ? 512 : 1024);
#pragma unroll
        for (int ai = 0; ai < 2; ++ai) { const int B = 2 * ai + wr;
            f32x4 p0, p1;
#pragma unroll
            for (int j = 0; j < 4; ++j) { p0[j] = e15 ? acc[ai][0][3][0][j] : acc[ai][0][0][0][j]; p1[j] = e15 ? acc[ai][0][3][1][j] : acc[ai][0][0][1][j]; }
            *(PG8_LAS f32x4*)(XB + slot + B * 128 + cl) = p0; *(PG8_LAS f32x4*)(XB + slot + B * 128 + cl + 4) = p1; }
        asm volatile("s_waitcnt lgkmcnt(0)" ::: "memory"); __builtin_amdgcn_s_barrier(); asm volatile("" ::: "memory");
        const int ch = 128 * u.pn + cl;
        typedef unsigned u32x2v __attribute__((ext_vector_type(2)));
#pragma unroll
        for (int ai = 0; ai < 2; ++ai) { const int B = 2 * ai + wr;
#pragma unroll
            for (int n = 0; n < 2; ++n) {
                const f32x4 w0 = *(const f32x4*)(cw + ch + 4 * n), w1 = *(const f32x4*)(cw + 2816 + ch + 4 * n), w2 = *(const f32x4*)(cw + 5632 + ch + 4 * n), bb = *(const f32x4*)(cb + ch + 4 * n);
                f32x4 pb = *(const PG8_LAS f32x4*)(XB + 512 + (B > 0 ? B - 1 : 0) * 128 + cl + 4 * n), nb = *(const PG8_LAS f32x4*)(XB + (B < 3 ? B + 1 : 3) * 128 + cl + 4 * n);
                if (B == 0) pb = (f32x4){0.f, 0.f, 0.f, 0.f};
                if (B == 3) nb = (f32x4){0.f, 0.f, 0.f, 0.f};
                float o[4][4];
#pragma unroll
                for (int j = 0; j < 4; ++j) {
                    float av[4], rr[4], ll[4];
#pragma unroll
                    for (int m = 0; m < 4; ++m) { av[m] = acc[ai][0][m][n][j]; rr[m] = dpp_ror1(av[m]); ll[m] = dpp_rol1(av[m]); }
#pragma unroll
                    for (int m = 0; m < 4; ++m) { const float pv = e0 ? (m > 0 ? rr[m - 1] : pb[j]) : rr[m], nv = e15 ? (m < 3 ? ll[m + 1] : nb[j]) : ll[m];
                        const float sv = bb[j] + w0[j] * pv + w1[j] * av[m] + w2[j] * nv;
                        o[m][j] = sv * __builtin_amdgcn_rcpf(1.0f + __builtin_amdgcn_exp2f(sv * -1.4426950408889634f)) * acc[ai][1][m][n][j]; }
                }
#pragma unroll
                for (int m = 0; m < 4; ++m) { const int tok = rowbase + lr0 + ai * HALF + m * 16;
                    if (tok >= own_lo && tok < own_hi) { u32x2v w; w.x = cvt_pk_bf16(o[m][0], o[m][1]); w.y = cvt_pk_bf16(o[m][2], o[m][3]); *(u32x2v*)(ACT + (size_t)tok * 2816 + ch + 4 * n) = w; } }
                __builtin_amdgcn_sched_barrier(0);
            } }
    }
};
}
namespace {
__device__ __forceinline__ void final_norm(const bf16* X2, const float* ss, const float* g, float* out, int TS, int gw, int NGW, int lane) {
    pg8::f32x4 g0[2], g1[2];
#pragma unroll
    for (int j = 0; j < 2; ++j) { g0[j] = *((const pg8::f32x4*)g + 2 * lane + 128 * j); g1[j] = *((const pg8::f32x4*)g + 2 * lane + 128 * j + 1); }
    for (int t = 2 * gw; t < TS; t += 2 * NGW) {
        pg8::u32x4 q[2][2]; float r[2];
#pragma unroll
        for (int k = 0; k < 2; ++k) { r[k] = rsqrtf(ss[t + k] * (1.0f / 1024.0f) + EPS);
#pragma unroll
            for (int j = 0; j < 2; ++j) q[k][j] = *((const pg8::u32x4*)(X2 + (size_t)(t + k) * 1024) + lane + 64 * j); }
#pragma unroll
        for (int k = 0; k < 2; ++k)
#pragma unroll
            for (int j = 0; j < 2; ++j) { pg8::f32x4 lo, hi; pg8::bf8_to_f32(q[k][j], lo, hi);
                pg8::f32x4* o = (pg8::f32x4*)(out + (size_t)(t + k) * 1024) + 2 * lane + 128 * j;
                o[0] = lo * g0[j] * r[k]; o[1] = hi * g1[j] * r[k]; }
    }
}
}

namespace {
constexpr int MLPW_W2 = 33 * 64, MLPW_W3 = MLPW_W2 + 4096, MLPW_B = MLPW_W3 + 4096, MLPW_N = MLPW_B + 256;
__device__ __forceinline__ float filt_z(int l, int j) {
    if (j == 0) return (float)((double)l / (double)(L - 1));
    const int i = (j - 1) & 15;
    const double band = 1e-4 + (double)i * ((15.0 - 1e-4) / 15.0);
    double rev = (double)l * band / (double)L;
    rev -= floor(rev);
    const float ang = (float)(rev * 6.283185307179586);
    return (j <= 16) ? cosf(ang) : -sinf(ang);
}
__device__ __forceinline__ void filter_mlp_rows2(const LAS float* wl, float* h3out, LAS float* scr, int l0, int l1, int j) {
    LAS float* za = scr; LAS float* zb = scr + 64;
    if (j < FEMB) { za[j] = filt_z(l0, j); zb[j] = filt_z(l1, j); }
    asm volatile("s_waitcnt lgkmcnt(0)" ::: "memory");
    const float a = wl[MLPW_B + 192 + j];
    float s0 = wl[MLPW_B + j], s1 = s0;
#pragma unroll 11
    for (int i = 0; i < FEMB; ++i) { const float w = wl[i * 64 + j]; s0 += za[i] * w; s1 += zb[i] * w; }
    asm volatile("s_waitcnt lgkmcnt(0)" ::: "memory");
    za[j] = sinf(a * s0); zb[j] = sinf(a * s1);
    asm volatile("s_waitcnt lgkmcnt(0)" ::: "memory");
    s0 = wl[MLPW_B + 64 + j]; s1 = s0;
#pragma unroll 8
    for (int i = 0; i < FHID; ++i) { const float w = wl[MLPW_W2 + i * 64 + j]; s0 += za[i] * w; s1 += zb[i] * w; }
    asm volatile("s_waitcnt lgkmcnt(0)" ::: "memory");
    za[j] = sinf(a * s0); zb[j] = sinf(a * s1);
    asm volatile("s_waitcnt lgkmcnt(0)" ::: "memory");
    s0 = wl[MLPW_B + 128 + j]; s1 = s0;
#pragma unroll 8
    for (int i = 0; i < FHID; ++i) { const float w = wl[MLPW_W3 + i * 64 + j]; s0 += za[i] * w; s1 += zb[i] * w; }
    h3out[l0 * FHID + j] = sinf(a * s0); h3out[l1 * FHID + j] = sinf(a * s1);
    asm volatile("s_waitcnt lgkmcnt(0)" ::: "memory");
}
typedef float f32x16_t __attribute__((ext_vector_type(16)));
__device__ __forceinline__ void stage_h3_rows32(const float* h3, int row0, LAS float* scr, int lane) {
#pragma unroll
    for (int i = 0; i < 8; ++i) { const int e = 4 * (lane + 64 * i), r = e >> 6, jj = e & 63;
        if (row0 + r < 4096) { const pg8::f32x4 v = *(const pg8::f32x4*)(h3 + (size_t)(row0 + r) * 64 + jj);
            LAS float* d = scr + r * 65 + jj; d[0] = v[0]; d[1] = v[1]; d[2] = v[2]; d[3] = v[3]; } }
}
__device__ __forceinline__ void filter_tables(const float* h3, const float* w4, const float* decay, float* fsum, float* fdif, LAS float* scr, int gw, int NGW, int lane) {
    const int r = lane & 31, h = lane >> 5;
    for (int it = gw; it < 2048; it += NGW) {
        const int c0 = (it & 31) * 32, nbase = (it >> 5) * 64;
        float af[32], ab[32];
#pragma unroll
        for (int kk = 0; kk < 32; ++kk) { af[kk] = w4[(2 * kk + h) * 2048 + c0 + r]; ab[kk] = w4[(2 * kk + h) * 2048 + 1024 + c0 + r]; }
        float dcf[16], dcb[16];
#pragma unroll
        for (int q = 0; q < 16; ++q) { const int c = c0 + (q & 3) + 8 * (q >> 2) + 4 * h; dcf[q] = fabsf(decay[c]); dcb[q] = fabsf(decay[1024 + c]); }
#pragma unroll 1
        for (int half = 0; half < 2; ++half) {
            const int n0 = nbase + 32 * half, n = n0 + r, nb = n ? 4096 - n : 0;
            stage_h3_rows32(h3, n0, scr, lane);
            stage_h3_rows32(h3, 4096 - n0 - 31, scr + 32 * 65, lane);
            asm volatile("s_waitcnt lgkmcnt(0)" ::: "memory");
            f32x16_t accF, accB;
#pragma unroll
            for (int q = 0; q < 16; ++q) { accF[q] = 0.f; accB[q] = 0.f; }
#pragma unroll
            for (int kk = 0; kk < 32; ++kk) {
                const float bF = scr[r * 65 + 2 * kk + h], bB = scr[32 * 65 + (31 - r) * 65 + 2 * kk + h];
                accF = __builtin_amdgcn_mfma_f32_32x32x2f32(af[kk], bF, accF, 0, 0, 0);
                accB = __builtin_amdgcn_mfma_f32_32x32x2f32(ab[kk], bB, accB, 0, 0, 0);
            }
            const float tf = (float)n * (1.0f / 4095.0f), tb = (float)nb * (1.0f / 4095.0f);
#pragma unroll
            for (int q = 0; q < 16; ++q) { const int c = c0 + (q & 3) + 8 * (q >> 2) + 4 * h;
                const float hf = accF[q] * expf(-tf * dcf[q]);
                const float hb = n ? accB[q] * expf(-tb * dcb[q]) : 0.f;
                fsum[(size_t)c * 4096 + n] = hf + hb;
                fdif[(size_t)c * 4096 + n] = hf - hb; }
            asm volatile("s_waitcnt lgkmcnt(0)" ::: "memory");
        }
    }
}
#define RLX_AGENT __ATOMIC_RELAXED, __HIP_MEMORY_SCOPE_AGENT
#define XB_TMO      128
#define XB_XCNT(j)  (256  + 64 * (j))
#define XB_XSUB(j)  (1280 + 64 * (j))
#define XB_XGEN(j)  (2304 + 64 * (j))
#define XB_TOP      3328
#define XB_TOPGEN   3392
#define XCD_BAR_WORDS 3456
#define XB_SPIN_CAP (1u << 18)

__device__ __forceinline__ unsigned xb_ld(unsigned* p)              { return __hip_atomic_load(p, __ATOMIC_RELAXED, __HIP_MEMORY_SCOPE_AGENT); }
__device__ __forceinline__ unsigned xb_add(unsigned* p, unsigned v) { return __hip_atomic_fetch_add(p, v, __ATOMIC_RELAXED, __HIP_MEMORY_SCOPE_AGENT); }
__device__ __forceinline__ unsigned xb_xcc_id() { return (unsigned)__builtin_amdgcn_s_getreg((3 << 11) | 20) & 0xFu; }
#define XB_SPIN(cond, bar) do { unsigned _sp = 0; while (cond) { __builtin_amdgcn_s_sleep(1); \
    if ((++_sp & 255u) == 0u) { if (xb_ld(&(bar)[XB_TMO])) break; if (_sp > XB_SPIN_CAP) { atomicAdd(&(bar)[XB_TMO], 1u); break; } } } } while (0)

struct XcdBarrier {
    unsigned* bar; unsigned x;
    volatile LAS unsigned* st;
};

__device__ __forceinline__ XcdBarrier xcd_barrier_post(unsigned* bar, volatile LAS unsigned* st) {
    XcdBarrier b; b.bar = bar; b.x = xb_xcc_id(); b.st = st;
    if (threadIdx.x == 0) (void)xb_add(&bar[XB_XCNT(b.x)], 1u);
    return b;
}
__device__ __forceinline__ void xcd_barrier_complete(unsigned* bar, unsigned x, unsigned& nloc, unsigned& nx) {
    const unsigned G = gridDim.x * gridDim.y * gridDim.z;
    unsigned sum, cnt, mine, sp = 0u;
    for (;;) {
        sum = 0u; cnt = 0u; mine = 0u;
#pragma unroll
        for (unsigned j = 0; j < 16; ++j) { const unsigned c = xb_ld(&bar[XB_XCNT(j)]); sum += c; cnt += (c > 0u) ? 1u : 0u; mine = (j == x) ? c : mine; }
        if (sum == G) break;
        __builtin_amdgcn_s_sleep(1);
        if ((++sp & 255u) == 0u) { if (xb_ld(&bar[XB_TMO])) break; if (sp > XB_SPIN_CAP) { atomicAdd(&bar[XB_TMO], 1u); break; } }
    }
    nloc = mine > 0u ? mine : 1u; nx = cnt > 0u ? cnt : 1u;
}

__device__ __forceinline__ void xcd_barrier(const XcdBarrier& b) {
    asm volatile("s_waitcnt vmcnt(0)" ::: "memory");
    block_sync();
    if (threadIdx.x == 0) {
        unsigned* bar = b.bar;
        __builtin_amdgcn_s_waitcnt(0);
        unsigned nloc = b.st[0], nx = b.st[1];
        if (nloc == 0u) { xcd_barrier_complete(bar, b.x, nloc, nx); b.st[0] = nloc; b.st[1] = nx; }
        const unsigned old = xb_add(&bar[XB_XSUB(b.x)], 1u);
        const unsigned gen = old / nloc;
        if (old + 1u == (gen + 1u) * nloc) {
            __builtin_amdgcn_fence(__ATOMIC_RELEASE, "agent");
            asm volatile("s_waitcnt vmcnt(0)" ::: "memory");
            const unsigned og = xb_add(&bar[XB_TOP], 1u);
            const unsigned tg = og / nx;
            if (og + 1u == (tg + 1u) * nx) xb_add(&bar[XB_TOPGEN], 1u);
            else XB_SPIN(xb_ld(&bar[XB_TOPGEN]) == tg, bar);
            __builtin_amdgcn_fence(__ATOMIC_ACQUIRE, "agent");
            xb_add(&bar[XB_XGEN(b.x)], 1u);
            asm volatile("s_waitcnt vmcnt(0)" ::: "memory");
        } else {
            XB_SPIN(xb_ld(&bar[XB_XGEN(b.x)]) == gen, bar);
            __builtin_amdgcn_fence(__ATOMIC_ACQUIRE, "agent");
            asm volatile("s_waitcnt vmcnt(0)" ::: "memory");
        }
    }
    block_sync();
}

constexpr size_t MiB = 1u << 20;
constexpr int M = NB * L;
constexpr size_t WS_VSS = 0, WS_XSS = 64 * 1024, WS_X2SS = 128 * 1024, WS_TTAB = 192 * 1024, WS_BAR = 256 * 1024, WS_PCNT = 272 * 1024, WS_H3 = 1 * MiB;
constexpr size_t WS_WTA = 2 * MiB, WS_WTB = 10 * MiB, WS_PAB = 16 * MiB, WS_WO = 20 * MiB;
constexpr size_t WS_FSUM = 24 * MiB, WS_WUP = 24 * MiB, WS_WDN = 35 * MiB;
constexpr size_t WS_HYT = 41 * MiB;
constexpr size_t WS_X1B = 41 * MiB, WS_MRG = 105 * MiB;
constexpr size_t WS_YAB = 169 * MiB;
constexpr size_t WS_FDIF = 233 * MiB;
constexpr size_t WS_AP = 73 * MiB, WS_GP = 161 * MiB;
static_assert(WS_GP + (size_t)M * FH * 2 <= 256 * MiB && WS_AP + (size_t)M * FH * 2 <= WS_GP && WS_FDIF + 16 * MiB <= 256 * MiB && WS_WDN + (size_t)D * FH * 2 <= WS_HYT, "d_ws map");
constexpr int LDS_BYTES = 155648;
static_assert(HY_LDS_END + 256 <= LDS_BYTES, "LDS map");
constexpr int NPH = 9;

struct MegaArgs { const float* in[27]; float* out; unsigned char* ws; int ph_lo, ph_hi; WJobs wj; };

__global__ void __launch_bounds__(512, 2) __attribute__((target("no-packed-fp32-ops"))) mega_fwd(MegaArgs a) {
    extern __shared__ __attribute__((aligned(16))) unsigned char lds_raw[];
    LAS unsigned char* lds = (LAS unsigned char*)lds_raw;
    cg::grid_group grid = cg::this_grid();
    const int wave = __builtin_amdgcn_readfirstlane((int)threadIdx.x >> 6);
    const int G = gridDim.x, bid = blockIdx.x, gw = bid * 8 + wave, NGW = G * 8;
#define FRESH_TID int lane; asm volatile("v_mbcnt_lo_u32_b32 %0, -1, 0\n\tv_mbcnt_hi_u32_b32 %0, -1, %0" : "=v"(lane)); const int tid = wave * 64 + lane; (void)tid
    unsigned char* ws = a.ws;
    const float* x = a.in[0];
    float* vss = (float*)(ws + WS_VSS); float* xss = (float*)(ws + WS_XSS); float* x2ss = (float*)(ws + WS_X2SS);
    cfv* Ttab = (cfv*)(ws + WS_TTAB); float* h3 = (float*)(ws + WS_H3);
    bf16* WtA = (bf16*)(ws + WS_WTA); bf16* WtB = (bf16*)(ws + WS_WTB); bf16* PabT = (bf16*)(ws + WS_PAB); bf16* WoT = (bf16*)(ws + WS_WO);
    bf16* WupT = (bf16*)(ws + WS_WUP); bf16* WdnT = (bf16*)(ws + WS_WDN);
    float* fsum = (float*)(ws + WS_FSUM); float* fdif = (float*)(ws + WS_FDIF);
    bf16* hyvT = (bf16*)(ws + WS_HYT); bf16* yaT = hyvT + (size_t)1024 * M; bf16* vT = hyvT + (size_t)3072 * M;
    bf16* YAB = (bf16*)(ws + WS_YAB); bf16* h1 = YAB; bf16* Ub = YAB + 1024;
    bf16* Gb = (bf16*)a.out;
    bf16* mrg = (bf16*)(ws + WS_MRG); bf16* X1b = (bf16*)(ws + WS_X1B); float* X1 = a.out;
    bf16* APb = (bf16*)(ws + WS_AP); bf16* GPb = (bf16*)(ws + WS_GP);
    const int lo = a.ph_lo, hi = a.ph_hi;
#define IN(k) (lo <= (k) && (k) < hi)
    for (int u = (int)threadIdx.x; u < 16; u += 512) ((LAS unsigned*)(lds + LDS_BYTES - 256))[u] = 0u;
    block_sync();
    XcdBarrier xbar = xcd_barrier_post((unsigned*)(ws + WS_BAR), (volatile LAS unsigned*)(lds + LDS_BYTES - 256));
#ifdef MK_PROBE
#define STAMP(i) do { if (threadIdx.x == 0) ((volatile LAS unsigned long long*)(lds + LDS_BYTES - 128))[i] = __builtin_amdgcn_s_memrealtime(); } while (0)
#else
#define STAMP(i) do { } while (0)
#endif
    STAMP(0);
#define SEAM(k) do { if (IN(k) && IN((k) + 1)) xcd_barrier(xbar); STAMP((k) + 1); } while (0)
    if (a.ph_hi > NPH) grid.sync();

    if (IN(0)) { FRESH_TID;
        p0_weights(a.wj, 0, 7, (LAS float*)lds + wave * 4096, gw, NGW, lane);
        for (int m = 4 * gw; m < M; m += 4 * NGW) rms_rows4_to_bf16(x + (size_t)m * 1024, a.in[1], h1 + (size_t)m * 2048, 2048, lane);
        for (int i = bid * 512 + tid; i < 3 * M; i += G * 512) vss[i] = 0.f;
        block_sync();
        { LAS float* wl = (LAS float*)lds;
          for (int i = tid; i < MLPW_N; i += 512) { float v;
              if (i < MLPW_W2) v = a.in[5][i]; else if (i < MLPW_W3) v = a.in[7][i - MLPW_W2]; else if (i < MLPW_B) v = a.in[9][i - MLPW_W3];
              else { const int q = i - MLPW_B; v = q < 64 ? a.in[6][q] : q < 128 ? a.in[8][q - 64] : q < 192 ? a.in[10][q - 128] : a.in[11][q - 192]; }
              wl[i] = v; }
          block_sync();
          for (int l = 2 * gw; l < L; l += 2 * NGW) filter_mlp_rows2(wl, h3, (LAS float*)(lds + 65536) + wave * 128, l, l + 1, lane); }
        for (int m = bid * 512 + tid; m < 4096; m += G * 512) { const float ang = (float)m / 4096.0f; Ttab[m] = (cfv){cospif(ang), -sinpif(ang)}; }
    }
    SEAM(0);
    if (IN(1)) { FRESH_TID;
        { pg8::Gemm g{WtA, h1, 4096, M, 1024, 1024, 2048}; pg8::StaticOrder S; S.init(4096, M, G, bid);
          pg8::EpiHyT E{hyvT, M, vss};
          pg8::gemm_phase<pg8::EpiHyT, pg8::StaticOrder, true, true>(lds, g, S, E, tid); }
        STAMP(11);
        { pg8::Gemm g{h1, WtB, M, 3072, 1024, 2048, 1024}; pg8::StaticOrder S; S.init(M, 3072, G, bid);
          pg8::EpiUG E{Ub, Gb, 2048};
          pg8::gemm_phase<pg8::EpiUG, pg8::StaticOrder, true, true>(lds, g, S, E, tid); }
        STAMP(12);
        filter_tables(h3, a.in[12], a.in[13], fsum, fdif, (LAS float*)(lds + wave * 17408), gw, NGW, lane);
    }
    SEAM(1);
    if (IN(2)) { FRESH_TID;
        HyArgs H; H.hyT = hyvT; H.yaT = yaT; H.fsum = fsum; H.fdif = fdif; H.cw = a.in[3]; H.cb = a.in[4]; H.skip = a.in[14]; H.T = Ttab;
        H.TS = M; H.npairs = 2; H.off00 = 0; H.off01 = L; H.off10 = 2 * L; H.off11 = 3 * L;
        hyena_phase(lds, H, bid, G, tid, wave);
        block_sync();
        STAMP(13);
        SguArgs Sg; Sg.vT = vT; Sg.U = Ub; Sg.vss = vss; Sg.ws = a.in[16]; Sg.bs = a.in[17]; Sg.gn = a.in[15]; Sg.TS = M; Sg.ldu = 2048;
        sgu_phase(lds, Sg, bid, G, tid, wave);
    }
    SEAM(2);
    if (IN(3)) { FRESH_TID;
        transpose_ya(yaT, M, YAB, 2048, (LAS unsigned short*)lds + wave * 8192, gw, NGW, lane);
        p0_weights(a.wj, 7, 9, (LAS float*)lds + wave * 4096, gw, NGW, lane);
    }
    SEAM(3);
    if (IN(4)) { FRESH_TID;
        pg8::Gemm g{YAB, PabT, M, 1024, 2048, 2048, 2048}; pg8::StaticOrder S; S.init(M, 1024, G, bid);
        pg8::EpiMerge E{Gb, mrg};
        pg8::gemm_phase<pg8::EpiMerge, pg8::StaticOrder, true, true>(lds, g, S, E, tid);
    }
    SEAM(4);
    if (IN(5)) { FRESH_TID;
        pg8::Gemm g{mrg, WoT, M, 1024, 1024, 1024, 1024}; pg8::StaticOrder S; S.init(M, 1024, G, bid);
        pg8::EpiResid<true> E{x, nullptr, nullptr, X1b, xss};
        pg8::gemm_phase<pg8::EpiResid<true>, pg8::StaticOrder, true, true>(lds, g, S, E, tid);
    }
    SEAM(5);
    if (IN(6)) { FRESH_TID;
        pg8::Gemm g{X1b, WupT, M, 2 * FH, 1024, 1024, 1024}; pg8::StaticOrder S; S.init(68 * 256, 2 * FH, G, bid);
        pg8::EpiUpAct E{GPb, (LAS float*)(lds + 131072), xss, a.in[23], a.in[24]};
        pg8::gemm_phase<pg8::EpiUpAct, pg8::StaticOrder, true, true>(lds, g, S, E, tid);
    }
    SEAM(6);
    if (IN(7)) { FRESH_TID;
        pg8::Gemm g{GPb, WdnT, M, 1024, FH, FH, FH}; pg8::StaticOrder S; S.init(M, 1024, G, bid);
        if (G == 256) { pg8::EpiResidNorm E{X1b, a.out, x2ss, a.in[26], (unsigned*)(ws + WS_PCNT)};
            pg8::gemm_phase<pg8::EpiResidNorm, pg8::StaticOrder, true, true>(lds, g, S, E, tid); }
        else { pg8::EpiResid<false> E{nullptr, X1b, nullptr, X1b, x2ss};
            pg8::gemm_phase<pg8::EpiResid<false>, pg8::StaticOrder, true, true>(lds, g, S, E, tid); }
    }
    if (G != 256) { SEAM(7);
        if (IN(8)) { FRESH_TID; final_norm(X1b, x2ss, a.in[26], a.out, M, gw, NGW, lane); } }
    STAMP(8); STAMP(9);
#ifdef MK_PROBE
#ifndef MK_PROBE_A
#define MK_PROBE_A MK_PROBE
#define MK_PROBE_B (MK_PROBE + 1)
#endif
    if (threadIdx.x == 0) { volatile LAS unsigned long long* ts = (volatile LAS unsigned long long*)(lds + LDS_BYTES - 128);
        const unsigned long long dt = 2ull * (ts[MK_PROBE_B] - ts[MK_PROBE_A]), t0 = __builtin_amdgcn_s_memrealtime();
        while (__builtin_amdgcn_s_memrealtime() - t0 < dt) __builtin_amdgcn_s_sleep(8); }
    block_sync();
#endif
#undef IN
#undef SEAM
}
}

#ifndef MK_CUTS
#define MK_CUTS 0
#endif
extern "C" void kernel_launch(void* const* d_in, const int* in_sizes, int n_in, void* d_out, int out_size, void* d_ws, size_t ws_size, hipStream_t stream) {
    static int grid = 0;
    if (grid == 0) {
        int dev = 0, cus = 0, per_cu = 0;
        hipGetDevice(&dev);
        hipDeviceGetAttribute(&cus, hipDeviceAttributeMultiprocessorCount, dev);
        hipFuncSetAttribute((const void*)mega_fwd, hipFuncAttributeMaxDynamicSharedMemorySize, LDS_BYTES);
        hipOccupancyMaxActiveBlocksPerMultiprocessor(&per_cu, (const void*)mega_fwd, 512, LDS_BYTES);
        if (per_cu < 1) { fprintf(stderr, "kernel_launch: occupancy query says %d blocks per CU\n", per_cu); per_cu = 1; }
        grid = cus * 1;
        (void)hipGetLastError();
    }
    hipMemsetAsync((char*)d_ws + WS_BAR, 0, 32 * 1024, stream);
    MegaArgs a{};
    for (int i = 0; i < 27; ++i) a.in[i] = (const float*)d_in[i];
    a.out = (float*)d_out; a.ws = (unsigned char*)d_ws;
    { unsigned char* ws = (unsigned char*)d_ws;
      bf16* WtA = (bf16*)(ws + WS_WTA); bf16* WtB = (bf16*)(ws + WS_WTB); bf16* PabT = (bf16*)(ws + WS_PAB); bf16* WoT = (bf16*)(ws + WS_WO); bf16* WupT = (bf16*)(ws + WS_WUP); bf16* WdnT = (bf16*)(ws + WS_WDN);
    a.wj.j[0] = WJob{(const float*)d_in[2], nullptr, WtA, 1024, INW, 0, 3072, 1024, 0, 0, 0};
    a.wj.j[1] = WJob{(const float*)d_in[2], nullptr, WtA, 1024, INW, 4096, 1024, 1024, 3072, 0, 0};
    a.wj.j[2] = WJob{(const float*)d_in[2], nullptr, WtB, 1024, INW, 3072, 1024, 1024, 0, 0, 0};
    a.wj.j[3] = WJob{(const float*)d_in[2], nullptr, WtB, 1024, INW, 5120, 2048, 1024, 1024, 0, 0};
    a.wj.j[4] = WJob{(const float*)d_in[18], nullptr, PabT, 1024, 1024, 0, 1024, 2048, 0, 0, 0};
    a.wj.j[5] = WJob{(const float*)d_in[19], nullptr, PabT, 1024, 1024, 0, 1024, 2048, 0, 1024, 0};
    a.wj.j[6] = WJob{(const float*)d_in[20], nullptr, WoT, 1024, 1024, 0, 1024, 1024, 0, 0, 0};
    a.wj.j[7] = WJob{(const float*)d_in[22], (const float*)d_in[21], WupT, 1024, 2 * FH, 0, 2 * FH, 1024, 0, 0, 1};
    a.wj.j[8] = WJob{(const float*)d_in[25], nullptr, WdnT, FH, 1024, 0, 1024, FH, 0, 0, 0};

    }
#if MK_CUTS
    for (int p = 0; p < NPH; ++p) { a.ph_lo = p; a.ph_hi = p + 1; hipLaunchKernelGGL(mega_fwd, dim3(grid), dim3(512), LDS_BYTES, stream, a); }
#else
    a.ph_lo = 0; a.ph_hi = NPH;
    void* args[] = {&a};
    hipError_t e = hipLaunchCooperativeKernel((const void*)mega_fwd, dim3(grid), dim3(512), args, LDS_BYTES, stream);
    if (e != hipSuccess) fprintf(stderr, "cooperative launch failed: %s (grid %d)\n", hipGetErrorString(e), grid);
#endif
}
```

```cpp
#include <hip/hip_runtime.h>
#include <hip/hip_cooperative_groups.h>
#include <math.h>
#include <stdint.h>
#include <cstdio>
namespace cg = cooperative_groups;
namespace pg8 {
#define PG8_LAS __attribute__((address_space(3)))
typedef unsigned short bf16_t;
typedef short bf16x8 __attribute__((ext_vector_type(8)));
typedef float f32x4 __attribute__((ext_vector_type(4)));
typedef unsigned u32x4 __attribute__((ext_vector_type(4)));
typedef short s16x4 __attribute__((ext_vector_type(4)));
constexpr int BM = 256, BK = 64, HALF = 128, HTB = HALF * BK * 2  , STAGE_BYTES = 8 * HTB, NXCD = 8, WGM = 8;

__host__ __device__ __forceinline__ int lds_byte(int r, int c) { const int st = (r >> 4) * 2 + (c >> 5), rr = r & 15, cc = c & 31, ob = rr * 64 + cc * 2; return st * 1024 + (ob ^ (((ob >> 9) & 1) << 5)); }
__host__ __device__ __forceinline__ void stage_rc(int b, int& R, int& C) { const int st = b / 1024, sb = b % 1024, swz = sb ^ (((sb >> 9) & 1) << 5); R = (st >> 1) * 16 + swz / 64; C = (st & 1) * 32 + (swz % 64) / 2; }
__host__ __device__ __forceinline__ int perm32(int rho) { const int n = rho >> 4, i = rho & 15; return 8 * (i >> 2) + 4 * n + (i & 3); }

struct Unit { int pm, pn; };
__host__ __device__ __forceinline__ int ovl_row(int pm) { const int seq = pm / 17, i = pm % 17; int s = 254 * i - 1; s = s < 0 ? 0 : (s > 3840 ? 3840 : s); return seq * 4096 + s; }
struct Gemm { const bf16_t* A; const bf16_t* Bt; int M, N, K, lda, ldb; const bf16_t* At; int ldt, ntr; };

struct StaticOrder {
    int nM, nN, nwg, G, c;
    __host__ __device__ __forceinline__ void init(int M, int N, int G_, int c_) { nM = M / BM; nN = N / BM; nwg = nM * nN; G = G_; c = c_; }
    __host__ __device__ __forceinline__ bool next(int i, Unit& u) const {
        const long L = (long)i * G + c; if (L >= nwg) return false;
        int wgid = (int)L; { const int q = nwg / NXCD, r = nwg % NXCD, xcd = wgid % NXCD, off = wgid / NXCD; wgid = (xcd < r ? xcd * (q + 1) : r * (q + 1) + (xcd - r) * q) + off; }
        const int nig = WGM * nN, gid = wgid / nig, fm = gid * WGM, gsz = (nM - fm) < WGM ? (nM - fm) : WGM;
        u.pm = fm + ((wgid % nig) % gsz); u.pn = (wgid % nig) / gsz; return true;
    }
    __device__ __forceinline__ void a_ready(const Unit&) const {}
    __device__ __forceinline__ void done(const Unit&) const {}
};

__device__ __forceinline__ unsigned cvt_pk_bf16(float lo, float hi) { unsigned r; asm volatile("v_cvt_pk_bf16_f32 %0, %1, %2" : "=v"(r) : "v"(lo), "v"(hi)); return r; }
typedef float f32x2 __attribute__((ext_vector_type(2)));
__device__ __forceinline__ f32x2 gelu_pk(f32x2 v) {
    const f32x2 av = __builtin_elementwise_abs(v), d = av * 0.2316418882f + 1.0f;
    f32x2 t; t.x = __builtin_amdgcn_rcpf(d.x); t.y = __builtin_amdgcn_rcpf(d.y);
    f32x2 q = t * 0.5307027145f + (-0.7265760135f); q = q * t + 0.7107068705f; q = q * t + (-0.142248368f); q = q * t + 0.127414796f; q = q * t;
    const f32x2 s = (v * v) * (-0.72134752044f);
    f32x2 e; e.x = __builtin_amdgcn_exp2f(s.x); e.y = __builtin_amdgcn_exp2f(s.y);
    const f32x2 m = v * (q * e), r = v - m;
    f32x2 o; o.x = v.x < 0.f ? m.x : r.x; o.y = v.y < 0.f ? m.y : r.y; return o;
}

template <int ACT  > struct EpiBf16 {
    static constexpr bool PERM = true, AFTER_DRAIN = false, MID = false, OVL = false, ATR = false; static_assert(ACT == 0 || ACT == 1, "EpiBf16: ACT is 0 (none) or 1 (gelu_pk)");
    bf16_t* O; int ldc; const float* bias; int split_cols; size_t split_stride; float scale0;
    __device__ __forceinline__ void operator()(const f32x4 (&acc)[2][2][4][2], const Unit& u, int wr, int wc, int fr, int fq) const {
        const int row0 = u.pm * BM + wr * 64 + fr; int colt = u.pn * BM; bf16_t* base = O;
        float sc = 1.f; if (split_cols) { const int t = colt / split_cols; base += (size_t)t * split_stride; colt -= t * split_cols; if (t == 0) sc = scale0; }
        const int col0 = colt + wc * 32 + 8 * fq, bcol0 = u.pn * BM + wc * 32 + 8 * fq;
        f32x4 bv[2][2];
#pragma unroll
        for (int bj = 0; bj < 2; ++bj)
#pragma unroll
            for (int n = 0; n < 2; ++n) bv[bj][n] = bias ? *(const f32x4*)(bias + bcol0 + bj * HALF + 4 * n) : (f32x4){0.f, 0.f, 0.f, 0.f};
#pragma unroll
        for (int ai = 0; ai < 2; ++ai)
#pragma unroll
            for (int m = 0; m < 4; ++m) { bf16_t* rowp = base + (size_t)(row0 + ai * HALF + m * 16) * ldc + col0;
#pragma unroll
                for (int bj = 0; bj < 2; ++bj) { f32x4 v0 = acc[ai][bj][m][0] + bv[bj][0], v1 = acc[ai][bj][m][1] + bv[bj][1];
                    if (ACT == 1) { f32x2 a = gelu_pk((f32x2){v0[0], v0[1]}), b = gelu_pk((f32x2){v0[2], v0[3]}), c = gelu_pk((f32x2){v1[0], v1[1]}), d = gelu_pk((f32x2){v1[2], v1[3]});
                        v0 = (f32x4){a.x, a.y, b.x, b.y}; v1 = (f32x4){c.x, c.y, d.x, d.y}; }
                    v0 = v0 * sc; v1 = v1 * sc; u32x4 w; w.x = cvt_pk_bf16(v0[0], v0[1]); w.y = cvt_pk_bf16(v0[2], v0[3]); w.z = cvt_pk_bf16(v1[0], v1[1]); w.w = cvt_pk_bf16(v1[2], v1[3]);
                    *(u32x4*)(rowp + bj * HALF) = w; } }
    }
};

struct EpiF32 {
    static constexpr bool PERM = false, AFTER_DRAIN = false, MID = false, OVL = false, ATR = false;
    float* C; int ldc; const float* bias;
    __device__ __forceinline__ void operator()(const f32x4 (&acc)[2][2][4][2], const Unit& u, int wr, int wc, int fr, int fq) const {
        const int row0 = u.pm * BM + wr * 64 + fr, col0 = u.pn * BM + wc * 32 + 4 * fq;
        f32x4 bv[2][2];
#pragma unroll
        for (int bj = 0; bj < 2; ++bj)
#pragma unroll
            for (int n = 0; n < 2; ++n) bv[bj][n] = bias ? *(const f32x4*)(bias + col0 + bj * HALF + n * 16) : (f32x4){0.f, 0.f, 0.f, 0.f};
#pragma unroll
        for (int ai = 0; ai < 2; ++ai)
#pragma unroll
            for (int m = 0; m < 4; ++m) { float* rowp = C + (size_t)(row0 + ai * HALF + m * 16) * ldc + col0;
#pragma unroll
                for (int bj = 0; bj < 2; ++bj)
#pragma unroll
                    for (int n = 0; n < 2; ++n) *(f32x4*)(rowp + bj * HALF + n * 16) = acc[ai][bj][m][n] + bv[bj][n]; }
    }
};

template <class Epi, class Sched, bool ALIGN_EPI = false, bool SP2 = false>
__device__ __forceinline__ void gemm_phase(PG8_LAS unsigned char* lds, const Gemm g, const Sched& S, const Epi& E, const int tid) {
    const int wid = __builtin_amdgcn_readfirstlane(tid >> 6), lane = tid & 63, wr = wid >> 2, wc = wid & 3, fr = lane & 15, fq = lane >> 4;
    const int K = g.K, nt = K / BK;
    unsigned voffA[2], voffB[2];
#pragma unroll
    for (int i = 0; i < 2; ++i) { int R, C; stage_rc(tid * 16 + i * 8192, R, C); const int Rb = Epi::PERM ? ((R & ~31) + perm32(R & 31)) : R;
        voffA[i] = (unsigned)(R * g.lda + C) * 2u; voffB[i] = (unsigned)(Rb * g.ldb + C) * 2u; }
    unsigned voffT[2] = {0u, 0u}; unsigned trb = 0u, trx = 0u; const int ntr = Epi::ATR ? g.ntr : 0; const size_t kstepT = (size_t)BK * g.ldt * 2;
    if constexpr (Epi::ATR) {
#pragma unroll
        for (int i = 0; i < 2; ++i) { const int r = 4 * (i * 8 + wid) + (lane >> 4), pch = lane & 15, ch = pch ^ (((r & 3) << 2) | ((r >> 2) & 3)); voffT[i] = (unsigned)(r * g.ldt + 8 * ch) * 2u; }
        const int q = fr >> 2, pp = fr & 3, f0 = (q << 2) | ((2 * fq) & 3);
        trb = (unsigned)(2048 * fq + 256 * q + 8 * (pp & 1)); trx = 16u * (unsigned)(((8 * wr) | (pp >> 1)) ^ f0);
    }
    const size_t kstep = (size_t)(BK * 2);
    const size_t hstepA = (size_t)HALF * g.lda * 2, hstepB = (size_t)HALF * g.ldb * 2;
    const size_t tstepA = 2 * hstepA, tstepB = 2 * hstepB;
    const unsigned ldsw = (unsigned)wid * 1024u;
    const int aoff = lds_byte(wr * 64 + fr, fq * 8), boff = lds_byte(wc * 32 + fr, fq * 8);
#define PG8_SA(b, h) (((b) * 2 + (h)) * HTB)
#define PG8_SB(b, h) ((4 + (b) * 2 + (h)) * HTB)
#define PG8_STAGE(bufoff, gbase, voff) do { _Pragma("unroll") for (int _i = 0; _i < 2; ++_i) \
        __builtin_amdgcn_global_load_lds((const unsigned*)((const char*)(gbase) + (voff)[_i]), (PG8_LAS unsigned*)(lds + (bufoff) + ldsw + _i * 8192), 16, 0, 0); } while (0)
#define PG8_LDA(dst, b, h) do { _Pragma("unroll") for (int m = 0; m < 4; ++m) _Pragma("unroll") for (int k = 0; k < 2; ++k) dst[m][k] = *(const PG8_LAS bf16x8*)(lds + PG8_SA(b, h) + aoff + m * 2048 + k * 1024); } while (0)
#define PG8_STAGE_A(bufoff, nbase, tbase, tile, half) do { if (Epi::ATR && (tile) < ntr) PG8_STAGE(bufoff, (tbase) + (size_t)(tile) * kstepT + (half) * 256, voffT); \
        else PG8_STAGE(bufoff, (nbase) + (size_t)((tile) - ntr) * kstep + (half) * hstepA, voffA); } while (0)
#define PG8_LDA_TR(dst, b, h) do { _Pragma("unroll") for (int m = 0; m < 4; ++m) _Pragma("unroll") for (int k = 0; k < 2; ++k) { \
        const s16x4 lo_ = __builtin_amdgcn_ds_read_tr16_b64_v4i16((PG8_LAS s16x4*)(lds + PG8_SA(b, h) + trb + (trx ^ (unsigned)(32 * m)) + 8192 * k)); \
        const s16x4 hi_ = __builtin_amdgcn_ds_read_tr16_b64_v4i16((PG8_LAS s16x4*)(lds + PG8_SA(b, h) + trb + (trx ^ (unsigned)(32 * m + 16)) + 8192 * k + 1024)); \
        dst[m][k] = __builtin_shufflevector(lo_, hi_, 0, 1, 2, 3, 4, 5, 6, 7); } } while (0)
#define PG8_LDA_X(dst, b, h, tile) do { if (Epi::ATR && (tile) < ntr) PG8_LDA_TR(dst, b, h); else PG8_LDA(dst, b, h); } while (0)
#define PG8_LDB(dst, b, h) do { _Pragma("unroll") for (int n = 0; n < 2; ++n) _Pragma("unroll") for (int k = 0; k < 2; ++k) dst[n][k] = *(const PG8_LAS bf16x8*)(lds + PG8_SB(b, h) + boff + n * 2048 + k * 1024); } while (0)
#define PG8_MMA(ai, bj, At, Bt) do { __builtin_amdgcn_s_setprio(1); _Pragma("unroll") for (int m = 0; m < 4; ++m) _Pragma("unroll") for (int n = 0; n < 2; ++n) _Pragma("unroll") for (int k = 0; k < 2; ++k) \
        acc[ai][bj][m][n] = __builtin_amdgcn_mfma_f32_16x16x32_bf16(Bt[n][k], At[m][k], acc[ai][bj][m][n], 0, 0, 0); __builtin_amdgcn_s_setprio(0); } while (0)
#define PG8_WAIT_V(n) asm volatile("s_waitcnt vmcnt(" #n ")" ::: "memory")
#define PG8_WAIT_L(n) asm volatile("s_waitcnt lgkmcnt(" #n ")" ::: "memory")
#define PG8_BAR __builtin_amdgcn_s_barrier()
#define PG8_SCHED __builtin_amdgcn_sched_barrier(0)
    Unit cur, nxt; int ui = 0;
    if (!S.next(0, cur)) return;
    f32x4 acc[2][2][4][2];
#pragma unroll
    for (int a = 0; a < 2; ++a)
#pragma unroll
        for (int b = 0; b < 2; ++b)
#pragma unroll
            for (int m = 0; m < 4; ++m)
#pragma unroll
                for (int n = 0; n < 2; ++n) acc[a][b][m][n] = (f32x4){0.f, 0.f, 0.f, 0.f};
    bf16x8 At[4][2], B0[2][2], B1[2][2];
    const char* cA = (const char*)g.A + (size_t)(Epi::OVL ? ovl_row(cur.pm) : cur.pm * BM) * (tstepA / BM); const char* cB = (const char*)g.Bt + (size_t)cur.pn * tstepB;
    const char* cT = Epi::ATR ? (const char*)g.At + (size_t)cur.pm * BM * 2 : nullptr;
    S.a_ready(cur);
    if constexpr (SP2) {
        PG8_STAGE(PG8_SB(0, 0), cB, voffB); PG8_STAGE(PG8_SB(0, 1), cB + hstepB, voffB); PG8_STAGE_A(PG8_SA(0, 0), cA, cT, 0, 0); PG8_STAGE_A(PG8_SA(0, 1), cA, cT, 0, 1);
        if (wr == 1) PG8_BAR;
        PG8_WAIT_V(2); PG8_BAR;
        PG8_STAGE(PG8_SB(1, 0), cB + kstep, voffB); PG8_STAGE_A(PG8_SA(1, 0), cA, cT, 1, 0); PG8_STAGE(PG8_SB(1, 1), cB + hstepB + kstep, voffB);
        PG8_WAIT_V(6); PG8_BAR;
    } else {
        PG8_STAGE(PG8_SB(0, 0), cB, voffB); PG8_STAGE(PG8_SA(0, 0), cA, voffA); PG8_STAGE(PG8_SB(0, 1), cB + hstepB, voffB); PG8_STAGE(PG8_SA(0, 1), cA + hstepA, voffA);
        if (wr == 1) PG8_BAR;
        PG8_WAIT_V(4); PG8_BAR;
        PG8_STAGE(PG8_SB(1, 0), cB + kstep, voffB); PG8_STAGE(PG8_SA(1, 0), cA + kstep, voffA); PG8_STAGE(PG8_SB(1, 1), cB + hstepB + kstep, voffB);
        PG8_WAIT_V(6); PG8_BAR;
    }
    for (;;) {
        const bool has_next = S.next(ui + 1, nxt);
        const char* nA = has_next ? (const char*)g.A + (size_t)(Epi::OVL ? ovl_row(nxt.pm) : nxt.pm * BM) * (tstepA / BM) : cA; const char* nB = has_next ? (const char*)g.Bt + (size_t)nxt.pn * tstepB : cB;
        const char* nT = (Epi::ATR && has_next) ? (const char*)g.At + (size_t)nxt.pm * BM * 2 : cT;
        for (int t = 0; t < nt; t += 2) {
            const bool last = (t == nt - 2);
            const char* a1 = cA + (size_t)(t + 1) * kstep;
            const char* a2 = last ? nA : cA + (size_t)(t + 2) * kstep; const char* b2 = last ? nB : cB + (size_t)(t + 2) * kstep;
            const char* a3 = a2 + kstep; const char* b3 = b2 + kstep;
            if (last && has_next) S.a_ready(nxt);
            if constexpr (Epi::MID) { if (t == (nt >> 1)) E.mid(acc, cur, wr, wc, fr, fq); }
            if constexpr (SP2) {
            PG8_LDB(B0, 0, 0); PG8_LDB(B1, 0, 1); PG8_SCHED; PG8_LDA_X(At, 0, 0, t); PG8_STAGE_A(PG8_SA(1, 1), cA, cT, t + 1, 1);
            PG8_WAIT_V(8); PG8_WAIT_L(0); PG8_BAR; PG8_MMA(0, 0, At, B0); PG8_MMA(0, 1, At, B1); PG8_BAR; PG8_SCHED;
            PG8_LDA_X(At, 0, 1, t); PG8_STAGE(PG8_SB(0, 0), b2, voffB); PG8_STAGE(PG8_SB(0, 1), b2 + hstepB, voffB); PG8_STAGE_A(PG8_SA(0, 0), last ? nA : cA, last ? nT : cT, last ? 0 : t + 2, 0);
            PG8_WAIT_V(8); PG8_WAIT_L(0); PG8_BAR; PG8_MMA(1, 0, At, B0); PG8_MMA(1, 1, At, B1); PG8_BAR; PG8_SCHED;
            PG8_LDB(B0, 1, 0); PG8_LDB(B1, 1, 1); PG8_SCHED; PG8_LDA_X(At, 1, 0, t + 1); PG8_STAGE_A(PG8_SA(0, 1), last ? nA : cA, last ? nT : cT, last ? 0 : t + 2, 1);
            PG8_WAIT_V(8); PG8_WAIT_L(0); PG8_BAR; PG8_MMA(0, 0, At, B0); PG8_MMA(0, 1, At, B1); PG8_BAR; PG8_SCHED;
            PG8_LDA_X(At, 1, 1, t + 1); PG8_STAGE(PG8_SB(1, 0), b3, voffB); PG8_STAGE(PG8_SB(1, 1), b3 + hstepB, voffB); PG8_STAGE_A(PG8_SA(1, 0), last ? nA : cA, last ? nT : cT, last ? 1 : t + 3, 0);
            PG8_WAIT_V(8); PG8_WAIT_L(0); PG8_BAR; PG8_MMA(1, 0, At, B0); PG8_MMA(1, 1, At, B1); PG8_BAR; PG8_SCHED;
            } else {
            PG8_LDB(B0, 0, 0); PG8_SCHED; PG8_LDA(At, 0, 0); PG8_STAGE(PG8_SA(1, 1), a1 + hstepA, voffA);
            PG8_WAIT_L(8); PG8_BAR; PG8_WAIT_L(0); PG8_MMA(0, 0, At, B0); PG8_BAR; PG8_SCHED;
            PG8_LDB(B1, 0, 1); PG8_STAGE(PG8_SB(0, 0), b2, voffB);
            PG8_BAR; PG8_WAIT_L(0); PG8_MMA(0, 1, At, B1); PG8_BAR;
            PG8_LDA(At, 0, 1); PG8_STAGE(PG8_SA(0, 0), a2, voffA);
            PG8_BAR; PG8_WAIT_L(0); PG8_MMA(1, 0, At, B0); PG8_BAR; PG8_SCHED;
            PG8_STAGE(PG8_SB(0, 1), b2 + hstepB, voffB);
            PG8_WAIT_V(6); PG8_BAR; PG8_MMA(1, 1, At, B1); PG8_BAR;
            PG8_LDB(B0, 1, 0); PG8_SCHED; PG8_LDA(At, 1, 0); PG8_STAGE(PG8_SA(0, 1), a2 + hstepA, voffA);
            PG8_WAIT_L(8); PG8_BAR; PG8_WAIT_L(0); PG8_MMA(0, 0, At, B0); PG8_BAR; PG8_SCHED;
            PG8_LDB(B1, 1, 1); PG8_STAGE(PG8_SB(1, 0), b3, voffB);
            PG8_BAR; PG8_WAIT_L(0); PG8_MMA(0, 1, At, B1); PG8_BAR;
            PG8_LDA(At, 1, 1); PG8_STAGE(PG8_SA(1, 0), a3, voffA);
            PG8_BAR; PG8_WAIT_L(0); PG8_MMA(1, 0, At, B0); PG8_BAR; PG8_SCHED;
            PG8_STAGE(PG8_SB(1, 1), b3 + hstepB, voffB);
            PG8_WAIT_V(6); PG8_BAR; PG8_MMA(1, 1, At, B1); PG8_BAR;
            }
        }
        if constexpr (ALIGN_EPI) { if (wr == 0) PG8_BAR; }
        if constexpr (!Epi::AFTER_DRAIN) { E(acc, cur, wr, wc, fr, fq); S.done(cur); }
        if (!has_next) break;
#pragma unroll
        for (int a = 0; a < 2; ++a)
#pragma unroll
            for (int b = 0; b < 2; ++b)
#pragma unroll
                for (int m = 0; m < 4; ++m)
#pragma unroll
                    for (int n = 0; n < 2; ++n) acc[a][b][m][n] = (f32x4){0.f, 0.f, 0.f, 0.f};
        cur = nxt; cA = nA; cB = nB; cT = nT; ++ui;
        if constexpr (ALIGN_EPI) { if (wr == 1) PG8_BAR; }
    }
    PG8_WAIT_V(0);
    if constexpr (!ALIGN_EPI) { if (wr == 0) PG8_BAR; }
    PG8_BAR;
    if constexpr (Epi::AFTER_DRAIN) { E.fused(acc, cur, wr, wc, fr, fq, lds, wid, lane); S.done(cur); }
#undef PG8_SA
#undef PG8_SB
#undef PG8_STAGE
#undef PG8_LDA
#undef PG8_LDB
#undef PG8_STAGE_A
#undef PG8_LDA_TR
#undef PG8_LDA_X
#undef PG8_MMA
#undef PG8_WAIT_V
#undef PG8_WAIT_L
#undef PG8_BAR
#undef PG8_SCHED
}
}
namespace {
constexpr int D = 1024, NB = 4, L = 4096, HW = 1024, SW = 1024, INW = 7168, FH = 2816, FHID = 64, FEMB = 33;
constexpr float EPS = 1e-6f;
typedef unsigned short bf16;
__device__ __forceinline__ unsigned f2bf(float f) { unsigned u = __builtin_bit_cast(unsigned, f); return (u + 0x7fffu + ((u >> 16) & 1u)) >> 16; }
__device__ __forceinline__ void block_sync() { __builtin_amdgcn_fence(__ATOMIC_RELEASE, "workgroup"); __builtin_amdgcn_s_barrier(); __builtin_amdgcn_fence(__ATOMIC_ACQUIRE, "workgroup"); }
}
namespace {
#define HD __device__ __forceinline__
#define FFT_OPAQUE(w) asm volatile("" : "+v"((w).x), "+v"((w).y))
#ifndef HD
#define HD inline
#endif
typedef float cfv __attribute__((ext_vector_type(2)));
struct cf { float x, y; };
HD cf cmk(float x, float y) { cf r; r.x = x; r.y = y; return r; }
template <class P> HD cf ldz(P Z, int i) { const cfv t = Z[i]; return cmk(t.x, t.y); }
template <class P> HD void stz(P Z, int i, cf v) { Z[i] = (cfv){v.x, v.y}; }
HD cf cadd(cf a, cf b) { return cmk(a.x + b.x, a.y + b.y); }
HD cf csub(cf a, cf b) { return cmk(a.x - b.x, a.y - b.y); }
HD cf cmul(cf a, cf b) { return cmk(a.x * b.x - a.y * b.y, a.x * b.y + a.y * b.x); }
HD cf cconj(cf a) { return cmk(a.x, -a.y); }
template <bool INV> HD cf mulmi(cf a) { return INV ? cmk(-a.y, a.x) : cmk(a.y, -a.x); }
template <bool INV> HD cf twc(float c, float s) { return INV ? cmk(c, s) : cmk(c, -s); }
HD int fpad(int p) { return p + (p >> 4); }
constexpr int FSUB = 4352;

template <bool INV> HD void dft4(cf& a, cf& b, cf& c, cf& d) {
    const cf t0 = cadd(a, c), t1 = csub(a, c), t2 = cadd(b, d), t3 = mulmi<INV>(csub(b, d));
    a = cadd(t0, t2); b = cadd(t1, t3); c = csub(t0, t2); d = csub(t1, t3);
}
template <bool INV> HD void dft16(cf (&v)[16]) {
    constexpr float C1 = 0.92387953251128674f, S1 = 0.38268343236508977f, R = 0.70710678118654752f;
#pragma unroll
    for (int n0 = 0; n0 < 4; ++n0) dft4<INV>(v[n0], v[n0 + 4], v[n0 + 8], v[n0 + 12]);
    v[1 + 4 * 1] = cmul(v[1 + 4 * 1], twc<INV>(C1, S1));
    v[1 + 4 * 2] = cmul(v[1 + 4 * 2], twc<INV>(R, R));
    v[1 + 4 * 3] = cmul(v[1 + 4 * 3], twc<INV>(S1, C1));
    v[2 + 4 * 1] = cmul(v[2 + 4 * 1], twc<INV>(R, R));
    v[2 + 4 * 2] = mulmi<INV>(v[2 + 4 * 2]);
    v[2 + 4 * 3] = cmul(v[2 + 4 * 3], twc<INV>(-R, R));
    v[3 + 4 * 1] = cmul(v[3 + 4 * 1], twc<INV>(S1, C1));
    v[3 + 4 * 2] = cmul(v[3 + 4 * 2], twc<INV>(-R, R));
    v[3 + 4 * 3] = cmul(v[3 + 4 * 3], twc<INV>(-C1, -S1));
#pragma unroll
    for (int k0 = 0; k0 < 4; ++k0) dft4<INV>(v[4 * k0], v[4 * k0 + 1], v[4 * k0 + 2], v[4 * k0 + 3]);
    cf t;
    t = v[1]; v[1] = v[4]; v[4] = t;   t = v[2]; v[2] = v[8]; v[8] = t;   t = v[3]; v[3] = v[12]; v[12] = t;
    t = v[6]; v[6] = v[9]; v[9] = t;   t = v[7]; v[7] = v[13]; v[13] = t; t = v[11]; v[11] = v[14]; v[14] = t;
}
#ifndef FFT_OPAQUE
#define FFT_OPAQUE(w)
#endif
HD void twiddle16(cf (&v)[16], cf w) {
    FFT_OPAQUE(w);
    cf p = w;
#pragma unroll
    for (int k = 1; k < 16; ++k) { v[k] = cmul(v[k], p); if (k < 15) p = cmul(p, w); }
}
template <class P> HD void fwd_pass1(P Z, int t, cf w1) {
    cf v[16]; const int b = t + (t >> 4);
#pragma unroll
    for (int j = 0; j < 16; ++j) v[j] = ldz(Z, b + 272 * j);
    dft16<false>(v); twiddle16(v, w1);
#pragma unroll
    for (int j = 0; j < 16; ++j) stz(Z, b + 272 * j, v[j]);
}
template <class P> HD void fwd_pass2(P Z, int t, cf w2) {
    const int b = 272 * (t >> 4) + (t & 15);
    cf v[16];
#pragma unroll
    for (int j = 0; j < 16; ++j) v[j] = ldz(Z, b + 17 * j);
    dft16<false>(v); twiddle16(v, w2);
#pragma unroll
    for (int j = 0; j < 16; ++j) stz(Z, b + 17 * j, v[j]);
}
template <class P> HD void fwd_pass3_load(P Z, int t, cf (&v)[16]) {
#pragma unroll
    for (int j = 0; j < 16; ++j) v[j] = ldz(Z, 17 * t + j);
    dft16<false>(v);
}
template <class P> HD void inv_pass1_store(P Z, int t, cf (&v)[16]) {
    dft16<true>(v);
#pragma unroll
    for (int j = 0; j < 16; ++j) stz(Z, 17 * t + j, v[j]);
}
template <class P> HD void inv_pass2(P Z, int t, cf w2) {
    const int b = 272 * (t >> 4) + (t & 15);
    cf v[16];
#pragma unroll
    for (int j = 0; j < 16; ++j) v[j] = ldz(Z, b + 17 * j);
    twiddle16(v, cconj(w2)); dft16<true>(v);
#pragma unroll
    for (int j = 0; j < 16; ++j) stz(Z, b + 17 * j, v[j]);
}
template <class P> HD void inv_pass3(P Z, int t, cf w1) {
    cf v[16]; const int b = t + (t >> 4);
#pragma unroll
    for (int j = 0; j < 16; ++j) v[j] = ldz(Z, b + 272 * j);
    twiddle16(v, cconj(w1)); dft16<true>(v);
#pragma unroll
    for (int j = 0; j < 16; ++j) stz(Z, b + 272 * j, v[j]);
}
#define LAS __attribute__((address_space(3)))
typedef LAS cfv* lcf;
struct HyArgs {
    const bf16* hyT;
    bf16* yaT;
    const float* fsum;
    const float* fdif;
    const float* cw;
    const float* cb;
    const float* skip;
    const cfv* T;
    int TS, npairs, off00, off01, off10, off11;
};
__device__ __forceinline__ float bf2f(unsigned h) { return __builtin_bit_cast(float, h << 16); }
constexpr int HOFF_SX1 = 2 * FSUB * 8, HOFF_SV = HOFF_SX1 + 16384, HOFF_SX0 = HOFF_SV + 16384, HOFF_SF = HOFF_SX0 + 16384, HY_LDS_END = HOFF_SF + 32768;
#define HBAR() do { asm volatile("s_waitcnt lgkmcnt(0)" ::: "memory"); __builtin_amdgcn_s_barrier(); asm volatile("" ::: "memory"); } while (0)
#define HDMA_WAIT() asm volatile("s_waitcnt vmcnt(0)" ::: "memory")
#define WAVE_FENCE() asm volatile("s_waitcnt lgkmcnt(0)" ::: "memory")
__device__ __forceinline__ void hdma16(const void* gp, LAS unsigned char* wave_dst) { __builtin_amdgcn_global_load_lds((const unsigned*)gp, (LAS unsigned*)wave_dst, 16, 0, 0); }
__device__ __forceinline__ void conv8s(const LAS unsigned char* S, int tid, float w0, float w1, float w2, float b, float (&o)[8]) {
    const pg8::u32x4 q = *(const LAS pg8::u32x4*)(S + 16 * tid);
    const unsigned lft = *(const LAS unsigned short*)(S + (tid > 0 ? 16 * tid - 2 : 0)), rgt = *(const LAS unsigned short*)(S + (tid < 511 ? 16 * tid + 16 : 8190));
    float x[10];
    x[0] = tid > 0 ? bf2f(lft) : 0.f; x[9] = tid < 511 ? bf2f(rgt) : 0.f;
    x[1] = bf2f(q.x & 0xffffu); x[2] = bf2f(q.x >> 16); x[3] = bf2f(q.y & 0xffffu); x[4] = bf2f(q.y >> 16);
    x[5] = bf2f(q.z & 0xffffu); x[6] = bf2f(q.z >> 16); x[7] = bf2f(q.w & 0xffffu); x[8] = bf2f(q.w >> 16);
#pragma unroll
    for (int i = 0; i < 8; ++i) o[i] = b + w0 * x[i] + w1 * x[i + 1] + w2 * x[i + 2];
}
__device__ __forceinline__ pg8::u32x4 pack8(const float (&x)[8], const float (&y)[8]) {
    pg8::u32x4 w;
    w.x = f2bf(x[0] * y[0]) | (f2bf(x[1] * y[1]) << 16); w.y = f2bf(x[2] * y[2]) | (f2bf(x[3] * y[3]) << 16);
    w.z = f2bf(x[4] * y[4]) | (f2bf(x[5] * y[5]) << 16); w.w = f2bf(x[6] * y[6]) | (f2bf(x[7] * y[7]) << 16);
    return w;
}
__device__ __forceinline__ void hyena_phase(LAS unsigned char* lds, const HyArgs& A, int first, int stride, const int tid, const int wave) {
    lcf Z = (lcf)lds;
    const int s = tid >> 8, t = tid & 255, pb = 8 * tid + (tid >> 1);
    const cf w1 = ldz(A.T, 2 * t), w2 = ldz(A.T, 32 * (t & 15)), wp = ldz(A.T, 8 * tid);
    lcf Zs = Z + s * FSUB;
    LAS unsigned char* wdst = lds + wave * 1024;
    constexpr float W8C[8] = {1.0f, 0.99999970586f, 0.99999882345f, 0.99999735277f, 0.99999529381f, 0.99999264659f, 0.99998941108f, 0.99998558731f};
    constexpr float W8S[8] = {0.0f, 0.00076699031874f, 0.0015339801863f, 0.0023009691514f, 0.0030679567630f, 0.0038349425697f, 0.0046019261204f, 0.0053689069640f};
    if (first >= 1024) return;
#define ISSUE_PAIR(cc, oa, ob) do { \
        hdma16(A.hyT + (size_t)(1024 + (cc)) * A.TS + (oa) + 8 * tid, wdst + HOFF_SX1); hdma16(A.hyT + (size_t)(1024 + (cc)) * A.TS + (ob) + 8 * tid, wdst + HOFF_SX1 + 8192); \
        hdma16(A.hyT + (size_t)(2048 + (cc)) * A.TS + (oa) + 8 * tid, wdst + HOFF_SV);  hdma16(A.hyT + (size_t)(2048 + (cc)) * A.TS + (ob) + 8 * tid, wdst + HOFF_SV + 8192); } while (0)
#define ISSUE_X0(cc, oa, ob) do { hdma16(A.hyT + (size_t)(cc) * A.TS + (oa) + 8 * tid, wdst + HOFF_SX0); hdma16(A.hyT + (size_t)(cc) * A.TS + (ob) + 8 * tid, wdst + HOFF_SX0 + 8192); } while (0)
#define ISSUE_FILT(cc) do { \
        hdma16(A.fsum + (size_t)(cc) * 4096 + 8 * tid, wdst + HOFF_SF); hdma16(A.fsum + (size_t)(cc) * 4096 + 8 * tid + 4, wdst + HOFF_SF + 8192); \
        hdma16(A.fdif + (size_t)(cc) * 4096 + 8 * tid, wdst + HOFF_SF + 16384); hdma16(A.fdif + (size_t)(cc) * 4096 + 8 * tid + 4, wdst + HOFF_SF + 24576); } while (0)
    ISSUE_FILT(first); ISSUE_PAIR(first, A.off00, A.off01);
    for (int c = first; c < 1024; c += stride) {
        const int cn = c + stride;
        const float sk = A.skip[c];
        const float cx0 = A.cw[c], cx1 = A.cw[3072 + c], cx2 = A.cw[6144 + c], cxb = A.cb[c];
        const float ca0 = A.cw[1024 + c], ca1 = A.cw[3072 + 1024 + c], ca2 = A.cw[6144 + 1024 + c], cab = A.cb[1024 + c];
        const float cv0 = A.cw[2048 + c], cv1 = A.cw[3072 + 2048 + c], cv2 = A.cw[6144 + 2048 + c], cvb = A.cb[2048 + c];
        cf Kr[16];
        HDMA_WAIT();
        {
            const pg8::f32x4 s0 = *(const LAS pg8::f32x4*)(lds + HOFF_SF + 16 * tid), s1 = *(const LAS pg8::f32x4*)(lds + HOFF_SF + 8192 + 16 * tid);
            const pg8::f32x4 d0 = *(const LAS pg8::f32x4*)(lds + HOFF_SF + 16384 + 16 * tid), d1 = *(const LAS pg8::f32x4*)(lds + HOFF_SF + 24576 + 16 * tid);
            const float fs[8] = {s0[0], s0[1], s0[2], s0[3], s1[0], s1[1], s1[2], s1[3]}, fd[8] = {d0[0], d0[1], d0[2], d0[3], d1[0], d1[1], d1[2], d1[3]};
#pragma unroll
            for (int i = 0; i < 8; ++i) { cf wq = wp; FFT_OPAQUE(wq); const cf tw = cmul(wq, cmk(W8C[i], -W8S[i])); stz(Z, pb + i, cmk(fs[i], 0.f)); stz(Z, FSUB + pb + i, cmk(fd[i] * tw.x, fd[i] * tw.y)); }
        }
        HBAR();
        fwd_pass1(Zs, t, w1); HBAR();
        fwd_pass2(Zs, t, w2); WAVE_FENCE();
        fwd_pass3_load(Zs, t, Kr);
#pragma unroll
        for (int j = 0; j < 16; ++j) { Kr[j].x *= (1.0f / 8192.0f); Kr[j].y *= (1.0f / 8192.0f); }
        HBAR();
        for (int p = 0; p < A.npairs; ++p) {
            const int o0 = p ? A.off10 : A.off00, o1 = p ? A.off11 : A.off01;
            float u0[8], u1[8];
            {
                float a[8], b[8];
                conv8s(lds + HOFF_SX1, tid, ca0, ca1, ca2, cab, a); conv8s(lds + HOFF_SV, tid, cv0, cv1, cv2, cvb, b);
#pragma unroll
                for (int i = 0; i < 8; ++i) u0[i] = a[i] * b[i];
                conv8s(lds + HOFF_SX1 + 8192, tid, ca0, ca1, ca2, cab, a); conv8s(lds + HOFF_SV + 8192, tid, cv0, cv1, cv2, cvb, b);
#pragma unroll
                for (int i = 0; i < 8; ++i) u1[i] = a[i] * b[i];
            }
#pragma unroll
            for (int i = 0; i < 8; ++i) { cf wq = wp; FFT_OPAQUE(wq); const cf tw = cmul(wq, cmk(W8C[i], -W8S[i])); const cf z = cmk(u0[i], u1[i]); stz(Z, pb + i, z); stz(Z, FSUB + pb + i, cmul(z, tw)); }
            HBAR();
            ISSUE_X0(c, o0, o1);
            if (p + 1 < A.npairs) ISSUE_PAIR(c, A.off10, A.off11);
            else if (cn < 1024) { ISSUE_PAIR(cn, A.off00, A.off01); ISSUE_FILT(cn); }
            fwd_pass1(Zs, t, w1); HBAR();
            fwd_pass2(Zs, t, w2); WAVE_FENCE();
            {
                cf v[16];
                fwd_pass3_load(Zs, t, v);
#pragma unroll
                for (int j = 0; j < 16; ++j) v[j] = cmul(v[j], Kr[j]);
                inv_pass1_store(Zs, t, v);
            }
            WAVE_FENCE();
            inv_pass2(Zs, t, w2); HBAR();
            inv_pass3(Zs, t, w1);
            HDMA_WAIT(); HBAR();
            {
                float y0[8], y1[8];
#pragma unroll
                for (int i = 0; i < 8; ++i) { cf wq = wp; FFT_OPAQUE(wq); const cf tw = cmul(wq, cmk(W8C[i], -W8S[i])); const cf e = ldz(Z, pb + i), o = ldz(Z, FSUB + pb + i); const cf y = cadd(e, cmul(o, cconj(tw))); y0[i] = y.x + sk * u0[i]; y1[i] = y.y + sk * u1[i]; }
                float x0c[8];
                conv8s(lds + HOFF_SX0, tid, cx0, cx1, cx2, cxb, x0c);
                *(pg8::u32x4*)(A.yaT + (size_t)c * A.TS + o0 + 8 * tid) = pack8(x0c, y0);
                if (o1 != o0) { conv8s(lds + HOFF_SX0 + 8192, tid, cx0, cx1, cx2, cxb, x0c); *(pg8::u32x4*)(A.yaT + (size_t)c * A.TS + o1 + 8 * tid) = pack8(x0c, y1); }
            }
        }
    }
    HDMA_WAIT(); HBAR();
#undef ISSUE_PAIR
#undef ISSUE_X0
#undef ISSUE_FILT
}
}
namespace pg8 {
__device__ __forceinline__ f32x2 sigmoid_pk(f32x2 v) {
    f32x2 e; e.x = __builtin_amdgcn_exp2f(v.x * -1.4426950408889634f); e.y = __builtin_amdgcn_exp2f(v.y * -1.4426950408889634f);
    f32x2 o; o.x = __builtin_amdgcn_rcpf(1.0f + e.x); o.y = __builtin_amdgcn_rcpf(1.0f + e.y); return o;
}
struct EpiHyT {
    static constexpr bool PERM = true, AFTER_DRAIN = false, MID = false, OVL = false, ATR = false;
    bf16_t* O; int ldc; float* vss;
    __device__ __forceinline__ void operator()(const f32x4 (&acc)[2][2][4][2], const Unit& u, int wr, int wc, int fr, int fq) const {
        const int row0 = u.pm * BM + wr * 64 + fr, col0 = u.pn * BM + wc * 32 + 8 * fq;
        const bool isv = u.pm >= 12;
        f32x4 ss[2][2];
#pragma unroll
        for (int bj = 0; bj < 2; ++bj)
#pragma unroll
            for (int n = 0; n < 2; ++n) ss[bj][n] = (f32x4){0.f, 0.f, 0.f, 0.f};
#pragma unroll
        for (int ai = 0; ai < 2; ++ai)
#pragma unroll
            for (int m = 0; m < 4; ++m) { bf16_t* rowp = O + (size_t)(row0 + ai * HALF + m * 16) * ldc + col0;
#pragma unroll
                for (int bj = 0; bj < 2; ++bj) { f32x4 v0 = acc[ai][bj][m][0], v1 = acc[ai][bj][m][1];
                    if (isv) { f32x2 a = gelu_pk((f32x2){v0[0], v0[1]}), b = gelu_pk((f32x2){v0[2], v0[3]}), c = gelu_pk((f32x2){v1[0], v1[1]}), d = gelu_pk((f32x2){v1[2], v1[3]});
                        v0 = (f32x4){a.x, a.y, b.x, b.y}; v1 = (f32x4){c.x, c.y, d.x, d.y}; ss[bj][0] += v0 * v0; ss[bj][1] += v1 * v1; }
                    u32x4 w; w.x = cvt_pk_bf16(v0[0], v0[1]); w.y = cvt_pk_bf16(v0[2], v0[3]); w.z = cvt_pk_bf16(v1[0], v1[1]); w.w = cvt_pk_bf16(v1[2], v1[3]);
                    *(u32x4*)(rowp + bj * HALF) = w; } }
        if (isv) {
#pragma unroll
            for (int bj = 0; bj < 2; ++bj)
#pragma unroll
                for (int n = 0; n < 2; ++n)
#pragma unroll
                    for (int j = 0; j < 4; ++j) { float s = ss[bj][n][j]; s += __shfl_xor(s, 1); s += __shfl_xor(s, 2); s += __shfl_xor(s, 4); s += __shfl_xor(s, 8);
                        if (fr == 0) atomicAdd(vss + col0 + bj * HALF + 4 * n + j, s); }
        }
    }
};
struct EpiUG {
    static constexpr bool PERM = true, AFTER_DRAIN = false, MID = false, OVL = false, ATR = false;
    bf16_t* U; bf16_t* G; int ldu;
    __device__ __forceinline__ void operator()(const f32x4 (&acc)[2][2][4][2], const Unit& u, int wr, int wc, int fr, int fq) const {
        const int row0 = u.pm * BM + wr * 64 + fr; int colt = u.pn * BM; const bool isu = colt < 1024;
        bf16_t* base = isu ? U : G; const int ldc = isu ? ldu : 2048; if (!isu) colt -= 1024;
        const int col0 = colt + wc * 32 + 8 * fq;
#pragma unroll
        for (int ai = 0; ai < 2; ++ai)
#pragma unroll
            for (int m = 0; m < 4; ++m) { bf16_t* rowp = base + (size_t)(row0 + ai * HALF + m * 16) * ldc + col0;
#pragma unroll
                for (int bj = 0; bj < 2; ++bj) { f32x4 v0 = acc[ai][bj][m][0], v1 = acc[ai][bj][m][1];
                    f32x2 a, b, c, d;
                    if (isu) { a = gelu_pk((f32x2){v0[0], v0[1]}); b = gelu_pk((f32x2){v0[2], v0[3]}); c = gelu_pk((f32x2){v1[0], v1[1]}); d = gelu_pk((f32x2){v1[2], v1[3]}); }
                    else { a = sigmoid_pk((f32x2){v0[0], v0[1]}); b = sigmoid_pk((f32x2){v0[2], v0[3]}); c = sigmoid_pk((f32x2){v1[0], v1[1]}); d = sigmoid_pk((f32x2){v1[2], v1[3]}); }
                    u32x4 w; w.x = cvt_pk_bf16(a.x, a.y); w.y = cvt_pk_bf16(b.x, b.y); w.z = cvt_pk_bf16(c.x, c.y); w.w = cvt_pk_bf16(d.x, d.y);
                    *(u32x4*)(rowp + bj * HALF) = w; } }
    }
};
}
namespace {
struct WJob { const float* W; const float* g; bf16* dst; int K, N, c0, nc, ldd, r0, koff, perm; };
constexpr int NWJ = 9;
struct WJobs { WJob j[NWJ]; };
__device__ __forceinline__ unsigned pk2(float lo, float hi) { return f2bf(lo) | (f2bf(hi) << 16); }
__device__ __forceinline__ void wT_item(const WJob& J, LAS float* scr, int item, int lane) {
    const int nblk = J.nc / 32, kb = item / nblk, nb = item % nblk, k0 = 64 * kb, n0 = 32 * nb;
    float v[32];
#pragma unroll
    for (int i = 0; i < 32; ++i) v[i] = J.W[(size_t)(k0 + 2 * i + (lane >> 5)) * J.N + J.c0 + n0 + (lane & 31)];
    if (J.g) {
#pragma unroll
        for (int i = 0; i < 32; ++i) v[i] *= J.g[k0 + 2 * i + (lane >> 5)]; }
#pragma unroll
    for (int i = 0; i < 32; ++i) scr[(2 * i + (lane >> 5)) * 33 + (lane & 31)] = v[i];
    asm volatile("s_waitcnt lgkmcnt(0)" ::: "memory");
    const int c = lane & 7; int rb = n0;
    if (J.perm) { const int half = n0 >= 2816, cc = n0 - half * 2816; rb = 256 * (cc >> 7) + 128 * half + (cc & 127); }
#pragma unroll
    for (int j = 0; j < 4; ++j) { const int n = (lane >> 3) + 8 * j; const LAS float* s = scr + (8 * c) * 33 + n;
        uint4 o; o.x = pk2(s[0 * 33], s[1 * 33]); o.y = pk2(s[2 * 33], s[3 * 33]); o.z = pk2(s[4 * 33], s[5 * 33]); o.w = pk2(s[6 * 33], s[7 * 33]);
        *(uint4*)(J.dst + (size_t)(J.r0 + rb + n) * J.ldd + J.koff + k0 + 8 * c) = o; }
    asm volatile("s_waitcnt lgkmcnt(0)" ::: "memory");
}
__device__ __forceinline__ void p0_weights(const WJobs& WJ, int jlo, int jhi, LAS float* scr, int gw, int NGW, int lane) {
    int base = 0;
    for (int q = jlo; q < jhi; ++q) {
        const WJob& J = WJ.j[q]; const int ni = (J.K / 64) * (J.nc / 32);
        int it = gw - (base % NGW); if (it < 0) it += NGW;
        for (; it < ni; it += NGW) wT_item(J, scr, it, lane);
        base += ni;
    }
}
__device__ __forceinline__ float wave_sum(float v) {
#pragma unroll
    for (int o = 1; o < 64; o <<= 1) v += __shfl_xor(v, o);
    return v;
}
__device__ __forceinline__ void rms_row_to_bf16(const float* xrow, const float* g, bf16* orow, int lane) {
    const float4* xr = (const float4*)xrow + lane; const float4* gr = (const float4*)g + lane;
    float4 v[4]; float s = 0.f;
#pragma unroll
    for (int j = 0; j < 4; ++j) { v[j] = xr[64 * j]; s += (v[j].x * v[j].x + v[j].y * v[j].y) + (v[j].z * v[j].z + v[j].w * v[j].w); }
    const float r = rsqrtf(wave_sum(s) * (1.f / 1024.f) + EPS);
    unsigned long long* o8 = (unsigned long long*)orow + lane;
#pragma unroll
    for (int j = 0; j < 4; ++j) { const float4 gg = gr[64 * j];
        o8[64 * j] = (unsigned long long)pk2(v[j].x * r * gg.x, v[j].y * r * gg.y) | ((unsigned long long)pk2(v[j].z * r * gg.z, v[j].w * r * gg.w) << 32); }
}
__device__ __forceinline__ void rms_rows4_to_bf16(const float* xrow, const float* g, bf16* orow, int ldo, int lane) {
    float4 v[4][4]; float s[4];
#pragma unroll
    for (int r = 0; r < 4; ++r)
#pragma unroll
        for (int j = 0; j < 4; ++j) v[r][j] = ((const float4*)(xrow + (size_t)r * 1024) + lane)[64 * j];
#pragma unroll
    for (int r = 0; r < 4; ++r) { s[r] = 0.f;
#pragma unroll
        for (int j = 0; j < 4; ++j) s[r] += (v[r][j].x * v[r][j].x + v[r][j].y * v[r][j].y) + (v[r][j].z * v[r][j].z + v[r][j].w * v[r][j].w); }
#pragma unroll
    for (int r = 0; r < 4; ++r) { const float rr = rsqrtf(wave_sum(s[r]) * (1.f / 1024.f) + EPS);
        unsigned long long* o8 = (unsigned long long*)(orow + (size_t)r * ldo) + lane;
#pragma unroll
        for (int j = 0; j < 4; ++j) { const float4 gg = ((const float4*)g + lane)[64 * j];
            o8[64 * j] = (unsigned long long)pk2(v[r][j].x * rr * gg.x, v[r][j].y * rr * gg.y) | ((unsigned long long)pk2(v[r][j].z * rr * gg.z, v[r][j].w * rr * gg.w) << 32); } }
}
}

namespace {
struct SguArgs {
    const bf16* vT;
    bf16* U;
    const float* vss;
    const float* ws;
    const float* bs;
    const float* gn;
    int TS, ldu;
};
typedef short bf16x8_t __attribute__((ext_vector_type(8)));
typedef float f32x4_t __attribute__((ext_vector_type(4)));
#define SBAR() do { asm volatile("s_waitcnt lgkmcnt(0)" ::: "memory"); __builtin_amdgcn_s_barrier(); asm volatile("" ::: "memory"); } while (0)
__device__ __forceinline__ void sgu_phase(LAS unsigned char* lds, const SguArgs& A, int first, int stride, const int tid, const int wave) {
    const int nitems = (A.TS / 128) * 8;
    if (first >= nitems) return;
    const int lane = tid & 63, fr = lane & 15, fq = lane >> 4, p = 16 * wave + fr;
    LAS float* rtab = (LAS float*)(lds + 131072);
    LAS float* gnl = (LAS float*)(lds + 131072 + 4096);
#define SGU_ISSUE(item, buf) do { const int g_ = (item) & 7, tok0_ = ((item) >> 3) * 128; \
        _Pragma("unroll") for (int i_ = 0; i_ < 4; ++i_) { const int r_ = (i_ * 8 + wave) * 4 + (lane >> 4), c_ = (lane & 15) ^ (r_ & 15); \
            __builtin_amdgcn_global_load_lds((const unsigned*)(A.vT + (size_t)(g_ * 128 + r_) * A.TS + tok0_ + 8 * c_), (LAS unsigned*)(lds + (buf) * 65536 + (i_ * 8 + wave) * 1024), 16, 0, 0); \
            __builtin_amdgcn_global_load_lds((const unsigned*)(A.U + (size_t)(tok0_ + r_) * A.ldu + g_ * 128 + 8 * c_), (LAS unsigned*)(lds + (buf) * 65536 + 32768 + (i_ * 8 + wave) * 1024), 16, 0, 0); } } while (0)
    SGU_ISSUE(first, 0);
    int gcur = -1; float wf[4][8]; float bsp = 0.f;
    for (int e = tid; e < 1024; e += 512) { const int k = e >> 7, it = first + k * stride;
        if (it < nitems) rtab[e] = rsqrtf(A.vss[(it >> 3) * 128 + (e & 127)] * (1.f / 1024.f) + EPS); }
    int k = 0;
    for (int it = first; it < nitems; it += stride, ++k) {
        const int g = it & 7, tok0 = (it >> 3) * 128, buf = k & 1;
        if (g != gcur) {
            gcur = g;
#pragma unroll
            for (int kk = 0; kk < 4; ++kk) { const float4 w0 = *(const float4*)(A.ws + ((size_t)g * 128 + p) * 128 + 32 * kk + 8 * fq), w1 = *(const float4*)(A.ws + ((size_t)g * 128 + p) * 128 + 32 * kk + 8 * fq + 4);
                wf[kk][0] = w0.x; wf[kk][1] = w0.y; wf[kk][2] = w0.z; wf[kk][3] = w0.w; wf[kk][4] = w1.x; wf[kk][5] = w1.y; wf[kk][6] = w1.z; wf[kk][7] = w1.w; }
            bsp = A.bs[g * 128 + p];
            SBAR();
            if (tid < 128) gnl[tid] = A.gn[g * 128 + tid];
        }
        asm volatile("s_waitcnt vmcnt(0)" ::: "memory"); SBAR();
        if (it + stride < nitems) SGU_ISSUE(it + stride, buf ^ 1);
        const LAS unsigned char* BT = lds + buf * 65536; const LAS unsigned char* UT = BT + 32768;
        bf16x8_t af[4];
#pragma unroll
        for (int kk = 0; kk < 4; ++kk) { const f32x4_t r0 = *(const LAS f32x4_t*)(rtab + k * 128 + 32 * kk + 8 * fq), r1 = *(const LAS f32x4_t*)(rtab + k * 128 + 32 * kk + 8 * fq + 4);
            uint4 o; o.x = pk2(wf[kk][0] * r0[0], wf[kk][1] * r0[1]); o.y = pk2(wf[kk][2] * r0[2], wf[kk][3] * r0[3]); o.z = pk2(wf[kk][4] * r1[0], wf[kk][5] * r1[1]); o.w = pk2(wf[kk][6] * r1[2], wf[kk][7] * r1[3]);
            af[kk] = __builtin_bit_cast(bf16x8_t, o); }
        f32x4_t acc[8];
#pragma unroll
        for (int nt = 0; nt < 8; ++nt) acc[nt] = (f32x4_t){0.f, 0.f, 0.f, 0.f};
#pragma unroll
        for (int kk = 0; kk < 4; ++kk) {
            bf16x8_t bfr[8];
#pragma unroll
            for (int nt = 0; nt < 8; ++nt) bfr[nt] = *(const LAS bf16x8_t*)(BT + (16 * nt + fr) * 256 + 16 * ((4 * kk + fq) ^ fr));
#pragma unroll
            for (int nt = 0; nt < 8; ++nt) acc[nt] = __builtin_amdgcn_mfma_f32_16x16x32_bf16(bfr[nt], af[kk], acc[nt], 0, 0, 0);
        }
        bf16* urow = A.U + (size_t)(tok0 + p) * A.ldu + g * 128 + 4 * fq;
#pragma unroll
        for (int nt = 0; nt < 8; ++nt) {
            typedef unsigned u32x2_t __attribute__((ext_vector_type(2)));
            const u32x2_t uu = *(const LAS u32x2_t*)(UT + p * 256 + 16 * ((2 * nt + (fq >> 1)) ^ fr) + 8 * (fq & 1));
            const f32x4_t gv = *(const LAS f32x4_t*)(gnl + 16 * nt + 4 * fq);
            const float y0 = bf2f(uu.x & 0xffffu) * (gv[0] * acc[nt][0] + bsp), y1 = bf2f(uu.x >> 16) * (gv[1] * acc[nt][1] + bsp);
            const float y2 = bf2f(uu.y & 0xffffu) * (gv[2] * acc[nt][2] + bsp), y3 = bf2f(uu.y >> 16) * (gv[3] * acc[nt][3] + bsp);
            uint2 o; o.x = pk2(y0, y1); o.y = pk2(y2, y3);
            *(uint2*)(urow + 16 * nt) = o;
        }
    }
    asm volatile("s_waitcnt vmcnt(0)" ::: "memory"); SBAR();
#undef SGU_ISSUE
}
}

namespace pg8 {
__device__ __forceinline__ void bf8_to_f32(const u32x4 q, f32x4& lo, f32x4& hi) {
    lo = (f32x4){__builtin_bit_cast(float, q.x << 16), __builtin_bit_cast(float, q.x & 0xffff0000u), __builtin_bit_cast(float, q.y << 16), __builtin_bit_cast(float, q.y & 0xffff0000u)};
    hi = (f32x4){__builtin_bit_cast(float, q.z << 16), __builtin_bit_cast(float, q.z & 0xffff0000u), __builtin_bit_cast(float, q.w << 16), __builtin_bit_cast(float, q.w & 0xffff0000u)};
}
struct EpiMerge {
    static constexpr bool PERM = true, AFTER_DRAIN = false, MID = true, OVL = false, ATR = true;
    const bf16_t* G; bf16_t* O;
    __device__ __forceinline__ void mid(f32x4 (&acc)[2][2][4][2], const Unit& u, int wr, int wc, int fr, int fq) const {
        unsigned off0 = (unsigned)(u.pm * BM + wr * 64 + fr) * 2048u + (unsigned)(u.pn * BM + wc * 32 + 8 * fq);
        asm volatile("" : "+v"(off0));
#pragma unroll
        for (int ai = 0; ai < 2; ++ai)
#pragma unroll
            for (int m = 0; m < 4; ++m)
#pragma unroll
                for (int bj = 0; bj < 2; ++bj) { const bf16_t* gp = G + (off0 + (unsigned)((ai * HALF + m * 16) * 2048 + bj * HALF));
                    const u32x4 qa = *(const u32x4*)gp, qb = *(const u32x4*)(gp + 1024);
                    f32x4 a0, a1, b0, b1; bf8_to_f32(qa, a0, a1); bf8_to_f32(qb, b0, b1);
#pragma unroll
                    for (int j = 0; j < 4; ++j) { acc[ai][bj][m][0][j] *= a0[j] * __builtin_amdgcn_rcpf(b0[j]); acc[ai][bj][m][1][j] *= a1[j] * __builtin_amdgcn_rcpf(b1[j]); }
                    asm volatile("" ::: "memory"); }
    }
    __device__ __forceinline__ void operator()(const f32x4 (&acc)[2][2][4][2], const Unit& u, int wr, int wc, int fr, int fq) const {
        const int row0 = u.pm * BM + wr * 64 + fr, col0 = u.pn * BM + wc * 32 + 8 * fq;
#pragma unroll
        for (int ai = 0; ai < 2; ++ai)
#pragma unroll
            for (int m = 0; m < 4; ++m) { const size_t r = (size_t)(row0 + ai * HALF + m * 16);
#pragma unroll
                for (int bj = 0; bj < 2; ++bj) { f32x4 b0, b1; bf8_to_f32(*(const u32x4*)(G + r * 2048 + 1024 + col0 + bj * HALF), b0, b1);
                    const f32x4 v0 = acc[ai][bj][m][0] * b0, v1 = acc[ai][bj][m][1] * b1;
                    u32x4 w; w.x = cvt_pk_bf16(v0[0], v0[1]); w.y = cvt_pk_bf16(v0[2], v0[3]); w.z = cvt_pk_bf16(v1[0], v1[1]); w.w = cvt_pk_bf16(v1[2], v1[3]);
                    *(u32x4*)(O + r * 1024 + col0 + bj * HALF) = w; } }
    }
};
}
namespace {
__device__ __forceinline__ void tr64_item(const bf16* yaT, int TS, bf16* out, int ldo, LAS unsigned short* scr, int c0, int t0, int lane) {
#pragma unroll
    for (int i = 0; i < 8; ++i) { const int r = 8 * i + (lane >> 3), ch = lane & 7;
        const pg8::u32x4 q = *(const pg8::u32x4*)(yaT + (size_t)(c0 + r) * TS + t0 + 8 * ch);
        LAS unsigned short* d = scr + (8 * ch) * 72 + r;
        d[0 * 72] = (unsigned short)(q.x & 0xffffu); d[1 * 72] = (unsigned short)(q.x >> 16); d[2 * 72] = (unsigned short)(q.y & 0xffffu); d[3 * 72] = (unsigned short)(q.y >> 16);
        d[4 * 72] = (unsigned short)(q.z & 0xffffu); d[5 * 72] = (unsigned short)(q.z >> 16); d[6 * 72] = (unsigned short)(q.w & 0xffffu); d[7 * 72] = (unsigned short)(q.w >> 16); }
    asm volatile("s_waitcnt lgkmcnt(0)" ::: "memory");
#pragma unroll
    for (int i = 0; i < 8; ++i) { const int tk = 8 * i + (lane >> 3), ch = lane & 7;
        const pg8::u32x4 q = *(const LAS pg8::u32x4*)(scr + tk * 72 + 8 * ch);
        *(pg8::u32x4*)(out + (size_t)(t0 + tk) * ldo + c0 + 8 * ch) = q; }
    asm volatile("s_waitcnt lgkmcnt(0)" ::: "memory");
}
__device__ __forceinline__ void transpose_ya(const bf16* yaT, int TS, bf16* out, int ldo, LAS unsigned short* scr, int gw, int NGW, int lane) {
    const int ntt = TS / 64, nit = 16 * ntt;
    for (int it = gw; it < nit; it += NGW) tr64_item(yaT, TS, out, ldo, scr, 64 * (it / ntt), 64 * (it % ntt), lane);
}
}

namespace pg8 {
template <bool FIRST> struct EpiResid {
    static constexpr bool PERM = false, AFTER_DRAIN = false, MID = false, OVL = false, ATR = false;
    const float* X; const bf16_t* XB; float* X1; bf16_t* X1b; float* xss;
    __device__ __forceinline__ void operator()(const f32x4 (&acc)[2][2][4][2], const Unit& u, int wr, int wc, int fr, int fq) const {
        const int row0 = u.pm * BM + wr * 64 + fr, col0 = u.pn * BM + wc * 32 + 4 * fq;
        typedef unsigned u32x2v __attribute__((ext_vector_type(2)));
#pragma unroll
        for (int ai = 0; ai < 2; ++ai)
#pragma unroll
            for (int m = 0; m < 4; ++m) { const size_t r = (size_t)(row0 + ai * HALF + m * 16); float s = 0.f;
#pragma unroll
                for (int bj = 0; bj < 2; ++bj)
#pragma unroll
                    for (int n = 0; n < 2; ++n) { const size_t o = r * 1024 + col0 + bj * HALF + n * 16;
                        f32x4 v;
                        if (FIRST) v = acc[ai][bj][m][n] + *(const f32x4*)(X + o);
                        else { const u32x2v q = *(const u32x2v*)(XB + o);
                               v = acc[ai][bj][m][n] + (f32x4){__builtin_bit_cast(float, q.x << 16), __builtin_bit_cast(float, q.x & 0xffff0000u), __builtin_bit_cast(float, q.y << 16), __builtin_bit_cast(float, q.y & 0xffff0000u)}; }
                        { u32x2v w; w.x = cvt_pk_bf16(v[0], v[1]); w.y = cvt_pk_bf16(v[2], v[3]); *(u32x2v*)(X1b + o) = w; }
                        s += (v[0] * v[0] + v[1] * v[1]) + (v[2] * v[2] + v[3] * v[3]); }
                s += __shfl_xor(s, 16); s += __shfl_xor(s, 32);
                if (fq == 0) atomicAdd(xss + r, s);
                asm volatile("" ::: "memory"); }
    }
};
struct EpiResidNorm {
    static constexpr bool PERM = false, AFTER_DRAIN = true, MID = false, OVL = false, ATR = false;
    const bf16_t* XB; float* out; float* x2ss; const float* g; unsigned* cnt;
    __device__ __forceinline__ void fused(f32x4 (&acc)[2][2][4][2], const Unit& u, int wr, int wc, int fr, int fq, PG8_LAS unsigned char* lds, int wid, int lane) const {
        typedef unsigned u32x2v __attribute__((ext_vector_type(2)));
        const int row0 = u.pm * BM + wr * 64 + fr, col0 = u.pn * BM + wc * 32 + 4 * fq;
        float keep = 0.f;
#pragma unroll
        for (int ai = 0; ai < 2; ++ai)
#pragma unroll
            for (int m = 0; m < 4; ++m) { const size_t r = (size_t)(row0 + ai * HALF + m * 16); float s = 0.f;
#pragma unroll
                for (int bj = 0; bj < 2; ++bj)
#pragma unroll
                    for (int n = 0; n < 2; ++n) { const u32x2v q = *(const u32x2v*)(XB + r * 1024 + col0 + bj * HALF + n * 16);
                        const f32x4 v = acc[ai][bj][m][n] + (f32x4){__builtin_bit_cast(float, q.x << 16), __builtin_bit_cast(float, q.x & 0xffff0000u), __builtin_bit_cast(float, q.y << 16), __builtin_bit_cast(float, q.y & 0xffff0000u)};
                        acc[ai][bj][m][n] = v; s += (v[0] * v[0] + v[1] * v[1]) + (v[2] * v[2] + v[3] * v[3]); }
                s += __shfl_xor(s, 16); s += __shfl_xor(s, 32);
                if (fq == 0) keep += atomicAdd(x2ss + r, s); }
        asm volatile("s_waitcnt vmcnt(0)" :: "v"(keep) : "memory");
        asm volatile("s_waitcnt lgkmcnt(0)" ::: "memory"); __builtin_amdgcn_s_barrier(); asm volatile("" ::: "memory");
        if (wid == 0) {
            if (lane == 0) { __hip_atomic_fetch_add(cnt + 64 * u.pm, 1u, __ATOMIC_RELAXED, __HIP_MEMORY_SCOPE_AGENT);
                unsigned spins = 0;
                while (__hip_atomic_load(cnt + 64 * u.pm, __ATOMIC_RELAXED, __HIP_MEMORY_SCOPE_AGENT) < 4u) { __builtin_amdgcn_s_sleep(2); if (++spins > (1u << 22)) break; } }
            __builtin_amdgcn_fence(__ATOMIC_ACQUIRE, "agent");
            asm volatile("s_waitcnt vmcnt(0)" ::: "memory");
        }
        asm volatile("s_waitcnt lgkmcnt(0)" ::: "memory"); __builtin_amdgcn_s_barrier(); asm volatile("" ::: "memory");
        f32x4 gv[2][2];
#pragma unroll
        for (int bj = 0; bj < 2; ++bj)
#pragma unroll
            for (int n = 0; n < 2; ++n) gv[bj][n] = *(const f32x4*)(g + col0 + bj * HALF + n * 16);
#pragma unroll
        for (int ai = 0; ai < 2; ++ai)
#pragma unroll
            for (int m = 0; m < 4; ++m) { const size_t r = (size_t)(row0 + ai * HALF + m * 16);
                const float rs = rsqrtf(__hip_atomic_load(x2ss + r, __ATOMIC_RELAXED, __HIP_MEMORY_SCOPE_AGENT) * (1.0f / 1024.0f) + 1e-6f);
#pragma unroll
                for (int bj = 0; bj < 2; ++bj)
#pragma unroll
                    for (int n = 0; n < 2; ++n) *(f32x4*)(out + r * 1024 + col0 + bj * HALF + n * 16) = acc[ai][bj][m][n] * gv[bj][n] * rs; }
    }
};
__device__ __forceinline__ float dpp_ror1(float v) { return __builtin_bit_cast(float, __builtin_amdgcn_update_dpp(0, __builtin_bit_cast(int, v), 0x121, 0xf, 0xf, false)); }
__device__ __forceinline__ float dpp_rol1(float v) { return __builtin_bit_cast(float, __builtin_amdgcn_update_dpp(0, __builtin_bit_cast(int, v), 0x12f, 0xf, 0xf, false)); }
struct EpiUpAct {
    static constexpr bool PERM = true, AFTER_DRAIN = false, MID = false, OVL = true, ATR = false;
    bf16_t* ACT; PG8_LAS float* XB; const float* xss; const float* cw; const float* cb;
    __device__ __forceinline__ void operator()(f32x4 (&acc)[2][2][4][2], const Unit& u, int wr, int wc, int fr_, int fq_) const {
        int lane_; asm volatile("v_mbcnt_lo_u32_b32 %0, -1, 0\n\tv_mbcnt_hi_u32_b32 %0, -1, %0" : "=v"(lane_));
        const int fr = lane_ & 15, fq = lane_ >> 4; (void)fr_; (void)fq_;
        const int seq = u.pm / 17, ti = u.pm % 17, rowbase = ovl_row(u.pm);
        const int own_lo = seq * 4096 + 254 * ti, own_hi = seq * 4096 + (254 * ti + 254 < 4096 ? 254 * ti + 254 : 4096);
        const int lr0 = wr * 64 + fr, cl = 32 * wc + 8 * fq;
#pragma unroll
        for (int ai = 0; ai < 2; ++ai)
#pragma unroll
            for (int m = 0; m < 4; ++m) { const float rs = rsqrtf(xss[rowbase + lr0 + ai * HALF + m * 16] * (1.0f / 1024.0f) + 1e-6f);
#pragma unroll
                for (int bj = 0; bj < 2; ++bj) { acc[ai][bj][m][0] *= rs; acc[ai][bj][m][1] *= rs; }
                __builtin_amdgcn_sched_barrier(0); }
        const bool e0 = fr == 0, e15 = fr == 15;
        const int slot = e0 ? 0 : (e15 ? 512 : 1024);
#pragma unroll
        for (int ai = 0; ai < 2; ++ai) { const int B = 2 * ai + wr;
            f32x4 p0, p1;
#pragma unroll
            for (int j = 0; j < 4; ++j) { p0[j] = e15 ? acc[ai][0][3][0][j] : acc[ai][0][0][0][j]; p1[j] = e15 ? acc[ai][0][3][1][j] : acc[ai][0][0][1][j]; }
            *(PG8_LAS f32x4*)(XB + slot + B * 128 + cl) = p0; *(PG8_LAS f32x4*)(XB + slot + B * 128 + cl + 4) = p1; }
        asm volatile("s_waitcnt lgkmcnt(0)" ::: "memory"); __builtin_amdgcn_s_barrier(); asm volatile("" ::: "memory");
        const int ch = 128 * u.pn + cl;
        typedef unsigned u32x2v __attribute__((ext_vector_type(2)));
#pragma unroll
        for (int ai = 0; ai < 2; ++ai) { const int B = 2 * ai + wr;
#pragma unroll
            for (int n = 0; n < 2; ++n) {
                const f32x4 w0 = *(const f32x4*)(cw + ch + 4 * n), w1 = *(const f32x4*)(cw + 2816 + ch + 4 * n), w2 = *(const f32x4*)(cw + 5632 + ch + 4 * n), bb = *(const f32x4*)(cb + ch + 4 * n);
                f32x4 pb = *(const PG8_LAS f32x4*)(XB + 512 + (B > 0 ? B - 1 : 0) * 128 + cl + 4 * n), nb = *(const PG8_LAS f32x4*)(XB + (B < 3 ? B + 1 : 3) * 128 + cl + 4 * n);
                if (B == 0) pb = (f32x4){0.f, 0.f, 0.f, 0.f};
                if (B == 3) nb = (f32x4){0.f, 0.f, 0.f, 0.f};
                float o[4][4];
#pragma unroll
                for (int j = 0; j < 4; ++j) {
                    float av[4], rr[4], ll[4];
#pragma unroll
                    for (int m = 0; m < 4; ++m) { av[m] = acc[ai][0][m][n][j]; rr[m] = dpp_ror1(av[m]); ll[m] = dpp_rol1(av[m]); }
#pragma unroll
                    for (int m = 0; m < 4; ++m) { const float pv = e0 ? (m > 0 ? rr[m - 1] : pb[j]) : rr[m], nv = e15 ? (m < 3 ? ll[m + 1] : nb[j]) : ll[m];
                        const float sv = bb[j] + w0[j] * pv + w1[j] * av[m] + w2[j] * nv;
                        o[m][j] = sv * __builtin_amdgcn_rcpf(1.0f + __builtin_amdgcn_exp2f(sv * -1.4426950408889634f)) * acc[ai][1][m][n][j]; }
                }
#pragma unroll
                for (int m = 0; m < 4; ++m) { const int tok = rowbase + lr0 + ai * HALF + m * 16;
                    if (tok >= own_lo && tok < own_hi) { u32x2v w; w.x = cvt_pk_bf16(o[m][0], o[m][1]); w.y = cvt_pk_bf16(o[m][2], o[m][3]); *(u32x2v*)(ACT + (size_t)tok * 2816 + ch + 4 * n) = w; } }
                __builtin_amdgcn_sched_barrier(0);
            } }
    }
};
}
namespace {
__device__ __forceinline__ void final_norm(const bf16* X2, const float* ss, const float* g, float* out, int TS, int gw, int NGW, int lane) {
    pg8::f32x4 g0[2], g1[2];
#pragma unroll
    for (int j = 0; j < 2; ++j) { g0[j] = *((const pg8::f32x4*)g + 2 * lane + 128 * j); g1[j] = *((const pg8::f32x4*)g + 2 * lane + 128 * j + 1); }
    for (int t = 2 * gw; t < TS; t += 2 * NGW) {
        pg8::u32x4 q[2][2]; float r[2];
#pragma unroll
        for (int k = 0; k < 2; ++k) { r[k] = rsqrtf(ss[t + k] * (1.0f / 1024.0f) + EPS);
#pragma unroll
            for (int j = 0; j < 2; ++j) q[k][j] = *((const pg8::u32x4*)(X2 + (size_t)(t + k) * 1024) + lane + 64 * j); }
#pragma unroll
        for (int k = 0; k < 2; ++k)
#pragma unroll
            for (int j = 0; j < 2; ++j) { pg8::f32x4 lo, hi; pg8::bf8_to_f32(q[k][j], lo, hi);
                pg8::f32x4* o = (pg8::f32x4*)(out + (size_t)(t + k) * 1024) + 2 * lane + 128 * j;
                o[0] = lo * g0[j] * r[k]; o[1] = hi * g1[j] * r[k]; }
    }
}
}

namespace {
constexpr int MLPW_W2 = 33 * 64, MLPW_W3 = MLPW_W2 + 4096, MLPW_B = MLPW_W3 + 4096, MLPW_N = MLPW_B + 256;
__device__ __forceinline__ float filt_z(int l, int j) {
    if (j == 0) return (float)((double)l / (double)(L - 1));
    const int i = (j - 1) & 15;
    const double band = 1e-4 + (double)i * ((15.0 - 1e-4) / 15.0);
    double rev = (double)l * band / (double)L;
    rev -= floor(rev);
    const float ang = (float)(rev * 6.283185307179586);
    return (j <= 16) ? cosf(ang) : -sinf(ang);
}
__device__ __forceinline__ void filter_mlp_rows2(const LAS float* wl, float* h3out, LAS float* scr, int l0, int l1, int j) {
    LAS float* za = scr; LAS float* zb = scr + 64;
    if (j < FEMB) { za[j] = filt_z(l0, j); zb[j] = filt_z(l1, j); }
    asm volatile("s_waitcnt lgkmcnt(0)" ::: "memory");
    const float a = wl[MLPW_B + 192 + j];
    float s0 = wl[MLPW_B + j], s1 = s0;
#pragma unroll 11
    for (int i = 0; i < FEMB; ++i) { const float w = wl[i * 64 + j]; s0 += za[i] * w; s1 += zb[i] * w; }
    asm volatile("s_waitcnt lgkmcnt(0)" ::: "memory");
    za[j] = sinf(a * s0); zb[j] = sinf(a * s1);
    asm volatile("s_waitcnt lgkmcnt(0)" ::: "memory");
    s0 = wl[MLPW_B + 64 + j]; s1 = s0;
#pragma unroll 8
    for (int i = 0; i < FHID; ++i) { const float w = wl[MLPW_W2 + i * 64 + j]; s0 += za[i] * w; s1 += zb[i] * w; }
    asm volatile("s_waitcnt lgkmcnt(0)" ::: "memory");
    za[j] = sinf(a * s0); zb[j] = sinf(a * s1);
    asm volatile("s_waitcnt lgkmcnt(0)" ::: "memory");
    s0 = wl[MLPW_B + 128 + j]; s1 = s0;
#pragma unroll 8
    for (int i = 0; i < FHID; ++i) { const float w = wl[MLPW_W3 + i * 64 + j]; s0 += za[i] * w; s1 += zb[i] * w; }
    h3out[l0 * FHID + j] = sinf(a * s0); h3out[l1 * FHID + j] = sinf(a * s1);
    asm volatile("s_waitcnt lgkmcnt(0)" ::: "memory");
}
typedef float f32x16_t __attribute__((ext_vector_type(16)));
__device__ __forceinline__ void stage_h3_rows32(const float* h3, int row0, LAS float* scr, int lane) {
#pragma unroll
    for (int i = 0; i < 8; ++i) { const int e = 4 * (lane + 64 * i), r = e >> 6, jj = e & 63;
        if (row0 + r < 4096) { const pg8::f32x4 v = *(const pg8::f32x4*)(h3 + (size_t)(row0 + r) * 64 + jj);
            LAS float* d = scr + r * 65 + jj; d[0] = v[0]; d[1] = v[1]; d[2] = v[2]; d[3] = v[3]; } }
}
__device__ __forceinline__ void filter_tables(const float* h3, const float* w4, const float* decay, float* fsum, float* fdif, LAS float* scr, int gw, int NGW, int lane) {
    const int r = lane & 31, h = lane >> 5;
    for (int it = gw; it < 2048; it += NGW) {
        const int c0 = (it & 31) * 32, nbase = (it >> 5) * 64;
        float af[32], ab[32];
#pragma unroll
        for (int kk = 0; kk < 32; ++kk) { af[kk] = w4[(2 * kk + h) * 2048 + c0 + r]; ab[kk] = w4[(2 * kk + h) * 2048 + 1024 + c0 + r]; }
        float dcf[16], dcb[16];
#pragma unroll
        for (int q = 0; q < 16; ++q) { const int c = c0 + (q & 3) + 8 * (q >> 2) + 4 * h; dcf[q] = fabsf(decay[c]); dcb[q] = fabsf(decay[1024 + c]); }
#pragma unroll 1
        for (int half = 0; half < 2; ++half) {
            const int n0 = nbase + 32 * half, n = n0 + r, nb = n ? 4096 - n : 0;
            stage_h3_rows32(h3, n0, scr, lane);
            stage_h3_rows32(h3, 4096 - n0 - 31, scr + 32 * 65, lane);
            asm volatile("s_waitcnt lgkmcnt(0)" ::: "memory");
            f32x16_t accF, accB;
#pragma unroll
            for (int q = 0; q < 16; ++q) { accF[q] = 0.f; accB[q] = 0.f; }
#pragma unroll
            for (int kk = 0; kk < 32; ++kk) {
                const float bF = scr[r * 65 + 2 * kk + h], bB = scr[32 * 65 + (31 - r) * 65 + 2 * kk + h];
                accF = __builtin_amdgcn_mfma_f32_32x32x2f32(af[kk], bF, accF, 0, 0, 0);
                accB = __builtin_amdgcn_mfma_f32_32x32x2f32(ab[kk], bB, accB, 0, 0, 0);
            }
            const float tf = (float)n * (1.0f / 4095.0f), tb = (float)nb * (1.0f / 4095.0f);
#pragma unroll
            for (int q = 0; q < 16; ++q) { const int c = c0 + (q & 3) + 8 * (q >> 2) + 4 * h;
                const float hf = accF[q] * expf(-tf * dcf[q]);
                const float hb = n ? accB[q] * expf(-tb * dcb[q]) : 0.f;
                fsum[(size_t)c * 4096 + n] = hf + hb;
                fdif[(size_t)c * 4096 + n] = hf - hb; }
            asm volatile("s_waitcnt lgkmcnt(0)" ::: "memory");
        }
    }
}
#define RLX_AGENT __ATOMIC_RELAXED, __HIP_MEMORY_SCOPE_AGENT
#define XB_TMO      128
#define XB_XCNT(j)  (256  + 64 * (j))
#define XB_XSUB(j)  (1280 + 64 * (j))
#define XB_XGEN(j)  (2304 + 64 * (j))
#define XB_TOP      3328
#define XB_TOPGEN   3392
#define XCD_BAR_WORDS 3456
#define XB_SPIN_CAP (1u << 18)

__device__ __forceinline__ unsigned xb_ld(unsigned* p)              { return __hip_atomic_load(p, __ATOMIC_RELAXED, __HIP_MEMORY_SCOPE_AGENT); }
__device__ __forceinline__ unsigned xb_add(unsigned* p, unsigned v) { return __hip_atomic_fetch_add(p, v, __ATOMIC_RELAXED, __HIP_MEMORY_SCOPE_AGENT); }
__device__ __forceinline__ unsigned xb_xcc_id() { return (unsigned)__builtin_amdgcn_s_getreg((3 << 11) | 20) & 0xFu; }
#define XB_SPIN(cond, bar) do { unsigned _sp = 0; while (cond) { __builtin_amdgcn_s_sleep(1); \
    if ((++_sp & 255u) == 0u) { if (xb_ld(&(bar)[XB_TMO])) break; if (_sp > XB_SPIN_CAP) { atomicAdd(&(bar)[XB_TMO], 1u); break; } } } } while (0)

struct XcdBarrier {
    unsigned* bar; unsigned x;
    volatile LAS unsigned* st;
};

__device__ __forceinline__ XcdBarrier xcd_barrier_post(unsigned* bar, volatile LAS unsigned* st) {
    XcdBarrier b; b.bar = bar; b.x = xb_xcc_id(); b.st = st;
    if (threadIdx.x == 0) (void)xb_add(&bar[XB_XCNT(b.x)], 1u);
    return b;
}
__device__ __forceinline__ void xcd_barrier_complete(unsigned* bar, unsigned x, unsigned& nloc, unsigned& nx) {
    const unsigned G = gridDim.x * gridDim.y * gridDim.z;
    unsigned sum, cnt, mine, sp = 0u;
    for (;;) {
        sum = 0u; cnt = 0u; mine = 0u;
#pragma unroll
        for (unsigned j = 0; j < 16; ++j) { const unsigned c = xb_ld(&bar[XB_XCNT(j)]); sum += c; cnt += (c > 0u) ? 1u : 0u; mine = (j == x) ? c : mine; }
        if (sum == G) break;
        __builtin_amdgcn_s_sleep(1);
        if ((++sp & 255u) == 0u) { if (xb_ld(&bar[XB_TMO])) break; if (sp > XB_SPIN_CAP) { atomicAdd(&bar[XB_TMO], 1u); break; } }
    }
    nloc = mine > 0u ? mine : 1u; nx = cnt > 0u ? cnt : 1u;
}

__device__ __forceinline__ void xcd_barrier(const XcdBarrier& b) {
    asm volatile("s_waitcnt vmcnt(0)" ::: "memory");
    block_sync();
    if (threadIdx.x == 0) {
        unsigned* bar = b.bar;
        __builtin_amdgcn_s_waitcnt(0);
        unsigned nloc = b.st[0], nx = b.st[1];
        if (nloc == 0u) { xcd_barrier_complete(bar, b.x, nloc, nx); b.st[0] = nloc; b.st[1] = nx; }
        const unsigned old = xb_add(&bar[XB_XSUB(b.x)], 1u);
        const unsigned gen = old / nloc;
        if (old + 1u == (gen + 1u) * nloc) {
            __builtin_amdgcn_fence(__ATOMIC_RELEASE, "agent");
            asm volatile("s_waitcnt vmcnt(0)" ::: "memory");
            const unsigned og = xb_add(&bar[XB_TOP], 1u);
            const unsigned tg = og / nx;
            if (og + 1u == (tg + 1u) * nx) xb_add(&bar[XB_TOPGEN], 1u);
            else XB_SPIN(xb_ld(&bar[XB_TOPGEN]) == tg, bar);
            __builtin_amdgcn_fence(__ATOMIC_ACQUIRE, "agent");
            xb_add(&bar[XB_XGEN(b.x)], 1u);
            asm volatile("s_waitcnt vmcnt(0)" ::: "memory");
        } else {
            XB_SPIN(xb_ld(&bar[XB_XGEN(b.x)]) == gen, bar);
            __builtin_amdgcn_fence(__ATOMIC_ACQUIRE, "agent");
            asm volatile("s_waitcnt vmcnt(0)" ::: "memory");
        }
    }
    block_sync();
}

constexpr size_t MiB = 1u << 20;
constexpr int M = NB * L;
constexpr size_t WS_VSS = 0, WS_XSS = 64 * 1024, WS_X2SS = 128 * 1024, WS_TTAB = 192 * 1024, WS_BAR = 256 * 1024, WS_PCNT = 272 * 1024, WS_H3 = 1 * MiB;
constexpr size_t WS_WTA = 2 * MiB, WS_WTB = 10 * MiB, WS_PAB = 16 * MiB, WS_WO = 20 * MiB;
constexpr size_t WS_FSUM = 24 * MiB, WS_WUP = 24 * MiB, WS_WDN = 249 * MiB;
constexpr size_t WS_HYT = 41 * MiB;
constexpr size_t WS_X1B = 41 * MiB, WS_MRG = 105 * MiB;
constexpr size_t WS_YAB = 169 * MiB;
constexpr size_t WS_FDIF = 233 * MiB;
constexpr size_t WS_AP = 73 * MiB, WS_GP = 161 * MiB;
static_assert(WS_GP + (size_t)M * FH * 2 <= 256 * MiB && WS_AP + (size_t)M * FH * 2 <= WS_GP && WS_FDIF + 16 * MiB <= 256 * MiB && WS_WDN + (size_t)D * FH * 2 <= 256 * MiB && WS_WUP + (size_t)2 * FH * D * 2 <= WS_HYT, "d_ws map");
constexpr int LDS_BYTES = 155648;
static_assert(HY_LDS_END + 256 <= LDS_BYTES, "LDS map");
constexpr int NPH = 8;

struct MegaArgs { const float* in[27]; float* out; unsigned char* ws; int ph_lo, ph_hi; WJobs wj; };

__global__ void __launch_bounds__(512, 2) __attribute__((target("no-packed-fp32-ops"))) mega_fwd(MegaArgs a) {
    extern __shared__ __attribute__((aligned(16))) unsigned char lds_raw[];
    LAS unsigned char* lds = (LAS unsigned char*)lds_raw;
    cg::grid_group grid = cg::this_grid();
    const int wave = __builtin_amdgcn_readfirstlane((int)threadIdx.x >> 6);
    const int G = gridDim.x, bid = blockIdx.x, gw = bid * 8 + wave, NGW = G * 8;
#define FRESH_TID int lane; asm volatile("v_mbcnt_lo_u32_b32 %0, -1, 0\n\tv_mbcnt_hi_u32_b32 %0, -1, %0" : "=v"(lane)); const int tid = wave * 64 + lane; (void)tid
    unsigned char* ws = a.ws;
    const float* x = a.in[0];
    float* vss = (float*)(ws + WS_VSS); float* xss = (float*)(ws + WS_XSS); float* x2ss = (float*)(ws + WS_X2SS);
    cfv* Ttab = (cfv*)(ws + WS_TTAB); float* h3 = (float*)(ws + WS_H3);
    bf16* WtA = (bf16*)(ws + WS_WTA); bf16* WtB = (bf16*)(ws + WS_WTB); bf16* PabT = (bf16*)(ws + WS_PAB); bf16* WoT = (bf16*)(ws + WS_WO);
    bf16* WupT = (bf16*)(ws + WS_WUP); bf16* WdnT = (bf16*)(ws + WS_WDN);
    float* fsum = (float*)(ws + WS_FSUM); float* fdif = (float*)(ws + WS_FDIF);
    bf16* hyvT = (bf16*)(ws + WS_HYT); bf16* yaT = hyvT + (size_t)1024 * M; bf16* vT = hyvT + (size_t)3072 * M;
    bf16* YAB = (bf16*)(ws + WS_YAB); bf16* h1 = YAB; bf16* Ub = YAB + 1024;
    bf16* Gb = (bf16*)a.out;
    bf16* mrg = (bf16*)(ws + WS_MRG); bf16* X1b = (bf16*)(ws + WS_X1B); float* X1 = a.out;
    bf16* APb = (bf16*)(ws + WS_AP); bf16* GPb = (bf16*)(ws + WS_GP);
    const int lo = a.ph_lo, hi = a.ph_hi;
#define IN(k) (lo <= (k) && (k) < hi)
    for (int u = (int)threadIdx.x; u < 16; u += 512) ((LAS unsigned*)(lds + LDS_BYTES - 256))[u] = 0u;
    block_sync();
    XcdBarrier xbar = xcd_barrier_post((unsigned*)(ws + WS_BAR), (volatile LAS unsigned*)(lds + LDS_BYTES - 256));
#ifdef MK_PROBE
#define STAMP(i) do { if (threadIdx.x == 0) ((volatile LAS unsigned long long*)(lds + LDS_BYTES - 128))[i] = __builtin_amdgcn_s_memrealtime(); } while (0)
#else
#define STAMP(i) do { } while (0)
#endif
    STAMP(0);
#define SEAM(k) do { if (IN(k) && IN((k) + 1)) xcd_barrier(xbar); STAMP((k) + 1); } while (0)
    if (a.ph_hi > NPH) grid.sync();

    if (IN(0)) { FRESH_TID;
        p0_weights(a.wj, 0, 8, (LAS float*)lds + wave * 4096, gw, NGW, lane);
        for (int m = 4 * gw; m < M; m += 4 * NGW) rms_rows4_to_bf16(x + (size_t)m * 1024, a.in[1], h1 + (size_t)m * 2048, 2048, lane);
        for (int i = bid * 512 + tid; i < 3 * M; i += G * 512) vss[i] = 0.f;
        block_sync();
        { LAS float* wl = (LAS float*)lds;
          for (int i = tid; i < MLPW_N; i += 512) { float v;
              if (i < MLPW_W2) v = a.in[5][i]; else if (i < MLPW_W3) v = a.in[7][i - MLPW_W2]; else if (i < MLPW_B) v = a.in[9][i - MLPW_W3];
              else { const int q = i - MLPW_B; v = q < 64 ? a.in[6][q] : q < 128 ? a.in[8][q - 64] : q < 192 ? a.in[10][q - 128] : a.in[11][q - 192]; }
              wl[i] = v; }
          block_sync();
          for (int l = 2 * gw; l < L; l += 2 * NGW) filter_mlp_rows2(wl, h3, (LAS float*)(lds + 65536) + wave * 128, l, l + 1, lane); }
        for (int m = bid * 512 + tid; m < 4096; m += G * 512) { const float ang = (float)m / 4096.0f; Ttab[m] = (cfv){cospif(ang), -sinpif(ang)}; }
    }
    SEAM(0);
    if (IN(1)) { FRESH_TID;
        { pg8::Gemm g{WtA, h1, 4096, M, 1024, 1024, 2048}; pg8::StaticOrder S; S.init(4096, M, G, bid);
          pg8::EpiHyT E{hyvT, M, vss};
          pg8::gemm_phase<pg8::EpiHyT, pg8::StaticOrder, true, true>(lds, g, S, E, tid); }
        STAMP(11);
        { pg8::Gemm g{h1, WtB, M, 3072, 1024, 2048, 1024}; pg8::StaticOrder S; S.init(M, 3072, G, bid);
          pg8::EpiUG E{Ub, Gb, 2048};
          pg8::gemm_phase<pg8::EpiUG, pg8::StaticOrder, true, true>(lds, g, S, E, tid); }
        STAMP(12);
        filter_tables(h3, a.in[12], a.in[13], fsum, fdif, (LAS float*)(lds + wave * 17408), gw, NGW, lane);
    }
    SEAM(1);
    if (IN(2)) { FRESH_TID;
        HyArgs H; H.hyT = hyvT; H.yaT = yaT; H.fsum = fsum; H.fdif = fdif; H.cw = a.in[3]; H.cb = a.in[4]; H.skip = a.in[14]; H.T = Ttab;
        H.TS = M; H.npairs = 2; H.off00 = 0; H.off01 = L; H.off10 = 2 * L; H.off11 = 3 * L;
        hyena_phase(lds, H, bid, G, tid, wave);
        block_sync();
        STAMP(13);
        SguArgs Sg; Sg.vT = vT; Sg.U = Ub; Sg.vss = vss; Sg.ws = a.in[16]; Sg.bs = a.in[17]; Sg.gn = a.in[15]; Sg.TS = M; Sg.ldu = 2048;
        sgu_phase(lds, Sg, bid, G, tid, wave);
    }
    SEAM(2);
    if (IN(3)) { FRESH_TID;
        p0_weights(a.wj, 8, 9, (LAS float*)lds + wave * 4096, gw, NGW, lane);
        block_sync();
        pg8::Gemm g{Ub, PabT, M, 1024, 2048, 2048, 2048, yaT, M, 16}; pg8::StaticOrder S; S.init(M, 1024, G, bid);
        pg8::EpiMerge E{Gb, mrg};
        pg8::gemm_phase<pg8::EpiMerge, pg8::StaticOrder, true, true>(lds, g, S, E, tid);
    }
    SEAM(3);
    if (IN(4)) { FRESH_TID;
        pg8::Gemm g{mrg, WoT, M, 1024, 1024, 1024, 1024}; pg8::StaticOrder S; S.init(M, 1024, G, bid);
        pg8::EpiResid<true> E{x, nullptr, nullptr, X1b, xss};
        pg8::gemm_phase<pg8::EpiResid<true>, pg8::StaticOrder, true, true>(lds, g, S, E, tid);
    }
    SEAM(4);
    if (IN(5)) { FRESH_TID;
        pg8::Gemm g{X1b, WupT, M, 2 * FH, 1024, 1024, 1024}; pg8::StaticOrder S; S.init(68 * 256, 2 * FH, G, bid);
        pg8::EpiUpAct E{GPb, (LAS float*)(lds + 131072), xss, a.in[23], a.in[24]};
        pg8::gemm_phase<pg8::EpiUpAct, pg8::StaticOrder, true, true>(lds, g, S, E, tid);
    }
    SEAM(5);
    if (IN(6)) { FRESH_TID;
        pg8::Gemm g{GPb, WdnT, M, 1024, FH, FH, FH}; pg8::StaticOrder S; S.init(M, 1024, G, bid);
        if (G == 256) { pg8::EpiResidNorm E{X1b, a.out, x2ss, a.in[26], (unsigned*)(ws + WS_PCNT)};
            pg8::gemm_phase<pg8::EpiResidNorm, pg8::StaticOrder, true, true>(lds, g, S, E, tid); }
        else { pg8::EpiResid<false> E{nullptr, X1b, nullptr, X1b, x2ss};
            pg8::gemm_phase<pg8::EpiResid<false>, pg8::StaticOrder, true, true>(lds, g, S, E, tid); }
    }
    if (G != 256) { SEAM(6);
        if (IN(7)) { FRESH_TID; final_norm(X1b, x2ss, a.in[26], a.out, M, gw, NGW, lane); } }
    STAMP(7); STAMP(8);
#ifdef MK_PROBE
#ifndef MK_PROBE_A
#define MK_PROBE_A MK_PROBE
#define MK_PROBE_B (MK_PROBE + 1)
#endif
    if (threadIdx.x == 0) { volatile LAS unsigned long long* ts = (volatile LAS unsigned long long*)(lds + LDS_BYTES - 128);
        const unsigned long long dt = 2ull * (ts[MK_PROBE_B] - ts[MK_PROBE_A]), t0 = __builtin_amdgcn_s_memrealtime();
        while (__builtin_amdgcn_s_memrealtime() - t0 < dt) __builtin_amdgcn_s_sleep(8); }
    block_sync();
#endif
#undef IN
#undef SEAM
}
}

#ifndef MK_CUTS
#define MK_CUTS 0
#endif
extern "C" void kernel_launch(void* const* d_in, const int* in_sizes, int n_in, void* d_out, int out_size, void* d_ws, size_t ws_size, hipStream_t stream) {
    static int grid = 0;
    if (grid == 0) {
        int dev = 0, cus = 0, per_cu = 0;
        hipGetDevice(&dev);
        hipDeviceGetAttribute(&cus, hipDeviceAttributeMultiprocessorCount, dev);
        hipFuncSetAttribute((const void*)mega_fwd, hipFuncAttributeMaxDynamicSharedMemorySize, LDS_BYTES);
        hipOccupancyMaxActiveBlocksPerMultiprocessor(&per_cu, (const void*)mega_fwd, 512, LDS_BYTES);
        if (per_cu < 1) { fprintf(stderr, "kernel_launch: occupancy query says %d blocks per CU\n", per_cu); per_cu = 1; }
        grid = cus * 1;
        (void)hipGetLastError();
    }
    hipMemsetAsync((char*)d_ws + WS_BAR, 0, 32 * 1024, stream);
    MegaArgs a{};
    for (int i = 0; i < 27; ++i) a.in[i] = (const float*)d_in[i];
    a.out = (float*)d_out; a.ws = (unsigned char*)d_ws;
    { unsigned char* ws = (unsigned char*)d_ws;
      bf16* WtA = (bf16*)(ws + WS_WTA); bf16* WtB = (bf16*)(ws + WS_WTB); bf16* PabT = (bf16*)(ws + WS_PAB); bf16* WoT = (bf16*)(ws + WS_WO); bf16* WupT = (bf16*)(ws + WS_WUP); bf16* WdnT = (bf16*)(ws + WS_WDN);
    a.wj.j[0] = WJob{(const float*)d_in[2], nullptr, WtA, 1024, INW, 0, 3072, 1024, 0, 0, 0};
    a.wj.j[1] = WJob{(const float*)d_in[2], nullptr, WtA, 1024, INW, 4096, 1024, 1024, 3072, 0, 0};
    a.wj.j[2] = WJob{(const float*)d_in[2], nullptr, WtB, 1024, INW, 3072, 1024, 1024, 0, 0, 0};
    a.wj.j[3] = WJob{(const float*)d_in[2], nullptr, WtB, 1024, INW, 5120, 2048, 1024, 1024, 0, 0};
    a.wj.j[4] = WJob{(const float*)d_in[18], nullptr, PabT, 1024, 1024, 0, 1024, 2048, 0, 0, 0};
    a.wj.j[5] = WJob{(const float*)d_in[19], nullptr, PabT, 1024, 1024, 0, 1024, 2048, 0, 1024, 0};
    a.wj.j[6] = WJob{(const float*)d_in[20], nullptr, WoT, 1024, 1024, 0, 1024, 1024, 0, 0, 0};
        a.wj.j[7] = WJob{(const float*)d_in[25], nullptr, WdnT, FH, 1024, 0, 1024, FH, 0, 0, 0};
    a.wj.j[8] = WJob{(const float*)d_in[22], (const float*)d_in[21], WupT, 1024, 2 * FH, 0, 2 * FH, 1024, 0, 0, 1};

    }
#if MK_CUTS
    for (int p = 0; p < NPH; ++p) { a.ph_lo = p; a.ph_hi = p + 1; hipLaunchKernelGGL(mega_fwd, dim3(grid), dim3(512), LDS_BYTES, stream, a); }
#else
    a.ph_lo = 0; a.ph_hi = NPH;
    void* args[] = {&a};
    hipError_t e = hipLaunchCooperativeKernel((const void*)mega_fwd, dim3(grid), dim3(512), args, LDS_BYTES, stream);
    if (e != hipSuccess) fprintf(stderr, "cooperative launch failed: %s (grid %d)\n", hipGetErrorString(e), grid);
#endif
}
```

```cpp
#include <hip/hip_runtime.h>
#include <hip/hip_cooperative_groups.h>
#include <math.h>
#include <stdint.h>
#include <cstdio>
namespace cg = cooperative_groups;
namespace pg8 {
#define PG8_LAS __attribute__((address_space(3)))
typedef unsigned short bf16_t;
typedef short bf16x8 __attribute__((ext_vector_type(8)));
typedef float f32x4 __attribute__((ext_vector_type(4)));
typedef unsigned u32x4 __attribute__((ext_vector_type(4)));
typedef short s16x4 __attribute__((ext_vector_type(4)));
constexpr int BM = 256, BK = 64, HALF = 128, HTB = HALF * BK * 2  , STAGE_BYTES = 8 * HTB, NXCD = 8, WGM = 8;

__host__ __device__ __forceinline__ int lds_byte(int r, int c) { const int st = (r >> 4) * 2 + (c >> 5), rr = r & 15, cc = c & 31, ob = rr * 64 + cc * 2; return st * 1024 + (ob ^ (((ob >> 9) & 1) << 5)); }
__host__ __device__ __forceinline__ void stage_rc(int b, int& R, int& C) { const int st = b / 1024, sb = b % 1024, swz = sb ^ (((sb >> 9) & 1) << 5); R = (st >> 1) * 16 + swz / 64; C = (st & 1) * 32 + (swz % 64) / 2; }
__host__ __device__ __forceinline__ int perm32(int rho) { const int n = rho >> 4, i = rho & 15; return 8 * (i >> 2) + 4 * n + (i & 3); }

struct Unit { int pm, pn; };
__host__ __device__ __forceinline__ int ovl_row(int pm) { const int seq = pm / 17, i = pm % 17; int s = 254 * i - 1; s = s < 0 ? 0 : (s > 3840 ? 3840 : s); return seq * 4096 + s; }
struct Gemm { const bf16_t* A; const bf16_t* Bt; int M, N, K, lda, ldb; const bf16_t* At; int ldt, ntr; };

struct StaticOrder {
    int nM, nN, nwg, G, c;
    __host__ __device__ __forceinline__ void init(int M, int N, int G_, int c_) { nM = M / BM; nN = N / BM; nwg = nM * nN; G = G_; c = c_; }
    __host__ __device__ __forceinline__ bool next(int i, Unit& u) const {
        const long L = (long)i * G + c; if (L >= nwg) return false;
        int wgid = (int)L; { const int q = nwg / NXCD, r = nwg % NXCD, xcd = wgid % NXCD, off = wgid / NXCD; wgid = (xcd < r ? xcd * (q + 1) : r * (q + 1) + (xcd - r) * q) + off; }
        const int nig = WGM * nN, gid = wgid / nig, fm = gid * WGM, gsz = (nM - fm) < WGM ? (nM - fm) : WGM;
        u.pm = fm + ((wgid % nig) % gsz); u.pn = (wgid % nig) / gsz; return true;
    }
    __device__ __forceinline__ void a_ready(const Unit&) const {}
    __device__ __forceinline__ void done(const Unit&) const {}
};

__device__ __forceinline__ unsigned cvt_pk_bf16(float lo, float hi) { unsigned r; asm volatile("v_cvt_pk_bf16_f32 %0, %1, %2" : "=v"(r) : "v"(lo), "v"(hi)); return r; }
typedef float f32x2 __attribute__((ext_vector_type(2)));
__device__ __forceinline__ f32x2 gelu_pk(f32x2 v) {
    const f32x2 av = __builtin_elementwise_abs(v), d = av * 0.2316418882f + 1.0f;
    f32x2 t; t.x = __builtin_amdgcn_rcpf(d.x); t.y = __builtin_amdgcn_rcpf(d.y);
    f32x2 q = t * 0.5307027145f + (-0.7265760135f); q = q * t + 0.7107068705f; q = q * t + (-0.142248368f); q = q * t + 0.127414796f; q = q * t;
    const f32x2 s = (v * v) * (-0.72134752044f);
    f32x2 e; e.x = __builtin_amdgcn_exp2f(s.x); e.y = __builtin_amdgcn_exp2f(s.y);
    const f32x2 m = v * (q * e), r = v - m;
    f32x2 o; o.x = v.x < 0.f ? m.x : r.x; o.y = v.y < 0.f ? m.y : r.y; return o;
}

template <int ACT  > struct EpiBf16 {
    static constexpr bool PERM = true, AFTER_DRAIN = false, MID = false, OVL = false, ATR = false; static_assert(ACT == 0 || ACT == 1, "EpiBf16: ACT is 0 (none) or 1 (gelu_pk)");
    bf16_t* O; int ldc; const float* bias; int split_cols; size_t split_stride; float scale0;
    __device__ __forceinline__ void operator()(const f32x4 (&acc)[2][2][4][2], const Unit& u, int wr, int wc, int fr, int fq) const {
        const int row0 = u.pm * BM + wr * 64 + fr; int colt = u.pn * BM; bf16_t* base = O;
        float sc = 1.f; if (split_cols) { const int t = colt / split_cols; base += (size_t)t * split_stride; colt -= t * split_cols; if (t == 0) sc = scale0; }
        const int col0 = colt + wc * 32 + 8 * fq, bcol0 = u.pn * BM + wc * 32 + 8 * fq;
        f32x4 bv[2][2];
#pragma unroll
        for (int bj = 0; bj < 2; ++bj)
#pragma unroll
            for (int n = 0; n < 2; ++n) bv[bj][n] = bias ? *(const f32x4*)(bias + bcol0 + bj * HALF + 4 * n) : (f32x4){0.f, 0.f, 0.f, 0.f};
#pragma unroll
        for (int ai = 0; ai < 2; ++ai)
#pragma unroll
            for (int m = 0; m < 4; ++m) { bf16_t* rowp = base + (size_t)(row0 + ai * HALF + m * 16) * ldc + col0;
#pragma unroll
                for (int bj = 0; bj < 2; ++bj) { f32x4 v0 = acc[ai][bj][m][0] + bv[bj][0], v1 = acc[ai][bj][m][1] + bv[bj][1];
                    if (ACT == 1) { f32x2 a = gelu_pk((f32x2){v0[0], v0[1]}), b = gelu_pk((f32x2){v0[2], v0[3]}), c = gelu_pk((f32x2){v1[0], v1[1]}), d = gelu_pk((f32x2){v1[2], v1[3]});
                        v0 = (f32x4){a.x, a.y, b.x, b.y}; v1 = (f32x4){c.x, c.y, d.x, d.y}; }
                    v0 = v0 * sc; v1 = v1 * sc; u32x4 w; w.x = cvt_pk_bf16(v0[0], v0[1]); w.y = cvt_pk_bf16(v0[2], v0[3]); w.z = cvt_pk_bf16(v1[0], v1[1]); w.w = cvt_pk_bf16(v1[2], v1[3]);
                    *(u32x4*)(rowp + bj * HALF) = w; } }
    }
};

struct EpiF32 {
    static constexpr bool PERM = false, AFTER_DRAIN = false, MID = false, OVL = false, ATR = false;
    float* C; int ldc; const float* bias;
    __device__ __forceinline__ void operator()(const f32x4 (&acc)[2][2][4][2], const Unit& u, int wr, int wc, int fr, int fq) const {
        const int row0 = u.pm * BM + wr * 64 + fr, col0 = u.pn * BM + wc * 32 + 4 * fq;
        f32x4 bv[2][2];
#pragma unroll
        for (int bj = 0; bj < 2; ++bj)
#pragma unroll
            for (int n = 0; n < 2; ++n) bv[bj][n] = bias ? *(const f32x4*)(bias + col0 + bj * HALF + n * 16) : (f32x4){0.f, 0.f, 0.f, 0.f};
#pragma unroll
        for (int ai = 0; ai < 2; ++ai)
#pragma unroll
            for (int m = 0; m < 4; ++m) { float* rowp = C + (size_t)(row0 + ai * HALF + m * 16) * ldc + col0;
#pragma unroll
                for (int bj = 0; bj < 2; ++bj)
#pragma unroll
                    for (int n = 0; n < 2; ++n) *(f32x4*)(rowp + bj * HALF + n * 16) = acc[ai][bj][m][n] + bv[bj][n]; }
    }
};

template <class Epi, class Sched, bool ALIGN_EPI = false, bool SP2 = false>
__device__ __forceinline__ void gemm_phase(PG8_LAS unsigned char* lds, const Gemm g, const Sched& S, const Epi& E, const int tid) {
    const int wid = __builtin_amdgcn_readfirstlane(tid >> 6), lane = tid & 63, wr = wid >> 2, wc = wid & 3, fr = lane & 15, fq = lane >> 4;
    const int K = g.K, nt = K / BK;
    unsigned voffA[2], voffB[2];
#pragma unroll
    for (int i = 0; i < 2; ++i) { int R, C; stage_rc(tid * 16 + i * 8192, R, C); const int Rb = Epi::PERM ? ((R & ~31) + perm32(R & 31)) : R;
        voffA[i] = (unsigned)(R * g.lda + C) * 2u; voffB[i] = (unsigned)(Rb * g.ldb + C) * 2u; }
    unsigned voffT[2] = {0u, 0u}; unsigned trb = 0u, trx = 0u; const int ntr = Epi::ATR ? g.ntr : 0; const size_t kstepT = (size_t)BK * g.ldt * 2;
    if constexpr (Epi::ATR) {
#pragma unroll
        for (int i = 0; i < 2; ++i) { const int r = 4 * (i * 8 + wid) + (lane >> 4), pch = lane & 15, ch = pch ^ (((r & 3) << 2) | ((r >> 2) & 3)); voffT[i] = (unsigned)(r * g.ldt + 8 * ch) * 2u; }
        const int q = fr >> 2, pp = fr & 3, f0 = (q << 2) | ((2 * fq) & 3);
        trb = (unsigned)(2048 * fq + 256 * q + 8 * (pp & 1)); trx = 16u * (unsigned)(((8 * wr) | (pp >> 1)) ^ f0);
    }
    const size_t kstep = (size_t)(BK * 2);
    const size_t hstepA = (size_t)HALF * g.lda * 2, hstepB = (size_t)HALF * g.ldb * 2;
    const size_t tstepA = 2 * hstepA, tstepB = 2 * hstepB;
    const unsigned ldsw = (unsigned)wid * 1024u;
    const int aoff = lds_byte(wr * 64 + fr, fq * 8), boff = lds_byte(wc * 32 + fr, fq * 8);
#define PG8_SA(b, h) (((b) * 2 + (h)) * HTB)
#define PG8_SB(b, h) ((4 + (b) * 2 + (h)) * HTB)
#define PG8_STAGE(bufoff, gbase, voff) do { _Pragma("unroll") for (int _i = 0; _i < 2; ++_i) \
        __builtin_amdgcn_global_load_lds((const unsigned*)((const char*)(gbase) + (voff)[_i]), (PG8_LAS unsigned*)(lds + (bufoff) + ldsw + _i * 8192), 16, 0, 0); } while (0)
#define PG8_LDA(dst, b, h) do { _Pragma("unroll") for (int m = 0; m < 4; ++m) _Pragma("unroll") for (int k = 0; k < 2; ++k) dst[m][k] = *(const PG8_LAS bf16x8*)(lds + PG8_SA(b, h) + aoff + m * 2048 + k * 1024); } while (0)
#define PG8_STAGE_A(bufoff, nbase, tbase, tile, half) do { if (Epi::ATR && (tile) < ntr) PG8_STAGE(bufoff, (tbase) + (size_t)(tile) * kstepT + (half) * 256, voffT); \
        else PG8_STAGE(bufoff, (nbase) + (size_t)((tile) - ntr) * kstep + (half) * hstepA, voffA); } while (0)
#define PG8_LDA_TR(dst, b, h) do { _Pragma("unroll") for (int m = 0; m < 4; ++m) _Pragma("unroll") for (int k = 0; k < 2; ++k) { \
        const s16x4 lo_ = __builtin_amdgcn_ds_read_tr16_b64_v4i16((PG8_LAS s16x4*)(lds + PG8_SA(b, h) + trb + (trx ^ (unsigned)(32 * m)) + 8192 * k)); \
        const s16x4 hi_ = __builtin_amdgcn_ds_read_tr16_b64_v4i16((PG8_LAS s16x4*)(lds + PG8_SA(b, h) + trb + (trx ^ (unsigned)(32 * m + 16)) + 8192 * k + 1024)); \
        dst[m][k] = __builtin_shufflevector(lo_, hi_, 0, 1, 2, 3, 4, 5, 6, 7); } } while (0)
#define PG8_LDA_X(dst, b, h, tile) do { if (Epi::ATR && (tile) < ntr) PG8_LDA_TR(dst, b, h); else PG8_LDA(dst, b, h); } while (0)
#define PG8_LDB(dst, b, h) do { _Pragma("unroll") for (int n = 0; n < 2; ++n) _Pragma("unroll") for (int k = 0; k < 2; ++k) dst[n][k] = *(const PG8_LAS bf16x8*)(lds + PG8_SB(b, h) + boff + n * 2048 + k * 1024); } while (0)
#define PG8_MMA(ai, bj, At, Bt) do { __builtin_amdgcn_s_setprio(1); _Pragma("unroll") for (int m = 0; m < 4; ++m) _Pragma("unroll") for (int n = 0; n < 2; ++n) _Pragma("unroll") for (int k = 0; k < 2; ++k) \
        acc[ai][bj][m][n] = __builtin_amdgcn_mfma_f32_16x16x32_bf16(Bt[n][k], At[m][k], acc[ai][bj][m][n], 0, 0, 0); __builtin_amdgcn_s_setprio(0); } while (0)
#define PG8_WAIT_V(n) asm volatile("s_waitcnt vmcnt(" #n ")" ::: "memory")
#define PG8_WAIT_L(n) asm volatile("s_waitcnt lgkmcnt(" #n ")" ::: "memory")
#define PG8_BAR __builtin_amdgcn_s_barrier()
#define PG8_SCHED __builtin_amdgcn_sched_barrier(0)
    Unit cur, nxt; int ui = 0;
    if (!S.next(0, cur)) return;
    f32x4 acc[2][2][4][2];
#pragma unroll
    for (int a = 0; a < 2; ++a)
#pragma unroll
        for (int b = 0; b < 2; ++b)
#pragma unroll
            for (int m = 0; m < 4; ++m)
#pragma unroll
                for (int n = 0; n < 2; ++n) acc[a][b][m][n] = (f32x4){0.f, 0.f, 0.f, 0.f};
    bf16x8 At[4][2], B0[2][2], B1[2][2];
    const char* cA = (const char*)g.A + (size_t)(Epi::OVL ? ovl_row(cur.pm) : cur.pm * BM) * (tstepA / BM); const char* cB = (const char*)g.Bt + (size_t)cur.pn * tstepB;
    const char* cT = Epi::ATR ? (const char*)g.At + (size_t)cur.pm * BM * 2 : nullptr;
    S.a_ready(cur);
    if constexpr (SP2) {
        PG8_STAGE(PG8_SB(0, 0), cB, voffB); PG8_STAGE(PG8_SB(0, 1), cB + hstepB, voffB); PG8_STAGE_A(PG8_SA(0, 0), cA, cT, 0, 0); PG8_STAGE_A(PG8_SA(0, 1), cA, cT, 0, 1);
        if (wr == 1) PG8_BAR;
        PG8_WAIT_V(2); PG8_BAR;
        PG8_STAGE(PG8_SB(1, 0), cB + kstep, voffB); PG8_STAGE_A(PG8_SA(1, 0), cA, cT, 1, 0); PG8_STAGE(PG8_SB(1, 1), cB + hstepB + kstep, voffB);
        PG8_WAIT_V(6); PG8_BAR;
    } else {
        PG8_STAGE(PG8_SB(0, 0), cB, voffB); PG8_STAGE(PG8_SA(0, 0), cA, voffA); PG8_STAGE(PG8_SB(0, 1), cB + hstepB, voffB); PG8_STAGE(PG8_SA(0, 1), cA + hstepA, voffA);
        if (wr == 1) PG8_BAR;
        PG8_WAIT_V(4); PG8_BAR;
        PG8_STAGE(PG8_SB(1, 0), cB + kstep, voffB); PG8_STAGE(PG8_SA(1, 0), cA + kstep, voffA); PG8_STAGE(PG8_SB(1, 1), cB + hstepB + kstep, voffB);
        PG8_WAIT_V(6); PG8_BAR;
    }
    for (;;) {
        const bool has_next = S.next(ui + 1, nxt);
        const char* nA = has_next ? (const char*)g.A + (size_t)(Epi::OVL ? ovl_row(nxt.pm) : nxt.pm * BM) * (tstepA / BM) : cA; const char* nB = has_next ? (const char*)g.Bt + (size_t)nxt.pn * tstepB : cB;
        const char* nT = (Epi::ATR && has_next) ? (const char*)g.At + (size_t)nxt.pm * BM * 2 : cT;
        for (int t = 0; t < nt; t += 2) {
            const bool last = (t == nt - 2);
            const char* a1 = cA + (size_t)(t + 1) * kstep;
            const char* a2 = last ? nA : cA + (size_t)(t + 2) * kstep; const char* b2 = last ? nB : cB + (size_t)(t + 2) * kstep;
            const char* a3 = a2 + kstep; const char* b3 = b2 + kstep;
            if (last && has_next) S.a_ready(nxt);
            if constexpr (Epi::MID) { if (t == (nt >> 1)) E.mid(acc, cur, wr, wc, fr, fq); }
            if constexpr (SP2) {
            PG8_LDB(B0, 0, 0); PG8_LDB(B1, 0, 1); PG8_SCHED; PG8_LDA_X(At, 0, 0, t); PG8_STAGE_A(PG8_SA(1, 1), cA, cT, t + 1, 1);
            PG8_WAIT_V(8); PG8_WAIT_L(0); PG8_BAR; PG8_MMA(0, 0, At, B0); PG8_MMA(0, 1, At, B1); PG8_BAR; PG8_SCHED;
            PG8_LDA_X(At, 0, 1, t); PG8_STAGE(PG8_SB(0, 0), b2, voffB); PG8_STAGE(PG8_SB(0, 1), b2 + hstepB, voffB); PG8_STAGE_A(PG8_SA(0, 0), last ? nA : cA, last ? nT : cT, last ? 0 : t + 2, 0);
            PG8_WAIT_V(8); PG8_WAIT_L(0); PG8_BAR; PG8_MMA(1, 0, At, B0); PG8_MMA(1, 1, At, B1); PG8_BAR; PG8_SCHED;
            PG8_LDB(B0, 1, 0); PG8_LDB(B1, 1, 1); PG8_SCHED; PG8_LDA_X(At, 1, 0, t + 1); PG8_STAGE_A(PG8_SA(0, 1), last ? nA : cA, last ? nT : cT, last ? 0 : t + 2, 1);
            PG8_WAIT_V(8); PG8_WAIT_L(0); PG8_BAR; PG8_MMA(0, 0, At, B0); PG8_MMA(0, 1, At, B1); PG8_BAR; PG8_SCHED;
            PG8_LDA_X(At, 1, 1, t + 1); PG8_STAGE(PG8_SB(1, 0), b3, voffB); PG8_STAGE(PG8_SB(1, 1), b3 + hstepB, voffB); PG8_STAGE_A(PG8_SA(1, 0), last ? nA : cA, last ? nT : cT, last ? 1 : t + 3, 0);
            PG8_WAIT_V(8); PG8_WAIT_L(0); PG8_BAR; PG8_MMA(1, 0, At, B0); PG8_MMA(1, 1, At, B1); PG8_BAR; PG8_SCHED;
            } else {
            PG8_LDB(B0, 0, 0); PG8_SCHED; PG8_LDA(At, 0, 0); PG8_STAGE(PG8_SA(1, 1), a1 + hstepA, voffA);
            PG8_WAIT_L(8); PG8_BAR; PG8_WAIT_L(0); PG8_MMA(0, 0, At, B0); PG8_BAR; PG8_SCHED;
            PG8_LDB(B1, 0, 1); PG8_STAGE(PG8_SB(0, 0), b2, voffB);
            PG8_BAR; PG8_WAIT_L(0); PG8_MMA(0, 1, At, B1); PG8_BAR;
            PG8_LDA(At, 0, 1); PG8_STAGE(PG8_SA(0, 0), a2, voffA);
            PG8_BAR; PG8_WAIT_L(0); PG8_MMA(1, 0, At, B0); PG8_BAR; PG8_SCHED;
            PG8_STAGE(PG8_SB(0, 1), b2 + hstepB, voffB);
            PG8_WAIT_V(6); PG8_BAR; PG8_MMA(1, 1, At, B1); PG8_BAR;
            PG8_LDB(B0, 1, 0); PG8_SCHED; PG8_LDA(At, 1, 0); PG8_STAGE(PG8_SA(0, 1), a2 + hstepA, voffA);
            PG8_WAIT_L(8); PG8_BAR; PG8_WAIT_L(0); PG8_MMA(0, 0, At, B0); PG8_BAR; PG8_SCHED;
            PG8_LDB(B1, 1, 1); PG8_STAGE(PG8_SB(1, 0), b3, voffB);
            PG8_BAR; PG8_WAIT_L(0); PG8_MMA(0, 1, At, B1); PG8_BAR;
            PG8_LDA(At, 1, 1); PG8_STAGE(PG8_SA(1, 0), a3, voffA);
            PG8_BAR; PG8_WAIT_L(0); PG8_MMA(1, 0, At, B0); PG8_BAR; PG8_SCHED;
            PG8_STAGE(PG8_SB(1, 1), b3 + hstepB, voffB);
            PG8_WAIT_V(6); PG8_BAR; PG8_MMA(1, 1, At, B1); PG8_BAR;
            }
        }
        if constexpr (ALIGN_EPI) { if (wr == 0) PG8_BAR; }
        if constexpr (!Epi::AFTER_DRAIN) { E(acc, cur, wr, wc, fr, fq); S.done(cur); }
        if (!has_next) break;
#pragma unroll
        for (int a = 0; a < 2; ++a)
#pragma unroll
            for (int b = 0; b < 2; ++b)
#pragma unroll
                for (int m = 0; m < 4; ++m)
#pragma unroll
                    for (int n = 0; n < 2; ++n) acc[a][b][m][n] = (f32x4){0.f, 0.f, 0.f, 0.f};
        cur = nxt; cA = nA; cB = nB; cT = nT; ++ui;
        if constexpr (ALIGN_EPI) { if (wr == 1) PG8_BAR; }
    }
    PG8_WAIT_V(0);
    if constexpr (!ALIGN_EPI) { if (wr == 0) PG8_BAR; }
    PG8_BAR;
    if constexpr (Epi::AFTER_DRAIN) { E.fused(acc, cur, wr, wc, fr, fq, lds, wid, lane); S.done(cur); }
#undef PG8_SA
#undef PG8_SB
#undef PG8_STAGE
#undef PG8_LDA
#undef PG8_LDB
#undef PG8_STAGE_A
#undef PG8_LDA_TR
#undef PG8_LDA_X
#undef PG8_MMA
#undef PG8_WAIT_V
#undef PG8_WAIT_L
#undef PG8_BAR
#undef PG8_SCHED
}
}
namespace {
constexpr int D = 1024, NB = 4, L = 4096, HW = 1024, SW = 1024, INW = 7168, FH = 2816, FHID = 64, FEMB = 33;
constexpr float EPS = 1e-6f;
typedef unsigned short bf16;
__device__ __forceinline__ unsigned f2bf(float f) { unsigned u = __builtin_bit_cast(unsigned, f); return (u + 0x7fffu + ((u >> 16) & 1u)) >> 16; }
__device__ __forceinline__ void block_sync() { __builtin_amdgcn_fence(__ATOMIC_RELEASE, "workgroup"); __builtin_amdgcn_s_barrier(); __builtin_amdgcn_fence(__ATOMIC_ACQUIRE, "workgroup"); }
}
namespace {
#define HD __device__ __forceinline__
#define FFT_OPAQUE(w) asm volatile("" : "+v"((w).x), "+v"((w).y))
#ifndef HD
#define HD inline
#endif
typedef float cfv __attribute__((ext_vector_type(2)));
struct cf { float x, y; };
HD cf cmk(float x, float y) { cf r; r.x = x; r.y = y; return r; }
template <class P> HD cf ldz(P Z, int i) { const cfv t = Z[i]; return cmk(t.x, t.y); }
template <class P> HD void stz(P Z, int i, cf v) { Z[i] = (cfv){v.x, v.y}; }
HD cf cadd(cf a, cf b) { return cmk(a.x + b.x, a.y + b.y); }
HD cf csub(cf a, cf b) { return cmk(a.x - b.x, a.y - b.y); }
HD cf cmul(cf a, cf b) { return cmk(a.x * b.x - a.y * b.y, a.x * b.y + a.y * b.x); }
HD cf cconj(cf a) { return cmk(a.x, -a.y); }
template <bool INV> HD cf mulmi(cf a) { return INV ? cmk(-a.y, a.x) : cmk(a.y, -a.x); }
template <bool INV> HD cf twc(float c, float s) { return INV ? cmk(c, s) : cmk(c, -s); }
HD int fpad(int p) { return p + (p >> 4); }
constexpr int FSUB = 4352;

template <bool INV> HD void dft4(cf& a, cf& b, cf& c, cf& d) {
    const cf t0 = cadd(a, c), t1 = csub(a, c), t2 = cadd(b, d), t3 = mulmi<INV>(csub(b, d));
    a = cadd(t0, t2); b = cadd(t1, t3); c = csub(t0, t2); d = csub(t1, t3);
}
template <bool INV> HD void dft16(cf (&v)[16]) {
    constexpr float C1 = 0.92387953251128674f, S1 = 0.38268343236508977f, R = 0.70710678118654752f;
#pragma unroll
    for (int n0 = 0; n0 < 4; ++n0) dft4<INV>(v[n0], v[n0 + 4], v[n0 + 8], v[n0 + 12]);
    v[1 + 4 * 1] = cmul(v[1 + 4 * 1], twc<INV>(C1, S1));
    v[1 + 4 * 2] = cmul(v[1 + 4 * 2], twc<INV>(R, R));
    v[1 + 4 * 3] = cmul(v[1 + 4 * 3], twc<INV>(S1, C1));
    v[2 + 4 * 1] = cmul(v[2 + 4 * 1], twc<INV>(R, R));
    v[2 + 4 * 2] = mulmi<INV>(v[2 + 4 * 2]);
    v[2 + 4 * 3] = cmul(v[2 + 4 * 3], twc<INV>(-R, R));
    v[3 + 4 * 1] = cmul(v[3 + 4 * 1], twc<INV>(S1, C1));
    v[3 + 4 * 2] = cmul(v[3 + 4 * 2], twc<INV>(-R, R));
    v[3 + 4 * 3] = cmul(v[3 + 4 * 3], twc<INV>(-C1, -S1));
#pragma unroll
    for (int k0 = 0; k0 < 4; ++k0) dft4<INV>(v[4 * k0], v[4 * k0 + 1], v[4 * k0 + 2], v[4 * k0 + 3]);
    cf t;
    t = v[1]; v[1] = v[4]; v[4] = t;   t = v[2]; v[2] = v[8]; v[8] = t;   t = v[3]; v[3] = v[12]; v[12] = t;
    t = v[6]; v[6] = v[9]; v[9] = t;   t = v[7]; v[7] = v[13]; v[13] = t; t = v[11]; v[11] = v[14]; v[14] = t;
}
#ifndef FFT_OPAQUE
#define FFT_OPAQUE(w)
#endif
HD void twiddle16(cf (&v)[16], cf w) {
    FFT_OPAQUE(w);
    cf p = w;
#pragma unroll
    for (int k = 1; k < 16; ++k) { v[k] = cmul(v[k], p); if (k < 15) p = cmul(p, w); }
}
template <class P> HD void fwd_pass1(P Z, int t, cf w1) {
    cf v[16]; const int b = t + (t >> 4);
#pragma unroll
    for (int j = 0; j < 16; ++j) v[j] = ldz(Z, b + 272 * j);
    dft16<false>(v); twiddle16(v, w1);
#pragma unroll
    for (int j = 0; j < 16; ++j) stz(Z, b + 272 * j, v[j]);
}
template <class P> HD void fwd_pass2(P Z, int t, cf w2) {
    const int b = 272 * (t >> 4) + (t & 15);
    cf v[16];
#pragma unroll
    for (int j = 0; j < 16; ++j) v[j] = ldz(Z, b + 17 * j);
    dft16<false>(v); twiddle16(v, w2);
#pragma unroll
    for (int j = 0; j < 16; ++j) stz(Z, b + 17 * j, v[j]);
}
template <class P> HD void fwd_pass3_load(P Z, int t, cf (&v)[16]) {
#pragma unroll
    for (int j = 0; j < 16; ++j) v[j] = ldz(Z, 17 * t + j);
    dft16<false>(v);
}
template <class P> HD void inv_pass1_store(P Z, int t, cf (&v)[16]) {
    dft16<true>(v);
#pragma unroll
    for (int j = 0; j < 16; ++j) stz(Z, 17 * t + j, v[j]);
}
template <class P> HD void inv_pass2(P Z, int t, cf w2) {
    const int b = 272 * (t >> 4) + (t & 15);
    cf v[16];
#pragma unroll
    for (int j = 0; j < 16; ++j) v[j] = ldz(Z, b + 17 * j);
    twiddle16(v, cconj(w2)); dft16<true>(v);
#pragma unroll
    for (int j = 0; j < 16; ++j) stz(Z, b + 17 * j, v[j]);
}
template <class P> HD void inv_pass3(P Z, int t, cf w1) {
    cf v[16]; const int b = t + (t >> 4);
#pragma unroll
    for (int j = 0; j < 16; ++j) v[j] = ldz(Z, b + 272 * j);
    twiddle16(v, cconj(w1)); dft16<true>(v);
#pragma unroll
    for (int j = 0; j < 16; ++j) stz(Z, b + 272 * j, v[j]);
}
#define LAS __attribute__((address_space(3)))
typedef LAS cfv* lcf;
struct HyArgs {
    const bf16* hyT;
    bf16* yaT;
    const float* fsum;
    const float* fdif;
    const float* cw;
    const float* cb;
    const float* skip;
    const cfv* T;
    int TS, npairs, off00, off01, off10, off11;
};
__device__ __forceinline__ float bf2f(unsigned h) { return __builtin_bit_cast(float, h << 16); }
constexpr int HOFF_SX1 = 2 * FSUB * 8, HOFF_SV = HOFF_SX1 + 16384, HOFF_SX0 = HOFF_SV + 16384, HOFF_SF = HOFF_SX0 + 16384, HY_LDS_END = HOFF_SF + 32768;
#define HBAR() do { asm volatile("s_waitcnt lgkmcnt(0)" ::: "memory"); __builtin_amdgcn_s_barrier(); asm volatile("" ::: "memory"); } while (0)
#define HDMA_WAIT() asm volatile("s_waitcnt vmcnt(0)" ::: "memory")
#define WAVE_FENCE() asm volatile("s_waitcnt lgkmcnt(0)" ::: "memory")
__device__ __forceinline__ void hdma16(const void* gp, LAS unsigned char* wave_dst) { __builtin_amdgcn_global_load_lds((const unsigned*)gp, (LAS unsigned*)wave_dst, 16, 0, 0); }
__device__ __forceinline__ void conv8s(const LAS unsigned char* S, int tid, float w0, float w1, float w2, float b, float (&o)[8]) {
    const pg8::u32x4 q = *(const LAS pg8::u32x4*)(S + 16 * tid);
    const unsigned lft = *(const LAS unsigned short*)(S + (tid > 0 ? 16 * tid - 2 : 0)), rgt = *(const LAS unsigned short*)(S + (tid < 511 ? 16 * tid + 16 : 8190));
    float x[10];
    x[0] = tid > 0 ? bf2f(lft) : 0.f; x[9] = tid < 511 ? bf2f(rgt) : 0.f;
    x[1] = bf2f(q.x & 0xffffu); x[2] = bf2f(q.x >> 16); x[3] = bf2f(q.y & 0xffffu); x[4] = bf2f(q.y >> 16);
    x[5] = bf2f(q.z & 0xffffu); x[6] = bf2f(q.z >> 16); x[7] = bf2f(q.w & 0xffffu); x[8] = bf2f(q.w >> 16);
#pragma unroll
    for (int i = 0; i < 8; ++i) o[i] = b + w0 * x[i] + w1 * x[i + 1] + w2 * x[i + 2];
}
__device__ __forceinline__ pg8::u32x4 pack8(const float (&x)[8], const float (&y)[8]) {
    pg8::u32x4 w;
    w.x = f2bf(x[0] * y[0]) | (f2bf(x[1] * y[1]) << 16); w.y = f2bf(x[2] * y[2]) | (f2bf(x[3] * y[3]) << 16);
    w.z = f2bf(x[4] * y[4]) | (f2bf(x[5] * y[5]) << 16); w.w = f2bf(x[6] * y[6]) | (f2bf(x[7] * y[7]) << 16);
    return w;
}
__device__ __forceinline__ void hyena_phase(LAS unsigned char* lds, const HyArgs& A, int first, int stride, const int tid, const int wave) {
    lcf Z = (lcf)lds;
    const int s = tid >> 8, t = tid & 255, pb = 8 * tid + (tid >> 1);
    const cf w1 = ldz(A.T, 2 * t), w2 = ldz(A.T, 32 * (t & 15)), wp = ldz(A.T, 8 * tid);
    lcf Zs = Z + s * FSUB;
    LAS unsigned char* wdst = lds + wave * 1024;
    constexpr float W8C[8] = {1.0f, 0.99999970586f, 0.99999882345f, 0.99999735277f, 0.99999529381f, 0.99999264659f, 0.99998941108f, 0.99998558731f};
    constexpr float W8S[8] = {0.0f, 0.00076699031874f, 0.0015339801863f, 0.0023009691514f, 0.0030679567630f, 0.0038349425697f, 0.0046019261204f, 0.0053689069640f};
    if (first >= 1024) return;
#define ISSUE_PAIR(cc, oa, ob) do { \
        hdma16(A.hyT + (size_t)(1024 + (cc)) * A.TS + (oa) + 8 * tid, wdst + HOFF_SX1); hdma16(A.hyT + (size_t)(1024 + (cc)) * A.TS + (ob) + 8 * tid, wdst + HOFF_SX1 + 8192); \
        hdma16(A.hyT + (size_t)(2048 + (cc)) * A.TS + (oa) + 8 * tid, wdst + HOFF_SV);  hdma16(A.hyT + (size_t)(2048 + (cc)) * A.TS + (ob) + 8 * tid, wdst + HOFF_SV + 8192); } while (0)
#define ISSUE_X0(cc, oa, ob) do { hdma16(A.hyT + (size_t)(cc) * A.TS + (oa) + 8 * tid, wdst + HOFF_SX0); hdma16(A.hyT + (size_t)(cc) * A.TS + (ob) + 8 * tid, wdst + HOFF_SX0 + 8192); } while (0)
#define ISSUE_FILT(cc) do { \
        hdma16(A.fsum + (size_t)(cc) * 4096 + 8 * tid, wdst + HOFF_SF); hdma16(A.fsum + (size_t)(cc) * 4096 + 8 * tid + 4, wdst + HOFF_SF + 8192); \
        hdma16(A.fdif + (size_t)(cc) * 4096 + 8 * tid, wdst + HOFF_SF + 16384); hdma16(A.fdif + (size_t)(cc) * 4096 + 8 * tid + 4, wdst + HOFF_SF + 24576); } while (0)
    ISSUE_FILT(first); ISSUE_PAIR(first, A.off00, A.off01);
    for (int c = first; c < 1024; c += stride) {
        const int cn = c + stride;
        const float sk = A.skip[c];
        const float cx0 = A.cw[c], cx1 = A.cw[3072 + c], cx2 = A.cw[6144 + c], cxb = A.cb[c];
        const float ca0 = A.cw[1024 + c], ca1 = A.cw[3072 + 1024 + c], ca2 = A.cw[6144 + 1024 + c], cab = A.cb[1024 + c];
        const float cv0 = A.cw[2048 + c], cv1 = A.cw[3072 + 2048 + c], cv2 = A.cw[6144 + 2048 + c], cvb = A.cb[2048 + c];
        cf Kr[16];
        HDMA_WAIT();
        {
            const pg8::f32x4 s0 = *(const LAS pg8::f32x4*)(lds + HOFF_SF + 16 * tid), s1 = *(const LAS pg8::f32x4*)(lds + HOFF_SF + 8192 + 16 * tid);
            const pg8::f32x4 d0 = *(const LAS pg8::f32x4*)(lds + HOFF_SF + 16384 + 16 * tid), d1 = *(const LAS pg8::f32x4*)(lds + HOFF_SF + 24576 + 16 * tid);
            const float fs[8] = {s0[0], s0[1], s0[2], s0[3], s1[0], s1[1], s1[2], s1[3]}, fd[8] = {d0[0], d0[1], d0[2], d0[3], d1[0], d1[1], d1[2], d1[3]};
#pragma unroll
            for (int i = 0; i < 8; ++i) { cf wq = wp; FFT_OPAQUE(wq); const cf tw = cmul(wq, cmk(W8C[i], -W8S[i])); stz(Z, pb + i, cmk(fs[i], 0.f)); stz(Z, FSUB + pb + i, cmk(fd[i] * tw.x, fd[i] * tw.y)); }
        }
        HBAR();
        fwd_pass1(Zs, t, w1); HBAR();
        fwd_pass2(Zs, t, w2); WAVE_FENCE();
        fwd_pass3_load(Zs, t, Kr);
#pragma unroll
        for (int j = 0; j < 16; ++j) { Kr[j].x *= (1.0f / 8192.0f); Kr[j].y *= (1.0f / 8192.0f); }
        HBAR();
        for (int p = 0; p < A.npairs; ++p) {
            const int o0 = p ? A.off10 : A.off00, o1 = p ? A.off11 : A.off01;
            float u0[8], u1[8];
            {
                float a[8], b[8];
                conv8s(lds + HOFF_SX1, tid, ca0, ca1, ca2, cab, a); conv8s(lds + HOFF_SV, tid, cv0, cv1, cv2, cvb, b);
#pragma unroll
                for (int i = 0; i < 8; ++i) u0[i] = a[i] * b[i];
                conv8s(lds + HOFF_SX1 + 8192, tid, ca0, ca1, ca2, cab, a); conv8s(lds + HOFF_SV + 8192, tid, cv0, cv1, cv2, cvb, b);
#pragma unroll
                for (int i = 0; i < 8; ++i) u1[i] = a[i] * b[i];
            }
#pragma unroll
            for (int i = 0; i < 8; ++i) { cf wq = wp; FFT_OPAQUE(wq); const cf tw = cmul(wq, cmk(W8C[i], -W8S[i])); const cf z = cmk(u0[i], u1[i]); stz(Z, pb + i, z); stz(Z, FSUB + pb + i, cmul(z, tw)); }
            HBAR();
            ISSUE_X0(c, o0, o1);
            if (p + 1 < A.npairs) ISSUE_PAIR(c, A.off10, A.off11);
            else if (cn < 1024) { ISSUE_PAIR(cn, A.off00, A.off01); ISSUE_FILT(cn); }
            fwd_pass1(Zs, t, w1); HBAR();
            fwd_pass2(Zs, t, w2); WAVE_FENCE();
            {
                cf v[16];
                fwd_pass3_load(Zs, t, v);
#pragma unroll
                for (int j = 0; j < 16; ++j) v[j] = cmul(v[j], Kr[j]);
                inv_pass1_store(Zs, t, v);
            }
            WAVE_FENCE();
            inv_pass2(Zs, t, w2); HBAR();
            inv_pass3(Zs, t, w1);
            HDMA_WAIT(); HBAR();
            {
                float y0[8], y1[8];
#pragma unroll
                for (int i = 0; i < 8; ++i) { cf wq = wp; FFT_OPAQUE(wq); const cf tw = cmul(wq, cmk(W8C[i], -W8S[i])); const cf e = ldz(Z, pb + i), o = ldz(Z, FSUB + pb + i); const cf y = cadd(e, cmul(o, cconj(tw))); y0[i] = y.x + sk * u0[i]; y1[i] = y.y + sk * u1[i]; }
                float x0c[8];
                conv8s(lds + HOFF_SX0, tid, cx0, cx1, cx2, cxb, x0c);
                *(pg8::u32x4*)(A.yaT + (size_t)c * A.TS + o0 + 8 * tid) = pack8(x0c, y0);
                if (o1 != o0) { conv8s(lds + HOFF_SX0 + 8192, tid, cx0, cx1, cx2, cxb, x0c); *(pg8::u32x4*)(A.yaT + (size_t)c * A.TS + o1 + 8 * tid) = pack8(x0c, y1); }
            }
        }
    }
    HDMA_WAIT(); HBAR();
#undef ISSUE_PAIR
#undef ISSUE_X0
#undef ISSUE_FILT
}
}
namespace pg8 {
__device__ __forceinline__ f32x2 sigmoid_pk(f32x2 v) {
    f32x2 e; e.x = __builtin_amdgcn_exp2f(v.x * -1.4426950408889634f); e.y = __builtin_amdgcn_exp2f(v.y * -1.4426950408889634f);
    f32x2 o; o.x = __builtin_amdgcn_rcpf(1.0f + e.x); o.y = __builtin_amdgcn_rcpf(1.0f + e.y); return o;
}
struct EpiHyT {
    static constexpr bool PERM = true, AFTER_DRAIN = false, MID = false, OVL = false, ATR = false;
    bf16_t* O; int ldc; float* vss;
    __device__ __forceinline__ void operator()(const f32x4 (&acc)[2][2][4][2], const Unit& u, int wr, int wc, int fr, int fq) const {
        const int row0 = u.pm * BM + wr * 64 + fr, col0 = u.pn * BM + wc * 32 + 8 * fq;
        const bool isv = u.pm >= 12;
        f32x4 ss[2][2];
#pragma unroll
        for (int bj = 0; bj < 2; ++bj)
#pragma unroll
            for (int n = 0; n < 2; ++n) ss[bj][n] = (f32x4){0.f, 0.f, 0.f, 0.f};
#pragma unroll
        for (int ai = 0; ai < 2; ++ai)
#pragma unroll
            for (int m = 0; m < 4; ++m) { bf16_t* rowp = O + (size_t)(row0 + ai * HALF + m * 16) * ldc + col0;
#pragma unroll
                for (int bj = 0; bj < 2; ++bj) { f32x4 v0 = acc[ai][bj][m][0], v1 = acc[ai][bj][m][1];
                    if (isv) { f32x2 a = gelu_pk((f32x2){v0[0], v0[1]}), b = gelu_pk((f32x2){v0[2], v0[3]}), c = gelu_pk((f32x2){v1[0], v1[1]}), d = gelu_pk((f32x2){v1[2], v1[3]});
                        v0 = (f32x4){a.x, a.y, b.x, b.y}; v1 = (f32x4){c.x, c.y, d.x, d.y}; ss[bj][0] += v0 * v0; ss[bj][1] += v1 * v1; }
                    u32x4 w; w.x = cvt_pk_bf16(v0[0], v0[1]); w.y = cvt_pk_bf16(v0[2], v0[3]); w.z = cvt_pk_bf16(v1[0], v1[1]); w.w = cvt_pk_bf16(v1[2], v1[3]);
                    *(u32x4*)(rowp + bj * HALF) = w; } }
        if (isv) {
#pragma unroll
            for (int bj = 0; bj < 2; ++bj)
#pragma unroll
                for (int n = 0; n < 2; ++n)
#pragma unroll
                    for (int j = 0; j < 4; ++j) { float s = ss[bj][n][j]; s += __shfl_xor(s, 1); s += __shfl_xor(s, 2); s += __shfl_xor(s, 4); s += __shfl_xor(s, 8);
                        if (fr == 0) atomicAdd(vss + col0 + bj * HALF + 4 * n + j, s); }
        }
    }
};
struct EpiUG {
    static constexpr bool PERM = true, AFTER_DRAIN = false, MID = false, OVL = false, ATR = false;
    bf16_t* U; bf16_t* G; int ldu;
    __device__ __forceinline__ void operator()(const f32x4 (&acc)[2][2][4][2], const Unit& u, int wr, int wc, int fr, int fq) const {
        const int row0 = u.pm * BM + wr * 64 + fr; int colt = u.pn * BM; const bool isu = colt < 1024;
        bf16_t* base = isu ? U : G; const int ldc = isu ? ldu : 2048; if (!isu) colt -= 1024;
        const int col0 = colt + wc * 32 + 8 * fq;
#pragma unroll
        for (int ai = 0; ai < 2; ++ai)
#pragma unroll
            for (int m = 0; m < 4; ++m) { bf16_t* rowp = base + (size_t)(row0 + ai * HALF + m * 16) * ldc + col0;
#pragma unroll
                for (int bj = 0; bj < 2; ++bj) { f32x4 v0 = acc[ai][bj][m][0], v1 = acc[ai][bj][m][1];
                    f32x2 a, b, c, d;
                    if (isu) { a = gelu_pk((f32x2){v0[0], v0[1]}); b = gelu_pk((f32x2){v0[2], v0[3]}); c = gelu_pk((f32x2){v1[0], v1[1]}); d = gelu_pk((f32x2){v1[2], v1[3]}); }
                    else { a = sigmoid_pk((f32x2){v0[0], v0[1]}); b = sigmoid_pk((f32x2){v0[2], v0[3]}); c = sigmoid_pk((f32x2){v1[0], v1[1]}); d = sigmoid_pk((f32x2){v1[2], v1[3]}); }
                    u32x4 w; w.x = cvt_pk_bf16(a.x, a.y); w.y = cvt_pk_bf16(b.x, b.y); w.z = cvt_pk_bf16(c.x, c.y); w.w = cvt_pk_bf16(d.x, d.y);
                    *(u32x4*)(rowp + bj * HALF) = w; } }
    }
};
}
namespace {
struct WJob { const float* W; const float* g; bf16* dst; int K, N, c0, nc, ldd, r0, koff, perm; };
constexpr int NWJ = 9;
struct WJobs { WJob j[NWJ]; };
__device__ __forceinline__ unsigned pk2(float lo, float hi) { return f2bf(lo) | (f2bf(hi) << 16); }
__device__ __forceinline__ void wT_item(const WJob& J, LAS float* scr, int item, int lane) {
    const int nblk = J.nc / 32, kb = item / nblk, nb = item % nblk, k0 = 64 * kb, n0 = 32 * nb;
    float v[32];
#pragma unroll
    for (int i = 0; i < 32; ++i) v[i] = J.W[(size_t)(k0 + 2 * i + (lane >> 5)) * J.N + J.c0 + n0 + (lane & 31)];
    if (J.g) {
#pragma unroll
        for (int i = 0; i < 32; ++i) v[i] *= J.g[k0 + 2 * i + (lane >> 5)]; }
#pragma unroll
    for (int i = 0; i < 32; ++i) scr[(2 * i + (lane >> 5)) * 33 + (lane & 31)] = v[i];
    asm volatile("s_waitcnt lgkmcnt(0)" ::: "memory");
    const int c = lane & 7; int rb = n0;
    if (J.perm) { const int half = n0 >= 2816, cc = n0 - half * 2816; rb = 256 * (cc >> 7) + 128 * half + (cc & 127); }
#pragma unroll
    for (int j = 0; j < 4; ++j) { const int n = (lane >> 3) + 8 * j; const LAS float* s = scr + (8 * c) * 33 + n;
        uint4 o; o.x = pk2(s[0 * 33], s[1 * 33]); o.y = pk2(s[2 * 33], s[3 * 33]); o.z = pk2(s[4 * 33], s[5 * 33]); o.w = pk2(s[6 * 33], s[7 * 33]);
        *(uint4*)(J.dst + (size_t)(J.r0 + rb + n) * J.ldd + J.koff + k0 + 8 * c) = o; }
    asm volatile("s_waitcnt lgkmcnt(0)" ::: "memory");
}
__device__ __forceinline__ void p0_weights(const WJobs& WJ, int jlo, int jhi, LAS float* scr, int gw, int NGW, int lane) {
    int base = 0;
    for (int q = jlo; q < jhi; ++q) {
        const WJob& J = WJ.j[q]; const int ni = (J.K / 64) * (J.nc / 32);
        int it = gw - (base % NGW); if (it < 0) it += NGW;
        for (; it < ni; it += NGW) wT_item(J, scr, it, lane);
        base += ni;
    }
}
__device__ __forceinline__ float wave_sum(float v) {
#pragma unroll
    for (int o = 1; o < 64; o <<= 1) v += __shfl_xor(v, o);
    return v;
}
__device__ __forceinline__ void rms_row_to_bf16(const float* xrow, const float* g, bf16* orow, int lane) {
    const float4* xr = (const float4*)xrow + lane; const float4* gr = (const float4*)g + lane;
    float4 v[4]; float s = 0.f;
#pragma unroll
    for (int j = 0; j < 4; ++j) { v[j] = xr[64 * j]; s += (v[j].x * v[j].x + v[j].y * v[j].y) + (v[j].z * v[j].z + v[j].w * v[j].w); }
    const float r = rsqrtf(wave_sum(s) * (1.f / 1024.f) + EPS);
    unsigned long long* o8 = (unsigned long long*)orow + lane;
#pragma unroll
    for (int j = 0; j < 4; ++j) { const float4 gg = gr[64 * j];
        o8[64 * j] = (unsigned long long)pk2(v[j].x * r * gg.x, v[j].y * r * gg.y) | ((unsigned long long)pk2(v[j].z * r * gg.z, v[j].w * r * gg.w) << 32); }
}
__device__ __forceinline__ void rms_rows4_to_bf16(const float* xrow, const float* g, bf16* orow, int ldo, int lane) {
    float4 v[4][4]; float s[4];
#pragma unroll
    for (int r = 0; r < 4; ++r)
#pragma unroll
        for (int j = 0; j < 4; ++j) v[r][j] = ((const float4*)(xrow + (size_t)r * 1024) + lane)[64 * j];
#pragma unroll
    for (int r = 0; r < 4; ++r) { s[r] = 0.f;
#pragma unroll
        for (int j = 0; j < 4; ++j) s[r] += (v[r][j].x * v[r][j].x + v[r][j].y * v[r][j].y) + (v[r][j].z * v[r][j].z + v[r][j].w * v[r][j].w); }
#pragma unroll
    for (int r = 0; r < 4; ++r) { const float rr = rsqrtf(wave_sum(s[r]) * (1.f / 1024.f) + EPS);
        unsigned long long* o8 = (unsigned long long*)(orow + (size_t)r * ldo) + lane;
#pragma unroll
        for (int j = 0; j < 4; ++j) { const float4 gg = ((const float4*)g + lane)[64 * j];
            o8[64 * j] = (unsigned long long)pk2(v[r][j].x * rr * gg.x, v[r][j].y * rr * gg.y) | ((unsigned long long)pk2(v[r][j].z * rr * gg.z, v[r][j].w * rr * gg.w) << 32); } }
}
}

namespace {
struct SguArgs {
    const bf16* vT;
    bf16* U;
    const float* vss;
    const float* ws;
    const float* bs;
    const float* gn;
    int TS, ldu;
};
typedef short bf16x8_t __attribute__((ext_vector_type(8)));
typedef float f32x4_t __attribute__((ext_vector_type(4)));
#define SBAR() do { asm volatile("s_waitcnt lgkmcnt(0)" ::: "memory"); __builtin_amdgcn_s_barrier(); asm volatile("" ::: "memory"); } while (0)
__device__ __forceinline__ void sgu_phase(LAS unsigned char* lds, const SguArgs& A, int first, int stride, const int tid, const int wave) {
    const int nitems = (A.TS / 128) * 8;
    if (first >= nitems) return;
    const int lane = tid & 63, fr = lane & 15, fq = lane >> 4, p = 16 * wave + fr;
    LAS float* rtab = (LAS float*)(lds + 131072);
    LAS float* gnl = (LAS float*)(lds + 131072 + 4096);
#define SGU_ISSUE(item, buf) do { const int g_ = (item) & 7, tok0_ = ((item) >> 3) * 128; \
        _Pragma("unroll") for (int i_ = 0; i_ < 4; ++i_) { const int r_ = (i_ * 8 + wave) * 4 + (lane >> 4), c_ = (lane & 15) ^ (r_ & 15); \
            __builtin_amdgcn_global_load_lds((const unsigned*)(A.vT + (size_t)(g_ * 128 + r_) * A.TS + tok0_ + 8 * c_), (LAS unsigned*)(lds + (buf) * 65536 + (i_ * 8 + wave) * 1024), 16, 0, 0); \
            __builtin_amdgcn_global_load_lds((const unsigned*)(A.U + (size_t)(tok0_ + r_) * A.ldu + g_ * 128 + 8 * c_), (LAS unsigned*)(lds + (buf) * 65536 + 32768 + (i_ * 8 + wave) * 1024), 16, 0, 0); } } while (0)
    SGU_ISSUE(first, 0);
    int gcur = -1; float wf[4][8]; float bsp = 0.f;
    for (int e = tid; e < 1024; e += 512) { const int k = e >> 7, it = first + k * stride;
        if (it < nitems) rtab[e] = rsqrtf(A.vss[(it >> 3) * 128 + (e & 127)] * (1.f / 1024.f) + EPS); }
    int k = 0;
    for (int it = first; it < nitems; it += stride, ++k) {
        const int g = it & 7, tok0 = (it >> 3) * 128, buf = k & 1;
        if (g != gcur) {
            gcur = g;
#pragma unroll
            for (int kk = 0; kk < 4; ++kk) { const float4 w0 = *(const float4*)(A.ws + ((size_t)g * 128 + p) * 128 + 32 * kk + 8 * fq), w1 = *(const float4*)(A.ws + ((size_t)g * 128 + p) * 128 + 32 * kk + 8 * fq + 4);
                wf[kk][0] = w0.x; wf[kk][1] = w0.y; wf[kk][2] = w0.z; wf[kk][3] = w0.w; wf[kk][4] = w1.x; wf[kk][5] = w1.y; wf[kk][6] = w1.z; wf[kk][7] = w1.w; }
            bsp = A.bs[g * 128 + p];
            SBAR();
            if (tid < 128) gnl[tid] = A.gn[g * 128 + tid];
        }
        asm volatile("s_waitcnt vmcnt(0)" ::: "memory"); SBAR();
        if (it + stride < nitems) SGU_ISSUE(it + stride, buf ^ 1);
        const LAS unsigned char* BT = lds + buf * 65536; const LAS unsigned char* UT = BT + 32768;
        bf16x8_t af[4];
#pragma unroll
        for (int kk = 0; kk < 4; ++kk) { const f32x4_t r0 = *(const LAS f32x4_t*)(rtab + k * 128 + 32 * kk + 8 * fq), r1 = *(const LAS f32x4_t*)(rtab + k * 128 + 32 * kk + 8 * fq + 4);
            uint4 o; o.x = pk2(wf[kk][0] * r0[0], wf[kk][1] * r0[1]); o.y = pk2(wf[kk][2] * r0[2], wf[kk][3] * r0[3]); o.z = pk2(wf[kk][4] * r1[0], wf[kk][5] * r1[1]); o.w = pk2(wf[kk][6] * r1[2], wf[kk][7] * r1[3]);
            af[kk] = __builtin_bit_cast(bf16x8_t, o); }
        f32x4_t acc[8];
#pragma unroll
        for (int nt = 0; nt < 8; ++nt) acc[nt] = (f32x4_t){0.f, 0.f, 0.f, 0.f};
#pragma unroll
        for (int kk = 0; kk < 4; ++kk) {
            bf16x8_t bfr[8];
#pragma unroll
            for (int nt = 0; nt < 8; ++nt) bfr[nt] = *(const LAS bf16x8_t*)(BT + (16 * nt + fr) * 256 + 16 * ((4 * kk + fq) ^ fr));
#pragma unroll
            for (int nt = 0; nt < 8; ++nt) acc[nt] = __builtin_amdgcn_mfma_f32_16x16x32_bf16(bfr[nt], af[kk], acc[nt], 0, 0, 0);
        }
        bf16* urow = A.U + (size_t)(tok0 + p) * A.ldu + g * 128 + 4 * fq;
#pragma unroll
        for (int nt = 0; nt < 8; ++nt) {
            typedef unsigned u32x2_t __attribute__((ext_vector_type(2)));
            const u32x2_t uu = *(const LAS u32x2_t*)(UT + p * 256 + 16 * ((2 * nt + (fq >> 1)) ^ fr) + 8 * (fq & 1));
            const f32x4_t gv = *(const LAS f32x4_t*)(gnl + 16 * nt + 4 * fq);
            const float y0 = bf2f(uu.x & 0xffffu) * (gv[0] * acc[nt][0] + bsp), y1 = bf2f(uu.x >> 16) * (gv[1] * acc[nt][1] + bsp);
            const float y2 = bf2f(uu.y & 0xffffu) * (gv[2] * acc[nt][2] + bsp), y3 = bf2f(uu.y >> 16) * (gv[3] * acc[nt][3] + bsp);
            uint2 o; o.x = pk2(y0, y1); o.y = pk2(y2, y3);
            *(uint2*)(urow + 16 * nt) = o;
        }
    }
    asm volatile("s_waitcnt vmcnt(0)" ::: "memory"); SBAR();
#undef SGU_ISSUE
}
}

namespace pg8 {
__device__ __forceinline__ void bf8_to_f32(const u32x4 q, f32x4& lo, f32x4& hi) {
    lo = (f32x4){__builtin_bit_cast(float, q.x << 16), __builtin_bit_cast(float, q.x & 0xffff0000u), __builtin_bit_cast(float, q.y << 16), __builtin_bit_cast(float, q.y & 0xffff0000u)};
    hi = (f32x4){__builtin_bit_cast(float, q.z << 16), __builtin_bit_cast(float, q.z & 0xffff0000u), __builtin_bit_cast(float, q.w << 16), __builtin_bit_cast(float, q.w & 0xffff0000u)};
}
struct EpiMerge {
    static constexpr bool PERM = true, AFTER_DRAIN = false, MID = true, OVL = false, ATR = true;
    const bf16_t* G; bf16_t* O;
    __device__ __forceinline__ void mid(f32x4 (&acc)[2][2][4][2], const Unit& u, int wr, int wc, int fr, int fq) const {
        unsigned off0 = (unsigned)(u.pm * BM + wr * 64 + fr) * 2048u + (unsigned)(u.pn * BM + wc * 32 + 8 * fq);
        asm volatile("" : "+v"(off0));
#pragma unroll
        for (int ai = 0; ai < 2; ++ai)
#pragma unroll
            for (int mh = 0; mh < 2; ++mh) {
                u32x4 qa[2][2], qb[2][2];
#pragma unroll
                for (int mm = 0; mm < 2; ++mm)
#pragma unroll
                    for (int bj = 0; bj < 2; ++bj) { const bf16_t* gp = G + (off0 + (unsigned)((ai * HALF + (2 * mh + mm) * 16) * 2048 + bj * HALF)); qa[mm][bj] = *(const u32x4*)gp; qb[mm][bj] = *(const u32x4*)(gp + 1024); }
#pragma unroll
                for (int mm = 0; mm < 2; ++mm)
#pragma unroll
                    for (int bj = 0; bj < 2; ++bj) { const int m = 2 * mh + mm; f32x4 a0, a1, b0, b1; bf8_to_f32(qa[mm][bj], a0, a1); bf8_to_f32(qb[mm][bj], b0, b1);
#pragma unroll
                        for (int j = 0; j < 4; ++j) { acc[ai][bj][m][0][j] *= a0[j] * __builtin_amdgcn_rcpf(b0[j]); acc[ai][bj][m][1][j] *= a1[j] * __builtin_amdgcn_rcpf(b1[j]); } }
                asm volatile("" ::: "memory"); }
    }
    __device__ __forceinline__ void operator()(const f32x4 (&acc)[2][2][4][2], const Unit& u, int wr, int wc, int fr, int fq) const {
        const int row0 = u.pm * BM + wr * 64 + fr, col0 = u.pn * BM + wc * 32 + 8 * fq;
#pragma unroll
        for (int ai = 0; ai < 2; ++ai)
#pragma unroll
            for (int m = 0; m < 4; ++m) { const size_t r = (size_t)(row0 + ai * HALF + m * 16);
#pragma unroll
                for (int bj = 0; bj < 2; ++bj) { f32x4 b0, b1; bf8_to_f32(*(const u32x4*)(G + r * 2048 + 1024 + col0 + bj * HALF), b0, b1);
                    const f32x4 v0 = acc[ai][bj][m][0] * b0, v1 = acc[ai][bj][m][1] * b1;
                    u32x4 w; w.x = cvt_pk_bf16(v0[0], v0[1]); w.y = cvt_pk_bf16(v0[2], v0[3]); w.z = cvt_pk_bf16(v1[0], v1[1]); w.w = cvt_pk_bf16(v1[2], v1[3]);
                    *(u32x4*)(O + r * 1024 + col0 + bj * HALF) = w; } }
    }
};
}
namespace {
__device__ __forceinline__ void tr64_item(const bf16* yaT, int TS, bf16* out, int ldo, LAS unsigned short* scr, int c0, int t0, int lane) {
#pragma unroll
    for (int i = 0; i < 8; ++i) { const int r = 8 * i + (lane >> 3), ch = lane & 7;
        const pg8::u32x4 q = *(const pg8::u32x4*)(yaT + (size_t)(c0 + r) * TS + t0 + 8 * ch);
        LAS unsigned short* d = scr + (8 * ch) * 72 + r;
        d[0 * 72] = (unsigned short)(q.x & 0xffffu); d[1 * 72] = (unsigned short)(q.x >> 16); d[2 * 72] = (unsigned short)(q.y & 0xffffu); d[3 * 72] = (unsigned short)(q.y >> 16);
        d[4 * 72] = (unsigned short)(q.z & 0xffffu); d[5 * 72] = (unsigned short)(q.z >> 16); d[6 * 72] = (unsigned short)(q.w & 0xffffu); d[7 * 72] = (unsigned short)(q.w >> 16); }
    asm volatile("s_waitcnt lgkmcnt(0)" ::: "memory");
#pragma unroll
    for (int i = 0; i < 8; ++i) { const int tk = 8 * i + (lane >> 3), ch = lane & 7;
        const pg8::u32x4 q = *(const LAS pg8::u32x4*)(scr + tk * 72 + 8 * ch);
        *(pg8::u32x4*)(out + (size_t)(t0 + tk) * ldo + c0 + 8 * ch) = q; }
    asm volatile("s_waitcnt lgkmcnt(0)" ::: "memory");
}
__device__ __forceinline__ void transpose_ya(const bf16* yaT, int TS, bf16* out, int ldo, LAS unsigned short* scr, int gw, int NGW, int lane) {
    const int ntt = TS / 64, nit = 16 * ntt;
    for (int it = gw; it < nit; it += NGW) tr64_item(yaT, TS, out, ldo, scr, 64 * (it / ntt), 64 * (it % ntt), lane);
}
}

namespace pg8 {
template <bool FIRST> struct EpiResid {
    static constexpr bool PERM = false, AFTER_DRAIN = false, MID = false, OVL = false, ATR = false;
    const float* X; const bf16_t* XB; float* X1; bf16_t* X1b; float* xss;
    __device__ __forceinline__ void operator()(const f32x4 (&acc)[2][2][4][2], const Unit& u, int wr, int wc, int fr, int fq) const {
        const int row0 = u.pm * BM + wr * 64 + fr, col0 = u.pn * BM + wc * 32 + 4 * fq;
        typedef unsigned u32x2v __attribute__((ext_vector_type(2)));
#pragma unroll
        for (int ai = 0; ai < 2; ++ai)
#pragma unroll
            for (int mh = 0; mh < 2; ++mh) {
                f32x4 xr[2][2][2];
#pragma unroll
                for (int mm = 0; mm < 2; ++mm) { const size_t r = (size_t)(row0 + ai * HALF + (2 * mh + mm) * 16);
#pragma unroll
                    for (int bj = 0; bj < 2; ++bj)
#pragma unroll
                        for (int n = 0; n < 2; ++n) { const size_t o = r * 1024 + col0 + bj * HALF + n * 16;
                            if (FIRST) xr[mm][bj][n] = *(const f32x4*)(X + o);
                            else { const u32x2v q = *(const u32x2v*)(XB + o);
                                   xr[mm][bj][n] = (f32x4){__builtin_bit_cast(float, q.x << 16), __builtin_bit_cast(float, q.x & 0xffff0000u), __builtin_bit_cast(float, q.y << 16), __builtin_bit_cast(float, q.y & 0xffff0000u)}; } } }
#pragma unroll
                for (int mm = 0; mm < 2; ++mm) { const int m = 2 * mh + mm; const size_t r = (size_t)(row0 + ai * HALF + m * 16); float s = 0.f;
#pragma unroll
                    for (int bj = 0; bj < 2; ++bj)
#pragma unroll
                        for (int n = 0; n < 2; ++n) { const size_t o = r * 1024 + col0 + bj * HALF + n * 16;
                            const f32x4 v = acc[ai][bj][m][n] + xr[mm][bj][n];
                            { u32x2v w; w.x = cvt_pk_bf16(v[0], v[1]); w.y = cvt_pk_bf16(v[2], v[3]); *(u32x2v*)(X1b + o) = w; }
                            s += (v[0] * v[0] + v[1] * v[1]) + (v[2] * v[2] + v[3] * v[3]); }
                    s += __shfl_xor(s, 16); s += __shfl_xor(s, 32);
                    if (fq == 0) atomicAdd(xss + r, s); }
                asm volatile("" ::: "memory"); }
    }
};
struct EpiResidNorm {
    static constexpr bool PERM = false, AFTER_DRAIN = true, MID = false, OVL = false, ATR = false;
    const bf16_t* XB; float* out; float* x2ss; const float* g; unsigned* cnt;
    __device__ __forceinline__ void fused(f32x4 (&acc)[2][2][4][2], const Unit& u, int wr, int wc, int fr, int fq, PG8_LAS unsigned char* lds, int wid, int lane) const {
        typedef unsigned u32x2v __attribute__((ext_vector_type(2)));
        const int row0 = u.pm * BM + wr * 64 + fr, col0 = u.pn * BM + wc * 32 + 4 * fq;
        float keep = 0.f;
#pragma unroll
        for (int ai = 0; ai < 2; ++ai)
#pragma unroll
            for (int m = 0; m < 4; ++m) { const size_t r = (size_t)(row0 + ai * HALF + m * 16); float s = 0.f;
#pragma unroll
                for (int bj = 0; bj < 2; ++bj)
#pragma unroll
                    for (int n = 0; n < 2; ++n) { const u32x2v q = *(const u32x2v*)(XB + r * 1024 + col0 + bj * HALF + n * 16);
                        const f32x4 v = acc[ai][bj][m][n] + (f32x4){__builtin_bit_cast(float, q.x << 16), __builtin_bit_cast(float, q.x & 0xffff0000u), __builtin_bit_cast(float, q.y << 16), __builtin_bit_cast(float, q.y & 0xffff0000u)};
                        acc[ai][bj][m][n] = v; s += (v[0] * v[0] + v[1] * v[1]) + (v[2] * v[2] + v[3] * v[3]); }
                s += __shfl_xor(s, 16); s += __shfl_xor(s, 32);
                if (fq == 0) keep += atomicAdd(x2ss + r, s); }
        asm volatile("s_waitcnt vmcnt(0)" :: "v"(keep) : "memory");
        asm volatile("s_waitcnt lgkmcnt(0)" ::: "memory"); __builtin_amdgcn_s_barrier(); asm volatile("" ::: "memory");
        if (wid == 0) {
            if (lane == 0) { __hip_atomic_fetch_add(cnt + 64 * u.pm, 1u, __ATOMIC_RELAXED, __HIP_MEMORY_SCOPE_AGENT);
                unsigned spins = 0;
                while (__hip_atomic_load(cnt + 64 * u.pm, __ATOMIC_RELAXED, __HIP_MEMORY_SCOPE_AGENT) < 4u) { __builtin_amdgcn_s_sleep(2); if (++spins > (1u << 22)) break; } }
            __builtin_amdgcn_fence(__ATOMIC_ACQUIRE, "agent");
            asm volatile("s_waitcnt vmcnt(0)" ::: "memory");
        }
        asm volatile("s_waitcnt lgkmcnt(0)" ::: "memory"); __builtin_amdgcn_s_barrier(); asm volatile("" ::: "memory");
        f32x4 gv[2][2];
#pragma unroll
        for (int bj = 0; bj < 2; ++bj)
#pragma unroll
            for (int n = 0; n < 2; ++n) gv[bj][n] = *(const f32x4*)(g + col0 + bj * HALF + n * 16);
#pragma unroll
        for (int ai = 0; ai < 2; ++ai)
#pragma unroll
            for (int m = 0; m < 4; ++m) { const size_t r = (size_t)(row0 + ai * HALF + m * 16);
                const float rs = rsqrtf(__hip_atomic_load(x2ss + r, __ATOMIC_RELAXED, __HIP_MEMORY_SCOPE_AGENT) * (1.0f / 1024.0f) + 1e-6f);
#pragma unroll
                for (int bj = 0; bj < 2; ++bj)
#pragma unroll
                    for (int n = 0; n < 2; ++n) *(f32x4*)(out + r * 1024 + col0 + bj * HALF + n * 16) = acc[ai][bj][m][n] * gv[bj][n] * rs; }
    }
};
__device__ __forceinline__ float dpp_ror1(float v) { return __builtin_bit_cast(float, __builtin_amdgcn_update_dpp(0, __builtin_bit_cast(int, v), 0x121, 0xf, 0xf, false)); }
__device__ __forceinline__ float dpp_rol1(float v) { return __builtin_bit_cast(float, __builtin_amdgcn_update_dpp(0, __builtin_bit_cast(int, v), 0x12f, 0xf, 0xf, false)); }
struct EpiUpAct {
    static constexpr bool PERM = true, AFTER_DRAIN = false, MID = false, OVL = true, ATR = false;
    bf16_t* ACT; PG8_LAS float* XB; const float* xss; const float* cw; const float* cb;
    __device__ __forceinline__ void operator()(f32x4 (&acc)[2][2][4][2], const Unit& u, int wr, int wc, int fr_, int fq_) const {
        int lane_; asm volatile("v_mbcnt_lo_u32_b32 %0, -1, 0\n\tv_mbcnt_hi_u32_b32 %0, -1, %0" : "=v"(lane_));
        const int fr = lane_ & 15, fq = lane_ >> 4; (void)fr_; (void)fq_;
        const int seq = u.pm / 17, ti = u.pm % 17, rowbase = ovl_row(u.pm);
        const int own_lo = seq * 4096 + 254 * ti, own_hi = seq * 4096 + (254 * ti + 254 < 4096 ? 254 * ti + 254 : 4096);
        const int lr0 = wr * 64 + fr, cl = 32 * wc + 8 * fq;
#pragma unroll
        for (int ai = 0; ai < 2; ++ai)
#pragma unroll
            for (int m = 0; m < 4; ++m) { const float rs = rsqrtf(xss[rowbase + lr0 + ai * HALF + m * 16] * (1.0f / 1024.0f) + 1e-6f);
#pragma unroll
                for (int bj = 0; bj < 2; ++bj) { acc[ai][bj][m][0] *= rs; acc[ai][bj][m][1] *= rs; }
                __builtin_amdgcn_sched_barrier(0); }
        const bool e0 = fr == 0, e15 = fr == 15;
        const int slot = e0 ? 0 : (e15 ? 512 : 1024);
#pragma unroll
        for (int ai = 0; ai < 2; ++ai) { const int B = 2 * ai + wr;
            f32x4 p0, p1;
#pragma unroll
            for (int j = 0; j < 4; ++j) { p0[j] = e15 ? acc[ai][0][3][0][j] : acc[ai][0][0][0][j]; p1[j] = e15 ? acc[ai][0][3][1][j] : acc[ai][0][0][1][j]; }
            *(PG8_LAS f32x4*)(XB + slot + B * 128 + cl) = p0; *(PG8_LAS f32x4*)(XB + slot + B * 128 + cl + 4) = p1; }
        asm volatile("s_waitcnt lgkmcnt(0)" ::: "memory"); __builtin_amdgcn_s_barrier(); asm volatile("" ::: "memory");
        const int ch = 128 * u.pn + cl;
        typedef unsigned u32x2v __attribute__((ext_vector_type(2)));
#pragma unroll
        for (int ai = 0; ai < 2; ++ai) { const int B = 2 * ai + wr;
#pragma unroll
            for (int n = 0; n < 2; ++n) {
                const f32x4 w0 = *(const f32x4*)(cw + ch + 4 * n), w1 = *(const f32x4*)(cw + 2816 + ch + 4 * n), w2 = *(const f32x4*)(cw + 5632 + ch + 4 * n), bb = *(const f32x4*)(cb + ch + 4 * n);
                f32x4 pb = *(const PG8_LAS f32x4*)(XB + 512 + (B > 0 ? B - 1 : 0) * 128 + cl + 4 * n), nb = *(const PG8_LAS f32x4*)(XB + (B < 3 ? B + 1 : 3) * 128 + cl + 4 * n);
                if (B == 0) pb = (f32x4){0.f, 0.f, 0.f, 0.f};
                if (B == 3) nb = (f32x4){0.f, 0.f, 0.f, 0.f};
                float o[4][4];
#pragma unroll
                for (int j = 0; j < 4; ++j) {
                    float av[4], rr[4], ll[4];
#pragma unroll
                    for (int m = 0; m < 4; ++m) { av[m] = acc[ai][0][m][n][j]; rr[m] = dpp_ror1(av[m]); ll[m] = dpp_rol1(av[m]); }
#pragma unroll
                    for (int m = 0; m < 4; ++m) { const float pv = e0 ? (m > 0 ? rr[m - 1] : pb[j]) : rr[m], nv = e15 ? (m < 3 ? ll[m + 1] : nb[j]) : ll[m];
                        const float sv = bb[j] + w0[j] * pv + w1[j] * av[m] + w2[j] * nv;
                        o[m][j] = sv * __builtin_amdgcn_rcpf(1.0f + __builtin_amdgcn_exp2f(sv * -1.4426950408889634f)) * acc[ai][1][m][n][j]; }
                }
#pragma unroll
                for (int m = 0; m < 4; ++m) { const int tok = rowbase + lr0 + ai * HALF + m * 16;
                    if (tok >= own_lo && tok < own_hi) { u32x2v w; w.x = cvt_pk_bf16(o[m][0], o[m][1]); w.y = cvt_pk_bf16(o[m][2], o[m][3]); *(u32x2v*)(ACT + (size_t)tok * 2816 + ch + 4 * n) = w; } }
                __builtin_amdgcn_sched_barrier(0);
            } }
    }
};
}
namespace {
__device__ __forceinline__ void final_norm(const bf16* X2, const float* ss, const float* g, float* out, int TS, int gw, int NGW, int lane) {
    pg8::f32x4 g0[2], g1[2];
#pragma unroll
    for (int j = 0; j < 2; ++j) { g0[j] = *((const pg8::f32x4*)g + 2 * lane + 128 * j); g1[j] = *((const pg8::f32x4*)g + 2 * lane + 128 * j + 1); }
    for (int t = 2 * gw; t < TS; t += 2 * NGW) {
        pg8::u32x4 q[2][2]; float r[2];
#pragma unroll
        for (int k = 0; k < 2; ++k) { r[k] = rsqrtf(ss[t + k] * (1.0f / 1024.0f) + EPS);
#pragma unroll
            for (int j = 0; j < 2; ++j) q[k][j] = *((const pg8::u32x4*)(X2 + (size_t)(t + k) * 1024) + lane + 64 * j); }
#pragma unroll
        for (int k = 0; k < 2; ++k)
#pragma unroll
            for (int j = 0; j < 2; ++j) { pg8::f32x4 lo, hi; pg8::bf8_to_f32(q[k][j], lo, hi);
                pg8::f32x4* o = (pg8::f32x4*)(out + (size_t)(t + k) * 1024) + 2 * lane + 128 * j;
                o[0] = lo * g0[j] * r[k]; o[1] = hi * g1[j] * r[k]; }
    }
}
}

namespace {
constexpr int MLPW_W2 = 33 * 64, MLPW_W3 = MLPW_W2 + 4096, MLPW_B = MLPW_W3 + 4096, MLPW_N = MLPW_B + 256;
__device__ __forceinline__ float filt_z(int l, int j) {
    if (j == 0) return (float)((double)l / (double)(L - 1));
    const int i = (j - 1) & 15;
    const double band = 1e-4 + (double)i * ((15.0 - 1e-4) / 15.0);
    double rev = (double)l * band / (double)L;
    rev -= floor(rev);
    const float ang = (float)(rev * 6.283185307179586);
    return (j <= 16) ? cosf(ang) : -sinf(ang);
}
__device__ __forceinline__ void filter_mlp_rows2(const LAS float* wl, float* h3out, LAS float* scr, int l0, int l1, int j) {
    LAS float* za = scr; LAS float* zb = scr + 64;
    if (j < FEMB) { za[j] = filt_z(l0, j); zb[j] = filt_z(l1, j); }
    asm volatile("s_waitcnt lgkmcnt(0)" ::: "memory");
    const float a = wl[MLPW_B + 192 + j];
    float s0 = wl[MLPW_B + j], s1 = s0;
#pragma unroll 11
    for (int i = 0; i < FEMB; ++i) { const float w = wl[i * 64 + j]; s0 += za[i] * w; s1 += zb[i] * w; }
    asm volatile("s_waitcnt lgkmcnt(0)" ::: "memory");
    za[j] = sinf(a * s0); zb[j] = sinf(a * s1);
    asm volatile("s_waitcnt lgkmcnt(0)" ::: "memory");
    s0 = wl[MLPW_B + 64 + j]; s1 = s0;
#pragma unroll 8
    for (int i = 0; i < FHID; ++i) { const float w = wl[MLPW_W2 + i * 64 + j]; s0 += za[i] * w; s1 += zb[i] * w; }
    asm volatile("s_waitcnt lgkmcnt(0)" ::: "memory");
    za[j] = sinf(a * s0); zb[j] = sinf(a * s1);
    asm volatile("s_waitcnt lgkmcnt(0)" ::: "memory");
    s0 = wl[MLPW_B + 128 + j]; s1 = s0;
#pragma unroll 8
    for (int i = 0; i < FHID; ++i) { const float w = wl[MLPW_W3 + i * 64 + j]; s0 += za[i] * w; s1 += zb[i] * w; }
    h3out[l0 * FHID + j] = sinf(a * s0); h3out[l1 * FHID + j] = sinf(a * s1);
    asm volatile("s_waitcnt lgkmcnt(0)" ::: "memory");
}
typedef float f32x16_t __attribute__((ext_vector_type(16)));
__device__ __forceinline__ void stage_h3_rows32(const float* h3, int row0, LAS float* scr, int lane) {
#pragma unroll
    for (int i = 0; i < 8; ++i) { const int e = 4 * (lane + 64 * i), r = e >> 6, jj = e & 63;
        if (row0 + r < 4096) { const pg8::f32x4 v = *(const pg8::f32x4*)(h3 + (size_t)(row0 + r) * 64 + jj);
            LAS float* d = scr + r * 65 + jj; d[0] = v[0]; d[1] = v[1]; d[2] = v[2]; d[3] = v[3]; } }
}
__device__ __forceinline__ void filter_tables(const float* h3, const float* w4, const float* decay, float* fsum, float* fdif, LAS float* scr, int gw, int NGW, int lane) {
    const int r = lane & 31, h = lane >> 5;
    for (int it = gw; it < 2048; it += NGW) {
        const int c0 = (it & 31) * 32, nbase = (it >> 5) * 64;
        float af[32], ab[32];
#pragma unroll
        for (int kk = 0; kk < 32; ++kk) { af[kk] = w4[(2 * kk + h) * 2048 + c0 + r]; ab[kk] = w4[(2 * kk + h) * 2048 + 1024 + c0 + r]; }
        float dcf[16], dcb[16];
#pragma unroll
        for (int q = 0; q < 16; ++q) { const int c = c0 + (q & 3) + 8 * (q >> 2) + 4 * h; dcf[q] = fabsf(decay[c]); dcb[q] = fabsf(decay[1024 + c]); }
#pragma unroll 1
        for (int half = 0; half < 2; ++half) {
            const int n0 = nbase + 32 * half, n = n0 + r, nb = n ? 4096 - n : 0;
            stage_h3_rows32(h3, n0, scr, lane);
            stage_h3_rows32(h3, 4096 - n0 - 31, scr + 32 * 65, lane);
            asm volatile("s_waitcnt lgkmcnt(0)" ::: "memory");
            f32x16_t accF, accB;
#pragma unroll
            for (int q = 0; q < 16; ++q) { accF[q] = 0.f; accB[q] = 0.f; }
#pragma unroll
            for (int kk = 0; kk < 32; ++kk) {
                const float bF = scr[r * 65 + 2 * kk + h], bB = scr[32 * 65 + (31 - r) * 65 + 2 * kk + h];
                accF = __builtin_amdgcn_mfma_f32_32x32x2f32(af[kk], bF, accF, 0, 0, 0);
                accB = __builtin_amdgcn_mfma_f32_32x32x2f32(ab[kk], bB, accB, 0, 0, 0);
            }
            const float tf = (float)n * (1.0f / 4095.0f), tb = (float)nb * (1.0f / 4095.0f);
#pragma unroll
            for (int q = 0; q < 16; ++q) { const int c = c0 + (q & 3) + 8 * (q >> 2) + 4 * h;
                const float hf = accF[q] * expf(-tf * dcf[q]);
                const float hb = n ? accB[q] * expf(-tb * dcb[q]) : 0.f;
                fsum[(size_t)c * 4096 + n] = hf + hb;
                fdif[(size_t)c * 4096 + n] = hf - hb; }
            asm volatile("s_waitcnt lgkmcnt(0)" ::: "memory");
        }
    }
}
#define RLX_AGENT __ATOMIC_RELAXED, __HIP_MEMORY_SCOPE_AGENT
#define XB_TMO      128
#define XB_XCNT(j)  (256  + 64 * (j))
#define XB_XSUB(j)  (1280 + 64 * (j))
#define XB_XGEN(j)  (2304 + 64 * (j))
#define XB_TOP      3328
#define XB_TOPGEN   3392
#define XCD_BAR_WORDS 3456
#define XB_SPIN_CAP (1u << 18)

__device__ __forceinline__ unsigned xb_ld(unsigned* p)              { return __hip_atomic_load(p, __ATOMIC_RELAXED, __HIP_MEMORY_SCOPE_AGENT); }
__device__ __forceinline__ unsigned xb_add(unsigned* p, unsigned v) { return __hip_atomic_fetch_add(p, v, __ATOMIC_RELAXED, __HIP_MEMORY_SCOPE_AGENT); }
__device__ __forceinline__ unsigned xb_xcc_id() { return (unsigned)__builtin_amdgcn_s_getreg((3 << 11) | 20) & 0xFu; }
#define XB_SPIN(cond, bar) do { unsigned _sp = 0; while (cond) { __builtin_amdgcn_s_sleep(1); \
    if ((++_sp & 255u) == 0u) { if (xb_ld(&(bar)[XB_TMO])) break; if (_sp > XB_SPIN_CAP) { atomicAdd(&(bar)[XB_TMO], 1u); break; } } } } while (0)

struct XcdBarrier {
    unsigned* bar; unsigned x;
    volatile LAS unsigned* st;
};

__device__ __forceinline__ XcdBarrier xcd_barrier_post(unsigned* bar, volatile LAS unsigned* st) {
    XcdBarrier b; b.bar = bar; b.x = xb_xcc_id(); b.st = st;
    if (threadIdx.x == 0) (void)xb_add(&bar[XB_XCNT(b.x)], 1u);
    return b;
}
__device__ __forceinline__ void xcd_barrier_complete(unsigned* bar, unsigned x, unsigned& nloc, unsigned& nx) {
    const unsigned G = gridDim.x * gridDim.y * gridDim.z;
    unsigned sum, cnt, mine, sp = 0u;
    for (;;) {
        sum = 0u; cnt = 0u; mine = 0u;
#pragma unroll
        for (unsigned j = 0; j < 16; ++j) { const unsigned c = xb_ld(&bar[XB_XCNT(j)]); sum += c; cnt += (c > 0u) ? 1u : 0u; mine = (j == x) ? c : mine; }
        if (sum == G) break;
        __builtin_amdgcn_s_sleep(1);
        if ((++sp & 255u) == 0u) { if (xb_ld(&bar[XB_TMO])) break; if (sp > XB_SPIN_CAP) { atomicAdd(&bar[XB_TMO], 1u); break; } }
    }
    nloc = mine > 0u ? mine : 1u; nx = cnt > 0u ? cnt : 1u;
}

__device__ __forceinline__ void xcd_barrier(const XcdBarrier& b) {
    asm volatile("s_waitcnt vmcnt(0)" ::: "memory");
    block_sync();
    if (threadIdx.x == 0) {
        unsigned* bar = b.bar;
        __builtin_amdgcn_s_waitcnt(0);
        unsigned nloc = b.st[0], nx = b.st[1];
        if (nloc == 0u) { xcd_barrier_complete(bar, b.x, nloc, nx); b.st[0] = nloc; b.st[1] = nx; }
        const unsigned old = xb_add(&bar[XB_XSUB(b.x)], 1u);
        const unsigned gen = old / nloc;
        if (old + 1u == (gen + 1u) * nloc) {
            __builtin_amdgcn_fence(__ATOMIC_RELEASE, "agent");
            asm volatile("s_waitcnt vmcnt(0)" ::: "memory");
            const unsigned og = xb_add(&bar[XB_TOP], 1u);
            const unsigned tg = og / nx;
            if (og + 1u == (tg + 1u) * nx) xb_add(&bar[XB_TOPGEN], 1u);
            else XB_SPIN(xb_ld(&bar[XB_TOPGEN]) == tg, bar);
            __builtin_amdgcn_fence(__ATOMIC_ACQUIRE, "agent");
            xb_add(&bar[XB_XGEN(b.x)], 1u);
            asm volatile("s_waitcnt vmcnt(0)" ::: "memory");
        } else {
            XB_SPIN(xb_ld(&bar[XB_XGEN(b.x)]) == gen, bar);
            __builtin_amdgcn_fence(__ATOMIC_ACQUIRE, "agent");
            asm volatile("s_waitcnt vmcnt(0)" ::: "memory");
        }
    }
    block_sync();
}

constexpr size_t MiB = 1u << 20;
constexpr int M = NB * L;
constexpr size_t WS_VSS = 0, WS_XSS = 64 * 1024, WS_X2SS = 128 * 1024, WS_TTAB = 192 * 1024, WS_BAR = 256 * 1024, WS_PCNT = 272 * 1024, WS_H3 = 1 * MiB;
constexpr size_t WS_WTA = 2 * MiB, WS_WTB = 10 * MiB, WS_PAB = 16 * MiB, WS_WO = 20 * MiB;
constexpr size_t WS_FSUM = 24 * MiB, WS_WUP = 24 * MiB, WS_WDN = 249 * MiB;
constexpr size_t WS_HYT = 41 * MiB;
constexpr size_t WS_X1B = 41 * MiB, WS_MRG = 105 * MiB;
constexpr size_t WS_YAB = 169 * MiB;
constexpr size_t WS_FDIF = 233 * MiB;
constexpr size_t WS_AP = 73 * MiB, WS_GP = 161 * MiB;
static_assert(WS_GP + (size_t)M * FH * 2 <= 256 * MiB && WS_AP + (size_t)M * FH * 2 <= WS_GP && WS_FDIF + 16 * MiB <= 256 * MiB && WS_WDN + (size_t)D * FH * 2 <= 256 * MiB && WS_WUP + (size_t)2 * FH * D * 2 <= WS_HYT, "d_ws map");
constexpr int LDS_BYTES = 155648;
static_assert(HY_LDS_END + 256 <= LDS_BYTES, "LDS map");
constexpr int NPH = 8;

struct MegaArgs { const float* in[27]; float* out; unsigned char* ws; int ph_lo, ph_hi; WJobs wj; };

__global__ void __launch_bounds__(512, 2) __attribute__((target("no-packed-fp32-ops"))) mega_fwd(MegaArgs a) {
    extern __shared__ __attribute__((aligned(16))) unsigned char lds_raw[];
    LAS unsigned char* lds = (LAS unsigned char*)lds_raw;
    cg::grid_group grid = cg::this_grid();
    const int wave = __builtin_amdgcn_readfirstlane((int)threadIdx.x >> 6);
    const int G = gridDim.x, bid = blockIdx.x, gw = bid * 8 + wave, NGW = G * 8;
#define FRESH_TID int lane; asm volatile("v_mbcnt_lo_u32_b32 %0, -1, 0\n\tv_mbcnt_hi_u32_b32 %0, -1, %0" : "=v"(lane)); const int tid = wave * 64 + lane; (void)tid
    unsigned char* ws = a.ws;
    const float* x = a.in[0];
    float* vss = (float*)(ws + WS_VSS); float* xss = (float*)(ws + WS_XSS); float* x2ss = (float*)(ws + WS_X2SS);
    cfv* Ttab = (cfv*)(ws + WS_TTAB); float* h3 = (float*)(ws + WS_H3);
    bf16* WtA = (bf16*)(ws + WS_WTA); bf16* WtB = (bf16*)(ws + WS_WTB); bf16* PabT = (bf16*)(ws + WS_PAB); bf16* WoT = (bf16*)(ws + WS_WO);
    bf16* WupT = (bf16*)(ws + WS_WUP); bf16* WdnT = (bf16*)(ws + WS_WDN);
    float* fsum = (float*)(ws + WS_FSUM); float* fdif = (float*)(ws + WS_FDIF);
    bf16* hyvT = (bf16*)(ws + WS_HYT); bf16* yaT = hyvT + (size_t)1024 * M; bf16* vT = hyvT + (size_t)3072 * M;
    bf16* YAB = (bf16*)(ws + WS_YAB); bf16* h1 = YAB; bf16* Ub = YAB + 1024;
    bf16* Gb = (bf16*)a.out;
    bf16* mrg = (bf16*)(ws + WS_MRG); bf16* X1b = (bf16*)(ws + WS_X1B); float* X1 = a.out;
    bf16* APb = (bf16*)(ws + WS_AP); bf16* GPb = (bf16*)(ws + WS_GP);
    const int lo = a.ph_lo, hi = a.ph_hi;
#define IN(k) (lo <= (k) && (k) < hi)
    for (int u = (int)threadIdx.x; u < 16; u += 512) ((LAS unsigned*)(lds + LDS_BYTES - 256))[u] = 0u;
    block_sync();
    XcdBarrier xbar = xcd_barrier_post((unsigned*)(ws + WS_BAR), (volatile LAS unsigned*)(lds + LDS_BYTES - 256));
#ifdef MK_PROBE
#define STAMP(i) do { if (threadIdx.x == 0) ((volatile LAS unsigned long long*)(lds + LDS_BYTES - 128))[i] = __builtin_amdgcn_s_memrealtime(); } while (0)
#else
#define STAMP(i) do { } while (0)
#endif
    STAMP(0);
#define SEAM(k) do { if (IN(k) && IN((k) + 1)) xcd_barrier(xbar); STAMP((k) + 1); } while (0)
    if (a.ph_hi > NPH) grid.sync();

    if (IN(0)) { FRESH_TID;
        p0_weights(a.wj, 0, 8, (LAS float*)lds + wave * 4096, gw, NGW, lane);
        for (int m = 4 * gw; m < M; m += 4 * NGW) rms_rows4_to_bf16(x + (size_t)m * 1024, a.in[1], h1 + (size_t)m * 2048, 2048, lane);
        for (int i = bid * 512 + tid; i < 3 * M; i += G * 512) vss[i] = 0.f;
        block_sync();
        { LAS float* wl = (LAS float*)lds;
          for (int i = tid; i < MLPW_N; i += 512) { float v;
              if (i < MLPW_W2) v = a.in[5][i]; else if (i < MLPW_W3) v = a.in[7][i - MLPW_W2]; else if (i < MLPW_B) v = a.in[9][i - MLPW_W3];
              else { const int q = i - MLPW_B; v = q < 64 ? a.in[6][q] : q < 128 ? a.in[8][q - 64] : q < 192 ? a.in[10][q - 128] : a.in[11][q - 192]; }
              wl[i] = v; }
          block_sync();
          for (int l = 2 * gw; l < L; l += 2 * NGW) filter_mlp_rows2(wl, h3, (LAS float*)(lds + 65536) + wave * 128, l, l + 1, lane); }
        for (int m = bid * 512 + tid; m < 4096; m += G * 512) { const float ang = (float)m / 4096.0f; Ttab[m] = (cfv){cospif(ang), -sinpif(ang)}; }
    }
    SEAM(0);
    if (IN(1)) { FRESH_TID;
        { pg8::Gemm g{WtA, h1, 4096, M, 1024, 1024, 2048}; pg8::StaticOrder S; S.init(4096, M, G, bid);
          pg8::EpiHyT E{hyvT, M, vss};
          pg8::gemm_phase<pg8::EpiHyT, pg8::StaticOrder, true, true>(lds, g, S, E, tid); }
        STAMP(11);
        { pg8::Gemm g{h1, WtB, M, 3072, 1024, 2048, 1024}; pg8::StaticOrder S; S.init(M, 3072, G, bid);
          pg8::EpiUG E{Ub, Gb, 2048};
          pg8::gemm_phase<pg8::EpiUG, pg8::StaticOrder, true, true>(lds, g, S, E, tid); }
        STAMP(12);
        filter_tables(h3, a.in[12], a.in[13], fsum, fdif, (LAS float*)(lds + wave * 17408), gw, NGW, lane);
    }
    SEAM(1);
    if (IN(2)) { FRESH_TID;
        HyArgs H; H.hyT = hyvT; H.yaT = yaT; H.fsum = fsum; H.fdif = fdif; H.cw = a.in[3]; H.cb = a.in[4]; H.skip = a.in[14]; H.T = Ttab;
        H.TS = M; H.npairs = 2; H.off00 = 0; H.off01 = L; H.off10 = 2 * L; H.off11 = 3 * L;
        hyena_phase(lds, H, bid, G, tid, wave);
        block_sync();
        STAMP(13);
        SguArgs Sg; Sg.vT = vT; Sg.U = Ub; Sg.vss = vss; Sg.ws = a.in[16]; Sg.bs = a.in[17]; Sg.gn = a.in[15]; Sg.TS = M; Sg.ldu = 2048;
        sgu_phase(lds, Sg, bid, G, tid, wave);
    }
    SEAM(2);
    if (IN(3)) { FRESH_TID;
        p0_weights(a.wj, 8, 9, (LAS float*)lds + wave * 4096, gw, NGW, lane);
        block_sync();
        pg8::Gemm g{Ub, PabT, M, 1024, 2048, 2048, 2048, yaT, M, 16}; pg8::StaticOrder S; S.init(M, 1024, G, bid);
        pg8::EpiMerge E{Gb, mrg};
        pg8::gemm_phase<pg8::EpiMerge, pg8::StaticOrder, true, true>(lds, g, S, E, tid);
    }
    SEAM(3);
    if (IN(4)) { FRESH_TID;
        pg8::Gemm g{mrg, WoT, M, 1024, 1024, 1024, 1024}; pg8::StaticOrder S; S.init(M, 1024, G, bid);
        pg8::EpiResid<true> E{x, nullptr, nullptr, X1b, xss};
        pg8::gemm_phase<pg8::EpiResid<true>, pg8::StaticOrder, true, true>(lds, g, S, E, tid);
    }
    SEAM(4);
    if (IN(5)) { FRESH_TID;
        pg8::Gemm g{X1b, WupT, M, 2 * FH, 1024, 1024, 1024}; pg8::StaticOrder S; S.init(68 * 256, 2 * FH, G, bid);
        pg8::EpiUpAct E{GPb, (LAS float*)(lds + 131072), xss, a.in[23], a.in[24]};
        pg8::gemm_phase<pg8::EpiUpAct, pg8::StaticOrder, true, true>(lds, g, S, E, tid);
    }
    SEAM(5);
    if (IN(6)) { FRESH_TID;
        pg8::Gemm g{GPb, WdnT, M, 1024, FH, FH, FH}; pg8::StaticOrder S; S.init(M, 1024, G, bid);
        if (G == 256) { pg8::EpiResidNorm E{X1b, a.out, x2ss, a.in[26], (unsigned*)(ws + WS_PCNT)};
            pg8::gemm_phase<pg8::EpiResidNorm, pg8::StaticOrder, true, true>(lds, g, S, E, tid); }
        else { pg8::EpiResid<false> E{nullptr, X1b, nullptr, X1b, x2ss};
            pg8::gemm_phase<pg8::EpiResid<false>, pg8::StaticOrder, true, true>(lds, g, S, E, tid); }
    }
    if (G != 256) { SEAM(6);
        if (IN(7)) { FRESH_TID; final_norm(X1b, x2ss, a.in[26], a.out, M, gw, NGW, lane); } }
    STAMP(7); STAMP(8);
#ifdef MK_PROBE
#ifndef MK_PROBE_A
#define MK_PROBE_A MK_PROBE
#define MK_PROBE_B (MK_PROBE + 1)
#endif
    if (threadIdx.x == 0) { volatile LAS unsigned long long* ts = (volatile LAS unsigned long long*)(lds + LDS_BYTES - 128);
        const unsigned long long dt = 2ull * (ts[MK_PROBE_B] - ts[MK_PROBE_A]), t0 = __builtin_amdgcn_s_memrealtime();
        while (__builtin_amdgcn_s_memrealtime() - t0 < dt) __builtin_amdgcn_s_sleep(8); }
    block_sync();
#endif
#undef IN
#undef SEAM
}
}

#ifndef MK_CUTS
#define MK_CUTS 0
#endif
extern "C" void kernel_launch(void* const* d_in, const int* in_sizes, int n_in, void* d_out, int out_size, void* d_ws, size_t ws_size, hipStream_t stream) {
    static int grid = 0;
    if (grid == 0) {
        int dev = 0, cus = 0, per_cu = 0;
        hipGetDevice(&dev);
        hipDeviceGetAttribute(&cus, hipDeviceAttributeMultiprocessorCount, dev);
        hipFuncSetAttribute((const void*)mega_fwd, hipFuncAttributeMaxDynamicSharedMemorySize, LDS_BYTES);
        hipOccupancyMaxActiveBlocksPerMultiprocessor(&per_cu, (const void*)mega_fwd, 512, LDS_BYTES);
        if (per_cu < 1) { fprintf(stderr, "kernel_launch: occupancy query says %d blocks per CU\n", per_cu); per_cu = 1; }
        grid = cus * 1;
        (void)hipGetLastError();
    }
    hipMemsetAsync((char*)d_ws + WS_BAR, 0, 32 * 1024, stream);
    MegaArgs a{};
    for (int i = 0; i < 27; ++i) a.in[i] = (const float*)d_in[i];
    a.out = (float*)d_out; a.ws = (unsigned char*)d_ws;
    { unsigned char* ws = (unsigned char*)d_ws;
      bf16* WtA = (bf16*)(ws + WS_WTA); bf16* WtB = (bf16*)(ws + WS_WTB); bf16* PabT = (bf16*)(ws + WS_PAB); bf16* WoT = (bf16*)(ws + WS_WO); bf16* WupT = (bf16*)(ws + WS_WUP); bf16* WdnT = (bf16*)(ws + WS_WDN);
    a.wj.j[0] = WJob{(const float*)d_in[2], nullptr, WtA, 1024, INW, 0, 3072, 1024, 0, 0, 0};
    a.wj.j[1] = WJob{(const float*)d_in[2], nullptr, WtA, 1024, INW, 4096, 1024, 1024, 3072, 0, 0};
    a.wj.j[2] = WJob{(const float*)d_in[2], nullptr, WtB, 1024, INW, 3072, 1024, 1024, 0, 0, 0};
    a.wj.j[3] = WJob{(const float*)d_in[2], nullptr, WtB, 1024, INW, 5120, 2048, 1024, 1024, 0, 0};
    a.wj.j[4] = WJob{(const float*)d_in[18], nullptr, PabT, 1024, 1024, 0, 1024, 2048, 0, 0, 0};
    a.wj.j[5] = WJob{(const float*)d_in[19], nullptr, PabT, 1024, 1024, 0, 1024, 2048, 0, 1024, 0};
    a.wj.j[6] = WJob{(const float*)d_in[20], nullptr, WoT, 1024, 1024, 0, 1024, 1024, 0, 0, 0};
        a.wj.j[7] = WJob{(const float*)d_in[25], nullptr, WdnT, FH, 1024, 0, 1024, FH, 0, 0, 0};
    a.wj.j[8] = WJob{(const float*)d_in[22], (const float*)d_in[21], WupT, 1024, 2 * FH, 0, 2 * FH, 1024, 0, 0, 1};

    }
#if MK_CUTS
    for (int p = 0; p < NPH; ++p) { a.ph_lo = p; a.ph_hi = p + 1; hipLaunchKernelGGL(mega_fwd, dim3(grid), dim3(512), LDS_BYTES, stream, a); }
#else
    a.ph_lo = 0; a.ph_hi = NPH;
    void* args[] = {&a};
    hipError_t e = hipLaunchCooperativeKernel((const void*)mega_fwd, dim3(grid), dim3(512), args, LDS_BYTES, stream);
    if (e != hipSuccess) fprintf(stderr, "cooperative launch failed: %s (grid %d)\n", hipGetErrorString(e), grid);
#endif
}
```

```cpp
#include <hip/hip_runtime.h>
#include <hip/hip_cooperative_groups.h>
#include <math.h>
#include <stdint.h>
#include <cstdio>
namespace cg = cooperative_groups;
namespace pg8 {
#define PG8_LAS __attribute__((address_space(3)))
typedef unsigned short bf16_t;
typedef short bf16x8 __attribute__((ext_vector_type(8)));
typedef float f32x4 __attribute__((ext_vector_type(4)));
typedef unsigned u32x4 __attribute__((ext_vector_type(4)));
typedef short s16x4 __attribute__((ext_vector_type(4)));
constexpr int BM = 256, BK = 64, HALF = 128, HTB = HALF * BK * 2  , STAGE_BYTES = 8 * HTB, NXCD = 8, WGM = 8;

__host__ __device__ __forceinline__ int lds_byte(int r, int c) { const int st = (r >> 4) * 2 + (c >> 5), rr = r & 15, cc = c & 31, ob = rr * 64 + cc * 2; return st * 1024 + (ob ^ (((ob >> 9) & 1) << 5)); }
__host__ __device__ __forceinline__ void stage_rc(int b, int& R, int& C) { const int st = b / 1024, sb = b % 1024, swz = sb ^ (((sb >> 9) & 1) << 5); R = (st >> 1) * 16 + swz / 64; C = (st & 1) * 32 + (swz % 64) / 2; }
__host__ __device__ __forceinline__ int perm32(int rho) { const int n = rho >> 4, i = rho & 15; return 8 * (i >> 2) + 4 * n + (i & 3); }

struct Unit { int pm, pn; };
__host__ __device__ __forceinline__ int ovl_row(int pm) { const int seq = pm / 17, i = pm % 17; int s = 254 * i - 1; s = s < 0 ? 0 : (s > 3840 ? 3840 : s); return seq * 4096 + s; }
struct Gemm { const bf16_t* A; const bf16_t* Bt; int M, N, K, lda, ldb; const bf16_t* At; int ldt, ntr; };

struct StaticOrder {
    int nM, nN, nwg, G, c;
    __host__ __device__ __forceinline__ void init(int M, int N, int G_, int c_) { nM = M / BM; nN = N / BM; nwg = nM * nN; G = G_; c = c_; }
    __host__ __device__ __forceinline__ bool next(int i, Unit& u) const {
        const long L = (long)i * G + c; if (L >= nwg) return false;
        int wgid = (int)L; { const int q = nwg / NXCD, r = nwg % NXCD, xcd = wgid % NXCD, off = wgid / NXCD; wgid = (xcd < r ? xcd * (q + 1) : r * (q + 1) + (xcd - r) * q) + off; }
        const int nig = WGM * nN, gid = wgid / nig, fm = gid * WGM, gsz = (nM - fm) < WGM ? (nM - fm) : WGM;
        u.pm = fm + ((wgid % nig) % gsz); u.pn = (wgid % nig) / gsz; return true;
    }
    __device__ __forceinline__ void a_ready(const Unit&) const {}
    __device__ __forceinline__ void done(const Unit&) const {}
};

__device__ __forceinline__ unsigned cvt_pk_bf16(float lo, float hi) { unsigned r; asm volatile("v_cvt_pk_bf16_f32 %0, %1, %2" : "=v"(r) : "v"(lo), "v"(hi)); return r; }
typedef float f32x2 __attribute__((ext_vector_type(2)));
__device__ __forceinline__ f32x2 gelu_pk(f32x2 v) {
    const f32x2 av = __builtin_elementwise_abs(v), d = av * 0.2316418882f + 1.0f;
    f32x2 t; t.x = __builtin_amdgcn_rcpf(d.x); t.y = __builtin_amdgcn_rcpf(d.y);
    f32x2 q = t * 0.5307027145f + (-0.7265760135f); q = q * t + 0.7107068705f; q = q * t + (-0.142248368f); q = q * t + 0.127414796f; q = q * t;
    const f32x2 s = (v * v) * (-0.72134752044f);
    f32x2 e; e.x = __builtin_amdgcn_exp2f(s.x); e.y = __builtin_amdgcn_exp2f(s.y);
    const f32x2 m = v * (q * e), r = v - m;
    f32x2 o; o.x = v.x < 0.f ? m.x : r.x; o.y = v.y < 0.f ? m.y : r.y; return o;
}

template <int ACT  > struct EpiBf16 {
    static constexpr bool PERM = true, AFTER_DRAIN = false, MID = false, OVL = false, ATR = false; static_assert(ACT == 0 || ACT == 1, "EpiBf16: ACT is 0 (none) or 1 (gelu_pk)");
    bf16_t* O; int ldc; const float* bias; int split_cols; size_t split_stride; float scale0;
    __device__ __forceinline__ void operator()(const f32x4 (&acc)[2][2][4][2], const Unit& u, int wr, int wc, int fr, int fq) const {
        const int row0 = u.pm * BM + wr * 64 + fr; int colt = u.pn * BM; bf16_t* base = O;
        float sc = 1.f; if (split_cols) { const int t = colt / split_cols; base += (size_t)t * split_stride; colt -= t * split_cols; if (t == 0) sc = scale0; }
        const int col0 = colt + wc * 32 + 8 * fq, bcol0 = u.pn * BM + wc * 32 + 8 * fq;
        f32x4 bv[2][2];
#pragma unroll
        for (int bj = 0; bj < 2; ++bj)
#pragma unroll
            for (int n = 0; n < 2; ++n) bv[bj][n] = bias ? *(const f32x4*)(bias + bcol0 + bj * HALF + 4 * n) : (f32x4){0.f, 0.f, 0.f, 0.f};
#pragma unroll
        for (int ai = 0; ai < 2; ++ai)
#pragma unroll
            for (int m = 0; m < 4; ++m) { bf16_t* rowp = base + (size_t)(row0 + ai * HALF + m * 16) * ldc + col0;
#pragma unroll
                for (int bj = 0; bj < 2; ++bj) { f32x4 v0 = acc[ai][bj][m][0] + bv[bj][0], v1 = acc[ai][bj][m][1] + bv[bj][1];
                    if (ACT == 1) { f32x2 a = gelu_pk((f32x2){v0[0], v0[1]}), b = gelu_pk((f32x2){v0[2], v0[3]}), c = gelu_pk((f32x2){v1[0], v1[1]}), d = gelu_pk((f32x2){v1[2], v1[3]});
                        v0 = (f32x4){a.x, a.y, b.x, b.y}; v1 = (f32x4){c.x, c.y, d.x, d.y}; }
                    v0 = v0 * sc; v1 = v1 * sc; u32x4 w; w.x = cvt_pk_bf16(v0[0], v0[1]); w.y = cvt_pk_bf16(v0[2], v0[3]); w.z = cvt_pk_bf16(v1[0], v1[1]); w.w = cvt_pk_bf16(v1[2], v1[3]);
                    *(u32x4*)(rowp + bj * HALF) = w; } }
    }
};

struct EpiF32 {
    static constexpr bool PERM = false, AFTER_DRAIN = false, MID = false, OVL = false, ATR = false;
    float* C; int ldc; const float* bias;
    __device__ __forceinline__ void operator()(const f32x4 (&acc)[2][2][4][2], const Unit& u, int wr, int wc, int fr, int fq) const {
        const int row0 = u.pm * BM + wr * 64 + fr, col0 = u.pn * BM + wc * 32 + 4 * fq;
        f32x4 bv[2][2];
#pragma unroll
        for (int bj = 0; bj < 2; ++bj)
#pragma unroll
            for (int n = 0; n < 2; ++n) bv[bj][n] = bias ? *(const f32x4*)(bias + col0 + bj * HALF + n * 16) : (f32x4){0.f, 0.f, 0.f, 0.f};
#pragma unroll
        for (int ai = 0; ai < 2; ++ai)
#pragma unroll
            for (int m = 0; m < 4; ++m) { float* rowp = C + (size_t)(row0 + ai * HALF + m * 16) * ldc + col0;
#pragma unroll
                for (int bj = 0; bj < 2; ++bj)
#pragma unroll
                    for (int n = 0; n < 2; ++n) *(f32x4*)(rowp + bj * HALF + n * 16) = acc[ai][bj][m][n] + bv[bj][n]; }
    }
};

template <class Epi, class Sched, bool ALIGN_EPI = false, bool SP2 = false>
__device__ __forceinline__ void gemm_phase(PG8_LAS unsigned char* lds, const Gemm g, const Sched& S, const Epi& E, const int tid) {
    const int wid = __builtin_amdgcn_readfirstlane(tid >> 6), lane = tid & 63, wr = wid >> 2, wc = wid & 3, fr = lane & 15, fq = lane >> 4;
    const int K = g.K, nt = K / BK;
    unsigned voffA[2], voffB[2];
#pragma unroll
    for (int i = 0; i < 2; ++i) { int R, C; stage_rc(tid * 16 + i * 8192, R, C); const int Rb = Epi::PERM ? ((R & ~31) + perm32(R & 31)) : R;
        voffA[i] = (unsigned)(R * g.lda + C) * 2u; voffB[i] = (unsigned)(Rb * g.ldb + C) * 2u; }
    unsigned voffT[2] = {0u, 0u}; unsigned trb = 0u, trx = 0u; const int ntr = Epi::ATR ? g.ntr : 0; const size_t kstepT = (size_t)BK * g.ldt * 2;
    if constexpr (Epi::ATR) {
#pragma unroll
        for (int i = 0; i < 2; ++i) { const int r = 4 * (i * 8 + wid) + (lane >> 4), pch = lane & 15, ch = pch ^ (((r & 3) << 2) | ((r >> 2) & 3)); voffT[i] = (unsigned)(r * g.ldt + 8 * ch) * 2u; }
        const int q = fr >> 2, pp = fr & 3, f0 = (q << 2) | ((2 * fq) & 3);
        trb = (unsigned)(2048 * fq + 256 * q + 8 * (pp & 1)); trx = 16u * (unsigned)(((8 * wr) | (pp >> 1)) ^ f0);
    }
    const size_t kstep = (size_t)(BK * 2);
    const size_t hstepA = (size_t)HALF * g.lda * 2, hstepB = (size_t)HALF * g.ldb * 2;
    const size_t tstepA = 2 * hstepA, tstepB = 2 * hstepB;
    const unsigned ldsw = (unsigned)wid * 1024u;
    const int aoff = lds_byte(wr * 64 + fr, fq * 8), boff = lds_byte(wc * 32 + fr, fq * 8);
#define PG8_SA(b, h) (((b) * 2 + (h)) * HTB)
#define PG8_SB(b, h) ((4 + (b) * 2 + (h)) * HTB)
#define PG8_STAGE(bufoff, gbase, voff) do { _Pragma("unroll") for (int _i = 0; _i < 2; ++_i) \
        __builtin_amdgcn_global_load_lds((const unsigned*)((const char*)(gbase) + (voff)[_i]), (PG8_LAS unsigned*)(lds + (bufoff) + ldsw + _i * 8192), 16, 0, 0); } while (0)
#define PG8_LDA(dst, b, h) do { _Pragma("unroll") for (int m = 0; m < 4; ++m) _Pragma("unroll") for (int k = 0; k < 2; ++k) dst[m][k] = *(const PG8_LAS bf16x8*)(lds + PG8_SA(b, h) + aoff + m * 2048 + k * 1024); } while (0)
#define PG8_STAGE_A(bufoff, nbase, tbase, tile, half) do { if (Epi::ATR && (tile) < ntr) PG8_STAGE(bufoff, (tbase) + (size_t)(tile) * kstepT + (half) * 256, voffT); \
        else PG8_STAGE(bufoff, (nbase) + (size_t)((tile) - ntr) * kstep + (half) * hstepA, voffA); } while (0)
#define PG8_LDA_TR(dst, b, h) do { _Pragma("unroll") for (int m = 0; m < 4; ++m) _Pragma("unroll") for (int k = 0; k < 2; ++k) { \
        const s16x4 lo_ = __builtin_amdgcn_ds_read_tr16_b64_v4i16((PG8_LAS s16x4*)(lds + PG8_SA(b, h) + trb + (trx ^ (unsigned)(32 * m)) + 8192 * k)); \
        const s16x4 hi_ = __builtin_amdgcn_ds_read_tr16_b64_v4i16((PG8_LAS s16x4*)(lds + PG8_SA(b, h) + trb + (trx ^ (unsigned)(32 * m + 16)) + 8192 * k + 1024)); \
        dst[m][k] = __builtin_shufflevector(lo_, hi_, 0, 1, 2, 3, 4, 5, 6, 7); } } while (0)
#define PG8_LDA_X(dst, b, h, tile) do { if (Epi::ATR && (tile) < ntr) PG8_LDA_TR(dst, b, h); else PG8_LDA(dst, b, h); } while (0)
#define PG8_LDB(dst, b, h) do { _Pragma("unroll") for (int n = 0; n < 2; ++n) _Pragma("unroll") for (int k = 0; k < 2; ++k) dst[n][k] = *(const PG8_LAS bf16x8*)(lds + PG8_SB(b, h) + boff + n * 2048 + k * 1024); } while (0)
#define PG8_MMA(ai, bj, At, Bt) do { __builtin_amdgcn_s_setprio(1); _Pragma("unroll") for (int m = 0; m < 4; ++m) _Pragma("unroll") for (int n = 0; n < 2; ++n) _Pragma("unroll") for (int k = 0; k < 2; ++k) \
        acc[ai][bj][m][n] = __builtin_amdgcn_mfma_f32_16x16x32_bf16(Bt[n][k], At[m][k], acc[ai][bj][m][n], 0, 0, 0); __builtin_amdgcn_s_setprio(0); } while (0)
#define PG8_WAIT_V(n) asm volatile("s_waitcnt vmcnt(" #n ")" ::: "memory")
#define PG8_WAIT_L(n) asm volatile("s_waitcnt lgkmcnt(" #n ")" ::: "memory")
#define PG8_BAR __builtin_amdgcn_s_barrier()
#define PG8_SCHED __builtin_amdgcn_sched_barrier(0)
    Unit cur, nxt; int ui = 0;
    if (!S.next(0, cur)) return;
    f32x4 acc[2][2][4][2];
#pragma unroll
    for (int a = 0; a < 2; ++a)
#pragma unroll
        for (int b = 0; b < 2; ++b)
#pragma unroll
            for (int m = 0; m < 4; ++m)
#pragma unroll
                for (int n = 0; n < 2; ++n) acc[a][b][m][n] = (f32x4){0.f, 0.f, 0.f, 0.f};
    bf16x8 At[4][2], B0[2][2], B1[2][2];
    const char* cA = (const char*)g.A + (size_t)(Epi::OVL ? ovl_row(cur.pm) : cur.pm * BM) * (tstepA / BM); const char* cB = (const char*)g.Bt + (size_t)cur.pn * tstepB;
    const char* cT = Epi::ATR ? (const char*)g.At + (size_t)cur.pm * BM * 2 : nullptr;
    S.a_ready(cur);
    if constexpr (SP2) {
        PG8_STAGE(PG8_SB(0, 0), cB, voffB); PG8_STAGE(PG8_SB(0, 1), cB + hstepB, voffB); PG8_STAGE_A(PG8_SA(0, 0), cA, cT, 0, 0); PG8_STAGE_A(PG8_SA(0, 1), cA, cT, 0, 1);
        if (wr == 1) PG8_BAR;
        PG8_WAIT_V(2); PG8_BAR;
        PG8_STAGE(PG8_SB(1, 0), cB + kstep, voffB); PG8_STAGE_A(PG8_SA(1, 0), cA, cT, 1, 0); PG8_STAGE(PG8_SB(1, 1), cB + hstepB + kstep, voffB);
        PG8_WAIT_V(6); PG8_BAR;
    } else {
        PG8_STAGE(PG8_SB(0, 0), cB, voffB); PG8_STAGE(PG8_SA(0, 0), cA, voffA); PG8_STAGE(PG8_SB(0, 1), cB + hstepB, voffB); PG8_STAGE(PG8_SA(0, 1), cA + hstepA, voffA);
        if (wr == 1) PG8_BAR;
        PG8_WAIT_V(4); PG8_BAR;
        PG8_STAGE(PG8_SB(1, 0), cB + kstep, voffB); PG8_STAGE(PG8_SA(1, 0), cA + kstep, voffA); PG8_STAGE(PG8_SB(1, 1), cB + hstepB + kstep, voffB);
        PG8_WAIT_V(6); PG8_BAR;
    }
    for (;;) {
        const bool has_next = S.next(ui + 1, nxt);
        const char* nA = has_next ? (const char*)g.A + (size_t)(Epi::OVL ? ovl_row(nxt.pm) : nxt.pm * BM) * (tstepA / BM) : cA; const char* nB = has_next ? (const char*)g.Bt + (size_t)nxt.pn * tstepB : cB;
        const char* nT = (Epi::ATR && has_next) ? (const char*)g.At + (size_t)nxt.pm * BM * 2 : cT;
        for (int t = 0; t < nt; t += 2) {
            const bool last = (t == nt - 2);
            const char* a1 = cA + (size_t)(t + 1) * kstep;
            const char* a2 = last ? nA : cA + (size_t)(t + 2) * kstep; const char* b2 = last ? nB : cB + (size_t)(t + 2) * kstep;
            const char* a3 = a2 + kstep; const char* b3 = b2 + kstep;
            if (last && has_next) S.a_ready(nxt);
            if constexpr (Epi::MID) { if (t == (nt >> 1)) E.mid(acc, cur, wr, wc, fr, fq); }
            if constexpr (SP2) {
            PG8_LDB(B0, 0, 0); PG8_LDB(B1, 0, 1); PG8_SCHED; PG8_LDA_X(At, 0, 0, t); PG8_STAGE_A(PG8_SA(1, 1), cA, cT, t + 1, 1);
            PG8_WAIT_V(8); PG8_WAIT_L(0); PG8_BAR; PG8_MMA(0, 0, At, B0); PG8_MMA(0, 1, At, B1); PG8_BAR; PG8_SCHED;
            PG8_LDA_X(At, 0, 1, t); PG8_STAGE(PG8_SB(0, 0), b2, voffB); PG8_STAGE(PG8_SB(0, 1), b2 + hstepB, voffB); PG8_STAGE_A(PG8_SA(0, 0), last ? nA : cA, last ? nT : cT, last ? 0 : t + 2, 0);
            PG8_WAIT_V(8); PG8_WAIT_L(0); PG8_BAR; PG8_MMA(1, 0, At, B0); PG8_MMA(1, 1, At, B1); PG8_BAR; PG8_SCHED;
            PG8_LDB(B0, 1, 0); PG8_LDB(B1, 1, 1); PG8_SCHED; PG8_LDA_X(At, 1, 0, t + 1); PG8_STAGE_A(PG8_SA(0, 1), last ? nA : cA, last ? nT : cT, last ? 0 : t + 2, 1);
            PG8_WAIT_V(8); PG8_WAIT_L(0); PG8_BAR; PG8_MMA(0, 0, At, B0); PG8_MMA(0, 1, At, B1); PG8_BAR; PG8_SCHED;
            PG8_LDA_X(At, 1, 1, t + 1); PG8_STAGE(PG8_SB(1, 0), b3, voffB); PG8_STAGE(PG8_SB(1, 1), b3 + hstepB, voffB); PG8_STAGE_A(PG8_SA(1, 0), last ? nA : cA, last ? nT : cT, last ? 1 : t + 3, 0);
            PG8_WAIT_V(8); PG8_WAIT_L(0); PG8_BAR; PG8_MMA(1, 0, At, B0); PG8_MMA(1, 1, At, B1); PG8_BAR; PG8_SCHED;
            } else {
            PG8_LDB(B0, 0, 0); PG8_SCHED; PG8_LDA(At, 0, 0); PG8_STAGE(PG8_SA(1, 1), a1 + hstepA, voffA);
            PG8_WAIT_L(8); PG8_BAR; PG8_WAIT_L(0); PG8_MMA(0, 0, At, B0); PG8_BAR; PG8_SCHED;
            PG8_LDB(B1, 0, 1); PG8_STAGE(PG8_SB(0, 0), b2, voffB);
            PG8_BAR; PG8_WAIT_L(0); PG8_MMA(0, 1, At, B1); PG8_BAR;
            PG8_LDA(At, 0, 1); PG8_STAGE(PG8_SA(0, 0), a2, voffA);
            PG8_BAR; PG8_WAIT_L(0); PG8_MMA(1, 0, At, B0); PG8_BAR; PG8_SCHED;
            PG8_STAGE(PG8_SB(0, 1), b2 + hstepB, voffB);
            PG8_WAIT_V(6); PG8_BAR; PG8_MMA(1, 1, At, B1); PG8_BAR;
            PG8_LDB(B0, 1, 0); PG8_SCHED; PG8_LDA(At, 1, 0); PG8_STAGE(PG8_SA(0, 1), a2 + hstepA, voffA);
            PG8_WAIT_L(8); PG8_BAR; PG8_WAIT_L(0); PG8_MMA(0, 0, At, B0); PG8_BAR; PG8_SCHED;
            PG8_LDB(B1, 1, 1); PG8_STAGE(PG8_SB(1, 0), b3, voffB);
            PG8_BAR; PG8_WAIT_L(0); PG8_MMA(0, 1, At, B1); PG8_BAR;
            PG8_LDA(At, 1, 1); PG8_STAGE(PG8_SA(1, 0), a3, voffA);
            PG8_BAR; PG8_WAIT_L(0); PG8_MMA(1, 0, At, B0); PG8_BAR; PG8_SCHED;
            PG8_STAGE(PG8_SB(1, 1), b3 + hstepB, voffB);
            PG8_WAIT_V(6); PG8_BAR; PG8_MMA(1, 1, At, B1); PG8_BAR;
            }
        }
        if constexpr (ALIGN_EPI) { if (wr == 0) PG8_BAR; }
        if constexpr (!Epi::AFTER_DRAIN) { E(acc, cur, wr, wc, fr, fq); S.done(cur); }
        if (!has_next) break;
#pragma unroll
        for (int a = 0; a < 2; ++a)
#pragma unroll
            for (int b = 0; b < 2; ++b)
#pragma unroll
                for (int m = 0; m < 4; ++m)
#pragma unroll
                    for (int n = 0; n < 2; ++n) acc[a][b][m][n] = (f32x4){0.f, 0.f, 0.f, 0.f};
        cur = nxt; cA = nA; cB = nB; cT = nT; ++ui;
        if constexpr (ALIGN_EPI) { if (wr == 1) PG8_BAR; }
    }
    PG8_WAIT_V(0);
    if constexpr (!ALIGN_EPI) { if (wr == 0) PG8_BAR; }
    PG8_BAR;
    if constexpr (Epi::AFTER_DRAIN) { E.fused(acc, cur, wr, wc, fr, fq, lds, wid, lane); S.done(cur); }
#undef PG8_SA
#undef PG8_SB
#undef PG8_STAGE
#undef PG8_LDA
#undef PG8_LDB
#undef PG8_STAGE_A
#undef PG8_LDA_TR
#undef PG8_LDA_X
#undef PG8_MMA
#undef PG8_WAIT_V
#undef PG8_WAIT_L
#undef PG8_BAR
#undef PG8_SCHED
}
}
namespace {
constexpr int D = 1024, NB = 4, L = 4096, HW = 1024, SW = 1024, INW = 7168, FH = 2816, FHID = 64, FEMB = 33;
constexpr float EPS = 1e-6f;
typedef unsigned short bf16;
__device__ __forceinline__ unsigned f2bf(float f) { unsigned u = __builtin_bit_cast(unsigned, f); return (u + 0x7fffu + ((u >> 16) & 1u)) >> 16; }
__device__ __forceinline__ void block_sync() { __builtin_amdgcn_fence(__ATOMIC_RELEASE, "workgroup"); __builtin_amdgcn_s_barrier(); __builtin_amdgcn_fence(__ATOMIC_ACQUIRE, "workgroup"); }
}
namespace {
#define HD __device__ __forceinline__
#define FFT_OPAQUE(w) asm volatile("" : "+v"((w).x), "+v"((w).y))
#ifndef HD
#define HD inline
#endif
typedef float cfv __attribute__((ext_vector_type(2)));
struct cf { float x, y; };
HD cf cmk(float x, float y) { cf r; r.x = x; r.y = y; return r; }
template <class P> HD cf ldz(P Z, int i) { const cfv t = Z[i]; return cmk(t.x, t.y); }
template <class P> HD void stz(P Z, int i, cf v) { Z[i] = (cfv){v.x, v.y}; }
HD cf cadd(cf a, cf b) { return cmk(a.x + b.x, a.y + b.y); }
HD cf csub(cf a, cf b) { return cmk(a.x - b.x, a.y - b.y); }
HD cf cmul(cf a, cf b) { return cmk(a.x * b.x - a.y * b.y, a.x * b.y + a.y * b.x); }
HD cf cconj(cf a) { return cmk(a.x, -a.y); }
template <bool INV> HD cf mulmi(cf a) { return INV ? cmk(-a.y, a.x) : cmk(a.y, -a.x); }
template <bool INV> HD cf twc(float c, float s) { return INV ? cmk(c, s) : cmk(c, -s); }
HD int fpad(int p) { return p + (p >> 4); }
constexpr int FSUB = 4352;

template <bool INV> HD void dft4(cf& a, cf& b, cf& c, cf& d) {
    const cf t0 = cadd(a, c), t1 = csub(a, c), t2 = cadd(b, d), t3 = mulmi<INV>(csub(b, d));
    a = cadd(t0, t2); b = cadd(t1, t3); c = csub(t0, t2); d = csub(t1, t3);
}
template <bool INV> HD void dft16(cf (&v)[16]) {
    constexpr float C1 = 0.92387953251128674f, S1 = 0.38268343236508977f, R = 0.70710678118654752f;
#pragma unroll
    for (int n0 = 0; n0 < 4; ++n0) dft4<INV>(v[n0], v[n0 + 4], v[n0 + 8], v[n0 + 12]);
    v[1 + 4 * 1] = cmul(v[1 + 4 * 1], twc<INV>(C1, S1));
    v[1 + 4 * 2] = cmul(v[1 + 4 * 2], twc<INV>(R, R));
    v[1 + 4 * 3] = cmul(v[1 + 4 * 3], twc<INV>(S1, C1));
    v[2 + 4 * 1] = cmul(v[2 + 4 * 1], twc<INV>(R, R));
    v[2 + 4 * 2] = mulmi<INV>(v[2 + 4 * 2]);
    v[2 + 4 * 3] = cmul(v[2 + 4 * 3], twc<INV>(-R, R));
    v[3 + 4 * 1] = cmul(v[3 + 4 * 1], twc<INV>(S1, C1));
    v[3 + 4 * 2] = cmul(v[3 + 4 * 2], twc<INV>(-R, R));
    v[3 + 4 * 3] = cmul(v[3 + 4 * 3], twc<INV>(-C1, -S1));
#pragma unroll
    for (int k0 = 0; k0 < 4; ++k0) dft4<INV>(v[4 * k0], v[4 * k0 + 1], v[4 * k0 + 2], v[4 * k0 + 3]);
    cf t;
    t = v[1]; v[1] = v[4]; v[4] = t;   t = v[2]; v[2] = v[8]; v[8] = t;   t = v[3]; v[3] = v[12]; v[12] = t;
    t = v[6]; v[6] = v[9]; v[9] = t;   t = v[7]; v[7] = v[13]; v[13] = t; t = v[11]; v[11] = v[14]; v[14] = t;
}
#ifndef FFT_OPAQUE
#define FFT_OPAQUE(w)
#endif
HD void twiddle16(cf (&v)[16], cf w) {
    FFT_OPAQUE(w);
    cf p = w;
#pragma unroll
    for (int k = 1; k < 16; ++k) { v[k] = cmul(v[k], p); if (k < 15) p = cmul(p, w); }
}
template <bool CONJ> HD void twiddle16t(cf (&v)[16], const cf (&tw)[15]) {
#pragma unroll
    for (int k = 1; k < 16; ++k) v[k] = cmul(v[k], CONJ ? cconj(tw[k - 1]) : tw[k - 1]);
}
HD void twpowers(cf w, cf (&tw)[15]) { tw[0] = w;
#pragma unroll
    for (int k = 1; k < 15; ++k) tw[k] = cmul(tw[k - 1], w); }
template <class P> HD void fwd_pass1(P Z, int t, cf w1) {
    cf v[16]; const int b = t + (t >> 4);
#pragma unroll
    for (int j = 0; j < 16; ++j) v[j] = ldz(Z, b + 272 * j);
    dft16<false>(v); twiddle16(v, w1);
#pragma unroll
    for (int j = 0; j < 16; ++j) stz(Z, b + 272 * j, v[j]);
}
template <class P> HD void fwd_pass2(P Z, int t, cf w2) {
    const int b = 272 * (t >> 4) + (t & 15);
    cf v[16];
#pragma unroll
    for (int j = 0; j < 16; ++j) v[j] = ldz(Z, b + 17 * j);
    dft16<false>(v); twiddle16(v, w2);
#pragma unroll
    for (int j = 0; j < 16; ++j) stz(Z, b + 17 * j, v[j]);
}
template <class P> HD void fwd_pass1t(P Z, int t, const cf (&tw)[15]) {
    cf v[16]; const int b = t + (t >> 4);
#pragma unroll
    for (int j = 0; j < 16; ++j) v[j] = ldz(Z, b + 272 * j);
    dft16<false>(v); twiddle16t<false>(v, tw);
#pragma unroll
    for (int j = 0; j < 16; ++j) stz(Z, b + 272 * j, v[j]);
}
template <class P> HD void fwd_pass2t(P Z, int t, const cf (&tw)[15]) {
    const int b = 272 * (t >> 4) + (t & 15);
    cf v[16];
#pragma unroll
    for (int j = 0; j < 16; ++j) v[j] = ldz(Z, b + 17 * j);
    dft16<false>(v); twiddle16t<false>(v, tw);
#pragma unroll
    for (int j = 0; j < 16; ++j) stz(Z, b + 17 * j, v[j]);
}
template <class P> HD void inv_pass2t(P Z, int t, const cf (&tw)[15]) {
    const int b = 272 * (t >> 4) + (t & 15);
    cf v[16];
#pragma unroll
    for (int j = 0; j < 16; ++j) v[j] = ldz(Z, b + 17 * j);
    twiddle16t<true>(v, tw); dft16<true>(v);
#pragma unroll
    for (int j = 0; j < 16; ++j) stz(Z, b + 17 * j, v[j]);
}
template <class P> HD void inv_pass3t(P Z, int t, const cf (&tw)[15]) {
    cf v[16]; const int b = t + (t >> 4);
#pragma unroll
    for (int j = 0; j < 16; ++j) v[j] = ldz(Z, b + 272 * j);
    twiddle16t<true>(v, tw); dft16<true>(v);
#pragma unroll
    for (int j = 0; j < 16; ++j) stz(Z, b + 272 * j, v[j]);
}
template <class P> HD void fwd_pass3_load(P Z, int t, cf (&v)[16]) {
#pragma unroll
    for (int j = 0; j < 16; ++j) v[j] = ldz(Z, 17 * t + j);
    dft16<false>(v);
}
template <class P> HD void inv_pass1_store(P Z, int t, cf (&v)[16]) {
    dft16<true>(v);
#pragma unroll
    for (int j = 0; j < 16; ++j) stz(Z, 17 * t + j, v[j]);
}
template <class P> HD void inv_pass2(P Z, int t, cf w2) {
    const int b = 272 * (t >> 4) + (t & 15);
    cf v[16];
#pragma unroll
    for (int j = 0; j < 16; ++j) v[j] = ldz(Z, b + 17 * j);
    twiddle16(v, cconj(w2)); dft16<true>(v);
#pragma unroll
    for (int j = 0; j < 16; ++j) stz(Z, b + 17 * j, v[j]);
}
template <class P> HD void inv_pass3(P Z, int t, cf w1) {
    cf v[16]; const int b = t + (t >> 4);
#pragma unroll
    for (int j = 0; j < 16; ++j) v[j] = ldz(Z, b + 272 * j);
    twiddle16(v, cconj(w1)); dft16<true>(v);
#pragma unroll
    for (int j = 0; j < 16; ++j) stz(Z, b + 272 * j, v[j]);
}
#define LAS __attribute__((address_space(3)))
typedef LAS cfv* lcf;
struct HyArgs {
    const bf16* hyT;
    bf16* yaT;
    const float* fsum;
    const float* fdif;
    const float* cw;
    const float* cb;
    const float* skip;
    const cfv* T;
    int TS, npairs, off00, off01, off10, off11;
};
__device__ __forceinline__ float bf2f(unsigned h) { return __builtin_bit_cast(float, h << 16); }
constexpr int HOFF_SX1 = 2 * FSUB * 8, HOFF_SV = HOFF_SX1 + 16384, HOFF_SX0 = HOFF_SV + 16384, HOFF_SF = HOFF_SX0 + 16384, HY_LDS_END = HOFF_SF + 32768;
#define HBAR() do { asm volatile("s_waitcnt lgkmcnt(0)" ::: "memory"); __builtin_amdgcn_s_barrier(); asm volatile("" ::: "memory"); } while (0)
#define HDMA_WAIT() asm volatile("s_waitcnt vmcnt(0)" ::: "memory")
#define WAVE_FENCE() asm volatile("s_waitcnt lgkmcnt(0)" ::: "memory")
__device__ __forceinline__ void hdma16(const void* gp, LAS unsigned char* wave_dst) { __builtin_amdgcn_global_load_lds((const unsigned*)gp, (LAS unsigned*)wave_dst, 16, 0, 0); }
__device__ __forceinline__ void conv8s(const LAS unsigned char* S, int tid, float w0, float w1, float w2, float b, float (&o)[8]) {
    const pg8::u32x4 q = *(const LAS pg8::u32x4*)(S + 16 * tid);
    const unsigned lft = *(const LAS unsigned short*)(S + (tid > 0 ? 16 * tid - 2 : 0)), rgt = *(const LAS unsigned short*)(S + (tid < 511 ? 16 * tid + 16 : 8190));
    float x[10];
    x[0] = tid > 0 ? bf2f(lft) : 0.f; x[9] = tid < 511 ? bf2f(rgt) : 0.f;
    x[1] = bf2f(q.x & 0xffffu); x[2] = bf2f(q.x >> 16); x[3] = bf2f(q.y & 0xffffu); x[4] = bf2f(q.y >> 16);
    x[5] = bf2f(q.z & 0xffffu); x[6] = bf2f(q.z >> 16); x[7] = bf2f(q.w & 0xffffu); x[8] = bf2f(q.w >> 16);
#pragma unroll
    for (int i = 0; i < 8; ++i) o[i] = b + w0 * x[i] + w1 * x[i + 1] + w2 * x[i + 2];
}
__device__ __forceinline__ pg8::u32x4 pack8(const float (&x)[8], const float (&y)[8]) {
    pg8::u32x4 w;
    w.x = f2bf(x[0] * y[0]) | (f2bf(x[1] * y[1]) << 16); w.y = f2bf(x[2] * y[2]) | (f2bf(x[3] * y[3]) << 16);
    w.z = f2bf(x[4] * y[4]) | (f2bf(x[5] * y[5]) << 16); w.w = f2bf(x[6] * y[6]) | (f2bf(x[7] * y[7]) << 16);
    return w;
}
__device__ __forceinline__ void hyena_phase(LAS unsigned char* lds, const HyArgs& A, int first, int stride, const int tid, const int wave) {
    lcf Z = (lcf)lds;
    const int s = tid >> 8, t = tid & 255, pb = 8 * tid + (tid >> 1);
    const cf w1 = ldz(A.T, 2 * t), w2 = ldz(A.T, 32 * (t & 15)), wp = ldz(A.T, 8 * tid);
    lcf Zs = Z + s * FSUB;
    cf t1[15], t2[15]; twpowers(w1, t1); twpowers(w2, t2);
    LAS unsigned char* wdst = lds + wave * 1024;
    constexpr float W8C[8] = {1.0f, 0.99999970586f, 0.99999882345f, 0.99999735277f, 0.99999529381f, 0.99999264659f, 0.99998941108f, 0.99998558731f};
    constexpr float W8S[8] = {0.0f, 0.00076699031874f, 0.0015339801863f, 0.0023009691514f, 0.0030679567630f, 0.0038349425697f, 0.0046019261204f, 0.0053689069640f};
    if (first >= 1024) return;
#define ISSUE_PAIR(cc, oa, ob) do { \
        hdma16(A.hyT + (size_t)(1024 + (cc)) * A.TS + (oa) + 8 * tid, wdst + HOFF_SX1); hdma16(A.hyT + (size_t)(1024 + (cc)) * A.TS + (ob) + 8 * tid, wdst + HOFF_SX1 + 8192); \
        hdma16(A.hyT + (size_t)(2048 + (cc)) * A.TS + (oa) + 8 * tid, wdst + HOFF_SV);  hdma16(A.hyT + (size_t)(2048 + (cc)) * A.TS + (ob) + 8 * tid, wdst + HOFF_SV + 8192); } while (0)
#define ISSUE_X0(cc, oa, ob) do { hdma16(A.hyT + (size_t)(cc) * A.TS + (oa) + 8 * tid, wdst + HOFF_SX0); hdma16(A.hyT + (size_t)(cc) * A.TS + (ob) + 8 * tid, wdst + HOFF_SX0 + 8192); } while (0)
#define ISSUE_FILT(cc) do { \
        hdma16(A.fsum + (size_t)(cc) * 4096 + 8 * tid, wdst + HOFF_SF); hdma16(A.fsum + (size_t)(cc) * 4096 + 8 * tid + 4, wdst + HOFF_SF + 8192); \
        hdma16(A.fdif + (size_t)(cc) * 4096 + 8 * tid, wdst + HOFF_SF + 16384); hdma16(A.fdif + (size_t)(cc) * 4096 + 8 * tid + 4, wdst + HOFF_SF + 24576); } while (0)
    ISSUE_FILT(first); ISSUE_PAIR(first, A.off00, A.off01);
    for (int c = first; c < 1024; c += stride) {
        const int cn = c + stride;
        const float sk = A.skip[c];
        const float cx0 = A.cw[c], cx1 = A.cw[3072 + c], cx2 = A.cw[6144 + c], cxb = A.cb[c];
        const float ca0 = A.cw[1024 + c], ca1 = A.cw[3072 + 1024 + c], ca2 = A.cw[6144 + 1024 + c], cab = A.cb[1024 + c];
        const float cv0 = A.cw[2048 + c], cv1 = A.cw[3072 + 2048 + c], cv2 = A.cw[6144 + 2048 + c], cvb = A.cb[2048 + c];
        cf Kr[16];
        HDMA_WAIT();
        {
            const pg8::f32x4 s0 = *(const LAS pg8::f32x4*)(lds + HOFF_SF + 16 * tid), s1 = *(const LAS pg8::f32x4*)(lds + HOFF_SF + 8192 + 16 * tid);
            const pg8::f32x4 d0 = *(const LAS pg8::f32x4*)(lds + HOFF_SF + 16384 + 16 * tid), d1 = *(const LAS pg8::f32x4*)(lds + HOFF_SF + 24576 + 16 * tid);
            const float fs[8] = {s0[0], s0[1], s0[2], s0[3], s1[0], s1[1], s1[2], s1[3]}, fd[8] = {d0[0], d0[1], d0[2], d0[3], d1[0], d1[1], d1[2], d1[3]};
#pragma unroll
            for (int i = 0; i < 8; ++i) { cf wq = wp; FFT_OPAQUE(wq); const cf tw = cmul(wq, cmk(W8C[i], -W8S[i])); stz(Z, pb + i, cmk(fs[i], 0.f)); stz(Z, FSUB + pb + i, cmk(fd[i] * tw.x, fd[i] * tw.y)); }
        }
        HBAR();
        fwd_pass1t(Zs, t, t1); HBAR();
        fwd_pass2t(Zs, t, t2); WAVE_FENCE();
        fwd_pass3_load(Zs, t, Kr);
#pragma unroll
        for (int j = 0; j < 16; ++j) { Kr[j].x *= (1.0f / 8192.0f); Kr[j].y *= (1.0f / 8192.0f); }
        HBAR();
        for (int p = 0; p < A.npairs; ++p) {
            const int o0 = p ? A.off10 : A.off00, o1 = p ? A.off11 : A.off01;
            float u0[8], u1[8];
            {
                float a[8], b[8];
                conv8s(lds + HOFF_SX1, tid, ca0, ca1, ca2, cab, a); conv8s(lds + HOFF_SV, tid, cv0, cv1, cv2, cvb, b);
#pragma unroll
                for (int i = 0; i < 8; ++i) u0[i] = a[i] * b[i];
                conv8s(lds + HOFF_SX1 + 8192, tid, ca0, ca1, ca2, cab, a); conv8s(lds + HOFF_SV + 8192, tid, cv0, cv1, cv2, cvb, b);
#pragma unroll
                for (int i = 0; i < 8; ++i) u1[i] = a[i] * b[i];
            }
#pragma unroll
            for (int i = 0; i < 8; ++i) { cf wq = wp; FFT_OPAQUE(wq); const cf tw = cmul(wq, cmk(W8C[i], -W8S[i])); const cf z = cmk(u0[i], u1[i]); stz(Z, pb + i, z); stz(Z, FSUB + pb + i, cmul(z, tw)); }
            HBAR();
            ISSUE_X0(c, o0, o1);
            if (p + 1 < A.npairs) ISSUE_PAIR(c, A.off10, A.off11);
            else if (cn < 1024) { ISSUE_PAIR(cn, A.off00, A.off01); ISSUE_FILT(cn); }
            fwd_pass1t(Zs, t, t1); HBAR();
            fwd_pass2t(Zs, t, t2); WAVE_FENCE();
            {
                cf v[16];
                fwd_pass3_load(Zs, t, v);
#pragma unroll
                for (int j = 0; j < 16; ++j) v[j] = cmul(v[j], Kr[j]);
                inv_pass1_store(Zs, t, v);
            }
            WAVE_FENCE();
            inv_pass2t(Zs, t, t2); HBAR();
            inv_pass3t(Zs, t, t1);
            HDMA_WAIT(); HBAR();
            {
                float y0[8], y1[8];
#pragma unroll
                for (int i = 0; i < 8; ++i) { cf wq = wp; FFT_OPAQUE(wq); const cf tw = cmul(wq, cmk(W8C[i], -W8S[i])); const cf e = ldz(Z, pb + i), o = ldz(Z, FSUB + pb + i); const cf y = cadd(e, cmul(o, cconj(tw))); y0[i] = y.x + sk * u0[i]; y1[i] = y.y + sk * u1[i]; }
                float x0c[8];
                conv8s(lds + HOFF_SX0, tid, cx0, cx1, cx2, cxb, x0c);
                *(pg8::u32x4*)(A.yaT + (size_t)c * A.TS + o0 + 8 * tid) = pack8(x0c, y0);
                if (o1 != o0) { conv8s(lds + HOFF_SX0 + 8192, tid, cx0, cx1, cx2, cxb, x0c); *(pg8::u32x4*)(A.yaT + (size_t)c * A.TS + o1 + 8 * tid) = pack8(x0c, y1); }
            }
        }
    }
    HDMA_WAIT(); HBAR();
#undef ISSUE_PAIR
#undef ISSUE_X0
#undef ISSUE_FILT
}
}
namespace pg8 {
__device__ __forceinline__ f32x2 sigmoid_pk(f32x2 v) {
    f32x2 e; e.x = __builtin_amdgcn_exp2f(v.x * -1.4426950408889634f); e.y = __builtin_amdgcn_exp2f(v.y * -1.4426950408889634f);
    f32x2 o; o.x = __builtin_amdgcn_rcpf(1.0f + e.x); o.y = __builtin_amdgcn_rcpf(1.0f + e.y); return o;
}
struct EpiHyT {
    static constexpr bool PERM = true, AFTER_DRAIN = false, MID = false, OVL = false, ATR = false;
    bf16_t* O; int ldc; float* vss;
    __device__ __forceinline__ void operator()(const f32x4 (&acc)[2][2][4][2], const Unit& u, int wr, int wc, int fr, int fq) const {
        const int row0 = u.pm * BM + wr * 64 + fr, col0 = u.pn * BM + wc * 32 + 8 * fq;
        const bool isv = u.pm >= 12;
        f32x4 ss[2][2];
#pragma unroll
        for (int bj = 0; bj < 2; ++bj)
#pragma unroll
            for (int n = 0; n < 2; ++n) ss[bj][n] = (f32x4){0.f, 0.f, 0.f, 0.f};
#pragma unroll
        for (int ai = 0; ai < 2; ++ai)
#pragma unroll
            for (int m = 0; m < 4; ++m) { bf16_t* rowp = O + (size_t)(row0 + ai * HALF + m * 16) * ldc + col0;
#pragma unroll
                for (int bj = 0; bj < 2; ++bj) { f32x4 v0 = acc[ai][bj][m][0], v1 = acc[ai][bj][m][1];
                    if (isv) { f32x2 a = gelu_pk((f32x2){v0[0], v0[1]}), b = gelu_pk((f32x2){v0[2], v0[3]}), c = gelu_pk((f32x2){v1[0], v1[1]}), d = gelu_pk((f32x2){v1[2], v1[3]});
                        v0 = (f32x4){a.x, a.y, b.x, b.y}; v1 = (f32x4){c.x, c.y, d.x, d.y}; ss[bj][0] += v0 * v0; ss[bj][1] += v1 * v1; }
                    u32x4 w; w.x = cvt_pk_bf16(v0[0], v0[1]); w.y = cvt_pk_bf16(v0[2], v0[3]); w.z = cvt_pk_bf16(v1[0], v1[1]); w.w = cvt_pk_bf16(v1[2], v1[3]);
                    *(u32x4*)(rowp + bj * HALF) = w; } }
        if (isv) {
            float mine = 0.f;
#pragma unroll
            for (int bj = 0; bj < 2; ++bj)
#pragma unroll
                for (int n = 0; n < 2; ++n)
#pragma unroll
                    for (int j = 0; j < 4; ++j) { float s = ss[bj][n][j];
                        s += __builtin_bit_cast(float, __builtin_amdgcn_update_dpp(0, __builtin_bit_cast(int, s), 0x121, 0xf, 0xf, false));
                        s += __builtin_bit_cast(float, __builtin_amdgcn_update_dpp(0, __builtin_bit_cast(int, s), 0x122, 0xf, 0xf, false));
                        s += __builtin_bit_cast(float, __builtin_amdgcn_update_dpp(0, __builtin_bit_cast(int, s), 0x124, 0xf, 0xf, false));
                        s += __builtin_bit_cast(float, __builtin_amdgcn_update_dpp(0, __builtin_bit_cast(int, s), 0x128, 0xf, 0xf, false));
                        mine = (fr == bj * 8 + n * 4 + j) ? s : mine; }
            atomicAdd(vss + col0 + (fr >> 3) * HALF + 4 * ((fr >> 2) & 1) + (fr & 3), mine);
        }
    }
};
struct EpiUG {
    static constexpr bool PERM = true, AFTER_DRAIN = false, MID = false, OVL = false, ATR = false;
    bf16_t* U; bf16_t* G; int ldu;
    __device__ __forceinline__ void operator()(const f32x4 (&acc)[2][2][4][2], const Unit& u, int wr, int wc, int fr, int fq) const {
        const int row0 = u.pm * BM + wr * 64 + fr; int colt = u.pn * BM; const bool isu = colt < 1024;
        bf16_t* base = isu ? U : G; const int ldc = isu ? ldu : 2048; if (!isu) colt -= 1024;
        const int col0 = colt + wc * 32 + 8 * fq;
#pragma unroll
        for (int ai = 0; ai < 2; ++ai)
#pragma unroll
            for (int m = 0; m < 4; ++m) { bf16_t* rowp = base + (size_t)(row0 + ai * HALF + m * 16) * ldc + col0;
#pragma unroll
                for (int bj = 0; bj < 2; ++bj) { f32x4 v0 = acc[ai][bj][m][0], v1 = acc[ai][bj][m][1];
                    f32x2 a, b, c, d;
                    if (isu) { a = gelu_pk((f32x2){v0[0], v0[1]}); b = gelu_pk((f32x2){v0[2], v0[3]}); c = gelu_pk((f32x2){v1[0], v1[1]}); d = gelu_pk((f32x2){v1[2], v1[3]}); }
                    else { a = sigmoid_pk((f32x2){v0[0], v0[1]}); b = sigmoid_pk((f32x2){v0[2], v0[3]}); c = sigmoid_pk((f32x2){v1[0], v1[1]}); d = sigmoid_pk((f32x2){v1[2], v1[3]}); }
                    u32x4 w; w.x = cvt_pk_bf16(a.x, a.y); w.y = cvt_pk_bf16(b.x, b.y); w.z = cvt_pk_bf16(c.x, c.y); w.w = cvt_pk_bf16(d.x, d.y);
                    *(u32x4*)(rowp + bj * HALF) = w; } }
    }
};
}
namespace {
struct WJob { const float* W; const float* g; bf16* dst; int K, N, c0, nc, ldd, r0, koff, perm; };
constexpr int NWJ = 9;
struct WJobs { WJob j[NWJ]; };
__device__ __forceinline__ unsigned pk2(float lo, float hi) { return f2bf(lo) | (f2bf(hi) << 16); }
__device__ __forceinline__ void wT_item(const WJob& J, LAS float* scr, int item, int lane) {
    const int nblk = J.nc / 32, kb = item / nblk, nb = item % nblk, k0 = 64 * kb, n0 = 32 * nb;
    float v[32];
#pragma unroll
    for (int i = 0; i < 32; ++i) v[i] = J.W[(size_t)(k0 + 2 * i + (lane >> 5)) * J.N + J.c0 + n0 + (lane & 31)];
    if (J.g) {
#pragma unroll
        for (int i = 0; i < 32; ++i) v[i] *= J.g[k0 + 2 * i + (lane >> 5)]; }
#pragma unroll
    for (int i = 0; i < 32; ++i) scr[(2 * i + (lane >> 5)) * 33 + (lane & 31)] = v[i];
    asm volatile("s_waitcnt lgkmcnt(0)" ::: "memory");
    const int c = lane & 7; int rb = n0;
    if (J.perm) { const int half = n0 >= 2816, cc = n0 - half * 2816; rb = 256 * (cc >> 7) + 128 * half + (cc & 127); }
#pragma unroll
    for (int j = 0; j < 4; ++j) { const int n = (lane >> 3) + 8 * j; const LAS float* s = scr + (8 * c) * 33 + n;
        uint4 o; o.x = pk2(s[0 * 33], s[1 * 33]); o.y = pk2(s[2 * 33], s[3 * 33]); o.z = pk2(s[4 * 33], s[5 * 33]); o.w = pk2(s[6 * 33], s[7 * 33]);
        *(uint4*)(J.dst + (size_t)(J.r0 + rb + n) * J.ldd + J.koff + k0 + 8 * c) = o; }
    asm volatile("s_waitcnt lgkmcnt(0)" ::: "memory");
}
__device__ __forceinline__ void p0_weights(const WJobs& WJ, int jlo, int jhi, LAS float* scr, int gw, int NGW, int lane) {
    int base = 0;
    for (int q = jlo; q < jhi; ++q) {
        const WJob& J = WJ.j[q]; const int ni = (J.K / 64) * (J.nc / 32);
        int it = gw - (base % NGW); if (it < 0) it += NGW;
        for (; it < ni; it += NGW) wT_item(J, scr, it, lane);
        base += ni;
    }
}
__device__ __forceinline__ float wave_sum(float v) {
#pragma unroll
    for (int o = 1; o < 64; o <<= 1) v += __shfl_xor(v, o);
    return v;
}
__device__ __forceinline__ void rms_row_to_bf16(const float* xrow, const float* g, bf16* orow, int lane) {
    const float4* xr = (const float4*)xrow + lane; const float4* gr = (const float4*)g + lane;
    float4 v[4]; float s = 0.f;
#pragma unroll
    for (int j = 0; j < 4; ++j) { v[j] = xr[64 * j]; s += (v[j].x * v[j].x + v[j].y * v[j].y) + (v[j].z * v[j].z + v[j].w * v[j].w); }
    const float r = rsqrtf(wave_sum(s) * (1.f / 1024.f) + EPS);
    unsigned long long* o8 = (unsigned long long*)orow + lane;
#pragma unroll
    for (int j = 0; j < 4; ++j) { const float4 gg = gr[64 * j];
        o8[64 * j] = (unsigned long long)pk2(v[j].x * r * gg.x, v[j].y * r * gg.y) | ((unsigned long long)pk2(v[j].z * r * gg.z, v[j].w * r * gg.w) << 32); }
}
template <int NR> __device__ __forceinline__ void rms_rowsN_to_bf16(const float* xrow, const float* g, bf16* orow, int ldo, int lane) {
    float4 v[NR][4]; float s[NR];
#pragma unroll
    for (int r = 0; r < NR; ++r)
#pragma unroll
        for (int j = 0; j < 4; ++j) v[r][j] = ((const float4*)(xrow + (size_t)r * 1024) + lane)[64 * j];
#pragma unroll
    for (int r = 0; r < NR; ++r) { s[r] = 0.f;
#pragma unroll
        for (int j = 0; j < 4; ++j) s[r] += (v[r][j].x * v[r][j].x + v[r][j].y * v[r][j].y) + (v[r][j].z * v[r][j].z + v[r][j].w * v[r][j].w); }
#pragma unroll
    for (int r = 0; r < NR; ++r) { const float rr = rsqrtf(wave_sum(s[r]) * (1.f / 1024.f) + EPS);
        unsigned long long* o8 = (unsigned long long*)(orow + (size_t)r * ldo) + lane;
#pragma unroll
        for (int j = 0; j < 4; ++j) { const float4 gg = ((const float4*)g + lane)[64 * j];
            o8[64 * j] = (unsigned long long)pk2(v[r][j].x * rr * gg.x, v[r][j].y * rr * gg.y) | ((unsigned long long)pk2(v[r][j].z * rr * gg.z, v[r][j].w * rr * gg.w) << 32); } }
}
}

namespace {
struct SguArgs {
    const bf16* vT;
    bf16* U;
    const float* vss;
    const float* ws;
    const float* bs;
    const float* gn;
    int TS, ldu;
};
typedef short bf16x8_t __attribute__((ext_vector_type(8)));
typedef float f32x4_t __attribute__((ext_vector_type(4)));
#define SBAR() do { asm volatile("s_waitcnt lgkmcnt(0)" ::: "memory"); __builtin_amdgcn_s_barrier(); asm volatile("" ::: "memory"); } while (0)
__device__ __forceinline__ void sgu_phase(LAS unsigned char* lds, const SguArgs& A, int first, int stride, const int tid, const int wave) {
    const int nitems = (A.TS / 128) * 8;
    if (first >= nitems) return;
    const int lane = tid & 63, fr = lane & 15, fq = lane >> 4, p = 16 * wave + fr;
    LAS float* rtab = (LAS float*)(lds + 131072);
    LAS float* gnl = (LAS float*)(lds + 131072 + 4096);
#define SGU_ISSUE(item, buf) do { const int g_ = (item) & 7, tok0_ = ((item) >> 3) * 128; \
        _Pragma("unroll") for (int i_ = 0; i_ < 4; ++i_) { const int r_ = (i_ * 8 + wave) * 4 + (lane >> 4), c_ = (lane & 15) ^ (r_ & 15); \
            __builtin_amdgcn_global_load_lds((const unsigned*)(A.vT + (size_t)(g_ * 128 + r_) * A.TS + tok0_ + 8 * c_), (LAS unsigned*)(lds + (buf) * 65536 + (i_ * 8 + wave) * 1024), 16, 0, 0); \
            __builtin_amdgcn_global_load_lds((const unsigned*)(A.U + (size_t)(tok0_ + r_) * A.ldu + g_ * 128 + 8 * c_), (LAS unsigned*)(lds + (buf) * 65536 + 32768 + (i_ * 8 + wave) * 1024), 16, 0, 0); } } while (0)
    SGU_ISSUE(first, 0);
    int gcur = -1; float wf[4][8]; float bsp = 0.f;
    for (int e = tid; e < 1024; e += 512) { const int k = e >> 7, it = first + k * stride;
        if (it < nitems) rtab[e] = rsqrtf(A.vss[(it >> 3) * 128 + (e & 127)] * (1.f / 1024.f) + EPS); }
    int k = 0;
    for (int it = first; it < nitems; it += stride, ++k) {
        const int g = it & 7, tok0 = (it >> 3) * 128, buf = k & 1;
        if (g != gcur) {
            gcur = g;
#pragma unroll
            for (int kk = 0; kk < 4; ++kk) { const float4 w0 = *(const float4*)(A.ws + ((size_t)g * 128 + p) * 128 + 32 * kk + 8 * fq), w1 = *(const float4*)(A.ws + ((size_t)g * 128 + p) * 128 + 32 * kk + 8 * fq + 4);
                wf[kk][0] = w0.x; wf[kk][1] = w0.y; wf[kk][2] = w0.z; wf[kk][3] = w0.w; wf[kk][4] = w1.x; wf[kk][5] = w1.y; wf[kk][6] = w1.z; wf[kk][7] = w1.w; }
            bsp = A.bs[g * 128 + p];
            SBAR();
            if (tid < 128) gnl[tid] = A.gn[g * 128 + tid];
        }
        asm volatile("s_waitcnt vmcnt(0)" ::: "memory"); SBAR();
        if (it + stride < nitems) SGU_ISSUE(it + stride, buf ^ 1);
        const LAS unsigned char* BT = lds + buf * 65536; const LAS unsigned char* UT = BT + 32768;
        bf16x8_t af[4];
#pragma unroll
        for (int kk = 0; kk < 4; ++kk) { const f32x4_t r0 = *(const LAS f32x4_t*)(rtab + k * 128 + 32 * kk + 8 * fq), r1 = *(const LAS f32x4_t*)(rtab + k * 128 + 32 * kk + 8 * fq + 4);
            uint4 o; o.x = pk2(wf[kk][0] * r0[0], wf[kk][1] * r0[1]); o.y = pk2(wf[kk][2] * r0[2], wf[kk][3] * r0[3]); o.z = pk2(wf[kk][4] * r1[0], wf[kk][5] * r1[1]); o.w = pk2(wf[kk][6] * r1[2], wf[kk][7] * r1[3]);
            af[kk] = __builtin_bit_cast(bf16x8_t, o); }
        f32x4_t acc[8];
#pragma unroll
        for (int nt = 0; nt < 8; ++nt) acc[nt] = (f32x4_t){0.f, 0.f, 0.f, 0.f};
#pragma unroll
        for (int kk = 0; kk < 4; ++kk) {
            bf16x8_t bfr[8];
#pragma unroll
            for (int nt = 0; nt < 8; ++nt) bfr[nt] = *(const LAS bf16x8_t*)(BT + (16 * nt + fr) * 256 + 16 * ((4 * kk + fq) ^ fr));
#pragma unroll
            for (int nt = 0; nt < 8; ++nt) acc[nt] = __builtin_amdgcn_mfma_f32_16x16x32_bf16(bfr[nt], af[kk], acc[nt], 0, 0, 0);
        }
        bf16* urow = A.U + (size_t)(tok0 + p) * A.ldu + g * 128 + 4 * fq;
#pragma unroll
        for (int nt = 0; nt < 8; ++nt) {
            typedef unsigned u32x2_t __attribute__((ext_vector_type(2)));
            const u32x2_t uu = *(const LAS u32x2_t*)(UT + p * 256 + 16 * ((2 * nt + (fq >> 1)) ^ fr) + 8 * (fq & 1));
            const f32x4_t gv = *(const LAS f32x4_t*)(gnl + 16 * nt + 4 * fq);
            const float y0 = bf2f(uu.x & 0xffffu) * (gv[0] * acc[nt][0] + bsp), y1 = bf2f(uu.x >> 16) * (gv[1] * acc[nt][1] + bsp);
            const float y2 = bf2f(uu.y & 0xffffu) * (gv[2] * acc[nt][2] + bsp), y3 = bf2f(uu.y >> 16) * (gv[3] * acc[nt][3] + bsp);
            uint2 o; o.x = pk2(y0, y1); o.y = pk2(y2, y3);
            *(uint2*)(urow + 16 * nt) = o;
        }
    }
    asm volatile("s_waitcnt vmcnt(0)" ::: "memory"); SBAR();
#undef SGU_ISSUE
}
}

namespace pg8 {
__device__ __forceinline__ void bf8_to_f32(const u32x4 q, f32x4& lo, f32x4& hi) {
    lo = (f32x4){__builtin_bit_cast(float, q.x << 16), __builtin_bit_cast(float, q.x & 0xffff0000u), __builtin_bit_cast(float, q.y << 16), __builtin_bit_cast(float, q.y & 0xffff0000u)};
    hi = (f32x4){__builtin_bit_cast(float, q.z << 16), __builtin_bit_cast(float, q.z & 0xffff0000u), __builtin_bit_cast(float, q.w << 16), __builtin_bit_cast(float, q.w & 0xffff0000u)};
}
struct EpiMerge {
    static constexpr bool PERM = true, AFTER_DRAIN = false, MID = true, OVL = false, ATR = true;
    const bf16_t* G; bf16_t* O;
    __device__ __forceinline__ void mid(f32x4 (&acc)[2][2][4][2], const Unit& u, int wr, int wc, int fr, int fq) const {
        unsigned off0 = (unsigned)(u.pm * BM + wr * 64 + fr) * 2048u + (unsigned)(u.pn * BM + wc * 32 + 8 * fq);
        asm volatile("" : "+v"(off0));
#pragma unroll
        for (int ai = 0; ai < 2; ++ai)
#pragma unroll
            for (int mh = 0; mh < 2; ++mh) {
                u32x4 qa[2][2], qb[2][2];
#pragma unroll
                for (int mm = 0; mm < 2; ++mm)
#pragma unroll
                    for (int bj = 0; bj < 2; ++bj) { const bf16_t* gp = G + (off0 + (unsigned)((ai * HALF + (2 * mh + mm) * 16) * 2048 + bj * HALF)); qa[mm][bj] = *(const u32x4*)gp; qb[mm][bj] = *(const u32x4*)(gp + 1024); }
#pragma unroll
                for (int mm = 0; mm < 2; ++mm)
#pragma unroll
                    for (int bj = 0; bj < 2; ++bj) { const int m = 2 * mh + mm; f32x4 a0, a1, b0, b1; bf8_to_f32(qa[mm][bj], a0, a1); bf8_to_f32(qb[mm][bj], b0, b1);
#pragma unroll
                        for (int j = 0; j < 4; ++j) { acc[ai][bj][m][0][j] *= a0[j] * __builtin_amdgcn_rcpf(b0[j]); acc[ai][bj][m][1][j] *= a1[j] * __builtin_amdgcn_rcpf(b1[j]); } }
                asm volatile("" ::: "memory"); }
    }
    __device__ __forceinline__ void operator()(const f32x4 (&acc)[2][2][4][2], const Unit& u, int wr, int wc, int fr, int fq) const {
        const int row0 = u.pm * BM + wr * 64 + fr, col0 = u.pn * BM + wc * 32 + 8 * fq;
#pragma unroll
        for (int ai = 0; ai < 2; ++ai)
#pragma unroll
            for (int m = 0; m < 4; ++m) { const size_t r = (size_t)(row0 + ai * HALF + m * 16);
#pragma unroll
                for (int bj = 0; bj < 2; ++bj) { f32x4 b0, b1; bf8_to_f32(*(const u32x4*)(G + r * 2048 + 1024 + col0 + bj * HALF), b0, b1);
                    const f32x4 v0 = acc[ai][bj][m][0] * b0, v1 = acc[ai][bj][m][1] * b1;
                    u32x4 w; w.x = cvt_pk_bf16(v0[0], v0[1]); w.y = cvt_pk_bf16(v0[2], v0[3]); w.z = cvt_pk_bf16(v1[0], v1[1]); w.w = cvt_pk_bf16(v1[2], v1[3]);
                    *(u32x4*)(O + r * 1024 + col0 + bj * HALF) = w; } }
    }
};
}
namespace {
__device__ __forceinline__ void tr64_item(const bf16* yaT, int TS, bf16* out, int ldo, LAS unsigned short* scr, int c0, int t0, int lane) {
#pragma unroll
    for (int i = 0; i < 8; ++i) { const int r = 8 * i + (lane >> 3), ch = lane & 7;
        const pg8::u32x4 q = *(const pg8::u32x4*)(yaT + (size_t)(c0 + r) * TS + t0 + 8 * ch);
        LAS unsigned short* d = scr + (8 * ch) * 72 + r;
        d[0 * 72] = (unsigned short)(q.x & 0xffffu); d[1 * 72] = (unsigned short)(q.x >> 16); d[2 * 72] = (unsigned short)(q.y & 0xffffu); d[3 * 72] = (unsigned short)(q.y >> 16);
        d[4 * 72] = (unsigned short)(q.z & 0xffffu); d[5 * 72] = (unsigned short)(q.z >> 16); d[6 * 72] = (unsigned short)(q.w & 0xffffu); d[7 * 72] = (unsigned short)(q.w >> 16); }
    asm volatile("s_waitcnt lgkmcnt(0)" ::: "memory");
#pragma unroll
    for (int i = 0; i < 8; ++i) { const int tk = 8 * i + (lane >> 3), ch = lane & 7;
        const pg8::u32x4 q = *(const LAS pg8::u32x4*)(scr + tk * 72 + 8 * ch);
        *(pg8::u32x4*)(out + (size_t)(t0 + tk) * ldo + c0 + 8 * ch) = q; }
    asm volatile("s_waitcnt lgkmcnt(0)" ::: "memory");
}
__device__ __forceinline__ void transpose_ya(const bf16* yaT, int TS, bf16* out, int ldo, LAS unsigned short* scr, int gw, int NGW, int lane) {
    const int ntt = TS / 64, nit = 16 * ntt;
    for (int it = gw; it < nit; it += NGW) tr64_item(yaT, TS, out, ldo, scr, 64 * (it / ntt), 64 * (it % ntt), lane);
}
}

namespace pg8 {
template <bool FIRST> struct EpiResid {
    static constexpr bool PERM = true, AFTER_DRAIN = false, MID = false, OVL = false, ATR = false;
    const float* X; const bf16_t* XB; float* X1; bf16_t* X1b; float* xss;
    __device__ __forceinline__ void operator()(const f32x4 (&acc)[2][2][4][2], const Unit& u, int wr, int wc, int fr, int fq) const {
        const int row0 = u.pm * BM + wr * 64 + fr, col0 = u.pn * BM + wc * 32 + 8 * fq;
        float rsum[8];
#pragma unroll
        for (int ai = 0; ai < 2; ++ai)
#pragma unroll
            for (int mh = 0; mh < 2; ++mh) {
                f32x4 xr[2][2][2];
#pragma unroll
                for (int mm = 0; mm < 2; ++mm) { const size_t r = (size_t)(row0 + ai * HALF + (2 * mh + mm) * 16);
#pragma unroll
                    for (int bj = 0; bj < 2; ++bj) { const size_t o = r * 1024 + col0 + bj * HALF;
                        if (FIRST) { xr[mm][bj][0] = *(const f32x4*)(X + o); xr[mm][bj][1] = *(const f32x4*)(X + o + 4); }
                        else bf8_to_f32(*(const u32x4*)(XB + o), xr[mm][bj][0], xr[mm][bj][1]); } }
#pragma unroll
                for (int mm = 0; mm < 2; ++mm) { const int m = 2 * mh + mm; const size_t r = (size_t)(row0 + ai * HALF + m * 16); float s = 0.f;
#pragma unroll
                    for (int bj = 0; bj < 2; ++bj) { const size_t o = r * 1024 + col0 + bj * HALF;
                        const f32x4 v0 = acc[ai][bj][m][0] + xr[mm][bj][0], v1 = acc[ai][bj][m][1] + xr[mm][bj][1];
                        u32x4 w; w.x = cvt_pk_bf16(v0[0], v0[1]); w.y = cvt_pk_bf16(v0[2], v0[3]); w.z = cvt_pk_bf16(v1[0], v1[1]); w.w = cvt_pk_bf16(v1[2], v1[3]);
                        *(u32x4*)(X1b + o) = w;
                        s += ((v0[0] * v0[0] + v0[1] * v0[1]) + (v0[2] * v0[2] + v0[3] * v0[3])) + ((v1[0] * v1[0] + v1[1] * v1[1]) + (v1[2] * v1[2] + v1[3] * v1[3])); }
                    s += __shfl_xor(s, 16); s += __shfl_xor(s, 32);
                    rsum[ai * 4 + m] = s; }
                asm volatile("" ::: "memory"); }
        if (fq == 0) {
#pragma unroll
            for (int k = 0; k < 8; ++k) atomicAdd(xss + (size_t)(row0 + (k >> 2) * HALF + (k & 3) * 16), rsum[k]); }
    }
};
struct EpiResidNorm {
    static constexpr bool PERM = false, AFTER_DRAIN = true, MID = false, OVL = false, ATR = false;
    const bf16_t* XB; float* out; float* x2ss; const float* g; unsigned* cnt;
    __device__ __forceinline__ void fused(f32x4 (&acc)[2][2][4][2], const Unit& u, int wr, int wc, int fr, int fq, PG8_LAS unsigned char* lds, int wid, int lane) const {
        typedef unsigned u32x2v __attribute__((ext_vector_type(2)));
        const int row0 = u.pm * BM + wr * 64 + fr, col0 = u.pn * BM + wc * 32 + 4 * fq;
        float keep = 0.f; float rsum[8];
#pragma unroll
        for (int ai = 0; ai < 2; ++ai)
#pragma unroll
            for (int m = 0; m < 4; ++m) { const size_t r = (size_t)(row0 + ai * HALF + m * 16); float s = 0.f;
#pragma unroll
                for (int bj = 0; bj < 2; ++bj)
#pragma unroll
                    for (int n = 0; n < 2; ++n) { const u32x2v q = *(const u32x2v*)(XB + r * 1024 + col0 + bj * HALF + n * 16);
                        const f32x4 v = acc[ai][bj][m][n] + (f32x4){__builtin_bit_cast(float, q.x << 16), __builtin_bit_cast(float, q.x & 0xffff0000u), __builtin_bit_cast(float, q.y << 16), __builtin_bit_cast(float, q.y & 0xffff0000u)};
                        acc[ai][bj][m][n] = v; s += (v[0] * v[0] + v[1] * v[1]) + (v[2] * v[2] + v[3] * v[3]); }
                s += __shfl_xor(s, 16); s += __shfl_xor(s, 32);
                rsum[ai * 4 + m] = s; }
        if (fq == 0) {
#pragma unroll
            for (int k = 0; k < 8; ++k) keep += atomicAdd(x2ss + (size_t)(row0 + (k >> 2) * HALF + (k & 3) * 16), rsum[k]); }
        asm volatile("s_waitcnt vmcnt(0)" :: "v"(keep) : "memory");
        asm volatile("s_waitcnt lgkmcnt(0)" ::: "memory"); __builtin_amdgcn_s_barrier(); asm volatile("" ::: "memory");
        if (wid == 0) {
            if (lane == 0) { __hip_atomic_fetch_add(cnt + 64 * u.pm, 1u, __ATOMIC_RELAXED, __HIP_MEMORY_SCOPE_AGENT);
                unsigned spins = 0;
                while (__hip_atomic_load(cnt + 64 * u.pm, __ATOMIC_RELAXED, __HIP_MEMORY_SCOPE_AGENT) < 4u) { __builtin_amdgcn_s_sleep(2); if (++spins > (1u << 22)) break; } }
            __builtin_amdgcn_fence(__ATOMIC_ACQUIRE, "agent");
            asm volatile("s_waitcnt vmcnt(0)" ::: "memory");
        }
        asm volatile("s_waitcnt lgkmcnt(0)" ::: "memory"); __builtin_amdgcn_s_barrier(); asm volatile("" ::: "memory");
        f32x4 gv[2][2];
#pragma unroll
        for (int bj = 0; bj < 2; ++bj)
#pragma unroll
            for (int n = 0; n < 2; ++n) gv[bj][n] = *(const f32x4*)(g + col0 + bj * HALF + n * 16);
#pragma unroll
        for (int ai = 0; ai < 2; ++ai)
#pragma unroll
            for (int m = 0; m < 4; ++m) { const size_t r = (size_t)(row0 + ai * HALF + m * 16);
                const float rs = rsqrtf(__hip_atomic_load(x2ss + r, __ATOMIC_RELAXED, __HIP_MEMORY_SCOPE_AGENT) * (1.0f / 1024.0f) + 1e-6f);
#pragma unroll
                for (int bj = 0; bj < 2; ++bj)
#pragma unroll
                    for (int n = 0; n < 2; ++n) *(f32x4*)(out + r * 1024 + col0 + bj * HALF + n * 16) = acc[ai][bj][m][n] * gv[bj][n] * rs; }
    }
};
__device__ __forceinline__ float dpp_ror1(float v) { return __builtin_bit_cast(float, __builtin_amdgcn_update_dpp(0, __builtin_bit_cast(int, v), 0x121, 0xf, 0xf, false)); }
__device__ __forceinline__ float dpp_rol1(float v) { return __builtin_bit_cast(float, __builtin_amdgcn_update_dpp(0, __builtin_bit_cast(int, v), 0x12f, 0xf, 0xf, false)); }
struct EpiUpAct {
    static constexpr bool PERM = true, AFTER_DRAIN = false, MID = false, OVL = true, ATR = false;
    bf16_t* ACT; PG8_LAS float* XB; const float* xss; const float* cw; const float* cb;
    __device__ __forceinline__ void operator()(f32x4 (&acc)[2][2][4][2], const Unit& u, int wr, int wc, int fr_, int fq_) const {
        int lane_; asm volatile("v_mbcnt_lo_u32_b32 %0, -1, 0\n\tv_mbcnt_hi_u32_b32 %0, -1, %0" : "=v"(lane_));
        const int fr = lane_ & 15, fq = lane_ >> 4; (void)fr_; (void)fq_;
        const int seq = u.pm / 17, ti = u.pm % 17, rowbase = ovl_row(u.pm);
        const int own_lo = seq * 4096 + 254 * ti, own_hi = seq * 4096 + (254 * ti + 254 < 4096 ? 254 * ti + 254 : 4096);
        const int lr0 = wr * 64 + fr, cl = 32 * wc + 8 * fq;
        PG8_LAS float* RS = XB + 1536; PG8_LAS float* CW = XB + 1792;
        { const int w8 = wr * 4 + wc, t = w8 * 64 + lane_;
          if (t < 256) RS[t] = rsqrtf(xss[rowbase + t] * (1.0f / 1024.0f) + 1e-6f);
          const int q = t >> 7, c = t & 127; CW[q * 128 + c] = q < 3 ? cw[q * 2816 + 128 * u.pn + c] : cb[128 * u.pn + c]; }
        asm volatile("s_waitcnt lgkmcnt(0)" ::: "memory"); __builtin_amdgcn_s_barrier(); asm volatile("" ::: "memory");
#pragma unroll
        for (int ai = 0; ai < 2; ++ai)
#pragma unroll
            for (int m = 0; m < 4; ++m) { const float rs = RS[lr0 + ai * HALF + m * 16];
#pragma unroll
                for (int bj = 0; bj < 2; ++bj) { acc[ai][bj][m][0] *= rs; acc[ai][bj][m][1] *= rs; }
                __builtin_amdgcn_sched_barrier(0); }
        const bool e0 = fr == 0, e15 = fr == 15;
        const int slot = e0 ? 0 : (e15 ? 512 : 1024);
#pragma unroll
        for (int ai = 0; ai < 2; ++ai) { const int B = 2 * ai + wr;
            f32x4 p0, p1;
#pragma unroll
            for (int j = 0; j < 4; ++j) { p0[j] = e15 ? acc[ai][0][3][0][j] : acc[ai][0][0][0][j]; p1[j] = e15 ? acc[ai][0][3][1][j] : acc[ai][0][0][1][j]; }
            *(PG8_LAS f32x4*)(XB + slot + B * 128 + cl) = p0; *(PG8_LAS f32x4*)(XB + slot + B * 128 + cl + 4) = p1; }
        asm volatile("s_waitcnt lgkmcnt(0)" ::: "memory"); __builtin_amdgcn_s_barrier(); asm volatile("" ::: "memory");
        const int ch = 128 * u.pn + cl;
        typedef unsigned u32x2v __attribute__((ext_vector_type(2)));
#pragma unroll
        for (int ai = 0; ai < 2; ++ai) { const int B = 2 * ai + wr;
            u32x2v pk0[4];
#pragma unroll
            for (int n = 0; n < 2; ++n) {
                const f32x4 w0 = *(const PG8_LAS f32x4*)(CW + cl + 4 * n), w1 = *(const PG8_LAS f32x4*)(CW + 128 + cl + 4 * n), w2 = *(const PG8_LAS f32x4*)(CW + 256 + cl + 4 * n), bb = *(const PG8_LAS f32x4*)(CW + 384 + cl + 4 * n);
                f32x4 pb = *(const PG8_LAS f32x4*)(XB + 512 + (B > 0 ? B - 1 : 0) * 128 + cl + 4 * n), nb = *(const PG8_LAS f32x4*)(XB + (B < 3 ? B + 1 : 3) * 128 + cl + 4 * n);
                if (B == 0) pb = (f32x4){0.f, 0.f, 0.f, 0.f};
                if (B == 3) nb = (f32x4){0.f, 0.f, 0.f, 0.f};
                float o[4][4];
#pragma unroll
                for (int j = 0; j < 4; ++j) {
                    float av[4], rr[4], ll[4];
#pragma unroll
                    for (int m = 0; m < 4; ++m) { av[m] = acc[ai][0][m][n][j]; rr[m] = dpp_ror1(av[m]); ll[m] = dpp_rol1(av[m]); }
#pragma unroll
                    for (int m = 0; m < 4; ++m) { const float pv = e0 ? (m > 0 ? rr[m - 1] : pb[j]) : rr[m], nv = e15 ? (m < 3 ? ll[m + 1] : nb[j]) : ll[m];
                        const float sv = bb[j] + w0[j] * pv + w1[j] * av[m] + w2[j] * nv;
                        o[m][j] = sv * __builtin_amdgcn_rcpf(1.0f + __builtin_amdgcn_exp2f(sv * -1.4426950408889634f)) * acc[ai][1][m][n][j]; }
                }
#pragma unroll
                for (int m = 0; m < 4; ++m) { u32x2v w; w.x = cvt_pk_bf16(o[m][0], o[m][1]); w.y = cvt_pk_bf16(o[m][2], o[m][3]);
                    if (n == 0) pk0[m] = w;
                    else { const int tok = rowbase + lr0 + ai * HALF + m * 16;
                        if (tok >= own_lo && tok < own_hi) *(u32x4*)(ACT + (size_t)tok * 2816 + ch) = (u32x4){pk0[m].x, pk0[m].y, w.x, w.y}; } }
                __builtin_amdgcn_sched_barrier(0);
            } }
    }
};
}
namespace {
__device__ __forceinline__ void final_norm(const bf16* X2, const float* ss, const float* g, float* out, int TS, int gw, int NGW, int lane) {
    pg8::f32x4 g0[2], g1[2];
#pragma unroll
    for (int j = 0; j < 2; ++j) { g0[j] = *((const pg8::f32x4*)g + 2 * lane + 128 * j); g1[j] = *((const pg8::f32x4*)g + 2 * lane + 128 * j + 1); }
    for (int t = 2 * gw; t < TS; t += 2 * NGW) {
        pg8::u32x4 q[2][2]; float r[2];
#pragma unroll
        for (int k = 0; k < 2; ++k) { r[k] = rsqrtf(ss[t + k] * (1.0f / 1024.0f) + EPS);
#pragma unroll
            for (int j = 0; j < 2; ++j) q[k][j] = *((const pg8::u32x4*)(X2 + (size_t)(t + k) * 1024) + lane + 64 * j); }
#pragma unroll
        for (int k = 0; k < 2; ++k)
#pragma unroll
            for (int j = 0; j < 2; ++j) { pg8::f32x4 lo, hi; pg8::bf8_to_f32(q[k][j], lo, hi);
                pg8::f32x4* o = (pg8::f32x4*)(out + (size_t)(t + k) * 1024) + 2 * lane + 128 * j;
                o[0] = lo * g0[j] * r[k]; o[1] = hi * g1[j] * r[k]; }
    }
}
}

namespace {
constexpr int MLPW_W2 = 33 * 64, MLPW_W3 = MLPW_W2 + 4096, MLPW_B = MLPW_W3 + 4096, MLPW_N = MLPW_B + 256;
__device__ __forceinline__ float filt_z(int l, int j) {
    if (j == 0) return (float)((double)l / (double)(L - 1));
    const int i = (j - 1) & 15;
    const double band = 1e-4 + (double)i * ((15.0 - 1e-4) / 15.0);
    double rev = (double)l * band / (double)L;
    rev -= floor(rev);
    const float ang = (float)(rev * 6.283185307179586);
    return (j <= 16) ? cosf(ang) : -sinf(ang);
}
constexpr int MLPW_CHUNKS = 9 + 16 + 16 + 4;
__device__ __forceinline__ void mlp_stage_dma(LAS unsigned char* wl, const float* const* in, int wave, int lane) {
    for (int c = wave; c < MLPW_CHUNKS; c += 8) {
        const float* src; int dstf, n = 256;
        if (c < 9) { src = in[5] + 256 * c; dstf = 256 * c; n = c < 8 ? 256 : 64; }
        else if (c < 25) { src = in[7] + 256 * (c - 9); dstf = MLPW_W2 + 256 * (c - 9); }
        else if (c < 41) { src = in[9] + 256 * (c - 25); dstf = MLPW_W3 + 256 * (c - 25); }
        else { const int q = c - 41; src = q == 0 ? in[6] : q == 1 ? in[8] : q == 2 ? in[10] : in[11]; dstf = MLPW_B + 64 * q; n = 64; }
        if (4 * lane < n) __builtin_amdgcn_global_load_lds((const unsigned*)(src + 4 * lane), (LAS unsigned*)(wl + dstf * 4), 16, 0, 0);
    }
}
__device__ __forceinline__ float bcast_lane(float v, int i) { return __builtin_bit_cast(float, __builtin_amdgcn_readlane(__builtin_bit_cast(int, v), i)); }
__device__ __forceinline__ void filter_mlp_rows2(const LAS float* wl, float* h3out, int l0, int l1, int j) {
    float za = 0.f, zb = 0.f;
    if (j < FEMB) { za = filt_z(l0, j); zb = filt_z(l1, j); }
    const float a = wl[MLPW_B + 192 + j];
    float s0 = wl[MLPW_B + j], s1 = s0;
#pragma unroll 11
    for (int i = 0; i < FEMB; ++i) { const float w = wl[i * 64 + j]; s0 += bcast_lane(za, i) * w; s1 += bcast_lane(zb, i) * w; }
    za = sinf(a * s0); zb = sinf(a * s1);
    s0 = wl[MLPW_B + 64 + j]; s1 = s0;
#pragma unroll 8
    for (int i = 0; i < FHID; ++i) { const float w = wl[MLPW_W2 + i * 64 + j]; s0 += bcast_lane(za, i) * w; s1 += bcast_lane(zb, i) * w; }
    za = sinf(a * s0); zb = sinf(a * s1);
    s0 = wl[MLPW_B + 128 + j]; s1 = s0;
#pragma unroll 8
    for (int i = 0; i < FHID; ++i) { const float w = wl[MLPW_W3 + i * 64 + j]; s0 += bcast_lane(za, i) * w; s1 += bcast_lane(zb, i) * w; }
    h3out[l0 * FHID + j] = sinf(a * s0); h3out[l1 * FHID + j] = sinf(a * s1);
}
typedef float f32x16_t __attribute__((ext_vector_type(16)));
__device__ __forceinline__ void stage_h3_rows32(const float* h3, int row0, LAS float* scr, int lane) {
#pragma unroll
    for (int i = 0; i < 8; ++i) { const int e = 4 * (lane + 64 * i), r = e >> 6, jj = e & 63;
        if (row0 + r < 4096) { const pg8::f32x4 v = *(const pg8::f32x4*)(h3 + (size_t)(row0 + r) * 64 + jj);
            LAS float* d = scr + r * 65 + jj; d[0] = v[0]; d[1] = v[1]; d[2] = v[2]; d[3] = v[3]; } }
}
__device__ __forceinline__ void filter_tables(const float* h3, const float* w4, const float* decay, float* fsum, float* fdif, LAS float* scr, int gw, int NGW, int lane) {
    const int r = lane & 31, h = lane >> 5;
    for (int it = gw; it < 2048; it += NGW) {
        const int c0 = (it & 31) * 32, nbase = (it >> 5) * 64;
        float af[32], ab[32];
#pragma unroll
        for (int kk = 0; kk < 32; ++kk) { af[kk] = w4[(2 * kk + h) * 2048 + c0 + r]; ab[kk] = w4[(2 * kk + h) * 2048 + 1024 + c0 + r]; }
        float dcf[16], dcb[16];
#pragma unroll
        for (int q = 0; q < 16; ++q) { const int c = c0 + (q & 3) + 8 * (q >> 2) + 4 * h; dcf[q] = fabsf(decay[c]); dcb[q] = fabsf(decay[1024 + c]); }
#pragma unroll 1
        for (int half = 0; half < 2; ++half) {
            const int n0 = nbase + 32 * half, n = n0 + r, nb = n ? 4096 - n : 0;
            stage_h3_rows32(h3, n0, scr, lane);
            stage_h3_rows32(h3, 4096 - n0 - 31, scr + 32 * 65, lane);
            asm volatile("s_waitcnt lgkmcnt(0)" ::: "memory");
            f32x16_t accF, accB;
#pragma unroll
            for (int q = 0; q < 16; ++q) { accF[q] = 0.f; accB[q] = 0.f; }
#pragma unroll
            for (int kk = 0; kk < 32; ++kk) {
                const float bF = scr[r * 65 + 2 * kk + h], bB = scr[32 * 65 + (31 - r) * 65 + 2 * kk + h];
                accF = __builtin_amdgcn_mfma_f32_32x32x2f32(af[kk], bF, accF, 0, 0, 0);
                accB = __builtin_amdgcn_mfma_f32_32x32x2f32(ab[kk], bB, accB, 0, 0, 0);
            }
            const float tf = (float)n * (1.0f / 4095.0f), tb = (float)nb * (1.0f / 4095.0f);
#pragma unroll
            for (int q = 0; q < 16; ++q) { const int c = c0 + (q & 3) + 8 * (q >> 2) + 4 * h;
                const float hf = accF[q] * expf(-tf * dcf[q]);
                const float hb = n ? accB[q] * expf(-tb * dcb[q]) : 0.f;
                fsum[(size_t)c * 4096 + n] = hf + hb;
                fdif[(size_t)c * 4096 + n] = hf - hb; }
            asm volatile("s_waitcnt lgkmcnt(0)" ::: "memory");
        }
    }
}
#define RLX_AGENT __ATOMIC_RELAXED, __HIP_MEMORY_SCOPE_AGENT
#define XB_TMO      128
#define XB_XCNT(j)  (256  + 64 * (j))
#define XB_XSUB(j)  (1280 + 64 * (j))
#define XB_XGEN(j)  (2304 + 64 * (j))
#define XB_TOP      3328
#define XB_TOPGEN   3392
#define XCD_BAR_WORDS 3456
#define XB_SPIN_CAP (1u << 18)

__device__ __forceinline__ unsigned xb_ld(unsigned* p)              { return __hip_atomic_load(p, __ATOMIC_RELAXED, __HIP_MEMORY_SCOPE_AGENT); }
__device__ __forceinline__ unsigned xb_add(unsigned* p, unsigned v) { return __hip_atomic_fetch_add(p, v, __ATOMIC_RELAXED, __HIP_MEMORY_SCOPE_AGENT); }
__device__ __forceinline__ unsigned xb_xcc_id() { return (unsigned)__builtin_amdgcn_s_getreg((3 << 11) | 20) & 0xFu; }
#define XB_SPIN(cond, bar) do { unsigned _sp = 0; while (cond) { __builtin_amdgcn_s_sleep(1); \
    if ((++_sp & 255u) == 0u) { if (xb_ld(&(bar)[XB_TMO])) break; if (_sp > XB_SPIN_CAP) { atomicAdd(&(bar)[XB_TMO], 1u); break; } } } } while (0)

struct XcdBarrier {
    unsigned* bar; unsigned x;
    volatile LAS unsigned* st;
};

__device__ __forceinline__ XcdBarrier xcd_barrier_post(unsigned* bar, volatile LAS unsigned* st) {
    XcdBarrier b; b.bar = bar; b.x = xb_xcc_id(); b.st = st;
    if (threadIdx.x == 0) (void)xb_add(&bar[XB_XCNT(b.x)], 1u);
    return b;
}
__device__ __forceinline__ void xcd_barrier_complete(unsigned* bar, unsigned x, unsigned& nloc, unsigned& nx) {
    const unsigned G = gridDim.x * gridDim.y * gridDim.z;
    unsigned sum, cnt, mine, sp = 0u;
    for (;;) {
        sum = 0u; cnt = 0u; mine = 0u;
#pragma unroll
        for (unsigned j = 0; j < 16; ++j) { const unsigned c = xb_ld(&bar[XB_XCNT(j)]); sum += c; cnt += (c > 0u) ? 1u : 0u; mine = (j == x) ? c : mine; }
        if (sum == G) break;
        __builtin_amdgcn_s_sleep(1);
        if ((++sp & 255u) == 0u) { if (xb_ld(&bar[XB_TMO])) break; if (sp > XB_SPIN_CAP) { atomicAdd(&bar[XB_TMO], 1u); break; } }
    }
    nloc = mine > 0u ? mine : 1u; nx = cnt > 0u ? cnt : 1u;
}

struct XbNoHook { __device__ __forceinline__ void operator()() const {} };
template <class Hook>
__device__ __forceinline__ void xcd_barrier(const XcdBarrier& b, const Hook& hook) {
    asm volatile("s_waitcnt vmcnt(0)" ::: "memory");
    block_sync();
    hook();
    if (threadIdx.x == 0) {
        unsigned* bar = b.bar;
        __builtin_amdgcn_s_waitcnt(0);
        unsigned nloc = b.st[0], nx = b.st[1];
        if (nloc == 0u) { xcd_barrier_complete(bar, b.x, nloc, nx); b.st[0] = nloc; b.st[1] = nx; }
        const unsigned old = xb_add(&bar[XB_XSUB(b.x)], 1u);
        const unsigned gen = old / nloc;
        if (old + 1u == (gen + 1u) * nloc) {
            __builtin_amdgcn_fence(__ATOMIC_RELEASE, "agent");
            asm volatile("s_waitcnt vmcnt(0)" ::: "memory");
            const unsigned og = xb_add(&bar[XB_TOP], 1u);
            const unsigned tg = og / nx;
            if (og + 1u == (tg + 1u) * nx) xb_add(&bar[XB_TOPGEN], 1u);
            else XB_SPIN(xb_ld(&bar[XB_TOPGEN]) == tg, bar);
            __builtin_amdgcn_fence(__ATOMIC_ACQUIRE, "agent");
            xb_add(&bar[XB_XGEN(b.x)], 1u);
            asm volatile("s_waitcnt vmcnt(0)" ::: "memory");
        } else {
            XB_SPIN(xb_ld(&bar[XB_XGEN(b.x)]) == gen, bar);
            __builtin_amdgcn_fence(__ATOMIC_ACQUIRE, "agent");
            asm volatile("s_waitcnt vmcnt(0)" ::: "memory");
        }
    }
    block_sync();
}
__device__ __forceinline__ void xcd_barrier(const XcdBarrier& b) { xcd_barrier(b, XbNoHook{}); }

constexpr int WUP_PER_WG = 22;
constexpr int WUP_GOFF = WUP_PER_WG * 4096;
__device__ __forceinline__ void wup_issue(LAS unsigned char* lds, const float* W, const float* g, int bid, int wave) {
    if (wave == 0) return;
    int ln; asm volatile("v_mbcnt_lo_u32_b32 %0, -1, 0\n\tv_mbcnt_hi_u32_b32 %0, -1, %0" : "=v"(ln));
    if (wave == 7) {
#pragma unroll
        for (int q = 0; q < 4; ++q) __builtin_amdgcn_global_load_lds((const unsigned*)(g + q * 256 + 4 * ln), (LAS unsigned*)(lds + WUP_GOFF + q * 1024), 16, 0, 0); }
    for (int j = wave - 1; j < WUP_PER_WG; j += 7) { const int id = bid * WUP_PER_WG + j, kb = id & 63, nb = id >> 6;
        const float* src = W + (size_t)(kb * 16 + (ln >> 4)) * (2 * FH) + nb * 64 + 4 * (ln & 15);
#pragma unroll
        for (int q = 0; q < 4; ++q) __builtin_amdgcn_global_load_lds((const unsigned*)(src + (size_t)q * 4 * (2 * FH)), (LAS unsigned*)(lds + j * 4096 + q * 1024), 16, 0, 0); }
}
__device__ __forceinline__ void wup_convert(LAS unsigned char* lds, bf16* D, int bid, int wave) {
    asm volatile("s_waitcnt vmcnt(0)" ::: "memory");
    __builtin_amdgcn_s_barrier(); asm volatile("" ::: "memory");
    if (wave == 0) return;
    int ln; asm volatile("v_mbcnt_lo_u32_b32 %0, -1, 0\n\tv_mbcnt_hi_u32_b32 %0, -1, %0" : "=v"(ln));
    for (int j = wave - 1; j < WUP_PER_WG; j += 7) { const int id = bid * WUP_PER_WG + j, kb = id & 63, nb = id >> 6;
        const LAS float* it = (const LAS float*)(lds + j * 4096);
        const LAS pg8::f32x4* gp = (const LAS pg8::f32x4*)(lds + WUP_GOFF + kb * 64);
        const int cc = nb * 64 + ln, hf = cc >= FH ? 1 : 0, c2 = cc - FH * hf, row = 256 * (c2 >> 7) + 128 * hf + (c2 & 127);
        bf16* d = D + (size_t)row * 1024 + kb * 16;
#pragma unroll
        for (int h = 0; h < 2; ++h) { float v[8]; const pg8::f32x4 g0 = gp[2 * h], g1 = gp[2 * h + 1];
#pragma unroll
            for (int i = 0; i < 8; ++i) v[i] = it[(8 * h + i) * 64 + ln] * (i < 4 ? g0[i & 3] : g1[i & 3]);
            pg8::u32x4 o; o.x = pg8::cvt_pk_bf16(v[0], v[1]); o.y = pg8::cvt_pk_bf16(v[2], v[3]); o.z = pg8::cvt_pk_bf16(v[4], v[5]); o.w = pg8::cvt_pk_bf16(v[6], v[7]);
            *(pg8::u32x4*)(d + 8 * h) = o; } }
}
struct WupHook { LAS unsigned char* lds; const float* W; const float* g; int bid, wave; __device__ __forceinline__ void operator()() const { wup_issue(lds, W, g, bid, wave); } };
constexpr size_t MiB = 1u << 20;
constexpr int M = NB * L;
constexpr size_t WS_VSS = 0, WS_XSS = 64 * 1024, WS_X2SS = 128 * 1024, WS_TTAB = 192 * 1024, WS_BAR = 256 * 1024, WS_PCNT = 272 * 1024, WS_H3 = 1 * MiB;
constexpr size_t WS_WTA = 2 * MiB, WS_WTB = 10 * MiB, WS_PAB = 16 * MiB, WS_WO = 20 * MiB;
constexpr size_t WS_FSUM = 24 * MiB, WS_WUP = 24 * MiB, WS_WDN = 249 * MiB;
constexpr size_t WS_HYT = 41 * MiB;
constexpr size_t WS_X1B = 41 * MiB, WS_MRG = 105 * MiB;
constexpr size_t WS_YAB = 169 * MiB;
constexpr size_t WS_FDIF = 233 * MiB;
constexpr size_t WS_AP = 73 * MiB, WS_GP = 161 * MiB;
static_assert(WS_GP + (size_t)M * FH * 2 <= 256 * MiB && WS_AP + (size_t)M * FH * 2 <= WS_GP && WS_FDIF + 16 * MiB <= 256 * MiB && WS_WDN + (size_t)D * FH * 2 <= 256 * MiB && WS_WUP + (size_t)2 * FH * D * 2 <= WS_HYT, "d_ws map");
constexpr int LDS_BYTES = 155648;
static_assert(HY_LDS_END + 256 <= LDS_BYTES, "LDS map");
constexpr int NPH = 8;

struct MegaArgs { const float* in[27]; float* out; unsigned char* ws; int ph_lo, ph_hi; WJobs wj; };

__global__ void __launch_bounds__(512, 2) __attribute__((target("no-packed-fp32-ops"))) mega_fwd(MegaArgs a) {
    extern __shared__ __attribute__((aligned(16))) unsigned char lds_raw[];
    LAS unsigned char* lds = (LAS unsigned char*)lds_raw;
    cg::grid_group grid = cg::this_grid();
    const int wave = __builtin_amdgcn_readfirstlane((int)threadIdx.x >> 6);
    const int G = gridDim.x, bid = blockIdx.x, gw = bid * 8 + wave, NGW = G * 8;
#define FRESH_TID int lane; asm volatile("v_mbcnt_lo_u32_b32 %0, -1, 0\n\tv_mbcnt_hi_u32_b32 %0, -1, %0" : "=v"(lane)); const int tid = wave * 64 + lane; (void)tid
    unsigned char* ws = a.ws;
    const float* x = a.in[0];
    float* vss = (float*)(ws + WS_VSS); float* xss = (float*)(ws + WS_XSS); float* x2ss = (float*)(ws + WS_X2SS);
    cfv* Ttab = (cfv*)(ws + WS_TTAB); float* h3 = (float*)(ws + WS_H3);
    bf16* WtA = (bf16*)(ws + WS_WTA); bf16* WtB = (bf16*)(ws + WS_WTB); bf16* PabT = (bf16*)(ws + WS_PAB); bf16* WoT = (bf16*)(ws + WS_WO);
    bf16* WupT = (bf16*)(ws + WS_WUP); bf16* WdnT = (bf16*)(ws + WS_WDN);
    float* fsum = (float*)(ws + WS_FSUM); float* fdif = (float*)(ws + WS_FDIF);
    bf16* hyvT = (bf16*)(ws + WS_HYT); bf16* yaT = hyvT + (size_t)1024 * M; bf16* vT = hyvT + (size_t)3072 * M;
    bf16* YAB = (bf16*)(ws + WS_YAB); bf16* h1 = YAB; bf16* Ub = YAB + 1024;
    bf16* Gb = (bf16*)a.out;
    bf16* mrg = (bf16*)(ws + WS_MRG); bf16* X1b = (bf16*)(ws + WS_X1B); float* X1 = a.out;
    bf16* APb = (bf16*)(ws + WS_AP); bf16* GPb = (bf16*)(ws + WS_GP);
    const int lo = a.ph_lo, hi = a.ph_hi;
#define IN(k) (lo <= (k) && (k) < hi)
    for (int u = (int)threadIdx.x; u < 16; u += 512) ((LAS unsigned*)(lds + LDS_BYTES - 256))[u] = 0u;
    block_sync();
    XcdBarrier xbar = xcd_barrier_post((unsigned*)(ws + WS_BAR), (volatile LAS unsigned*)(lds + LDS_BYTES - 256));
#ifdef MK_PROBE
#define STAMP(i) do { if (threadIdx.x == 0) ((volatile LAS unsigned long long*)(lds + LDS_BYTES - 128))[i] = __builtin_amdgcn_s_memrealtime(); } while (0)
#else
#define STAMP(i) do { } while (0)
#endif
    STAMP(0);
#define SEAM(k) do { if (IN(k) && IN((k) + 1)) xcd_barrier(xbar); STAMP((k) + 1); } while (0)
    if (a.ph_hi > NPH) grid.sync();

    if (IN(0)) { FRESH_TID;
        constexpr int P0_WL = 8 * 8448;
        mlp_stage_dma(lds + P0_WL, a.in, wave, lane);
        p0_weights(a.wj, 0, 8, (LAS float*)(lds + wave * 8448), gw, NGW, lane);
        for (int m = 4 * gw; m < M; m += 4 * NGW) rms_rowsN_to_bf16<4>(x + (size_t)m * 1024, a.in[1], h1 + (size_t)m * 2048, 2048, lane);
        for (int i = bid * 512 + tid; i < 3 * M; i += G * 512) vss[i] = 0.f;
        if (tid < 4096 / 256) { const int m = bid * (4096 / 256) + tid; if (G == 256) { const float ang = (float)m / 4096.0f; Ttab[m] = (cfv){cospif(ang), -sinpif(ang)}; } }
        if (G != 256) for (int m = bid * 512 + tid; m < 4096; m += G * 512) { const float ang = (float)m / 4096.0f; Ttab[m] = (cfv){cospif(ang), -sinpif(ang)}; }
        asm volatile("s_waitcnt vmcnt(0)" ::: "memory");
        block_sync();
        for (int l = 2 * gw; l < L; l += 2 * NGW) filter_mlp_rows2((const LAS float*)(lds + P0_WL), h3, l, l + 1, lane);
    }
    SEAM(0);
    if (IN(1)) { FRESH_TID;
        { pg8::Gemm g{WtA, h1, 4096, M, 1024, 1024, 2048}; pg8::StaticOrder S; S.init(4096, M, G, bid);
          pg8::EpiHyT E{hyvT, M, vss};
          pg8::gemm_phase<pg8::EpiHyT, pg8::StaticOrder, true, true>(lds, g, S, E, tid); }
        STAMP(11);
        { pg8::Gemm g{h1, WtB, M, 3072, 1024, 2048, 1024}; pg8::StaticOrder S; S.init(M, 3072, G, bid);
          pg8::EpiUG E{Ub, Gb, 2048};
          pg8::gemm_phase<pg8::EpiUG, pg8::StaticOrder, true, true>(lds, g, S, E, tid); }
        STAMP(12);
        filter_tables(h3, a.in[12], a.in[13], fsum, fdif, (LAS float*)(lds + wave * 17408), gw, NGW, lane);
    }
    SEAM(1);
    if (IN(2)) { FRESH_TID;
        HyArgs H; H.hyT = hyvT; H.yaT = yaT; H.fsum = fsum; H.fdif = fdif; H.cw = a.in[3]; H.cb = a.in[4]; H.skip = a.in[14]; H.T = Ttab;
        H.TS = M; H.npairs = 2; H.off00 = 0; H.off01 = L; H.off10 = 2 * L; H.off11 = 3 * L;
        hyena_phase(lds, H, bid, G, tid, wave);
        block_sync();
        STAMP(13);
        SguArgs Sg; Sg.vT = vT; Sg.U = Ub; Sg.vss = vss; Sg.ws = a.in[16]; Sg.bs = a.in[17]; Sg.gn = a.in[15]; Sg.TS = M; Sg.ldu = 2048;
        sgu_phase(lds, Sg, bid, G, tid, wave);
    }
    bool wup_started = false;
    if (G == 256 && IN(2) && IN(3)) { xcd_barrier(xbar, WupHook{lds, a.wj.j[8].W, a.wj.j[8].g, bid, wave}); wup_started = true; STAMP(3); }
    else SEAM(2);
    if (IN(3)) { FRESH_TID;
        if (G == 256) { if (!wup_started) wup_issue(lds, a.wj.j[8].W, a.wj.j[8].g, bid, wave);
            wup_convert(lds, WupT, bid, wave);
            asm volatile("s_waitcnt lgkmcnt(0)" ::: "memory"); __builtin_amdgcn_s_barrier(); asm volatile("" ::: "memory"); }
        else { p0_weights(a.wj, 8, 9, (LAS float*)lds + wave * 4096, gw, NGW, lane); block_sync(); }
        pg8::Gemm g{Ub, PabT, M, 1024, 2048, 2048, 2048, yaT, M, 16}; pg8::StaticOrder S; S.init(M, 1024, G, bid);
        pg8::EpiMerge E{Gb, mrg};
        pg8::gemm_phase<pg8::EpiMerge, pg8::StaticOrder, true, true>(lds, g, S, E, tid);
    }
    SEAM(3);
    if (IN(4)) { FRESH_TID;
        pg8::Gemm g{mrg, WoT, M, 1024, 1024, 1024, 1024}; pg8::StaticOrder S; S.init(M, 1024, G, bid);
        pg8::EpiResid<true> E{x, nullptr, nullptr, X1b, xss};
        pg8::gemm_phase<pg8::EpiResid<true>, pg8::StaticOrder, true, true>(lds, g, S, E, tid);
    }
    SEAM(4);
    if (IN(5)) { FRESH_TID;
        pg8::Gemm g{X1b, WupT, M, 2 * FH, 1024, 1024, 1024}; pg8::StaticOrder S; S.init(68 * 256, 2 * FH, G, bid);
        pg8::EpiUpAct E{GPb, (LAS float*)(lds + 131072), xss, a.in[23], a.in[24]};
        pg8::gemm_phase<pg8::EpiUpAct, pg8::StaticOrder, true, true>(lds, g, S, E, tid);
    }
    SEAM(5);
    if (IN(6)) { FRESH_TID;
        pg8::Gemm g{GPb, WdnT, M, 1024, FH, FH, FH}; pg8::StaticOrder S; S.init(M, 1024, G, bid);
        if (G == 256) { pg8::EpiResidNorm E{X1b, a.out, x2ss, a.in[26], (unsigned*)(ws + WS_PCNT)};
            pg8::gemm_phase<pg8::EpiResidNorm, pg8::StaticOrder, true, true>(lds, g, S, E, tid); }
        else { pg8::EpiResid<false> E{nullptr, X1b, nullptr, X1b, x2ss};
            pg8::gemm_phase<pg8::EpiResid<false>, pg8::StaticOrder, true, true>(lds, g, S, E, tid); }
    }
    if (G != 256) { SEAM(6);
        if (IN(7)) { FRESH_TID; final_norm(X1b, x2ss, a.in[26], a.out, M, gw, NGW, lane); } }
    STAMP(7); STAMP(8);
#ifdef MK_PROBE
#ifndef MK_PROBE_A
#define MK_PROBE_A MK_PROBE
#define MK_PROBE_B (MK_PROBE + 1)
#endif
    if (threadIdx.x == 0) { volatile LAS unsigned long long* ts = (volatile LAS unsigned long long*)(lds + LDS_BYTES - 128);
        unsigned long long dt = 2ull * (ts[MK_PROBE_B] - ts[MK_PROBE_A]); if (dt > 400000ull) dt = 0ull; const unsigned long long t0 = __builtin_amdgcn_s_memrealtime();
        while (__builtin_amdgcn_s_memrealtime() - t0 < dt) __builtin_amdgcn_s_sleep(8); }
    block_sync();
#endif
#undef IN
#undef SEAM
}
}

#ifndef MK_CUTS
#define MK_CUTS 0
#endif
extern "C" void kernel_launch(void* const* d_in, const int* in_sizes, int n_in, void* d_out, int out_size, void* d_ws, size_t ws_size, hipStream_t stream) {
    static int grid = 0;
    if (grid == 0) {
        int dev = 0, cus = 0, per_cu = 0;
        hipGetDevice(&dev);
        hipDeviceGetAttribute(&cus, hipDeviceAttributeMultiprocessorCount, dev);
        hipFuncSetAttribute((const void*)mega_fwd, hipFuncAttributeMaxDynamicSharedMemorySize, LDS_BYTES);
        hipOccupancyMaxActiveBlocksPerMultiprocessor(&per_cu, (const void*)mega_fwd, 512, LDS_BYTES);
        if (per_cu < 1) { fprintf(stderr, "kernel_launch: occupancy query says %d blocks per CU\n", per_cu); per_cu = 1; }
        grid = cus * 1;
        (void)hipGetLastError();
    }
    hipMemsetAsync((char*)d_ws + WS_BAR, 0, 32 * 1024, stream);
    MegaArgs a{};
    for (int i = 0; i < 27; ++i) a.in[i] = (const float*)d_in[i];
    a.out = (float*)d_out; a.ws = (unsigned char*)d_ws;
    { unsigned char* ws = (unsigned char*)d_ws;
      bf16* WtA = (bf16*)(ws + WS_WTA); bf16* WtB = (bf16*)(ws + WS_WTB); bf16* PabT = (bf16*)(ws + WS_PAB); bf16* WoT = (bf16*)(ws + WS_WO); bf16* WupT = (bf16*)(ws + WS_WUP); bf16* WdnT = (bf16*)(ws + WS_WDN);
    a.wj.j[0] = WJob{(const float*)d_in[2], nullptr, WtA, 1024, INW, 0, 3072, 1024, 0, 0, 0};
    a.wj.j[1] = WJob{(const float*)d_in[2], nullptr, WtA, 1024, INW, 4096, 1024, 1024, 3072, 0, 0};
    a.wj.j[2] = WJob{(const float*)d_in[2], nullptr, WtB, 1024, INW, 3072, 1024, 1024, 0, 0, 0};
    a.wj.j[3] = WJob{(const float*)d_in[2], nullptr, WtB, 1024, INW, 5120, 2048, 1024, 1024, 0, 0};
    a.wj.j[4] = WJob{(const float*)d_in[18], nullptr, PabT, 1024, 1024, 0, 1024, 2048, 0, 0, 0};
    a.wj.j[5] = WJob{(const float*)d_in[19], nullptr, PabT, 1024, 1024, 0, 1024, 2048, 0, 1024, 0};
    a.wj.j[6] = WJob{(const float*)d_in[20], nullptr, WoT, 1024, 1024, 0, 1024, 1024, 0, 0, 0};
        a.wj.j[7] = WJob{(const float*)d_in[25], nullptr, WdnT, FH, 1024, 0, 1024, FH, 0, 0, 0};
    a.wj.j[8] = WJob{(const float*)d_in[22], (const float*)d_in[21], WupT, 1024, 2 * FH, 0, 2 * FH, 1024, 0, 0, 1};

    }
#if MK_CUTS
    for (int p = 0; p < NPH; ++p) { a.ph_lo = p; a.ph_hi = p + 1; hipLaunchKernelGGL(mega_fwd, dim3(grid), dim3(512), LDS_BYTES, stream, a); }
#else
    a.ph_lo = 0; a.ph_hi = NPH;
    void* args[] = {&a};
    hipError_t e = hipLaunchCooperativeKernel((const void*)mega_fwd, dim3(grid), dim3(512), args, LDS_BYTES, stream);
    if (e != hipSuccess) fprintf(stderr, "cooperative launch failed: %s (grid %d)\n", hipGetErrorString(e), grid);
#endif
}
```

```cpp
#include <hip/hip_runtime.h>
#include <hip/hip_cooperative_groups.h>
#include <math.h>
#include <stdint.h>
#include <cstdio>
namespace cg = cooperative_groups;
namespace pg8 {
#define PG8_LAS __attribute__((address_space(3)))
typedef unsigned short bf16_t;
typedef short bf16x8 __attribute__((ext_vector_type(8)));
typedef float f32x4 __attribute__((ext_vector_type(4)));
typedef unsigned u32x4 __attribute__((ext_vector_type(4)));
typedef short s16x4 __attribute__((ext_vector_type(4)));
constexpr int BM = 256, BK = 64, HALF = 128, HTB = HALF * BK * 2  , STAGE_BYTES = 8 * HTB, NXCD = 8, WGM = 8;

__host__ __device__ __forceinline__ int lds_byte(int r, int c) { const int st = (r >> 4) * 2 + (c >> 5), rr = r & 15, cc = c & 31, ob = rr * 64 + cc * 2; return st * 1024 + (ob ^ (((ob >> 9) & 1) << 5)); }
__host__ __device__ __forceinline__ void stage_rc(int b, int& R, int& C) { const int st = b / 1024, sb = b % 1024, swz = sb ^ (((sb >> 9) & 1) << 5); R = (st >> 1) * 16 + swz / 64; C = (st & 1) * 32 + (swz % 64) / 2; }
__host__ __device__ __forceinline__ int perm32(int rho) { const int n = rho >> 4, i = rho & 15; return 8 * (i >> 2) + 4 * n + (i & 3); }

struct Unit { int pm, pn; };
__host__ __device__ __forceinline__ int ovl_row(int pm) { const int seq = pm / 17, i = pm % 17; int s = 254 * i - 1; s = s < 0 ? 0 : (s > 3840 ? 3840 : s); return seq * 4096 + s; }
struct Gemm { const bf16_t* A; const bf16_t* Bt; int M, N, K, lda, ldb; const bf16_t* At; int ldt, ntr; };

struct StaticOrder {
    int nM, nN, nwg, G, c;
    __host__ __device__ __forceinline__ void init(int M, int N, int G_, int c_) { nM = M / BM; nN = N / BM; nwg = nM * nN; G = G_; c = c_; }
    __host__ __device__ __forceinline__ bool next(int i, Unit& u) const {
        const long L = (long)i * G + c; if (L >= nwg) return false;
        int wgid = (int)L; { const int q = nwg / NXCD, r = nwg % NXCD, xcd = wgid % NXCD, off = wgid / NXCD; wgid = (xcd < r ? xcd * (q + 1) : r * (q + 1) + (xcd - r) * q) + off; }
        const int nig = WGM * nN, gid = wgid / nig, fm = gid * WGM, gsz = (nM - fm) < WGM ? (nM - fm) : WGM;
        u.pm = fm + ((wgid % nig) % gsz); u.pn = (wgid % nig) / gsz; return true;
    }
    __device__ __forceinline__ void a_ready(const Unit&) const {}
    __device__ __forceinline__ void done(const Unit&) const {}
};

struct HyOrder {
    int c;
    __host__ __device__ __forceinline__ void init(int c_) { c = c_; }
    __host__ __device__ __forceinline__ bool next(int i, Unit& u) const { if (i >= 4) return false; const int x = c % NXCD, j = c / NXCD; u.pm = 4 * i + (j & 3); u.pn = 8 * x + (j >> 2); return true; }
    __device__ __forceinline__ void a_ready(const Unit&) const {}
    __device__ __forceinline__ void done(const Unit&) const {}
};

__device__ __forceinline__ unsigned cvt_pk_bf16(float lo, float hi) { unsigned r; asm volatile("v_cvt_pk_bf16_f32 %0, %1, %2" : "=v"(r) : "v"(lo), "v"(hi)); return r; }
typedef float f32x2 __attribute__((ext_vector_type(2)));
__device__ __forceinline__ f32x2 gelu_pk(f32x2 v) {
    const f32x2 av = __builtin_elementwise_abs(v), d = av * 0.2316418882f + 1.0f;
    f32x2 t; t.x = __builtin_amdgcn_rcpf(d.x); t.y = __builtin_amdgcn_rcpf(d.y);
    f32x2 q = t * 0.5307027145f + (-0.7265760135f); q = q * t + 0.7107068705f; q = q * t + (-0.142248368f); q = q * t + 0.127414796f; q = q * t;
    const f32x2 s = (v * v) * (-0.72134752044f);
    f32x2 e; e.x = __builtin_amdgcn_exp2f(s.x); e.y = __builtin_amdgcn_exp2f(s.y);
    const f32x2 m = v * (q * e), r = v - m;
    f32x2 o; o.x = v.x < 0.f ? m.x : r.x; o.y = v.y < 0.f ? m.y : r.y; return o;
}

template <int ACT  > struct EpiBf16 {
    static constexpr bool PERM = true, AFTER_DRAIN = false, MID = false, OVL = false, ATR = false; static_assert(ACT == 0 || ACT == 1, "EpiBf16: ACT is 0 (none) or 1 (gelu_pk)");
    bf16_t* O; int ldc; const float* bias; int split_cols; size_t split_stride; float scale0;
    __device__ __forceinline__ void operator()(const f32x4 (&acc)[2][2][4][2], const Unit& u, int wr, int wc, int fr, int fq) const {
        const int row0 = u.pm * BM + wr * 64 + fr; int colt = u.pn * BM; bf16_t* base = O;
        float sc = 1.f; if (split_cols) { const int t = colt / split_cols; base += (size_t)t * split_stride; colt -= t * split_cols; if (t == 0) sc = scale0; }
        const int col0 = colt + wc * 32 + 8 * fq, bcol0 = u.pn * BM + wc * 32 + 8 * fq;
        f32x4 bv[2][2];
#pragma unroll
        for (int bj = 0; bj < 2; ++bj)
#pragma unroll
            for (int n = 0; n < 2; ++n) bv[bj][n] = bias ? *(const f32x4*)(bias + bcol0 + bj * HALF + 4 * n) : (f32x4){0.f, 0.f, 0.f, 0.f};
#pragma unroll
        for (int ai = 0; ai < 2; ++ai)
#pragma unroll
            for (int m = 0; m < 4; ++m) { bf16_t* rowp = base + (size_t)(row0 + ai * HALF + m * 16) * ldc + col0;
#pragma unroll
                for (int bj = 0; bj < 2; ++bj) { f32x4 v0 = acc[ai][bj][m][0] + bv[bj][0], v1 = acc[ai][bj][m][1] + bv[bj][1];
                    if (ACT == 1) { f32x2 a = gelu_pk((f32x2){v0[0], v0[1]}), b = gelu_pk((f32x2){v0[2], v0[3]}), c = gelu_pk((f32x2){v1[0], v1[1]}), d = gelu_pk((f32x2){v1[2], v1[3]});
                        v0 = (f32x4){a.x, a.y, b.x, b.y}; v1 = (f32x4){c.x, c.y, d.x, d.y}; }
                    v0 = v0 * sc; v1 = v1 * sc; u32x4 w; w.x = cvt_pk_bf16(v0[0], v0[1]); w.y = cvt_pk_bf16(v0[2], v0[3]); w.z = cvt_pk_bf16(v1[0], v1[1]); w.w = cvt_pk_bf16(v1[2], v1[3]);
                    *(u32x4*)(rowp + bj * HALF) = w; } }
    }
};

struct EpiF32 {
    static constexpr bool PERM = false, AFTER_DRAIN = false, MID = false, OVL = false, ATR = false;
    float* C; int ldc; const float* bias;
    __device__ __forceinline__ void operator()(const f32x4 (&acc)[2][2][4][2], const Unit& u, int wr, int wc, int fr, int fq) const {
        const int row0 = u.pm * BM + wr * 64 + fr, col0 = u.pn * BM + wc * 32 + 4 * fq;
        f32x4 bv[2][2];
#pragma unroll
        for (int bj = 0; bj < 2; ++bj)
#pragma unroll
            for (int n = 0; n < 2; ++n) bv[bj][n] = bias ? *(const f32x4*)(bias + col0 + bj * HALF + n * 16) : (f32x4){0.f, 0.f, 0.f, 0.f};
#pragma unroll
        for (int ai = 0; ai < 2; ++ai)
#pragma unroll
            for (int m = 0; m < 4; ++m) { float* rowp = C + (size_t)(row0 + ai * HALF + m * 16) * ldc + col0;
#pragma unroll
                for (int bj = 0; bj < 2; ++bj)
#pragma unroll
                    for (int n = 0; n < 2; ++n) *(f32x4*)(rowp + bj * HALF + n * 16) = acc[ai][bj][m][n] + bv[bj][n]; }
    }
};

template <class E, class = void> struct epi_nst { static constexpr int v = 0; };
template <class E> struct epi_nst<E, decltype((void)E::NST)> { static constexpr int v = E::NST; };
template <int N> __device__ __forceinline__ void pg8_wait_v8_or(int relaxed) {
    asm volatile("s_cmp_lg_u32 %0, 0\n\ts_cbranch_scc1 .Lpg8rl%=\n\ts_waitcnt vmcnt(8)\n\ts_branch .Lpg8rd%=\n.Lpg8rl%=:\n\ts_waitcnt vmcnt(%1)\n.Lpg8rd%=:" :: "s"(relaxed), "n"(N) : "memory", "scc"); }
template <class Epi, class Sched, bool ALIGN_EPI = false, bool SP2 = false>
__device__ __forceinline__ void gemm_phase(PG8_LAS unsigned char* lds, const Gemm g, const Sched& S, const Epi& E, const int tid) {
    const int wid = __builtin_amdgcn_readfirstlane(tid >> 6), lane = tid & 63, wr = wid >> 2, wc = wid & 3, fr = lane & 15, fq = lane >> 4;
    const int K = g.K, nt = K / BK;
    unsigned voffA[2], voffB[2];
#pragma unroll
    for (int i = 0; i < 2; ++i) { int R, C; stage_rc(tid * 16 + i * 8192, R, C); const int Rb = Epi::PERM ? ((R & ~31) + perm32(R & 31)) : R;
        voffA[i] = (unsigned)(R * g.lda + C) * 2u; voffB[i] = (unsigned)(Rb * g.ldb + C) * 2u; }
    unsigned voffT[2] = {0u, 0u}; unsigned trb = 0u, trx = 0u; const int ntr = Epi::ATR ? g.ntr : 0; const size_t kstepT = (size_t)BK * g.ldt * 2;
    if constexpr (Epi::ATR) {
#pragma unroll
        for (int i = 0; i < 2; ++i) { const int r = 4 * (i * 8 + wid) + (lane >> 4), pch = lane & 15, ch = pch ^ (((r & 3) << 2) | ((r >> 2) & 3)); voffT[i] = (unsigned)(r * g.ldt + 8 * ch) * 2u; }
        const int q = fr >> 2, pp = fr & 3, f0 = (q << 2) | ((2 * fq) & 3);
        trb = (unsigned)(2048 * fq + 256 * q + 8 * (pp & 1)); trx = 16u * (unsigned)(((8 * wr) | (pp >> 1)) ^ f0);
    }
    const size_t kstep = (size_t)(BK * 2);
    const size_t hstepA = (size_t)HALF * g.lda * 2, hstepB = (size_t)HALF * g.ldb * 2;
    const size_t tstepA = 2 * hstepA, tstepB = 2 * hstepB;
    const unsigned ldsw = (unsigned)wid * 1024u;
    const int aoff = lds_byte(wr * 64 + fr, fq * 8), boff = lds_byte(wc * 32 + fr, fq * 8);
#define PG8_SA(b, h) (((b) * 2 + (h)) * HTB)
#define PG8_SB(b, h) ((4 + (b) * 2 + (h)) * HTB)
#define PG8_STAGE(bufoff, gbase, voff) do { _Pragma("unroll") for (int _i = 0; _i < 2; ++_i) \
        __builtin_amdgcn_global_load_lds((const unsigned*)((const char*)(gbase) + (voff)[_i]), (PG8_LAS unsigned*)(lds + (bufoff) + ldsw + _i * 8192), 16, 0, 0); } while (0)
#define PG8_LDA(dst, b, h) do { _Pragma("unroll") for (int m = 0; m < 4; ++m) _Pragma("unroll") for (int k = 0; k < 2; ++k) dst[m][k] = *(const PG8_LAS bf16x8*)(lds + PG8_SA(b, h) + aoff + m * 2048 + k * 1024); } while (0)
#define PG8_STAGE_A(bufoff, nbase, tbase, tile, half) do { if (Epi::ATR && (tile) < ntr) PG8_STAGE(bufoff, (tbase) + (size_t)(tile) * kstepT + (half) * 256, voffT); \
        else PG8_STAGE(bufoff, (nbase) + (size_t)((tile) - ntr) * kstep + (half) * hstepA, voffA); } while (0)
#define PG8_LDA_TR(dst, b, h) do { _Pragma("unroll") for (int m = 0; m < 4; ++m) _Pragma("unroll") for (int k = 0; k < 2; ++k) { \
        const s16x4 lo_ = __builtin_amdgcn_ds_read_tr16_b64_v4i16((PG8_LAS s16x4*)(lds + PG8_SA(b, h) + trb + (trx ^ (unsigned)(32 * m)) + 8192 * k)); \
        const s16x4 hi_ = __builtin_amdgcn_ds_read_tr16_b64_v4i16((PG8_LAS s16x4*)(lds + PG8_SA(b, h) + trb + (trx ^ (unsigned)(32 * m + 16)) + 8192 * k + 1024)); \
        dst[m][k] = __builtin_shufflevector(lo_, hi_, 0, 1, 2, 3, 4, 5, 6, 7); } } while (0)
#define PG8_LDA_X(dst, b, h, tile) do { if (Epi::ATR && (tile) < ntr) PG8_LDA_TR(dst, b, h); else PG8_LDA(dst, b, h); } while (0)
#define PG8_LDB(dst, b, h) do { _Pragma("unroll") for (int n = 0; n < 2; ++n) _Pragma("unroll") for (int k = 0; k < 2; ++k) dst[n][k] = *(const PG8_LAS bf16x8*)(lds + PG8_SB(b, h) + boff + n * 2048 + k * 1024); } while (0)
#define PG8_MMA(ai, bj, At, Bt) do { __builtin_amdgcn_s_setprio(1); _Pragma("unroll") for (int m = 0; m < 4; ++m) _Pragma("unroll") for (int n = 0; n < 2; ++n) _Pragma("unroll") for (int k = 0; k < 2; ++k) \
        acc[ai][bj][m][n] = __builtin_amdgcn_mfma_f32_16x16x32_bf16(Bt[n][k], At[m][k], acc[ai][bj][m][n], 0, 0, 0); __builtin_amdgcn_s_setprio(0); } while (0)
#define PG8_WAIT_V(n) asm volatile("s_waitcnt vmcnt(" #n ")" ::: "memory")
#define PG8_WAIT_L(n) asm volatile("s_waitcnt lgkmcnt(" #n ")" ::: "memory")
#define PG8_BAR __builtin_amdgcn_s_barrier()
#define PG8_SCHED __builtin_amdgcn_sched_barrier(0)
    Unit cur, nxt; int ui = 0;
    if (!S.next(0, cur)) return;
    f32x4 acc[2][2][4][2];
#pragma unroll
    for (int a = 0; a < 2; ++a)
#pragma unroll
        for (int b = 0; b < 2; ++b)
#pragma unroll
            for (int m = 0; m < 4; ++m)
#pragma unroll
                for (int n = 0; n < 2; ++n) acc[a][b][m][n] = (f32x4){0.f, 0.f, 0.f, 0.f};
    bf16x8 At[4][2], B0[2][2], B1[2][2];
    const char* cA = (const char*)g.A + (size_t)(Epi::OVL ? ovl_row(cur.pm) : cur.pm * BM) * (tstepA / BM); const char* cB = (const char*)g.Bt + (size_t)cur.pn * tstepB;
    const char* cT = Epi::ATR ? (const char*)g.At + (size_t)cur.pm * BM * 2 : nullptr;
    S.a_ready(cur);
    if constexpr (SP2) {
        PG8_STAGE(PG8_SB(0, 0), cB, voffB); PG8_STAGE(PG8_SB(0, 1), cB + hstepB, voffB); PG8_STAGE_A(PG8_SA(0, 0), cA, cT, 0, 0); PG8_STAGE_A(PG8_SA(0, 1), cA, cT, 0, 1);
        if (wr == 1) PG8_BAR;
        PG8_WAIT_V(2); PG8_BAR;
        PG8_STAGE(PG8_SB(1, 0), cB + kstep, voffB); PG8_STAGE_A(PG8_SA(1, 0), cA, cT, 1, 0); PG8_STAGE(PG8_SB(1, 1), cB + hstepB + kstep, voffB);
        PG8_WAIT_V(6); PG8_BAR;
    } else {
        PG8_STAGE(PG8_SB(0, 0), cB, voffB); PG8_STAGE(PG8_SA(0, 0), cA, voffA); PG8_STAGE(PG8_SB(0, 1), cB + hstepB, voffB); PG8_STAGE(PG8_SA(0, 1), cA + hstepA, voffA);
        if (wr == 1) PG8_BAR;
        PG8_WAIT_V(4); PG8_BAR;
        PG8_STAGE(PG8_SB(1, 0), cB + kstep, voffB); PG8_STAGE(PG8_SA(1, 0), cA + kstep, voffA); PG8_STAGE(PG8_SB(1, 1), cB + hstepB + kstep, voffB);
        PG8_WAIT_V(6); PG8_BAR;
    }
    for (;;) {
        const bool has_next = S.next(ui + 1, nxt);
        const char* nA = has_next ? (const char*)g.A + (size_t)(Epi::OVL ? ovl_row(nxt.pm) : nxt.pm * BM) * (tstepA / BM) : cA; const char* nB = has_next ? (const char*)g.Bt + (size_t)nxt.pn * tstepB : cB;
        const char* nT = (Epi::ATR && has_next) ? (const char*)g.At + (size_t)nxt.pm * BM * 2 : cT;
        for (int t = 0; t < nt; t += 2) {
            const bool last = (t == nt - 2);
            const char* a1 = cA + (size_t)(t + 1) * kstep;
            const char* a2 = last ? nA : cA + (size_t)(t + 2) * kstep; const char* b2 = last ? nB : cB + (size_t)(t + 2) * kstep;
            const char* a3 = a2 + kstep; const char* b3 = b2 + kstep;
            if (last && has_next) S.a_ready(nxt);
            if constexpr (Epi::MID) { if (t == (nt >> 1)) E.mid(acc, cur, wr, wc, fr, fq); }
            if constexpr (SP2) {
            const int after_epi = __builtin_amdgcn_readfirstlane((epi_nst<Epi>::v > 0 && t == 0 && ui > 0) ? 1 : 0);
            PG8_LDB(B0, 0, 0); PG8_LDB(B1, 0, 1); PG8_SCHED; PG8_LDA_X(At, 0, 0, t); PG8_STAGE_A(PG8_SA(1, 1), cA, cT, t + 1, 1);
            if constexpr (epi_nst<Epi>::v > 0) pg8_wait_v8_or<8 + epi_nst<Epi>::v>(after_epi); else PG8_WAIT_V(8);
            PG8_WAIT_L(0); PG8_BAR; PG8_MMA(0, 0, At, B0); PG8_MMA(0, 1, At, B1); PG8_BAR; PG8_SCHED;
            PG8_LDA_X(At, 0, 1, t); PG8_STAGE(PG8_SB(0, 0), b2, voffB); PG8_STAGE(PG8_SB(0, 1), b2 + hstepB, voffB); PG8_STAGE_A(PG8_SA(0, 0), last ? nA : cA, last ? nT : cT, last ? 0 : t + 2, 0);
            if constexpr (epi_nst<Epi>::v > 0) pg8_wait_v8_or<8 + epi_nst<Epi>::v>(after_epi); else PG8_WAIT_V(8);
            PG8_WAIT_L(0); PG8_BAR; PG8_MMA(1, 0, At, B0); PG8_MMA(1, 1, At, B1); PG8_BAR; PG8_SCHED;
            PG8_LDB(B0, 1, 0); PG8_LDB(B1, 1, 1); PG8_SCHED; PG8_LDA_X(At, 1, 0, t + 1); PG8_STAGE_A(PG8_SA(0, 1), last ? nA : cA, last ? nT : cT, last ? 0 : t + 2, 1);
            PG8_WAIT_V(8); PG8_WAIT_L(0); PG8_BAR; PG8_MMA(0, 0, At, B0); PG8_MMA(0, 1, At, B1); PG8_BAR; PG8_SCHED;
            PG8_LDA_X(At, 1, 1, t + 1); PG8_STAGE(PG8_SB(1, 0), b3, voffB); PG8_STAGE(PG8_SB(1, 1), b3 + hstepB, voffB); PG8_STAGE_A(PG8_SA(1, 0), last ? nA : cA, last ? nT : cT, last ? 1 : t + 3, 0);
            PG8_WAIT_V(8); PG8_WAIT_L(0); PG8_BAR; PG8_MMA(1, 0, At, B0); PG8_MMA(1, 1, At, B1); PG8_BAR; PG8_SCHED;
            } else {
            PG8_LDB(B0, 0, 0); PG8_SCHED; PG8_LDA(At, 0, 0); PG8_STAGE(PG8_SA(1, 1), a1 + hstepA, voffA);
            PG8_WAIT_L(8); PG8_BAR; PG8_WAIT_L(0); PG8_MMA(0, 0, At, B0); PG8_BAR; PG8_SCHED;
            PG8_LDB(B1, 0, 1); PG8_STAGE(PG8_SB(0, 0), b2, voffB);
            PG8_BAR; PG8_WAIT_L(0); PG8_MMA(0, 1, At, B1); PG8_BAR;
            PG8_LDA(At, 0, 1); PG8_STAGE(PG8_SA(0, 0), a2, voffA);
            PG8_BAR; PG8_WAIT_L(0); PG8_MMA(1, 0, At, B0); PG8_BAR; PG8_SCHED;
            PG8_STAGE(PG8_SB(0, 1), b2 + hstepB, voffB);
            PG8_WAIT_V(6); PG8_BAR; PG8_MMA(1, 1, At, B1); PG8_BAR;
            PG8_LDB(B0, 1, 0); PG8_SCHED; PG8_LDA(At, 1, 0); PG8_STAGE(PG8_SA(0, 1), a2 + hstepA, voffA);
            PG8_WAIT_L(8); PG8_BAR; PG8_WAIT_L(0); PG8_MMA(0, 0, At, B0); PG8_BAR; PG8_SCHED;
            PG8_LDB(B1, 1, 1); PG8_STAGE(PG8_SB(1, 0), b3, voffB);
            PG8_BAR; PG8_WAIT_L(0); PG8_MMA(0, 1, At, B1); PG8_BAR;
            PG8_LDA(At, 1, 1); PG8_STAGE(PG8_SA(1, 0), a3, voffA);
            PG8_BAR; PG8_WAIT_L(0); PG8_MMA(1, 0, At, B0); PG8_BAR; PG8_SCHED;
            PG8_STAGE(PG8_SB(1, 1), b3 + hstepB, voffB);
            PG8_WAIT_V(6); PG8_BAR; PG8_MMA(1, 1, At, B1); PG8_BAR;
            }
        }
        if constexpr (ALIGN_EPI) { if (wr == 0) PG8_BAR; }
        if constexpr (!Epi::AFTER_DRAIN) { E(acc, cur, wr, wc, fr, fq); S.done(cur); }
        if (!has_next) break;
#pragma unroll
        for (int a = 0; a < 2; ++a)
#pragma unroll
            for (int b = 0; b < 2; ++b)
#pragma unroll
                for (int m = 0; m < 4; ++m)
#pragma unroll
                    for (int n = 0; n < 2; ++n) acc[a][b][m][n] = (f32x4){0.f, 0.f, 0.f, 0.f};
        cur = nxt; cA = nA; cB = nB; cT = nT; ++ui;
        if constexpr (ALIGN_EPI) { if (wr == 1) PG8_BAR; }
    }
    PG8_WAIT_V(0);
    if constexpr (!ALIGN_EPI) { if (wr == 0) PG8_BAR; }
    PG8_BAR;
    if constexpr (Epi::AFTER_DRAIN) { E.fused(acc, cur, wr, wc, fr, fq, lds, wid, lane); S.done(cur); }
#undef PG8_SA
#undef PG8_SB
#undef PG8_STAGE
#undef PG8_LDA
#undef PG8_LDB
#undef PG8_STAGE_A
#undef PG8_LDA_TR
#undef PG8_LDA_X
#undef PG8_MMA
#undef PG8_WAIT_V
#undef PG8_WAIT_L
#undef PG8_BAR
#undef PG8_SCHED
}
}
namespace {
constexpr int D = 1024, NB = 4, L = 4096, HW = 1024, SW = 1024, INW = 7168, FH = 2816, FHID = 64, FEMB = 33;
constexpr float EPS = 1e-6f;
typedef unsigned short bf16;
__device__ __forceinline__ unsigned f2bf(float f) { unsigned u = __builtin_bit_cast(unsigned, f); return (u + 0x7fffu + ((u >> 16) & 1u)) >> 16; }
__device__ __forceinline__ void block_sync() { __builtin_amdgcn_fence(__ATOMIC_RELEASE, "workgroup"); __builtin_amdgcn_s_barrier(); __builtin_amdgcn_fence(__ATOMIC_ACQUIRE, "workgroup"); }
}
namespace {
#define HD __device__ __forceinline__
#define FFT_OPAQUE(w) asm volatile("" : "+v"((w).x), "+v"((w).y))
#ifndef HD
#define HD inline
#endif
typedef float cfv __attribute__((ext_vector_type(2)));
struct cf { float x, y; };
HD cf cmk(float x, float y) { cf r; r.x = x; r.y = y; return r; }
template <class P> HD cf ldz(P Z, int i) { const cfv t = Z[i]; return cmk(t.x, t.y); }
#ifdef __HIP_DEVICE_COMPILE__
typedef __attribute__((address_space(3))) cfv* lcf_t_;
HD cf ldz(lcf_t_ Z, int i) { const cfv t = *(volatile __attribute__((address_space(3))) cfv*)(Z + i); return cmk(t.x, t.y); }
#endif
template <class P> HD void stz(P Z, int i, cf v) { Z[i] = (cfv){v.x, v.y}; }
HD cf cadd(cf a, cf b) { return cmk(a.x + b.x, a.y + b.y); }
HD cf csub(cf a, cf b) { return cmk(a.x - b.x, a.y - b.y); }
HD cf cmul(cf a, cf b) { return cmk(a.x * b.x - a.y * b.y, a.x * b.y + a.y * b.x); }
HD cf cconj(cf a) { return cmk(a.x, -a.y); }
template <bool INV> HD cf mulmi(cf a) { return INV ? cmk(-a.y, a.x) : cmk(a.y, -a.x); }
template <bool INV> HD cf twc(float c, float s) { return INV ? cmk(c, s) : cmk(c, -s); }
HD int fpad(int p) { return p + (p >> 4); }
constexpr int FSUB = 4352;

template <bool INV> HD void dft4(cf& a, cf& b, cf& c, cf& d) {
    const cf t0 = cadd(a, c), t1 = csub(a, c), t2 = cadd(b, d), t3 = mulmi<INV>(csub(b, d));
    a = cadd(t0, t2); b = cadd(t1, t3); c = csub(t0, t2); d = csub(t1, t3);
}
template <bool INV> HD void dft16(cf (&v)[16]) {
    constexpr float C1 = 0.92387953251128674f, S1 = 0.38268343236508977f, R = 0.70710678118654752f;
#pragma unroll
    for (int n0 = 0; n0 < 4; ++n0) dft4<INV>(v[n0], v[n0 + 4], v[n0 + 8], v[n0 + 12]);
    v[1 + 4 * 1] = cmul(v[1 + 4 * 1], twc<INV>(C1, S1));
    v[1 + 4 * 2] = cmul(v[1 + 4 * 2], twc<INV>(R, R));
    v[1 + 4 * 3] = cmul(v[1 + 4 * 3], twc<INV>(S1, C1));
    v[2 + 4 * 1] = cmul(v[2 + 4 * 1], twc<INV>(R, R));
    v[2 + 4 * 2] = mulmi<INV>(v[2 + 4 * 2]);
    v[2 + 4 * 3] = cmul(v[2 + 4 * 3], twc<INV>(-R, R));
    v[3 + 4 * 1] = cmul(v[3 + 4 * 1], twc<INV>(S1, C1));
    v[3 + 4 * 2] = cmul(v[3 + 4 * 2], twc<INV>(-R, R));
    v[3 + 4 * 3] = cmul(v[3 + 4 * 3], twc<INV>(-C1, -S1));
#pragma unroll
    for (int k0 = 0; k0 < 4; ++k0) dft4<INV>(v[4 * k0], v[4 * k0 + 1], v[4 * k0 + 2], v[4 * k0 + 3]);
    cf t;
    t = v[1]; v[1] = v[4]; v[4] = t;   t = v[2]; v[2] = v[8]; v[8] = t;   t = v[3]; v[3] = v[12]; v[12] = t;
    t = v[6]; v[6] = v[9]; v[9] = t;   t = v[7]; v[7] = v[13]; v[13] = t; t = v[11]; v[11] = v[14]; v[14] = t;
}
#ifndef FFT_OPAQUE
#define FFT_OPAQUE(w)
#endif
HD void twiddle16(cf (&v)[16], cf w) {
    FFT_OPAQUE(w);
    cf p = w;
#pragma unroll
    for (int k = 1; k < 16; ++k) { v[k] = cmul(v[k], p); if (k < 15) p = cmul(p, w); }
}
template <bool CONJ> HD void twiddle16t(cf (&v)[16], const cf (&tw)[15]) {
#pragma unroll
    for (int k = 1; k < 16; ++k) v[k] = cmul(v[k], CONJ ? cconj(tw[k - 1]) : tw[k - 1]);
}
HD void twpowers(cf w, cf (&tw)[15]) { tw[0] = w;
#pragma unroll
    for (int k = 1; k < 15; ++k) tw[k] = cmul(tw[k - 1], w); }
template <class P> HD void fwd_pass1(P Z, int t, cf w1) {
    cf v[16]; const int b = t + (t >> 4);
#pragma unroll
    for (int j = 0; j < 16; ++j) v[j] = ldz(Z, b + 272 * j);
    dft16<false>(v); twiddle16(v, w1);
#pragma unroll
    for (int j = 0; j < 16; ++j) stz(Z, b + 272 * j, v[j]);
}
template <class P> HD void fwd_pass2(P Z, int t, cf w2) {
    const int b = 272 * (t >> 4) + (t & 15);
    cf v[16];
#pragma unroll
    for (int j = 0; j < 16; ++j) v[j] = ldz(Z, b + 17 * j);
    dft16<false>(v); twiddle16(v, w2);
#pragma unroll
    for (int j = 0; j < 16; ++j) stz(Z, b + 17 * j, v[j]);
}
template <class P> HD void fwd_pass1t(P Z, int t, const cf (&tw)[15]) {
    cf v[16]; const int b = t + (t >> 4);
#pragma unroll
    for (int j = 0; j < 16; ++j) v[j] = ldz(Z, b + 272 * j);
    dft16<false>(v); twiddle16t<false>(v, tw);
#pragma unroll
    for (int j = 0; j < 16; ++j) stz(Z, b + 272 * j, v[j]);
}
template <class P> HD void fwd_pass2t(P Z, int t, const cf (&tw)[15]) {
    const int b = 272 * (t >> 4) + (t & 15);
    cf v[16];
#pragma unroll
    for (int j = 0; j < 16; ++j) v[j] = ldz(Z, b + 17 * j);
    dft16<false>(v); twiddle16t<false>(v, tw);
#pragma unroll
    for (int j = 0; j < 16; ++j) stz(Z, b + 17 * j, v[j]);
}
template <class P> HD void inv_pass2t(P Z, int t, const cf (&tw)[15]) {
    const int b = 272 * (t >> 4) + (t & 15);
    cf v[16];
#pragma unroll
    for (int j = 0; j < 16; ++j) v[j] = ldz(Z, b + 17 * j);
    twiddle16t<true>(v, tw); dft16<true>(v);
#pragma unroll
    for (int j = 0; j < 16; ++j) stz(Z, b + 17 * j, v[j]);
}
template <class P> HD void inv_pass3t(P Z, int t, const cf (&tw)[15]) {
    cf v[16]; const int b = t + (t >> 4);
#pragma unroll
    for (int j = 0; j < 16; ++j) v[j] = ldz(Z, b + 272 * j);
    twiddle16t<true>(v, tw); dft16<true>(v);
#pragma unroll
    for (int j = 0; j < 16; ++j) stz(Z, b + 272 * j, v[j]);
}
template <class P> HD void fwd_pass3_load(P Z, int t, cf (&v)[16]) {
#pragma unroll
    for (int j = 0; j < 16; ++j) v[j] = ldz(Z, 17 * t + j);
    dft16<false>(v);
}
template <class P> HD void inv_pass1_store(P Z, int t, cf (&v)[16]) {
    dft16<true>(v);
#pragma unroll
    for (int j = 0; j < 16; ++j) stz(Z, 17 * t + j, v[j]);
}
template <class P> HD void inv_pass2(P Z, int t, cf w2) {
    const int b = 272 * (t >> 4) + (t & 15);
    cf v[16];
#pragma unroll
    for (int j = 0; j < 16; ++j) v[j] = ldz(Z, b + 17 * j);
    twiddle16(v, cconj(w2)); dft16<true>(v);
#pragma unroll
    for (int j = 0; j < 16; ++j) stz(Z, b + 17 * j, v[j]);
}
template <class P> HD void inv_pass3(P Z, int t, cf w1) {
    cf v[16]; const int b = t + (t >> 4);
#pragma unroll
    for (int j = 0; j < 16; ++j) v[j] = ldz(Z, b + 272 * j);
    twiddle16(v, cconj(w1)); dft16<true>(v);
#pragma unroll
    for (int j = 0; j < 16; ++j) stz(Z, b + 272 * j, v[j]);
}
#define LAS __attribute__((address_space(3)))
typedef LAS cfv* lcf;
struct HyArgs {
    const bf16* hyT;
    bf16* yaT;
    const float* fsum;
    const float* fdif;
    const float* cw;
    const float* cb;
    const float* skip;
    const cfv* T;
    int TS, npairs, off00, off01, off10, off11;
};
__device__ __forceinline__ float bf2f(unsigned h) { return __builtin_bit_cast(float, h << 16); }
constexpr int HOFF_SX1 = 2 * FSUB * 8, HOFF_SV = HOFF_SX1 + 16384, HOFF_SX0 = HOFF_SV + 16384, HOFF_SF = HOFF_SX0 + 16384, HY_LDS_END = HOFF_SF + 32768;
#define HBAR() do { asm volatile("s_waitcnt lgkmcnt(0)" ::: "memory"); __builtin_amdgcn_s_barrier(); asm volatile("" ::: "memory"); } while (0)
#define HDMA_WAIT() asm volatile("s_waitcnt vmcnt(0)" ::: "memory")
#define WAVE_FENCE() asm volatile("s_waitcnt lgkmcnt(0)" ::: "memory")
__device__ __forceinline__ void hdma16(const void* gp, LAS unsigned char* wave_dst) { __builtin_amdgcn_global_load_lds((const unsigned*)gp, (LAS unsigned*)wave_dst, 16, 0, 0); }
__device__ __forceinline__ void conv8s(const LAS unsigned char* S, int tid, float w0, float w1, float w2, float b, float (&o)[8]) {
    const pg8::u32x4 q = *(const LAS pg8::u32x4*)(S + 16 * tid);
    const unsigned lft = *(const LAS unsigned short*)(S + (tid > 0 ? 16 * tid - 2 : 0)), rgt = *(const LAS unsigned short*)(S + (tid < 511 ? 16 * tid + 16 : 8190));
    float x[10];
    x[0] = tid > 0 ? bf2f(lft) : 0.f; x[9] = tid < 511 ? bf2f(rgt) : 0.f;
    x[1] = bf2f(q.x & 0xffffu); x[2] = bf2f(q.x >> 16); x[3] = bf2f(q.y & 0xffffu); x[4] = bf2f(q.y >> 16);
    x[5] = bf2f(q.z & 0xffffu); x[6] = bf2f(q.z >> 16); x[7] = bf2f(q.w & 0xffffu); x[8] = bf2f(q.w >> 16);
#pragma unroll
    for (int i = 0; i < 8; ++i) o[i] = b + w0 * x[i] + w1 * x[i + 1] + w2 * x[i + 2];
}
__device__ __forceinline__ pg8::u32x4 pack8(const float (&x)[8], const float (&y)[8]) {
    pg8::u32x4 w;
    w.x = f2bf(x[0] * y[0]) | (f2bf(x[1] * y[1]) << 16); w.y = f2bf(x[2] * y[2]) | (f2bf(x[3] * y[3]) << 16);
    w.z = f2bf(x[4] * y[4]) | (f2bf(x[5] * y[5]) << 16); w.w = f2bf(x[6] * y[6]) | (f2bf(x[7] * y[7]) << 16);
    return w;
}
__device__ __forceinline__ void hyena_phase(LAS unsigned char* lds, const HyArgs& A, int first, int stride, const int tid, const int wave) {
    lcf Z = (lcf)lds;
    const int s = tid >> 8, t = tid & 255, pb = 8 * tid + (tid >> 1);
    const cf w1 = ldz(A.T, 2 * t), w2 = ldz(A.T, 32 * (t & 15)), wp = ldz(A.T, 8 * tid);
    lcf Zs = Z + s * FSUB;
    cf t1[15], t2[15]; twpowers(w1, t1); twpowers(w2, t2);
    LAS unsigned char* wdst = lds + wave * 1024;
    constexpr float W8C[8] = {1.0f, 0.99999970586f, 0.99999882345f, 0.99999735277f, 0.99999529381f, 0.99999264659f, 0.99998941108f, 0.99998558731f};
    constexpr float W8S[8] = {0.0f, 0.00076699031874f, 0.0015339801863f, 0.0023009691514f, 0.0030679567630f, 0.0038349425697f, 0.0046019261204f, 0.0053689069640f};
    if (first >= 1024) return;
#define ISSUE_PAIR(cc, oa, ob) do { \
        hdma16(A.hyT + (size_t)(1024 + (cc)) * A.TS + (oa) + 8 * tid, wdst + HOFF_SX1); hdma16(A.hyT + (size_t)(1024 + (cc)) * A.TS + (ob) + 8 * tid, wdst + HOFF_SX1 + 8192); \
        hdma16(A.hyT + (size_t)(2048 + (cc)) * A.TS + (oa) + 8 * tid, wdst + HOFF_SV);  hdma16(A.hyT + (size_t)(2048 + (cc)) * A.TS + (ob) + 8 * tid, wdst + HOFF_SV + 8192); } while (0)
#define ISSUE_X0(cc, oa, ob) do { hdma16(A.hyT + (size_t)(cc) * A.TS + (oa) + 8 * tid, wdst + HOFF_SX0); hdma16(A.hyT + (size_t)(cc) * A.TS + (ob) + 8 * tid, wdst + HOFF_SX0 + 8192); } while (0)
#define ISSUE_FILT(cc) do { \
        hdma16(A.fsum + (size_t)(cc) * 4096 + 8 * tid, wdst + HOFF_SF); hdma16(A.fsum + (size_t)(cc) * 4096 + 8 * tid + 4, wdst + HOFF_SF + 8192); \
        hdma16(A.fdif + (size_t)(cc) * 4096 + 8 * tid, wdst + HOFF_SF + 16384); hdma16(A.fdif + (size_t)(cc) * 4096 + 8 * tid + 4, wdst + HOFF_SF + 24576); } while (0)
    ISSUE_FILT(first); ISSUE_PAIR(first, A.off00, A.off01);
    for (int c = first; c < 1024; c += stride) {
        const int cn = c + stride;
        const float sk = A.skip[c];
        const float cx0 = A.cw[c], cx1 = A.cw[3072 + c], cx2 = A.cw[6144 + c], cxb = A.cb[c];
        const float ca0 = A.cw[1024 + c], ca1 = A.cw[3072 + 1024 + c], ca2 = A.cw[6144 + 1024 + c], cab = A.cb[1024 + c];
        const float cv0 = A.cw[2048 + c], cv1 = A.cw[3072 + 2048 + c], cv2 = A.cw[6144 + 2048 + c], cvb = A.cb[2048 + c];
        cf Kr[16];
        HDMA_WAIT();
        {
            const pg8::f32x4 s0 = *(const LAS pg8::f32x4*)(lds + HOFF_SF + 16 * tid), s1 = *(const LAS pg8::f32x4*)(lds + HOFF_SF + 8192 + 16 * tid);
            const pg8::f32x4 d0 = *(const LAS pg8::f32x4*)(lds + HOFF_SF + 16384 + 16 * tid), d1 = *(const LAS pg8::f32x4*)(lds + HOFF_SF + 24576 + 16 * tid);
            const float fs[8] = {s0[0], s0[1], s0[2], s0[3], s1[0], s1[1], s1[2], s1[3]}, fd[8] = {d0[0], d0[1], d0[2], d0[3], d1[0], d1[1], d1[2], d1[3]};
#pragma unroll
            for (int i = 0; i < 8; ++i) { cf wq = wp; FFT_OPAQUE(wq); const cf tw = cmul(wq, cmk(W8C[i], -W8S[i])); stz(Z, pb + i, cmk(fs[i], 0.f)); stz(Z, FSUB + pb + i, cmk(fd[i] * tw.x, fd[i] * tw.y)); }
        }
        HBAR();
        fwd_pass1t(Zs, t, t1); HBAR();
        fwd_pass2t(Zs, t, t2); WAVE_FENCE();
        fwd_pass3_load(Zs, t, Kr);
#pragma unroll
        for (int j = 0; j < 16; ++j) { Kr[j].x *= (1.0f / 8192.0f); Kr[j].y *= (1.0f / 8192.0f); }
        HBAR();
        for (int p = 0; p < A.npairs; ++p) {
            const int o0 = p ? A.off10 : A.off00, o1 = p ? A.off11 : A.off01;
            float u0[8], u1[8];
            {
                float a[8], b[8];
                conv8s(lds + HOFF_SX1, tid, ca0, ca1, ca2, cab, a); conv8s(lds + HOFF_SV, tid, cv0, cv1, cv2, cvb, b);
#pragma unroll
                for (int i = 0; i < 8; ++i) u0[i] = a[i] * b[i];
                conv8s(lds + HOFF_SX1 + 8192, tid, ca0, ca1, ca2, cab, a); conv8s(lds + HOFF_SV + 8192, tid, cv0, cv1, cv2, cvb, b);
#pragma unroll
                for (int i = 0; i < 8; ++i) u1[i] = a[i] * b[i];
            }
#pragma unroll
            for (int i = 0; i < 8; ++i) { cf wq = wp; FFT_OPAQUE(wq); const cf tw = cmul(wq, cmk(W8C[i], -W8S[i])); const cf z = cmk(u0[i], u1[i]); stz(Z, pb + i, z); stz(Z, FSUB + pb + i, cmul(z, tw)); }
            HBAR();
            ISSUE_X0(c, o0, o1);
            if (p + 1 < A.npairs) ISSUE_PAIR(c, A.off10, A.off11);
            else if (cn < 1024) { ISSUE_PAIR(cn, A.off00, A.off01); ISSUE_FILT(cn); }
            fwd_pass1t(Zs, t, t1); HBAR();
            fwd_pass2t(Zs, t, t2); WAVE_FENCE();
            {
                cf v[16];
                fwd_pass3_load(Zs, t, v);
#pragma unroll
                for (int j = 0; j < 16; ++j) v[j] = cmul(v[j], Kr[j]);
                inv_pass1_store(Zs, t, v);
            }
            WAVE_FENCE();
            inv_pass2t(Zs, t, t2); HBAR();
            inv_pass3t(Zs, t, t1);
            HDMA_WAIT(); HBAR();
            {
                float y0[8], y1[8];
#pragma unroll
                for (int i = 0; i < 8; ++i) { cf wq = wp; FFT_OPAQUE(wq); const cf tw = cmul(wq, cmk(W8C[i], -W8S[i])); const cf e = ldz(Z, pb + i), o = ldz(Z, FSUB + pb + i); const cf y = cadd(e, cmul(o, cconj(tw))); y0[i] = y.x + sk * u0[i]; y1[i] = y.y + sk * u1[i]; }
                float x0c[8];
                conv8s(lds + HOFF_SX0, tid, cx0, cx1, cx2, cxb, x0c);
                *(pg8::u32x4*)(A.yaT + (size_t)c * A.TS + o0 + 8 * tid) = pack8(x0c, y0);
                if (o1 != o0) { conv8s(lds + HOFF_SX0 + 8192, tid, cx0, cx1, cx2, cxb, x0c); *(pg8::u32x4*)(A.yaT + (size_t)c * A.TS + o1 + 8 * tid) = pack8(x0c, y1); }
            }
        }
    }
    HDMA_WAIT(); HBAR();
#undef ISSUE_PAIR
#undef ISSUE_X0
#undef ISSUE_FILT
}
}
namespace pg8 {
__device__ __forceinline__ f32x2 sigmoid_pk(f32x2 v) {
    f32x2 e; e.x = __builtin_amdgcn_exp2f(v.x * -1.4426950408889634f); e.y = __builtin_amdgcn_exp2f(v.y * -1.4426950408889634f);
    f32x2 o; o.x = __builtin_amdgcn_rcpf(1.0f + e.x); o.y = __builtin_amdgcn_rcpf(1.0f + e.y); return o;
}
struct EpiHyT {
    static constexpr bool PERM = true, AFTER_DRAIN = false, MID = false, OVL = false, ATR = false; static constexpr int NST = 16;
    bf16_t* O; int ldc; float* vss;
    __device__ __forceinline__ void operator()(const f32x4 (&acc)[2][2][4][2], const Unit& u, int wr, int wc, int fr, int fq) const {
        const int row0 = u.pm * BM + wr * 64 + fr, col0 = u.pn * BM + wc * 32 + 8 * fq;
        const bool isv = u.pm >= 12;
        f32x4 ss[2][2];
#pragma unroll
        for (int bj = 0; bj < 2; ++bj)
#pragma unroll
            for (int n = 0; n < 2; ++n) ss[bj][n] = (f32x4){0.f, 0.f, 0.f, 0.f};
#pragma unroll
        for (int ai = 0; ai < 2; ++ai)
#pragma unroll
            for (int m = 0; m < 4; ++m) { bf16_t* rowp = O + (size_t)(row0 + ai * HALF + m * 16) * ldc + col0;
#pragma unroll
                for (int bj = 0; bj < 2; ++bj) { f32x4 v0 = acc[ai][bj][m][0], v1 = acc[ai][bj][m][1];
                    if (isv) { f32x2 a = gelu_pk((f32x2){v0[0], v0[1]}), b = gelu_pk((f32x2){v0[2], v0[3]}), c = gelu_pk((f32x2){v1[0], v1[1]}), d = gelu_pk((f32x2){v1[2], v1[3]});
                        v0 = (f32x4){a.x, a.y, b.x, b.y}; v1 = (f32x4){c.x, c.y, d.x, d.y}; ss[bj][0] += v0 * v0; ss[bj][1] += v1 * v1; }
                    u32x4 w; w.x = cvt_pk_bf16(v0[0], v0[1]); w.y = cvt_pk_bf16(v0[2], v0[3]); w.z = cvt_pk_bf16(v1[0], v1[1]); w.w = cvt_pk_bf16(v1[2], v1[3]);
                    *(u32x4*)(rowp + bj * HALF) = w; } }
        if (isv) {
            float mine = 0.f;
#pragma unroll
            for (int bj = 0; bj < 2; ++bj)
#pragma unroll
                for (int n = 0; n < 2; ++n)
#pragma unroll
                    for (int j = 0; j < 4; ++j) { float s = ss[bj][n][j];
                        s += __builtin_bit_cast(float, __builtin_amdgcn_update_dpp(0, __builtin_bit_cast(int, s), 0x121, 0xf, 0xf, false));
                        s += __builtin_bit_cast(float, __builtin_amdgcn_update_dpp(0, __builtin_bit_cast(int, s), 0x122, 0xf, 0xf, false));
                        s += __builtin_bit_cast(float, __builtin_amdgcn_update_dpp(0, __builtin_bit_cast(int, s), 0x124, 0xf, 0xf, false));
                        s += __builtin_bit_cast(float, __builtin_amdgcn_update_dpp(0, __builtin_bit_cast(int, s), 0x128, 0xf, 0xf, false));
                        mine = (fr == bj * 8 + n * 4 + j) ? s : mine; }
            atomicAdd(vss + col0 + (fr >> 3) * HALF + 4 * ((fr >> 2) & 1) + (fr & 3), mine);
        }
    }
};
struct EpiUG {
    static constexpr bool PERM = true, AFTER_DRAIN = false, MID = false, OVL = false, ATR = false; static constexpr int NST = 16;
    bf16_t* U; bf16_t* G; int ldu;
    __device__ __forceinline__ void operator()(const f32x4 (&acc)[2][2][4][2], const Unit& u, int wr, int wc, int fr, int fq) const {
        const int row0 = u.pm * BM + wr * 64 + fr;
        if (u.pn < 4) {
            const int col0 = u.pn * BM + wc * 32 + 8 * fq;
#pragma unroll
            for (int ai = 0; ai < 2; ++ai)
#pragma unroll
                for (int m = 0; m < 4; ++m) { bf16_t* rowp = U + (size_t)(row0 + ai * HALF + m * 16) * ldu + col0;
#pragma unroll
                    for (int bj = 0; bj < 2; ++bj) { f32x4 v0 = acc[ai][bj][m][0], v1 = acc[ai][bj][m][1];
                        const f32x2 a = gelu_pk((f32x2){v0[0], v0[1]}), b = gelu_pk((f32x2){v0[2], v0[3]}), c = gelu_pk((f32x2){v1[0], v1[1]}), d = gelu_pk((f32x2){v1[2], v1[3]});
                        u32x4 w; w.x = cvt_pk_bf16(a.x, a.y); w.y = cvt_pk_bf16(b.x, b.y); w.z = cvt_pk_bf16(c.x, c.y); w.w = cvt_pk_bf16(d.x, d.y);
                        *(u32x4*)(rowp + bj * HALF) = w; } }
        } else {
            bf16_t* tp = G + ((size_t)(u.pm * 8 + (u.pn - 4)) * 32768 + (wr * 4 + wc) * 4096 + (fr + 16 * fq) * 8);
#pragma unroll
            for (int ai = 0; ai < 2; ++ai)
#pragma unroll
                for (int m = 0; m < 4; ++m) { bf16_t* rowp = tp + (ai * 4 + m) * 512;
                    float rr[8], gb[8];
#pragma unroll
                    for (int n = 0; n < 2; ++n)
#pragma unroll
                        for (int j = 0; j < 4; ++j) { const float ea = __builtin_amdgcn_exp2f(fminf(acc[ai][0][m][n][j] * -1.4426950408889634f, 120.0f)), eb = __builtin_amdgcn_exp2f(fminf(acc[ai][1][m][n][j] * -1.4426950408889634f, 120.0f));
                            const float db = 1.0f + eb; gb[4 * n + j] = __builtin_amdgcn_rcpf(db); rr[4 * n + j] = db * __builtin_amdgcn_rcpf(1.0f + ea); }
                    u32x4 w; w.x = cvt_pk_bf16(rr[0], rr[1]); w.y = cvt_pk_bf16(rr[2], rr[3]); w.z = cvt_pk_bf16(rr[4], rr[5]); w.w = cvt_pk_bf16(rr[6], rr[7]);
                    *(u32x4*)rowp = w;
                    w.x = cvt_pk_bf16(gb[0], gb[1]); w.y = cvt_pk_bf16(gb[2], gb[3]); w.z = cvt_pk_bf16(gb[4], gb[5]); w.w = cvt_pk_bf16(gb[6], gb[7]);
                    *(u32x4*)(rowp + 16 * 1024 * 1024) = w; }
        }
    }
};
}
namespace {
struct WJob { const float* W; const float* g; bf16* dst; int K, N, c0, nc, ldd, r0, koff, perm; };
constexpr int NWJ = 9;
struct WJobs { WJob j[NWJ]; };
__device__ __forceinline__ unsigned pk2(float lo, float hi) { return f2bf(lo) | (f2bf(hi) << 16); }
__device__ __forceinline__ void wT_item(const WJob& J, LAS float* scr, int item, int lane) {
    const int nblk = J.nc / 32, kb = item / nblk, nb = item % nblk, k0 = 64 * kb, n0 = 32 * nb;
    float v[32];
#pragma unroll
    for (int i = 0; i < 32; ++i) v[i] = J.W[(size_t)(k0 + 2 * i + (lane >> 5)) * J.N + J.c0 + n0 + (lane & 31)];
    if (J.g) {
#pragma unroll
        for (int i = 0; i < 32; ++i) v[i] *= J.g[k0 + 2 * i + (lane >> 5)]; }
#pragma unroll
    for (int i = 0; i < 32; ++i) scr[(2 * i + (lane >> 5)) * 33 + (lane & 31)] = v[i];
    asm volatile("s_waitcnt lgkmcnt(0)" ::: "memory");
    const int c = lane & 7; int rb = n0;
    if (J.perm) { const int half = n0 >= J.perm, cc = n0 - half * J.perm; rb = 256 * (cc >> 7) + 128 * half + (cc & 127); }
#pragma unroll
    for (int j = 0; j < 4; ++j) { const int n = (lane >> 3) + 8 * j; const LAS float* s = scr + (8 * c) * 33 + n;
        uint4 o; o.x = pk2(s[0 * 33], s[1 * 33]); o.y = pk2(s[2 * 33], s[3 * 33]); o.z = pk2(s[4 * 33], s[5 * 33]); o.w = pk2(s[6 * 33], s[7 * 33]);
        *(uint4*)(J.dst + (size_t)(J.r0 + rb + n) * J.ldd + J.koff + k0 + 8 * c) = o; }
    asm volatile("s_waitcnt lgkmcnt(0)" ::: "memory");
}
__device__ __forceinline__ void p0_weights(const WJobs& WJ, int jlo, int jhi, LAS float* scr, int gw, int NGW, int lane) {
    int base = 0;
    for (int q = jlo; q < jhi; ++q) {
        const WJob& J = WJ.j[q]; const int ni = (J.K / 64) * (J.nc / 32);
        int it = gw - (base % NGW); if (it < 0) it += NGW;
        for (; it < ni; it += NGW) wT_item(J, scr, it, lane);
        base += ni;
    }
}
__device__ __forceinline__ float wave_sum(float v) {
#pragma unroll
    for (int o = 1; o < 64; o <<= 1) v += __shfl_xor(v, o);
    return v;
}
__device__ __forceinline__ void rms_row_to_bf16(const float* xrow, const float* g, bf16* orow, int lane) {
    const float4* xr = (const float4*)xrow + lane; const float4* gr = (const float4*)g + lane;
    float4 v[4]; float s = 0.f;
#pragma unroll
    for (int j = 0; j < 4; ++j) { v[j] = xr[64 * j]; s += (v[j].x * v[j].x + v[j].y * v[j].y) + (v[j].z * v[j].z + v[j].w * v[j].w); }
    const float r = rsqrtf(wave_sum(s) * (1.f / 1024.f) + EPS);
    unsigned long long* o8 = (unsigned long long*)orow + lane;
#pragma unroll
    for (int j = 0; j < 4; ++j) { const float4 gg = gr[64 * j];
        o8[64 * j] = (unsigned long long)pk2(v[j].x * r * gg.x, v[j].y * r * gg.y) | ((unsigned long long)pk2(v[j].z * r * gg.z, v[j].w * r * gg.w) << 32); }
}
template <int NR> __device__ __forceinline__ void rms_rowsN_to_bf16(const float* xrow, const float* g, bf16* orow, int ldo, int lane) {
    float4 v[NR][4]; float s[NR];
#pragma unroll
    for (int r = 0; r < NR; ++r)
#pragma unroll
        for (int j = 0; j < 4; ++j) v[r][j] = ((const float4*)(xrow + (size_t)r * 1024) + lane)[64 * j];
#pragma unroll
    for (int r = 0; r < NR; ++r) { s[r] = 0.f;
#pragma unroll
        for (int j = 0; j < 4; ++j) s[r] += (v[r][j].x * v[r][j].x + v[r][j].y * v[r][j].y) + (v[r][j].z * v[r][j].z + v[r][j].w * v[r][j].w); }
#pragma unroll
    for (int r = 0; r < NR; ++r) { const float rr = rsqrtf(wave_sum(s[r]) * (1.f / 1024.f) + EPS);
        unsigned long long* o8 = (unsigned long long*)(orow + (size_t)r * ldo) + lane;
#pragma unroll
        for (int j = 0; j < 4; ++j) { const float4 gg = ((const float4*)g + lane)[64 * j];
            o8[64 * j] = (unsigned long long)pk2(v[r][j].x * rr * gg.x, v[r][j].y * rr * gg.y) | ((unsigned long long)pk2(v[r][j].z * rr * gg.z, v[r][j].w * rr * gg.w) << 32); } }
}
}

namespace {
struct SguArgs {
    const bf16* vT;
    bf16* U;
    const float* vss;
    const float* ws;
    const float* bs;
    const float* gn;
    int TS, ldu;
};
typedef short bf16x8_t __attribute__((ext_vector_type(8)));
typedef float f32x4_t __attribute__((ext_vector_type(4)));
#define SBAR() do { asm volatile("s_waitcnt lgkmcnt(0)" ::: "memory"); __builtin_amdgcn_s_barrier(); asm volatile("" ::: "memory"); } while (0)
__device__ __forceinline__ void sgu_phase(LAS unsigned char* lds, const SguArgs& A, int first, int stride, const int tid, const int wave) {
    const int nitems = (A.TS / 128) * 8;
    if (first >= nitems) return;
    const int lane = tid & 63, fr = lane & 15, fq = lane >> 4, p = 16 * wave + fr;
    LAS float* rtab = (LAS float*)(lds + 131072);
    LAS float* gnl = (LAS float*)(lds + 131072 + 4096);
#define SGU_ISSUE(item, buf) do { const int g_ = (item) & 7, tok0_ = ((item) >> 3) * 128; \
        _Pragma("unroll") for (int i_ = 0; i_ < 4; ++i_) { const int r_ = (i_ * 8 + wave) * 4 + (lane >> 4), c_ = (lane & 15) ^ (r_ & 15); \
            __builtin_amdgcn_global_load_lds((const unsigned*)(A.vT + (size_t)(g_ * 128 + r_) * A.TS + tok0_ + 8 * c_), (LAS unsigned*)(lds + (buf) * 65536 + (i_ * 8 + wave) * 1024), 16, 0, 0); \
            __builtin_amdgcn_global_load_lds((const unsigned*)(A.U + (size_t)(tok0_ + r_) * A.ldu + g_ * 128 + 8 * c_), (LAS unsigned*)(lds + (buf) * 65536 + 32768 + (i_ * 8 + wave) * 1024), 16, 0, 0); } } while (0)
    SGU_ISSUE(first, 0);
    int gcur = -1; float wf[4][8]; float bsp = 0.f;
    for (int e = tid; e < 1024; e += 512) { const int k = e >> 7, it = first + k * stride;
        if (it < nitems) rtab[e] = rsqrtf(A.vss[(it >> 3) * 128 + (e & 127)] * (1.f / 1024.f) + EPS); }
    int k = 0;
    for (int it = first; it < nitems; it += stride, ++k) {
        const int g = it & 7, tok0 = (it >> 3) * 128, buf = k & 1;
        if (g != gcur) {
            gcur = g;
#pragma unroll
            for (int kk = 0; kk < 4; ++kk) { const float4 w0 = *(const float4*)(A.ws + ((size_t)g * 128 + p) * 128 + 32 * kk + 8 * fq), w1 = *(const float4*)(A.ws + ((size_t)g * 128 + p) * 128 + 32 * kk + 8 * fq + 4);
                wf[kk][0] = w0.x; wf[kk][1] = w0.y; wf[kk][2] = w0.z; wf[kk][3] = w0.w; wf[kk][4] = w1.x; wf[kk][5] = w1.y; wf[kk][6] = w1.z; wf[kk][7] = w1.w; }
            bsp = A.bs[g * 128 + p];
            SBAR();
            if (tid < 128) gnl[tid] = A.gn[g * 128 + tid];
        }
        asm volatile("s_waitcnt vmcnt(0)" ::: "memory"); SBAR();
        if (it + stride < nitems) SGU_ISSUE(it + stride, buf ^ 1);
        const LAS unsigned char* BT = lds + buf * 65536; const LAS unsigned char* UT = BT + 32768;
        bf16x8_t af[4];
#pragma unroll
        for (int kk = 0; kk < 4; ++kk) { const f32x4_t r0 = *(const LAS f32x4_t*)(rtab + k * 128 + 32 * kk + 8 * fq), r1 = *(const LAS f32x4_t*)(rtab + k * 128 + 32 * kk + 8 * fq + 4);
            uint4 o; o.x = pk2(wf[kk][0] * r0[0], wf[kk][1] * r0[1]); o.y = pk2(wf[kk][2] * r0[2], wf[kk][3] * r0[3]); o.z = pk2(wf[kk][4] * r1[0], wf[kk][5] * r1[1]); o.w = pk2(wf[kk][6] * r1[2], wf[kk][7] * r1[3]);
            af[kk] = __builtin_bit_cast(bf16x8_t, o); }
        f32x4_t acc[8];
#pragma unroll
        for (int nt = 0; nt < 8; ++nt) acc[nt] = (f32x4_t){0.f, 0.f, 0.f, 0.f};
#pragma unroll
        for (int kk = 0; kk < 4; ++kk) {
            bf16x8_t bfr[8];
#pragma unroll
            for (int nt = 0; nt < 8; ++nt) bfr[nt] = *(const LAS bf16x8_t*)(BT + (16 * nt + fr) * 256 + 16 * ((4 * kk + fq) ^ fr));
#pragma unroll
            for (int nt = 0; nt < 8; ++nt) acc[nt] = __builtin_amdgcn_mfma_f32_16x16x32_bf16(bfr[nt], af[kk], acc[nt], 0, 0, 0);
        }
        bf16* urow = A.U + (size_t)(tok0 + p) * A.ldu + g * 128 + 4 * fq;
#pragma unroll
        for (int nt = 0; nt < 8; ++nt) {
            typedef unsigned u32x2_t __attribute__((ext_vector_type(2)));
            const u32x2_t uu = *(const LAS u32x2_t*)(UT + p * 256 + 16 * ((2 * nt + (fq >> 1)) ^ fr) + 8 * (fq & 1));
            const f32x4_t gv = *(const LAS f32x4_t*)(gnl + 16 * nt + 4 * fq);
            const float y0 = bf2f(uu.x & 0xffffu) * (gv[0] * acc[nt][0] + bsp), y1 = bf2f(uu.x >> 16) * (gv[1] * acc[nt][1] + bsp);
            const float y2 = bf2f(uu.y & 0xffffu) * (gv[2] * acc[nt][2] + bsp), y3 = bf2f(uu.y >> 16) * (gv[3] * acc[nt][3] + bsp);
            uint2 o; o.x = pk2(y0, y1); o.y = pk2(y2, y3);
            *(uint2*)(urow + 16 * nt) = o;
        }
    }
    asm volatile("s_waitcnt vmcnt(0)" ::: "memory"); SBAR();
#undef SGU_ISSUE
}
}

namespace pg8 {
__device__ __forceinline__ void bf8_to_f32(const u32x4 q, f32x4& lo, f32x4& hi) {
    lo = (f32x4){__builtin_bit_cast(float, q.x << 16), __builtin_bit_cast(float, q.x & 0xffff0000u), __builtin_bit_cast(float, q.y << 16), __builtin_bit_cast(float, q.y & 0xffff0000u)};
    hi = (f32x4){__builtin_bit_cast(float, q.z << 16), __builtin_bit_cast(float, q.z & 0xffff0000u), __builtin_bit_cast(float, q.w << 16), __builtin_bit_cast(float, q.w & 0xffff0000u)};
}
struct EpiMerge {
    static constexpr bool PERM = true, AFTER_DRAIN = false, MID = true, OVL = false, ATR = true;
    const bf16_t* G; bf16_t* O;
    __device__ __forceinline__ void mid(f32x4 (&acc)[2][2][4][2], const Unit& u, int wr, int wc, int fr, int fq) const {
        unsigned off0 = (unsigned)((u.pm * 8 + 2 * u.pn) * 32768 + (wr * 4 + wc) * 4096 + (fr + 16 * fq) * 8);
        asm volatile("" : "+v"(off0));
        u32x4 q[2][4][2];
#pragma unroll
        for (int ai = 0; ai < 2; ++ai)
#pragma unroll
            for (int m = 0; m < 4; ++m)
#pragma unroll
                for (int bj = 0; bj < 2; ++bj) q[ai][m][bj] = *(const u32x4*)(G + (off0 + (unsigned)(bj * 32768 + (ai * 4 + m) * 512)));
#pragma unroll
        for (int ai = 0; ai < 2; ++ai)
#pragma unroll
            for (int m = 0; m < 4; ++m)
#pragma unroll
                for (int bj = 0; bj < 2; ++bj) { f32x4 a0, a1; bf8_to_f32(q[ai][m][bj], a0, a1); acc[ai][bj][m][0] *= a0; acc[ai][bj][m][1] *= a1; }
        asm volatile("" ::: "memory");
    }
    __device__ __forceinline__ void operator()(f32x4 (&acc)[2][2][4][2], const Unit& u, int wr, int wc, int fr, int fq) const {
        const int row0 = u.pm * BM + wr * 64 + fr, col0 = u.pn * BM + wc * 32 + 8 * fq;
        const bf16_t* gbp = G + ((size_t)16 * 1024 * 1024 + (size_t)(u.pm * 8 + 2 * u.pn) * 32768 + (wr * 4 + wc) * 4096 + (fr + 16 * fq) * 8);
#pragma unroll
        for (int ai = 0; ai < 2; ++ai) { u32x4 q[4][2];
#pragma unroll
            for (int m = 0; m < 4; ++m)
#pragma unroll
                for (int bj = 0; bj < 2; ++bj) q[m][bj] = *(const u32x4*)(gbp + bj * 32768 + (ai * 4 + m) * 512);
#pragma unroll
            for (int m = 0; m < 4; ++m) { const size_t r = (size_t)(row0 + ai * HALF + m * 16);
#pragma unroll
                for (int bj = 0; bj < 2; ++bj) { f32x4 b0, b1; bf8_to_f32(q[m][bj], b0, b1);
                    const f32x4 v0 = acc[ai][bj][m][0] * b0, v1 = acc[ai][bj][m][1] * b1;
                    u32x4 w; w.x = cvt_pk_bf16(v0[0], v0[1]); w.y = cvt_pk_bf16(v0[2], v0[3]); w.z = cvt_pk_bf16(v1[0], v1[1]); w.w = cvt_pk_bf16(v1[2], v1[3]);
                    *(u32x4*)(O + r * 1024 + col0 + bj * HALF) = w; } }
            asm volatile("" ::: "memory"); }
    }
};
}
namespace {
__device__ __forceinline__ void tr64_item(const bf16* yaT, int TS, bf16* out, int ldo, LAS unsigned short* scr, int c0, int t0, int lane) {
#pragma unroll
    for (int i = 0; i < 8; ++i) { const int r = 8 * i + (lane >> 3), ch = lane & 7;
        const pg8::u32x4 q = *(const pg8::u32x4*)(yaT + (size_t)(c0 + r) * TS + t0 + 8 * ch);
        LAS unsigned short* d = scr + (8 * ch) * 72 + r;
        d[0 * 72] = (unsigned short)(q.x & 0xffffu); d[1 * 72] = (unsigned short)(q.x >> 16); d[2 * 72] = (unsigned short)(q.y & 0xffffu); d[3 * 72] = (unsigned short)(q.y >> 16);
        d[4 * 72] = (unsigned short)(q.z & 0xffffu); d[5 * 72] = (unsigned short)(q.z >> 16); d[6 * 72] = (unsigned short)(q.w & 0xffffu); d[7 * 72] = (unsigned short)(q.w >> 16); }
    asm volatile("s_waitcnt lgkmcnt(0)" ::: "memory");
#pragma unroll
    for (int i = 0; i < 8; ++i) { const int tk = 8 * i + (lane >> 3), ch = lane & 7;
        const pg8::u32x4 q = *(const LAS pg8::u32x4*)(scr + tk * 72 + 8 * ch);
        *(pg8::u32x4*)(out + (size_t)(t0 + tk) * ldo + c0 + 8 * ch) = q; }
    asm volatile("s_waitcnt lgkmcnt(0)" ::: "memory");
}
__device__ __forceinline__ void transpose_ya(const bf16* yaT, int TS, bf16* out, int ldo, LAS unsigned short* scr, int gw, int NGW, int lane) {
    const int ntt = TS / 64, nit = 16 * ntt;
    for (int it = gw; it < nit; it += NGW) tr64_item(yaT, TS, out, ldo, scr, 64 * (it / ntt), 64 * (it % ntt), lane);
}
}

namespace pg8 {
template <bool FIRST> struct EpiResid {
    static constexpr bool PERM = true, AFTER_DRAIN = false, MID = false, OVL = false, ATR = false;
    const float* X; const bf16_t* XB; float* X1; bf16_t* X1b; float* xss;
    __device__ __forceinline__ void operator()(const f32x4 (&acc)[2][2][4][2], const Unit& u, int wr, int wc, int fr, int fq) const {
        const int row0 = u.pm * BM + wr * 64 + fr, col0 = u.pn * BM + wc * 32 + 8 * fq;
        float rsum[8];
#pragma unroll
        for (int ai = 0; ai < 2; ++ai)
            {
                f32x4 xr[4][2][2];
#pragma unroll
                for (int m = 0; m < 4; ++m) { const size_t r = (size_t)(row0 + ai * HALF + m * 16);
#pragma unroll
                    for (int bj = 0; bj < 2; ++bj) { const size_t o = r * 1024 + col0 + bj * HALF;
                        if (FIRST) { xr[m][bj][0] = *(const f32x4*)(X + o); xr[m][bj][1] = *(const f32x4*)(X + o + 4); }
                        else bf8_to_f32(*(const u32x4*)(XB + o), xr[m][bj][0], xr[m][bj][1]); } }
#pragma unroll
                for (int m = 0; m < 4; ++m) { const size_t r = (size_t)(row0 + ai * HALF + m * 16); float s = 0.f;
#pragma unroll
                    for (int bj = 0; bj < 2; ++bj) { const size_t o = r * 1024 + col0 + bj * HALF;
                        const f32x4 v0 = acc[ai][bj][m][0] + xr[m][bj][0], v1 = acc[ai][bj][m][1] + xr[m][bj][1];
                        u32x4 w; w.x = cvt_pk_bf16(v0[0], v0[1]); w.y = cvt_pk_bf16(v0[2], v0[3]); w.z = cvt_pk_bf16(v1[0], v1[1]); w.w = cvt_pk_bf16(v1[2], v1[3]);
                        *(u32x4*)(X1b + o) = w;
                        s += ((v0[0] * v0[0] + v0[1] * v0[1]) + (v0[2] * v0[2] + v0[3] * v0[3])) + ((v1[0] * v1[0] + v1[1] * v1[1]) + (v1[2] * v1[2] + v1[3] * v1[3])); }
                    s += __shfl_xor(s, 16); s += __shfl_xor(s, 32);
                    rsum[ai * 4 + m] = s; }
                asm volatile("" ::: "memory"); }
        if (fq == 0) {
#pragma unroll
            for (int k = 0; k < 8; ++k) atomicAdd(xss + (size_t)(row0 + (k >> 2) * HALF + (k & 3) * 16), rsum[k]); }
    }
};
struct EpiResidNorm {
    static constexpr bool PERM = false, AFTER_DRAIN = true, MID = false, OVL = false, ATR = false;
    const bf16_t* XB; float* out; float* x2ss; const float* g; unsigned* cnt;
    __device__ __forceinline__ void fused(f32x4 (&acc)[2][2][4][2], const Unit& u, int wr, int wc, int fr, int fq, PG8_LAS unsigned char* lds, int wid, int lane) const {
        typedef unsigned u32x2v __attribute__((ext_vector_type(2)));
        const int row0 = u.pm * BM + wr * 64 + fr, col0 = u.pn * BM + wc * 32 + 4 * fq;
        float keep = 0.f; float rsum[8];
#pragma unroll
        for (int ai = 0; ai < 2; ++ai)
#pragma unroll
            for (int m = 0; m < 4; ++m) { const size_t r = (size_t)(row0 + ai * HALF + m * 16); float s = 0.f;
#pragma unroll
                for (int bj = 0; bj < 2; ++bj)
#pragma unroll
                    for (int n = 0; n < 2; ++n) { const u32x2v q = *(const u32x2v*)(XB + r * 1024 + col0 + bj * HALF + n * 16);
                        const f32x4 v = acc[ai][bj][m][n] + (f32x4){__builtin_bit_cast(float, q.x << 16), __builtin_bit_cast(float, q.x & 0xffff0000u), __builtin_bit_cast(float, q.y << 16), __builtin_bit_cast(float, q.y & 0xffff0000u)};
                        acc[ai][bj][m][n] = v; s += (v[0] * v[0] + v[1] * v[1]) + (v[2] * v[2] + v[3] * v[3]); }
                s += __shfl_xor(s, 16); s += __shfl_xor(s, 32);
                rsum[ai * 4 + m] = s; }
        if (fq == 0) {
#pragma unroll
            for (int k = 0; k < 8; ++k) keep += atomicAdd(x2ss + (size_t)(row0 + (k >> 2) * HALF + (k & 3) * 16), rsum[k]); }
        asm volatile("s_waitcnt vmcnt(0)" :: "v"(keep) : "memory");
        asm volatile("s_waitcnt lgkmcnt(0)" ::: "memory"); __builtin_amdgcn_s_barrier(); asm volatile("" ::: "memory");
        if (wid == 0) {
            if (lane == 0) { __hip_atomic_fetch_add(cnt + 64 * u.pm, 1u, __ATOMIC_RELAXED, __HIP_MEMORY_SCOPE_AGENT);
                unsigned spins = 0;
                while (__hip_atomic_load(cnt + 64 * u.pm, __ATOMIC_RELAXED, __HIP_MEMORY_SCOPE_AGENT) < 4u) { __builtin_amdgcn_s_sleep(2); if (++spins > (1u << 22)) break; } }
            __builtin_amdgcn_fence(__ATOMIC_ACQUIRE, "agent");
            asm volatile("s_waitcnt vmcnt(0)" ::: "memory");
        }
        asm volatile("s_waitcnt lgkmcnt(0)" ::: "memory"); __builtin_amdgcn_s_barrier(); asm volatile("" ::: "memory");
        f32x4 gv[2][2];
#pragma unroll
        for (int bj = 0; bj < 2; ++bj)
#pragma unroll
            for (int n = 0; n < 2; ++n) gv[bj][n] = *(const f32x4*)(g + col0 + bj * HALF + n * 16);
#pragma unroll
        for (int ai = 0; ai < 2; ++ai)
#pragma unroll
            for (int m = 0; m < 4; ++m) { const size_t r = (size_t)(row0 + ai * HALF + m * 16);
                const float rs = rsqrtf(__hip_atomic_load(x2ss + r, __ATOMIC_RELAXED, __HIP_MEMORY_SCOPE_AGENT) * (1.0f / 1024.0f) + 1e-6f);
#pragma unroll
                for (int bj = 0; bj < 2; ++bj)
#pragma unroll
                    for (int n = 0; n < 2; ++n) *(f32x4*)(out + r * 1024 + col0 + bj * HALF + n * 16) = acc[ai][bj][m][n] * gv[bj][n] * rs; }
    }
};
__device__ __forceinline__ float dpp_ror1(float v) { return __builtin_bit_cast(float, __builtin_amdgcn_update_dpp(0, __builtin_bit_cast(int, v), 0x121, 0xf, 0xf, false)); }
__device__ __forceinline__ float dpp_rol1(float v) { return __builtin_bit_cast(float, __builtin_amdgcn_update_dpp(0, __builtin_bit_cast(int, v), 0x12f, 0xf, 0xf, false)); }
struct EpiUpAct {
    static constexpr bool PERM = true, AFTER_DRAIN = false, MID = false, OVL = true, ATR = false;
    bf16_t* ACT; PG8_LAS float* XB; const float* xss; const float* cw; const float* cb;
    __device__ __forceinline__ void operator()(f32x4 (&acc)[2][2][4][2], const Unit& u, int wr, int wc, int fr_, int fq_) const {
        int lane_; asm volatile("v_mbcnt_lo_u32_b32 %0, -1, 0\n\tv_mbcnt_hi_u32_b32 %0, -1, %0" : "=v"(lane_));
        const int fr = lane_ & 15, fq = lane_ >> 4; (void)fr_; (void)fq_;
        const int seq = u.pm / 17, ti = u.pm % 17, rowbase = ovl_row(u.pm);
        const int own_lo = seq * 4096 + 254 * ti, own_hi = seq * 4096 + (254 * ti + 254 < 4096 ? 254 * ti + 254 : 4096);
        const int lr0 = wr * 64 + fr, cl = 32 * wc + 8 * fq;
        PG8_LAS float* RS = XB + 1536; PG8_LAS float* CW = XB + 1792;
        { const int w8 = wr * 4 + wc, t = w8 * 64 + lane_;
          if (t < 256) RS[t] = rsqrtf(xss[rowbase + t] * (1.0f / 1024.0f) + 1e-6f);
          const int q = t >> 7, c = t & 127; CW[q * 128 + c] = q < 3 ? cw[q * 2816 + 128 * u.pn + c] : cb[128 * u.pn + c]; }
        asm volatile("s_waitcnt lgkmcnt(0)" ::: "memory"); __builtin_amdgcn_s_barrier(); asm volatile("" ::: "memory");
#pragma unroll
        for (int ai = 0; ai < 2; ++ai)
#pragma unroll
            for (int m = 0; m < 4; ++m) { const float rs = RS[lr0 + ai * HALF + m * 16];
#pragma unroll
                for (int bj = 0; bj < 2; ++bj) { acc[ai][bj][m][0] *= rs; acc[ai][bj][m][1] *= rs; }
                __builtin_amdgcn_sched_barrier(0); }
        const bool e0 = fr == 0, e15 = fr == 15;
        const int slot = e0 ? 0 : (e15 ? 512 : 1024);
#pragma unroll
        for (int ai = 0; ai < 2; ++ai) { const int B = 2 * ai + wr;
            f32x4 p0, p1;
#pragma unroll
            for (int j = 0; j < 4; ++j) { p0[j] = e15 ? acc[ai][0][3][0][j] : acc[ai][0][0][0][j]; p1[j] = e15 ? acc[ai][0][3][1][j] : acc[ai][0][0][1][j]; }
            *(PG8_LAS f32x4*)(XB + slot + B * 128 + cl) = p0; *(PG8_LAS f32x4*)(XB + slot + B * 128 + cl + 4) = p1; }
        asm volatile("s_waitcnt lgkmcnt(0)" ::: "memory"); __builtin_amdgcn_s_barrier(); asm volatile("" ::: "memory");
        const int ch = 128 * u.pn + cl;
        typedef unsigned u32x2v __attribute__((ext_vector_type(2)));
#pragma unroll
        for (int ai = 0; ai < 2; ++ai) { const int B = 2 * ai + wr;
            u32x2v pk0[4];
#pragma unroll
            for (int n = 0; n < 2; ++n) {
                const f32x4 w0 = *(const PG8_LAS f32x4*)(CW + cl + 4 * n), w1 = *(const PG8_LAS f32x4*)(CW + 128 + cl + 4 * n), w2 = *(const PG8_LAS f32x4*)(CW + 256 + cl + 4 * n), bb = *(const PG8_LAS f32x4*)(CW + 384 + cl + 4 * n);
                f32x4 pb = *(const PG8_LAS f32x4*)(XB + 512 + (B > 0 ? B - 1 : 0) * 128 + cl + 4 * n), nb = *(const PG8_LAS f32x4*)(XB + (B < 3 ? B + 1 : 3) * 128 + cl + 4 * n);
                if (B == 0) pb = (f32x4){0.f, 0.f, 0.f, 0.f};
                if (B == 3) nb = (f32x4){0.f, 0.f, 0.f, 0.f};
                float o[4][4];
#pragma unroll
                for (int j = 0; j < 4; ++j) {
                    float av[4], rr[4], ll[4];
#pragma unroll
                    for (int m = 0; m < 4; ++m) { av[m] = acc[ai][0][m][n][j]; rr[m] = dpp_ror1(av[m]); ll[m] = dpp_rol1(av[m]); }
#pragma unroll
                    for (int m = 0; m < 4; ++m) { const float pv = e0 ? (m > 0 ? rr[m - 1] : pb[j]) : rr[m], nv = e15 ? (m < 3 ? ll[m + 1] : nb[j]) : ll[m];
                        const float sv = bb[j] + w0[j] * pv + w1[j] * av[m] + w2[j] * nv;
                        o[m][j] = sv * __builtin_amdgcn_rcpf(1.0f + __builtin_amdgcn_exp2f(sv * -1.4426950408889634f)) * acc[ai][1][m][n][j]; }
                }
#pragma unroll
                for (int m = 0; m < 4; ++m) { u32x2v w; w.x = cvt_pk_bf16(o[m][0], o[m][1]); w.y = cvt_pk_bf16(o[m][2], o[m][3]);
                    if (n == 0) pk0[m] = w;
                    else { const int tok = rowbase + lr0 + ai * HALF + m * 16;
                        if (tok >= own_lo && tok < own_hi) *(u32x4*)(ACT + (size_t)tok * 2816 + ch) = (u32x4){pk0[m].x, pk0[m].y, w.x, w.y}; } }
                __builtin_amdgcn_sched_barrier(0);
            } }
    }
};
}
namespace {
__device__ __forceinline__ void final_norm(const bf16* X2, const float* ss, const float* g, float* out, int TS, int gw, int NGW, int lane) {
    pg8::f32x4 g0[2], g1[2];
#pragma unroll
    for (int j = 0; j < 2; ++j) { g0[j] = *((const pg8::f32x4*)g + 2 * lane + 128 * j); g1[j] = *((const pg8::f32x4*)g + 2 * lane + 128 * j + 1); }
    for (int t = 2 * gw; t < TS; t += 2 * NGW) {
        pg8::u32x4 q[2][2]; float r[2];
#pragma unroll
        for (int k = 0; k < 2; ++k) { r[k] = rsqrtf(ss[t + k] * (1.0f / 1024.0f) + EPS);
#pragma unroll
            for (int j = 0; j < 2; ++j) q[k][j] = *((const pg8::u32x4*)(X2 + (size_t)(t + k) * 1024) + lane + 64 * j); }
#pragma unroll
        for (int k = 0; k < 2; ++k)
#pragma unroll
            for (int j = 0; j < 2; ++j) { pg8::f32x4 lo, hi; pg8::bf8_to_f32(q[k][j], lo, hi);
                pg8::f32x4* o = (pg8::f32x4*)(out + (size_t)(t + k) * 1024) + 2 * lane + 128 * j;
                o[0] = lo * g0[j] * r[k]; o[1] = hi * g1[j] * r[k]; }
    }
}
}

namespace {
constexpr int MLPW_W2 = 33 * 64, MLPW_W3 = MLPW_W2 + 4096, MLPW_B = MLPW_W3 + 4096, MLPW_N = MLPW_B + 256;
__device__ __forceinline__ float filt_z(int l, int j) {
    if (j == 0) return (float)((double)l / (double)(L - 1));
    const int i = (j - 1) & 15;
    const double band = 1e-4 + (double)i * ((15.0 - 1e-4) / 15.0);
    double rev = (double)l * band / (double)L;
    rev -= floor(rev);
    const float ang = (float)(rev * 6.283185307179586);
    return (j <= 16) ? cosf(ang) : -sinf(ang);
}
constexpr int MLPW_CHUNKS = 9 + 16 + 16 + 4;
__device__ __forceinline__ void mlp_stage_dma(LAS unsigned char* wl, const float* const* in, int wave, int lane) {
    for (int c = wave; c < MLPW_CHUNKS; c += 8) {
        const float* src; int dstf, n = 256;
        if (c < 9) { src = in[5] + 256 * c; dstf = 256 * c; n = c < 8 ? 256 : 64; }
        else if (c < 25) { src = in[7] + 256 * (c - 9); dstf = MLPW_W2 + 256 * (c - 9); }
        else if (c < 41) { src = in[9] + 256 * (c - 25); dstf = MLPW_W3 + 256 * (c - 25); }
        else { const int q = c - 41; src = q == 0 ? in[6] : q == 1 ? in[8] : q == 2 ? in[10] : in[11]; dstf = MLPW_B + 64 * q; n = 64; }
        if (4 * lane < n) __builtin_amdgcn_global_load_lds((const unsigned*)(src + 4 * lane), (LAS unsigned*)(wl + dstf * 4), 16, 0, 0);
    }
}
__device__ __forceinline__ float bcast_lane(float v, int i) { return __builtin_bit_cast(float, __builtin_amdgcn_readlane(__builtin_bit_cast(int, v), i)); }
__device__ __forceinline__ void filter_mlp_rows2(const LAS float* wl, float* h3out, int l0, int l1, int j) {
    float za = 0.f, zb = 0.f;
    if (j < FEMB) { za = filt_z(l0, j); zb = filt_z(l1, j); }
    const float a = wl[MLPW_B + 192 + j];
    float s0 = wl[MLPW_B + j], s1 = s0;
#pragma unroll 11
    for (int i = 0; i < FEMB; ++i) { const float w = wl[i * 64 + j]; s0 += bcast_lane(za, i) * w; s1 += bcast_lane(zb, i) * w; }
    za = sinf(a * s0); zb = sinf(a * s1);
    s0 = wl[MLPW_B + 64 + j]; s1 = s0;
#pragma unroll 8
    for (int i = 0; i < FHID; ++i) { const float w = wl[MLPW_W2 + i * 64 + j]; s0 += bcast_lane(za, i) * w; s1 += bcast_lane(zb, i) * w; }
    za = sinf(a * s0); zb = sinf(a * s1);
    s0 = wl[MLPW_B + 128 + j]; s1 = s0;
#pragma unroll 8
    for (int i = 0; i < FHID; ++i) { const float w = wl[MLPW_W3 + i * 64 + j]; s0 += bcast_lane(za, i) * w; s1 += bcast_lane(zb, i) * w; }
    h3out[l0 * FHID + j] = sinf(a * s0); h3out[l1 * FHID + j] = sinf(a * s1);
}
typedef float f32x16_t __attribute__((ext_vector_type(16)));
__device__ __forceinline__ void filter_tables_wg(const float* h3, const float* w4, const float* decay, float* fsum, float* fdif, LAS unsigned char* lds, int bid, int G, int wave, int lane) {
    const int r = lane & 31, h = lane >> 5;
  for (int wi = bid; wi < 256; wi += G) {
    const int it = wi * 8 + wave, c0 = (it & 31) * 32, nbase = (it >> 5) * 64, mrow0 = 4033 - nbase;
#pragma unroll
    for (int q = 0; q < 16; ++q) { const int lr = wave * 16 + q, grow = lr < 64 ? nbase + lr : mrow0 + (lr - 64);
        if (grow < 4096) __builtin_amdgcn_global_load_lds((const unsigned*)(h3 + (size_t)grow * 64) + (unsigned)lane, (LAS unsigned*)(lds + lr * 260), 4, 0, 0);
        else ((LAS float*)(lds + lr * 260))[lane] = 0.f; }
    float af[32], ab[32]; const unsigned voff = (unsigned)(h * 2048 + r);
#pragma unroll
    for (int kk = 0; kk < 32; ++kk) { const float* wf = w4 + kk * 4096 + c0; const float* wb = wf + 1024; af[kk] = wf[voff]; ab[kk] = wb[voff];
        if ((kk & 3) == 3) __builtin_amdgcn_sched_barrier(0); }
    float dcf[16], dcb[16];
#pragma unroll
    for (int q = 0; q < 16; ++q) { const int c = c0 + (q & 3) + 8 * (q >> 2) + 4 * h; dcf[q] = fabsf(decay[c]); dcb[q] = fabsf(decay[1024 + c]); }
    asm volatile("s_waitcnt vmcnt(0) lgkmcnt(0)" ::: "memory"); __builtin_amdgcn_s_barrier(); asm volatile("" ::: "memory");
    const LAS float* S = (const LAS float*)lds;
#pragma unroll 1
    for (int half = 0; half < 2; ++half) {
        const int n = nbase + 32 * half + r, nb = n ? 4096 - n : 0;
        const LAS float* pF = S + (32 * half + r) * 65 + h; const LAS float* pB = S + (64 + 63 - 32 * half - r) * 65 + h;
        f32x16_t accF, accB;
#pragma unroll
        for (int q = 0; q < 16; ++q) { accF[q] = 0.f; accB[q] = 0.f; }
#pragma unroll
        for (int kk = 0; kk < 32; ++kk) {
            accF = __builtin_amdgcn_mfma_f32_32x32x2f32(af[kk], pF[2 * kk], accF, 0, 0, 0);
            accB = __builtin_amdgcn_mfma_f32_32x32x2f32(ab[kk], pB[2 * kk], accB, 0, 0, 0);
        }
        const float tf = (float)n * (1.0f / 4095.0f), tb = (float)nb * (1.0f / 4095.0f);
#pragma unroll
        for (int q = 0; q < 16; ++q) { const int c = c0 + (q & 3) + 8 * (q >> 2) + 4 * h;
            const float hf = accF[q] * expf(-tf * dcf[q]);
            const float hb = n ? accB[q] * expf(-tb * dcb[q]) : 0.f;
            fsum[(size_t)c * 4096 + n] = hf + hb;
            fdif[(size_t)c * 4096 + n] = hf - hb; }
    }
    asm volatile("s_waitcnt lgkmcnt(0)" ::: "memory"); __builtin_amdgcn_s_barrier(); asm volatile("" ::: "memory");
  }
}
#define RLX_AGENT __ATOMIC_RELAXED, __HIP_MEMORY_SCOPE_AGENT
#define XB_TMO      128
#define XB_XCNT(j)  (256  + 64 * (j))
#define XB_XSUB(j)  (1280 + 64 * (j))
#define XB_XGEN(j)  (2304 + 64 * (j))
#define XB_TOP      3328
#define XB_TOPGEN   3392
#define XCD_BAR_WORDS 3456
#define XB_SPIN_CAP (1u << 18)

__device__ __forceinline__ unsigned xb_ld(unsigned* p)              { return __hip_atomic_load(p, __ATOMIC_RELAXED, __HIP_MEMORY_SCOPE_AGENT); }
__device__ __forceinline__ unsigned xb_add(unsigned* p, unsigned v) { return __hip_atomic_fetch_add(p, v, __ATOMIC_RELAXED, __HIP_MEMORY_SCOPE_AGENT); }
__device__ __forceinline__ unsigned xb_xcc_id() { return (unsigned)__builtin_amdgcn_s_getreg((3 << 11) | 20) & 0xFu; }
#define XB_SPIN(cond, bar) do { unsigned _sp = 0; while (cond) { __builtin_amdgcn_s_sleep(1); \
    if ((++_sp & 255u) == 0u) { if (xb_ld(&(bar)[XB_TMO])) break; if (_sp > XB_SPIN_CAP) { atomicAdd(&(bar)[XB_TMO], 1u); break; } } } } while (0)

struct XcdBarrier {
    unsigned* bar; unsigned x;
    volatile LAS unsigned* st;
};

__device__ __forceinline__ XcdBarrier xcd_barrier_post(unsigned* bar, volatile LAS unsigned* st) {
    XcdBarrier b; b.bar = bar; b.x = xb_xcc_id(); b.st = st;
    if (threadIdx.x == 0) (void)xb_add(&bar[XB_XCNT(b.x)], 1u);
    return b;
}
__device__ __forceinline__ void xcd_barrier_complete(unsigned* bar, unsigned x, unsigned& nloc, unsigned& nx) {
    const unsigned G = gridDim.x * gridDim.y * gridDim.z;
    unsigned sum, cnt, mine, sp = 0u;
    for (;;) {
        sum = 0u; cnt = 0u; mine = 0u;
#pragma unroll
        for (unsigned j = 0; j < 16; ++j) { const unsigned c = xb_ld(&bar[XB_XCNT(j)]); sum += c; cnt += (c > 0u) ? 1u : 0u; mine = (j == x) ? c : mine; }
        if (sum == G) break;
        __builtin_amdgcn_s_sleep(1);
        if ((++sp & 255u) == 0u) { if (xb_ld(&bar[XB_TMO])) break; if (sp > XB_SPIN_CAP) { atomicAdd(&bar[XB_TMO], 1u); break; } }
    }
    nloc = mine > 0u ? mine : 1u; nx = cnt > 0u ? cnt : 1u;
}

struct XbNoHook { __device__ __forceinline__ void operator()() const {} };
template <class Hook>
__device__ __forceinline__ void xcd_barrier(const XcdBarrier& b, const Hook& hook) {
    asm volatile("s_waitcnt vmcnt(0)" ::: "memory");
    block_sync();
    hook();
    if (threadIdx.x == 0) {
        unsigned* bar = b.bar;
        __builtin_amdgcn_s_waitcnt(0);
        unsigned nloc = b.st[0], nx = b.st[1];
        if (nloc == 0u) { xcd_barrier_complete(bar, b.x, nloc, nx); b.st[0] = nloc; b.st[1] = nx; }
        const unsigned old = xb_add(&bar[XB_XSUB(b.x)], 1u);
        const unsigned gen = old / nloc;
        if (old + 1u == (gen + 1u) * nloc) {
            __builtin_amdgcn_fence(__ATOMIC_RELEASE, "agent");
            asm volatile("s_waitcnt vmcnt(0)" ::: "memory");
            const unsigned og = xb_add(&bar[XB_TOP], 1u);
            const unsigned tg = og / nx;
            if (og + 1u == (tg + 1u) * nx) xb_add(&bar[XB_TOPGEN], 1u);
            else XB_SPIN(xb_ld(&bar[XB_TOPGEN]) == tg, bar);
            __builtin_amdgcn_fence(__ATOMIC_ACQUIRE, "agent");
            xb_add(&bar[XB_XGEN(b.x)], 1u);
            asm volatile("s_waitcnt vmcnt(0)" ::: "memory");
        } else {
            XB_SPIN(xb_ld(&bar[XB_XGEN(b.x)]) == gen, bar);
            __builtin_amdgcn_fence(__ATOMIC_ACQUIRE, "agent");
            asm volatile("s_waitcnt vmcnt(0)" ::: "memory");
        }
    }
    block_sync();
}
__device__ __forceinline__ void xcd_barrier(const XcdBarrier& b) { xcd_barrier(b, XbNoHook{}); }

constexpr int WUP_PER_WG = 22;
constexpr int WUP_GOFF = WUP_PER_WG * 4096;
__device__ __forceinline__ void wup_issue(LAS unsigned char* lds, const float* W, const float* g, int bid, int wave) {
    if (wave == 0) return;
    int ln; asm volatile("v_mbcnt_lo_u32_b32 %0, -1, 0\n\tv_mbcnt_hi_u32_b32 %0, -1, %0" : "=v"(ln));
    if (wave == 7) {
#pragma unroll
        for (int q = 0; q < 4; ++q) __builtin_amdgcn_global_load_lds((const unsigned*)(g + q * 256 + 4 * ln), (LAS unsigned*)(lds + WUP_GOFF + q * 1024), 16, 0, 0); }
    for (int j = wave - 1; j < WUP_PER_WG; j += 7) { const int id = bid * WUP_PER_WG + j, kb = id & 63, nb = id >> 6;
        const float* src = W + (size_t)(kb * 16 + (ln >> 4)) * (2 * FH) + nb * 64 + 4 * (ln & 15);
#pragma unroll
        for (int q = 0; q < 4; ++q) __builtin_amdgcn_global_load_lds((const unsigned*)(src + (size_t)q * 4 * (2 * FH)), (LAS unsigned*)(lds + j * 4096 + q * 1024), 16, 0, 0); }
}
__device__ __forceinline__ void wup_convert(LAS unsigned char* lds, bf16* D, int bid, int wave) {
    asm volatile("s_waitcnt vmcnt(0)" ::: "memory");
    __builtin_amdgcn_s_barrier(); asm volatile("" ::: "memory");
    if (wave == 0) return;
    int ln; asm volatile("v_mbcnt_lo_u32_b32 %0, -1, 0\n\tv_mbcnt_hi_u32_b32 %0, -1, %0" : "=v"(ln));
    for (int j = wave - 1; j < WUP_PER_WG; j += 7) { const int id = bid * WUP_PER_WG + j, kb = id & 63, nb = id >> 6;
        const LAS float* it = (const LAS float*)(lds + j * 4096);
        const LAS pg8::f32x4* gp = (const LAS pg8::f32x4*)(lds + WUP_GOFF + kb * 64);
        const int cc = nb * 64 + ln, hf = cc >= FH ? 1 : 0, c2 = cc - FH * hf, row = 256 * (c2 >> 7) + 128 * hf + (c2 & 127);
        bf16* d = D + (size_t)row * 1024 + kb * 16;
#pragma unroll
        for (int h = 0; h < 2; ++h) { float v[8]; const pg8::f32x4 g0 = gp[2 * h], g1 = gp[2 * h + 1];
#pragma unroll
            for (int i = 0; i < 8; ++i) v[i] = it[(8 * h + i) * 64 + ln] * (i < 4 ? g0[i & 3] : g1[i & 3]);
            pg8::u32x4 o; o.x = pg8::cvt_pk_bf16(v[0], v[1]); o.y = pg8::cvt_pk_bf16(v[2], v[3]); o.z = pg8::cvt_pk_bf16(v[4], v[5]); o.w = pg8::cvt_pk_bf16(v[6], v[7]);
            *(pg8::u32x4*)(d + 8 * h) = o; } }
}
struct WcvJob { const float* W; bf16* D; int N, KB, ldd, koff, cnt, slot0; };
__device__ __forceinline__ void wcv_issue(LAS unsigned char* lds, const WcvJob& J, int bid, int wave) {
    if (wave == 0) return;
    int ln; asm volatile("v_mbcnt_lo_u32_b32 %0, -1, 0\n\tv_mbcnt_hi_u32_b32 %0, -1, %0" : "=v"(ln));
    for (int j = wave - 1; j < J.cnt; j += 7) { const int id = bid * J.cnt + j, kb = id % J.KB, nb = id / J.KB;
        const float* src = J.W + (size_t)(kb * 16 + (ln >> 4)) * J.N + nb * 64 + 4 * (ln & 15);
#pragma unroll
        for (int q = 0; q < 4; ++q) __builtin_amdgcn_global_load_lds((const unsigned*)(src + (size_t)q * 4 * J.N), (LAS unsigned*)(lds + (J.slot0 + j) * 4096 + q * 1024), 16, 0, 0); }
}
__device__ __forceinline__ void wcv_convert(LAS unsigned char* lds, const WcvJob& J, int bid, int wave) {
    if (wave == 0) return;
    int ln; asm volatile("v_mbcnt_lo_u32_b32 %0, -1, 0\n\tv_mbcnt_hi_u32_b32 %0, -1, %0" : "=v"(ln));
    for (int j = wave - 1; j < J.cnt; j += 7) { const int id = bid * J.cnt + j, kb = id % J.KB, nb = id / J.KB;
        const LAS float* it = (const LAS float*)(lds + (J.slot0 + j) * 4096);
        bf16* d = J.D + (size_t)(nb * 64 + ln) * J.ldd + J.koff + kb * 16;
#pragma unroll
        for (int h = 0; h < 2; ++h) { float v[8];
#pragma unroll
            for (int i = 0; i < 8; ++i) v[i] = it[(8 * h + i) * 64 + ln];
            pg8::u32x4 o; o.x = pg8::cvt_pk_bf16(v[0], v[1]); o.y = pg8::cvt_pk_bf16(v[2], v[3]); o.z = pg8::cvt_pk_bf16(v[4], v[5]); o.w = pg8::cvt_pk_bf16(v[6], v[7]);
            *(pg8::u32x4*)(d + 8 * h) = o; } }
}
__device__ __forceinline__ void wdn_idle_copy(LAS unsigned char* lds, const WcvJob& J, int rank, int nidle, int wave) {
    int ln; asm volatile("v_mbcnt_lo_u32_b32 %0, -1, 0\n\tv_mbcnt_hi_u32_b32 %0, -1, %0" : "=v"(ln));
    const int total = J.KB * (1024 / 64), mine = (total - rank + nidle - 1) / nidle;
    for (int base = 0; base < mine; base += 24) {
        const int n = mine - base < 24 ? mine - base : 24;
        for (int j = wave; j < n; j += 8) { const int id = rank + nidle * (base + j), kb = id % J.KB, nb = id / J.KB;
            const float* src = J.W + (size_t)(kb * 16 + (ln >> 4)) * J.N + nb * 64 + 4 * (ln & 15);
#pragma unroll
            for (int q = 0; q < 4; ++q) __builtin_amdgcn_global_load_lds((const unsigned*)(src + (size_t)q * 4 * J.N), (LAS unsigned*)(lds + j * 4096 + q * 1024), 16, 0, 0); }
        asm volatile("s_waitcnt vmcnt(0)" ::: "memory");
        for (int j = wave; j < n; j += 8) { const int id = rank + nidle * (base + j), kb = id % J.KB, nb = id / J.KB;
            const LAS float* it = (const LAS float*)(lds + j * 4096);
            bf16* d = J.D + (size_t)(nb * 64 + ln) * J.ldd + J.koff + kb * 16;
#pragma unroll
            for (int h = 0; h < 2; ++h) { float v[8];
#pragma unroll
                for (int i = 0; i < 8; ++i) v[i] = it[(8 * h + i) * 64 + ln];
                pg8::u32x4 o; o.x = pg8::cvt_pk_bf16(v[0], v[1]); o.y = pg8::cvt_pk_bf16(v[2], v[3]); o.z = pg8::cvt_pk_bf16(v[4], v[5]); o.w = pg8::cvt_pk_bf16(v[6], v[7]);
                *(pg8::u32x4*)(d + 8 * h) = o; } }
        asm volatile("s_waitcnt lgkmcnt(0)" ::: "memory");
    }
}
struct WcvHook3 { LAS unsigned char* lds; WcvJob a, b, c; int bid, wave; __device__ __forceinline__ void operator()() const { wcv_issue(lds, a, bid, wave); wcv_issue(lds, b, bid, wave); wcv_issue(lds, c, bid, wave); } };
struct WcvHook1 { LAS unsigned char* lds; WcvJob a; int bid, wave; __device__ __forceinline__ void operator()() const { wcv_issue(lds, a, bid, wave); } };
struct WupHook { LAS unsigned char* lds; const float* W; const float* g; int bid, wave; __device__ __forceinline__ void operator()() const { wup_issue(lds, W, g, bid, wave); } };
constexpr size_t MiB = 1u << 20;
constexpr int M = NB * L;
constexpr size_t WS_VSS = 0, WS_XSS = 64 * 1024, WS_X2SS = 128 * 1024, WS_TTAB = 192 * 1024, WS_BAR = 256 * 1024, WS_PCNT = 272 * 1024, WS_H3 = 1 * MiB;
constexpr size_t WS_WTA = 2 * MiB, WS_WTB = 10 * MiB, WS_PAB = 16 * MiB, WS_WO = 20 * MiB;
constexpr size_t WS_FSUM = 24 * MiB, WS_WUP = 24 * MiB, WS_WDN = 249 * MiB;
constexpr size_t WS_HYT = 41 * MiB;
constexpr size_t WS_X1B = 41 * MiB, WS_MRG = 105 * MiB;
constexpr size_t WS_YAB = 169 * MiB;
constexpr size_t WS_FDIF = 233 * MiB;
constexpr size_t WS_AP = 73 * MiB, WS_GP = 161 * MiB;
static_assert(WS_GP + (size_t)M * FH * 2 <= 256 * MiB && WS_AP + (size_t)M * FH * 2 <= WS_GP && WS_FDIF + 16 * MiB <= 256 * MiB && WS_WDN + (size_t)D * FH * 2 <= 256 * MiB && WS_WUP + (size_t)2 * FH * D * 2 <= WS_HYT, "d_ws map");
constexpr int LDS_BYTES = 155648;
static_assert(HY_LDS_END + 256 <= LDS_BYTES, "LDS map");
constexpr int NPH = 8;

struct MegaArgs { const float* in[27]; float* out; unsigned char* ws; int ph_lo, ph_hi; WJobs wj; };

__global__ void __launch_bounds__(512, 2) __attribute__((target("no-packed-fp32-ops"))) mega_fwd(MegaArgs a) {
    extern __shared__ __attribute__((aligned(16))) unsigned char lds_raw[];
    LAS unsigned char* lds = (LAS unsigned char*)lds_raw;
    cg::grid_group grid = cg::this_grid();
    const int wave = __builtin_amdgcn_readfirstlane((int)threadIdx.x >> 6);
    const int G = gridDim.x, bid = blockIdx.x, gw = bid * 8 + wave, NGW = G * 8;
#define FRESH_TID int lane; asm volatile("v_mbcnt_lo_u32_b32 %0, -1, 0\n\tv_mbcnt_hi_u32_b32 %0, -1, %0" : "=v"(lane)); const int tid = wave * 64 + lane; (void)tid
    unsigned char* ws = a.ws;
    const float* x = a.in[0];
    float* vss = (float*)(ws + WS_VSS); float* xss = (float*)(ws + WS_XSS); float* x2ss = (float*)(ws + WS_X2SS);
    cfv* Ttab = (cfv*)(ws + WS_TTAB); float* h3 = (float*)(ws + WS_H3);
    bf16* WtA = (bf16*)(ws + WS_WTA); bf16* WtB = (bf16*)(ws + WS_WTB); bf16* PabT = (bf16*)(ws + WS_PAB); bf16* WoT = (bf16*)(ws + WS_WO);
    bf16* WupT = (bf16*)(ws + WS_WUP); bf16* WdnT = (bf16*)(ws + WS_WDN);
    float* fsum = (float*)(ws + WS_FSUM); float* fdif = (float*)(ws + WS_FDIF);
    bf16* hyvT = (bf16*)(ws + WS_HYT); bf16* yaT = hyvT + (size_t)1024 * M; bf16* vT = hyvT + (size_t)3072 * M;
    bf16* YAB = (bf16*)(ws + WS_YAB); bf16* h1 = YAB; bf16* Ub = YAB + 1024;
    bf16* Gb = (bf16*)a.out;
    bf16* mrg = (bf16*)(ws + WS_MRG); bf16* X1b = (bf16*)(ws + WS_X1B); float* X1 = a.out;
    bf16* APb = (bf16*)(ws + WS_AP); bf16* GPb = (bf16*)(ws + WS_GP);
    const int lo = a.ph_lo, hi = a.ph_hi;
#define IN(k) (lo <= (k) && (k) < hi)
    for (int u = (int)threadIdx.x; u < 16; u += 512) ((LAS unsigned*)(lds + LDS_BYTES - 256))[u] = 0u;
    block_sync();
    XcdBarrier xbar = xcd_barrier_post((unsigned*)(ws + WS_BAR), (volatile LAS unsigned*)(lds + LDS_BYTES - 256));
#ifdef MK_PROBE
#define STAMP(i) do { if (threadIdx.x == 0) ((volatile LAS unsigned long long*)(lds + LDS_BYTES - 128))[i] = __builtin_amdgcn_s_memrealtime(); } while (0)
#else
#define STAMP(i) do { } while (0)
#endif
    STAMP(0);
#define SEAM(k) do { if (IN(k) && IN((k) + 1)) xcd_barrier(xbar); STAMP((k) + 1); } while (0)
    if (a.ph_hi > NPH) grid.sync();

    if (IN(0)) { FRESH_TID;
        constexpr int P0_WL = 8 * 8448;
        mlp_stage_dma(lds + P0_WL, a.in, wave, lane);
        const bool mlp_first = ((bid >> 3) & 1) != 0;
        if (mlp_first) { asm volatile("s_waitcnt vmcnt(0)" ::: "memory"); block_sync();
            for (int l = 2 * gw; l < L; l += 2 * NGW) filter_mlp_rows2((const LAS float*)(lds + P0_WL), h3, l, l + 1, lane); }
#pragma unroll 1
        for (int step = 0; step < 2; ++step) {
            if ((step == 0) != mlp_first) p0_weights(a.wj, 0, G == 256 ? 4 : 8, (LAS float*)(lds + wave * 8448), gw, NGW, lane);
            else for (int m = 4 * gw; m < M; m += 4 * NGW) rms_rowsN_to_bf16<4>(x + (size_t)m * 1024, a.in[1], h1 + (size_t)m * 2048, 2048, lane);
        }
        for (int i = bid * 512 + tid; i < 3 * M; i += G * 512) vss[i] = 0.f;
        if (tid < 4096 / 256) { const int m = bid * (4096 / 256) + tid; if (G == 256) { const float ang = (float)m / 4096.0f; Ttab[m] = (cfv){cospif(ang), -sinpif(ang)}; } }
        if (G != 256) for (int m = bid * 512 + tid; m < 4096; m += G * 512) { const float ang = (float)m / 4096.0f; Ttab[m] = (cfv){cospif(ang), -sinpif(ang)}; }
        if (!mlp_first) { asm volatile("s_waitcnt vmcnt(0)" ::: "memory");
            block_sync();
            for (int l = 2 * gw; l < L; l += 2 * NGW) filter_mlp_rows2((const LAS float*)(lds + P0_WL), h3, l, l + 1, lane); }
    }
    SEAM(0);
    if (IN(1)) {
        const bool ft_first = ((bid >> 3) & 1) != 0;
        if (ft_first) { FRESH_TID; filter_tables_wg(h3, a.in[12], a.in[13], fsum, fdif, lds, bid, G, wave, lane); }
        FRESH_TID;
        { pg8::Gemm g{WtA, h1, 4096, M, 1024, 1024, 2048}; pg8::EpiHyT E{hyvT, M, vss};
          if (G == 256) { pg8::HyOrder S; S.init(bid); pg8::gemm_phase<pg8::EpiHyT, pg8::HyOrder, true, true>(lds, g, S, E, tid); }
          else { pg8::StaticOrder S; S.init(4096, M, G, bid); pg8::gemm_phase<pg8::EpiHyT, pg8::StaticOrder, true, true>(lds, g, S, E, tid); } }
        STAMP(11);
        { pg8::Gemm g{h1, WtB, M, 3072, 1024, 2048, 1024}; pg8::StaticOrder S; S.init(M, 3072, G, bid);
          pg8::EpiUG E{Ub, Gb, 2048};
          pg8::gemm_phase<pg8::EpiUG, pg8::StaticOrder, true, true>(lds, g, S, E, tid); }
        STAMP(12);
        if (!ft_first) filter_tables_wg(h3, a.in[12], a.in[13], fsum, fdif, lds, bid, G, wave, lane);
    }
    const WcvJob jPa{a.wj.j[4].W, PabT, 1024, 64, 2048, 0, 4, 0}, jPb{a.wj.j[5].W, PabT, 1024, 64, 2048, 1024, 4, 4}, jWo{a.wj.j[6].W, WoT, 1024, 64, 1024, 0, 4, 8}, jWd{a.wj.j[7].W, WdnT, 1024, FH / 16, FH, 0, 11, 0};
    bool wcv1 = false;
    if (G == 256 && IN(1) && IN(2)) { xcd_barrier(xbar, WcvHook3{lds, jPa, jPb, jWo, bid, wave}); wcv1 = true; STAMP(2); }
    else SEAM(1);
    if (IN(2)) {
        if (G == 256) { if (!wcv1) { wcv_issue(lds, jPa, bid, wave); wcv_issue(lds, jPb, bid, wave); wcv_issue(lds, jWo, bid, wave); }
            asm volatile("s_waitcnt vmcnt(0)" ::: "memory");
            wcv_convert(lds, jPa, bid, wave); wcv_convert(lds, jPb, bid, wave); wcv_convert(lds, jWo, bid, wave);
            asm volatile("s_waitcnt lgkmcnt(0)" ::: "memory"); __builtin_amdgcn_s_barrier(); asm volatile("" ::: "memory"); }
        const bool sgu_first = ((bid >> 3) & 1) != 0;
#pragma unroll 1
        for (int step = 0; step < 2; ++step) { FRESH_TID;
            if ((step == 0) != sgu_first) {
                HyArgs H; H.hyT = hyvT; H.yaT = yaT; H.fsum = fsum; H.fdif = fdif; H.cw = a.in[3]; H.cb = a.in[4]; H.skip = a.in[14]; H.T = Ttab;
                H.TS = M; H.npairs = 2; H.off00 = 0; H.off01 = L; H.off10 = 2 * L; H.off11 = 3 * L;
                hyena_phase(lds, H, bid, G, tid, wave);
            } else {
                SguArgs Sg; Sg.vT = vT; Sg.U = Ub; Sg.vss = vss; Sg.ws = a.in[16]; Sg.bs = a.in[17]; Sg.gn = a.in[15]; Sg.TS = M; Sg.ldu = 2048;
                sgu_phase(lds, Sg, bid, G, tid, wave);
            }
            block_sync();
        }
    }
    bool wup_started = false;
    if (G == 256 && IN(2) && IN(3)) { xcd_barrier(xbar, WupHook{lds, a.wj.j[8].W, a.wj.j[8].g, bid, wave}); wup_started = true; STAMP(3); }
    else SEAM(2);
    if (IN(3)) { FRESH_TID;
        if (G == 256) { if (!wup_started) wup_issue(lds, a.wj.j[8].W, a.wj.j[8].g, bid, wave);
            wup_convert(lds, WupT, bid, wave);
            asm volatile("s_waitcnt lgkmcnt(0)" ::: "memory"); __builtin_amdgcn_s_barrier(); asm volatile("" ::: "memory"); }
        else { p0_weights(a.wj, 8, 9, (LAS float*)lds + wave * 4096, gw, NGW, lane); block_sync(); }
        pg8::Gemm g{Ub, PabT, M, 1024, 2048, 2048, 2048, yaT, M, 16}; pg8::StaticOrder S; S.init(M, 1024, G, bid);
        pg8::EpiMerge E{Gb, mrg};
        pg8::gemm_phase<pg8::EpiMerge, pg8::StaticOrder, true, true>(lds, g, S, E, tid);
    }
    SEAM(3);
    if (IN(4)) { FRESH_TID;
        pg8::Gemm g{mrg, WoT, M, 1024, 1024, 1024, 1024}; pg8::StaticOrder S; S.init(M, 1024, G, bid);
        pg8::EpiResid<true> E{x, nullptr, nullptr, X1b, xss};
        pg8::gemm_phase<pg8::EpiResid<true>, pg8::StaticOrder, true, true>(lds, g, S, E, tid);
    }
    SEAM(4);
    if (IN(5)) { FRESH_TID;
        pg8::Gemm g{X1b, WupT, M, 2 * FH, 1024, 1024, 1024}; pg8::StaticOrder S; S.init(68 * 256, 2 * FH, G, bid);
        pg8::EpiUpAct E{GPb, (LAS float*)(lds + 131072), xss, a.in[23], a.in[24]};
        pg8::gemm_phase<pg8::EpiUpAct, pg8::StaticOrder, true, true>(lds, g, S, E, tid);
        if (G == 256) { constexpr int NFULL = (68 * 22) % 256;
            if (bid >= NFULL) wdn_idle_copy(lds, jWd, bid - NFULL, 256 - NFULL, wave); }
    }
    SEAM(5);
    if (IN(6)) { FRESH_TID;
        pg8::Gemm g{GPb, WdnT, M, 1024, FH, FH, FH}; pg8::StaticOrder S; S.init(M, 1024, G, bid);
        if (G == 256) { pg8::EpiResidNorm E{X1b, a.out, x2ss, a.in[26], (unsigned*)(ws + WS_PCNT)};
            pg8::gemm_phase<pg8::EpiResidNorm, pg8::StaticOrder, true, true>(lds, g, S, E, tid); }
        else { pg8::EpiResid<false> E{nullptr, X1b, nullptr, X1b, x2ss};
            pg8::gemm_phase<pg8::EpiResid<false>, pg8::StaticOrder, true, true>(lds, g, S, E, tid); }
    }
    if (G != 256) { SEAM(6);
        if (IN(7)) { FRESH_TID; final_norm(X1b, x2ss, a.in[26], a.out, M, gw, NGW, lane); } }
    STAMP(7); STAMP(8);
#ifdef MK_PROBE
#ifndef MK_PROBE_A
#define MK_PROBE_A MK_PROBE
#define MK_PROBE_B (MK_PROBE + 1)
#endif
    if (threadIdx.x == 0) { volatile LAS unsigned long long* ts = (volatile LAS unsigned long long*)(lds + LDS_BYTES - 128);
        unsigned long long dt = 2ull * (ts[MK_PROBE_B] - ts[MK_PROBE_A]); if (dt > 400000ull) dt = 0ull; const unsigned long long t0 = __builtin_amdgcn_s_memrealtime();
        while (__builtin_amdgcn_s_memrealtime() - t0 < dt) __builtin_amdgcn_s_sleep(8); }
    block_sync();
#endif
#undef IN
#undef SEAM
}
}

#ifndef MK_CUTS
#define MK_CUTS 0
#endif
extern "C" void kernel_launch(void* const* d_in, const int* in_sizes, int n_in, void* d_out, int out_size, void* d_ws, size_t ws_size, hipStream_t stream) {
    static int grid = 0;
    if (grid == 0) {
        int dev = 0, cus = 0, per_cu = 0;
        hipGetDevice(&dev);
        hipDeviceGetAttribute(&cus, hipDeviceAttributeMultiprocessorCount, dev);
        hipFuncSetAttribute((const void*)mega_fwd, hipFuncAttributeMaxDynamicSharedMemorySize, LDS_BYTES);
        hipOccupancyMaxActiveBlocksPerMultiprocessor(&per_cu, (const void*)mega_fwd, 512, LDS_BYTES);
        if (per_cu < 1) { fprintf(stderr, "kernel_launch: occupancy query says %d blocks per CU\n", per_cu); per_cu = 1; }
        grid = cus * 1;
        (void)hipGetLastError();
    }
    hipMemsetAsync((char*)d_ws + WS_BAR, 0, 32 * 1024, stream);
    MegaArgs a{};
    for (int i = 0; i < 27; ++i) a.in[i] = (const float*)d_in[i];
    a.out = (float*)d_out; a.ws = (unsigned char*)d_ws;
    { unsigned char* ws = (unsigned char*)d_ws;
      bf16* WtA = (bf16*)(ws + WS_WTA); bf16* WtB = (bf16*)(ws + WS_WTB); bf16* PabT = (bf16*)(ws + WS_PAB); bf16* WoT = (bf16*)(ws + WS_WO); bf16* WupT = (bf16*)(ws + WS_WUP); bf16* WdnT = (bf16*)(ws + WS_WDN);
    a.wj.j[0] = WJob{(const float*)d_in[2], nullptr, WtA, 1024, INW, 0, 3072, 1024, 0, 0, 0};
    a.wj.j[1] = WJob{(const float*)d_in[2], nullptr, WtA, 1024, INW, 4096, 1024, 1024, 3072, 0, 0};
    a.wj.j[2] = WJob{(const float*)d_in[2], nullptr, WtB, 1024, INW, 3072, 1024, 1024, 0, 0, 0};
    a.wj.j[3] = WJob{(const float*)d_in[2], nullptr, WtB, 1024, INW, 5120, 2048, 1024, 1024, 0, 1024};
    a.wj.j[4] = WJob{(const float*)d_in[18], nullptr, PabT, 1024, 1024, 0, 1024, 2048, 0, 0, 0};
    a.wj.j[5] = WJob{(const float*)d_in[19], nullptr, PabT, 1024, 1024, 0, 1024, 2048, 0, 1024, 0};
    a.wj.j[6] = WJob{(const float*)d_in[20], nullptr, WoT, 1024, 1024, 0, 1024, 1024, 0, 0, 0};
        a.wj.j[7] = WJob{(const float*)d_in[25], nullptr, WdnT, FH, 1024, 0, 1024, FH, 0, 0, 0};
    a.wj.j[8] = WJob{(const float*)d_in[22], (const float*)d_in[21], WupT, 1024, 2 * FH, 0, 2 * FH, 1024, 0, 0, FH};

    }
#if MK_CUTS
    for (int p = 0; p < NPH; ++p) { a.ph_lo = p; a.ph_hi = p + 1; hipLaunchKernelGGL(mega_fwd, dim3(grid), dim3(512), LDS_BYTES, stream, a); }
#else
    a.ph_lo = 0; a.ph_hi = NPH;
    void* args[] = {&a};
    hipError_t e = hipLaunchCooperativeKernel((const void*)mega_fwd, dim3(grid), dim3(512), args, LDS_BYTES, stream);
    if (e != hipSuccess) fprintf(stderr, "cooperative launch failed: %s (grid %d)\n", hipGetErrorString(e), grid);
#endif
}
```
